# Optimizing an MI355X kernel written in HIP

```python
import math
import jax, jax.numpy as jnp
from jax import lax
import numpy as np

D_MODEL = 1024
BATCH = 4
SEQ = 8192
DEPTH = 2

HEAD_DIM = 64
A_Q_HEADS = 8
A_KV_HEADS = 2
A_GROUP = A_Q_HEADS // A_KV_HEADS
WINDOW = 128
BLOCK = 128
ROPE_THETA = 500000.0
ROPE_DIM = HEAD_DIM // 4
A_WIDTH = A_Q_HEADS * HEAD_DIM
KV_WIDTH = A_KV_HEADS * HEAD_DIM
B_GROUPS = 8
B_GROUP_DIM = 64
B_WIDTH = B_GROUPS * B_GROUP_DIM
CHUNK = 128
EVEN_IN_WIDTH = A_WIDTH + 2 * KV_WIDTH + 2 * B_WIDTH
EVEN_MIX_WIDTH = A_WIDTH + B_WIDTH
POOL_WINDOWS = (2, 4, 8, 16)
POOL_GROUPS = len(POOL_WINDOWS)
POOL_WIDTH = D_MODEL
POOL_GROUP_DIM = POOL_WIDTH // POOL_GROUPS
MEM_LEN = 256
X_HEADS = 4
X_HEAD_DIM = D_MODEL // X_HEADS
N_EXPERTS = 16
N_EXPERT_GROUPS = 4
EXPERTS_PER_GROUP = N_EXPERTS // N_EXPERT_GROUPS
TOP_K = 2
D_EXPERT = D_MODEL // 2
ALPHA = (2.0 * DEPTH) ** 0.25
BETA = (8.0 * DEPTH) ** -0.25
LN_EPS = 1e-5

kernel_name = "hybrid_swa_sgu_pool_memxattn_groupmoe"


def layer_norm(x, g, b):
    xf = x.astype(jnp.float32)
    mu = jnp.mean(xf, axis=-1, keepdims=True)
    var = jnp.mean(jnp.square(xf - mu), axis=-1, keepdims=True)
    y = (xf - mu) * lax.rsqrt(var + LN_EPS) * g.astype(jnp.float32) + b.astype(jnp.float32)
    return y.astype(x.dtype)


def partial_rope(t, positions):
    half = ROPE_DIM // 2
    inv_freq = ROPE_THETA ** (-(jnp.arange(half, dtype=jnp.float32) * 2.0 / ROPE_DIM))
    ang = positions.astype(jnp.float32)[..., None] * inv_freq
    cos = jnp.cos(ang)[:, :, None, :]
    sin = jnp.sin(ang)[:, :, None, :]
    tr = t[..., :ROPE_DIM].astype(jnp.float32)
    t1, t2 = tr[..., :half], tr[..., half:]
    rot = jnp.concatenate([t1 * cos - t2 * sin, t2 * cos + t1 * sin], axis=-1).astype(t.dtype)
    return jnp.concatenate([rot, t[..., ROPE_DIM:]], axis=-1)


def sliding_window_sink_attention(q, k, v, sinks):
    bsz, s_len = q.shape[0], q.shape[1]
    nb = s_len // BLOCK
    qb = q.reshape(bsz, nb, BLOCK, A_KV_HEADS, A_GROUP, HEAD_DIM)

    def with_prev(t):
        tb = t.reshape(bsz, nb, BLOCK, A_KV_HEADS, HEAD_DIM)
        prev = jnp.pad(tb[:, :-1], ((0, 0), (1, 0), (0, 0), (0, 0), (0, 0)))
        return jnp.concatenate([prev, tb], axis=2)

    kb, vb = with_prev(k), with_prev(v)
    s = jnp.einsum('bnqhgd,bnkhd->bnhgqk', qb, kb).astype(jnp.float32) * (HEAD_DIM ** -0.5)
    qi = jnp.arange(BLOCK)[:, None]
    kj = jnp.arange(2 * BLOCK)[None, :]
    rel = qi + BLOCK - kj
    band = (rel >= 0) & (rel < WINDOW)
    not_before_start = (jnp.arange(nb)[:, None, None] > 0) | (kj[None] >= BLOCK)
    valid = band[None] & not_before_start
    s = jnp.where(valid[None, :, None, None], s, -jnp.inf)
    sink = sinks.astype(jnp.float32).reshape(A_KV_HEADS, A_GROUP)[None, None, :, :, None, None]
    m = jnp.maximum(jnp.max(s, axis=-1, keepdims=True), sink)
    p = jnp.exp(s - m)
    denom = jnp.sum(p, axis=-1, keepdims=True) + jnp.exp(sink - m)
    p = (p / denom).astype(v.dtype)
    o = jnp.einsum('bnhgqk,bnkhd->bnqhgd', p, vb)
    return o.reshape(bsz, s_len, A_WIDTH)


def chunked_spatial_gating(u, v, ln_g, ln_b, w_s, b_s):
    bsz, s_len = u.shape[0], u.shape[1]
    nc = s_len // CHUNK
    vg = v.reshape(bsz, s_len, B_GROUPS, B_GROUP_DIM)
    vg = layer_norm(vg, ln_g.reshape(B_GROUPS, B_GROUP_DIM), ln_b.reshape(B_GROUPS, B_GROUP_DIM))
    vg = vg.reshape(bsz, nc, CHUNK, B_GROUPS, B_GROUP_DIM)
    causal = jnp.tril(jnp.ones((CHUNK, CHUNK), dtype=bool))
    w = jnp.where(causal[None], w_s, jnp.zeros_like(w_s))
    mixed = jnp.einsum('gts,bnsgc->bntgc', w, vg) + b_s.T[None, None, :, :, None]
    return u * mixed.reshape(bsz, s_len, B_WIDTH)


def even_mixer(x, positions, w_in, sinks, sgu_ln_g, sgu_ln_b, sgu_w, sgu_b, w_out):
    bsz, s_len, _ = x.shape
    h = x @ w_in
    c1 = A_WIDTH
    c2 = c1 + KV_WIDTH
    c3 = c2 + KV_WIDTH
    c4 = c3 + B_WIDTH
    q, k, v, bu, bv = h[..., :c1], h[..., c1:c2], h[..., c2:c3], h[..., c3:c4], h[..., c4:]
    q = partial_rope(q.reshape(bsz, s_len, A_Q_HEADS, HEAD_DIM), positions)
    k = partial_rope(k.reshape(bsz, s_len, A_KV_HEADS, HEAD_DIM), positions)
    v = v.reshape(bsz, s_len, A_KV_HEADS, HEAD_DIM)
    a_out = sliding_window_sink_attention(q, k, v, sinks)
    b_out = chunked_spatial_gating(jax.nn.gelu(bu), jax.nn.gelu(bv), sgu_ln_g, sgu_ln_b, sgu_w, sgu_b)
    return jnp.concatenate([a_out, b_out], axis=-1) @ w_out


def odd_mixer(x, w_in, pool_w, pool_scale, w_out):
    bsz, s_len, _ = x.shape
    h = x @ w_in
    hf = h.astype(jnp.float32)
    csum = jnp.cumsum(hf, axis=1)
    counts_base = jnp.arange(1, s_len + 1, dtype=jnp.float32)
    groups = []
    for g, win in enumerate(POOL_WINDOWS):
        sl = slice(g * POOL_GROUP_DIM, (g + 1) * POOL_GROUP_DIM)
        c = csum[..., sl]
        lagged = jnp.pad(c, ((0, 0), (win, 0), (0, 0)))[:, :s_len]
        count = jnp.minimum(counts_base, float(win))[None, :, None]
        groups.append((c - lagged) / count - hf[..., sl])
    pooled = jnp.stack(groups, axis=2).astype(x.dtype)
    mapped = jnp.einsum('bsgc,gcd->bsgd', pooled, pool_w).reshape(bsz, s_len, POOL_WIDTH)
    return (mapped * pool_scale) @ w_out


def memory_cross_attention(x, mem, wq, wkv, wo):
    bsz, s_len, _ = x.shape
    q = (x @ wq).reshape(bsz, s_len, X_HEADS, X_HEAD_DIM)
    kv = (mem @ wkv).reshape(bsz, mem.shape[1], 2, X_HEADS, X_HEAD_DIM)
    k, v = kv[:, :, 0], kv[:, :, 1]
    s = jnp.einsum('bshd,bmhd->bhsm', q, k).astype(jnp.float32) * (X_HEAD_DIM ** -0.5)
    p = jax.nn.softmax(s, axis=-1).astype(v.dtype)
    o = jnp.einsum('bhsm,bmhd->bshd', p, v).reshape(bsz, s_len, D_MODEL)
    return o @ wo


def grouped_moe(x, router_w, router_bias, w_gate, w_up, w_down):
    bsz, s_len, d = x.shape
    xt = x.reshape(-1, d)
    scores = jax.nn.softmax((xt @ router_w).astype(jnp.float32), axis=-1)
    biased = scores + router_bias.astype(jnp.float32)
    grouped = biased.reshape(-1, N_EXPERT_GROUPS, EXPERTS_PER_GROUP)
    group_score = jnp.sum(lax.top_k(grouped, TOP_K)[0], axis=-1)
    g_sel = jnp.argmax(group_score, axis=-1)
    in_group = jnp.take_along_axis(grouped, g_sel[:, None, None], axis=1)[:, 0]
    _, local_idx = lax.top_k(in_group, TOP_K)
    expert_idx = g_sel[:, None] * EXPERTS_PER_GROUP + local_idx
    sel = jnp.take_along_axis(scores, expert_idx, axis=1)
    weights = sel / jnp.sum(sel, axis=-1, keepdims=True)
    combine = jnp.sum(jax.nn.one_hot(expert_idx, N_EXPERTS, dtype=jnp.float32) * weights[..., None], axis=1)
    y = jnp.zeros(xt.shape, dtype=jnp.float32)
    for e in range(N_EXPERTS):
        he = jax.nn.silu(xt @ w_gate[e]) * (xt @ w_up[e])
        y = y + combine[:, e:e + 1] * (he @ w_down[e]).astype(jnp.float32)
    return y.astype(x.dtype).reshape(bsz, s_len, d)


def setup_inputs(seed: int = 0) -> dict:
    key = jax.random.key(seed)
    keys = iter(jax.random.split(key, 64))
    f32 = jnp.float32

    def nrm(shape, scale):
        return jax.random.normal(next(keys), shape, f32) * scale

    def gain(n):
        return 1.0 + nrm((n,), 0.05)

    def bias(n):
        return nrm((n,), 0.02)

    inp = {}
    inp["x"] = nrm((BATCH, SEQ, D_MODEL), 1.0)
    inp["mem"] = nrm((BATCH, MEM_LEN, D_MODEL), 1.0)
    offset = jax.random.randint(next(keys), (BATCH, 1), 0, 4096, dtype=jnp.int32)
    inp["positions"] = (offset + jnp.arange(SEQ, dtype=jnp.int32)[None, :]).astype(jnp.int32)
    inp["router_w"] = nrm((D_MODEL, N_EXPERTS), D_MODEL ** -0.5)
    inp["router_bias"] = nrm((N_EXPERTS,), 0.01)

    def common(prefix):
        inp[prefix + "ln1_g"] = gain(D_MODEL)
        inp[prefix + "ln1_b"] = bias(D_MODEL)
        inp[prefix + "xq"] = nrm((D_MODEL, D_MODEL), D_MODEL ** -0.5)
        inp[prefix + "xkv"] = nrm((D_MODEL, 2 * D_MODEL), D_MODEL ** -0.5)
        inp[prefix + "xo"] = nrm((D_MODEL, D_MODEL), BETA * D_MODEL ** -0.5)
        inp[prefix + "ln2_g"] = gain(D_MODEL)
        inp[prefix + "ln2_b"] = bias(D_MODEL)
        inp[prefix + "e_gate"] = nrm((N_EXPERTS, D_MODEL, D_EXPERT), D_MODEL ** -0.5)
        inp[prefix + "e_up"] = nrm((N_EXPERTS, D_MODEL, D_EXPERT), D_MODEL ** -0.5)
        inp[prefix + "e_down"] = nrm((N_EXPERTS, D_EXPERT, D_MODEL), BETA * D_EXPERT ** -0.5)
        inp[prefix + "ln3_g"] = gain(D_MODEL)
        inp[prefix + "ln3_b"] = bias(D_MODEL)

    inp["l0_w_in"] = nrm((D_MODEL, EVEN_IN_WIDTH), D_MODEL ** -0.5)
    inp["l0_sinks"] = nrm((A_Q_HEADS,), 0.5)
    inp["l0_sgu_ln_g"] = gain(B_WIDTH)
    inp["l0_sgu_ln_b"] = bias(B_WIDTH)
    inp["l0_sgu_w"] = nrm((B_GROUPS, CHUNK, CHUNK), CHUNK ** -0.5)
    inp["l0_sgu_b"] = 1.0 + nrm((B_GROUPS, CHUNK), 0.1)
    inp["l0_w_out"] = nrm((EVEN_MIX_WIDTH, D_MODEL), BETA * EVEN_MIX_WIDTH ** -0.5)
    common("l0_")
    inp["l1_w_in"] = nrm((D_MODEL, POOL_WIDTH), D_MODEL ** -0.5)
    inp["l1_pool_w"] = nrm((POOL_GROUPS, POOL_GROUP_DIM, POOL_GROUP_DIM), POOL_GROUP_DIM ** -0.5)
    inp["l1_pool_scale"] = 1.0 + nrm((POOL_WIDTH,), 0.1)
    inp["l1_w_out"] = nrm((POOL_WIDTH, D_MODEL), BETA * POOL_WIDTH ** -0.5)
    common("l1_")

    order = ["x", "mem", "positions", "router_w", "router_bias",
             "l0_w_in", "l0_sinks", "l0_sgu_ln_g", "l0_sgu_ln_b", "l0_sgu_w", "l0_sgu_b", "l0_w_out",
             "l0_ln1_g", "l0_ln1_b", "l0_xq", "l0_xkv", "l0_xo", "l0_ln2_g", "l0_ln2_b",
             "l0_e_gate", "l0_e_up", "l0_e_down", "l0_ln3_g", "l0_ln3_b",
             "l1_w_in", "l1_pool_w", "l1_pool_scale", "l1_w_out",
             "l1_ln1_g", "l1_ln1_b", "l1_xq", "l1_xkv", "l1_xo", "l1_ln2_g", "l1_ln2_b",
             "l1_e_gate", "l1_e_up", "l1_e_down", "l1_ln3_g", "l1_ln3_b"]
    return {name: inp[name] for name in order}


def reference(x, mem, positions, router_w, router_bias,
              l0_w_in, l0_sinks, l0_sgu_ln_g, l0_sgu_ln_b, l0_sgu_w, l0_sgu_b, l0_w_out,
              l0_ln1_g, l0_ln1_b, l0_xq, l0_xkv, l0_xo, l0_ln2_g, l0_ln2_b,
              l0_e_gate, l0_e_up, l0_e_down, l0_ln3_g, l0_ln3_b,
              l1_w_in, l1_pool_w, l1_pool_scale, l1_w_out,
              l1_ln1_g, l1_ln1_b, l1_xq, l1_xkv, l1_xo, l1_ln2_g, l1_ln2_b,
              l1_e_gate, l1_e_up, l1_e_down, l1_ln3_g, l1_ln3_b):
    mixer_params = [
        (l0_w_in, l0_sinks, l0_sgu_ln_g, l0_sgu_ln_b, l0_sgu_w, l0_sgu_b, l0_w_out),
        (l1_w_in, l1_pool_w, l1_pool_scale, l1_w_out),
    ]
    layer_params = [
        (l0_ln1_g, l0_ln1_b, l0_xq, l0_xkv, l0_xo, l0_ln2_g, l0_ln2_b,
         l0_e_gate, l0_e_up, l0_e_down, l0_ln3_g, l0_ln3_b),
        (l1_ln1_g, l1_ln1_b, l1_xq, l1_xkv, l1_xo, l1_ln2_g, l1_ln2_b,
         l1_e_gate, l1_e_up, l1_e_down, l1_ln3_g, l1_ln3_b),
    ]
    for layer in range(DEPTH):
        if layer % 2 == 0:
            mix = even_mixer(x, positions, *mixer_params[layer])
        else:
            mix = odd_mixer(x, *mixer_params[layer])
        (ln1_g, ln1_b, xq, xkv, xo, ln2_g, ln2_b,
         e_gate, e_up, e_down, ln3_g, ln3_b) = layer_params[layer]
        x = layer_norm(ALPHA * x + mix, ln1_g, ln1_b)
        x = layer_norm(ALPHA * x + memory_cross_attention(x, mem, xq, xkv, xo), ln2_g, ln2_b)
        x = layer_norm(ALPHA * x + grouped_moe(x, router_w, router_bias, e_gate, e_up, e_down), ln3_g, ln3_b)
    return x
```

```cpp
#include <hip/hip_runtime.h>
#include <stdint.h>
#include <math.h>

typedef unsigned short bf16_t;

namespace nv {
constexpr int B = 4, S = 8192, T = B * S, D = 1024;
constexpr int NIN0 = 1792;
constexpr int MEM = 256, XH = 4, XHD = 256;
constexpr int NE = 16, DE = 512;
constexpr int MPAD = 65536 + 16 * 256;
constexpr int NTILE = MPAD / 256;
constexpr float ALPHA = 1.4142135623730951f;
constexpr float LN_EPS = 1e-5f;
constexpr float QSCALE = 0.0625f * 1.4426950408889634f;
constexpr float ASCALE = 0.125f * 1.4426950408889634f;

constexpr size_t MiB = 1u << 20;
constexpr size_t WS_CTL = 0;
constexpr size_t WS_ROPE = 2 * MiB;
constexpr size_t WS_EIDX = 4 * MiB;
constexpr size_t WS_EWGT = 5 * MiB;
constexpr size_t WS_POS = 6 * MiB;
constexpr size_t WS_BCNT = 7 * MiB;
constexpr size_t WS_TILE = 7 * MiB + 65536;
constexpr size_t WS_TOK = 7 * MiB + 131072;
constexpr size_t WS_MEMKV = 8 * MiB;
constexpr size_t WS_MEMVT = 16 * MiB;
constexpr size_t WS_WB = 24 * MiB;
constexpr size_t WS_A = 152 * MiB, WS_B = 220 * MiB, WS_C = 288 * MiB, WS_D = 356 * MiB, WS_END = 492 * MiB;

__device__ __forceinline__ float bf2f(bf16_t v) { return __uint_as_float((unsigned)v << 16); }
__device__ __forceinline__ bf16_t f2bf(float f) { unsigned u = __float_as_uint(f); return (bf16_t)((u + 0x7fffu + ((u >> 16) & 1u)) >> 16); }
__device__ __forceinline__ float gelu_tanh(float x) { const float u = 0.7978845608028654f * (x + 0.044715f * x * x * x); const float e = __expf(2.f * u); const float th = 1.f - 2.f / (e + 1.f); return 0.5f * x * (1.f + th); }
__device__ __forceinline__ float silu(float x) { return x / (1.f + __expf(-x)); }
__device__ __forceinline__ float wave_sum(float v) {
#pragma unroll
    for (int o = 1; o < 64; o <<= 1) v += __shfl_xor(v, o);
    return v;
}
__device__ __forceinline__ float wave_max(float v) {
#pragma unroll
    for (int o = 1; o < 64; o <<= 1) v = fmaxf(v, __shfl_xor(v, o));
    return v;
}

template <class Epi>
__global__ __launch_bounds__(256) void k_gemm(const bf16_t* A, int lda, const float* W, int ldw, int K, Epi epi, const int* tile_e, size_t w_stride, const int* arow) {
    __shared__ float As[16][68];
    __shared__ float Bs[16][68];
    const int bm = blockIdx.y * 64, bn = blockIdx.x * 64;
    const float* Wp = W;
    if (tile_e) { const int e = tile_e[bm >> 8]; if (e < 0) return; Wp += (size_t)e * w_stride; }
    const int tid = threadIdx.x, tx = tid & 15, ty = tid >> 4;
    float acc[4][4];
#pragma unroll
    for (int i = 0; i < 4; ++i)
#pragma unroll
        for (int j = 0; j < 4; ++j) acc[i][j] = 0.f;
    for (int k0 = 0; k0 < K; k0 += 16) {
        {
            const int r = tid >> 2, kk = (tid & 3) * 4;
            const int ar = arow ? arow[bm + r] : bm + r;
            const ushort4 v = *(const ushort4*)(A + (size_t)ar * lda + k0 + kk);
            As[kk + 0][r] = bf2f(v.x); As[kk + 1][r] = bf2f(v.y); As[kk + 2][r] = bf2f(v.z); As[kk + 3][r] = bf2f(v.w);
        }
        {
            const int kk = tid >> 4, n = (tid & 15) * 4;
            const float4 v = *(const float4*)(Wp + (size_t)(k0 + kk) * ldw + bn + n);
            Bs[kk][n + 0] = v.x; Bs[kk][n + 1] = v.y; Bs[kk][n + 2] = v.z; Bs[kk][n + 3] = v.w;
        }
        __syncthreads();
#pragma unroll
        for (int kk = 0; kk < 16; ++kk) {
            float a[4], b[4];
#pragma unroll
            for (int i = 0; i < 4; ++i) a[i] = As[kk][ty * 4 + i];
#pragma unroll
            for (int j = 0; j < 4; ++j) b[j] = Bs[kk][tx * 4 + j];
#pragma unroll
            for (int i = 0; i < 4; ++i)
#pragma unroll
                for (int j = 0; j < 4; ++j) acc[i][j] += a[i] * b[j];
        }
        __syncthreads();
    }
#pragma unroll
    for (int i = 0; i < 4; ++i)
#pragma unroll
        for (int j = 0; j < 4; ++j) epi(bm + ty * 4 + i, bn + tx * 4 + j, acc[i][j]);
}

struct EpiBf16 { bf16_t* O; int ldo; float scale; __device__ void operator()(int r, int c, float v) const { O[(size_t)r * ldo + c] = f2bf(v * scale); } };
struct EpiInproj0 { bf16_t* O; __device__ void operator()(int r, int c, float v) const { if (c >= 768) v = gelu_tanh(v); O[(size_t)r * NIN0 + c] = f2bf(v); } };
struct EpiF32 { float* O; int ldo; __device__ void operator()(int r, int c, float v) const { O[(size_t)r * ldo + c] = v; } };
struct EpiSiluMul { const float* G; bf16_t* HS; __device__ void operator()(int r, int c, float v) const { HS[(size_t)r * DE + c] = f2bf(silu(G[(size_t)r * DE + c]) * v); } };
struct EpiKV { bf16_t* Kb; bf16_t* Vt; __device__ void operator()(int r, int c, float v) const {
    Kb[(size_t)r * 2048 + c] = f2bf(v);
    if (c >= 1024) { const int d = c - 1024, h = d >> 8, dd = d & 255, b = r >> 8, key = r & 255; Vt[((size_t)(b * XH + h) * XHD + dd) * MEM + key] = f2bf(v); } } };
struct EpiPoolMap { bf16_t* O; const float* scale; int coff; __device__ void operator()(int r, int c, float v) const { O[(size_t)r * D + coff + c] = f2bf(v * scale[coff + c]); } };

__global__ void k_cvt_x(const float* x, bf16_t* xb, size_t n4) {
    for (size_t i = (size_t)blockIdx.x * blockDim.x + threadIdx.x; i < n4; i += (size_t)gridDim.x * blockDim.x) {
        const float4 v = ((const float4*)x)[i];
        ushort4 o; o.x = f2bf(v.x); o.y = f2bf(v.y); o.z = f2bf(v.z); o.w = f2bf(v.w);
        ((ushort4*)xb)[i] = o;
    }
}
struct InvFreq { float f[8]; };
__global__ void k_rope_table(const int* positions, float* tab, InvFreq inv) {
    const int t = blockIdx.x * blockDim.x + threadIdx.x;
    if (t >= T) return;
    const float p = (float)positions[t];
#pragma unroll
    for (int j = 0; j < 8; ++j) {
        const float ang = p * inv.f[j];
        double rev = (double)ang * 0.15915494309189535; rev -= rint(rev);
        const float r = (float)rev;
        tab[(size_t)t * 16 + j] = __builtin_amdgcn_cosf(r);
        tab[(size_t)t * 16 + 8 + j] = __builtin_amdgcn_sinf(r);
    }
}
__global__ void k_rope_apply(bf16_t* H0, const float* tab) {
    const int i = blockIdx.x * blockDim.x + threadIdx.x;
    if (i >= T * 80) return;
    const int t = i / 80, r = i % 80, hd = r >> 3, j = r & 7;
    bf16_t* p = H0 + (size_t)t * NIN0 + hd * 64;
    const float t1 = bf2f(p[j]), t2 = bf2f(p[j + 8]);
    const float c = tab[(size_t)t * 16 + j], s = tab[(size_t)t * 16 + 8 + j];
    p[j] = f2bf(t1 * c - t2 * s); p[j + 8] = f2bf(t2 * c + t1 * s);
}

__global__ __launch_bounds__(128) void k_swa(const bf16_t* H0, const float* sinks, bf16_t* MIX) {
    __shared__ float Ks[256][65];
    __shared__ float Vs[256][65];
    const int head = blockIdx.x & 7, bn = blockIdx.x >> 3, n = bn & 63, b = bn >> 6;
    const int kvh = head >> 2;
    const int tid = threadIdx.x;
    const size_t row0 = (size_t)b * S + (size_t)n * 128;
    for (int idx = tid; idx < 256 * 64; idx += 128) {
        const int kj = idx >> 6, d = idx & 63;
        float kv = 0.f, vv = 0.f;
        if (n > 0 || kj >= 128) {
            const size_t row = row0 - 128 + kj;
            kv = bf2f(H0[row * NIN0 + 512 + kvh * 64 + d]);
            vv = bf2f(H0[row * NIN0 + 640 + kvh * 64 + d]);
        }
        Ks[kj][d] = kv; Vs[kj][d] = vv;
    }
    __syncthreads();
    float q[64], o[64];
    const bf16_t* qp = H0 + (row0 + tid) * NIN0 + head * 64;
#pragma unroll
    for (int d = 0; d < 64; ++d) { q[d] = bf2f(qp[d]) * ASCALE; o[d] = 0.f; }
    const float sink = sinks[head] * 1.4426950408889634f;
    float m = sink, l = 1.f;
    for (int kj = tid + 1; kj <= tid + 128; ++kj) {
        if (n == 0 && kj < 128) continue;
        float s = 0.f;
#pragma unroll
        for (int d = 0; d < 64; ++d) s += q[d] * Ks[kj][d];
        const float mn = fmaxf(m, s), sc = exp2f(m - mn), p = exp2f(s - mn);
        l = l * sc + p; m = mn;
#pragma unroll
        for (int d = 0; d < 64; ++d) o[d] = o[d] * sc + p * Vs[kj][d];
    }
    const float inv = 1.f / l;
    bf16_t* op = MIX + (row0 + tid) * D + head * 64;
#pragma unroll
    for (int d = 0; d < 64; ++d) op[d] = f2bf(o[d] * inv);
}

__global__ void k_sgu_ln(const bf16_t* H0, const float* lg, const float* lb, bf16_t* VG) {
    const int i = blockIdx.x * blockDim.x + threadIdx.x;
    if (i >= T * 8) return;
    const int t = i >> 3, g = i & 7;
    const bf16_t* p = H0 + (size_t)t * NIN0 + 1280 + g * 64;
    float s = 0.f;
    for (int c = 0; c < 64; ++c) s += bf2f(p[c]);
    const float mu = s * (1.f / 64.f);
    float q = 0.f;
    for (int c = 0; c < 64; ++c) { const float d = bf2f(p[c]) - mu; q += d * d; }
    const float rstd = 1.f / sqrtf(q * (1.f / 64.f) + LN_EPS);
    for (int c = 0; c < 64; ++c) VG[(size_t)t * 512 + g * 64 + c] = f2bf((bf2f(p[c]) - mu) * rstd * lg[g * 64 + c] + lb[g * 64 + c]);
}
__global__ void k_sgu_mix(const bf16_t* H0, const bf16_t* VG, const float* w, const float* bs, bf16_t* MIX) {
    const size_t i = (size_t)blockIdx.x * blockDim.x + threadIdx.x;
    if (i >= (size_t)T * 512) return;
    const int t = (int)(i >> 9), ch = (int)(i & 511), g = ch >> 6, tl = t & 127;
    const size_t c0 = (size_t)(t - tl);
    const float* wr = w + ((size_t)g * 128 + tl) * 128;
    float acc = 0.f;
    for (int s = 0; s <= tl; ++s) acc += wr[s] * bf2f(VG[(c0 + s) * 512 + ch]);
    acc += bs[g * 128 + tl];
    MIX[(size_t)t * D + 512 + ch] = f2bf(bf2f(H0[(size_t)t * NIN0 + 768 + ch]) * acc);
}

struct Row16 { float v[4][4]; };
__device__ __forceinline__ void load_row_bf16(const bf16_t* p, int lane, Row16& r) {
#pragma unroll
    for (int j = 0; j < 4; ++j) { const ushort4 u = *(const ushort4*)(p + 256 * j + 4 * lane); r.v[j][0] = bf2f(u.x); r.v[j][1] = bf2f(u.y); r.v[j][2] = bf2f(u.z); r.v[j][3] = bf2f(u.w); }
}
__device__ __forceinline__ void ln_row(Row16& z, const float* g, const float* b, int lane) {
    float s = 0.f;
#pragma unroll
    for (int j = 0; j < 4; ++j)
#pragma unroll
        for (int i = 0; i < 4; ++i) s += z.v[j][i];
    const float mu = wave_sum(s) * (1.f / D);
    float q = 0.f;
#pragma unroll
    for (int j = 0; j < 4; ++j)
#pragma unroll
        for (int i = 0; i < 4; ++i) { z.v[j][i] -= mu; q += z.v[j][i] * z.v[j][i]; }
    const float rstd = 1.f / sqrtf(wave_sum(q) * (1.f / D) + LN_EPS);
#pragma unroll
    for (int j = 0; j < 4; ++j) { const float4 gg = *(const float4*)(g + 256 * j + 4 * lane), bb = *(const float4*)(b + 256 * j + 4 * lane);
        z.v[j][0] = z.v[j][0] * rstd * gg.x + bb.x; z.v[j][1] = z.v[j][1] * rstd * gg.y + bb.y; z.v[j][2] = z.v[j][2] * rstd * gg.z + bb.z; z.v[j][3] = z.v[j][3] * rstd * gg.w + bb.w; }
}
__device__ __forceinline__ void store_row_bf16(bf16_t* p, int lane, const Row16& r) {
#pragma unroll
    for (int j = 0; j < 4; ++j) { ushort4 u; u.x = f2bf(r.v[j][0]); u.y = f2bf(r.v[j][1]); u.z = f2bf(r.v[j][2]); u.w = f2bf(r.v[j][3]); *(ushort4*)(p + 256 * j + 4 * lane) = u; }
}
__global__ __launch_bounds__(256) void k_ln_add(const bf16_t* X, const bf16_t* Y, const float* g, const float* b, bf16_t* out) {
    const int lane = threadIdx.x & 63, row = blockIdx.x * 4 + (threadIdx.x >> 6);
    Row16 x, y; load_row_bf16(X + (size_t)row * D, lane, x); load_row_bf16(Y + (size_t)row * D, lane, y);
#pragma unroll
    for (int j = 0; j < 4; ++j)
#pragma unroll
        for (int i = 0; i < 4; ++i) x.v[j][i] = ALPHA * x.v[j][i] + y.v[j][i];
    ln_row(x, g, b, lane);
    store_row_bf16(out + (size_t)row * D, lane, x);
}
__global__ __launch_bounds__(256) void k_ln_router(const bf16_t* X, const bf16_t* Y, const float* g, const float* b, bf16_t* out, const float* rw, const float* rbias, int* eidx, float* ewgt) {
    const int lane = threadIdx.x & 63, row = blockIdx.x * 4 + (threadIdx.x >> 6);
    Row16 x, y; load_row_bf16(X + (size_t)row * D, lane, x); load_row_bf16(Y + (size_t)row * D, lane, y);
#pragma unroll
    for (int j = 0; j < 4; ++j)
#pragma unroll
        for (int i = 0; i < 4; ++i) x.v[j][i] = ALPHA * x.v[j][i] + y.v[j][i];
    ln_row(x, g, b, lane);
    store_row_bf16(out + (size_t)row * D, lane, x);
    float lg[16];
#pragma unroll
    for (int e = 0; e < 16; ++e) lg[e] = 0.f;
#pragma unroll
    for (int j = 0; j < 4; ++j)
#pragma unroll
        for (int i = 0; i < 4; ++i) {
            const float* wr = rw + (size_t)(256 * j + 4 * lane + i) * 16;
            const float xv = x.v[j][i];
#pragma unroll
            for (int e4 = 0; e4 < 4; ++e4) { const float4 w4 = *(const float4*)(wr + 4 * e4); lg[4 * e4 + 0] += xv * w4.x; lg[4 * e4 + 1] += xv * w4.y; lg[4 * e4 + 2] += xv * w4.z; lg[4 * e4 + 3] += xv * w4.w; }
        }
#pragma unroll
    for (int e = 0; e < 16; ++e) lg[e] = wave_sum(lg[e]);
    float mx = lg[0];
#pragma unroll
    for (int e = 1; e < 16; ++e) mx = fmaxf(mx, lg[e]);
    float sc[16], sum = 0.f;
#pragma unroll
    for (int e = 0; e < 16; ++e) { sc[e] = expf(lg[e] - mx); sum += sc[e]; }
    const float isum = 1.f / sum;
    float bz[16];
#pragma unroll
    for (int e = 0; e < 16; ++e) { sc[e] *= isum; bz[e] = sc[e] + rbias[e]; }
    float gs[4]; int gi1[4], gi2[4];
#pragma unroll
    for (int gq = 0; gq < 4; ++gq) {
        float m1 = bz[4 * gq]; int i1 = 0;
#pragma unroll
        for (int j = 1; j < 4; ++j) if (bz[4 * gq + j] > m1) { m1 = bz[4 * gq + j]; i1 = j; }
        float m2 = -INFINITY; int i2 = 0;
#pragma unroll
        for (int j = 0; j < 4; ++j) if (j != i1 && bz[4 * gq + j] > m2) { m2 = bz[4 * gq + j]; i2 = j; }
        gs[gq] = m1 + m2; gi1[gq] = i1; gi2[gq] = i2;
    }
    int gsel = 0; float gm = gs[0];
#pragma unroll
    for (int gq = 1; gq < 4; ++gq) if (gs[gq] > gm) { gm = gs[gq]; gsel = gq; }
    int i1 = gi1[0], i2 = gi2[0];
#pragma unroll
    for (int gq = 1; gq < 4; ++gq) if (gsel == gq) { i1 = gi1[gq]; i2 = gi2[gq]; }
    const int e1 = gsel * 4 + i1, e2 = gsel * 4 + i2;
    float s1 = 0.f, s2 = 0.f;
#pragma unroll
    for (int e = 0; e < 16; ++e) { if (e == e1) s1 = sc[e]; if (e == e2) s2 = sc[e]; }
    const float inv = 1.f / (s1 + s2);
    if (lane == 0) { eidx[2 * row] = e1; eidx[2 * row + 1] = e2; ewgt[2 * row] = s1 * inv; ewgt[2 * row + 1] = s2 * inv; }
}
__global__ __launch_bounds__(256) void k_ln_moe(const bf16_t* X, const bf16_t* DS, const int* pos, const float* ewgt, const float* g, const float* b, bf16_t* outb, float* outf) {
    const int lane = threadIdx.x & 63, row = blockIdx.x * 4 + (threadIdx.x >> 6);
    Row16 x, y1, y2; load_row_bf16(X + (size_t)row * D, lane, x);
    const int r1 = pos[2 * row], r2 = pos[2 * row + 1]; const float w1 = ewgt[2 * row], w2 = ewgt[2 * row + 1];
    load_row_bf16(DS + (size_t)r1 * D, lane, y1); load_row_bf16(DS + (size_t)r2 * D, lane, y2);
#pragma unroll
    for (int j = 0; j < 4; ++j)
#pragma unroll
        for (int i = 0; i < 4; ++i) x.v[j][i] = ALPHA * x.v[j][i] + (w1 * y1.v[j][i] + w2 * y2.v[j][i]);
    ln_row(x, g, b, lane);
    if (outb) store_row_bf16(outb + (size_t)row * D, lane, x);
    if (outf) {
#pragma unroll
        for (int j = 0; j < 4; ++j) *(float4*)(outf + (size_t)row * D + 256 * j + 4 * lane) = make_float4(x.v[j][0], x.v[j][1], x.v[j][2], x.v[j][3]);
    }
}

__global__ __launch_bounds__(256) void k_xattn(const bf16_t* Q, const bf16_t* Kb, const bf16_t* Vt, bf16_t* O) {
    const int lane = threadIdx.x & 63;
    const int w = blockIdx.x * 4 + (threadIdx.x >> 6);
    const int t = w >> 2, h = w & 3, b = t / S;
    float q[4];
    { const ushort4 u = *(const ushort4*)(Q + (size_t)t * D + h * 256 + 4 * lane); q[0] = bf2f(u.x); q[1] = bf2f(u.y); q[2] = bf2f(u.z); q[3] = bf2f(u.w); }
    float sc[4];
#pragma unroll
    for (int jj = 0; jj < 4; ++jj) {
        sc[jj] = 0.f;
        for (int jl = 0; jl < 64; ++jl) {
            const int key = jj * 64 + jl;
            const ushort4 u = *(const ushort4*)(Kb + (size_t)(b * MEM + key) * 2048 + h * 256 + 4 * lane);
            float p = q[0] * bf2f(u.x) + q[1] * bf2f(u.y) + q[2] * bf2f(u.z) + q[3] * bf2f(u.w);
            p = wave_sum(p);
            if (lane == jl) sc[jj] = p;
        }
    }
    float m = fmaxf(fmaxf(sc[0], sc[1]), fmaxf(sc[2], sc[3])); m = wave_max(m);
    float l = 0.f;
#pragma unroll
    for (int jj = 0; jj < 4; ++jj) { sc[jj] = exp2f(sc[jj] - m); l += sc[jj]; }
    l = wave_sum(l);
    const float inv = 1.f / l;
    float o[4] = {0.f, 0.f, 0.f, 0.f};
    (void)Vt;
#pragma unroll
    for (int jj = 0; jj < 4; ++jj)
        for (int jl = 0; jl < 64; ++jl) {
            const float p = __shfl(sc[jj], jl);
            const int key = jj * 64 + jl;
            const ushort4 u = *(const ushort4*)(Kb + (size_t)(b * MEM + key) * 2048 + 1024 + h * 256 + 4 * lane);
            o[0] += p * bf2f(u.x); o[1] += p * bf2f(u.y); o[2] += p * bf2f(u.z); o[3] += p * bf2f(u.w);
        }
    ushort4 u; u.x = f2bf(o[0] * inv); u.y = f2bf(o[1] * inv); u.z = f2bf(o[2] * inv); u.w = f2bf(o[3] * inv);
    *(ushort4*)(O + (size_t)t * D + h * 256 + 4 * lane) = u;
}

__global__ __launch_bounds__(256) void k_moe_hist(const int* eidx, int* bcnt) {
    __shared__ int h[16];
    if (threadIdx.x < 16) h[threadIdx.x] = 0;
    __syncthreads();
    const int e = eidx[blockIdx.x * 256 + threadIdx.x];
    atomicAdd(&h[e], 1);
    __syncthreads();
    if (threadIdx.x < 16) bcnt[blockIdx.x * 16 + threadIdx.x] = h[threadIdx.x];
}
__global__ __launch_bounds__(256) void k_moe_scatter(const int* eidx, const int* bcnt, int* tok, int* pos, int* tile_e) {
    __shared__ int es[256], dst[256], off[17], base[16], tot[16];
    const int tid = threadIdx.x, blk = blockIdx.x;
    if (tid < 16) {
        int t = 0, bs = 0;
        for (int b2 = 0; b2 < 256; ++b2) { const int c = bcnt[b2 * 16 + tid]; t += c; if (b2 < blk) bs += c; }
        tot[tid] = t; base[tid] = bs;
    }
    es[tid] = eidx[blk * 256 + tid];
    __syncthreads();
    if (tid == 0) { int o = 0; for (int e = 0; e < 16; ++e) { off[e] = o; o += (tot[e] + 255) & ~255; } off[16] = o; }
    __syncthreads();
    {
        const int e = es[tid]; int rank = 0;
        for (int j = 0; j < tid; ++j) rank += (es[j] == e) ? 1 : 0;
        const int r = off[e] + base[e] + rank;
        dst[tid] = r; pos[blk * 256 + tid] = r; tok[r] = blk * 128 + (tid >> 1);
    }
    if (blk < 16) {
        const int e = blk, r0 = off[e] + tot[e], r1 = off[e + 1];
        for (int r = r0 + tid; r < r1; r += 256) tok[r] = 0;
    }
    if (blk == 16) {
        for (int tl = tid; tl < NTILE; tl += 256) { int e = -1; for (int k = 0; k < 16; ++k) if (tl * 256 >= off[k] && tl * 256 < off[k + 1]) e = k; tile_e[tl] = e; }
    }
}

__global__ void k_pool(const bf16_t* HP, bf16_t* PO) {
    const size_t i = (size_t)blockIdx.x * blockDim.x + threadIdx.x;
    if (i >= (size_t)T * D) return;
    const int t = (int)(i >> 10), c = (int)(i & 1023), g = c >> 8, win = 2 << g, ts = t & (S - 1);
    const int n = ts + 1 < win ? ts + 1 : win;
    float s = 0.f;
    for (int k = 0; k < n; ++k) s += bf2f(HP[(size_t)(t - k) * D + c]);
    PO[i] = f2bf(s / (float)n - bf2f(HP[i]));
}
}

using namespace nv;

template <class Epi>
static void gemm(hipStream_t st, const bf16_t* A, int lda, const float* W, int ldw, int M, int N, int K, Epi epi, const int* tile_e = nullptr, size_t w_stride = 0, const int* arow = nullptr) {
    hipLaunchKernelGGL((k_gemm<Epi>), dim3(N / 64, M / 64), dim3(256), 0, st, A, lda, W, ldw, K, epi, tile_e, w_stride, arow);
}

extern "C" void kernel_launch(void* const* d_in, const int* in_sizes, int n_in, void* d_out, int out_size, void* d_ws, size_t ws_size, hipStream_t stream) {
    (void)in_sizes; (void)n_in; (void)out_size;
    if (ws_size < WS_END) return;
    unsigned char* ws = (unsigned char*)d_ws;
    auto F = [&](int i) { return (const float*)d_in[i]; };
    const float* x = F(0); const float* mem = F(1); const int* positions = (const int*)d_in[2];
    const float* router_w = F(3); const float* router_b = F(4);
    float* rope = (float*)(ws + WS_ROPE); int* eidx = (int*)(ws + WS_EIDX); float* ewgt = (float*)(ws + WS_EWGT); int* pos = (int*)(ws + WS_POS);
    int* bcnt = (int*)(ws + WS_BCNT); int* tile_e = (int*)(ws + WS_TILE); int* tok = (int*)(ws + WS_TOK);
    bf16_t* RA = (bf16_t*)(ws + WS_A); bf16_t* RB = (bf16_t*)(ws + WS_B); bf16_t* RC = (bf16_t*)(ws + WS_C); bf16_t* RD = (bf16_t*)(ws + WS_D);
    bf16_t* MEMB = (bf16_t*)(ws + WS_WB);

    hipLaunchKernelGGL(k_cvt_x, dim3(2048), dim3(256), 0, stream, x, RA, (size_t)T * D / 4);
    hipLaunchKernelGGL(k_cvt_x, dim3(256), dim3(256), 0, stream, mem, MEMB, (size_t)B * MEM * D / 4);
    InvFreq inv; for (int j = 0; j < 8; ++j) inv.f[j] = (float)pow(500000.0, -(double)((float)j * 2.0f / 16.0f));
    hipLaunchKernelGGL(k_rope_table, dim3(T / 256), dim3(256), 0, stream, positions, rope, inv);
    for (int L = 0; L < 2; ++L) {
        const int cb = L == 0 ? 12 : 28;
        bf16_t* Kb = (bf16_t*)(ws + WS_MEMKV) + (size_t)L * B * MEM * 2048; bf16_t* Vt = (bf16_t*)(ws + WS_MEMVT) + (size_t)L * B * MEM * 1024;
        gemm(stream, MEMB, D, F(cb + 3), 2048, B * MEM, 2048, D, EpiKV{Kb, Vt});
    }
    gemm(stream, RA, D, F(5), NIN0, T, NIN0, D, EpiInproj0{RD});
    hipLaunchKernelGGL(k_rope_apply, dim3(T * 80 / 256), dim3(256), 0, stream, RD, rope);
    hipLaunchKernelGGL(k_swa, dim3(B * 64 * 8), dim3(128), 0, stream, RD, F(6), RB);
    hipLaunchKernelGGL(k_sgu_ln, dim3(T * 8 / 256), dim3(256), 0, stream, RD, F(7), F(8), RC);
    hipLaunchKernelGGL(k_sgu_mix, dim3(T * 512 / 256), dim3(256), 0, stream, RD, RC, F(9), F(10), RB);
    gemm(stream, RB, D, F(11), D, T, D, D, EpiBf16{RC, D, 1.f});
    hipLaunchKernelGGL(k_ln_add, dim3(T / 4), dim3(256), 0, stream, RA, RC, F(12), F(13), RB);
    for (int L = 0; L < 2; ++L) {
        const int cb = L == 0 ? 12 : 28;
        const bf16_t* Kb = (bf16_t*)(ws + WS_MEMKV) + (size_t)L * B * MEM * 2048; const bf16_t* Vt = (bf16_t*)(ws + WS_MEMVT) + (size_t)L * B * MEM * 1024;
        bf16_t *X1, *Qb, *Ob, *Y2, *X2, *HS, *DS, *X3; float* G;
        if (L == 0) { X1 = RB; Qb = RA; Ob = RC; Y2 = RA; X2 = RC; HS = RB; DS = RD; X3 = RA; }
        else        { X1 = RB; Qb = RC; Ob = RD; Y2 = RC; X2 = RA; HS = RB; DS = RD; X3 = nullptr; }
        G = (float*)RD;
        gemm(stream, X1, D, F(cb + 2), D, T, D, D, EpiBf16{Qb, D, QSCALE});
        hipLaunchKernelGGL(k_xattn, dim3(T * XH / 4), dim3(256), 0, stream, Qb, Kb, Vt, Ob);
        gemm(stream, Ob, D, F(cb + 4), D, T, D, D, EpiBf16{Y2, D, 1.f});
        hipLaunchKernelGGL(k_ln_router, dim3(T / 4), dim3(256), 0, stream, X1, Y2, F(cb + 5), F(cb + 6), X2, router_w, router_b, eidx, ewgt);
        hipLaunchKernelGGL(k_moe_hist, dim3(256), dim3(256), 0, stream, eidx, bcnt);
        hipLaunchKernelGGL(k_moe_scatter, dim3(256), dim3(256), 0, stream, eidx, bcnt, tok, pos, tile_e);
        gemm(stream, X2, D, F(cb + 7), DE, MPAD, DE, D, EpiF32{G, DE}, tile_e, (size_t)D * DE, tok);
        gemm(stream, X2, D, F(cb + 8), DE, MPAD, DE, D, EpiSiluMul{G, HS}, tile_e, (size_t)D * DE, tok);
        gemm(stream, HS, DE, F(cb + 9), D, MPAD, D, DE, EpiBf16{DS, D, 1.f}, tile_e, (size_t)DE * D);
        hipLaunchKernelGGL(k_ln_moe, dim3(T / 4), dim3(256), 0, stream, X2, DS, pos, ewgt, F(cb + 10), F(cb + 11), X3, L == 1 ? (float*)d_out : nullptr);
        if (L == 0) {
            gemm(stream, RA, D, F(24), D, T, D, D, EpiBf16{RB, D, 1.f});
            hipLaunchKernelGGL(k_pool, dim3(T * D / 256), dim3(256), 0, stream, RB, RC);
            for (int g = 0; g < 4; ++g) gemm(stream, RC + g * 256, D, F(25) + (size_t)g * 256 * 256, 256, T, 256, 256, EpiPoolMap{RD, F(26), g * 256});
            gemm(stream, RD, D, F(27), D, T, D, D, EpiBf16{RC, D, 1.f});
            hipLaunchKernelGGL(k_ln_add, dim3(T / 4), dim3(256), 0, stream, RA, RC, F(28), F(29), RB);
        }
    }
}
```

```cpp
#include <hip/hip_runtime.h>
#include <stdint.h>
#include <math.h>

typedef unsigned short bf16_t;

namespace nv {
constexpr int B = 4, S = 8192, T = B * S, D = 1024;
constexpr int NIN0 = 1792;
constexpr int MEM = 256, XH = 4, XHD = 256;
constexpr int NE = 16, DE = 512;
constexpr int MPAD = 65536 + 16 * 256;
constexpr int NTILE = MPAD / 256;
constexpr float ALPHA = 1.4142135623730951f;
constexpr float LN_EPS = 1e-5f;
constexpr float QSCALE = 0.0625f * 1.4426950408889634f;
constexpr float ASCALE = 0.125f * 1.4426950408889634f;

constexpr size_t MiB = 1u << 20;
constexpr size_t WS_CTL = 0;
constexpr size_t WS_ROPE = 2 * MiB;
constexpr size_t WS_EIDX = 4 * MiB;
constexpr size_t WS_EWGT = 5 * MiB;
constexpr size_t WS_POS = 6 * MiB;
constexpr size_t WS_BCNT = 7 * MiB;
constexpr size_t WS_TILE = 7 * MiB + 65536;
constexpr size_t WS_TOK = 7 * MiB + 131072;
constexpr size_t WS_MEMKV = 8 * MiB;
constexpr size_t WS_MEMVT = 16 * MiB;
constexpr size_t WS_MEMB = 20 * MiB;
constexpr size_t WS_WB = 24 * MiB;
constexpr size_t WS_A = 152 * MiB, WS_B = 220 * MiB, WS_C = 288 * MiB, WS_D = 356 * MiB, WS_END = 492 * MiB;
constexpr size_t WB_IN0 = 0;
constexpr size_t WB_OUT0 = WB_IN0 + (size_t)1792 * 1024;
constexpr size_t WB_IN1 = WB_OUT0 + (size_t)1024 * 1024;
constexpr size_t WB_POOL = WB_IN1 + (size_t)1024 * 1024;
constexpr size_t WB_OUT1 = WB_POOL + (size_t)1024 * 256;
constexpr size_t WB_SGUW = WB_OUT1 + (size_t)1024 * 1024;
constexpr size_t WB_LAYER = WB_SGUW + (size_t)8 * 128 * 128;
constexpr size_t WL_XQ = 0;
constexpr size_t WL_XKV = WL_XQ + (size_t)1024 * 1024;
constexpr size_t WL_XO = WL_XKV + (size_t)2048 * 1024;
constexpr size_t WL_GU = WL_XO + (size_t)1024 * 1024;
constexpr size_t WL_DN = WL_GU + (size_t)16 * 1024 * 1024;
constexpr size_t WL_SIZE = WL_DN + (size_t)16 * 1024 * 512;
static_assert((WB_LAYER + 2 * WL_SIZE) * 2 <= 128 * MiB, "bf16 weight region");

__device__ __forceinline__ float bf2f(bf16_t v) { return __uint_as_float((unsigned)v << 16); }
__device__ __forceinline__ bf16_t f2bf(float f) { unsigned u = __float_as_uint(f); return (bf16_t)((u + 0x7fffu + ((u >> 16) & 1u)) >> 16); }
__device__ __forceinline__ float gelu_tanh(float x) { const float u = 0.7978845608028654f * (x + 0.044715f * x * x * x); const float e = __expf(2.f * u); const float th = 1.f - 2.f / (e + 1.f); return 0.5f * x * (1.f + th); }
__device__ __forceinline__ float silu(float x) { return x / (1.f + __expf(-x)); }
template <int M> __device__ __forceinline__ float swz_xor(float v) { return __int_as_float(__builtin_amdgcn_ds_swizzle(__float_as_int(v), (M << 10) | 0x1f)); }
__device__ __forceinline__ float wave_sum(float v) {
    v += swz_xor<1>(v); v += swz_xor<2>(v); v += swz_xor<4>(v); v += swz_xor<8>(v); v += swz_xor<16>(v);
    const auto r = __builtin_amdgcn_permlane32_swap(__float_as_uint(v), __float_as_uint(v), false, false);
    return __uint_as_float(r[0]) + __uint_as_float(r[1]);
}
__device__ __forceinline__ float wave_max(float v) {
    v = fmaxf(v, swz_xor<1>(v)); v = fmaxf(v, swz_xor<2>(v)); v = fmaxf(v, swz_xor<4>(v)); v = fmaxf(v, swz_xor<8>(v)); v = fmaxf(v, swz_xor<16>(v));
    const auto r = __builtin_amdgcn_permlane32_swap(__float_as_uint(v), __float_as_uint(v), false, false);
    return fmaxf(__uint_as_float(r[0]), __uint_as_float(r[1]));
}
}

namespace pg8 {
#define PG8_LAS __attribute__((address_space(3)))
typedef short bf16x8 __attribute__((ext_vector_type(8)));
typedef float f32x4 __attribute__((ext_vector_type(4)));
typedef float f32x2 __attribute__((ext_vector_type(2)));
typedef unsigned u32x4 __attribute__((ext_vector_type(4)));
typedef unsigned u32x2 __attribute__((ext_vector_type(2)));
constexpr int BM = 256, BK = 64, HALF = 128, HTB = HALF * BK * 2  , STAGE_BYTES = 8 * HTB, NXCD = 8, WGM = 8;

__host__ __device__ __forceinline__ int lds_byte(int r, int c) { const int st = (r >> 4) * 2 + (c >> 5), rr = r & 15, cc = c & 31, ob = rr * 64 + cc * 2; return st * 1024 + (ob ^ (((ob >> 9) & 1) << 5)); }
__host__ __device__ __forceinline__ void stage_rc(int b, int& R, int& C) { const int st = b / 1024, sb = b % 1024, swz = sb ^ (((sb >> 9) & 1) << 5); R = (st >> 1) * 16 + swz / 64; C = (st & 1) * 32 + (swz % 64) / 2; }
__host__ __device__ __forceinline__ int perm32(int rho) { const int n = rho >> 4, i = rho & 15; return 8 * (i >> 2) + 4 * n + (i & 3); }

struct Unit { int pm, pn, pb; };
struct Gemm { const bf16_t* A; const bf16_t* Bt; const int* arow; };

struct StaticOrder {
    int nM, nN, nwg, G, c;
    __device__ void init(int M, int N, int G_, int c_) { nM = M / BM; nN = N / BM; nwg = nM * nN; G = G_; c = c_; }
    __device__ bool next(int i, Unit& u) const {
        const long L = (long)i * G + c; if (L >= nwg) return false;
        int wgid = (int)L; { const int q = nwg / NXCD, r = nwg % NXCD, xcd = wgid % NXCD, off = wgid / NXCD; wgid = (xcd < r ? xcd * (q + 1) : r * (q + 1) + (xcd - r) * q) + off; }
        const int nig = WGM * nN, gid = wgid / nig, fm = gid * WGM, gsz = (nM - fm) < WGM ? (nM - fm) : WGM;
        u.pm = fm + ((wgid % nig) % gsz); u.pn = (wgid % nig) / gsz; u.pb = u.pn; return true;
    }
};
struct MoeOrder {
    int nM, nwg, G, c; const int* tile_e;
    __device__ void init(int ntiles, const int* te, int G_, int c_) { nM = ntiles; nwg = nM * 4; G = G_; c = c_; tile_e = te; }
    __device__ bool next(int i, Unit& u) const {
        const long L = (long)i * G + c; if (L >= nwg) return false;
        int wgid = (int)L; { const int q = nwg / NXCD, r = nwg % NXCD, xcd = wgid % NXCD, off = wgid / NXCD; wgid = (xcd < r ? xcd * (q + 1) : r * (q + 1) + (xcd - r) * q) + off; }
        const int nig = WGM * 4, gid = wgid / nig, fm = gid * WGM, gsz = (nM - fm) < WGM ? (nM - fm) : WGM;
        u.pm = fm + ((wgid % nig) % gsz); u.pn = (wgid % nig) / gsz;
        const int e = __builtin_amdgcn_readfirstlane(tile_e[u.pm]); u.pb = e * 4 + u.pn; return true;
    }
};

__device__ __forceinline__ unsigned cvt_pk_bf16(float lo, float hi) { unsigned r; asm volatile("v_cvt_pk_bf16_f32 %0, %1, %2" : "=v"(r) : "v"(lo), "v"(hi)); return r; }


template <class Epi, class Sched, bool ALIGN_EPI, bool SP2, bool GATHER, int LDA, int LDB, int KK, int APN>
__device__ __forceinline__ void gemm_phase(PG8_LAS unsigned char* lds, int tid_in, const Gemm g, const Sched& S, const Epi& E) {
    int tid_ = tid_in; asm volatile("" : "+v"(tid_));
    const int tid = tid_, wid = __builtin_amdgcn_readfirstlane(tid >> 6), lane = tid & 63, wr = wid >> 2, wc = wid & 3, fr = lane & 15, fq = lane >> 4;
    constexpr int K = KK, nt = K / BK, lda = LDA, ldb = LDB; (void)K;
    unsigned voffA[2], voffB[2]; int rowA[2];
#pragma unroll
    for (int i = 0; i < 2; ++i) { int R, C; stage_rc(tid * 16 + i * 8192, R, C); const int Rb = Epi::PERM ? ((R & ~31) + perm32(R & 31)) : R;
        voffA[i] = GATHER ? (unsigned)C * 2u : (unsigned)(R * lda + C) * 2u; voffB[i] = (unsigned)(Rb * ldb + C) * 2u; rowA[i] = R; }
    const size_t kstep = (size_t)(BK * 2);
    const size_t hstepA = GATHER ? 0 : (size_t)HALF * lda * 2, hstepB = (size_t)HALF * ldb * 2;
    const size_t tstepA = (size_t)BM * lda * 2, tstepB = 2 * hstepB;
    const unsigned ldsw = (unsigned)wid * 1024u;
    const int aoff = lds_byte(wr * 64 + fr, fq * 8), boff = lds_byte(wc * 32 + fr, fq * 8);
    unsigned cg[2][2], ng[2][2], og[2][2];
#define PG8_SA(b, h) (((b) * 2 + (h)) * HTB)
#define PG8_SB(b, h) ((4 + (b) * 2 + (h)) * HTB)
#define PG8_STAGE(bufoff, gbase, voff) do { _Pragma("unroll") for (int _i = 0; _i < 2; ++_i) \
        __builtin_amdgcn_global_load_lds((const unsigned*)((const char*)(gbase) + (voff)[_i]), (PG8_LAS unsigned*)(lds + (bufoff) + ldsw + _i * 8192), 16, 0, 0); } while (0)
#define PG8_STAGE_A(bufoff, abase, h, GO) do { _Pragma("unroll") for (int _i = 0; _i < 2; ++_i) { \
        const char* _s = (const char*)(abase) + ((h) ? hstepA : (size_t)0) + voffA[_i]; if constexpr (GATHER) _s += GO[h][_i]; \
        __builtin_amdgcn_global_load_lds((const unsigned*)_s, (PG8_LAS unsigned*)(lds + (bufoff) + ldsw + _i * 8192), 16, 0, 0); } } while (0)
#define PG8_GLOAD(dst, pm_) do { _Pragma("unroll") for (int _h = 0; _h < 2; ++_h) _Pragma("unroll") for (int _i = 0; _i < 2; ++_i) \
        dst[_h][_i] = (unsigned)g.arow[(pm_) * BM + _h * HALF + rowA[_i]] * (unsigned)(lda * 2); } while (0)
#define PG8_LDA(dst, b, h) do { _Pragma("unroll") for (int m = 0; m < 4; ++m) _Pragma("unroll") for (int k = 0; k < 2; ++k) dst[m][k] = *(const PG8_LAS bf16x8*)(lds + PG8_SA(b, h) + aoff + m * 2048 + k * 1024); } while (0)
#define PG8_LDB(dst, b, h) do { _Pragma("unroll") for (int n = 0; n < 2; ++n) _Pragma("unroll") for (int k = 0; k < 2; ++k) dst[n][k] = *(const PG8_LAS bf16x8*)(lds + PG8_SB(b, h) + boff + n * 2048 + k * 1024); } while (0)
#define PG8_MMA(ai, bj, At, Bt) do { __builtin_amdgcn_s_setprio(1); _Pragma("unroll") for (int m = 0; m < 4; ++m) _Pragma("unroll") for (int n = 0; n < 2; ++n) _Pragma("unroll") for (int k = 0; k < 2; ++k) \
        acc[ai][bj][m][n] = __builtin_amdgcn_mfma_f32_16x16x32_bf16(Bt[n][k], At[m][k], acc[ai][bj][m][n], 0, 0, 0); __builtin_amdgcn_s_setprio(0); } while (0)
#define PG8_WAIT_V(n) asm volatile("s_waitcnt vmcnt(" #n ")" ::: "memory")
#define PG8_WAIT_L(n) asm volatile("s_waitcnt lgkmcnt(" #n ")" ::: "memory")
#define PG8_BAR __builtin_amdgcn_s_barrier()
#define PG8_SCHED __builtin_amdgcn_sched_barrier(0)
    Unit cur, nxt; int ui = 0;
    if (!S.next(0, cur)) return;
    f32x4 acc[2][2][4][2];
#pragma unroll
    for (int a = 0; a < 2; ++a)
#pragma unroll
        for (int b = 0; b < 2; ++b)
#pragma unroll
            for (int m = 0; m < 4; ++m)
#pragma unroll
                for (int n = 0; n < 2; ++n) acc[a][b][m][n] = (f32x4){0.f, 0.f, 0.f, 0.f};
    bf16x8 At[4][2], B0[2][2], B1[2][2];
    const char* cA = GATHER ? (const char*)g.A : (const char*)g.A + (size_t)cur.pm * tstepA + (size_t)cur.pn * APN * 2; const char* cB = (const char*)g.Bt + (size_t)cur.pb * tstepB;
    if constexpr (GATHER) { PG8_GLOAD(cg, cur.pm); }
    if constexpr (SP2) {
        PG8_STAGE(PG8_SB(0, 0), cB, voffB); PG8_STAGE(PG8_SB(0, 1), cB + hstepB, voffB); PG8_STAGE_A(PG8_SA(0, 0), cA, 0, cg); PG8_STAGE_A(PG8_SA(0, 1), cA, 1, cg);
        if (wr == 1) PG8_BAR;
        PG8_WAIT_V(2); PG8_BAR;
        PG8_STAGE(PG8_SB(1, 0), cB + kstep, voffB); PG8_STAGE_A(PG8_SA(1, 0), cA + kstep, 0, cg); PG8_STAGE(PG8_SB(1, 1), cB + hstepB + kstep, voffB);
        PG8_WAIT_V(6); PG8_BAR;
    } else {
        PG8_STAGE(PG8_SB(0, 0), cB, voffB); PG8_STAGE_A(PG8_SA(0, 0), cA, 0, cg); PG8_STAGE(PG8_SB(0, 1), cB + hstepB, voffB); PG8_STAGE_A(PG8_SA(0, 1), cA, 1, cg);
        if (wr == 1) PG8_BAR;
        PG8_WAIT_V(4); PG8_BAR;
        PG8_STAGE(PG8_SB(1, 0), cB + kstep, voffB); PG8_STAGE_A(PG8_SA(1, 0), cA + kstep, 0, cg); PG8_STAGE(PG8_SB(1, 1), cB + hstepB + kstep, voffB);
        PG8_WAIT_V(6); PG8_BAR;
    }
    for (;;) {
        const bool has_next = S.next(ui + 1, nxt);
        const char* nA = GATHER ? (const char*)g.A : (has_next ? (const char*)g.A + (size_t)nxt.pm * tstepA + (size_t)nxt.pn * APN * 2 : cA);
        const char* nB = has_next ? (const char*)g.Bt + (size_t)nxt.pb * tstepB : cB;
        if constexpr (GATHER) { if (has_next) { PG8_GLOAD(ng, nxt.pm); } else {
#pragma unroll
            for (int _h = 0; _h < 2; ++_h)
#pragma unroll
                for (int _i = 0; _i < 2; ++_i) ng[_h][_i] = cg[_h][_i]; } }
#pragma unroll 1
        for (int t = 0; t < nt; t += 2) {
            const bool last = (t == nt - 2);
            const char* a1 = cA + (size_t)(t + 1) * kstep;
            const char* a2 = last ? nA : cA + (size_t)(t + 2) * kstep; const char* b2 = last ? nB : cB + (size_t)(t + 2) * kstep;
            const char* a3 = a2 + kstep; const char* b3 = b2 + kstep;
            if constexpr (GATHER) {
#pragma unroll
                for (int _h = 0; _h < 2; ++_h)
#pragma unroll
                    for (int _i = 0; _i < 2; ++_i) og[_h][_i] = last ? ng[_h][_i] : cg[_h][_i]; }
            if constexpr (SP2) {
            PG8_LDB(B0, 0, 0); PG8_LDB(B1, 0, 1); PG8_SCHED; PG8_LDA(At, 0, 0); PG8_STAGE_A(PG8_SA(1, 1), a1, 1, cg);
            PG8_WAIT_V(8); PG8_WAIT_L(0); PG8_BAR; PG8_MMA(0, 0, At, B0); PG8_MMA(0, 1, At, B1); PG8_BAR; PG8_SCHED;
            PG8_LDA(At, 0, 1); PG8_STAGE(PG8_SB(0, 0), b2, voffB); PG8_STAGE(PG8_SB(0, 1), b2 + hstepB, voffB); PG8_STAGE_A(PG8_SA(0, 0), a2, 0, og);
            PG8_WAIT_V(8); PG8_WAIT_L(0); PG8_BAR; PG8_MMA(1, 0, At, B0); PG8_MMA(1, 1, At, B1); PG8_BAR; PG8_SCHED;
            PG8_LDB(B0, 1, 0); PG8_LDB(B1, 1, 1); PG8_SCHED; PG8_LDA(At, 1, 0); PG8_STAGE_A(PG8_SA(0, 1), a2, 1, og);
            PG8_WAIT_V(8); PG8_WAIT_L(0); PG8_BAR; PG8_MMA(0, 0, At, B0); PG8_MMA(0, 1, At, B1); PG8_BAR; PG8_SCHED;
            PG8_LDA(At, 1, 1); PG8_STAGE(PG8_SB(1, 0), b3, voffB); PG8_STAGE(PG8_SB(1, 1), b3 + hstepB, voffB); PG8_STAGE_A(PG8_SA(1, 0), a3, 0, og);
            PG8_WAIT_V(8); PG8_WAIT_L(0); PG8_BAR; PG8_MMA(1, 0, At, B0); PG8_MMA(1, 1, At, B1); PG8_BAR; PG8_SCHED;
            } else {
            PG8_LDB(B0, 0, 0); PG8_SCHED; PG8_LDA(At, 0, 0); PG8_STAGE_A(PG8_SA(1, 1), a1, 1, cg);
            PG8_WAIT_L(8); PG8_BAR; PG8_WAIT_L(0); PG8_MMA(0, 0, At, B0); PG8_BAR; PG8_SCHED;
            PG8_LDB(B1, 0, 1); PG8_STAGE(PG8_SB(0, 0), b2, voffB);
            PG8_BAR; PG8_WAIT_L(0); PG8_MMA(0, 1, At, B1); PG8_BAR;
            PG8_LDA(At, 0, 1); PG8_STAGE_A(PG8_SA(0, 0), a2, 0, og);
            PG8_BAR; PG8_WAIT_L(0); PG8_MMA(1, 0, At, B0); PG8_BAR; PG8_SCHED;
            PG8_STAGE(PG8_SB(0, 1), b2 + hstepB, voffB);
            PG8_WAIT_V(6); PG8_BAR; PG8_MMA(1, 1, At, B1); PG8_BAR;
            PG8_LDB(B0, 1, 0); PG8_SCHED; PG8_LDA(At, 1, 0); PG8_STAGE_A(PG8_SA(0, 1), a2, 1, og);
            PG8_WAIT_L(8); PG8_BAR; PG8_WAIT_L(0); PG8_MMA(0, 0, At, B0); PG8_BAR; PG8_SCHED;
            PG8_LDB(B1, 1, 1); PG8_STAGE(PG8_SB(1, 0), b3, voffB);
            PG8_BAR; PG8_WAIT_L(0); PG8_MMA(0, 1, At, B1); PG8_BAR;
            PG8_LDA(At, 1, 1); PG8_STAGE_A(PG8_SA(1, 0), a3, 0, og);
            PG8_BAR; PG8_WAIT_L(0); PG8_MMA(1, 0, At, B0); PG8_BAR; PG8_SCHED;
            PG8_STAGE(PG8_SB(1, 1), b3 + hstepB, voffB);
            PG8_WAIT_V(6); PG8_BAR; PG8_MMA(1, 1, At, B1); PG8_BAR;
            }
        }
        if constexpr (ALIGN_EPI) { if (wr == 0) PG8_BAR; }
        E(acc, cur, wr, wc, fr, fq);
        if (!has_next) break;
#pragma unroll
        for (int a = 0; a < 2; ++a)
#pragma unroll
            for (int b = 0; b < 2; ++b)
#pragma unroll
                for (int m = 0; m < 4; ++m)
#pragma unroll
                    for (int n = 0; n < 2; ++n) acc[a][b][m][n] = (f32x4){0.f, 0.f, 0.f, 0.f};
        cur = nxt; cA = nA; cB = nB; ++ui;
        if constexpr (GATHER) {
#pragma unroll
            for (int _h = 0; _h < 2; ++_h)
#pragma unroll
                for (int _i = 0; _i < 2; ++_i) cg[_h][_i] = ng[_h][_i]; }
        if constexpr (ALIGN_EPI) { if (wr == 1) PG8_BAR; }
    }
    PG8_WAIT_V(0);
    if constexpr (!ALIGN_EPI) { if (wr == 0) PG8_BAR; }
    PG8_BAR;
#undef PG8_SA
#undef PG8_SB
#undef PG8_STAGE
#undef PG8_STAGE_A
#undef PG8_GLOAD
#undef PG8_LDA
#undef PG8_LDB
#undef PG8_MMA
#undef PG8_WAIT_V
#undef PG8_WAIT_L
#undef PG8_BAR
#undef PG8_SCHED
}
}
namespace pg8 {

__device__ __forceinline__ float fast_sigmoid_mul(float x, float z) { return x * __builtin_amdgcn_rcpf(1.f + __builtin_amdgcn_exp2f(-1.4426950408889634f * z)); }
__device__ __forceinline__ float gelu_t(float x) { const float u = 0.7978845608028654f * (x + 0.044715f * x * x * x); return fast_sigmoid_mul(x, 2.f * u); }
__device__ __forceinline__ float silu_f(float x) { return fast_sigmoid_mul(x, x); }
__device__ __forceinline__ u32x4 pack8(const f32x4 v0, const f32x4 v1) { u32x4 w; w.x = cvt_pk_bf16(v0[0], v0[1]); w.y = cvt_pk_bf16(v0[2], v0[3]); w.z = cvt_pk_bf16(v1[0], v1[1]); w.w = cvt_pk_bf16(v1[2], v1[3]); return w; }

struct EpiBf16 {
    static constexpr bool PERM = true;
    bf16_t* O; int ldo; float scale;
    __device__ __forceinline__ void operator()(const f32x4 (&acc)[2][2][4][2], const Unit& u, int wr, int wc, int fr, int fq) const {
        const int row0 = u.pm * BM + wr * 64 + fr, col0 = u.pn * BM + wc * 32 + 8 * fq;
#pragma unroll
        for (int ai = 0; ai < 2; ++ai)
#pragma unroll
            for (int m = 0; m < 4; ++m) { bf16_t* rowp = O + (size_t)(row0 + ai * HALF + m * 16) * ldo + col0;
#pragma unroll
                for (int bj = 0; bj < 2; ++bj) *(u32x4*)(rowp + bj * HALF) = pack8(acc[ai][bj][m][0] * scale, acc[ai][bj][m][1] * scale); }
    }
};
struct EpiPoolMap {
    static constexpr bool PERM = true;
    bf16_t* O; const float* cscale;
    __device__ __forceinline__ void operator()(const f32x4 (&acc)[2][2][4][2], const Unit& u, int wr, int wc, int fr, int fq) const {
        const int row0 = u.pm * BM + wr * 64 + fr, col0 = u.pn * BM + wc * 32 + 8 * fq;
        f32x4 sc[2][2];
#pragma unroll
        for (int bj = 0; bj < 2; ++bj)
#pragma unroll
            for (int n = 0; n < 2; ++n) sc[bj][n] = *(const f32x4*)(cscale + col0 + bj * HALF + 4 * n);
#pragma unroll
        for (int ai = 0; ai < 2; ++ai)
#pragma unroll
            for (int m = 0; m < 4; ++m) { bf16_t* rowp = O + (size_t)(row0 + ai * HALF + m * 16) * nv::D + col0;
#pragma unroll
                for (int bj = 0; bj < 2; ++bj) *(u32x4*)(rowp + bj * HALF) = pack8(acc[ai][bj][m][0] * sc[bj][0], acc[ai][bj][m][1] * sc[bj][1]); }
    }
};
struct EpiGU {
    static constexpr bool PERM = true;
    bf16_t* HS;
    __device__ __forceinline__ void operator()(const f32x4 (&acc)[2][2][4][2], const Unit& u, int wr, int wc, int fr, int fq) const {
        const int row0 = u.pm * BM + wr * 64 + fr, col0 = u.pn * HALF + wc * 32 + 8 * fq;
#pragma unroll
        for (int ai = 0; ai < 2; ++ai)
#pragma unroll
            for (int m = 0; m < 4; ++m) { bf16_t* rowp = HS + (size_t)(row0 + ai * HALF + m * 16) * nv::DE + col0;
                f32x4 h0, h1;
#pragma unroll
                for (int j = 0; j < 4; ++j) { h0[j] = silu_f(acc[ai][0][m][0][j]) * acc[ai][1][m][0][j]; h1[j] = silu_f(acc[ai][0][m][1][j]) * acc[ai][1][m][1][j]; }
                *(u32x4*)rowp = pack8(h0, h1); }
    }
};
struct EpiKV {
    static constexpr bool PERM = true;
    bf16_t* Kb; bf16_t* Vt;
    __device__ __forceinline__ void operator()(const f32x4 (&acc)[2][2][4][2], const Unit& u, int wr, int wc, int fr, int fq) const {
        const int row0 = u.pm * BM + wr * 64 + fr, col0 = u.pn * BM + wc * 32 + 8 * fq;
#pragma unroll
        for (int ai = 0; ai < 2; ++ai)
#pragma unroll
            for (int m = 0; m < 4; ++m) { bf16_t* rowp = Kb + (size_t)(row0 + ai * HALF + m * 16) * 2048 + col0;
#pragma unroll
                for (int bj = 0; bj < 2; ++bj) *(u32x4*)(rowp + bj * HALF) = pack8(acc[ai][bj][m][0], acc[ai][bj][m][1]); }
        if (u.pn >= 4) {
            const int h = u.pn - 4, b = u.pm;
            bf16_t* vb = Vt + (size_t)(b * nv::XH + h) * nv::XHD * nv::MEM;
#pragma unroll
            for (int ai = 0; ai < 2; ++ai)
#pragma unroll
                for (int m = 0; m < 4; ++m) { const int key = ai * HALF + wr * 64 + m * 16 + fr;
#pragma unroll
                    for (int bj = 0; bj < 2; ++bj)
#pragma unroll
                        for (int n = 0; n < 2; ++n)
#pragma unroll
                            for (int j = 0; j < 4; ++j) { const int dd = bj * HALF + wc * 32 + 8 * fq + 4 * n + j; vb[(size_t)dd * nv::MEM + key] = nv::f2bf(acc[ai][bj][m][n][j]); } }
        }
    }
};
struct EpiInproj0 {
    static constexpr bool PERM = true;
    bf16_t* O; const float* rope;
    __device__ __forceinline__ void operator()(const f32x4 (&acc)[2][2][4][2], const Unit& u, int wr, int wc, int fr, int fq) const {
        const int row0 = u.pm * BM + wr * 64 + fr, col0 = u.pn * BM + wc * 32 + 8 * fq;
        if (u.pn >= 3) {
#pragma unroll
            for (int ai = 0; ai < 2; ++ai)
#pragma unroll
                for (int m = 0; m < 4; ++m) { bf16_t* rowp = O + (size_t)(row0 + ai * HALF + m * 16) * nv::NIN0 + col0;
#pragma unroll
                    for (int bj = 0; bj < 2; ++bj) { f32x4 v0 = acc[ai][bj][m][0], v1 = acc[ai][bj][m][1];
#pragma unroll
                        for (int j = 0; j < 4; ++j) { v0[j] = gelu_t(v0[j]); v1[j] = gelu_t(v1[j]); }
                        *(u32x4*)(rowp + bj * HALF) = pack8(v0, v1); } }
        } else {
            const bool wave_rope = (wc & 1) == 0;
            const float sgn = fq == 0 ? -1.f : 1.f;
#pragma unroll
            for (int ai = 0; ai < 2; ++ai)
#pragma unroll
                for (int m = 0; m < 4; ++m) { const int row = row0 + ai * HALF + m * 16; bf16_t* rowp = O + (size_t)row * nv::NIN0 + col0;
                    f32x4 c0, c1, s0, s1;
                    if (wave_rope) { const float* rp = rope + (size_t)row * 16; c0 = *(const f32x4*)rp; c1 = *(const f32x4*)(rp + 4); s0 = *(const f32x4*)(rp + 8); s1 = *(const f32x4*)(rp + 12); }
#pragma unroll
                    for (int bj = 0; bj < 2; ++bj) { f32x4 v0 = acc[ai][bj][m][0], v1 = acc[ai][bj][m][1];
                        if (wave_rope && (u.pn < 2 || bj == 0)) {
                            f32x4 p0, p1;
#pragma unroll
                            for (int j = 0; j < 4; ++j) { p0[j] = nv::swz_xor<16>(v0[j]); p1[j] = nv::swz_xor<16>(v1[j]); }
                            if (fq < 2) {
#pragma unroll
                                for (int j = 0; j < 4; ++j) { v0[j] = v0[j] * c0[j] + sgn * p0[j] * s0[j]; v1[j] = v1[j] * c1[j] + sgn * p1[j] * s1[j]; } }
                        }
                        *(u32x4*)(rowp + bj * HALF) = pack8(v0, v1); } }
        }
    }
};
}

#define LAS __attribute__((address_space(3)))
#define GAS __attribute__((address_space(1)))
typedef GAS unsigned gu32;
#define RLX_AGENT __ATOMIC_RELAXED, __HIP_MEMORY_SCOPE_AGENT
#define LDS_WAIT() asm volatile("s_waitcnt lgkmcnt(0)" ::: "memory")
#define VM_WAIT() asm volatile("s_waitcnt vmcnt(0)" ::: "memory")

#define XB_TMO      128
#define XB_XCNT(j)  (256  + 64 * (j))
#define XB_XSUB(j)  (1280 + 64 * (j))
#define XB_XGEN(j)  (2304 + 64 * (j))
#define XB_TOP      3328
#define XB_TOPGEN   3392
#define XCD_BAR_WORDS 3456
#define XB_SPIN_CAP (1u << 18)
__device__ __forceinline__ unsigned xb_ld(unsigned* p)              { return __hip_atomic_load(p, __ATOMIC_RELAXED, __HIP_MEMORY_SCOPE_AGENT); }
__device__ __forceinline__ unsigned xb_add(unsigned* p, unsigned v) { return __hip_atomic_fetch_add(p, v, __ATOMIC_RELAXED, __HIP_MEMORY_SCOPE_AGENT); }
__device__ __forceinline__ unsigned xb_xcc_id() { return (unsigned)__builtin_amdgcn_s_getreg((3 << 11) | 20) & 0xFu; }
#define XB_SPIN(cond, bar) do { unsigned _sp = 0; while (cond) { __builtin_amdgcn_s_sleep(1); \
    if ((++_sp & 255u) == 0u) { if (xb_ld(&(bar)[XB_TMO])) break; if (_sp > XB_SPIN_CAP) { atomicAdd(&(bar)[XB_TMO], 1u); break; } } } } while (0)
struct XcdBarrier { unsigned* bar; unsigned x; volatile LAS unsigned* st; int wave; };
__device__ __forceinline__ unsigned lane_id_fresh() { unsigned m = ~0u; asm volatile("" : "+s"(m)); return __builtin_amdgcn_mbcnt_hi(m, __builtin_amdgcn_mbcnt_lo(m, 0u)); }
__device__ __forceinline__ bool xb_thread0(int wave) { return wave == 0 && lane_id_fresh() == 0u; }
__device__ __forceinline__ XcdBarrier xcd_barrier_post(unsigned* bar, volatile LAS unsigned* st, int wave) {
    XcdBarrier b; b.bar = bar; b.x = xb_xcc_id(); b.st = st; b.wave = wave;
    if (xb_thread0(wave)) (void)xb_add(&bar[XB_XCNT(b.x)], 1u);
    return b;
}
__device__ __forceinline__ void xcd_barrier_complete(unsigned* bar, unsigned x, unsigned& nloc, unsigned& nx) {
    const unsigned G = gridDim.x * gridDim.y * gridDim.z;
    unsigned sum, cnt, mine, sp = 0u;
    for (;;) {
        sum = 0u; cnt = 0u; mine = 0u;
#pragma unroll
        for (unsigned j = 0; j < 16; ++j) { const unsigned c = xb_ld(&bar[XB_XCNT(j)]); sum += c; cnt += (c > 0u) ? 1u : 0u; mine = (j == x) ? c : mine; }
        if (sum == G) break;
        __builtin_amdgcn_s_sleep(1);
        if ((++sp & 255u) == 0u) { if (xb_ld(&bar[XB_TMO])) break; if (sp > XB_SPIN_CAP) { atomicAdd(&bar[XB_TMO], 1u); break; } }
    }
    nloc = mine > 0u ? mine : 1u; nx = cnt > 0u ? cnt : 1u;
}
__device__ __forceinline__ void xcd_barrier(const XcdBarrier& b) {
    asm volatile("s_waitcnt vmcnt(0)" ::: "memory");
    __syncthreads();
    if (xb_thread0(b.wave)) {
        unsigned* bar = b.bar;
        __builtin_amdgcn_s_waitcnt(0);
        unsigned nloc = b.st[0], nx = b.st[1];
        if (nloc == 0u) { xcd_barrier_complete(bar, b.x, nloc, nx); b.st[0] = nloc; b.st[1] = nx; }
        const unsigned old = xb_add(&bar[XB_XSUB(b.x)], 1u);
        const unsigned gen = old / nloc;
        if (old + 1u == (gen + 1u) * nloc) {
            __builtin_amdgcn_fence(__ATOMIC_RELEASE, "agent");
            asm volatile("s_waitcnt vmcnt(0)" ::: "memory");
            const unsigned og = xb_add(&bar[XB_TOP], 1u);
            const unsigned tg = og / nx;
            if (og + 1u == (tg + 1u) * nx) xb_add(&bar[XB_TOPGEN], 1u);
            else XB_SPIN(xb_ld(&bar[XB_TOPGEN]) == tg, bar);
            __builtin_amdgcn_fence(__ATOMIC_ACQUIRE, "agent");
            xb_add(&bar[XB_XGEN(b.x)], 1u);
            asm volatile("s_waitcnt vmcnt(0)" ::: "memory");
        } else {
            XB_SPIN(xb_ld(&bar[XB_XGEN(b.x)]) == gen, bar);
            __builtin_amdgcn_fence(__ATOMIC_ACQUIRE, "agent");
            asm volatile("s_waitcnt vmcnt(0)" ::: "memory");
        }
    }
    __syncthreads();
}

namespace mk {
using namespace nv;
typedef unsigned v4u __attribute__((ext_vector_type(4)));
typedef unsigned v2u __attribute__((ext_vector_type(2)));
typedef float f32x4 __attribute__((ext_vector_type(4)));
constexpr int NWAVES = 8, NTHREADS = 512;
constexpr int LDS_BYTES = 160 * 1024;
constexpr int MISC_OFF = LDS_BYTES - 256;
constexpr int CW_BAR = 4096;
constexpr size_t CTL_ZERO_BYTES = 64 * 1024;

__device__ __forceinline__ unsigned pk2(float lo, float hi) { return (unsigned)f2bf(lo) | ((unsigned)f2bf(hi) << 16); }

struct Frame {
    LAS unsigned char* lds; int tid, lane, wave, vcu, G, bx;
};

__device__ __forceinline__ void transpose_item(const float* W, int ldw, bf16_t* WT, int ldt, int k0, int n0, int dest_row0, LAS float* scr, int lane, const float* nscale = nullptr) {
    const float sc = nscale ? nscale[n0 + (lane & 31)] : 1.f;
#pragma unroll 8
    for (int i = 0; i < 32; ++i) { const int kk = 2 * i + (lane >> 5); scr[kk * 33 + (lane & 31)] = W[(size_t)(k0 + kk) * ldw + n0 + (lane & 31)] * sc; }
    LDS_WAIT(); asm volatile("" ::: "memory");
    const int c = lane & 7;
#pragma unroll
    for (int j = 0; j < 4; ++j) { const int n = (lane >> 3) + 8 * j; const LAS float* s = scr + (8 * c) * 33 + n;
        v4u o; o.x = pk2(s[0 * 33], s[1 * 33]); o.y = pk2(s[2 * 33], s[3 * 33]); o.z = pk2(s[4 * 33], s[5 * 33]); o.w = pk2(s[6 * 33], s[7 * 33]);
        *(v4u*)(WT + (size_t)(dest_row0 + n) * ldt + k0 + 8 * c) = o; }
    LDS_WAIT(); asm volatile("" ::: "memory");
}
template <int MAP>
__device__ __forceinline__ void transpose_job_item(const float* src, int K, int N, bf16_t* dst, size_t dstb, int r, LAS float* scr, int lane, const float* nscale = nullptr) {
    const int nblk = N / 32, per = (K / 64) * nblk, bi = r / per, it = r % per, kb = it / nblk, nb = it % nblk, n0 = 32 * nb;
    int dr = n0; if (MAP == 1) dr = (n0 >> 7) * 256 + (n0 & 127); if (MAP == 2) dr = (n0 >> 7) * 256 + 128 + (n0 & 127);
    transpose_item(src + (size_t)bi * K * N, N, dst + (size_t)bi * dstb, K, 64 * kb, n0, dr, scr, lane, nscale ? nscale + (size_t)bi * N : nullptr);
}

struct InvFreq { float f[8]; };
struct Args {
    const void* in[40]; float* out; unsigned char* ws; InvFreq inv; int ph_lo, ph_hi;
};

struct Row16 { float v[4][4]; };
__device__ __forceinline__ void load_row_bf16(const bf16_t* p, int lane, Row16& r) {
#pragma unroll
    for (int j = 0; j < 4; ++j) { const ushort4 u = *(const ushort4*)(p + 256 * j + 4 * lane); r.v[j][0] = bf2f(u.x); r.v[j][1] = bf2f(u.y); r.v[j][2] = bf2f(u.z); r.v[j][3] = bf2f(u.w); }
}
__device__ __forceinline__ void ln_row(Row16& z, const float* g, const float* b, int lane) {
    float s = 0.f;
#pragma unroll
    for (int j = 0; j < 4; ++j)
#pragma unroll
        for (int i = 0; i < 4; ++i) s += z.v[j][i];
    const float mu = wave_sum(s) * (1.f / D);
    float q = 0.f;
#pragma unroll
    for (int j = 0; j < 4; ++j)
#pragma unroll
        for (int i = 0; i < 4; ++i) { z.v[j][i] -= mu; q += z.v[j][i] * z.v[j][i]; }
    const float rstd = 1.f / sqrtf(wave_sum(q) * (1.f / D) + LN_EPS);
#pragma unroll
    for (int j = 0; j < 4; ++j) { const float4 gg = *(const float4*)(g + 256 * j + 4 * lane), bb = *(const float4*)(b + 256 * j + 4 * lane);
        z.v[j][0] = z.v[j][0] * rstd * gg.x + bb.x; z.v[j][1] = z.v[j][1] * rstd * gg.y + bb.y; z.v[j][2] = z.v[j][2] * rstd * gg.z + bb.z; z.v[j][3] = z.v[j][3] * rstd * gg.w + bb.w; }
}
__device__ __forceinline__ void store_row_bf16(bf16_t* p, int lane, const Row16& r) {
#pragma unroll
    for (int j = 0; j < 4; ++j) { v2u u; u.x = pk2(r.v[j][0], r.v[j][1]); u.y = pk2(r.v[j][2], r.v[j][3]); *(v2u*)(p + 256 * j + 4 * lane) = u; }
}

__device__ __forceinline__ void phase_ln_add(const Frame& F, const bf16_t* X, const bf16_t* Y, const float* g, const float* b, bf16_t* out) {
    const int gw = F.vcu * NWAVES + F.wave, NGW = F.G * NWAVES;
    for (int row = gw; row < T; row += NGW) {
        Row16 x, y; load_row_bf16(X + (size_t)row * D, F.lane, x); load_row_bf16(Y + (size_t)row * D, F.lane, y);
#pragma unroll
        for (int j = 0; j < 4; ++j)
#pragma unroll
            for (int i = 0; i < 4; ++i) x.v[j][i] = ALPHA * x.v[j][i] + y.v[j][i];
        ln_row(x, g, b, F.lane);
        store_row_bf16(out + (size_t)row * D, F.lane, x);
    }
}
__device__ __forceinline__ void phase_ln_moe(const Frame& F, const bf16_t* X, const bf16_t* DS, const int* pos, const float* ewgt, const float* g, const float* b, bf16_t* outb, float* outf) {
    const int gw = F.vcu * NWAVES + F.wave, NGW = F.G * NWAVES;
    for (int row = gw; row < T; row += NGW) {
        Row16 x, y1, y2; load_row_bf16(X + (size_t)row * D, F.lane, x);
        const int r1 = pos[2 * row], r2 = pos[2 * row + 1]; const float w1 = ewgt[2 * row], w2 = ewgt[2 * row + 1];
        load_row_bf16(DS + (size_t)r1 * D, F.lane, y1); load_row_bf16(DS + (size_t)r2 * D, F.lane, y2);
#pragma unroll
        for (int j = 0; j < 4; ++j)
#pragma unroll
            for (int i = 0; i < 4; ++i) x.v[j][i] = ALPHA * x.v[j][i] + (w1 * y1.v[j][i] + w2 * y2.v[j][i]);
        ln_row(x, g, b, F.lane);
        if (outb) store_row_bf16(outb + (size_t)row * D, F.lane, x);
        if (outf) {
#pragma unroll
            for (int j = 0; j < 4; ++j) *(float4*)(outf + (size_t)row * D + 256 * j + 4 * F.lane) = make_float4(x.v[j][0], x.v[j][1], x.v[j][2], x.v[j][3]);
        }
    }
}
constexpr int RW_LD = 20;
__device__ __forceinline__ void phase_ln_router(const Frame& F, const bf16_t* X, const bf16_t* Y, const float* g, const float* b, bf16_t* out, const float* rw, const float* rbias, int* eidx, float* ewgt, int* bcnt) {
    LAS float* rwl = (LAS float*)F.lds;
    LAS int* hist = (LAS int*)(F.lds + 1024 * RW_LD * 4);
    for (int i = F.tid; i < 1024 * 4; i += NTHREADS) { const int k = i >> 2, q = i & 3; const float4 v = *(const float4*)(rw + (size_t)k * 16 + 4 * q); LAS float* d = rwl + k * RW_LD + 4 * q; d[0] = v.x; d[1] = v.y; d[2] = v.z; d[3] = v.w; }
    float rb[16];
#pragma unroll
    for (int e = 0; e < 16; ++e) rb[e] = rbias[e];
    for (int vb = F.vcu; vb < T / 128; vb += F.G) {
        if (F.tid < 16) hist[F.tid] = 0;
        __syncthreads();
        for (int i = 0; i < 16; ++i) {
            const int row = vb * 128 + F.wave * 16 + i;
            Row16 x, y; load_row_bf16(X + (size_t)row * D, F.lane, x); load_row_bf16(Y + (size_t)row * D, F.lane, y);
#pragma unroll
            for (int j = 0; j < 4; ++j)
#pragma unroll
                for (int k = 0; k < 4; ++k) x.v[j][k] = ALPHA * x.v[j][k] + y.v[j][k];
            ln_row(x, g, b, F.lane);
            store_row_bf16(out + (size_t)row * D, F.lane, x);
            float lg[16];
#pragma unroll
            for (int e = 0; e < 16; ++e) lg[e] = 0.f;
#pragma unroll
            for (int j = 0; j < 4; ++j)
#pragma unroll
                for (int k = 0; k < 4; ++k) {
                    const LAS float* wr = rwl + (256 * j + 4 * F.lane + k) * RW_LD;
                    const float xv = x.v[j][k];
#pragma unroll
                    for (int e4 = 0; e4 < 4; ++e4) { const f32x4 w4 = *(const LAS f32x4*)(wr + 4 * e4); lg[4 * e4 + 0] += xv * w4[0]; lg[4 * e4 + 1] += xv * w4[1]; lg[4 * e4 + 2] += xv * w4[2]; lg[4 * e4 + 3] += xv * w4[3]; }
                }
#pragma unroll
            for (int e = 0; e < 16; ++e) lg[e] = wave_sum(lg[e]);
            float mx = lg[0];
#pragma unroll
            for (int e = 1; e < 16; ++e) mx = fmaxf(mx, lg[e]);
            float sc[16], sum = 0.f;
#pragma unroll
            for (int e = 0; e < 16; ++e) { sc[e] = __expf(lg[e] - mx); sum += sc[e]; }
            const float isum = 1.f / sum;
            float bz[16];
#pragma unroll
            for (int e = 0; e < 16; ++e) { sc[e] *= isum; bz[e] = sc[e] + rb[e]; }
            float gs[4]; int gi1[4], gi2[4];
#pragma unroll
            for (int gq = 0; gq < 4; ++gq) {
                float m1 = bz[4 * gq]; int i1 = 0;
#pragma unroll
                for (int j = 1; j < 4; ++j) if (bz[4 * gq + j] > m1) { m1 = bz[4 * gq + j]; i1 = j; }
                float m2 = -INFINITY; int i2 = 0;
#pragma unroll
                for (int j = 0; j < 4; ++j) if (j != i1 && bz[4 * gq + j] > m2) { m2 = bz[4 * gq + j]; i2 = j; }
                gs[gq] = m1 + m2; gi1[gq] = i1; gi2[gq] = i2;
            }
            int gsel = 0; float gm = gs[0];
#pragma unroll
            for (int gq = 1; gq < 4; ++gq) if (gs[gq] > gm) { gm = gs[gq]; gsel = gq; }
            int i1 = gi1[0], i2 = gi2[0];
#pragma unroll
            for (int gq = 1; gq < 4; ++gq) if (gsel == gq) { i1 = gi1[gq]; i2 = gi2[gq]; }
            const int e1 = gsel * 4 + i1, e2 = gsel * 4 + i2;
            float s1 = 0.f, s2 = 0.f;
#pragma unroll
            for (int e = 0; e < 16; ++e) { if (e == e1) s1 = sc[e]; if (e == e2) s2 = sc[e]; }
            const float inv = 1.f / (s1 + s2);
            if (F.lane == 0) { eidx[2 * row] = e1; eidx[2 * row + 1] = e2; ewgt[2 * row] = s1 * inv; ewgt[2 * row + 1] = s2 * inv; atomicAdd((int*)&hist[e1], 1); atomicAdd((int*)&hist[e2], 1); }
        }
        __syncthreads();
        if (F.tid < 16) bcnt[vb * 16 + F.tid] = hist[F.tid];
        __syncthreads();
    }
}
__device__ __forceinline__ void phase_moe_book(const Frame& F, const int* eidx, const int* bcnt, int* tok, int* pos, int* tile_e) {
    LAS int* bc = (LAS int*)F.lds;
    LAS int* es = bc + 4096;
    LAS int* off = es + 256;
    LAS int* base = off + 32;
    LAS int* tot = base + 16;
    for (int i = F.tid; i < 4096; i += NTHREADS) bc[i] = bcnt[i];
    __syncthreads();
    for (int vb = F.vcu; vb < T / 128; vb += F.G) {
        if (F.tid < 16) { int t = 0, bs = 0; for (int b2 = 0; b2 < 256; ++b2) { const int c = bc[b2 * 16 + F.tid]; t += c; if (b2 < vb) bs += c; } tot[F.tid] = t; base[F.tid] = bs; }
        if (F.tid < 256) es[F.tid] = eidx[vb * 256 + F.tid];
        __syncthreads();
        if (F.tid == 0) { int o = 0; for (int e = 0; e < 16; ++e) { off[e] = o; o += (tot[e] + 255) & ~255; } off[16] = o; }
        __syncthreads();
        if (F.tid < 256) {
            const int e = es[F.tid]; int rank = 0;
            for (int j = 0; j < F.tid; ++j) rank += (es[j] == e) ? 1 : 0;
            const int r = off[e] + base[e] + rank;
            pos[vb * 256 + F.tid] = r; tok[r] = vb * 128 + (F.tid >> 1);
        }
        if (vb < 16) { const int e = vb, r0 = off[e] + tot[e], r1 = off[e + 1]; for (int r = r0 + F.tid; r < r1; r += NTHREADS) tok[r] = 0; }
        if (vb == 16) {
            for (int tl = F.tid; tl < NTILE; tl += NTHREADS) { int e = -1; for (int k = 0; k < 16; ++k) if (tl * 256 >= off[k] && tl * 256 < off[k + 1]) e = k; tile_e[tl] = e; }
            if (F.tid == 0) tile_e[NTILE] = off[16] >> 8;
        }
        __syncthreads();
    }
}
__device__ __forceinline__ void phase_pool(const Frame& F, const bf16_t* HP, bf16_t* PO) {
    const int gt = F.vcu * NTHREADS + F.tid, NGT = F.G * NTHREADS;
    for (int i = gt; i < T * (D / 8); i += NGT) {
        const int t = i >> 7, c8 = i & 127, g = c8 >> 5, win = 2 << g, ts = t & (S - 1);
        const int n = ts + 1 < win ? ts + 1 : win;
        float s[8], h0[8];
        { const v4u u = *(const v4u*)(HP + (size_t)t * D + c8 * 8);
            h0[0] = __uint_as_float(u.x << 16); h0[1] = __uint_as_float(u.x & 0xffff0000u); h0[2] = __uint_as_float(u.y << 16); h0[3] = __uint_as_float(u.y & 0xffff0000u);
            h0[4] = __uint_as_float(u.z << 16); h0[5] = __uint_as_float(u.z & 0xffff0000u); h0[6] = __uint_as_float(u.w << 16); h0[7] = __uint_as_float(u.w & 0xffff0000u); }
#pragma unroll
        for (int q = 0; q < 8; ++q) s[q] = h0[q];
        for (int k = 1; k < n; ++k) {
            const v4u u = *(const v4u*)(HP + (size_t)(t - k) * D + c8 * 8);
            s[0] += __uint_as_float(u.x << 16); s[1] += __uint_as_float(u.x & 0xffff0000u); s[2] += __uint_as_float(u.y << 16); s[3] += __uint_as_float(u.y & 0xffff0000u);
            s[4] += __uint_as_float(u.z << 16); s[5] += __uint_as_float(u.z & 0xffff0000u); s[6] += __uint_as_float(u.w << 16); s[7] += __uint_as_float(u.w & 0xffff0000u);
        }
        const float inv = 1.f / (float)n;
        v4u o; o.x = pk2(s[0] * inv - h0[0], s[1] * inv - h0[1]); o.y = pk2(s[2] * inv - h0[2], s[3] * inv - h0[3]); o.z = pk2(s[4] * inv - h0[4], s[5] * inv - h0[5]); o.w = pk2(s[6] * inv - h0[6], s[7] * inv - h0[7]);
        *(v4u*)(PO + (size_t)t * D + c8 * 8) = o;
    }
}
}
namespace mk {
#ifndef MK_HAVE_SWA
#define MK_HAVE_SWA 0
#endif
#ifndef MK_HAVE_XATTN
#define MK_HAVE_XATTN 0
#endif
constexpr int NPHASE = 26;

typedef const __attribute__((address_space(4))) Args* KArgs;
__device__ __forceinline__ KArgs kargs() { KArgs p = (KArgs)__builtin_amdgcn_kernarg_segment_ptr(); asm volatile("" : "+s"(p)); return p; }

__device__ __forceinline__ bool in_range(int k) { KArgs ka = kargs(); return ka->ph_lo <= k && k < ka->ph_hi; }

__global__ void __launch_bounds__(NTHREADS, 2) mega(Args a) {
    extern __shared__ __attribute__((aligned(16))) unsigned char lds_raw[];
    LAS unsigned char* const F0lds = (LAS unsigned char*)lds_raw;
    const int F0wave = __builtin_amdgcn_readfirstlane((int)threadIdx.x >> 6);
    const int F0G = gridDim.x, F0bx = blockIdx.x, F0vcu = (F0G % 8 == 0) ? (F0bx % 8) * (F0G / 8) + F0bx / 8 : F0bx;
    volatile LAS unsigned* MISC = (volatile LAS unsigned*)(F0lds + MISC_OFF);
    if (threadIdx.x < 64) MISC[threadIdx.x] = 0u;
    __syncthreads();
    unsigned* ctl = (unsigned*)(a.ws + WS_CTL);
    XcdBarrier bar = xcd_barrier_post(ctl + CW_BAR + a.ph_lo * XCD_BAR_WORDS, MISC + 8, F0wave);
#define IN(k) in_range(k)
#define SEAM(k) do { if (IN(k) && IN((k) + 1)) { XcdBarrier b2_ = bar; asm volatile("" : "+s"(b2_.bar), "+s"(b2_.x)); xcd_barrier(b2_); } } while (0)
#define PH KArgs ka = kargs(); unsigned char* ws = ka->ws; (void)ws; Frame Fp; Fp.lds = F0lds; Fp.wave = F0wave; Fp.vcu = F0vcu; Fp.G = F0G; Fp.bx = F0bx; asm volatile("" : "+s"(Fp.wave), "+s"(Fp.vcu), "+s"(Fp.G), "+s"(Fp.bx)); \
    Fp.lane = (int)lane_id_fresh(); Fp.tid = Fp.wave * 64 + Fp.lane; const Frame& F = Fp; \
    const int bx = Fp.bx; (void)bx; LAS unsigned char* glds = F.lds; (void)glds; \
    bf16_t* RA = (bf16_t*)(ws + WS_A); bf16_t* RB = (bf16_t*)(ws + WS_B); bf16_t* RC = (bf16_t*)(ws + WS_C); bf16_t* RD = (bf16_t*)(ws + WS_D); bf16_t* WB = (bf16_t*)(ws + WS_WB); \
    (void)RA; (void)RB; (void)RC; (void)RD; (void)WB;
#define PHC PH const int cb = L == 0 ? 12 : 28; (void)cb; bf16_t* WBl = WB + WB_LAYER + (size_t)L * WL_SIZE; (void)WBl; \
    bf16_t *X1 = RB, *Qb, *Ob, *Y2, *X2, *HS = RB, *DS = RD, *X3; if (L == 0) { Qb = RA; Ob = RC; Y2 = RA; X2 = RC; X3 = RA; } else { Qb = RC; Ob = RD; Y2 = RC; X2 = RA; X3 = nullptr; } \
    (void)X1; (void)Qb; (void)Ob; (void)Y2; (void)X2; (void)HS; (void)DS; (void)X3;
#define INF(i) ((const float*)ka->in[i])
#define WSI(off) ((int*)(ws + (off)))
#define WSF(off) ((float*)(ws + (off)))

    for (int L = 0; L < 2; ++L) {
        const int pb = 13 * L;
        if (L == 0) {
            if (IN(0)) { PH
                LAS float* scr = (LAS float*)(F.lds + F.wave * 16384);
                const int gw = F.vcu * NWAVES + F.wave, NGW = F.G * NWAVES;
                constexpr int NITEMS = 896 + 512 + 512 + 128 + 512 + 2 * (512 + 1024 + 512 + 3 * 4096);
                for (int it = gw; it < NITEMS; it += NGW) {
                    int r = it;
#define JOB(MAP, src, K_, N_, dst, dstb, cnt) if (r < (cnt)) { transpose_job_item<MAP>((const float*)(src), K_, N_, dst, dstb, r, scr, F.lane); continue; } r -= (cnt);
                    JOB(0, ka->in[5], 1024, 1792, WB + WB_IN0, 0, 896)
                    JOB(0, ka->in[11], 1024, 1024, WB + WB_OUT0, 0, 512)
                    JOB(0, ka->in[24], 1024, 1024, WB + WB_IN1, 0, 512)
                    if (r < 128) { transpose_job_item<0>((const float*)ka->in[25], 256, 256, WB + WB_POOL, (size_t)256 * 256, r, scr, F.lane, (const float*)ka->in[26]); continue; } r -= 128;
                    JOB(0, ka->in[27], 1024, 1024, WB + WB_OUT1, 0, 512)
#define LAYER_JOBS(l, c2) { bf16_t* Wl = WB + WB_LAYER + (size_t)(l) * WL_SIZE; \
                        JOB(0, ka->in[(c2) + 2], 1024, 1024, Wl + WL_XQ, 0, 512) \
                        JOB(0, ka->in[(c2) + 3], 1024, 2048, Wl + WL_XKV, 0, 1024) \
                        JOB(0, ka->in[(c2) + 4], 1024, 1024, Wl + WL_XO, 0, 512) \
                        JOB(1, ka->in[(c2) + 7], 1024, 512, Wl + WL_GU, (size_t)1024 * 1024, 4096) \
                        JOB(2, ka->in[(c2) + 8], 1024, 512, Wl + WL_GU, (size_t)1024 * 1024, 4096) \
                        JOB(0, ka->in[(c2) + 9], 512, 1024, Wl + WL_DN, (size_t)1024 * 512, 4096) }
                    LAYER_JOBS(0, 12)
                    LAYER_JOBS(1, 28)
#undef LAYER_JOBS
#undef JOB
                }
                const int gt = F.vcu * NTHREADS + F.tid, NGT = F.G * NTHREADS;
                { const float4* x4 = (const float4*)ka->in[0]; v2u* o = (v2u*)RA;
                  for (int i = gt; i < T * D / 4; i += NGT) { const float4 v = x4[i]; v2u w; w.x = pk2(v.x, v.y); w.y = pk2(v.z, v.w); o[i] = w; } }
                { const float4* m4 = (const float4*)ka->in[1]; v2u* o = (v2u*)(ws + WS_MEMB);
                  for (int i = gt; i < B * MEM * D / 4; i += NGT) { const float4 v = m4[i]; v2u w; w.x = pk2(v.x, v.y); w.y = pk2(v.z, v.w); o[i] = w; } }
                { const int* positions = (const int*)ka->in[2]; float* ropew = WSF(WS_ROPE);
                  for (int t = gt; t < T; t += NGT) { const float p = (float)positions[t];
#pragma unroll
                      for (int j = 0; j < 8; ++j) { const float ang = p * ka->inv.f[j]; double rev = (double)ang * 0.15915494309189535; rev -= rint(rev); const float rr = (float)rev;
                          ropew[(size_t)t * 16 + j] = __builtin_amdgcn_cosf(rr); ropew[(size_t)t * 16 + 8 + j] = __builtin_amdgcn_sinf(rr); } } }
                { const float* sw = INF(9); bf16_t* o = WB + WB_SGUW;
                  for (int i = gt; i < 8 * 128 * 128; i += NGT) { const int s = i & 127, t = (i >> 7) & 127; o[i] = f2bf(s <= t ? sw[i] : 0.f); } }
            }
            SEAM(0);
            if (IN(1)) { PH float* rope = WSF(WS_ROPE); bf16_t* MEMB = (bf16_t*)(ws + WS_MEMB);
#pragma unroll 1
                for (int l = 0; l < 2; ++l) {
                    bf16_t* Wl = WB + WB_LAYER + (size_t)l * WL_SIZE;
                    pg8::Gemm g{MEMB, Wl + WL_XKV, nullptr};
                    const int c2 = bx - 128 - 32 * l;
                    pg8::StaticOrder S; S.init(B * MEM, 2048, F.G, (c2 >= 0 && c2 < 32) ? c2 : (1 << 20));
                    pg8::EpiKV E{(bf16_t*)(ws + WS_MEMKV) + (size_t)l * B * MEM * 2048, (bf16_t*)(ws + WS_MEMVT) + (size_t)l * B * MEM * 1024};
                    pg8::gemm_phase<pg8::EpiKV, pg8::StaticOrder, true, true, false, D, D, D, 0>(glds, F.tid, g, S, E);
                }
                {
                    pg8::Gemm g{RA, WB + WB_IN0, nullptr};
                    pg8::StaticOrder S; S.init(T, NIN0, F.G, bx);
                    pg8::EpiInproj0 E{RD, rope};
                    pg8::gemm_phase<pg8::EpiInproj0, pg8::StaticOrder, true, true, false, D, D, D, 0>(glds, F.tid, g, S, E);
                }
            }
            SEAM(1);
            if (IN(2)) { PH
#if MK_HAVE_SWA
                phase_swa_sgu(F, RD, INF(6), INF(7), INF(8), WB + WB_SGUW, INF(10), RB);
#endif
            }
            SEAM(2);
            if (IN(3)) { PH
                pg8::Gemm g{RB, WB + WB_OUT0, nullptr};
                pg8::StaticOrder S; S.init(T, D, F.G, bx);
                pg8::EpiBf16 E{RC, D, 1.f};
                pg8::gemm_phase<pg8::EpiBf16, pg8::StaticOrder, true, true, false, D, D, D, 0>(glds, F.tid, g, S, E);
            }
            SEAM(3);
            if (IN(4)) { PH phase_ln_add(F, RA, RC, INF(12), INF(13), RB); }
            SEAM(4);
        } else {
            if (IN(13)) { PH
                pg8::Gemm g{RA, WB + WB_IN1, nullptr};
                pg8::StaticOrder S; S.init(T, D, F.G, bx);
                pg8::EpiBf16 E{RB, D, 1.f};
                pg8::gemm_phase<pg8::EpiBf16, pg8::StaticOrder, true, true, false, D, D, D, 0>(glds, F.tid, g, S, E);
            }
            SEAM(13);
            if (IN(14)) { PH phase_pool(F, RB, RC); }
            SEAM(14);
            if (IN(15)) { PH
                pg8::Gemm g{RC, WB + WB_POOL, nullptr};
                pg8::StaticOrder S; S.init(T, D, F.G, bx);
                pg8::EpiBf16 E{RD, D, 1.f};
                pg8::gemm_phase<pg8::EpiBf16, pg8::StaticOrder, true, true, false, D, 256, 256, 256>(glds, F.tid, g, S, E);
            }
            SEAM(15);
            if (IN(16)) { PH
                pg8::Gemm g{RD, WB + WB_OUT1, nullptr};
                pg8::StaticOrder S; S.init(T, D, F.G, bx);
                pg8::EpiBf16 E{RC, D, 1.f};
                pg8::gemm_phase<pg8::EpiBf16, pg8::StaticOrder, true, true, false, D, D, D, 0>(glds, F.tid, g, S, E);
            }
            SEAM(16);
            if (IN(17)) { PH phase_ln_add(F, RA, RC, INF(28), INF(29), RB); }
            SEAM(17);
        }
        if (IN(pb + 5)) { PHC
            pg8::Gemm g{X1, WBl + WL_XQ, nullptr};
            pg8::StaticOrder S; S.init(T, D, F.G, bx);
            pg8::EpiBf16 E{Qb, D, QSCALE};
            pg8::gemm_phase<pg8::EpiBf16, pg8::StaticOrder, true, true, false, D, D, D, 0>(glds, F.tid, g, S, E);
        }
        SEAM(pb + 5);
        if (IN(pb + 6)) { PHC bf16_t* Kb = (bf16_t*)(ws + WS_MEMKV) + (size_t)L * B * MEM * 2048; bf16_t* Vt = (bf16_t*)(ws + WS_MEMVT) + (size_t)L * B * MEM * 1024; (void)Kb; (void)Vt;
#if MK_HAVE_XATTN
            phase_xattn(F, Qb, Kb, Vt, Ob);
#endif
        }
        SEAM(pb + 6);
        if (IN(pb + 7)) { PHC
            pg8::Gemm g{Ob, WBl + WL_XO, nullptr};
            pg8::StaticOrder S; S.init(T, D, F.G, bx);
            pg8::EpiBf16 E{Y2, D, 1.f};
            pg8::gemm_phase<pg8::EpiBf16, pg8::StaticOrder, true, true, false, D, D, D, 0>(glds, F.tid, g, S, E);
        }
        SEAM(pb + 7);
        if (IN(pb + 8)) { PHC phase_ln_router(F, X1, Y2, INF(cb + 5), INF(cb + 6), X2, INF(3), INF(4), WSI(WS_EIDX), WSF(WS_EWGT), WSI(WS_BCNT)); }
        SEAM(pb + 8);
        if (IN(pb + 9)) { PHC phase_moe_book(F, WSI(WS_EIDX), WSI(WS_BCNT), WSI(WS_TOK), WSI(WS_POS), WSI(WS_TILE)); }
        SEAM(pb + 9);
        if (IN(pb + 10)) { PHC const int* tile_e = WSI(WS_TILE); const int* tok = WSI(WS_TOK);
            const int ntiles = __builtin_amdgcn_readfirstlane(tile_e[NTILE]);
            pg8::Gemm g{X2, WBl + WL_GU, tok};
            pg8::MoeOrder S; S.init(ntiles, tile_e, F.G, bx);
            pg8::EpiGU E{HS};
            pg8::gemm_phase<pg8::EpiGU, pg8::MoeOrder, true, true, true, D, D, D, 0>(glds, F.tid, g, S, E);
        }
        SEAM(pb + 10);
        if (IN(pb + 11)) { PHC const int* tile_e = WSI(WS_TILE);
            const int ntiles = __builtin_amdgcn_readfirstlane(tile_e[NTILE]);
            pg8::Gemm g{HS, WBl + WL_DN, nullptr};
            pg8::MoeOrder S; S.init(ntiles, tile_e, F.G, bx);
            pg8::EpiBf16 E{DS, D, 1.f};
            pg8::gemm_phase<pg8::EpiBf16, pg8::MoeOrder, true, true, false, DE, DE, DE, 0>(glds, F.tid, g, S, E);
        }
        SEAM(pb + 11);
        if (IN(pb + 12)) { PHC phase_ln_moe(F, X2, DS, WSI(WS_POS), WSF(WS_EWGT), INF(cb + 10), INF(cb + 11), X3, L == 1 ? ka->out : nullptr); }
        SEAM(pb + 12);
    }
#undef IN
#undef SEAM
#undef INF
#undef PH
#undef PHC
#undef WSI
#undef WSF
}
}
namespace nv {
template <class Epi>
__global__ __launch_bounds__(256) void k_gemm(const bf16_t* A, int lda, const float* W, int ldw, int K, Epi epi, const int* tile_e, size_t w_stride, const int* arow) {
    __shared__ float As[16][68];
    __shared__ float Bs[16][68];
    const int bm = blockIdx.y * 64, bn = blockIdx.x * 64;
    const float* Wp = W;
    if (tile_e) { const int e = tile_e[bm >> 8]; if (e < 0) return; Wp += (size_t)e * w_stride; }
    const int tid = threadIdx.x, tx = tid & 15, ty = tid >> 4;
    float acc[4][4];
#pragma unroll
    for (int i = 0; i < 4; ++i)
#pragma unroll
        for (int j = 0; j < 4; ++j) acc[i][j] = 0.f;
    for (int k0 = 0; k0 < K; k0 += 16) {
        {
            const int r = tid >> 2, kk = (tid & 3) * 4;
            const int ar = arow ? arow[bm + r] : bm + r;
            const ushort4 v = *(const ushort4*)(A + (size_t)ar * lda + k0 + kk);
            As[kk + 0][r] = bf2f(v.x); As[kk + 1][r] = bf2f(v.y); As[kk + 2][r] = bf2f(v.z); As[kk + 3][r] = bf2f(v.w);
        }
        {
            const int kk = tid >> 4, n = (tid & 15) * 4;
            const float4 v = *(const float4*)(Wp + (size_t)(k0 + kk) * ldw + bn + n);
            Bs[kk][n + 0] = v.x; Bs[kk][n + 1] = v.y; Bs[kk][n + 2] = v.z; Bs[kk][n + 3] = v.w;
        }
        __syncthreads();
#pragma unroll
        for (int kk = 0; kk < 16; ++kk) {
            float a[4], b[4];
#pragma unroll
            for (int i = 0; i < 4; ++i) a[i] = As[kk][ty * 4 + i];
#pragma unroll
            for (int j = 0; j < 4; ++j) b[j] = Bs[kk][tx * 4 + j];
#pragma unroll
            for (int i = 0; i < 4; ++i)
#pragma unroll
                for (int j = 0; j < 4; ++j) acc[i][j] += a[i] * b[j];
        }
        __syncthreads();
    }
#pragma unroll
    for (int i = 0; i < 4; ++i)
#pragma unroll
        for (int j = 0; j < 4; ++j) epi(bm + ty * 4 + i, bn + tx * 4 + j, acc[i][j]);
}

struct EpiBf16 { bf16_t* O; int ldo; float scale; __device__ void operator()(int r, int c, float v) const { O[(size_t)r * ldo + c] = f2bf(v * scale); } };
struct EpiInproj0 { bf16_t* O; __device__ void operator()(int r, int c, float v) const { if (c >= 768) v = gelu_tanh(v); O[(size_t)r * NIN0 + c] = f2bf(v); } };
struct EpiF32 { float* O; int ldo; __device__ void operator()(int r, int c, float v) const { O[(size_t)r * ldo + c] = v; } };
struct EpiSiluMul { const float* G; bf16_t* HS; __device__ void operator()(int r, int c, float v) const { HS[(size_t)r * DE + c] = f2bf(silu(G[(size_t)r * DE + c]) * v); } };
struct EpiKV { bf16_t* Kb; bf16_t* Vt; __device__ void operator()(int r, int c, float v) const {
    Kb[(size_t)r * 2048 + c] = f2bf(v);
    if (c >= 1024) { const int d = c - 1024, h = d >> 8, dd = d & 255, b = r >> 8, key = r & 255; Vt[((size_t)(b * XH + h) * XHD + dd) * MEM + key] = f2bf(v); } } };
struct EpiPoolMap { bf16_t* O; const float* scale; int coff; __device__ void operator()(int r, int c, float v) const { O[(size_t)r * D + coff + c] = f2bf(v * scale[coff + c]); } };

__global__ void k_cvt_x(const float* x, bf16_t* xb, size_t n4) {
    for (size_t i = (size_t)blockIdx.x * blockDim.x + threadIdx.x; i < n4; i += (size_t)gridDim.x * blockDim.x) {
        const float4 v = ((const float4*)x)[i];
        ushort4 o; o.x = f2bf(v.x); o.y = f2bf(v.y); o.z = f2bf(v.z); o.w = f2bf(v.w);
        ((ushort4*)xb)[i] = o;
    }
}
struct InvFreq { float f[8]; };
__global__ void k_rope_table(const int* positions, float* tab, InvFreq inv) {
    const int t = blockIdx.x * blockDim.x + threadIdx.x;
    if (t >= T) return;
    const float p = (float)positions[t];
#pragma unroll
    for (int j = 0; j < 8; ++j) {
        const float ang = p * inv.f[j];
        double rev = (double)ang * 0.15915494309189535; rev -= rint(rev);
        const float r = (float)rev;
        tab[(size_t)t * 16 + j] = __builtin_amdgcn_cosf(r);
        tab[(size_t)t * 16 + 8 + j] = __builtin_amdgcn_sinf(r);
    }
}
__global__ void k_rope_apply(bf16_t* H0, const float* tab) {
    const int i = blockIdx.x * blockDim.x + threadIdx.x;
    if (i >= T * 80) return;
    const int t = i / 80, r = i % 80, hd = r >> 3, j = r & 7;
    bf16_t* p = H0 + (size_t)t * NIN0 + hd * 64;
    const float t1 = bf2f(p[j]), t2 = bf2f(p[j + 8]);
    const float c = tab[(size_t)t * 16 + j], s = tab[(size_t)t * 16 + 8 + j];
    p[j] = f2bf(t1 * c - t2 * s); p[j + 8] = f2bf(t2 * c + t1 * s);
}

__global__ __launch_bounds__(128) void k_swa(const bf16_t* H0, const float* sinks, bf16_t* MIX) {
    __shared__ float Ks[256][65];
    __shared__ float Vs[256][65];
    const int head = blockIdx.x & 7, bn = blockIdx.x >> 3, n = bn & 63, b = bn >> 6;
    const int kvh = head >> 2;
    const int tid = threadIdx.x;
    const size_t row0 = (size_t)b * S + (size_t)n * 128;
    for (int idx = tid; idx < 256 * 64; idx += 128) {
        const int kj = idx >> 6, d = idx & 63;
        float kv = 0.f, vv = 0.f;
        if (n > 0 || kj >= 128) {
            const size_t row = row0 - 128 + kj;
            kv = bf2f(H0[row * NIN0 + 512 + kvh * 64 + d]);
            vv = bf2f(H0[row * NIN0 + 640 + kvh * 64 + d]);
        }
        Ks[kj][d] = kv; Vs[kj][d] = vv;
    }
    __syncthreads();
    float q[64], o[64];
    const bf16_t* qp = H0 + (row0 + tid) * NIN0 + head * 64;
#pragma unroll
    for (int d = 0; d < 64; ++d) { q[d] = bf2f(qp[d]) * ASCALE; o[d] = 0.f; }
    const float sink = sinks[head] * 1.4426950408889634f;
    float m = sink, l = 1.f;
    for (int kj = tid + 1; kj <= tid + 128; ++kj) {
        if (n == 0 && kj < 128) continue;
        float s = 0.f;
#pragma unroll
        for (int d = 0; d < 64; ++d) s += q[d] * Ks[kj][d];
        const float mn = fmaxf(m, s), sc = exp2f(m - mn), p = exp2f(s - mn);
        l = l * sc + p; m = mn;
#pragma unroll
        for (int d = 0; d < 64; ++d) o[d] = o[d] * sc + p * Vs[kj][d];
    }
    const float inv = 1.f / l;
    bf16_t* op = MIX + (row0 + tid) * D + head * 64;
#pragma unroll
    for (int d = 0; d < 64; ++d) op[d] = f2bf(o[d] * inv);
}

__global__ void k_sgu_ln(const bf16_t* H0, const float* lg, const float* lb, bf16_t* VG) {
    const int i = blockIdx.x * blockDim.x + threadIdx.x;
    if (i >= T * 8) return;
    const int t = i >> 3, g = i & 7;
    const bf16_t* p = H0 + (size_t)t * NIN0 + 1280 + g * 64;
    float s = 0.f;
    for (int c = 0; c < 64; ++c) s += bf2f(p[c]);
    const float mu = s * (1.f / 64.f);
    float q = 0.f;
    for (int c = 0; c < 64; ++c) { const float d = bf2f(p[c]) - mu; q += d * d; }
    const float rstd = 1.f / sqrtf(q * (1.f / 64.f) + LN_EPS);
    for (int c = 0; c < 64; ++c) VG[(size_t)t * 512 + g * 64 + c] = f2bf((bf2f(p[c]) - mu) * rstd * lg[g * 64 + c] + lb[g * 64 + c]);
}
__global__ void k_sgu_mix(const bf16_t* H0, const bf16_t* VG, const float* w, const float* bs, bf16_t* MIX) {
    const size_t i = (size_t)blockIdx.x * blockDim.x + threadIdx.x;
    if (i >= (size_t)T * 512) return;
    const int t = (int)(i >> 9), ch = (int)(i & 511), g = ch >> 6, tl = t & 127;
    const size_t c0 = (size_t)(t - tl);
    const float* wr = w + ((size_t)g * 128 + tl) * 128;
    float acc = 0.f;
    for (int s = 0; s <= tl; ++s) acc += wr[s] * bf2f(VG[(c0 + s) * 512 + ch]);
    acc += bs[g * 128 + tl];
    MIX[(size_t)t * D + 512 + ch] = f2bf(bf2f(H0[(size_t)t * NIN0 + 768 + ch]) * acc);
}

struct Row16 { float v[4][4]; };
__device__ __forceinline__ void load_row_bf16(const bf16_t* p, int lane, Row16& r) {
#pragma unroll
    for (int j = 0; j < 4; ++j) { const ushort4 u = *(const ushort4*)(p + 256 * j + 4 * lane); r.v[j][0] = bf2f(u.x); r.v[j][1] = bf2f(u.y); r.v[j][2] = bf2f(u.z); r.v[j][3] = bf2f(u.w); }
}
__device__ __forceinline__ void ln_row(Row16& z, const float* g, const float* b, int lane) {
    float s = 0.f;
#pragma unroll
    for (int j = 0; j < 4; ++j)
#pragma unroll
        for (int i = 0; i < 4; ++i) s += z.v[j][i];
    const float mu = wave_sum(s) * (1.f / D);
    float q = 0.f;
#pragma unroll
    for (int j = 0; j < 4; ++j)
#pragma unroll
        for (int i = 0; i < 4; ++i) { z.v[j][i] -= mu; q += z.v[j][i] * z.v[j][i]; }
    const float rstd = 1.f / sqrtf(wave_sum(q) * (1.f / D) + LN_EPS);
#pragma unroll
    for (int j = 0; j < 4; ++j) { const float4 gg = *(const float4*)(g + 256 * j + 4 * lane), bb = *(const float4*)(b + 256 * j + 4 * lane);
        z.v[j][0] = z.v[j][0] * rstd * gg.x + bb.x; z.v[j][1] = z.v[j][1] * rstd * gg.y + bb.y; z.v[j][2] = z.v[j][2] * rstd * gg.z + bb.z; z.v[j][3] = z.v[j][3] * rstd * gg.w + bb.w; }
}
__device__ __forceinline__ void store_row_bf16(bf16_t* p, int lane, const Row16& r) {
#pragma unroll
    for (int j = 0; j < 4; ++j) { ushort4 u; u.x = f2bf(r.v[j][0]); u.y = f2bf(r.v[j][1]); u.z = f2bf(r.v[j][2]); u.w = f2bf(r.v[j][3]); *(ushort4*)(p + 256 * j + 4 * lane) = u; }
}
__global__ __launch_bounds__(256) void k_ln_add(const bf16_t* X, const bf16_t* Y, const float* g, const float* b, bf16_t* out) {
    const int lane = threadIdx.x & 63, row = blockIdx.x * 4 + (threadIdx.x >> 6);
    Row16 x, y; load_row_bf16(X + (size_t)row * D, lane, x); load_row_bf16(Y + (size_t)row * D, lane, y);
#pragma unroll
    for (int j = 0; j < 4; ++j)
#pragma unroll
        for (int i = 0; i < 4; ++i) x.v[j][i] = ALPHA * x.v[j][i] + y.v[j][i];
    ln_row(x, g, b, lane);
    store_row_bf16(out + (size_t)row * D, lane, x);
}
__global__ __launch_bounds__(256) void k_ln_router(const bf16_t* X, const bf16_t* Y, const float* g, const float* b, bf16_t* out, const float* rw, const float* rbias, int* eidx, float* ewgt) {
    const int lane = threadIdx.x & 63, row = blockIdx.x * 4 + (threadIdx.x >> 6);
    Row16 x, y; load_row_bf16(X + (size_t)row * D, lane, x); load_row_bf16(Y + (size_t)row * D, lane, y);
#pragma unroll
    for (int j = 0; j < 4; ++j)
#pragma unroll
        for (int i = 0; i < 4; ++i) x.v[j][i] = ALPHA * x.v[j][i] + y.v[j][i];
    ln_row(x, g, b, lane);
    store_row_bf16(out + (size_t)row * D, lane, x);
    float lg[16];
#pragma unroll
    for (int e = 0; e < 16; ++e) lg[e] = 0.f;
#pragma unroll
    for (int j = 0; j < 4; ++j)
#pragma unroll
        for (int i = 0; i < 4; ++i) {
            const float* wr = rw + (size_t)(256 * j + 4 * lane + i) * 16;
            const float xv = x.v[j][i];
#pragma unroll
            for (int e4 = 0; e4 < 4; ++e4) { const float4 w4 = *(const float4*)(wr + 4 * e4); lg[4 * e4 + 0] += xv * w4.x; lg[4 * e4 + 1] += xv * w4.y; lg[4 * e4 + 2] += xv * w4.z; lg[4 * e4 + 3] += xv * w4.w; }
        }
#pragma unroll
    for (int e = 0; e < 16; ++e) lg[e] = wave_sum(lg[e]);
    float mx = lg[0];
#pragma unroll
    for (int e = 1; e < 16; ++e) mx = fmaxf(mx, lg[e]);
    float sc[16], sum = 0.f;
#pragma unroll
    for (int e = 0; e < 16; ++e) { sc[e] = expf(lg[e] - mx); sum += sc[e]; }
    const float isum = 1.f / sum;
    float bz[16];
#pragma unroll
    for (int e = 0; e < 16; ++e) { sc[e] *= isum; bz[e] = sc[e] + rbias[e]; }
    float gs[4]; int gi1[4], gi2[4];
#pragma unroll
    for (int gq = 0; gq < 4; ++gq) {
        float m1 = bz[4 * gq]; int i1 = 0;
#pragma unroll
        for (int j = 1; j < 4; ++j) if (bz[4 * gq + j] > m1) { m1 = bz[4 * gq + j]; i1 = j; }
        float m2 = -INFINITY; int i2 = 0;
#pragma unroll
        for (int j = 0; j < 4; ++j) if (j != i1 && bz[4 * gq + j] > m2) { m2 = bz[4 * gq + j]; i2 = j; }
        gs[gq] = m1 + m2; gi1[gq] = i1; gi2[gq] = i2;
    }
    int gsel = 0; float gm = gs[0];
#pragma unroll
    for (int gq = 1; gq < 4; ++gq) if (gs[gq] > gm) { gm = gs[gq]; gsel = gq; }
    int i1 = gi1[0], i2 = gi2[0];
#pragma unroll
    for (int gq = 1; gq < 4; ++gq) if (gsel == gq) { i1 = gi1[gq]; i2 = gi2[gq]; }
    const int e1 = gsel * 4 + i1, e2 = gsel * 4 + i2;
    float s1 = 0.f, s2 = 0.f;
#pragma unroll
    for (int e = 0; e < 16; ++e) { if (e == e1) s1 = sc[e]; if (e == e2) s2 = sc[e]; }
    const float inv = 1.f / (s1 + s2);
    if (lane == 0) { eidx[2 * row] = e1; eidx[2 * row + 1] = e2; ewgt[2 * row] = s1 * inv; ewgt[2 * row + 1] = s2 * inv; }
}
__global__ __launch_bounds__(256) void k_ln_moe(const bf16_t* X, const bf16_t* DS, const int* pos, const float* ewgt, const float* g, const float* b, bf16_t* outb, float* outf) {
    const int lane = threadIdx.x & 63, row = blockIdx.x * 4 + (threadIdx.x >> 6);
    Row16 x, y1, y2; load_row_bf16(X + (size_t)row * D, lane, x);
    const int r1 = pos[2 * row], r2 = pos[2 * row + 1]; const float w1 = ewgt[2 * row], w2 = ewgt[2 * row + 1];
    load_row_bf16(DS + (size_t)r1 * D, lane, y1); load_row_bf16(DS + (size_t)r2 * D, lane, y2);
#pragma unroll
    for (int j = 0; j < 4; ++j)
#pragma unroll
        for (int i = 0; i < 4; ++i) x.v[j][i] = ALPHA * x.v[j][i] + (w1 * y1.v[j][i] + w2 * y2.v[j][i]);
    ln_row(x, g, b, lane);
    if (outb) store_row_bf16(outb + (size_t)row * D, lane, x);
    if (outf) {
#pragma unroll
        for (int j = 0; j < 4; ++j) *(float4*)(outf + (size_t)row * D + 256 * j + 4 * lane) = make_float4(x.v[j][0], x.v[j][1], x.v[j][2], x.v[j][3]);
    }
}

__global__ __launch_bounds__(256) void k_xattn(const bf16_t* Q, const bf16_t* Kb, const bf16_t* Vt, bf16_t* O) {
    const int lane = threadIdx.x & 63;
    const int w = blockIdx.x * 4 + (threadIdx.x >> 6);
    const int t = w >> 2, h = w & 3, b = t / S;
    float q[4];
    { const ushort4 u = *(const ushort4*)(Q + (size_t)t * D + h * 256 + 4 * lane); q[0] = bf2f(u.x); q[1] = bf2f(u.y); q[2] = bf2f(u.z); q[3] = bf2f(u.w); }
    float sc[4];
#pragma unroll
    for (int jj = 0; jj < 4; ++jj) {
        sc[jj] = 0.f;
        for (int jl = 0; jl < 64; ++jl) {
            const int key = jj * 64 + jl;
            const ushort4 u = *(const ushort4*)(Kb + (size_t)(b * MEM + key) * 2048 + h * 256 + 4 * lane);
            float p = q[0] * bf2f(u.x) + q[1] * bf2f(u.y) + q[2] * bf2f(u.z) + q[3] * bf2f(u.w);
            p = wave_sum(p);
            if (lane == jl) sc[jj] = p;
        }
    }
    float m = fmaxf(fmaxf(sc[0], sc[1]), fmaxf(sc[2], sc[3])); m = wave_max(m);
    float l = 0.f;
#pragma unroll
    for (int jj = 0; jj < 4; ++jj) { sc[jj] = exp2f(sc[jj] - m); l += sc[jj]; }
    l = wave_sum(l);
    const float inv = 1.f / l;
    float o[4] = {0.f, 0.f, 0.f, 0.f};
    (void)Vt;
#pragma unroll
    for (int jj = 0; jj < 4; ++jj)
        for (int jl = 0; jl < 64; ++jl) {
            const float p = __shfl(sc[jj], jl);
            const int key = jj * 64 + jl;
            const ushort4 u = *(const ushort4*)(Kb + (size_t)(b * MEM + key) * 2048 + 1024 + h * 256 + 4 * lane);
            o[0] += p * bf2f(u.x); o[1] += p * bf2f(u.y); o[2] += p * bf2f(u.z); o[3] += p * bf2f(u.w);
        }
    ushort4 u; u.x = f2bf(o[0] * inv); u.y = f2bf(o[1] * inv); u.z = f2bf(o[2] * inv); u.w = f2bf(o[3] * inv);
    *(ushort4*)(O + (size_t)t * D + h * 256 + 4 * lane) = u;
}

__global__ __launch_bounds__(256) void k_moe_hist(const int* eidx, int* bcnt) {
    __shared__ int h[16];
    if (threadIdx.x < 16) h[threadIdx.x] = 0;
    __syncthreads();
    const int e = eidx[blockIdx.x * 256 + threadIdx.x];
    atomicAdd(&h[e], 1);
    __syncthreads();
    if (threadIdx.x < 16) bcnt[blockIdx.x * 16 + threadIdx.x] = h[threadIdx.x];
}
__global__ __launch_bounds__(256) void k_moe_scatter(const int* eidx, const int* bcnt, int* tok, int* pos, int* tile_e) {
    __shared__ int es[256], dst[256], off[17], base[16], tot[16];
    const int tid = threadIdx.x, blk = blockIdx.x;
    if (tid < 16) {
        int t = 0, bs = 0;
        for (int b2 = 0; b2 < 256; ++b2) { const int c = bcnt[b2 * 16 + tid]; t += c; if (b2 < blk) bs += c; }
        tot[tid] = t; base[tid] = bs;
    }
    es[tid] = eidx[blk * 256 + tid];
    __syncthreads();
    if (tid == 0) { int o = 0; for (int e = 0; e < 16; ++e) { off[e] = o; o += (tot[e] + 255) & ~255; } off[16] = o; }
    __syncthreads();
    {
        const int e = es[tid]; int rank = 0;
        for (int j = 0; j < tid; ++j) rank += (es[j] == e) ? 1 : 0;
        const int r = off[e] + base[e] + rank;
        dst[tid] = r; pos[blk * 256 + tid] = r; tok[r] = blk * 128 + (tid >> 1);
    }
    if (blk < 16) {
        const int e = blk, r0 = off[e] + tot[e], r1 = off[e + 1];
        for (int r = r0 + tid; r < r1; r += 256) tok[r] = 0;
    }
    if (blk == 16) {
        for (int tl = tid; tl < NTILE; tl += 256) { int e = -1; for (int k = 0; k < 16; ++k) if (tl * 256 >= off[k] && tl * 256 < off[k + 1]) e = k; tile_e[tl] = e; }
        if (tid == 0) tile_e[NTILE] = off[16] >> 8;
    }
}

__global__ void k_pool(const bf16_t* HP, bf16_t* PO) {
    const size_t i = (size_t)blockIdx.x * blockDim.x + threadIdx.x;
    if (i >= (size_t)T * D) return;
    const int t = (int)(i >> 10), c = (int)(i & 1023), g = c >> 8, win = 2 << g, ts = t & (S - 1);
    const int n = ts + 1 < win ? ts + 1 : win;
    float s = 0.f;
    for (int k = 0; k < n; ++k) s += bf2f(HP[(size_t)(t - k) * D + c]);
    PO[i] = f2bf(s / (float)n - bf2f(HP[i]));
}
}

using namespace nv;
template <class Epi>
static void ngemm(hipStream_t st, const bf16_t* A, int lda, const float* W, int ldw, int M, int N, int K, Epi epi, const int* tile_e = nullptr, size_t w_stride = 0, const int* arow = nullptr) {
    hipLaunchKernelGGL((k_gemm<Epi>), dim3(N / 64, M / 64), dim3(256), 0, st, A, lda, W, ldw, K, epi, tile_e, w_stride, arow);
}

#ifndef MEGA_MASK
#define MEGA_MASK 0x3f7ffbbu
#endif

extern "C" void kernel_launch(void* const* d_in, const int* in_sizes, int n_in, void* d_out, int out_size, void* d_ws, size_t ws_size, hipStream_t stream) {
    (void)in_sizes; (void)out_size;
    if (ws_size < WS_END || n_in != 40) return;
    static int grid = 0;
    if (grid == 0) {
        int dev = 0, cus = 0;
        if (hipGetDevice(&dev) != hipSuccess || hipDeviceGetAttribute(&cus, hipDeviceAttributeMultiprocessorCount, dev) != hipSuccess) { grid = -1; return; }
        if (hipFuncSetAttribute((const void*)mk::mega, hipFuncAttributeMaxDynamicSharedMemorySize, mk::LDS_BYTES) != hipSuccess) { grid = -1; return; }
        int per_cu = 0;
        if (hipOccupancyMaxActiveBlocksPerMultiprocessor(&per_cu, (const void*)mk::mega, mk::NTHREADS, mk::LDS_BYTES) != hipSuccess || per_cu < 1) { (void)hipGetLastError(); }
        grid = cus;
    }
    if (grid < 0) return;
    unsigned char* ws = (unsigned char*)d_ws;
    (void)hipMemsetAsync(ws + WS_CTL, 0, 512 * 1024, stream);
    mk::Args a{};
    for (int i = 0; i < 40; ++i) a.in[i] = d_in[i];
    a.out = (float*)d_out; a.ws = ws;
    for (int j = 0; j < 8; ++j) a.inv.f[j] = (float)pow(500000.0, -(double)((float)j * 2.0f / 16.0f));
    auto F = [&](int i) { return (const float*)d_in[i]; };
    const float* router_w = F(3); const float* router_b = F(4);
    float* rope = (float*)(ws + WS_ROPE); int* eidx = (int*)(ws + WS_EIDX); float* ewgt = (float*)(ws + WS_EWGT); int* pos = (int*)(ws + WS_POS);
    int* bcnt = (int*)(ws + WS_BCNT); int* tile_e = (int*)(ws + WS_TILE); int* tok = (int*)(ws + WS_TOK);
    bf16_t* RA = (bf16_t*)(ws + WS_A); bf16_t* RB = (bf16_t*)(ws + WS_B); bf16_t* RC = (bf16_t*)(ws + WS_C); bf16_t* RD = (bf16_t*)(ws + WS_D);
    bf16_t* MEMB = (bf16_t*)(ws + WS_MEMB);
    const unsigned mask = MEGA_MASK;
    int p = 0;
    while (p < mk::NPHASE) {
        if (mask & (1u << p)) {
            int q = p; while (q < mk::NPHASE && (mask & (1u << q))) ++q;
            a.ph_lo = p; a.ph_hi = q;
            hipLaunchKernelGGL(mk::mega, dim3(grid), dim3(mk::NTHREADS), mk::LDS_BYTES, stream, a);
            p = q; continue;
        }
        const int L = p / 13, lp = p % 13, cb = L == 0 ? 12 : 28;
        bf16_t* Kb = (bf16_t*)(ws + WS_MEMKV) + (size_t)L * B * MEM * 2048; bf16_t* Vt = (bf16_t*)(ws + WS_MEMVT) + (size_t)L * B * MEM * 1024;
        bf16_t *X1 = RB, *Qb, *Ob, *Y2, *X2, *HS = RB, *DS = RD, *X3; float* G = (float*)RD;
        if (L == 0) { Qb = RA; Ob = RC; Y2 = RA; X2 = RC; X3 = RA; } else { Qb = RC; Ob = RD; Y2 = RC; X2 = RA; X3 = nullptr; }
        if (L == 0 && lp == 0) {
            hipLaunchKernelGGL(k_cvt_x, dim3(2048), dim3(256), 0, stream, F(0), RA, (size_t)T * D / 4);
            hipLaunchKernelGGL(k_cvt_x, dim3(256), dim3(256), 0, stream, F(1), MEMB, (size_t)B * MEM * D / 4);
            nv::InvFreq inv; for (int j = 0; j < 8; ++j) inv.f[j] = a.inv.f[j];
            hipLaunchKernelGGL(k_rope_table, dim3(T / 256), dim3(256), 0, stream, (const int*)d_in[2], rope, inv);
        } else if (L == 0 && lp == 1) {
            for (int l = 0; l < 2; ++l) ngemm(stream, MEMB, D, F((l == 0 ? 12 : 28) + 3), 2048, B * MEM, 2048, D, nv::EpiKV{(bf16_t*)(ws + WS_MEMKV) + (size_t)l * B * MEM * 2048, (bf16_t*)(ws + WS_MEMVT) + (size_t)l * B * MEM * 1024});
            ngemm(stream, RA, D, F(5), NIN0, T, NIN0, D, nv::EpiInproj0{RD});
            hipLaunchKernelGGL(k_rope_apply, dim3(T * 80 / 256), dim3(256), 0, stream, RD, rope);
        } else if (L == 0 && lp == 2) {
            hipLaunchKernelGGL(k_swa, dim3(B * 64 * 8), dim3(128), 0, stream, RD, F(6), RB);
            hipLaunchKernelGGL(k_sgu_ln, dim3(T * 8 / 256), dim3(256), 0, stream, RD, F(7), F(8), RC);
            hipLaunchKernelGGL(k_sgu_mix, dim3(T * 512 / 256), dim3(256), 0, stream, RD, RC, F(9), F(10), RB);
        } else if (L == 0 && lp == 3) { ngemm(stream, RB, D, F(11), D, T, D, D, nv::EpiBf16{RC, D, 1.f});
        } else if (L == 0 && lp == 4) { hipLaunchKernelGGL(k_ln_add, dim3(T / 4), dim3(256), 0, stream, RA, RC, F(12), F(13), RB);
        } else if (L == 1 && lp == 0) { ngemm(stream, RA, D, F(24), D, T, D, D, nv::EpiBf16{RB, D, 1.f});
        } else if (L == 1 && lp == 1) { hipLaunchKernelGGL(k_pool, dim3(T * D / 256), dim3(256), 0, stream, RB, RC);
        } else if (L == 1 && lp == 2) { for (int g = 0; g < 4; ++g) ngemm(stream, RC + g * 256, D, F(25) + (size_t)g * 256 * 256, 256, T, 256, 256, nv::EpiPoolMap{RD, F(26), g * 256});
        } else if (L == 1 && lp == 3) { ngemm(stream, RD, D, F(27), D, T, D, D, nv::EpiBf16{RC, D, 1.f});
        } else if (L == 1 && lp == 4) { hipLaunchKernelGGL(k_ln_add, dim3(T / 4), dim3(256), 0, stream, RA, RC, F(28), F(29), RB);
        } else if (lp == 5) { ngemm(stream, X1, D, F(cb + 2), D, T, D, D, nv::EpiBf16{Qb, D, QSCALE});
        } else if (lp == 6) { hipLaunchKernelGGL(k_xattn, dim3(T * XH / 4), dim3(256), 0, stream, Qb, Kb, Vt, Ob);
        } else if (lp == 7) { ngemm(stream, Ob, D, F(cb + 4), D, T, D, D, nv::EpiBf16{Y2, D, 1.f});
        } else if (lp == 8) {
            hipLaunchKernelGGL(k_ln_router, dim3(T / 4), dim3(256), 0, stream, X1, Y2, F(cb + 5), F(cb + 6), X2, router_w, router_b, eidx, ewgt);
            hipLaunchKernelGGL(k_moe_hist, dim3(256), dim3(256), 0, stream, eidx, bcnt);
        } else if (lp == 9) { hipLaunchKernelGGL(k_moe_scatter, dim3(256), dim3(256), 0, stream, eidx, bcnt, tok, pos, tile_e);
        } else if (lp == 10) {
            ngemm(stream, X2, D, F(cb + 7), DE, MPAD, DE, D, nv::EpiF32{G, DE}, tile_e, (size_t)D * DE, tok);
            ngemm(stream, X2, D, F(cb + 8), DE, MPAD, DE, D, nv::EpiSiluMul{G, HS}, tile_e, (size_t)D * DE, tok);
        } else if (lp == 11) { ngemm(stream, HS, DE, F(cb + 9), D, MPAD, D, DE, nv::EpiBf16{DS, D, 1.f}, tile_e, (size_t)DE * D);
        } else if (lp == 12) { hipLaunchKernelGGL(k_ln_moe, dim3(T / 4), dim3(256), 0, stream, X2, DS, pos, ewgt, F(cb + 10), F(cb + 11), X3, L == 1 ? (float*)d_out : nullptr);
        }
        ++p;
    }
}
```

```cpp
#include <hip/hip_runtime.h>
#include <stdint.h>
#include <math.h>

typedef unsigned short bf16_t;

namespace nv {
constexpr int B = 4, S = 8192, T = B * S, D = 1024;
constexpr int NIN0 = 1792;
constexpr int MEM = 256, XH = 4, XHD = 256;
constexpr int NE = 16, DE = 512;
constexpr int MPAD = 65536 + 16 * 256;
constexpr int NTILE = MPAD / 256;
constexpr float ALPHA = 1.4142135623730951f;
constexpr float LN_EPS = 1e-5f;
constexpr float QSCALE = 0.0625f * 1.4426950408889634f;
constexpr float ASCALE = 0.125f * 1.4426950408889634f;

constexpr size_t MiB = 1u << 20;
constexpr size_t WS_CTL = 0;
constexpr size_t WS_ROPE = 2 * MiB;
constexpr size_t WS_EIDX = 4 * MiB;
constexpr size_t WS_EWGT = 5 * MiB;
constexpr size_t WS_POS = 6 * MiB;
constexpr size_t WS_BCNT = 7 * MiB;
constexpr size_t WS_TILE = 7 * MiB + 65536;
constexpr size_t WS_TOK = 7 * MiB + 131072;
constexpr size_t WS_MEMKV = 8 * MiB;
constexpr size_t WS_MEMVT = 16 * MiB;
constexpr size_t WS_MEMB = 20 * MiB;
constexpr size_t WS_WB = 24 * MiB;
constexpr size_t WS_A = 152 * MiB, WS_B = 220 * MiB, WS_C = 288 * MiB, WS_D = 356 * MiB, WS_END = 492 * MiB;
constexpr size_t WB_IN0 = 0;
constexpr size_t WB_OUT0 = WB_IN0 + (size_t)1792 * 1024;
constexpr size_t WB_IN1 = WB_OUT0 + (size_t)1024 * 1024;
constexpr size_t WB_POOL = WB_IN1 + (size_t)1024 * 1024;
constexpr size_t WB_OUT1 = WB_POOL + (size_t)1024 * 256;
constexpr size_t WB_SGUW = WB_OUT1 + (size_t)1024 * 1024;
constexpr size_t WB_LAYER = WB_SGUW + (size_t)8 * 128 * 128;
constexpr size_t WL_XQ = 0;
constexpr size_t WL_XKV = WL_XQ + (size_t)1024 * 1024;
constexpr size_t WL_XO = WL_XKV + (size_t)2048 * 1024;
constexpr size_t WL_GU = WL_XO + (size_t)1024 * 1024;
constexpr size_t WL_DN = WL_GU + (size_t)16 * 1024 * 1024;
constexpr size_t WL_SIZE = WL_DN + (size_t)16 * 1024 * 512;
static_assert((WB_LAYER + 2 * WL_SIZE) * 2 <= 128 * MiB, "bf16 weight region");

__device__ __forceinline__ float bf2f(bf16_t v) { return __uint_as_float((unsigned)v << 16); }
__device__ __forceinline__ bf16_t f2bf(float f) { unsigned u = __float_as_uint(f); return (bf16_t)((u + 0x7fffu + ((u >> 16) & 1u)) >> 16); }
__device__ __forceinline__ float gelu_tanh(float x) { const float u = 0.7978845608028654f * (x + 0.044715f * x * x * x); const float e = __expf(2.f * u); const float th = 1.f - 2.f / (e + 1.f); return 0.5f * x * (1.f + th); }
__device__ __forceinline__ float silu(float x) { return x / (1.f + __expf(-x)); }
template <int M> __device__ __forceinline__ float swz_xor(float v) { return __int_as_float(__builtin_amdgcn_ds_swizzle(__float_as_int(v), (M << 10) | 0x1f)); }
__device__ __forceinline__ float wave_sum(float v) {
    v += swz_xor<1>(v); v += swz_xor<2>(v); v += swz_xor<4>(v); v += swz_xor<8>(v); v += swz_xor<16>(v);
    const auto r = __builtin_amdgcn_permlane32_swap(__float_as_uint(v), __float_as_uint(v), false, false);
    return __uint_as_float(r[0]) + __uint_as_float(r[1]);
}
__device__ __forceinline__ float wave_max(float v) {
    v = fmaxf(v, swz_xor<1>(v)); v = fmaxf(v, swz_xor<2>(v)); v = fmaxf(v, swz_xor<4>(v)); v = fmaxf(v, swz_xor<8>(v)); v = fmaxf(v, swz_xor<16>(v));
    const auto r = __builtin_amdgcn_permlane32_swap(__float_as_uint(v), __float_as_uint(v), false, false);
    return fmaxf(__uint_as_float(r[0]), __uint_as_float(r[1]));
}
}

namespace pg8 {
#define PG8_LAS __attribute__((address_space(3)))
typedef short bf16x8 __attribute__((ext_vector_type(8)));
typedef float f32x4 __attribute__((ext_vector_type(4)));
typedef float f32x2 __attribute__((ext_vector_type(2)));
typedef unsigned u32x4 __attribute__((ext_vector_type(4)));
typedef unsigned u32x2 __attribute__((ext_vector_type(2)));
constexpr int BM = 256, BK = 64, HALF = 128, HTB = HALF * BK * 2  , STAGE_BYTES = 8 * HTB, NXCD = 8, WGM = 8;

__host__ __device__ __forceinline__ int lds_byte(int r, int c) { const int st = (r >> 4) * 2 + (c >> 5), rr = r & 15, cc = c & 31, ob = rr * 64 + cc * 2; return st * 1024 + (ob ^ (((ob >> 9) & 1) << 5)); }
__host__ __device__ __forceinline__ void stage_rc(int b, int& R, int& C) { const int st = b / 1024, sb = b % 1024, swz = sb ^ (((sb >> 9) & 1) << 5); R = (st >> 1) * 16 + swz / 64; C = (st & 1) * 32 + (swz % 64) / 2; }
__host__ __device__ __forceinline__ int perm32(int rho) { const int n = rho >> 4, i = rho & 15; return 8 * (i >> 2) + 4 * n + (i & 3); }

struct Unit { int pm, pn, pb; };
struct Gemm { const bf16_t* A; const bf16_t* Bt; const int* arow; };

struct StaticOrder {
    int nM, nN, nwg, G, c;
    __device__ void init(int M, int N, int G_, int c_) { nM = M / BM; nN = N / BM; nwg = nM * nN; G = G_; c = c_; }
    __device__ bool next(int i, Unit& u) const {
        const long L = (long)i * G + c; if (L >= nwg) return false;
        int wgid = (int)L; { const int q = nwg / NXCD, r = nwg % NXCD, xcd = wgid % NXCD, off = wgid / NXCD; wgid = (xcd < r ? xcd * (q + 1) : r * (q + 1) + (xcd - r) * q) + off; }
        const int nig = WGM * nN, gid = wgid / nig, fm = gid * WGM, gsz = (nM - fm) < WGM ? (nM - fm) : WGM;
        u.pm = fm + ((wgid % nig) % gsz); u.pn = (wgid % nig) / gsz; u.pb = u.pn; return true;
    }
};
struct MoeOrder {
    int nM, nwg, G, c; const int* tile_e;
    __device__ void init(int ntiles, const int* te, int G_, int c_) { nM = ntiles; nwg = nM * 4; G = G_; c = c_; tile_e = te; }
    __device__ bool next(int i, Unit& u) const {
        const long L = (long)i * G + c; if (L >= nwg) return false;
        int wgid = (int)L; { const int q = nwg / NXCD, r = nwg % NXCD, xcd = wgid % NXCD, off = wgid / NXCD; wgid = (xcd < r ? xcd * (q + 1) : r * (q + 1) + (xcd - r) * q) + off; }
        const int nig = WGM * 4, gid = wgid / nig, fm = gid * WGM, gsz = (nM - fm) < WGM ? (nM - fm) : WGM;
        u.pm = fm + ((wgid % nig) % gsz); u.pn = (wgid % nig) / gsz;
        const int e = __builtin_amdgcn_readfirstlane(tile_e[u.pm]); u.pb = e * 4 + u.pn; return true;
    }
};

__device__ __forceinline__ unsigned cvt_pk_bf16(float lo, float hi) { unsigned r; asm volatile("v_cvt_pk_bf16_f32 %0, %1, %2" : "=v"(r) : "v"(lo), "v"(hi)); return r; }


template <class Epi, class Sched, bool ALIGN_EPI, bool SP2, bool GATHER, int LDA, int LDB, int KK, int APN>
__device__ __forceinline__ void gemm_phase(PG8_LAS unsigned char* lds, int tid_in, const Gemm g, const Sched& S, const Epi& E) {
    int tid_ = tid_in; asm volatile("" : "+v"(tid_));
    const int tid = tid_, wid = __builtin_amdgcn_readfirstlane(tid >> 6), lane = tid & 63, wr = wid >> 2, wc = wid & 3, fr = lane & 15, fq = lane >> 4;
    constexpr int K = KK, nt = K / BK, lda = LDA, ldb = LDB; (void)K;
    unsigned voffA[2], voffB[2]; int rowA[2];
#pragma unroll
    for (int i = 0; i < 2; ++i) { int R, C; stage_rc(tid * 16 + i * 8192, R, C); const int Rb = Epi::PERM ? ((R & ~31) + perm32(R & 31)) : R;
        voffA[i] = GATHER ? (unsigned)C * 2u : (unsigned)(R * lda + C) * 2u; voffB[i] = (unsigned)(Rb * ldb + C) * 2u; rowA[i] = R; }
    const size_t kstep = (size_t)(BK * 2);
    const size_t hstepA = GATHER ? 0 : (size_t)HALF * lda * 2, hstepB = (size_t)HALF * ldb * 2;
    const size_t tstepA = (size_t)BM * lda * 2, tstepB = 2 * hstepB;
    const unsigned ldsw = (unsigned)wid * 1024u;
    const int aoff = lds_byte(wr * 64 + fr, fq * 8), boff = lds_byte(wc * 32 + fr, fq * 8);
    unsigned cg[2][2], ng[2][2], og[2][2];
#define PG8_SA(b, h) (((b) * 2 + (h)) * HTB)
#define PG8_SB(b, h) ((4 + (b) * 2 + (h)) * HTB)
#define PG8_STAGE(bufoff, gbase, voff) do { _Pragma("unroll") for (int _i = 0; _i < 2; ++_i) \
        __builtin_amdgcn_global_load_lds((const unsigned*)((const char*)(gbase) + (voff)[_i]), (PG8_LAS unsigned*)(lds + (bufoff) + ldsw + _i * 8192), 16, 0, 0); } while (0)
#define PG8_STAGE_A(bufoff, abase, h, GO) do { _Pragma("unroll") for (int _i = 0; _i < 2; ++_i) { \
        const char* _s = (const char*)(abase) + ((h) ? hstepA : (size_t)0) + voffA[_i]; if constexpr (GATHER) _s += GO[h][_i]; \
        __builtin_amdgcn_global_load_lds((const unsigned*)_s, (PG8_LAS unsigned*)(lds + (bufoff) + ldsw + _i * 8192), 16, 0, 0); } } while (0)
#define PG8_GLOAD(dst, pm_) do { _Pragma("unroll") for (int _h = 0; _h < 2; ++_h) _Pragma("unroll") for (int _i = 0; _i < 2; ++_i) \
        dst[_h][_i] = (unsigned)g.arow[(pm_) * BM + _h * HALF + rowA[_i]] * (unsigned)(lda * 2); } while (0)
#define PG8_LDA(dst, b, h) do { _Pragma("unroll") for (int m = 0; m < 4; ++m) _Pragma("unroll") for (int k = 0; k < 2; ++k) dst[m][k] = *(const PG8_LAS bf16x8*)(lds + PG8_SA(b, h) + aoff + m * 2048 + k * 1024); } while (0)
#define PG8_LDB(dst, b, h) do { _Pragma("unroll") for (int n = 0; n < 2; ++n) _Pragma("unroll") for (int k = 0; k < 2; ++k) dst[n][k] = *(const PG8_LAS bf16x8*)(lds + PG8_SB(b, h) + boff + n * 2048 + k * 1024); } while (0)
#define PG8_MMA(ai, bj, At, Bt) do { __builtin_amdgcn_s_setprio(1); _Pragma("unroll") for (int m = 0; m < 4; ++m) _Pragma("unroll") for (int n = 0; n < 2; ++n) _Pragma("unroll") for (int k = 0; k < 2; ++k) \
        acc[ai][bj][m][n] = __builtin_amdgcn_mfma_f32_16x16x32_bf16(Bt[n][k], At[m][k], acc[ai][bj][m][n], 0, 0, 0); __builtin_amdgcn_s_setprio(0); } while (0)
#define PG8_WAIT_V(n) asm volatile("s_waitcnt vmcnt(" #n ")" ::: "memory")
#define PG8_WAIT_L(n) asm volatile("s_waitcnt lgkmcnt(" #n ")" ::: "memory")
#define PG8_BAR __builtin_amdgcn_s_barrier()
#define PG8_SCHED __builtin_amdgcn_sched_barrier(0)
    Unit cur, nxt; int ui = 0;
    if (!S.next(0, cur)) return;
    f32x4 acc[2][2][4][2];
#pragma unroll
    for (int a = 0; a < 2; ++a)
#pragma unroll
        for (int b = 0; b < 2; ++b)
#pragma unroll
            for (int m = 0; m < 4; ++m)
#pragma unroll
                for (int n = 0; n < 2; ++n) acc[a][b][m][n] = (f32x4){0.f, 0.f, 0.f, 0.f};
    bf16x8 At[4][2], B0[2][2], B1[2][2];
    const char* cA = GATHER ? (const char*)g.A : (const char*)g.A + (size_t)cur.pm * tstepA + (size_t)cur.pn * APN * 2; const char* cB = (const char*)g.Bt + (size_t)cur.pb * tstepB;
    if constexpr (GATHER) { PG8_GLOAD(cg, cur.pm); }
    if constexpr (SP2) {
        PG8_STAGE(PG8_SB(0, 0), cB, voffB); PG8_STAGE(PG8_SB(0, 1), cB + hstepB, voffB); PG8_STAGE_A(PG8_SA(0, 0), cA, 0, cg); PG8_STAGE_A(PG8_SA(0, 1), cA, 1, cg);
        if (wr == 1) PG8_BAR;
        PG8_WAIT_V(2); PG8_BAR;
        PG8_STAGE(PG8_SB(1, 0), cB + kstep, voffB); PG8_STAGE_A(PG8_SA(1, 0), cA + kstep, 0, cg); PG8_STAGE(PG8_SB(1, 1), cB + hstepB + kstep, voffB);
        PG8_WAIT_V(6); PG8_BAR;
    } else {
        PG8_STAGE(PG8_SB(0, 0), cB, voffB); PG8_STAGE_A(PG8_SA(0, 0), cA, 0, cg); PG8_STAGE(PG8_SB(0, 1), cB + hstepB, voffB); PG8_STAGE_A(PG8_SA(0, 1), cA, 1, cg);
        if (wr == 1) PG8_BAR;
        PG8_WAIT_V(4); PG8_BAR;
        PG8_STAGE(PG8_SB(1, 0), cB + kstep, voffB); PG8_STAGE_A(PG8_SA(1, 0), cA + kstep, 0, cg); PG8_STAGE(PG8_SB(1, 1), cB + hstepB + kstep, voffB);
        PG8_WAIT_V(6); PG8_BAR;
    }
    for (;;) {
        const bool has_next = S.next(ui + 1, nxt);
        const char* nA = GATHER ? (const char*)g.A : (has_next ? (const char*)g.A + (size_t)nxt.pm * tstepA + (size_t)nxt.pn * APN * 2 : cA);
        const char* nB = has_next ? (const char*)g.Bt + (size_t)nxt.pb * tstepB : cB;
        if constexpr (GATHER) { if (has_next) { PG8_GLOAD(ng, nxt.pm); } else {
#pragma unroll
            for (int _h = 0; _h < 2; ++_h)
#pragma unroll
                for (int _i = 0; _i < 2; ++_i) ng[_h][_i] = cg[_h][_i]; } }
#pragma unroll 1
        for (int t = 0; t < nt; t += 2) {
            const bool last = (t == nt - 2);
            const char* a1 = cA + (size_t)(t + 1) * kstep;
            const char* a2 = last ? nA : cA + (size_t)(t + 2) * kstep; const char* b2 = last ? nB : cB + (size_t)(t + 2) * kstep;
            const char* a3 = a2 + kstep; const char* b3 = b2 + kstep;
            if constexpr (GATHER) {
#pragma unroll
                for (int _h = 0; _h < 2; ++_h)
#pragma unroll
                    for (int _i = 0; _i < 2; ++_i) og[_h][_i] = last ? ng[_h][_i] : cg[_h][_i]; }
            if constexpr (SP2) {
            PG8_LDB(B0, 0, 0); PG8_LDB(B1, 0, 1); PG8_SCHED; PG8_LDA(At, 0, 0); PG8_STAGE_A(PG8_SA(1, 1), a1, 1, cg);
            PG8_WAIT_V(8); PG8_WAIT_L(0); PG8_BAR; PG8_MMA(0, 0, At, B0); PG8_MMA(0, 1, At, B1); PG8_BAR; PG8_SCHED;
            PG8_LDA(At, 0, 1); PG8_STAGE(PG8_SB(0, 0), b2, voffB); PG8_STAGE(PG8_SB(0, 1), b2 + hstepB, voffB); PG8_STAGE_A(PG8_SA(0, 0), a2, 0, og);
            PG8_WAIT_V(8); PG8_WAIT_L(0); PG8_BAR; PG8_MMA(1, 0, At, B0); PG8_MMA(1, 1, At, B1); PG8_BAR; PG8_SCHED;
            PG8_LDB(B0, 1, 0); PG8_LDB(B1, 1, 1); PG8_SCHED; PG8_LDA(At, 1, 0); PG8_STAGE_A(PG8_SA(0, 1), a2, 1, og);
            PG8_WAIT_V(8); PG8_WAIT_L(0); PG8_BAR; PG8_MMA(0, 0, At, B0); PG8_MMA(0, 1, At, B1); PG8_BAR; PG8_SCHED;
            PG8_LDA(At, 1, 1); PG8_STAGE(PG8_SB(1, 0), b3, voffB); PG8_STAGE(PG8_SB(1, 1), b3 + hstepB, voffB); PG8_STAGE_A(PG8_SA(1, 0), a3, 0, og);
            PG8_WAIT_V(8); PG8_WAIT_L(0); PG8_BAR; PG8_MMA(1, 0, At, B0); PG8_MMA(1, 1, At, B1); PG8_BAR; PG8_SCHED;
            } else {
            PG8_LDB(B0, 0, 0); PG8_SCHED; PG8_LDA(At, 0, 0); PG8_STAGE_A(PG8_SA(1, 1), a1, 1, cg);
            PG8_WAIT_L(8); PG8_BAR; PG8_WAIT_L(0); PG8_MMA(0, 0, At, B0); PG8_BAR; PG8_SCHED;
            PG8_LDB(B1, 0, 1); PG8_STAGE(PG8_SB(0, 0), b2, voffB);
            PG8_BAR; PG8_WAIT_L(0); PG8_MMA(0, 1, At, B1); PG8_BAR;
            PG8_LDA(At, 0, 1); PG8_STAGE_A(PG8_SA(0, 0), a2, 0, og);
            PG8_BAR; PG8_WAIT_L(0); PG8_MMA(1, 0, At, B0); PG8_BAR; PG8_SCHED;
            PG8_STAGE(PG8_SB(0, 1), b2 + hstepB, voffB);
            PG8_WAIT_V(6); PG8_BAR; PG8_MMA(1, 1, At, B1); PG8_BAR;
            PG8_LDB(B0, 1, 0); PG8_SCHED; PG8_LDA(At, 1, 0); PG8_STAGE_A(PG8_SA(0, 1), a2, 1, og);
            PG8_WAIT_L(8); PG8_BAR; PG8_WAIT_L(0); PG8_MMA(0, 0, At, B0); PG8_BAR; PG8_SCHED;
            PG8_LDB(B1, 1, 1); PG8_STAGE(PG8_SB(1, 0), b3, voffB);
            PG8_BAR; PG8_WAIT_L(0); PG8_MMA(0, 1, At, B1); PG8_BAR;
            PG8_LDA(At, 1, 1); PG8_STAGE_A(PG8_SA(1, 0), a3, 0, og);
            PG8_BAR; PG8_WAIT_L(0); PG8_MMA(1, 0, At, B0); PG8_BAR; PG8_SCHED;
            PG8_STAGE(PG8_SB(1, 1), b3 + hstepB, voffB);
            PG8_WAIT_V(6); PG8_BAR; PG8_MMA(1, 1, At, B1); PG8_BAR;
            }
        }
        if constexpr (ALIGN_EPI) { if (wr == 0) PG8_BAR; }
        E(acc, cur, wr, wc, fr, fq);
        if (!has_next) break;
#pragma unroll
        for (int a = 0; a < 2; ++a)
#pragma unroll
            for (int b = 0; b < 2; ++b)
#pragma unroll
                for (int m = 0; m < 4; ++m)
#pragma unroll
                    for (int n = 0; n < 2; ++n) acc[a][b][m][n] = (f32x4){0.f, 0.f, 0.f, 0.f};
        cur = nxt; cA = nA; cB = nB; ++ui;
        if constexpr (GATHER) {
#pragma unroll
            for (int _h = 0; _h < 2; ++_h)
#pragma unroll
                for (int _i = 0; _i < 2; ++_i) cg[_h][_i] = ng[_h][_i]; }
        if constexpr (ALIGN_EPI) { if (wr == 1) PG8_BAR; }
    }
    PG8_WAIT_V(0);
    if constexpr (!ALIGN_EPI) { if (wr == 0) PG8_BAR; }
    PG8_BAR;
#undef PG8_SA
#undef PG8_SB
#undef PG8_STAGE
#undef PG8_STAGE_A
#undef PG8_GLOAD
#undef PG8_LDA
#undef PG8_LDB
#undef PG8_MMA
#undef PG8_WAIT_V
#undef PG8_WAIT_L
#undef PG8_BAR
#undef PG8_SCHED
}
}
namespace pg8 {

__device__ __forceinline__ float fast_sigmoid_mul(float x, float z) { return x * __builtin_amdgcn_rcpf(1.f + __builtin_amdgcn_exp2f(-1.4426950408889634f * z)); }
__device__ __forceinline__ float gelu_t(float x) { const float u = 0.7978845608028654f * (x + 0.044715f * x * x * x); return fast_sigmoid_mul(x, 2.f * u); }
__device__ __forceinline__ float silu_f(float x) { return fast_sigmoid_mul(x, x); }
__device__ __forceinline__ u32x4 pack8(const f32x4 v0, const f32x4 v1) { u32x4 w; w.x = cvt_pk_bf16(v0[0], v0[1]); w.y = cvt_pk_bf16(v0[2], v0[3]); w.z = cvt_pk_bf16(v1[0], v1[1]); w.w = cvt_pk_bf16(v1[2], v1[3]); return w; }

struct EpiBf16 {
    static constexpr bool PERM = true;
    bf16_t* O; int ldo; float scale;
    __device__ __forceinline__ void operator()(const f32x4 (&acc)[2][2][4][2], const Unit& u, int wr, int wc, int fr, int fq) const {
        const int row0 = u.pm * BM + wr * 64 + fr, col0 = u.pn * BM + wc * 32 + 8 * fq;
#pragma unroll
        for (int ai = 0; ai < 2; ++ai)
#pragma unroll
            for (int m = 0; m < 4; ++m) { bf16_t* rowp = O + (size_t)(row0 + ai * HALF + m * 16) * ldo + col0;
#pragma unroll
                for (int bj = 0; bj < 2; ++bj) *(u32x4*)(rowp + bj * HALF) = pack8(acc[ai][bj][m][0] * scale, acc[ai][bj][m][1] * scale); }
    }
};
struct EpiPoolMap {
    static constexpr bool PERM = true;
    bf16_t* O; const float* cscale;
    __device__ __forceinline__ void operator()(const f32x4 (&acc)[2][2][4][2], const Unit& u, int wr, int wc, int fr, int fq) const {
        const int row0 = u.pm * BM + wr * 64 + fr, col0 = u.pn * BM + wc * 32 + 8 * fq;
        f32x4 sc[2][2];
#pragma unroll
        for (int bj = 0; bj < 2; ++bj)
#pragma unroll
            for (int n = 0; n < 2; ++n) sc[bj][n] = *(const f32x4*)(cscale + col0 + bj * HALF + 4 * n);
#pragma unroll
        for (int ai = 0; ai < 2; ++ai)
#pragma unroll
            for (int m = 0; m < 4; ++m) { bf16_t* rowp = O + (size_t)(row0 + ai * HALF + m * 16) * nv::D + col0;
#pragma unroll
                for (int bj = 0; bj < 2; ++bj) *(u32x4*)(rowp + bj * HALF) = pack8(acc[ai][bj][m][0] * sc[bj][0], acc[ai][bj][m][1] * sc[bj][1]); }
    }
};
struct EpiGU {
    static constexpr bool PERM = true;
    bf16_t* HS;
    __device__ __forceinline__ void operator()(const f32x4 (&acc)[2][2][4][2], const Unit& u, int wr, int wc, int fr, int fq) const {
        const int row0 = u.pm * BM + wr * 64 + fr, col0 = u.pn * HALF + wc * 32 + 8 * fq;
#pragma unroll
        for (int ai = 0; ai < 2; ++ai)
#pragma unroll
            for (int m = 0; m < 4; ++m) { bf16_t* rowp = HS + (size_t)(row0 + ai * HALF + m * 16) * nv::DE + col0;
                f32x4 h0, h1;
#pragma unroll
                for (int j = 0; j < 4; ++j) { h0[j] = silu_f(acc[ai][0][m][0][j]) * acc[ai][1][m][0][j]; h1[j] = silu_f(acc[ai][0][m][1][j]) * acc[ai][1][m][1][j]; }
                *(u32x4*)rowp = pack8(h0, h1); }
    }
};
struct EpiKV {
    static constexpr bool PERM = true;
    bf16_t* Kb; bf16_t* Vt;
    __device__ __forceinline__ void operator()(const f32x4 (&acc)[2][2][4][2], const Unit& u, int wr, int wc, int fr, int fq) const {
        const int row0 = u.pm * BM + wr * 64 + fr, col0 = u.pn * BM + wc * 32 + 8 * fq;
#pragma unroll
        for (int ai = 0; ai < 2; ++ai)
#pragma unroll
            for (int m = 0; m < 4; ++m) { bf16_t* rowp = Kb + (size_t)(row0 + ai * HALF + m * 16) * 2048 + col0;
#pragma unroll
                for (int bj = 0; bj < 2; ++bj) *(u32x4*)(rowp + bj * HALF) = pack8(acc[ai][bj][m][0], acc[ai][bj][m][1]); }
        if (u.pn >= 4) {
            const int h = u.pn - 4, b = u.pm;
            bf16_t* vb = Vt + (size_t)(b * nv::XH + h) * nv::XHD * nv::MEM;
#pragma unroll
            for (int ai = 0; ai < 2; ++ai)
#pragma unroll
                for (int m = 0; m < 4; ++m) { const int key = ai * HALF + wr * 64 + m * 16 + fr;
#pragma unroll
                    for (int bj = 0; bj < 2; ++bj)
#pragma unroll
                        for (int n = 0; n < 2; ++n)
#pragma unroll
                            for (int j = 0; j < 4; ++j) { const int dd = bj * HALF + wc * 32 + 8 * fq + 4 * n + j; vb[(size_t)dd * nv::MEM + key] = nv::f2bf(acc[ai][bj][m][n][j]); } }
        }
    }
};
struct EpiInproj0 {
    static constexpr bool PERM = true;
    bf16_t* O; const float* rope;
    __device__ __forceinline__ void operator()(const f32x4 (&acc)[2][2][4][2], const Unit& u, int wr, int wc, int fr, int fq) const {
        const int row0 = u.pm * BM + wr * 64 + fr, col0 = u.pn * BM + wc * 32 + 8 * fq;
        if (u.pn >= 3) {
#pragma unroll
            for (int ai = 0; ai < 2; ++ai)
#pragma unroll
                for (int m = 0; m < 4; ++m) { bf16_t* rowp = O + (size_t)(row0 + ai * HALF + m * 16) * nv::NIN0 + col0;
#pragma unroll
                    for (int bj = 0; bj < 2; ++bj) { f32x4 v0 = acc[ai][bj][m][0], v1 = acc[ai][bj][m][1];
#pragma unroll
                        for (int j = 0; j < 4; ++j) { v0[j] = gelu_t(v0[j]); v1[j] = gelu_t(v1[j]); }
                        *(u32x4*)(rowp + bj * HALF) = pack8(v0, v1); } }
        } else {
            const bool wave_rope = (wc & 1) == 0;
            const float sgn = fq == 0 ? -1.f : 1.f;
#pragma unroll
            for (int ai = 0; ai < 2; ++ai)
#pragma unroll
                for (int m = 0; m < 4; ++m) { const int row = row0 + ai * HALF + m * 16; bf16_t* rowp = O + (size_t)row * nv::NIN0 + col0;
                    f32x4 c0, c1, s0, s1;
                    if (wave_rope) { const float* rp = rope + (size_t)row * 16; c0 = *(const f32x4*)rp; c1 = *(const f32x4*)(rp + 4); s0 = *(const f32x4*)(rp + 8); s1 = *(const f32x4*)(rp + 12); }
#pragma unroll
                    for (int bj = 0; bj < 2; ++bj) { f32x4 v0 = acc[ai][bj][m][0], v1 = acc[ai][bj][m][1];
                        if (wave_rope && (u.pn < 2 || bj == 0)) {
                            f32x4 p0, p1;
#pragma unroll
                            for (int j = 0; j < 4; ++j) { p0[j] = nv::swz_xor<16>(v0[j]); p1[j] = nv::swz_xor<16>(v1[j]); }
                            if (fq < 2) {
#pragma unroll
                                for (int j = 0; j < 4; ++j) { v0[j] = v0[j] * c0[j] + sgn * p0[j] * s0[j]; v1[j] = v1[j] * c1[j] + sgn * p1[j] * s1[j]; } }
                        }
                        *(u32x4*)(rowp + bj * HALF) = pack8(v0, v1); } }
        }
    }
};
}

#define LAS __attribute__((address_space(3)))
#define GAS __attribute__((address_space(1)))
typedef GAS unsigned gu32;
#define RLX_AGENT __ATOMIC_RELAXED, __HIP_MEMORY_SCOPE_AGENT
#define LDS_WAIT() asm volatile("s_waitcnt lgkmcnt(0)" ::: "memory")
#define VM_WAIT() asm volatile("s_waitcnt vmcnt(0)" ::: "memory")

#define XB_TMO      128
#define XB_XCNT(j)  (256  + 64 * (j))
#define XB_XSUB(j)  (1280 + 64 * (j))
#define XB_XGEN(j)  (2304 + 64 * (j))
#define XB_TOP      3328
#define XB_TOPGEN   3392
#define XCD_BAR_WORDS 3456
#define XB_SPIN_CAP (1u << 18)
__device__ __forceinline__ unsigned xb_ld(unsigned* p)              { return __hip_atomic_load(p, __ATOMIC_RELAXED, __HIP_MEMORY_SCOPE_AGENT); }
__device__ __forceinline__ unsigned xb_add(unsigned* p, unsigned v) { return __hip_atomic_fetch_add(p, v, __ATOMIC_RELAXED, __HIP_MEMORY_SCOPE_AGENT); }
__device__ __forceinline__ unsigned xb_xcc_id() { return (unsigned)__builtin_amdgcn_s_getreg((3 << 11) | 20) & 0xFu; }
#define XB_SPIN(cond, bar) do { unsigned _sp = 0; while (cond) { __builtin_amdgcn_s_sleep(1); \
    if ((++_sp & 255u) == 0u) { if (xb_ld(&(bar)[XB_TMO])) break; if (_sp > XB_SPIN_CAP) { atomicAdd(&(bar)[XB_TMO], 1u); break; } } } } while (0)
struct XcdBarrier { unsigned* bar; unsigned x; volatile LAS unsigned* st; int wave; };
__device__ __forceinline__ unsigned lane_id_fresh() { unsigned m = ~0u; asm volatile("" : "+s"(m)); return __builtin_amdgcn_mbcnt_hi(m, __builtin_amdgcn_mbcnt_lo(m, 0u)); }
__device__ __forceinline__ bool xb_thread0(int wave) { return wave == 0 && lane_id_fresh() == 0u; }
__device__ __forceinline__ XcdBarrier xcd_barrier_post(unsigned* bar, volatile LAS unsigned* st, int wave) {
    XcdBarrier b; b.bar = bar; b.x = xb_xcc_id(); b.st = st; b.wave = wave;
    if (xb_thread0(wave)) (void)xb_add(&bar[XB_XCNT(b.x)], 1u);
    return b;
}
__device__ __forceinline__ void xcd_barrier_complete(unsigned* bar, unsigned x, unsigned& nloc, unsigned& nx) {
    const unsigned G = gridDim.x * gridDim.y * gridDim.z;
    unsigned sum, cnt, mine, sp = 0u;
    for (;;) {
        sum = 0u; cnt = 0u; mine = 0u;
#pragma unroll
        for (unsigned j = 0; j < 16; ++j) { const unsigned c = xb_ld(&bar[XB_XCNT(j)]); sum += c; cnt += (c > 0u) ? 1u : 0u; mine = (j == x) ? c : mine; }
        if (sum == G) break;
        __builtin_amdgcn_s_sleep(1);
        if ((++sp & 255u) == 0u) { if (xb_ld(&bar[XB_TMO])) break; if (sp > XB_SPIN_CAP) { atomicAdd(&bar[XB_TMO], 1u); break; } }
    }
    nloc = mine > 0u ? mine : 1u; nx = cnt > 0u ? cnt : 1u;
}
__device__ __forceinline__ void xcd_barrier(const XcdBarrier& b) {
    asm volatile("s_waitcnt vmcnt(0)" ::: "memory");
    __syncthreads();
    if (xb_thread0(b.wave)) {
        unsigned* bar = b.bar;
        __builtin_amdgcn_s_waitcnt(0);
        unsigned nloc = b.st[0], nx = b.st[1];
        if (nloc == 0u) { xcd_barrier_complete(bar, b.x, nloc, nx); b.st[0] = nloc; b.st[1] = nx; }
        const unsigned old = xb_add(&bar[XB_XSUB(b.x)], 1u);
        const unsigned gen = old / nloc;
        if (old + 1u == (gen + 1u) * nloc) {
            __builtin_amdgcn_fence(__ATOMIC_RELEASE, "agent");
            asm volatile("s_waitcnt vmcnt(0)" ::: "memory");
            const unsigned og = xb_add(&bar[XB_TOP], 1u);
            const unsigned tg = og / nx;
            if (og + 1u == (tg + 1u) * nx) xb_add(&bar[XB_TOPGEN], 1u);
            else XB_SPIN(xb_ld(&bar[XB_TOPGEN]) == tg, bar);
            __builtin_amdgcn_fence(__ATOMIC_ACQUIRE, "agent");
            xb_add(&bar[XB_XGEN(b.x)], 1u);
            asm volatile("s_waitcnt vmcnt(0)" ::: "memory");
        } else {
            XB_SPIN(xb_ld(&bar[XB_XGEN(b.x)]) == gen, bar);
            __builtin_amdgcn_fence(__ATOMIC_ACQUIRE, "agent");
            asm volatile("s_waitcnt vmcnt(0)" ::: "memory");
        }
    }
    __syncthreads();
}

namespace mk {
using namespace nv;
typedef unsigned v4u __attribute__((ext_vector_type(4)));
typedef unsigned v2u __attribute__((ext_vector_type(2)));
typedef float f32x4 __attribute__((ext_vector_type(4)));
constexpr int NWAVES = 8, NTHREADS = 512;
constexpr int LDS_BYTES = 160 * 1024;
constexpr int MISC_OFF = LDS_BYTES - 256;
constexpr int CW_BAR = 4096;
constexpr size_t CTL_ZERO_BYTES = 64 * 1024;

__device__ __forceinline__ unsigned pk2(float lo, float hi) { return (unsigned)f2bf(lo) | ((unsigned)f2bf(hi) << 16); }

struct Frame {
    LAS unsigned char* lds; int tid, lane, wave, vcu, G, bx;
};

__device__ __forceinline__ void transpose_item(const float* W, int ldw, bf16_t* WT, int ldt, int k0, int n0, int dest_row0, LAS float* scr, int lane, const float* nscale = nullptr) {
    const float sc = nscale ? nscale[n0 + (lane & 31)] : 1.f;
#pragma unroll 8
    for (int i = 0; i < 32; ++i) { const int kk = 2 * i + (lane >> 5); scr[kk * 33 + (lane & 31)] = W[(size_t)(k0 + kk) * ldw + n0 + (lane & 31)] * sc; }
    LDS_WAIT(); asm volatile("" ::: "memory");
    const int c = lane & 7;
#pragma unroll
    for (int j = 0; j < 4; ++j) { const int n = (lane >> 3) + 8 * j; const LAS float* s = scr + (8 * c) * 33 + n;
        v4u o; o.x = pk2(s[0 * 33], s[1 * 33]); o.y = pk2(s[2 * 33], s[3 * 33]); o.z = pk2(s[4 * 33], s[5 * 33]); o.w = pk2(s[6 * 33], s[7 * 33]);
        *(v4u*)(WT + (size_t)(dest_row0 + n) * ldt + k0 + 8 * c) = o; }
    LDS_WAIT(); asm volatile("" ::: "memory");
}
template <int MAP>
__device__ __forceinline__ void transpose_job_item(const float* src, int K, int N, bf16_t* dst, size_t dstb, int r, LAS float* scr, int lane, const float* nscale = nullptr) {
    const int nblk = N / 32, per = (K / 64) * nblk, bi = r / per, it = r % per, kb = it / nblk, nb = it % nblk, n0 = 32 * nb;
    int dr = n0; if (MAP == 1) dr = (n0 >> 7) * 256 + (n0 & 127); if (MAP == 2) dr = (n0 >> 7) * 256 + 128 + (n0 & 127);
    transpose_item(src + (size_t)bi * K * N, N, dst + (size_t)bi * dstb, K, 64 * kb, n0, dr, scr, lane, nscale ? nscale + (size_t)bi * N : nullptr);
}

struct InvFreq { float f[8]; };
struct Args {
    const void* in[40]; float* out; unsigned char* ws; InvFreq inv; int ph_lo, ph_hi;
};

struct Row16 { float v[4][4]; };
__device__ __forceinline__ void load_row_bf16(const bf16_t* p, int lane, Row16& r) {
#pragma unroll
    for (int j = 0; j < 4; ++j) { const ushort4 u = *(const ushort4*)(p + 256 * j + 4 * lane); r.v[j][0] = bf2f(u.x); r.v[j][1] = bf2f(u.y); r.v[j][2] = bf2f(u.z); r.v[j][3] = bf2f(u.w); }
}
__device__ __forceinline__ void ln_row(Row16& z, const float* g, const float* b, int lane) {
    float s = 0.f;
#pragma unroll
    for (int j = 0; j < 4; ++j)
#pragma unroll
        for (int i = 0; i < 4; ++i) s += z.v[j][i];
    const float mu = wave_sum(s) * (1.f / D);
    float q = 0.f;
#pragma unroll
    for (int j = 0; j < 4; ++j)
#pragma unroll
        for (int i = 0; i < 4; ++i) { z.v[j][i] -= mu; q += z.v[j][i] * z.v[j][i]; }
    const float rstd = 1.f / sqrtf(wave_sum(q) * (1.f / D) + LN_EPS);
#pragma unroll
    for (int j = 0; j < 4; ++j) { const float4 gg = *(const float4*)(g + 256 * j + 4 * lane), bb = *(const float4*)(b + 256 * j + 4 * lane);
        z.v[j][0] = z.v[j][0] * rstd * gg.x + bb.x; z.v[j][1] = z.v[j][1] * rstd * gg.y + bb.y; z.v[j][2] = z.v[j][2] * rstd * gg.z + bb.z; z.v[j][3] = z.v[j][3] * rstd * gg.w + bb.w; }
}
__device__ __forceinline__ void store_row_bf16(bf16_t* p, int lane, const Row16& r) {
#pragma unroll
    for (int j = 0; j < 4; ++j) { v2u u; u.x = pk2(r.v[j][0], r.v[j][1]); u.y = pk2(r.v[j][2], r.v[j][3]); *(v2u*)(p + 256 * j + 4 * lane) = u; }
}

__device__ __forceinline__ void phase_ln_add(const Frame& F, const bf16_t* X, const bf16_t* Y, const float* g, const float* b, bf16_t* out) {
    const int gw = F.vcu * NWAVES + F.wave, NGW = F.G * NWAVES;
    for (int row = gw; row < T; row += NGW) {
        Row16 x, y; load_row_bf16(X + (size_t)row * D, F.lane, x); load_row_bf16(Y + (size_t)row * D, F.lane, y);
#pragma unroll
        for (int j = 0; j < 4; ++j)
#pragma unroll
            for (int i = 0; i < 4; ++i) x.v[j][i] = ALPHA * x.v[j][i] + y.v[j][i];
        ln_row(x, g, b, F.lane);
        store_row_bf16(out + (size_t)row * D, F.lane, x);
    }
}
__device__ __forceinline__ void phase_ln_moe(const Frame& F, const bf16_t* X, const bf16_t* DS, const int* pos, const float* ewgt, const float* g, const float* b, bf16_t* outb, float* outf) {
    const int gw = F.vcu * NWAVES + F.wave, NGW = F.G * NWAVES;
    for (int row = gw; row < T; row += NGW) {
        Row16 x, y1, y2; load_row_bf16(X + (size_t)row * D, F.lane, x);
        const int r1 = pos[2 * row], r2 = pos[2 * row + 1]; const float w1 = ewgt[2 * row], w2 = ewgt[2 * row + 1];
        load_row_bf16(DS + (size_t)r1 * D, F.lane, y1); load_row_bf16(DS + (size_t)r2 * D, F.lane, y2);
#pragma unroll
        for (int j = 0; j < 4; ++j)
#pragma unroll
            for (int i = 0; i < 4; ++i) x.v[j][i] = ALPHA * x.v[j][i] + (w1 * y1.v[j][i] + w2 * y2.v[j][i]);
        ln_row(x, g, b, F.lane);
        if (outb) store_row_bf16(outb + (size_t)row * D, F.lane, x);
        if (outf) {
#pragma unroll
            for (int j = 0; j < 4; ++j) *(float4*)(outf + (size_t)row * D + 256 * j + 4 * F.lane) = make_float4(x.v[j][0], x.v[j][1], x.v[j][2], x.v[j][3]);
        }
    }
}
constexpr int RW_LD = 20;
__device__ __forceinline__ void phase_ln_router(const Frame& F, const bf16_t* X, const bf16_t* Y, const float* g, const float* b, bf16_t* out, const float* rw, const float* rbias, int* eidx, float* ewgt, int* bcnt) {
    LAS float* rwl = (LAS float*)F.lds;
    LAS int* hist = (LAS int*)(F.lds + 1024 * RW_LD * 4);
    for (int i = F.tid; i < 1024 * 4; i += NTHREADS) { const int k = i >> 2, q = i & 3; const float4 v = *(const float4*)(rw + (size_t)k * 16 + 4 * q); LAS float* d = rwl + k * RW_LD + 4 * q; d[0] = v.x; d[1] = v.y; d[2] = v.z; d[3] = v.w; }
    float rb[16];
#pragma unroll
    for (int e = 0; e < 16; ++e) rb[e] = rbias[e];
    for (int vb = F.vcu; vb < T / 128; vb += F.G) {
        if (F.tid < 16) hist[F.tid] = 0;
        __syncthreads();
        for (int i = 0; i < 16; ++i) {
            const int row = vb * 128 + F.wave * 16 + i;
            Row16 x, y; load_row_bf16(X + (size_t)row * D, F.lane, x); load_row_bf16(Y + (size_t)row * D, F.lane, y);
#pragma unroll
            for (int j = 0; j < 4; ++j)
#pragma unroll
                for (int k = 0; k < 4; ++k) x.v[j][k] = ALPHA * x.v[j][k] + y.v[j][k];
            ln_row(x, g, b, F.lane);
            store_row_bf16(out + (size_t)row * D, F.lane, x);
            float lg[16];
#pragma unroll
            for (int e = 0; e < 16; ++e) lg[e] = 0.f;
#pragma unroll
            for (int j = 0; j < 4; ++j)
#pragma unroll
                for (int k = 0; k < 4; ++k) {
                    const LAS float* wr = rwl + (256 * j + 4 * F.lane + k) * RW_LD;
                    const float xv = x.v[j][k];
#pragma unroll
                    for (int e4 = 0; e4 < 4; ++e4) { const f32x4 w4 = *(const LAS f32x4*)(wr + 4 * e4); lg[4 * e4 + 0] += xv * w4[0]; lg[4 * e4 + 1] += xv * w4[1]; lg[4 * e4 + 2] += xv * w4[2]; lg[4 * e4 + 3] += xv * w4[3]; }
                }
#pragma unroll
            for (int e = 0; e < 16; ++e) lg[e] = wave_sum(lg[e]);
            float mx = lg[0];
#pragma unroll
            for (int e = 1; e < 16; ++e) mx = fmaxf(mx, lg[e]);
            float sc[16], sum = 0.f;
#pragma unroll
            for (int e = 0; e < 16; ++e) { sc[e] = __expf(lg[e] - mx); sum += sc[e]; }
            const float isum = 1.f / sum;
            float bz[16];
#pragma unroll
            for (int e = 0; e < 16; ++e) { sc[e] *= isum; bz[e] = sc[e] + rb[e]; }
            float gs[4]; int gi1[4], gi2[4];
#pragma unroll
            for (int gq = 0; gq < 4; ++gq) {
                float m1 = bz[4 * gq]; int i1 = 0;
#pragma unroll
                for (int j = 1; j < 4; ++j) if (bz[4 * gq + j] > m1) { m1 = bz[4 * gq + j]; i1 = j; }
                float m2 = -INFINITY; int i2 = 0;
#pragma unroll
                for (int j = 0; j < 4; ++j) if (j != i1 && bz[4 * gq + j] > m2) { m2 = bz[4 * gq + j]; i2 = j; }
                gs[gq] = m1 + m2; gi1[gq] = i1; gi2[gq] = i2;
            }
            int gsel = 0; float gm = gs[0];
#pragma unroll
            for (int gq = 1; gq < 4; ++gq) if (gs[gq] > gm) { gm = gs[gq]; gsel = gq; }
            int i1 = gi1[0], i2 = gi2[0];
#pragma unroll
            for (int gq = 1; gq < 4; ++gq) if (gsel == gq) { i1 = gi1[gq]; i2 = gi2[gq]; }
            const int e1 = gsel * 4 + i1, e2 = gsel * 4 + i2;
            float s1 = 0.f, s2 = 0.f;
#pragma unroll
            for (int e = 0; e < 16; ++e) { if (e == e1) s1 = sc[e]; if (e == e2) s2 = sc[e]; }
            const float inv = 1.f / (s1 + s2);
            if (F.lane == 0) { eidx[2 * row] = e1; eidx[2 * row + 1] = e2; ewgt[2 * row] = s1 * inv; ewgt[2 * row + 1] = s2 * inv; atomicAdd((int*)&hist[e1], 1); atomicAdd((int*)&hist[e2], 1); }
        }
        __syncthreads();
        if (F.tid < 16) bcnt[vb * 16 + F.tid] = hist[F.tid];
        __syncthreads();
    }
}
__device__ __forceinline__ void phase_moe_book(const Frame& F, const int* eidx, const int* bcnt, int* tok, int* pos, int* tile_e) {
    LAS int* bc = (LAS int*)F.lds;
    LAS int* es = bc + 4096;
    LAS int* off = es + 256;
    LAS int* base = off + 32;
    LAS int* tot = base + 16;
    for (int i = F.tid; i < 4096; i += NTHREADS) bc[i] = bcnt[i];
    __syncthreads();
    for (int vb = F.vcu; vb < T / 128; vb += F.G) {
        if (F.tid < 16) { int t = 0, bs = 0; for (int b2 = 0; b2 < 256; ++b2) { const int c = bc[b2 * 16 + F.tid]; t += c; if (b2 < vb) bs += c; } tot[F.tid] = t; base[F.tid] = bs; }
        if (F.tid < 256) es[F.tid] = eidx[vb * 256 + F.tid];
        __syncthreads();
        if (F.tid == 0) { int o = 0; for (int e = 0; e < 16; ++e) { off[e] = o; o += (tot[e] + 255) & ~255; } off[16] = o; }
        __syncthreads();
        if (F.tid < 256) {
            const int e = es[F.tid]; int rank = 0;
            for (int j = 0; j < F.tid; ++j) rank += (es[j] == e) ? 1 : 0;
            const int r = off[e] + base[e] + rank;
            pos[vb * 256 + F.tid] = r; tok[r] = vb * 128 + (F.tid >> 1);
        }
        if (vb < 16) { const int e = vb, r0 = off[e] + tot[e], r1 = off[e + 1]; for (int r = r0 + F.tid; r < r1; r += NTHREADS) tok[r] = 0; }
        if (vb == 16) {
            for (int tl = F.tid; tl < NTILE; tl += NTHREADS) { int e = -1; for (int k = 0; k < 16; ++k) if (tl * 256 >= off[k] && tl * 256 < off[k + 1]) e = k; tile_e[tl] = e; }
            if (F.tid == 0) tile_e[NTILE] = off[16] >> 8;
        }
        __syncthreads();
    }
}
__device__ __forceinline__ void phase_pool(const Frame& F, const bf16_t* HP, bf16_t* PO) {
    const int gt = F.vcu * NTHREADS + F.tid, NGT = F.G * NTHREADS;
    for (int i = gt; i < T * (D / 8); i += NGT) {
        const int t = i >> 7, c8 = i & 127, g = c8 >> 5, win = 2 << g, ts = t & (S - 1);
        const int n = ts + 1 < win ? ts + 1 : win;
        float s[8], h0[8];
        { const v4u u = *(const v4u*)(HP + (size_t)t * D + c8 * 8);
            h0[0] = __uint_as_float(u.x << 16); h0[1] = __uint_as_float(u.x & 0xffff0000u); h0[2] = __uint_as_float(u.y << 16); h0[3] = __uint_as_float(u.y & 0xffff0000u);
            h0[4] = __uint_as_float(u.z << 16); h0[5] = __uint_as_float(u.z & 0xffff0000u); h0[6] = __uint_as_float(u.w << 16); h0[7] = __uint_as_float(u.w & 0xffff0000u); }
#pragma unroll
        for (int q = 0; q < 8; ++q) s[q] = h0[q];
        for (int k = 1; k < n; ++k) {
            const v4u u = *(const v4u*)(HP + (size_t)(t - k) * D + c8 * 8);
            s[0] += __uint_as_float(u.x << 16); s[1] += __uint_as_float(u.x & 0xffff0000u); s[2] += __uint_as_float(u.y << 16); s[3] += __uint_as_float(u.y & 0xffff0000u);
            s[4] += __uint_as_float(u.z << 16); s[5] += __uint_as_float(u.z & 0xffff0000u); s[6] += __uint_as_float(u.w << 16); s[7] += __uint_as_float(u.w & 0xffff0000u);
        }
        const float inv = 1.f / (float)n;
        v4u o; o.x = pk2(s[0] * inv - h0[0], s[1] * inv - h0[1]); o.y = pk2(s[2] * inv - h0[2], s[3] * inv - h0[3]); o.z = pk2(s[4] * inv - h0[4], s[5] * inv - h0[5]); o.w = pk2(s[6] * inv - h0[6], s[7] * inv - h0[7]);
        *(v4u*)(PO + (size_t)t * D + c8 * 8) = o;
    }
}
}
namespace mk {
typedef short bf16x8 __attribute__((ext_vector_type(8)));
typedef float f32x16 __attribute__((ext_vector_type(16)));
#define MFMA32(a, b, c) __builtin_amdgcn_mfma_f32_32x32x16_bf16((a), (b), (c), 0, 0, 0)
__device__ __forceinline__ int crow(int i, int h) { return (i & 3) + 8 * (i >> 2) + 4 * h; }
__device__ __forceinline__ float swap32_max(float v) { const auto r = __builtin_amdgcn_permlane32_swap(__float_as_uint(v), __float_as_uint(v), false, false); return fmaxf(__uint_as_float(r[0]), __uint_as_float(r[1])); }
__device__ __forceinline__ float swap32_sum(float v) { const auto r = __builtin_amdgcn_permlane32_swap(__float_as_uint(v), __float_as_uint(v), false, false); return __uint_as_float(r[0]) + __uint_as_float(r[1]); }
__device__ __forceinline__ unsigned pkbf(float lo, float hi) { unsigned r; asm volatile("v_cvt_pk_bf16_f32 %0, %1, %2" : "=v"(r) : "v"(lo), "v"(hi)); return r; }
__device__ __forceinline__ bf16x8 pack_step(const f32x16& x, int s) {
    v4u p; p.x = pkbf(x[8 * s + 0], x[8 * s + 1]); p.y = pkbf(x[8 * s + 2], x[8 * s + 3]); p.z = pkbf(x[8 * s + 4], x[8 * s + 5]); p.w = pkbf(x[8 * s + 6], x[8 * s + 7]);
    return __builtin_bit_cast(bf16x8, p);
}
__device__ __forceinline__ bf16x8 lds_frag2x8(const LAS unsigned char* p) {
    const v2u a = *(const LAS v2u*)p, b = *(const LAS v2u*)(p + 16);
    v4u q; q.x = a.x; q.y = a.y; q.z = b.x; q.w = b.y; return __builtin_bit_cast(bf16x8, q);
}
__device__ __forceinline__ void unpack8(const v4u u, float (&x)[8]) {
    x[0] = __uint_as_float(u.x << 16); x[1] = __uint_as_float(u.x & 0xffff0000u); x[2] = __uint_as_float(u.y << 16); x[3] = __uint_as_float(u.y & 0xffff0000u);
    x[4] = __uint_as_float(u.z << 16); x[5] = __uint_as_float(u.z & 0xffff0000u); x[6] = __uint_as_float(u.w << 16); x[7] = __uint_as_float(u.w & 0xffff0000u);
}

__device__ __forceinline__ void phase_swa_sgu(const Frame& F, const bf16_t* H0, const float* sinks, const float* lng, const float* lnb, const bf16_t* SW, const float* bs, bf16_t* MIX) {
    constexpr int KSTR = 272, VSTR = 520, VT_OFF = 256 * KSTR, VGSTR = 272, VGW = 64 * VGSTR;
    LAS unsigned char* KS = F.lds; LAS unsigned char* VT = F.lds + VT_OFF;
    const int lane = F.lane, r = lane & 31, h = lane >> 5, w = F.wave, kvh = w >> 2;
    const float NEG = -INFINITY;
    for (int vb = F.vcu; vb < T / 128; vb += F.G) {
        const int n = vb & 63; const size_t row0 = (size_t)vb * 128;
#pragma unroll
        for (int i = 0; i < 8; ++i) { const int p = F.tid + NTHREADS * i, row = p >> 4, c16 = p & 15; v4u v = (v4u){0u, 0u, 0u, 0u};
            if (n > 0 || row >= 128) v = *(const v4u*)(H0 + (row0 + row - 128) * NIN0 + 512 + c16 * 8);
            *(LAS v4u*)(KS + row * KSTR + c16 * 16) = v; }
#pragma unroll
        for (int i = 0; i < 8; ++i) { const int p = F.tid + NTHREADS * i, c16 = p >> 8, row = p & 255; v4u v = (v4u){0u, 0u, 0u, 0u};
            if (n > 0 || row >= 128) v = *(const v4u*)(H0 + (row0 + row - 128) * NIN0 + 640 + c16 * 8);
            LAS bf16_t* d = (LAS bf16_t*)(VT + (c16 * 8) * VSTR + row * 2);
            d[0 * (VSTR / 2)] = (bf16_t)(v.x & 0xffffu); d[1 * (VSTR / 2)] = (bf16_t)(v.x >> 16); d[2 * (VSTR / 2)] = (bf16_t)(v.y & 0xffffu); d[3 * (VSTR / 2)] = (bf16_t)(v.y >> 16);
            d[4 * (VSTR / 2)] = (bf16_t)(v.z & 0xffffu); d[5 * (VSTR / 2)] = (bf16_t)(v.z >> 16); d[6 * (VSTR / 2)] = (bf16_t)(v.w & 0xffffu); d[7 * (VSTR / 2)] = (bf16_t)(v.w >> 16); }
        __syncthreads();
        const float sink2 = sinks[w] * 1.4426950408889634f;
#pragma unroll 1
        for (int qg = 0; qg < 4; ++qg) {
            bf16x8 qf[4];
            { const bf16_t* qp = H0 + (row0 + 32 * qg + r) * NIN0 + w * 64 + 8 * h;
#pragma unroll
              for (int ks = 0; ks < 4; ++ks) qf[ks] = *(const bf16x8*)(qp + 16 * ks); }
            f32x16 st[5];
#pragma unroll
            for (int kt = 0; kt < 5; ++kt) {
#pragma unroll
                for (int i = 0; i < 16; ++i) st[kt][i] = 0.f;
                const LAS unsigned char* kp = KS + (32 * qg + 32 * kt + r) * KSTR + (kvh * 64 + 8 * h) * 2;
#pragma unroll
                for (int ks = 0; ks < 4; ++ks) { const bf16x8 kf = *(const LAS bf16x8*)(kp + 32 * ks); st[kt] = MFMA32(kf, qf[ks], st[kt]); }
            }
            float m = sink2;
#pragma unroll
            for (int kt = 0; kt < 5; ++kt)
#pragma unroll
                for (int i = 0; i < 16; ++i) { const int dk = 32 * kt + crow(i, h) - r;
                    const bool valid = dk >= 1 && dk <= 128 && (n > 0 || (32 * qg + 32 * kt + crow(i, h)) >= 128);
                    const float s = valid ? st[kt][i] * ASCALE : NEG; st[kt][i] = s; m = fmaxf(m, s); }
            m = swap32_max(m);
            float l = 0.f;
#pragma unroll
            for (int kt = 0; kt < 5; ++kt)
#pragma unroll
                for (int i = 0; i < 16; ++i) { const float p = __builtin_amdgcn_exp2f(st[kt][i] - m); st[kt][i] = p; l += p; }
            l = swap32_sum(l) + __builtin_amdgcn_exp2f(sink2 - m);
            f32x16 o[2];
#pragma unroll
            for (int i = 0; i < 16; ++i) { o[0][i] = 0.f; o[1][i] = 0.f; }
#pragma unroll
            for (int kt = 0; kt < 5; ++kt)
#pragma unroll
                for (int s = 0; s < 2; ++s) { const bf16x8 pf = pack_step(st[kt], s);
#pragma unroll
                    for (int dt = 0; dt < 2; ++dt) { const bf16x8 vf = lds_frag2x8(VT + (kvh * 64 + 32 * dt + r) * VSTR + (32 * qg + 32 * kt + 16 * s + 4 * h) * 2); o[dt] = MFMA32(vf, pf, o[dt]); } }
            const float inv = 1.f / l;
            bf16_t* op = MIX + (row0 + 32 * qg + r) * D + w * 64 + 4 * h;
#pragma unroll
            for (int dt = 0; dt < 2; ++dt)
#pragma unroll
                for (int g4 = 0; g4 < 4; ++g4) { v2u u; u.x = pkbf(o[dt][4 * g4 + 0] * inv, o[dt][4 * g4 + 1] * inv); u.y = pkbf(o[dt][4 * g4 + 2] * inv, o[dt][4 * g4 + 3] * inv); *(v2u*)(op + 32 * dt + 8 * g4) = u; }
        }
        __syncthreads();
        {
            LAS unsigned char* VG = F.lds + w * VGW; const int g = w;
#pragma unroll 1
            for (int it = 0; it < 2; ++it) { const int s = 64 * it + lane; const bf16_t* vp = H0 + (row0 + s) * NIN0 + 1280 + g * 64;
                float x[8][8]; float sum = 0.f;
#pragma unroll
                for (int cq = 0; cq < 8; ++cq) { unpack8(*(const v4u*)(vp + 8 * cq), x[cq]);
#pragma unroll
                    for (int e = 0; e < 8; ++e) sum += x[cq][e]; }
                const float mu = sum * (1.f / 64.f); float q = 0.f;
#pragma unroll
                for (int cq = 0; cq < 8; ++cq)
#pragma unroll
                    for (int e = 0; e < 8; ++e) { x[cq][e] -= mu; q += x[cq][e] * x[cq][e]; }
                const float rstd = 1.f / sqrtf(q * (1.f / 64.f) + LN_EPS);
#pragma unroll
                for (int cq = 0; cq < 8; ++cq)
#pragma unroll
                    for (int e = 0; e < 8; ++e) { const int c = 8 * cq + e; *(LAS bf16_t*)(VG + c * VGSTR + s * 2) = f2bf(x[cq][e] * rstd * lng[g * 64 + c] + lnb[g * 64 + c]); }
            }
            LDS_WAIT();
#pragma unroll 1
            for (int tt = 0; tt < 4; ++tt) {
                f32x16 acc[2];
#pragma unroll
                for (int i = 0; i < 16; ++i) { acc[0][i] = 0.f; acc[1][i] = 0.f; }
                const bf16_t* wp = SW + ((size_t)(g * 128 + 32 * tt + r) * 128 + 8 * h);
                for (int ks = 0; ks < 2 * (tt + 1); ++ks) { const bf16x8 bfr = *(const bf16x8*)(wp + 16 * ks);
#pragma unroll
                    for (int ct = 0; ct < 2; ++ct) { const bf16x8 af = *(const LAS bf16x8*)(VG + (32 * ct + r) * VGSTR + (16 * ks + 8 * h) * 2); acc[ct] = MFMA32(af, bfr, acc[ct]); } }
                const int t = 32 * tt + r; const float bias = bs[g * 128 + t];
                const bf16_t* up = H0 + (row0 + t) * NIN0 + 768 + g * 64 + 4 * h; bf16_t* op = MIX + (row0 + t) * D + 512 + g * 64 + 4 * h;
#pragma unroll
                for (int ct = 0; ct < 2; ++ct)
#pragma unroll
                    for (int g4 = 0; g4 < 4; ++g4) { const v2u uu = *(const v2u*)(up + 32 * ct + 8 * g4);
                        const float u0 = __uint_as_float(uu.x << 16), u1 = __uint_as_float(uu.x & 0xffff0000u), u2 = __uint_as_float(uu.y << 16), u3 = __uint_as_float(uu.y & 0xffff0000u);
                        v2u o2; o2.x = pkbf(u0 * (acc[ct][4 * g4 + 0] + bias), u1 * (acc[ct][4 * g4 + 1] + bias)); o2.y = pkbf(u2 * (acc[ct][4 * g4 + 2] + bias), u3 * (acc[ct][4 * g4 + 3] + bias));
                        *(v2u*)(op + 32 * ct + 8 * g4) = o2; }
            }
        }
        __syncthreads();
    }
}

__device__ __forceinline__ void phase_xattn(const Frame& F, const bf16_t* Qb, const bf16_t* Kb, const bf16_t* Vt, bf16_t* Ob) {
    constexpr int KSTR = 528, VSTR = 520;
    LAS unsigned char* KS = F.lds;
    const int lane = F.lane, r = lane & 31, h5 = lane >> 5, w = F.wave;
    for (int u = F.vcu; u < B * XH * (S / 256); u += F.G) {
        const int b = u >> 7, hd = (u >> 5) & 3, qt = u & 31;
#pragma unroll
        for (int i = 0; i < 16; ++i) { const int p = F.tid + NTHREADS * i, row = p >> 5, c = p & 31;
            const v4u v = *(const v4u*)(Kb + (size_t)(b * MEM + row) * 2048 + hd * 256 + c * 8); *(LAS v4u*)(KS + row * KSTR + c * 16) = v; }
        __syncthreads();
        const size_t qrow = (size_t)b * S + qt * 256 + 32 * w + r;
        f32x16 st[8];
#pragma unroll
        for (int kt = 0; kt < 8; ++kt)
#pragma unroll
            for (int i = 0; i < 16; ++i) st[kt][i] = 0.f;
        { const bf16_t* qp = Qb + qrow * D + hd * 256 + 8 * h5;
#pragma unroll 4
          for (int ks = 0; ks < 16; ++ks) { const bf16x8 qf = *(const bf16x8*)(qp + 16 * ks);
#pragma unroll
              for (int kt = 0; kt < 8; ++kt) { const bf16x8 kf = *(const LAS bf16x8*)(KS + (32 * kt + r) * KSTR + (16 * ks + 8 * h5) * 2); st[kt] = MFMA32(kf, qf, st[kt]); } } }
        float m = -INFINITY;
#pragma unroll
        for (int kt = 0; kt < 8; ++kt)
#pragma unroll
            for (int i = 0; i < 16; ++i) m = fmaxf(m, st[kt][i]);
        m = swap32_max(m);
        float l = 0.f;
#pragma unroll
        for (int kt = 0; kt < 8; ++kt)
#pragma unroll
            for (int i = 0; i < 16; ++i) { const float p = __builtin_amdgcn_exp2f(st[kt][i] - m); st[kt][i] = p; l += p; }
        l = swap32_sum(l);
        bf16x8 pf[8][2];
#pragma unroll
        for (int kt = 0; kt < 8; ++kt) { pf[kt][0] = pack_step(st[kt], 0); pf[kt][1] = pack_step(st[kt], 1); }
        __syncthreads();
        { const bf16_t* vsrc = Vt + (size_t)(b * XH + hd) * XHD * MEM;
#pragma unroll
          for (int i = 0; i < 16; ++i) { const int p = F.tid + NTHREADS * i, row = p >> 5, c = p & 31;
              const v4u v = *(const v4u*)(vsrc + (size_t)row * MEM + c * 8); LAS v2u* d = (LAS v2u*)(KS + row * VSTR + c * 16); d[0] = (v2u){v.x, v.y}; d[1] = (v2u){v.z, v.w}; } }
        __syncthreads();
        const float inv = 1.f / l;
        bf16_t* op = Ob + qrow * D + hd * 256 + 4 * h5;
#pragma unroll 1
        for (int half = 0; half < 2; ++half) {
            f32x16 o[4];
#pragma unroll
            for (int dt = 0; dt < 4; ++dt)
#pragma unroll
                for (int i = 0; i < 16; ++i) o[dt][i] = 0.f;
#pragma unroll
            for (int kt = 0; kt < 8; ++kt)
#pragma unroll
                for (int s = 0; s < 2; ++s)
#pragma unroll
                    for (int dt = 0; dt < 4; ++dt) { const bf16x8 vf = lds_frag2x8(KS + (128 * half + 32 * dt + r) * VSTR + (32 * kt + 16 * s + 4 * h5) * 2); o[dt] = MFMA32(vf, pf[kt][s], o[dt]); }
#pragma unroll
            for (int dt = 0; dt < 4; ++dt)
#pragma unroll
                for (int g4 = 0; g4 < 4; ++g4) { v2u uu; uu.x = pkbf(o[dt][4 * g4 + 0] * inv, o[dt][4 * g4 + 1] * inv); uu.y = pkbf(o[dt][4 * g4 + 2] * inv, o[dt][4 * g4 + 3] * inv); *(v2u*)(op + 128 * half + 32 * dt + 8 * g4) = uu; }
        }
        __syncthreads();
    }
}
}
namespace mk {
#ifndef MK_HAVE_SWA
#define MK_HAVE_SWA 1
#endif
#ifndef MK_HAVE_XATTN
#define MK_HAVE_XATTN 1
#endif
constexpr int NPHASE = 26;

typedef const __attribute__((address_space(4))) Args* KArgs;
__device__ __forceinline__ KArgs kargs() { KArgs p = (KArgs)__builtin_amdgcn_kernarg_segment_ptr(); asm volatile("" : "+s"(p)); return p; }

__device__ __forceinline__ bool in_range(int k) { KArgs ka = kargs(); return ka->ph_lo <= k && k < ka->ph_hi; }

__global__ void __launch_bounds__(NTHREADS, 2) mega(Args a) {
    extern __shared__ __attribute__((aligned(16))) unsigned char lds_raw[];
    LAS unsigned char* const F0lds = (LAS unsigned char*)lds_raw;
    const int F0wave = __builtin_amdgcn_readfirstlane((int)threadIdx.x >> 6);
    const int F0G = gridDim.x, F0bx = blockIdx.x, F0vcu = (F0G % 8 == 0) ? (F0bx % 8) * (F0G / 8) + F0bx / 8 : F0bx;
    volatile LAS unsigned* MISC = (volatile LAS unsigned*)(F0lds + MISC_OFF);
    if (threadIdx.x < 64) MISC[threadIdx.x] = 0u;
    __syncthreads();
    unsigned* ctl = (unsigned*)(a.ws + WS_CTL);
    XcdBarrier bar = xcd_barrier_post(ctl + CW_BAR + a.ph_lo * XCD_BAR_WORDS, MISC + 8, F0wave);
#define IN(k) in_range(k)
#define SEAM(k) do { if (IN(k) && IN((k) + 1)) { XcdBarrier b2_ = bar; asm volatile("" : "+s"(b2_.bar), "+s"(b2_.x)); xcd_barrier(b2_); } } while (0)
#define PH KArgs ka = kargs(); unsigned char* ws = ka->ws; (void)ws; Frame Fp; Fp.lds = F0lds; Fp.wave = F0wave; Fp.vcu = F0vcu; Fp.G = F0G; Fp.bx = F0bx; asm volatile("" : "+s"(Fp.wave), "+s"(Fp.vcu), "+s"(Fp.G), "+s"(Fp.bx)); \
    Fp.lane = (int)lane_id_fresh(); Fp.tid = Fp.wave * 64 + Fp.lane; const Frame& F = Fp; \
    const int bx = Fp.bx; (void)bx; LAS unsigned char* glds = F.lds; (void)glds; \
    bf16_t* RA = (bf16_t*)(ws + WS_A); bf16_t* RB = (bf16_t*)(ws + WS_B); bf16_t* RC = (bf16_t*)(ws + WS_C); bf16_t* RD = (bf16_t*)(ws + WS_D); bf16_t* WB = (bf16_t*)(ws + WS_WB); \
    (void)RA; (void)RB; (void)RC; (void)RD; (void)WB;
#define PHC PH const int cb = L == 0 ? 12 : 28; (void)cb; bf16_t* WBl = WB + WB_LAYER + (size_t)L * WL_SIZE; (void)WBl; \
    bf16_t *X1 = RB, *Qb, *Ob, *Y2, *X2, *HS = RB, *DS = RD, *X3; if (L == 0) { Qb = RA; Ob = RC; Y2 = RA; X2 = RC; X3 = RA; } else { Qb = RC; Ob = RD; Y2 = RC; X2 = RA; X3 = nullptr; } \
    (void)X1; (void)Qb; (void)Ob; (void)Y2; (void)X2; (void)HS; (void)DS; (void)X3;
#define INF(i) ((const float*)ka->in[i])
#define WSI(off) ((int*)(ws + (off)))
#define WSF(off) ((float*)(ws + (off)))

    for (int L = 0; L < 2; ++L) {
        const int pb = 13 * L;
        if (L == 0) {
            if (IN(0)) { PH
                LAS float* scr = (LAS float*)(F.lds + F.wave * 16384);
                const int gw = F.vcu * NWAVES + F.wave, NGW = F.G * NWAVES;
                constexpr int NITEMS = 896 + 512 + 512 + 128 + 512 + 2 * (512 + 1024 + 512 + 3 * 4096);
                for (int it = gw; it < NITEMS; it += NGW) {
                    int r = it;
#define JOB(MAP, src, K_, N_, dst, dstb, cnt) if (r < (cnt)) { transpose_job_item<MAP>((const float*)(src), K_, N_, dst, dstb, r, scr, F.lane); continue; } r -= (cnt);
                    JOB(0, ka->in[5], 1024, 1792, WB + WB_IN0, 0, 896)
                    JOB(0, ka->in[11], 1024, 1024, WB + WB_OUT0, 0, 512)
                    JOB(0, ka->in[24], 1024, 1024, WB + WB_IN1, 0, 512)
                    if (r < 128) { transpose_job_item<0>((const float*)ka->in[25], 256, 256, WB + WB_POOL, (size_t)256 * 256, r, scr, F.lane, (const float*)ka->in[26]); continue; } r -= 128;
                    JOB(0, ka->in[27], 1024, 1024, WB + WB_OUT1, 0, 512)
#define LAYER_JOBS(l, c2) { bf16_t* Wl = WB + WB_LAYER + (size_t)(l) * WL_SIZE; \
                        JOB(0, ka->in[(c2) + 2], 1024, 1024, Wl + WL_XQ, 0, 512) \
                        JOB(0, ka->in[(c2) + 3], 1024, 2048, Wl + WL_XKV, 0, 1024) \
                        JOB(0, ka->in[(c2) + 4], 1024, 1024, Wl + WL_XO, 0, 512) \
                        JOB(1, ka->in[(c2) + 7], 1024, 512, Wl + WL_GU, (size_t)1024 * 1024, 4096) \
                        JOB(2, ka->in[(c2) + 8], 1024, 512, Wl + WL_GU, (size_t)1024 * 1024, 4096) \
                        JOB(0, ka->in[(c2) + 9], 512, 1024, Wl + WL_DN, (size_t)1024 * 512, 4096) }
                    LAYER_JOBS(0, 12)
                    LAYER_JOBS(1, 28)
#undef LAYER_JOBS
#undef JOB
                }
                const int gt = F.vcu * NTHREADS + F.tid, NGT = F.G * NTHREADS;
                { const float4* x4 = (const float4*)ka->in[0]; v2u* o = (v2u*)RA;
                  for (int i = gt; i < T * D / 4; i += NGT) { const float4 v = x4[i]; v2u w; w.x = pk2(v.x, v.y); w.y = pk2(v.z, v.w); o[i] = w; } }
                { const float4* m4 = (const float4*)ka->in[1]; v2u* o = (v2u*)(ws + WS_MEMB);
                  for (int i = gt; i < B * MEM * D / 4; i += NGT) { const float4 v = m4[i]; v2u w; w.x = pk2(v.x, v.y); w.y = pk2(v.z, v.w); o[i] = w; } }
                { const int* positions = (const int*)ka->in[2]; float* ropew = WSF(WS_ROPE);
                  for (int t = gt; t < T; t += NGT) { const float p = (float)positions[t];
#pragma unroll
                      for (int j = 0; j < 8; ++j) { const float ang = p * ka->inv.f[j]; double rev = (double)ang * 0.15915494309189535; rev -= rint(rev); const float rr = (float)rev;
                          ropew[(size_t)t * 16 + j] = __builtin_amdgcn_cosf(rr); ropew[(size_t)t * 16 + 8 + j] = __builtin_amdgcn_sinf(rr); } } }
                { const float* sw = INF(9); bf16_t* o = WB + WB_SGUW;
                  for (int i = gt; i < 8 * 128 * 128; i += NGT) { const int s = i & 127, t = (i >> 7) & 127; o[i] = f2bf(s <= t ? sw[i] : 0.f); } }
            }
            SEAM(0);
            if (IN(1)) { PH float* rope = WSF(WS_ROPE); bf16_t* MEMB = (bf16_t*)(ws + WS_MEMB);
#pragma unroll 1
                for (int l = 0; l < 2; ++l) {
                    bf16_t* Wl = WB + WB_LAYER + (size_t)l * WL_SIZE;
                    pg8::Gemm g{MEMB, Wl + WL_XKV, nullptr};
                    const int c2 = bx - 128 - 32 * l;
                    pg8::StaticOrder S; S.init(B * MEM, 2048, F.G, (c2 >= 0 && c2 < 32) ? c2 : (1 << 20));
                    pg8::EpiKV E{(bf16_t*)(ws + WS_MEMKV) + (size_t)l * B * MEM * 2048, (bf16_t*)(ws + WS_MEMVT) + (size_t)l * B * MEM * 1024};
                    pg8::gemm_phase<pg8::EpiKV, pg8::StaticOrder, true, true, false, D, D, D, 0>(glds, F.tid, g, S, E);
                }
                {
                    pg8::Gemm g{RA, WB + WB_IN0, nullptr};
                    pg8::StaticOrder S; S.init(T, NIN0, F.G, bx);
                    pg8::EpiInproj0 E{RD, rope};
                    pg8::gemm_phase<pg8::EpiInproj0, pg8::StaticOrder, true, true, false, D, D, D, 0>(glds, F.tid, g, S, E);
                }
            }
            SEAM(1);
            if (IN(2)) { PH
#if MK_HAVE_SWA
                phase_swa_sgu(F, RD, INF(6), INF(7), INF(8), WB + WB_SGUW, INF(10), RB);
#endif
            }
            SEAM(2);
            if (IN(3)) { PH
                pg8::Gemm g{RB, WB + WB_OUT0, nullptr};
                pg8::StaticOrder S; S.init(T, D, F.G, bx);
                pg8::EpiBf16 E{RC, D, 1.f};
                pg8::gemm_phase<pg8::EpiBf16, pg8::StaticOrder, true, true, false, D, D, D, 0>(glds, F.tid, g, S, E);
            }
            SEAM(3);
            if (IN(4)) { PH phase_ln_add(F, RA, RC, INF(12), INF(13), RB); }
            SEAM(4);
        } else {
            if (IN(13)) { PH
                pg8::Gemm g{RA, WB + WB_IN1, nullptr};
                pg8::StaticOrder S; S.init(T, D, F.G, bx);
                pg8::EpiBf16 E{RB, D, 1.f};
                pg8::gemm_phase<pg8::EpiBf16, pg8::StaticOrder, true, true, false, D, D, D, 0>(glds, F.tid, g, S, E);
            }
            SEAM(13);
            if (IN(14)) { PH phase_pool(F, RB, RC); }
            SEAM(14);
            if (IN(15)) { PH
                pg8::Gemm g{RC, WB + WB_POOL, nullptr};
                pg8::StaticOrder S; S.init(T, D, F.G, bx);
                pg8::EpiBf16 E{RD, D, 1.f};
                pg8::gemm_phase<pg8::EpiBf16, pg8::StaticOrder, true, true, false, D, 256, 256, 256>(glds, F.tid, g, S, E);
            }
            SEAM(15);
            if (IN(16)) { PH
                pg8::Gemm g{RD, WB + WB_OUT1, nullptr};
                pg8::StaticOrder S; S.init(T, D, F.G, bx);
                pg8::EpiBf16 E{RC, D, 1.f};
                pg8::gemm_phase<pg8::EpiBf16, pg8::StaticOrder, true, true, false, D, D, D, 0>(glds, F.tid, g, S, E);
            }
            SEAM(16);
            if (IN(17)) { PH phase_ln_add(F, RA, RC, INF(28), INF(29), RB); }
            SEAM(17);
        }
        if (IN(pb + 5)) { PHC
            pg8::Gemm g{X1, WBl + WL_XQ, nullptr};
            pg8::StaticOrder S; S.init(T, D, F.G, bx);
            pg8::EpiBf16 E{Qb, D, QSCALE};
            pg8::gemm_phase<pg8::EpiBf16, pg8::StaticOrder, true, true, false, D, D, D, 0>(glds, F.tid, g, S, E);
        }
        SEAM(pb + 5);
        if (IN(pb + 6)) { PHC bf16_t* Kb = (bf16_t*)(ws + WS_MEMKV) + (size_t)L * B * MEM * 2048; bf16_t* Vt = (bf16_t*)(ws + WS_MEMVT) + (size_t)L * B * MEM * 1024; (void)Kb; (void)Vt;
#if MK_HAVE_XATTN
            phase_xattn(F, Qb, Kb, Vt, Ob);
#endif
        }
        SEAM(pb + 6);
        if (IN(pb + 7)) { PHC
            pg8::Gemm g{Ob, WBl + WL_XO, nullptr};
            pg8::StaticOrder S; S.init(T, D, F.G, bx);
            pg8::EpiBf16 E{Y2, D, 1.f};
            pg8::gemm_phase<pg8::EpiBf16, pg8::StaticOrder, true, true, false, D, D, D, 0>(glds, F.tid, g, S, E);
        }
        SEAM(pb + 7);
        if (IN(pb + 8)) { PHC phase_ln_router(F, X1, Y2, INF(cb + 5), INF(cb + 6), X2, INF(3), INF(4), WSI(WS_EIDX), WSF(WS_EWGT), WSI(WS_BCNT)); }
        SEAM(pb + 8);
        if (IN(pb + 9)) { PHC phase_moe_book(F, WSI(WS_EIDX), WSI(WS_BCNT), WSI(WS_TOK), WSI(WS_POS), WSI(WS_TILE)); }
        SEAM(pb + 9);
        if (IN(pb + 10)) { PHC const int* tile_e = WSI(WS_TILE); const int* tok = WSI(WS_TOK);
            const int ntiles = __builtin_amdgcn_readfirstlane(tile_e[NTILE]);
            pg8::Gemm g{X2, WBl + WL_GU, tok};
            pg8::MoeOrder S; S.init(ntiles, tile_e, F.G, bx);
            pg8::EpiGU E{HS};
            pg8::gemm_phase<pg8::EpiGU, pg8::MoeOrder, true, true, true, D, D, D, 0>(glds, F.tid, g, S, E);
        }
        SEAM(pb + 10);
        if (IN(pb + 11)) { PHC const int* tile_e = WSI(WS_TILE);
            const int ntiles = __builtin_amdgcn_readfirstlane(tile_e[NTILE]);
            pg8::Gemm g{HS, WBl + WL_DN, nullptr};
            pg8::MoeOrder S; S.init(ntiles, tile_e, F.G, bx);
            pg8::EpiBf16 E{DS, D, 1.f};
            pg8::gemm_phase<pg8::EpiBf16, pg8::MoeOrder, true, true, false, DE, DE, DE, 0>(glds, F.tid, g, S, E);
        }
        SEAM(pb + 11);
        if (IN(pb + 12)) { PHC phase_ln_moe(F, X2, DS, WSI(WS_POS), WSF(WS_EWGT), INF(cb + 10), INF(cb + 11), X3, L == 1 ? ka->out : nullptr); }
        SEAM(pb + 12);
    }
#undef IN
#undef SEAM
#undef INF
#undef PH
#undef PHC
#undef WSI
#undef WSF
}
}
namespace nv {
template <class Epi>
__global__ __launch_bounds__(256) void k_gemm(const bf16_t* A, int lda, const float* W, int ldw, int K, Epi epi, const int* tile_e, size_t w_stride, const int* arow) {
    __shared__ float As[16][68];
    __shared__ float Bs[16][68];
    const int bm = blockIdx.y * 64, bn = blockIdx.x * 64;
    const float* Wp = W;
    if (tile_e) { const int e = tile_e[bm >> 8]; if (e < 0) return; Wp += (size_t)e * w_stride; }
    const int tid = threadIdx.x, tx = tid & 15, ty = tid >> 4;
    float acc[4][4];
#pragma unroll
    for (int i = 0; i < 4; ++i)
#pragma unroll
        for (int j = 0; j < 4; ++j) acc[i][j] = 0.f;
    for (int k0 = 0; k0 < K; k0 += 16) {
        {
            const int r = tid >> 2, kk = (tid & 3) * 4;
            const int ar = arow ? arow[bm + r] : bm + r;
            const ushort4 v = *(const ushort4*)(A + (size_t)ar * lda + k0 + kk);
            As[kk + 0][r] = bf2f(v.x); As[kk + 1][r] = bf2f(v.y); As[kk + 2][r] = bf2f(v.z); As[kk + 3][r] = bf2f(v.w);
        }
        {
            const int kk = tid >> 4, n = (tid & 15) * 4;
            const float4 v = *(const float4*)(Wp + (size_t)(k0 + kk) * ldw + bn + n);
            Bs[kk][n + 0] = v.x; Bs[kk][n + 1] = v.y; Bs[kk][n + 2] = v.z; Bs[kk][n + 3] = v.w;
        }
        __syncthreads();
#pragma unroll
        for (int kk = 0; kk < 16; ++kk) {
            float a[4], b[4];
#pragma unroll
            for (int i = 0; i < 4; ++i) a[i] = As[kk][ty * 4 + i];
#pragma unroll
            for (int j = 0; j < 4; ++j) b[j] = Bs[kk][tx * 4 + j];
#pragma unroll
            for (int i = 0; i < 4; ++i)
#pragma unroll
                for (int j = 0; j < 4; ++j) acc[i][j] += a[i] * b[j];
        }
        __syncthreads();
    }
#pragma unroll
    for (int i = 0; i < 4; ++i)
#pragma unroll
        for (int j = 0; j < 4; ++j) epi(bm + ty * 4 + i, bn + tx * 4 + j, acc[i][j]);
}

struct EpiBf16 { bf16_t* O; int ldo; float scale; __device__ void operator()(int r, int c, float v) const { O[(size_t)r * ldo + c] = f2bf(v * scale); } };
struct EpiInproj0 { bf16_t* O; __device__ void operator()(int r, int c, float v) const { if (c >= 768) v = gelu_tanh(v); O[(size_t)r * NIN0 + c] = f2bf(v); } };
struct EpiF32 { float* O; int ldo; __device__ void operator()(int r, int c, float v) const { O[(size_t)r * ldo + c] = v; } };
struct EpiSiluMul { const float* G; bf16_t* HS; __device__ void operator()(int r, int c, float v) const { HS[(size_t)r * DE + c] = f2bf(silu(G[(size_t)r * DE + c]) * v); } };
struct EpiKV { bf16_t* Kb; bf16_t* Vt; __device__ void operator()(int r, int c, float v) const {
    Kb[(size_t)r * 2048 + c] = f2bf(v);
    if (c >= 1024) { const int d = c - 1024, h = d >> 8, dd = d & 255, b = r >> 8, key = r & 255; Vt[((size_t)(b * XH + h) * XHD + dd) * MEM + key] = f2bf(v); } } };
struct EpiPoolMap { bf16_t* O; const float* scale; int coff; __device__ void operator()(int r, int c, float v) const { O[(size_t)r * D + coff + c] = f2bf(v * scale[coff + c]); } };

__global__ void k_cvt_x(const float* x, bf16_t* xb, size_t n4) {
    for (size_t i = (size_t)blockIdx.x * blockDim.x + threadIdx.x; i < n4; i += (size_t)gridDim.x * blockDim.x) {
        const float4 v = ((const float4*)x)[i];
        ushort4 o; o.x = f2bf(v.x); o.y = f2bf(v.y); o.z = f2bf(v.z); o.w = f2bf(v.w);
        ((ushort4*)xb)[i] = o;
    }
}
struct InvFreq { float f[8]; };
__global__ void k_rope_table(const int* positions, float* tab, InvFreq inv) {
    const int t = blockIdx.x * blockDim.x + threadIdx.x;
    if (t >= T) return;
    const float p = (float)positions[t];
#pragma unroll
    for (int j = 0; j < 8; ++j) {
        const float ang = p * inv.f[j];
        double rev = (double)ang * 0.15915494309189535; rev -= rint(rev);
        const float r = (float)rev;
        tab[(size_t)t * 16 + j] = __builtin_amdgcn_cosf(r);
        tab[(size_t)t * 16 + 8 + j] = __builtin_amdgcn_sinf(r);
    }
}
__global__ void k_rope_apply(bf16_t* H0, const float* tab) {
    const int i = blockIdx.x * blockDim.x + threadIdx.x;
    if (i >= T * 80) return;
    const int t = i / 80, r = i % 80, hd = r >> 3, j = r & 7;
    bf16_t* p = H0 + (size_t)t * NIN0 + hd * 64;
    const float t1 = bf2f(p[j]), t2 = bf2f(p[j + 8]);
    const float c = tab[(size_t)t * 16 + j], s = tab[(size_t)t * 16 + 8 + j];
    p[j] = f2bf(t1 * c - t2 * s); p[j + 8] = f2bf(t2 * c + t1 * s);
}

__global__ __launch_bounds__(128) void k_swa(const bf16_t* H0, const float* sinks, bf16_t* MIX) {
    __shared__ float Ks[256][65];
    __shared__ float Vs[256][65];
    const int head = blockIdx.x & 7, bn = blockIdx.x >> 3, n = bn & 63, b = bn >> 6;
    const int kvh = head >> 2;
    const int tid = threadIdx.x;
    const size_t row0 = (size_t)b * S + (size_t)n * 128;
    for (int idx = tid; idx < 256 * 64; idx += 128) {
        const int kj = idx >> 6, d = idx & 63;
        float kv = 0.f, vv = 0.f;
        if (n > 0 || kj >= 128) {
            const size_t row = row0 - 128 + kj;
            kv = bf2f(H0[row * NIN0 + 512 + kvh * 64 + d]);
            vv = bf2f(H0[row * NIN0 + 640 + kvh * 64 + d]);
        }
        Ks[kj][d] = kv; Vs[kj][d] = vv;
    }
    __syncthreads();
    float q[64], o[64];
    const bf16_t* qp = H0 + (row0 + tid) * NIN0 + head * 64;
#pragma unroll
    for (int d = 0; d < 64; ++d) { q[d] = bf2f(qp[d]) * ASCALE; o[d] = 0.f; }
    const float sink = sinks[head] * 1.4426950408889634f;
    float m = sink, l = 1.f;
    for (int kj = tid + 1; kj <= tid + 128; ++kj) {
        if (n == 0 && kj < 128) continue;
        float s = 0.f;
#pragma unroll
        for (int d = 0; d < 64; ++d) s += q[d] * Ks[kj][d];
        const float mn = fmaxf(m, s), sc = exp2f(m - mn), p = exp2f(s - mn);
        l = l * sc + p; m = mn;
#pragma unroll
        for (int d = 0; d < 64; ++d) o[d] = o[d] * sc + p * Vs[kj][d];
    }
    const float inv = 1.f / l;
    bf16_t* op = MIX + (row0 + tid) * D + head * 64;
#pragma unroll
    for (int d = 0; d < 64; ++d) op[d] = f2bf(o[d] * inv);
}

__global__ void k_sgu_ln(const bf16_t* H0, const float* lg, const float* lb, bf16_t* VG) {
    const int i = blockIdx.x * blockDim.x + threadIdx.x;
    if (i >= T * 8) return;
    const int t = i >> 3, g = i & 7;
    const bf16_t* p = H0 + (size_t)t * NIN0 + 1280 + g * 64;
    float s = 0.f;
    for (int c = 0; c < 64; ++c) s += bf2f(p[c]);
    const float mu = s * (1.f / 64.f);
    float q = 0.f;
    for (int c = 0; c < 64; ++c) { const float d = bf2f(p[c]) - mu; q += d * d; }
    const float rstd = 1.f / sqrtf(q * (1.f / 64.f) + LN_EPS);
    for (int c = 0; c < 64; ++c) VG[(size_t)t * 512 + g * 64 + c] = f2bf((bf2f(p[c]) - mu) * rstd * lg[g * 64 + c] + lb[g * 64 + c]);
}
__global__ void k_sgu_mix(const bf16_t* H0, const bf16_t* VG, const float* w, const float* bs, bf16_t* MIX) {
    const size_t i = (size_t)blockIdx.x * blockDim.x + threadIdx.x;
    if (i >= (size_t)T * 512) return;
    const int t = (int)(i >> 9), ch = (int)(i & 511), g = ch >> 6, tl = t & 127;
    const size_t c0 = (size_t)(t - tl);
    const float* wr = w + ((size_t)g * 128 + tl) * 128;
    float acc = 0.f;
    for (int s = 0; s <= tl; ++s) acc += wr[s] * bf2f(VG[(c0 + s) * 512 + ch]);
    acc += bs[g * 128 + tl];
    MIX[(size_t)t * D + 512 + ch] = f2bf(bf2f(H0[(size_t)t * NIN0 + 768 + ch]) * acc);
}

struct Row16 { float v[4][4]; };
__device__ __forceinline__ void load_row_bf16(const bf16_t* p, int lane, Row16& r) {
#pragma unroll
    for (int j = 0; j < 4; ++j) { const ushort4 u = *(const ushort4*)(p + 256 * j + 4 * lane); r.v[j][0] = bf2f(u.x); r.v[j][1] = bf2f(u.y); r.v[j][2] = bf2f(u.z); r.v[j][3] = bf2f(u.w); }
}
__device__ __forceinline__ void ln_row(Row16& z, const float* g, const float* b, int lane) {
    float s = 0.f;
#pragma unroll
    for (int j = 0; j < 4; ++j)
#pragma unroll
        for (int i = 0; i < 4; ++i) s += z.v[j][i];
    const float mu = wave_sum(s) * (1.f / D);
    float q = 0.f;
#pragma unroll
    for (int j = 0; j < 4; ++j)
#pragma unroll
        for (int i = 0; i < 4; ++i) { z.v[j][i] -= mu; q += z.v[j][i] * z.v[j][i]; }
    const float rstd = 1.f / sqrtf(wave_sum(q) * (1.f / D) + LN_EPS);
#pragma unroll
    for (int j = 0; j < 4; ++j) { const float4 gg = *(const float4*)(g + 256 * j + 4 * lane), bb = *(const float4*)(b + 256 * j + 4 * lane);
        z.v[j][0] = z.v[j][0] * rstd * gg.x + bb.x; z.v[j][1] = z.v[j][1] * rstd * gg.y + bb.y; z.v[j][2] = z.v[j][2] * rstd * gg.z + bb.z; z.v[j][3] = z.v[j][3] * rstd * gg.w + bb.w; }
}
__device__ __forceinline__ void store_row_bf16(bf16_t* p, int lane, const Row16& r) {
#pragma unroll
    for (int j = 0; j < 4; ++j) { ushort4 u; u.x = f2bf(r.v[j][0]); u.y = f2bf(r.v[j][1]); u.z = f2bf(r.v[j][2]); u.w = f2bf(r.v[j][3]); *(ushort4*)(p + 256 * j + 4 * lane) = u; }
}
__global__ __launch_bounds__(256) void k_ln_add(const bf16_t* X, const bf16_t* Y, const float* g, const float* b, bf16_t* out) {
    const int lane = threadIdx.x & 63, row = blockIdx.x * 4 + (threadIdx.x >> 6);
    Row16 x, y; load_row_bf16(X + (size_t)row * D, lane, x); load_row_bf16(Y + (size_t)row * D, lane, y);
#pragma unroll
    for (int j = 0; j < 4; ++j)
#pragma unroll
        for (int i = 0; i < 4; ++i) x.v[j][i] = ALPHA * x.v[j][i] + y.v[j][i];
    ln_row(x, g, b, lane);
    store_row_bf16(out + (size_t)row * D, lane, x);
}
__global__ __launch_bounds__(256) void k_ln_router(const bf16_t* X, const bf16_t* Y, const float* g, const float* b, bf16_t* out, const float* rw, const float* rbias, int* eidx, float* ewgt) {
    const int lane = threadIdx.x & 63, row = blockIdx.x * 4 + (threadIdx.x >> 6);
    Row16 x, y; load_row_bf16(X + (size_t)row * D, lane, x); load_row_bf16(Y + (size_t)row * D, lane, y);
#pragma unroll
    for (int j = 0; j < 4; ++j)
#pragma unroll
        for (int i = 0; i < 4; ++i) x.v[j][i] = ALPHA * x.v[j][i] + y.v[j][i];
    ln_row(x, g, b, lane);
    store_row_bf16(out + (size_t)row * D, lane, x);
    float lg[16];
#pragma unroll
    for (int e = 0; e < 16; ++e) lg[e] = 0.f;
#pragma unroll
    for (int j = 0; j < 4; ++j)
#pragma unroll
        for (int i = 0; i < 4; ++i) {
            const float* wr = rw + (size_t)(256 * j + 4 * lane + i) * 16;
            const float xv = x.v[j][i];
#pragma unroll
            for (int e4 = 0; e4 < 4; ++e4) { const float4 w4 = *(const float4*)(wr + 4 * e4); lg[4 * e4 + 0] += xv * w4.x; lg[4 * e4 + 1] += xv * w4.y; lg[4 * e4 + 2] += xv * w4.z; lg[4 * e4 + 3] += xv * w4.w; }
        }
#pragma unroll
    for (int e = 0; e < 16; ++e) lg[e] = wave_sum(lg[e]);
    float mx = lg[0];
#pragma unroll
    for (int e = 1; e < 16; ++e) mx = fmaxf(mx, lg[e]);
    float sc[16], sum = 0.f;
#pragma unroll
    for (int e = 0; e < 16; ++e) { sc[e] = expf(lg[e] - mx); sum += sc[e]; }
    const float isum = 1.f / sum;
    float bz[16];
#pragma unroll
    for (int e = 0; e < 16; ++e) { sc[e] *= isum; bz[e] = sc[e] + rbias[e]; }
    float gs[4]; int gi1[4], gi2[4];
#pragma unroll
    for (int gq = 0; gq < 4; ++gq) {
        float m1 = bz[4 * gq]; int i1 = 0;
#pragma unroll
        for (int j = 1; j < 4; ++j) if (bz[4 * gq + j] > m1) { m1 = bz[4 * gq + j]; i1 = j; }
        float m2 = -INFINITY; int i2 = 0;
#pragma unroll
        for (int j = 0; j < 4; ++j) if (j != i1 && bz[4 * gq + j] > m2) { m2 = bz[4 * gq + j]; i2 = j; }
        gs[gq] = m1 + m2; gi1[gq] = i1; gi2[gq] = i2;
    }
    int gsel = 0; float gm = gs[0];
#pragma unroll
    for (int gq = 1; gq < 4; ++gq) if (gs[gq] > gm) { gm = gs[gq]; gsel = gq; }
    int i1 = gi1[0], i2 = gi2[0];
#pragma unroll
    for (int gq = 1; gq < 4; ++gq) if (gsel == gq) { i1 = gi1[gq]; i2 = gi2[gq]; }
    const int e1 = gsel * 4 + i1, e2 = gsel * 4 + i2;
    float s1 = 0.f, s2 = 0.f;
#pragma unroll
    for (int e = 0; e < 16; ++e) { if (e == e1) s1 = sc[e]; if (e == e2) s2 = sc[e]; }
    const float inv = 1.f / (s1 + s2);
    if (lane == 0) { eidx[2 * row] = e1; eidx[2 * row + 1] = e2; ewgt[2 * row] = s1 * inv; ewgt[2 * row + 1] = s2 * inv; }
}
__global__ __launch_bounds__(256) void k_ln_moe(const bf16_t* X, const bf16_t* DS, const int* pos, const float* ewgt, const float* g, const float* b, bf16_t* outb, float* outf) {
    const int lane = threadIdx.x & 63, row = blockIdx.x * 4 + (threadIdx.x >> 6);
    Row16 x, y1, y2; load_row_bf16(X + (size_t)row * D, lane, x);
    const int r1 = pos[2 * row], r2 = pos[2 * row + 1]; const float w1 = ewgt[2 * row], w2 = ewgt[2 * row + 1];
    load_row_bf16(DS + (size_t)r1 * D, lane, y1); load_row_bf16(DS + (size_t)r2 * D, lane, y2);
#pragma unroll
    for (int j = 0; j < 4; ++j)
#pragma unroll
        for (int i = 0; i < 4; ++i) x.v[j][i] = ALPHA * x.v[j][i] + (w1 * y1.v[j][i] + w2 * y2.v[j][i]);
    ln_row(x, g, b, lane);
    if (outb) store_row_bf16(outb + (size_t)row * D, lane, x);
    if (outf) {
#pragma unroll
        for (int j = 0; j < 4; ++j) *(float4*)(outf + (size_t)row * D + 256 * j + 4 * lane) = make_float4(x.v[j][0], x.v[j][1], x.v[j][2], x.v[j][3]);
    }
}

__global__ __launch_bounds__(256) void k_xattn(const bf16_t* Q, const bf16_t* Kb, const bf16_t* Vt, bf16_t* O) {
    const int lane = threadIdx.x & 63;
    const int w = blockIdx.x * 4 + (threadIdx.x >> 6);
    const int t = w >> 2, h = w & 3, b = t / S;
    float q[4];
    { const ushort4 u = *(const ushort4*)(Q + (size_t)t * D + h * 256 + 4 * lane); q[0] = bf2f(u.x); q[1] = bf2f(u.y); q[2] = bf2f(u.z); q[3] = bf2f(u.w); }
    float sc[4];
#pragma unroll
    for (int jj = 0; jj < 4; ++jj) {
        sc[jj] = 0.f;
        for (int jl = 0; jl < 64; ++jl) {
            const int key = jj * 64 + jl;
            const ushort4 u = *(const ushort4*)(Kb + (size_t)(b * MEM + key) * 2048 + h * 256 + 4 * lane);
            float p = q[0] * bf2f(u.x) + q[1] * bf2f(u.y) + q[2] * bf2f(u.z) + q[3] * bf2f(u.w);
            p = wave_sum(p);
            if (lane == jl) sc[jj] = p;
        }
    }
    float m = fmaxf(fmaxf(sc[0], sc[1]), fmaxf(sc[2], sc[3])); m = wave_max(m);
    float l = 0.f;
#pragma unroll
    for (int jj = 0; jj < 4; ++jj) { sc[jj] = exp2f(sc[jj] - m); l += sc[jj]; }
    l = wave_sum(l);
    const float inv = 1.f / l;
    float o[4] = {0.f, 0.f, 0.f, 0.f};
    (void)Vt;
#pragma unroll
    for (int jj = 0; jj < 4; ++jj)
        for (int jl = 0; jl < 64; ++jl) {
            const float p = __shfl(sc[jj], jl);
            const int key = jj * 64 + jl;
            const ushort4 u = *(const ushort4*)(Kb + (size_t)(b * MEM + key) * 2048 + 1024 + h * 256 + 4 * lane);
            o[0] += p * bf2f(u.x); o[1] += p * bf2f(u.y); o[2] += p * bf2f(u.z); o[3] += p * bf2f(u.w);
        }
    ushort4 u; u.x = f2bf(o[0] * inv); u.y = f2bf(o[1] * inv); u.z = f2bf(o[2] * inv); u.w = f2bf(o[3] * inv);
    *(ushort4*)(O + (size_t)t * D + h * 256 + 4 * lane) = u;
}

__global__ __launch_bounds__(256) void k_moe_hist(const int* eidx, int* bcnt) {
    __shared__ int h[16];
    if (threadIdx.x < 16) h[threadIdx.x] = 0;
    __syncthreads();
    const int e = eidx[blockIdx.x * 256 + threadIdx.x];
    atomicAdd(&h[e], 1);
    __syncthreads();
    if (threadIdx.x < 16) bcnt[blockIdx.x * 16 + threadIdx.x] = h[threadIdx.x];
}
__global__ __launch_bounds__(256) void k_moe_scatter(const int* eidx, const int* bcnt, int* tok, int* pos, int* tile_e) {
    __shared__ int es[256], dst[256], off[17], base[16], tot[16];
    const int tid = threadIdx.x, blk = blockIdx.x;
    if (tid < 16) {
        int t = 0, bs = 0;
        for (int b2 = 0; b2 < 256; ++b2) { const int c = bcnt[b2 * 16 + tid]; t += c; if (b2 < blk) bs += c; }
        tot[tid] = t; base[tid] = bs;
    }
    es[tid] = eidx[blk * 256 + tid];
    __syncthreads();
    if (tid == 0) { int o = 0; for (int e = 0; e < 16; ++e) { off[e] = o; o += (tot[e] + 255) & ~255; } off[16] = o; }
    __syncthreads();
    {
        const int e = es[tid]; int rank = 0;
        for (int j = 0; j < tid; ++j) rank += (es[j] == e) ? 1 : 0;
        const int r = off[e] + base[e] + rank;
        dst[tid] = r; pos[blk * 256 + tid] = r; tok[r] = blk * 128 + (tid >> 1);
    }
    if (blk < 16) {
        const int e = blk, r0 = off[e] + tot[e], r1 = off[e + 1];
        for (int r = r0 + tid; r < r1; r += 256) tok[r] = 0;
    }
    if (blk == 16) {
        for (int tl = tid; tl < NTILE; tl += 256) { int e = -1; for (int k = 0; k < 16; ++k) if (tl * 256 >= off[k] && tl * 256 < off[k + 1]) e = k; tile_e[tl] = e; }
        if (tid == 0) tile_e[NTILE] = off[16] >> 8;
    }
}

__global__ void k_pool(const bf16_t* HP, bf16_t* PO) {
    const size_t i = (size_t)blockIdx.x * blockDim.x + threadIdx.x;
    if (i >= (size_t)T * D) return;
    const int t = (int)(i >> 10), c = (int)(i & 1023), g = c >> 8, win = 2 << g, ts = t & (S - 1);
    const int n = ts + 1 < win ? ts + 1 : win;
    float s = 0.f;
    for (int k = 0; k < n; ++k) s += bf2f(HP[(size_t)(t - k) * D + c]);
    PO[i] = f2bf(s / (float)n - bf2f(HP[i]));
}
}

using namespace nv;
template <class Epi>
static void ngemm(hipStream_t st, const bf16_t* A, int lda, const float* W, int ldw, int M, int N, int K, Epi epi, const int* tile_e = nullptr, size_t w_stride = 0, const int* arow = nullptr) {
    hipLaunchKernelGGL((k_gemm<Epi>), dim3(N / 64, M / 64), dim3(256), 0, st, A, lda, W, ldw, K, epi, tile_e, w_stride, arow);
}

#ifndef MEGA_MASK
#define MEGA_MASK 0x3ffffffu
#endif

extern "C" void kernel_launch(void* const* d_in, const int* in_sizes, int n_in, void* d_out, int out_size, void* d_ws, size_t ws_size, hipStream_t stream) {
    (void)in_sizes; (void)out_size;
    if (ws_size < WS_END || n_in != 40) return;
    static int grid = 0;
    if (grid == 0) {
        int dev = 0, cus = 0;
        if (hipGetDevice(&dev) != hipSuccess || hipDeviceGetAttribute(&cus, hipDeviceAttributeMultiprocessorCount, dev) != hipSuccess) { grid = -1; return; }
        if (hipFuncSetAttribute((const void*)mk::mega, hipFuncAttributeMaxDynamicSharedMemorySize, mk::LDS_BYTES) != hipSuccess) { grid = -1; return; }
        int per_cu = 0;
        if (hipOccupancyMaxActiveBlocksPerMultiprocessor(&per_cu, (const void*)mk::mega, mk::NTHREADS, mk::LDS_BYTES) != hipSuccess || per_cu < 1) { (void)hipGetLastError(); }
        grid = cus;
    }
    if (grid < 0) return;
    unsigned char* ws = (unsigned char*)d_ws;
    (void)hipMemsetAsync(ws + WS_CTL, 0, 512 * 1024, stream);
    mk::Args a{};
    for (int i = 0; i < 40; ++i) a.in[i] = d_in[i];
    a.out = (float*)d_out; a.ws = ws;
    for (int j = 0; j < 8; ++j) a.inv.f[j] = (float)pow(500000.0, -(double)((float)j * 2.0f / 16.0f));
    auto F = [&](int i) { return (const float*)d_in[i]; };
    const float* router_w = F(3); const float* router_b = F(4);
    float* rope = (float*)(ws + WS_ROPE); int* eidx = (int*)(ws + WS_EIDX); float* ewgt = (float*)(ws + WS_EWGT); int* pos = (int*)(ws + WS_POS);
    int* bcnt = (int*)(ws + WS_BCNT); int* tile_e = (int*)(ws + WS_TILE); int* tok = (int*)(ws + WS_TOK);
    bf16_t* RA = (bf16_t*)(ws + WS_A); bf16_t* RB = (bf16_t*)(ws + WS_B); bf16_t* RC = (bf16_t*)(ws + WS_C); bf16_t* RD = (bf16_t*)(ws + WS_D);
    bf16_t* MEMB = (bf16_t*)(ws + WS_MEMB);
    const unsigned mask = MEGA_MASK;
    int p = 0;
    while (p < mk::NPHASE) {
        if (mask & (1u << p)) {
            int q = p; while (q < mk::NPHASE && (mask & (1u << q))) ++q;
            a.ph_lo = p; a.ph_hi = q;
            hipLaunchKernelGGL(mk::mega, dim3(grid), dim3(mk::NTHREADS), mk::LDS_BYTES, stream, a);
            p = q; continue;
        }
        const int L = p / 13, lp = p % 13, cb = L == 0 ? 12 : 28;
        bf16_t* Kb = (bf16_t*)(ws + WS_MEMKV) + (size_t)L * B * MEM * 2048; bf16_t* Vt = (bf16_t*)(ws + WS_MEMVT) + (size_t)L * B * MEM * 1024;
        bf16_t *X1 = RB, *Qb, *Ob, *Y2, *X2, *HS = RB, *DS = RD, *X3; float* G = (float*)RD;
        if (L == 0) { Qb = RA; Ob = RC; Y2 = RA; X2 = RC; X3 = RA; } else { Qb = RC; Ob = RD; Y2 = RC; X2 = RA; X3 = nullptr; }
        if (L == 0 && lp == 0) {
            hipLaunchKernelGGL(k_cvt_x, dim3(2048), dim3(256), 0, stream, F(0), RA, (size_t)T * D / 4);
            hipLaunchKernelGGL(k_cvt_x, dim3(256), dim3(256), 0, stream, F(1), MEMB, (size_t)B * MEM * D / 4);
            nv::InvFreq inv; for (int j = 0; j < 8; ++j) inv.f[j] = a.inv.f[j];
            hipLaunchKernelGGL(k_rope_table, dim3(T / 256), dim3(256), 0, stream, (const int*)d_in[2], rope, inv);
        } else if (L == 0 && lp == 1) {
            for (int l = 0; l < 2; ++l) ngemm(stream, MEMB, D, F((l == 0 ? 12 : 28) + 3), 2048, B * MEM, 2048, D, nv::EpiKV{(bf16_t*)(ws + WS_MEMKV) + (size_t)l * B * MEM * 2048, (bf16_t*)(ws + WS_MEMVT) + (size_t)l * B * MEM * 1024});
            ngemm(stream, RA, D, F(5), NIN0, T, NIN0, D, nv::EpiInproj0{RD});
            hipLaunchKernelGGL(k_rope_apply, dim3(T * 80 / 256), dim3(256), 0, stream, RD, rope);
        } else if (L == 0 && lp == 2) {
            hipLaunchKernelGGL(k_swa, dim3(B * 64 * 8), dim3(128), 0, stream, RD, F(6), RB);
            hipLaunchKernelGGL(k_sgu_ln, dim3(T * 8 / 256), dim3(256), 0, stream, RD, F(7), F(8), RC);
            hipLaunchKernelGGL(k_sgu_mix, dim3(T * 512 / 256), dim3(256), 0, stream, RD, RC, F(9), F(10), RB);
        } else if (L == 0 && lp == 3) { ngemm(stream, RB, D, F(11), D, T, D, D, nv::EpiBf16{RC, D, 1.f});
        } else if (L == 0 && lp == 4) { hipLaunchKernelGGL(k_ln_add, dim3(T / 4), dim3(256), 0, stream, RA, RC, F(12), F(13), RB);
        } else if (L == 1 && lp == 0) { ngemm(stream, RA, D, F(24), D, T, D, D, nv::EpiBf16{RB, D, 1.f});
        } else if (L == 1 && lp == 1) { hipLaunchKernelGGL(k_pool, dim3(T * D / 256), dim3(256), 0, stream, RB, RC);
        } else if (L == 1 && lp == 2) { for (int g = 0; g < 4; ++g) ngemm(stream, RC + g * 256, D, F(25) + (size_t)g * 256 * 256, 256, T, 256, 256, nv::EpiPoolMap{RD, F(26), g * 256});
        } else if (L == 1 && lp == 3) { ngemm(stream, RD, D, F(27), D, T, D, D, nv::EpiBf16{RC, D, 1.f});
        } else if (L == 1 && lp == 4) { hipLaunchKernelGGL(k_ln_add, dim3(T / 4), dim3(256), 0, stream, RA, RC, F(28), F(29), RB);
        } else if (lp == 5) { ngemm(stream, X1, D, F(cb + 2), D, T, D, D, nv::EpiBf16{Qb, D, QSCALE});
        } else if (lp == 6) { hipLaunchKernelGGL(k_xattn, dim3(T * XH / 4), dim3(256), 0, stream, Qb, Kb, Vt, Ob);
        } else if (lp == 7) { ngemm(stream, Ob, D, F(cb + 4), D, T, D, D, nv::EpiBf16{Y2, D, 1.f});
        } else if (lp == 8) {
            hipLaunchKernelGGL(k_ln_router, dim3(T / 4), dim3(256), 0, stream, X1, Y2, F(cb + 5), F(cb + 6), X2, router_w, router_b, eidx, ewgt);
            hipLaunchKernelGGL(k_moe_hist, dim3(256), dim3(256), 0, stream, eidx, bcnt);
        } else if (lp == 9) { hipLaunchKernelGGL(k_moe_scatter, dim3(256), dim3(256), 0, stream, eidx, bcnt, tok, pos, tile_e);
        } else if (lp == 10) {
            ngemm(stream, X2, D, F(cb + 7), DE, MPAD, DE, D, nv::EpiF32{G, DE}, tile_e, (size_t)D * DE, tok);
            ngemm(stream, X2, D, F(cb + 8), DE, MPAD, DE, D, nv::EpiSiluMul{G, HS}, tile_e, (size_t)D * DE, tok);
        } else if (lp == 11) { ngemm(stream, HS, DE, F(cb + 9), D, MPAD, D, DE, nv::EpiBf16{DS, D, 1.f}, tile_e, (size_t)DE * D);
        } else if (lp == 12) { hipLaunchKernelGGL(k_ln_moe, dim3(T / 4), dim3(256), 0, stream, X2, DS, pos, ewgt, F(cb + 10), F(cb + 11), X3, L == 1 ? (float*)d_out : nullptr);
        }
        ++p;
    }
}
```

```cpp
#include <hip/hip_runtime.h>
#include <stdint.h>
#include <math.h>

typedef unsigned short bf16_t;

namespace nv {
constexpr int B = 4, S = 8192, T = B * S, D = 1024;
constexpr int NIN0 = 1792;
constexpr int MEM = 256, XH = 4, XHD = 256;
constexpr int NE = 16, DE = 512;
constexpr int MPAD = 65536 + 16 * 256;
constexpr int NTILE = MPAD / 256;
constexpr float ALPHA = 1.4142135623730951f;
constexpr float LN_EPS = 1e-5f;
constexpr float QSCALE = 0.0625f * 1.4426950408889634f;
constexpr float ASCALE = 0.125f * 1.4426950408889634f;

constexpr size_t MiB = 1u << 20;
constexpr size_t WS_CTL = 0;
constexpr size_t WS_ROPE = 2 * MiB;
constexpr size_t WS_EIDX = 4 * MiB;
constexpr size_t WS_EWGT = 5 * MiB;
constexpr size_t WS_POS = 6 * MiB;
constexpr size_t WS_BCNT = 7 * MiB;
constexpr size_t WS_TILE = 7 * MiB + 65536;
constexpr size_t WS_TOK = 7 * MiB + 131072;
constexpr size_t WS_MEMKV = 8 * MiB;
constexpr size_t WS_MEMVT = 16 * MiB;
constexpr size_t WS_MEMB = 20 * MiB;
constexpr size_t WS_WB = 24 * MiB;
constexpr size_t WS_A = 152 * MiB, WS_B = 220 * MiB, WS_C = 288 * MiB, WS_D = 356 * MiB, WS_END = 492 * MiB;
constexpr size_t WB_IN0 = 0;
constexpr size_t WB_OUT0 = WB_IN0 + (size_t)1792 * 1024;
constexpr size_t WB_IN1 = WB_OUT0 + (size_t)1024 * 1024;
constexpr size_t WB_POOL = WB_IN1 + (size_t)1024 * 1024;
constexpr size_t WB_OUT1 = WB_POOL + (size_t)1024 * 256;
constexpr size_t WB_SGUW = WB_OUT1 + (size_t)1024 * 1024;
constexpr size_t WB_LAYER = WB_SGUW + (size_t)8 * 128 * 128;
constexpr size_t WL_XQ = 0;
constexpr size_t WL_XKV = WL_XQ + (size_t)1024 * 1024;
constexpr size_t WL_XO = WL_XKV + (size_t)2048 * 1024;
constexpr size_t WL_GU = WL_XO + (size_t)1024 * 1024;
constexpr size_t WL_DN = WL_GU + (size_t)16 * 1024 * 1024;
constexpr size_t WL_SIZE = WL_DN + (size_t)16 * 1024 * 512;
static_assert((WB_LAYER + 2 * WL_SIZE) * 2 <= 128 * MiB, "bf16 weight region");

__device__ __forceinline__ float bf2f(bf16_t v) { return __uint_as_float((unsigned)v << 16); }
__device__ __forceinline__ bf16_t f2bf(float f) { unsigned u = __float_as_uint(f); return (bf16_t)((u + 0x7fffu + ((u >> 16) & 1u)) >> 16); }
__device__ __forceinline__ float gelu_tanh(float x) { const float u = 0.7978845608028654f * (x + 0.044715f * x * x * x); const float e = __expf(2.f * u); const float th = 1.f - 2.f / (e + 1.f); return 0.5f * x * (1.f + th); }
__device__ __forceinline__ float silu(float x) { return x / (1.f + __expf(-x)); }
template <int M> __device__ __forceinline__ float swz_xor(float v) { return __int_as_float(__builtin_amdgcn_ds_swizzle(__float_as_int(v), (M << 10) | 0x1f)); }
__device__ __forceinline__ float wave_sum(float v) {
    v += swz_xor<1>(v); v += swz_xor<2>(v); v += swz_xor<4>(v); v += swz_xor<8>(v); v += swz_xor<16>(v);
    const auto r = __builtin_amdgcn_permlane32_swap(__float_as_uint(v), __float_as_uint(v), false, false);
    return __uint_as_float(r[0]) + __uint_as_float(r[1]);
}
__device__ __forceinline__ float wave_max(float v) {
    v = fmaxf(v, swz_xor<1>(v)); v = fmaxf(v, swz_xor<2>(v)); v = fmaxf(v, swz_xor<4>(v)); v = fmaxf(v, swz_xor<8>(v)); v = fmaxf(v, swz_xor<16>(v));
    const auto r = __builtin_amdgcn_permlane32_swap(__float_as_uint(v), __float_as_uint(v), false, false);
    return fmaxf(__uint_as_float(r[0]), __uint_as_float(r[1]));
}
}

namespace pg8 {
#define PG8_LAS __attribute__((address_space(3)))
typedef short bf16x8 __attribute__((ext_vector_type(8)));
typedef float f32x4 __attribute__((ext_vector_type(4)));
typedef float f32x2 __attribute__((ext_vector_type(2)));
typedef unsigned u32x4 __attribute__((ext_vector_type(4)));
typedef unsigned u32x2 __attribute__((ext_vector_type(2)));
constexpr int BM = 256, BK = 64, HALF = 128, HTB = HALF * BK * 2  , STAGE_BYTES = 8 * HTB, NXCD = 8, WGM = 8;

__host__ __device__ __forceinline__ int lds_byte(int r, int c) { const int st = (r >> 4) * 2 + (c >> 5), rr = r & 15, cc = c & 31, ob = rr * 64 + cc * 2; return st * 1024 + (ob ^ (((ob >> 9) & 1) << 5)); }
__host__ __device__ __forceinline__ void stage_rc(int b, int& R, int& C) { const int st = b / 1024, sb = b % 1024, swz = sb ^ (((sb >> 9) & 1) << 5); R = (st >> 1) * 16 + swz / 64; C = (st & 1) * 32 + (swz % 64) / 2; }
__host__ __device__ __forceinline__ int perm32(int rho) { const int n = rho >> 4, i = rho & 15; return 8 * (i >> 2) + 4 * n + (i & 3); }

struct Unit { int pm, pn, pb; };
struct Gemm { const bf16_t* A; const bf16_t* Bt; const int* arow; };

struct StaticOrder {
    int nM, nN, nwg, G, c;
    __device__ void init(int M, int N, int G_, int c_) { nM = M / BM; nN = N / BM; nwg = nM * nN; G = G_; c = c_; }
    __device__ bool next(int i, Unit& u) const {
        const long L = (long)i * G + c; if (L >= nwg) return false;
        int wgid = (int)L; { const int q = nwg / NXCD, r = nwg % NXCD, xcd = wgid % NXCD, off = wgid / NXCD; wgid = (xcd < r ? xcd * (q + 1) : r * (q + 1) + (xcd - r) * q) + off; }
        const int nig = WGM * nN, gid = wgid / nig, fm = gid * WGM, gsz = (nM - fm) < WGM ? (nM - fm) : WGM;
        u.pm = fm + ((wgid % nig) % gsz); u.pn = (wgid % nig) / gsz; u.pb = u.pn; return true;
    }
};
struct MoeOrder {
    int nM, nwg, G, c; const int* tile_e;
    __device__ void init(int ntiles, const int* te, int G_, int c_) { nM = ntiles; nwg = nM * 4; G = G_; c = c_; tile_e = te; }
    __device__ bool next(int i, Unit& u) const {
        const long L = (long)i * G + c; if (L >= nwg) return false;
        int wgid = (int)L; { const int q = nwg / NXCD, r = nwg % NXCD, xcd = wgid % NXCD, off = wgid / NXCD; wgid = (xcd < r ? xcd * (q + 1) : r * (q + 1) + (xcd - r) * q) + off; }
        const int nig = WGM * 4, gid = wgid / nig, fm = gid * WGM, gsz = (nM - fm) < WGM ? (nM - fm) : WGM;
        u.pm = fm + ((wgid % nig) % gsz); u.pn = (wgid % nig) / gsz;
        const int e = __builtin_amdgcn_readfirstlane(tile_e[u.pm]); u.pb = e * 4 + u.pn; return true;
    }
};

__device__ __forceinline__ unsigned cvt_pk_bf16(float lo, float hi) { unsigned r; asm volatile("v_cvt_pk_bf16_f32 %0, %1, %2" : "=v"(r) : "v"(lo), "v"(hi)); return r; }


template <class Epi, class Sched, bool ALIGN_EPI, bool SP2, bool GATHER, int LDA, int LDB, int KK, int APN>
__device__ __forceinline__ void gemm_phase(PG8_LAS unsigned char* lds, int tid_in, const Gemm g, const Sched& S, const Epi& E) {
    int tid_ = tid_in; asm volatile("" : "+v"(tid_));
    const int tid = tid_, wid = __builtin_amdgcn_readfirstlane(tid >> 6), lane = tid & 63, wr = wid >> 2, wc = wid & 3, fr = lane & 15, fq = lane >> 4;
    constexpr int K = KK, nt = K / BK, lda = LDA, ldb = LDB; (void)K;
    unsigned voffA[2], voffB[2]; int rowA[2];
#pragma unroll
    for (int i = 0; i < 2; ++i) { int R, C; stage_rc(tid * 16 + i * 8192, R, C); const int Rb = Epi::PERM ? ((R & ~31) + perm32(R & 31)) : R;
        voffA[i] = GATHER ? (unsigned)C * 2u : (unsigned)(R * lda + C) * 2u; voffB[i] = (unsigned)(Rb * ldb + C) * 2u; rowA[i] = R; }
    const size_t kstep = (size_t)(BK * 2);
    const size_t hstepA = GATHER ? 0 : (size_t)HALF * lda * 2, hstepB = (size_t)HALF * ldb * 2;
    const size_t tstepA = (size_t)BM * lda * 2, tstepB = 2 * hstepB;
    const unsigned ldsw = (unsigned)wid * 1024u;
    const int aoff = lds_byte(wr * 64 + fr, fq * 8), boff = lds_byte(wc * 32 + fr, fq * 8);
    unsigned cg[2][2], ng[2][2], og[2][2];
#define PG8_SA(b, h) (((b) * 2 + (h)) * HTB)
#define PG8_SB(b, h) ((4 + (b) * 2 + (h)) * HTB)
#define PG8_STAGE(bufoff, gbase, voff) do { _Pragma("unroll") for (int _i = 0; _i < 2; ++_i) \
        __builtin_amdgcn_global_load_lds((const unsigned*)((const char*)(gbase) + (voff)[_i]), (PG8_LAS unsigned*)(lds + (bufoff) + ldsw + _i * 8192), 16, 0, 0); } while (0)
#define PG8_STAGE_A(bufoff, abase, h, GO) do { _Pragma("unroll") for (int _i = 0; _i < 2; ++_i) { \
        const char* _s = (const char*)(abase) + ((h) ? hstepA : (size_t)0) + voffA[_i]; if constexpr (GATHER) _s += GO[h][_i]; \
        __builtin_amdgcn_global_load_lds((const unsigned*)_s, (PG8_LAS unsigned*)(lds + (bufoff) + ldsw + _i * 8192), 16, 0, 0); } } while (0)
#define PG8_GLOAD(dst, pm_) do { _Pragma("unroll") for (int _h = 0; _h < 2; ++_h) _Pragma("unroll") for (int _i = 0; _i < 2; ++_i) \
        dst[_h][_i] = (unsigned)g.arow[(pm_) * BM + _h * HALF + rowA[_i]] * (unsigned)(lda * 2); } while (0)
#define PG8_LDA(dst, b, h) do { _Pragma("unroll") for (int m = 0; m < 4; ++m) _Pragma("unroll") for (int k = 0; k < 2; ++k) dst[m][k] = *(const PG8_LAS bf16x8*)(lds + PG8_SA(b, h) + aoff + m * 2048 + k * 1024); } while (0)
#define PG8_LDB(dst, b, h) do { _Pragma("unroll") for (int n = 0; n < 2; ++n) _Pragma("unroll") for (int k = 0; k < 2; ++k) dst[n][k] = *(const PG8_LAS bf16x8*)(lds + PG8_SB(b, h) + boff + n * 2048 + k * 1024); } while (0)
#define PG8_MMA(ai, bj, At, Bt) do { __builtin_amdgcn_s_setprio(1); _Pragma("unroll") for (int m = 0; m < 4; ++m) _Pragma("unroll") for (int n = 0; n < 2; ++n) _Pragma("unroll") for (int k = 0; k < 2; ++k) \
        acc[ai][bj][m][n] = __builtin_amdgcn_mfma_f32_16x16x32_bf16(Bt[n][k], At[m][k], acc[ai][bj][m][n], 0, 0, 0); __builtin_amdgcn_s_setprio(0); } while (0)
#define PG8_WAIT_V(n) asm volatile("s_waitcnt vmcnt(" #n ")" ::: "memory")
#define PG8_WAIT_L(n) asm volatile("s_waitcnt lgkmcnt(" #n ")" ::: "memory")
#define PG8_BAR __builtin_amdgcn_s_barrier()
#define PG8_SCHED __builtin_amdgcn_sched_barrier(0)
    Unit cur, nxt; int ui = 0;
    if (!S.next(0, cur)) return;
    f32x4 acc[2][2][4][2];
#pragma unroll
    for (int a = 0; a < 2; ++a)
#pragma unroll
        for (int b = 0; b < 2; ++b)
#pragma unroll
            for (int m = 0; m < 4; ++m)
#pragma unroll
                for (int n = 0; n < 2; ++n) acc[a][b][m][n] = (f32x4){0.f, 0.f, 0.f, 0.f};
    bf16x8 At[4][2], B0[2][2], B1[2][2];
    const char* cA = GATHER ? (const char*)g.A : (const char*)g.A + (size_t)cur.pm * tstepA + (size_t)cur.pn * APN * 2; const char* cB = (const char*)g.Bt + (size_t)cur.pb * tstepB;
    if constexpr (GATHER) { PG8_GLOAD(cg, cur.pm); }
    if constexpr (SP2) {
        PG8_STAGE(PG8_SB(0, 0), cB, voffB); PG8_STAGE(PG8_SB(0, 1), cB + hstepB, voffB); PG8_STAGE_A(PG8_SA(0, 0), cA, 0, cg); PG8_STAGE_A(PG8_SA(0, 1), cA, 1, cg);
        if (wr == 1) PG8_BAR;
        PG8_WAIT_V(2); PG8_BAR;
        PG8_STAGE(PG8_SB(1, 0), cB + kstep, voffB); PG8_STAGE_A(PG8_SA(1, 0), cA + kstep, 0, cg); PG8_STAGE(PG8_SB(1, 1), cB + hstepB + kstep, voffB);
        PG8_WAIT_V(6); PG8_BAR;
    } else {
        PG8_STAGE(PG8_SB(0, 0), cB, voffB); PG8_STAGE_A(PG8_SA(0, 0), cA, 0, cg); PG8_STAGE(PG8_SB(0, 1), cB + hstepB, voffB); PG8_STAGE_A(PG8_SA(0, 1), cA, 1, cg);
        if (wr == 1) PG8_BAR;
        PG8_WAIT_V(4); PG8_BAR;
        PG8_STAGE(PG8_SB(1, 0), cB + kstep, voffB); PG8_STAGE_A(PG8_SA(1, 0), cA + kstep, 0, cg); PG8_STAGE(PG8_SB(1, 1), cB + hstepB + kstep, voffB);
        PG8_WAIT_V(6); PG8_BAR;
    }
    for (;;) {
        const bool has_next = S.next(ui + 1, nxt);
        const char* nA = GATHER ? (const char*)g.A : (has_next ? (const char*)g.A + (size_t)nxt.pm * tstepA + (size_t)nxt.pn * APN * 2 : cA);
        const char* nB = has_next ? (const char*)g.Bt + (size_t)nxt.pb * tstepB : cB;
        if constexpr (GATHER) { if (has_next) { PG8_GLOAD(ng, nxt.pm); } else {
#pragma unroll
            for (int _h = 0; _h < 2; ++_h)
#pragma unroll
                for (int _i = 0; _i < 2; ++_i) ng[_h][_i] = cg[_h][_i]; } }
#pragma unroll 1
        for (int t = 0; t < nt; t += 2) {
            const bool last = (t == nt - 2);
            const char* a1 = cA + (size_t)(t + 1) * kstep;
            const char* a2 = last ? nA : cA + (size_t)(t + 2) * kstep; const char* b2 = last ? nB : cB + (size_t)(t + 2) * kstep;
            const char* a3 = a2 + kstep; const char* b3 = b2 + kstep;
            if constexpr (GATHER) {
#pragma unroll
                for (int _h = 0; _h < 2; ++_h)
#pragma unroll
                    for (int _i = 0; _i < 2; ++_i) og[_h][_i] = last ? ng[_h][_i] : cg[_h][_i]; }
            if constexpr (SP2) {
            PG8_LDB(B0, 0, 0); PG8_LDB(B1, 0, 1); PG8_SCHED; PG8_LDA(At, 0, 0); PG8_STAGE_A(PG8_SA(1, 1), a1, 1, cg);
            PG8_WAIT_V(8); PG8_WAIT_L(0); PG8_BAR; PG8_MMA(0, 0, At, B0); PG8_MMA(0, 1, At, B1); PG8_BAR; PG8_SCHED;
            PG8_LDA(At, 0, 1); PG8_STAGE(PG8_SB(0, 0), b2, voffB); PG8_STAGE(PG8_SB(0, 1), b2 + hstepB, voffB); PG8_STAGE_A(PG8_SA(0, 0), a2, 0, og);
            PG8_WAIT_V(8); PG8_WAIT_L(0); PG8_BAR; PG8_MMA(1, 0, At, B0); PG8_MMA(1, 1, At, B1); PG8_BAR; PG8_SCHED;
            PG8_LDB(B0, 1, 0); PG8_LDB(B1, 1, 1); PG8_SCHED; PG8_LDA(At, 1, 0); PG8_STAGE_A(PG8_SA(0, 1), a2, 1, og);
            PG8_WAIT_V(8); PG8_WAIT_L(0); PG8_BAR; PG8_MMA(0, 0, At, B0); PG8_MMA(0, 1, At, B1); PG8_BAR; PG8_SCHED;
            PG8_LDA(At, 1, 1); PG8_STAGE(PG8_SB(1, 0), b3, voffB); PG8_STAGE(PG8_SB(1, 1), b3 + hstepB, voffB); PG8_STAGE_A(PG8_SA(1, 0), a3, 0, og);
            PG8_WAIT_V(8); PG8_WAIT_L(0); PG8_BAR; PG8_MMA(1, 0, At, B0); PG8_MMA(1, 1, At, B1); PG8_BAR; PG8_SCHED;
            } else {
            PG8_LDB(B0, 0, 0); PG8_SCHED; PG8_LDA(At, 0, 0); PG8_STAGE_A(PG8_SA(1, 1), a1, 1, cg);
            PG8_WAIT_L(8); PG8_BAR; PG8_WAIT_L(0); PG8_MMA(0, 0, At, B0); PG8_BAR; PG8_SCHED;
            PG8_LDB(B1, 0, 1); PG8_STAGE(PG8_SB(0, 0), b2, voffB);
            PG8_BAR; PG8_WAIT_L(0); PG8_MMA(0, 1, At, B1); PG8_BAR;
            PG8_LDA(At, 0, 1); PG8_STAGE_A(PG8_SA(0, 0), a2, 0, og);
            PG8_BAR; PG8_WAIT_L(0); PG8_MMA(1, 0, At, B0); PG8_BAR; PG8_SCHED;
            PG8_STAGE(PG8_SB(0, 1), b2 + hstepB, voffB);
            PG8_WAIT_V(6); PG8_BAR; PG8_MMA(1, 1, At, B1); PG8_BAR;
            PG8_LDB(B0, 1, 0); PG8_SCHED; PG8_LDA(At, 1, 0); PG8_STAGE_A(PG8_SA(0, 1), a2, 1, og);
            PG8_WAIT_L(8); PG8_BAR; PG8_WAIT_L(0); PG8_MMA(0, 0, At, B0); PG8_BAR; PG8_SCHED;
            PG8_LDB(B1, 1, 1); PG8_STAGE(PG8_SB(1, 0), b3, voffB);
            PG8_BAR; PG8_WAIT_L(0); PG8_MMA(0, 1, At, B1); PG8_BAR;
            PG8_LDA(At, 1, 1); PG8_STAGE_A(PG8_SA(1, 0), a3, 0, og);
            PG8_BAR; PG8_WAIT_L(0); PG8_MMA(1, 0, At, B0); PG8_BAR; PG8_SCHED;
            PG8_STAGE(PG8_SB(1, 1), b3 + hstepB, voffB);
            PG8_WAIT_V(6); PG8_BAR; PG8_MMA(1, 1, At, B1); PG8_BAR;
            }
        }
        if constexpr (ALIGN_EPI) { if (wr == 0) PG8_BAR; }
        E(acc, cur, wr, wc, fr, fq);
        if (!has_next) break;
#pragma unroll
        for (int a = 0; a < 2; ++a)
#pragma unroll
            for (int b = 0; b < 2; ++b)
#pragma unroll
                for (int m = 0; m < 4; ++m)
#pragma unroll
                    for (int n = 0; n < 2; ++n) acc[a][b][m][n] = (f32x4){0.f, 0.f, 0.f, 0.f};
        cur = nxt; cA = nA; cB = nB; ++ui;
        if constexpr (GATHER) {
#pragma unroll
            for (int _h = 0; _h < 2; ++_h)
#pragma unroll
                for (int _i = 0; _i < 2; ++_i) cg[_h][_i] = ng[_h][_i]; }
        if constexpr (ALIGN_EPI) { if (wr == 1) PG8_BAR; }
    }
    PG8_WAIT_V(0);
    if constexpr (!ALIGN_EPI) { if (wr == 0) PG8_BAR; }
    PG8_BAR;
#undef PG8_SA
#undef PG8_SB
#undef PG8_STAGE
#undef PG8_STAGE_A
#undef PG8_GLOAD
#undef PG8_LDA
#undef PG8_LDB
#undef PG8_MMA
#undef PG8_WAIT_V
#undef PG8_WAIT_L
#undef PG8_BAR
#undef PG8_SCHED
}
}
namespace pg8 {

__device__ __forceinline__ float fast_sigmoid_mul(float x, float z) { return x * __builtin_amdgcn_rcpf(1.f + __builtin_amdgcn_exp2f(-1.4426950408889634f * z)); }
__device__ __forceinline__ float gelu_t(float x) { const float u = 0.7978845608028654f * (x + 0.044715f * x * x * x); return fast_sigmoid_mul(x, 2.f * u); }
__device__ __forceinline__ float silu_f(float x) { return fast_sigmoid_mul(x, x); }
__device__ __forceinline__ u32x4 pack8(const f32x4 v0, const f32x4 v1) { u32x4 w; w.x = cvt_pk_bf16(v0[0], v0[1]); w.y = cvt_pk_bf16(v0[2], v0[3]); w.z = cvt_pk_bf16(v1[0], v1[1]); w.w = cvt_pk_bf16(v1[2], v1[3]); return w; }

struct EpiBf16 {
    static constexpr bool PERM = true;
    bf16_t* O; int ldo; float scale;
    __device__ __forceinline__ void operator()(const f32x4 (&acc)[2][2][4][2], const Unit& u, int wr, int wc, int fr, int fq) const {
        const int row0 = u.pm * BM + wr * 64 + fr, col0 = u.pn * BM + wc * 32 + 8 * fq;
#pragma unroll
        for (int ai = 0; ai < 2; ++ai)
#pragma unroll
            for (int m = 0; m < 4; ++m) { bf16_t* rowp = O + (size_t)(row0 + ai * HALF + m * 16) * ldo + col0;
#pragma unroll
                for (int bj = 0; bj < 2; ++bj) *(u32x4*)(rowp + bj * HALF) = pack8(acc[ai][bj][m][0] * scale, acc[ai][bj][m][1] * scale); }
    }
};
struct EpiPoolMap {
    static constexpr bool PERM = true;
    bf16_t* O; const float* cscale;
    __device__ __forceinline__ void operator()(const f32x4 (&acc)[2][2][4][2], const Unit& u, int wr, int wc, int fr, int fq) const {
        const int row0 = u.pm * BM + wr * 64 + fr, col0 = u.pn * BM + wc * 32 + 8 * fq;
        f32x4 sc[2][2];
#pragma unroll
        for (int bj = 0; bj < 2; ++bj)
#pragma unroll
            for (int n = 0; n < 2; ++n) sc[bj][n] = *(const f32x4*)(cscale + col0 + bj * HALF + 4 * n);
#pragma unroll
        for (int ai = 0; ai < 2; ++ai)
#pragma unroll
            for (int m = 0; m < 4; ++m) { bf16_t* rowp = O + (size_t)(row0 + ai * HALF + m * 16) * nv::D + col0;
#pragma unroll
                for (int bj = 0; bj < 2; ++bj) *(u32x4*)(rowp + bj * HALF) = pack8(acc[ai][bj][m][0] * sc[bj][0], acc[ai][bj][m][1] * sc[bj][1]); }
    }
};
struct EpiGU {
    static constexpr bool PERM = true;
    bf16_t* HS;
    __device__ __forceinline__ void operator()(const f32x4 (&acc)[2][2][4][2], const Unit& u, int wr, int wc, int fr, int fq) const {
        const int row0 = u.pm * BM + wr * 64 + fr, col0 = u.pn * HALF + wc * 32 + 8 * fq;
#pragma unroll
        for (int ai = 0; ai < 2; ++ai)
#pragma unroll
            for (int m = 0; m < 4; ++m) { bf16_t* rowp = HS + (size_t)(row0 + ai * HALF + m * 16) * nv::DE + col0;
                f32x4 h0, h1;
#pragma unroll
                for (int j = 0; j < 4; ++j) { h0[j] = silu_f(acc[ai][0][m][0][j]) * acc[ai][1][m][0][j]; h1[j] = silu_f(acc[ai][0][m][1][j]) * acc[ai][1][m][1][j]; }
                *(u32x4*)rowp = pack8(h0, h1); }
    }
};
struct EpiKV {
    static constexpr bool PERM = true;
    bf16_t* Kb; bf16_t* Vt;
    __device__ __forceinline__ void operator()(const f32x4 (&acc)[2][2][4][2], const Unit& u, int wr, int wc, int fr, int fq) const {
        const int row0 = u.pm * BM + wr * 64 + fr, col0 = u.pn * BM + wc * 32 + 8 * fq;
#pragma unroll
        for (int ai = 0; ai < 2; ++ai)
#pragma unroll
            for (int m = 0; m < 4; ++m) { bf16_t* rowp = Kb + (size_t)(row0 + ai * HALF + m * 16) * 2048 + col0;
#pragma unroll
                for (int bj = 0; bj < 2; ++bj) *(u32x4*)(rowp + bj * HALF) = pack8(acc[ai][bj][m][0], acc[ai][bj][m][1]); }
        if (u.pn >= 4) {
            const int h = u.pn - 4, b = u.pm;
            bf16_t* vb = Vt + (size_t)(b * nv::XH + h) * nv::XHD * nv::MEM;
#pragma unroll
            for (int ai = 0; ai < 2; ++ai)
#pragma unroll
                for (int m = 0; m < 4; ++m) { const int key = ai * HALF + wr * 64 + m * 16 + fr;
#pragma unroll
                    for (int bj = 0; bj < 2; ++bj)
#pragma unroll
                        for (int n = 0; n < 2; ++n)
#pragma unroll
                            for (int j = 0; j < 4; ++j) { const int dd = bj * HALF + wc * 32 + 8 * fq + 4 * n + j; vb[(size_t)dd * nv::MEM + key] = nv::f2bf(acc[ai][bj][m][n][j]); } }
        }
    }
};
struct EpiInproj0 {
    static constexpr bool PERM = true;
    bf16_t* O; const float* rope;
    __device__ __forceinline__ void operator()(const f32x4 (&acc)[2][2][4][2], const Unit& u, int wr, int wc, int fr, int fq) const {
        const int row0 = u.pm * BM + wr * 64 + fr, col0 = u.pn * BM + wc * 32 + 8 * fq;
        if (u.pn >= 3) {
#pragma unroll
            for (int ai = 0; ai < 2; ++ai)
#pragma unroll
                for (int m = 0; m < 4; ++m) { bf16_t* rowp = O + (size_t)(row0 + ai * HALF + m * 16) * nv::NIN0 + col0;
#pragma unroll
                    for (int bj = 0; bj < 2; ++bj) { f32x4 v0 = acc[ai][bj][m][0], v1 = acc[ai][bj][m][1];
#pragma unroll
                        for (int j = 0; j < 4; ++j) { v0[j] = gelu_t(v0[j]); v1[j] = gelu_t(v1[j]); }
                        *(u32x4*)(rowp + bj * HALF) = pack8(v0, v1); } }
        } else {
            const bool wave_rope = (wc & 1) == 0;
            const float sgn = fq == 0 ? -1.f : 1.f;
#pragma unroll
            for (int ai = 0; ai < 2; ++ai)
#pragma unroll
                for (int m = 0; m < 4; ++m) { const int row = row0 + ai * HALF + m * 16; bf16_t* rowp = O + (size_t)row * nv::NIN0 + col0;
                    f32x4 c0, c1, s0, s1;
                    if (wave_rope) { const float* rp = rope + (size_t)row * 16; c0 = *(const f32x4*)rp; c1 = *(const f32x4*)(rp + 4); s0 = *(const f32x4*)(rp + 8); s1 = *(const f32x4*)(rp + 12); }
#pragma unroll
                    for (int bj = 0; bj < 2; ++bj) { f32x4 v0 = acc[ai][bj][m][0], v1 = acc[ai][bj][m][1];
                        if (wave_rope && (u.pn < 2 || bj == 0)) {
                            f32x4 p0, p1;
#pragma unroll
                            for (int j = 0; j < 4; ++j) { p0[j] = nv::swz_xor<16>(v0[j]); p1[j] = nv::swz_xor<16>(v1[j]); }
                            if (fq < 2) {
#pragma unroll
                                for (int j = 0; j < 4; ++j) { v0[j] = v0[j] * c0[j] + sgn * p0[j] * s0[j]; v1[j] = v1[j] * c1[j] + sgn * p1[j] * s1[j]; } }
                        }
                        *(u32x4*)(rowp + bj * HALF) = pack8(v0, v1); } }
        }
    }
};
}

#define LAS __attribute__((address_space(3)))
#define GAS __attribute__((address_space(1)))
typedef GAS unsigned gu32;
#define RLX_AGENT __ATOMIC_RELAXED, __HIP_MEMORY_SCOPE_AGENT
#define LDS_WAIT() asm volatile("s_waitcnt lgkmcnt(0)" ::: "memory")
#define VM_WAIT() asm volatile("s_waitcnt vmcnt(0)" ::: "memory")

#define XB_TMO      128
#define XB_XCNT(j)  (256  + 64 * (j))
#define XB_XSUB(j)  (1280 + 64 * (j))
#define XB_XGEN(j)  (2304 + 64 * (j))
#define XB_TOP      3328
#define XB_TOPGEN   3392
#define XCD_BAR_WORDS 3456
#define XB_SPIN_CAP (1u << 18)
__device__ __forceinline__ unsigned xb_ld(unsigned* p)              { return __hip_atomic_load(p, __ATOMIC_RELAXED, __HIP_MEMORY_SCOPE_AGENT); }
__device__ __forceinline__ unsigned xb_add(unsigned* p, unsigned v) { return __hip_atomic_fetch_add(p, v, __ATOMIC_RELAXED, __HIP_MEMORY_SCOPE_AGENT); }
__device__ __forceinline__ unsigned xb_xcc_id() { return (unsigned)__builtin_amdgcn_s_getreg((3 << 11) | 20) & 0xFu; }
#define XB_SPIN(cond, bar) do { unsigned _sp = 0; while (cond) { __builtin_amdgcn_s_sleep(1); \
    if ((++_sp & 255u) == 0u) { if (xb_ld(&(bar)[XB_TMO])) break; if (_sp > XB_SPIN_CAP) { atomicAdd(&(bar)[XB_TMO], 1u); break; } } } } while (0)
struct XcdBarrier { unsigned* bar; unsigned x; volatile LAS unsigned* st; int wave; };
__device__ __forceinline__ unsigned lane_id_fresh() { unsigned m = ~0u; asm volatile("" : "+s"(m)); return __builtin_amdgcn_mbcnt_hi(m, __builtin_amdgcn_mbcnt_lo(m, 0u)); }
__device__ __forceinline__ bool xb_thread0(int wave) { return wave == 0 && lane_id_fresh() == 0u; }
__device__ __forceinline__ XcdBarrier xcd_barrier_post(unsigned* bar, volatile LAS unsigned* st, int wave) {
    XcdBarrier b; b.bar = bar; b.x = xb_xcc_id(); b.st = st; b.wave = wave;
    if (xb_thread0(wave)) (void)xb_add(&bar[XB_XCNT(b.x)], 1u);
    return b;
}
__device__ __forceinline__ void xcd_barrier_complete(unsigned* bar, unsigned x, unsigned& nloc, unsigned& nx) {
    const unsigned G = gridDim.x * gridDim.y * gridDim.z;
    unsigned sum, cnt, mine, sp = 0u;
    for (;;) {
        sum = 0u; cnt = 0u; mine = 0u;
#pragma unroll
        for (unsigned j = 0; j < 16; ++j) { const unsigned c = xb_ld(&bar[XB_XCNT(j)]); sum += c; cnt += (c > 0u) ? 1u : 0u; mine = (j == x) ? c : mine; }
        if (sum == G) break;
        __builtin_amdgcn_s_sleep(1);
        if ((++sp & 255u) == 0u) { if (xb_ld(&bar[XB_TMO])) break; if (sp > XB_SPIN_CAP) { atomicAdd(&bar[XB_TMO], 1u); break; } }
    }
    nloc = mine > 0u ? mine : 1u; nx = cnt > 0u ? cnt : 1u;
}
__device__ __forceinline__ void xcd_barrier(const XcdBarrier& b) {
    asm volatile("s_waitcnt vmcnt(0)" ::: "memory");
    __syncthreads();
    if (xb_thread0(b.wave)) {
        unsigned* bar = b.bar;
        __builtin_amdgcn_s_waitcnt(0);
        unsigned nloc = b.st[0], nx = b.st[1];
        if (nloc == 0u) { xcd_barrier_complete(bar, b.x, nloc, nx); b.st[0] = nloc; b.st[1] = nx; }
        const unsigned old = xb_add(&bar[XB_XSUB(b.x)], 1u);
        const unsigned gen = old / nloc;
        if (old + 1u == (gen + 1u) * nloc) {
            __builtin_amdgcn_fence(__ATOMIC_RELEASE, "agent");
            asm volatile("s_waitcnt vmcnt(0)" ::: "memory");
            const unsigned og = xb_add(&bar[XB_TOP], 1u);
            const unsigned tg = og / nx;
            if (og + 1u == (tg + 1u) * nx) xb_add(&bar[XB_TOPGEN], 1u);
            else XB_SPIN(xb_ld(&bar[XB_TOPGEN]) == tg, bar);
            __builtin_amdgcn_fence(__ATOMIC_ACQUIRE, "agent");
            xb_add(&bar[XB_XGEN(b.x)], 1u);
            asm volatile("s_waitcnt vmcnt(0)" ::: "memory");
        } else {
            XB_SPIN(xb_ld(&bar[XB_XGEN(b.x)]) == gen, bar);
            __builtin_amdgcn_fence(__ATOMIC_ACQUIRE, "agent");
            asm volatile("s_waitcnt vmcnt(0)" ::: "memory");
        }
    }
    __syncthreads();
}

namespace mk {
using namespace nv;
typedef unsigned v4u __attribute__((ext_vector_type(4)));
typedef unsigned v2u __attribute__((ext_vector_type(2)));
typedef float f32x4 __attribute__((ext_vector_type(4)));
constexpr int NWAVES = 8, NTHREADS = 512;
constexpr int LDS_BYTES = 160 * 1024;
constexpr int MISC_OFF = LDS_BYTES - 256;
constexpr int CW_BAR = 4096;
constexpr size_t CTL_ZERO_BYTES = 64 * 1024;

__device__ __forceinline__ unsigned pk2(float lo, float hi) { return (unsigned)f2bf(lo) | ((unsigned)f2bf(hi) << 16); }

struct Frame {
    LAS unsigned char* lds; int tid, lane, wave, vcu, G, bx;
};

__device__ __forceinline__ void transpose_item(const float* W, int ldw, bf16_t* WT, int ldt, int k0, int n0, int dest_row0, LAS float* scr, int lane, const float* nscale = nullptr) {
    const float sc = nscale ? nscale[n0 + (lane & 31)] : 1.f;
#pragma unroll 8
    for (int i = 0; i < 32; ++i) { const int kk = 2 * i + (lane >> 5); scr[kk * 33 + (lane & 31)] = W[(size_t)(k0 + kk) * ldw + n0 + (lane & 31)] * sc; }
    LDS_WAIT(); asm volatile("" ::: "memory");
    const int c = lane & 7;
#pragma unroll
    for (int j = 0; j < 4; ++j) { const int n = (lane >> 3) + 8 * j; const LAS float* s = scr + (8 * c) * 33 + n;
        v4u o; o.x = pk2(s[0 * 33], s[1 * 33]); o.y = pk2(s[2 * 33], s[3 * 33]); o.z = pk2(s[4 * 33], s[5 * 33]); o.w = pk2(s[6 * 33], s[7 * 33]);
        *(v4u*)(WT + (size_t)(dest_row0 + n) * ldt + k0 + 8 * c) = o; }
    LDS_WAIT(); asm volatile("" ::: "memory");
}
template <int MAP>
__device__ __forceinline__ void transpose_job_item(const float* src, int K, int N, bf16_t* dst, size_t dstb, int r, LAS float* scr, int lane, const float* nscale = nullptr) {
    const int nblk = N / 32, per = (K / 64) * nblk, bi = r / per, it = r % per, kb = it / nblk, nb = it % nblk, n0 = 32 * nb;
    int dr = n0; if (MAP == 1) dr = (n0 >> 7) * 256 + (n0 & 127); if (MAP == 2) dr = (n0 >> 7) * 256 + 128 + (n0 & 127);
    transpose_item(src + (size_t)bi * K * N, N, dst + (size_t)bi * dstb, K, 64 * kb, n0, dr, scr, lane, nscale ? nscale + (size_t)bi * N : nullptr);
}

struct InvFreq { float f[8]; };
struct Args {
    const void* in[40]; float* out; unsigned char* ws; InvFreq inv; int ph_lo, ph_hi;
};

struct RowV { float v[16]; };
__device__ __forceinline__ void unpk8(const v4u u, float* x) {
    x[0] = __uint_as_float(u.x << 16); x[1] = __uint_as_float(u.x & 0xffff0000u); x[2] = __uint_as_float(u.y << 16); x[3] = __uint_as_float(u.y & 0xffff0000u);
    x[4] = __uint_as_float(u.z << 16); x[5] = __uint_as_float(u.z & 0xffff0000u); x[6] = __uint_as_float(u.w << 16); x[7] = __uint_as_float(u.w & 0xffff0000u);
}
struct RowRaw { v4u a, b; };
__device__ __forceinline__ RowRaw load_raw(const bf16_t* p, int lane) { RowRaw r; r.a = *(const v4u*)(p + 8 * lane); r.b = *(const v4u*)(p + 512 + 8 * lane); return r; }
__device__ __forceinline__ void unpack_row(const RowRaw& r, RowV& x) { unpk8(r.a, x.v); unpk8(r.b, x.v + 8); }
struct GB { float g[16], b[16]; };
__device__ __forceinline__ void load_gb(const float* g, const float* b, int lane, GB& o) {
#pragma unroll
    for (int hh = 0; hh < 2; ++hh)
#pragma unroll
        for (int q = 0; q < 2; ++q) { const float4 gg = *(const float4*)(g + 512 * hh + 8 * lane + 4 * q), bb = *(const float4*)(b + 512 * hh + 8 * lane + 4 * q);
            o.g[8 * hh + 4 * q + 0] = gg.x; o.g[8 * hh + 4 * q + 1] = gg.y; o.g[8 * hh + 4 * q + 2] = gg.z; o.g[8 * hh + 4 * q + 3] = gg.w;
            o.b[8 * hh + 4 * q + 0] = bb.x; o.b[8 * hh + 4 * q + 1] = bb.y; o.b[8 * hh + 4 * q + 2] = bb.z; o.b[8 * hh + 4 * q + 3] = bb.w; }
}
__device__ __forceinline__ void ln_rowv(RowV& z, const GB& gb) {
    float s = 0.f;
#pragma unroll
    for (int i = 0; i < 16; ++i) s += z.v[i];
    const float mu = wave_sum(s) * (1.f / D);
    float q = 0.f;
#pragma unroll
    for (int i = 0; i < 16; ++i) { z.v[i] -= mu; q += z.v[i] * z.v[i]; }
    const float rstd = 1.f / sqrtf(wave_sum(q) * (1.f / D) + LN_EPS);
#pragma unroll
    for (int i = 0; i < 16; ++i) z.v[i] = z.v[i] * rstd * gb.g[i] + gb.b[i];
}
__device__ __forceinline__ void store_rowv_bf16(bf16_t* p, int lane, const RowV& r) {
    v4u a, b; a.x = pk2(r.v[0], r.v[1]); a.y = pk2(r.v[2], r.v[3]); a.z = pk2(r.v[4], r.v[5]); a.w = pk2(r.v[6], r.v[7]);
    b.x = pk2(r.v[8], r.v[9]); b.y = pk2(r.v[10], r.v[11]); b.z = pk2(r.v[12], r.v[13]); b.w = pk2(r.v[14], r.v[15]);
    *(v4u*)(p + 8 * lane) = a; *(v4u*)(p + 512 + 8 * lane) = b;
}
constexpr int LNR = 4;

__device__ __forceinline__ void phase_ln_add(const Frame& F, const bf16_t* X, const bf16_t* Y, const float* g, const float* b, bf16_t* out) {
    const int gw = F.vcu * NWAVES + F.wave, NGW = F.G * NWAVES;
    GB gb; load_gb(g, b, F.lane, gb);
    for (int row = gw; row < T; row += LNR * NGW) {
        RowRaw rx[LNR], ry[LNR];
#pragma unroll
        for (int k = 0; k < LNR; ++k) { const int rr = row + k * NGW; if (rr < T) { rx[k] = load_raw(X + (size_t)rr * D, F.lane); ry[k] = load_raw(Y + (size_t)rr * D, F.lane); } }
#pragma unroll
        for (int k = 0; k < LNR; ++k) { const int rr = row + k * NGW; if (rr < T) {
            RowV x, y; unpack_row(rx[k], x); unpack_row(ry[k], y);
#pragma unroll
            for (int i = 0; i < 16; ++i) x.v[i] = ALPHA * x.v[i] + y.v[i];
            ln_rowv(x, gb);
            store_rowv_bf16(out + (size_t)rr * D, F.lane, x); } }
    }
}
__device__ __forceinline__ void phase_ln_moe(const Frame& F, const bf16_t* X, const bf16_t* DS, const int* pos, const float* ewgt, const float* g, const float* b, bf16_t* outb, float* outf) {
    const int gw = F.vcu * NWAVES + F.wave, NGW = F.G * NWAVES;
    GB gb; load_gb(g, b, F.lane, gb);
    for (int row = gw; row < T; row += LNR * NGW) {
        RowRaw rx[LNR], r1[LNR], r2[LNR]; float w1[LNR], w2[LNR];
#pragma unroll
        for (int k = 0; k < LNR; ++k) { const int rr = row + k * NGW; if (rr < T) {
            const int2 pp = *(const int2*)(pos + 2 * rr); const float2 ww = *(const float2*)(ewgt + 2 * rr); w1[k] = ww.x; w2[k] = ww.y;
            rx[k] = load_raw(X + (size_t)rr * D, F.lane); r1[k] = load_raw(DS + (size_t)pp.x * D, F.lane); r2[k] = load_raw(DS + (size_t)pp.y * D, F.lane); } }
#pragma unroll
        for (int k = 0; k < LNR; ++k) { const int rr = row + k * NGW; if (rr < T) {
            RowV x, y1, y2; unpack_row(rx[k], x); unpack_row(r1[k], y1); unpack_row(r2[k], y2);
#pragma unroll
            for (int i = 0; i < 16; ++i) x.v[i] = ALPHA * x.v[i] + (w1[k] * y1.v[i] + w2[k] * y2.v[i]);
            ln_rowv(x, gb);
            if (outb) store_rowv_bf16(outb + (size_t)rr * D, F.lane, x);
            if (outf) { float* o = outf + (size_t)rr * D + 8 * F.lane;
                *(float4*)(o) = make_float4(x.v[0], x.v[1], x.v[2], x.v[3]); *(float4*)(o + 4) = make_float4(x.v[4], x.v[5], x.v[6], x.v[7]);
                *(float4*)(o + 512) = make_float4(x.v[8], x.v[9], x.v[10], x.v[11]); *(float4*)(o + 516) = make_float4(x.v[12], x.v[13], x.v[14], x.v[15]); } } }
    }
}
constexpr int RW_LD = 20;
__device__ __forceinline__ void phase_ln_router(const Frame& F, const bf16_t* X, const bf16_t* Y, const float* g, const float* b, bf16_t* out, const float* rw, const float* rbias, int* eidx, float* ewgt, int* bcnt) {
    LAS float* rwl = (LAS float*)F.lds;
    LAS int* hist = (LAS int*)(F.lds + 1024 * RW_LD * 4);
    LAS float* lgs = (LAS float*)(F.lds + 1024 * RW_LD * 4 + 256) + F.wave * 64;
    for (int i = F.tid; i < 1024 * 4; i += NTHREADS) { const int k = i >> 2, q = i & 3; const float4 v = *(const float4*)(rw + (size_t)k * 16 + 4 * q);
        const int j = (k >> 9) * 8 + (k & 7), l = (k >> 3) & 63; LAS float* d = rwl + (j * 64 + l) * RW_LD + 4 * q; d[0] = v.x; d[1] = v.y; d[2] = v.z; d[3] = v.w; }
    GB gb; load_gb(g, b, F.lane, gb);
    const int lane = F.lane;
    for (int vb = F.vcu; vb < T / 128; vb += F.G) {
        if (F.tid < 16) hist[F.tid] = 0;
        __syncthreads();
#pragma unroll 1
        for (int it = 0; it < 4; ++it) {
            const int row0 = vb * 128 + F.wave * 16 + it * 4;
            RowRaw rx[4], ry[4];
#pragma unroll
            for (int k = 0; k < 4; ++k) { rx[k] = load_raw(X + (size_t)(row0 + k) * D, lane); ry[k] = load_raw(Y + (size_t)(row0 + k) * D, lane); }
            RowV x[4];
#pragma unroll
            for (int k = 0; k < 4; ++k) { RowV y; unpack_row(rx[k], x[k]); unpack_row(ry[k], y);
#pragma unroll
                for (int i = 0; i < 16; ++i) x[k].v[i] = ALPHA * x[k].v[i] + y.v[i];
                ln_rowv(x[k], gb);
                store_rowv_bf16(out + (size_t)(row0 + k) * D, lane, x[k]); }
            float val[64];
#pragma unroll
            for (int i = 0; i < 64; ++i) val[i] = 0.f;
#pragma unroll
            for (int j = 0; j < 16; ++j) { const LAS float* wr = rwl + (j * 64 + lane) * RW_LD;
#pragma unroll
                for (int e4 = 0; e4 < 4; ++e4) { const f32x4 w4 = *(const LAS f32x4*)(wr + 4 * e4);
#pragma unroll
                    for (int k = 0; k < 4; ++k) { const float xv = x[k].v[j];
                        val[16 * k + 4 * e4 + 0] += xv * w4[0]; val[16 * k + 4 * e4 + 1] += xv * w4[1]; val[16 * k + 4 * e4 + 2] += xv * w4[2]; val[16 * k + 4 * e4 + 3] += xv * w4[3]; } } }
#pragma unroll
            for (int i = 0; i < 32; ++i) { const auto rr = __builtin_amdgcn_permlane32_swap(__float_as_uint(val[i]), __float_as_uint(val[i + 32]), false, false); val[i] = __uint_as_float(rr[0]) + __uint_as_float(rr[1]); }
            { const bool bt = (lane & 16) != 0;
#pragma unroll
              for (int i = 0; i < 16; ++i) { const float keep = bt ? val[i + 16] : val[i], send = bt ? val[i] : val[i + 16]; val[i] = keep + swz_xor<16>(send); } }
            { const bool bt = (lane & 8) != 0;
#pragma unroll
              for (int i = 0; i < 8; ++i) { const float keep = bt ? val[i + 8] : val[i], send = bt ? val[i] : val[i + 8]; val[i] = keep + swz_xor<8>(send); } }
            { const bool bt = (lane & 4) != 0;
#pragma unroll
              for (int i = 0; i < 4; ++i) { const float keep = bt ? val[i + 4] : val[i], send = bt ? val[i] : val[i + 4]; val[i] = keep + swz_xor<4>(send); } }
            { const bool bt = (lane & 2) != 0;
#pragma unroll
              for (int i = 0; i < 2; ++i) { const float keep = bt ? val[i + 2] : val[i], send = bt ? val[i] : val[i + 2]; val[i] = keep + swz_xor<2>(send); } }
            { const bool bt = (lane & 1) != 0; const float keep = bt ? val[1] : val[0], send = bt ? val[0] : val[1]; val[0] = keep + swz_xor<1>(send); }
            lgs[lane] = val[0];
            LDS_WAIT();
            if (lane < 4) {
                const int row = row0 + lane;
                float lg[16];
#pragma unroll
                for (int e4 = 0; e4 < 4; ++e4) { const f32x4 t4 = *(const LAS f32x4*)(lgs + 16 * lane + 4 * e4); lg[4 * e4] = t4[0]; lg[4 * e4 + 1] = t4[1]; lg[4 * e4 + 2] = t4[2]; lg[4 * e4 + 3] = t4[3]; }
                float mx = lg[0];
#pragma unroll
                for (int e = 1; e < 16; ++e) mx = fmaxf(mx, lg[e]);
                float sc[16], sum = 0.f;
#pragma unroll
                for (int e = 0; e < 16; ++e) { sc[e] = __expf(lg[e] - mx); sum += sc[e]; }
                const float isum = 1.f / sum;
                float bz[16];
#pragma unroll
                for (int e = 0; e < 16; ++e) { sc[e] *= isum; bz[e] = sc[e] + rbias[e]; }
                float gs[4]; int gi1[4], gi2[4];
#pragma unroll
                for (int gq = 0; gq < 4; ++gq) {
                    float m1 = bz[4 * gq]; int i1 = 0;
#pragma unroll
                    for (int j = 1; j < 4; ++j) if (bz[4 * gq + j] > m1) { m1 = bz[4 * gq + j]; i1 = j; }
                    float m2 = -INFINITY; int i2 = 0;
#pragma unroll
                    for (int j = 0; j < 4; ++j) if (j != i1 && bz[4 * gq + j] > m2) { m2 = bz[4 * gq + j]; i2 = j; }
                    gs[gq] = m1 + m2; gi1[gq] = i1; gi2[gq] = i2;
                }
                int gsel = 0; float gm = gs[0];
#pragma unroll
                for (int gq = 1; gq < 4; ++gq) if (gs[gq] > gm) { gm = gs[gq]; gsel = gq; }
                int i1 = gi1[0], i2 = gi2[0];
#pragma unroll
                for (int gq = 1; gq < 4; ++gq) if (gsel == gq) { i1 = gi1[gq]; i2 = gi2[gq]; }
                const int e1 = gsel * 4 + i1, e2 = gsel * 4 + i2;
                float s1 = 0.f, s2 = 0.f;
#pragma unroll
                for (int e = 0; e < 16; ++e) { if (e == e1) s1 = sc[e]; if (e == e2) s2 = sc[e]; }
                const float inv = 1.f / (s1 + s2);
                *(int2*)(eidx + 2 * row) = make_int2(e1, e2); *(float2*)(ewgt + 2 * row) = make_float2(s1 * inv, s2 * inv);
                atomicAdd((int*)&hist[e1], 1); atomicAdd((int*)&hist[e2], 1);
            }
        }
        __syncthreads();
        if (F.tid < 16) bcnt[vb * 16 + F.tid] = hist[F.tid];
        __syncthreads();
    }
}
__device__ __forceinline__ void phase_moe_book(const Frame& F, const int* eidx, const int* bcnt, int* tok, int* pos, int* tile_e) {
    LAS int* bc = (LAS int*)F.lds;
    LAS int* es = bc + 4096;
    LAS int* off = es + 256;
    LAS int* base = off + 32;
    LAS int* tot = base + 16;
    for (int i = F.tid; i < 4096; i += NTHREADS) bc[i] = bcnt[i];
    __syncthreads();
    for (int vb = F.vcu; vb < T / 128; vb += F.G) {
        if (F.tid < 16) { int t = 0, bs = 0; for (int b2 = 0; b2 < 256; ++b2) { const int c = bc[b2 * 16 + F.tid]; t += c; if (b2 < vb) bs += c; } tot[F.tid] = t; base[F.tid] = bs; }
        if (F.tid < 256) es[F.tid] = eidx[vb * 256 + F.tid];
        __syncthreads();
        if (F.tid == 0) { int o = 0; for (int e = 0; e < 16; ++e) { off[e] = o; o += (tot[e] + 255) & ~255; } off[16] = o; }
        __syncthreads();
        if (F.tid < 256) {
            const int e = es[F.tid]; int rank = 0;
            for (int j = 0; j < F.tid; ++j) rank += (es[j] == e) ? 1 : 0;
            const int r = off[e] + base[e] + rank;
            pos[vb * 256 + F.tid] = r; tok[r] = vb * 128 + (F.tid >> 1);
        }
        if (vb < 16) { const int e = vb, r0 = off[e] + tot[e], r1 = off[e + 1]; for (int r = r0 + F.tid; r < r1; r += NTHREADS) tok[r] = 0; }
        if (vb == 16) {
            for (int tl = F.tid; tl < NTILE; tl += NTHREADS) { int e = -1; for (int k = 0; k < 16; ++k) if (tl * 256 >= off[k] && tl * 256 < off[k + 1]) e = k; tile_e[tl] = e; }
            if (F.tid == 0) tile_e[NTILE] = off[16] >> 8;
        }
        __syncthreads();
    }
}
__device__ __forceinline__ void phase_pool(const Frame& F, const bf16_t* HP, bf16_t* PO) {
    constexpr int RUN = 32;
    const int gt = F.vcu * NTHREADS + F.tid, NGT = F.G * NTHREADS;
    for (int it = gt; it < (T / RUN) * (D / 8); it += NGT) {
        const int c8 = it & 127, run = it >> 7, g = c8 >> 5, win = 2 << g, t0 = run * RUN, ts0 = t0 & (S - 1);
        const bf16_t* hp = HP + (size_t)t0 * D + c8 * 8; bf16_t* po = PO + (size_t)t0 * D + c8 * 8;
        float s[8];
#pragma unroll
        for (int q = 0; q < 8; ++q) s[q] = 0.f;
        for (int k = 1; k < win; ++k) if (ts0 - k >= 0) { float v[8]; unpk8(*(const v4u*)(hp - (ptrdiff_t)k * D), v);
#pragma unroll
            for (int q = 0; q < 8; ++q) s[q] += v[q]; }
#pragma unroll 4
        for (int i = 0; i < RUN; ++i) {
            float hn[8]; unpk8(*(const v4u*)(hp + (size_t)i * D), hn);
            const int ts = ts0 + i;
#pragma unroll
            for (int q = 0; q < 8; ++q) s[q] += hn[q];
            const float inv = 1.f / (float)(ts + 1 < win ? ts + 1 : win);
            v4u o; o.x = pk2(s[0] * inv - hn[0], s[1] * inv - hn[1]); o.y = pk2(s[2] * inv - hn[2], s[3] * inv - hn[3]); o.z = pk2(s[4] * inv - hn[4], s[5] * inv - hn[5]); o.w = pk2(s[6] * inv - hn[6], s[7] * inv - hn[7]);
            *(v4u*)(po + (size_t)i * D) = o;
            if (ts + 1 >= win) { float ho[8]; unpk8(*(const v4u*)(hp + (ptrdiff_t)(i + 1 - win) * D), ho);
#pragma unroll
                for (int q = 0; q < 8; ++q) s[q] -= ho[q]; }
        }
    }
}
}
namespace mk {
typedef short bf16x8 __attribute__((ext_vector_type(8)));
typedef float f32x16 __attribute__((ext_vector_type(16)));
#define MFMA32(a, b, c) __builtin_amdgcn_mfma_f32_32x32x16_bf16((a), (b), (c), 0, 0, 0)
__device__ __forceinline__ int crow(int i, int h) { return (i & 3) + 8 * (i >> 2) + 4 * h; }
__device__ __forceinline__ float swap32_max(float v) { const auto r = __builtin_amdgcn_permlane32_swap(__float_as_uint(v), __float_as_uint(v), false, false); return fmaxf(__uint_as_float(r[0]), __uint_as_float(r[1])); }
__device__ __forceinline__ float swap32_sum(float v) { const auto r = __builtin_amdgcn_permlane32_swap(__float_as_uint(v), __float_as_uint(v), false, false); return __uint_as_float(r[0]) + __uint_as_float(r[1]); }
__device__ __forceinline__ unsigned pkbf(float lo, float hi) { unsigned r; asm volatile("v_cvt_pk_bf16_f32 %0, %1, %2" : "=v"(r) : "v"(lo), "v"(hi)); return r; }
__device__ __forceinline__ bf16x8 pack_step(const f32x16& x, int s) {
    v4u p; p.x = pkbf(x[8 * s + 0], x[8 * s + 1]); p.y = pkbf(x[8 * s + 2], x[8 * s + 3]); p.z = pkbf(x[8 * s + 4], x[8 * s + 5]); p.w = pkbf(x[8 * s + 6], x[8 * s + 7]);
    return __builtin_bit_cast(bf16x8, p);
}
__device__ __forceinline__ bf16x8 lds_frag2x8(const LAS unsigned char* p) {
    const v2u a = *(const LAS v2u*)p, b = *(const LAS v2u*)(p + 16);
    v4u q; q.x = a.x; q.y = a.y; q.z = b.x; q.w = b.y; return __builtin_bit_cast(bf16x8, q);
}
__device__ __forceinline__ void unpack8(const v4u u, float (&x)[8]) {
    x[0] = __uint_as_float(u.x << 16); x[1] = __uint_as_float(u.x & 0xffff0000u); x[2] = __uint_as_float(u.y << 16); x[3] = __uint_as_float(u.y & 0xffff0000u);
    x[4] = __uint_as_float(u.z << 16); x[5] = __uint_as_float(u.z & 0xffff0000u); x[6] = __uint_as_float(u.w << 16); x[7] = __uint_as_float(u.w & 0xffff0000u);
}

__device__ __forceinline__ void phase_swa_sgu(const Frame& F, const bf16_t* H0, const float* sinks, const float* lng, const float* lnb, const bf16_t* SW, const float* bs, bf16_t* MIX) {
    constexpr int KSTR = 272, VSTR = 520, VT_OFF = 256 * KSTR, VGSTR = 272, VGW = 64 * VGSTR;
    LAS unsigned char* KS = F.lds; LAS unsigned char* VT = F.lds + VT_OFF;
    const int lane = F.lane, r = lane & 31, h = lane >> 5, w = F.wave, kvh = w >> 2;
    const float NEG = -INFINITY;
    for (int vb = F.vcu; vb < T / 128; vb += F.G) {
        const int n = vb & 63; const size_t row0 = (size_t)vb * 128;
#pragma unroll
        for (int i = 0; i < 8; ++i) { const int p = F.tid + NTHREADS * i, row = p >> 4, c16 = p & 15; v4u v = (v4u){0u, 0u, 0u, 0u};
            if (n > 0 || row >= 128) v = *(const v4u*)(H0 + (row0 + row - 128) * NIN0 + 512 + c16 * 8);
            *(LAS v4u*)(KS + row * KSTR + c16 * 16) = v; }
#pragma unroll
        for (int i = 0; i < 8; ++i) { const int p = F.tid + NTHREADS * i, c16 = p >> 8, row = p & 255; v4u v = (v4u){0u, 0u, 0u, 0u};
            if (n > 0 || row >= 128) v = *(const v4u*)(H0 + (row0 + row - 128) * NIN0 + 640 + c16 * 8);
            LAS bf16_t* d = (LAS bf16_t*)(VT + (c16 * 8) * VSTR + row * 2);
            d[0 * (VSTR / 2)] = (bf16_t)(v.x & 0xffffu); d[1 * (VSTR / 2)] = (bf16_t)(v.x >> 16); d[2 * (VSTR / 2)] = (bf16_t)(v.y & 0xffffu); d[3 * (VSTR / 2)] = (bf16_t)(v.y >> 16);
            d[4 * (VSTR / 2)] = (bf16_t)(v.z & 0xffffu); d[5 * (VSTR / 2)] = (bf16_t)(v.z >> 16); d[6 * (VSTR / 2)] = (bf16_t)(v.w & 0xffffu); d[7 * (VSTR / 2)] = (bf16_t)(v.w >> 16); }
        __syncthreads();
        const float sink2 = sinks[w] * 1.4426950408889634f;
#pragma unroll 1
        for (int qg = 0; qg < 4; ++qg) {
            bf16x8 qf[4];
            { const bf16_t* qp = H0 + (row0 + 32 * qg + r) * NIN0 + w * 64 + 8 * h;
#pragma unroll
              for (int ks = 0; ks < 4; ++ks) qf[ks] = *(const bf16x8*)(qp + 16 * ks); }
            f32x16 st[5];
#pragma unroll
            for (int kt = 0; kt < 5; ++kt) {
#pragma unroll
                for (int i = 0; i < 16; ++i) st[kt][i] = 0.f;
                const LAS unsigned char* kp = KS + (32 * qg + 32 * kt + r) * KSTR + (kvh * 64 + 8 * h) * 2;
#pragma unroll
                for (int ks = 0; ks < 4; ++ks) { const bf16x8 kf = *(const LAS bf16x8*)(kp + 32 * ks); st[kt] = MFMA32(kf, qf[ks], st[kt]); }
            }
            float m = sink2;
#pragma unroll
            for (int kt = 0; kt < 5; ++kt)
#pragma unroll
                for (int i = 0; i < 16; ++i) { const int dk = 32 * kt + crow(i, h) - r;
                    const bool valid = dk >= 1 && dk <= 128 && (n > 0 || (32 * qg + 32 * kt + crow(i, h)) >= 128);
                    const float s = valid ? st[kt][i] * ASCALE : NEG; st[kt][i] = s; m = fmaxf(m, s); }
            m = swap32_max(m);
            float l = 0.f;
#pragma unroll
            for (int kt = 0; kt < 5; ++kt)
#pragma unroll
                for (int i = 0; i < 16; ++i) { const float p = __builtin_amdgcn_exp2f(st[kt][i] - m); st[kt][i] = p; l += p; }
            l = swap32_sum(l) + __builtin_amdgcn_exp2f(sink2 - m);
            f32x16 o[2];
#pragma unroll
            for (int i = 0; i < 16; ++i) { o[0][i] = 0.f; o[1][i] = 0.f; }
#pragma unroll
            for (int kt = 0; kt < 5; ++kt)
#pragma unroll
                for (int s = 0; s < 2; ++s) { const bf16x8 pf = pack_step(st[kt], s);
#pragma unroll
                    for (int dt = 0; dt < 2; ++dt) { const bf16x8 vf = lds_frag2x8(VT + (kvh * 64 + 32 * dt + r) * VSTR + (32 * qg + 32 * kt + 16 * s + 4 * h) * 2); o[dt] = MFMA32(vf, pf, o[dt]); } }
            const float inv = 1.f / l;
            bf16_t* op = MIX + (row0 + 32 * qg + r) * D + w * 64 + 4 * h;
#pragma unroll
            for (int dt = 0; dt < 2; ++dt)
#pragma unroll
                for (int g4 = 0; g4 < 4; ++g4) { v2u u; u.x = pkbf(o[dt][4 * g4 + 0] * inv, o[dt][4 * g4 + 1] * inv); u.y = pkbf(o[dt][4 * g4 + 2] * inv, o[dt][4 * g4 + 3] * inv); *(v2u*)(op + 32 * dt + 8 * g4) = u; }
        }
        __syncthreads();
        {
            LAS unsigned char* VG = F.lds + w * VGW; const int g = w;
#pragma unroll 1
            for (int it = 0; it < 2; ++it) { const int s = 64 * it + lane; const bf16_t* vp = H0 + (row0 + s) * NIN0 + 1280 + g * 64;
                float x[8][8]; float sum = 0.f;
#pragma unroll
                for (int cq = 0; cq < 8; ++cq) { unpack8(*(const v4u*)(vp + 8 * cq), x[cq]);
#pragma unroll
                    for (int e = 0; e < 8; ++e) sum += x[cq][e]; }
                const float mu = sum * (1.f / 64.f); float q = 0.f;
#pragma unroll
                for (int cq = 0; cq < 8; ++cq)
#pragma unroll
                    for (int e = 0; e < 8; ++e) { x[cq][e] -= mu; q += x[cq][e] * x[cq][e]; }
                const float rstd = 1.f / sqrtf(q * (1.f / 64.f) + LN_EPS);
#pragma unroll
                for (int cq = 0; cq < 8; ++cq)
#pragma unroll
                    for (int e = 0; e < 8; ++e) { const int c = 8 * cq + e; *(LAS bf16_t*)(VG + c * VGSTR + s * 2) = f2bf(x[cq][e] * rstd * lng[g * 64 + c] + lnb[g * 64 + c]); }
            }
            LDS_WAIT();
#pragma unroll 1
            for (int tt = 0; tt < 4; ++tt) {
                f32x16 acc[2];
#pragma unroll
                for (int i = 0; i < 16; ++i) { acc[0][i] = 0.f; acc[1][i] = 0.f; }
                const bf16_t* wp = SW + ((size_t)(g * 128 + 32 * tt + r) * 128 + 8 * h);
                for (int ks = 0; ks < 2 * (tt + 1); ++ks) { const bf16x8 bfr = *(const bf16x8*)(wp + 16 * ks);
#pragma unroll
                    for (int ct = 0; ct < 2; ++ct) { const bf16x8 af = *(const LAS bf16x8*)(VG + (32 * ct + r) * VGSTR + (16 * ks + 8 * h) * 2); acc[ct] = MFMA32(af, bfr, acc[ct]); } }
                const int t = 32 * tt + r; const float bias = bs[g * 128 + t];
                const bf16_t* up = H0 + (row0 + t) * NIN0 + 768 + g * 64 + 4 * h; bf16_t* op = MIX + (row0 + t) * D + 512 + g * 64 + 4 * h;
#pragma unroll
                for (int ct = 0; ct < 2; ++ct)
#pragma unroll
                    for (int g4 = 0; g4 < 4; ++g4) { const v2u uu = *(const v2u*)(up + 32 * ct + 8 * g4);
                        const float u0 = __uint_as_float(uu.x << 16), u1 = __uint_as_float(uu.x & 0xffff0000u), u2 = __uint_as_float(uu.y << 16), u3 = __uint_as_float(uu.y & 0xffff0000u);
                        v2u o2; o2.x = pkbf(u0 * (acc[ct][4 * g4 + 0] + bias), u1 * (acc[ct][4 * g4 + 1] + bias)); o2.y = pkbf(u2 * (acc[ct][4 * g4 + 2] + bias), u3 * (acc[ct][4 * g4 + 3] + bias));
                        *(v2u*)(op + 32 * ct + 8 * g4) = o2; }
            }
        }
        __syncthreads();
    }
}

__device__ __forceinline__ void phase_xattn(const Frame& F, const bf16_t* Qb, const bf16_t* Kb, const bf16_t* Vt, bf16_t* Ob) {
    constexpr int KSTR = 528, VSTR = 520;
    LAS unsigned char* KS = F.lds;
    const int lane = F.lane, r = lane & 31, h5 = lane >> 5, w = F.wave;
    for (int u = F.vcu; u < B * XH * (S / 256); u += F.G) {
        const int b = u >> 7, hd = (u >> 5) & 3, qt = u & 31;
#pragma unroll
        for (int i = 0; i < 16; ++i) { const int p = F.tid + NTHREADS * i, row = p >> 5, c = p & 31;
            const v4u v = *(const v4u*)(Kb + (size_t)(b * MEM + row) * 2048 + hd * 256 + c * 8); *(LAS v4u*)(KS + row * KSTR + c * 16) = v; }
        __syncthreads();
        const size_t qrow = (size_t)b * S + qt * 256 + 32 * w + r;
        f32x16 st[8];
#pragma unroll
        for (int kt = 0; kt < 8; ++kt)
#pragma unroll
            for (int i = 0; i < 16; ++i) st[kt][i] = 0.f;
        { const bf16_t* qp = Qb + qrow * D + hd * 256 + 8 * h5;
#pragma unroll 4
          for (int ks = 0; ks < 16; ++ks) { const bf16x8 qf = *(const bf16x8*)(qp + 16 * ks);
#pragma unroll
              for (int kt = 0; kt < 8; ++kt) { const bf16x8 kf = *(const LAS bf16x8*)(KS + (32 * kt + r) * KSTR + (16 * ks + 8 * h5) * 2); st[kt] = MFMA32(kf, qf, st[kt]); } } }
        float m = -INFINITY;
#pragma unroll
        for (int kt = 0; kt < 8; ++kt)
#pragma unroll
            for (int i = 0; i < 16; ++i) m = fmaxf(m, st[kt][i]);
        m = swap32_max(m);
        float l = 0.f;
#pragma unroll
        for (int kt = 0; kt < 8; ++kt)
#pragma unroll
            for (int i = 0; i < 16; ++i) { const float p = __builtin_amdgcn_exp2f(st[kt][i] - m); st[kt][i] = p; l += p; }
        l = swap32_sum(l);
        bf16x8 pf[8][2];
#pragma unroll
        for (int kt = 0; kt < 8; ++kt) { pf[kt][0] = pack_step(st[kt], 0); pf[kt][1] = pack_step(st[kt], 1); }
        __syncthreads();
        { const bf16_t* vsrc = Vt + (size_t)(b * XH + hd) * XHD * MEM;
#pragma unroll
          for (int i = 0; i < 16; ++i) { const int p = F.tid + NTHREADS * i, row = p >> 5, c = p & 31;
              const v4u v = *(const v4u*)(vsrc + (size_t)row * MEM + c * 8); LAS v2u* d = (LAS v2u*)(KS + row * VSTR + c * 16); d[0] = (v2u){v.x, v.y}; d[1] = (v2u){v.z, v.w}; } }
        __syncthreads();
        const float inv = 1.f / l;
        bf16_t* op = Ob + qrow * D + hd * 256 + 4 * h5;
#pragma unroll 1
        for (int half = 0; half < 2; ++half) {
            f32x16 o[4];
#pragma unroll
            for (int dt = 0; dt < 4; ++dt)
#pragma unroll
                for (int i = 0; i < 16; ++i) o[dt][i] = 0.f;
#pragma unroll
            for (int kt = 0; kt < 8; ++kt)
#pragma unroll
                for (int s = 0; s < 2; ++s)
#pragma unroll
                    for (int dt = 0; dt < 4; ++dt) { const bf16x8 vf = lds_frag2x8(KS + (128 * half + 32 * dt + r) * VSTR + (32 * kt + 16 * s + 4 * h5) * 2); o[dt] = MFMA32(vf, pf[kt][s], o[dt]); }
#pragma unroll
            for (int dt = 0; dt < 4; ++dt)
#pragma unroll
                for (int g4 = 0; g4 < 4; ++g4) { v2u uu; uu.x = pkbf(o[dt][4 * g4 + 0] * inv, o[dt][4 * g4 + 1] * inv); uu.y = pkbf(o[dt][4 * g4 + 2] * inv, o[dt][4 * g4 + 3] * inv); *(v2u*)(op + 128 * half + 32 * dt + 8 * g4) = uu; }
        }
        __syncthreads();
    }
}
}
namespace mk {
#ifndef MK_HAVE_SWA
#define MK_HAVE_SWA 1
#endif
#ifndef MK_HAVE_XATTN
#define MK_HAVE_XATTN 1
#endif
constexpr int NPHASE = 26;

typedef const __attribute__((address_space(4))) Args* KArgs;
__device__ __forceinline__ KArgs kargs() { KArgs p = (KArgs)__builtin_amdgcn_kernarg_segment_ptr(); asm volatile("" : "+s"(p)); return p; }

__device__ __forceinline__ bool in_range(int k) { KArgs ka = kargs(); return ka->ph_lo <= k && k < ka->ph_hi; }

__global__ void __launch_bounds__(NTHREADS, 2) mega(Args a) {
    extern __shared__ __attribute__((aligned(16))) unsigned char lds_raw[];
    LAS unsigned char* const F0lds = (LAS unsigned char*)lds_raw;
    const int F0wave = __builtin_amdgcn_readfirstlane((int)threadIdx.x >> 6);
    const int F0G = gridDim.x, F0bx = blockIdx.x, F0vcu = (F0G % 8 == 0) ? (F0bx % 8) * (F0G / 8) + F0bx / 8 : F0bx;
    volatile LAS unsigned* MISC = (volatile LAS unsigned*)(F0lds + MISC_OFF);
    if (threadIdx.x < 64) MISC[threadIdx.x] = 0u;
    __syncthreads();
    unsigned* ctl = (unsigned*)(a.ws + WS_CTL);
    XcdBarrier bar = xcd_barrier_post(ctl + CW_BAR + a.ph_lo * XCD_BAR_WORDS, MISC + 8, F0wave);
#define IN(k) in_range(k)
#define SEAM(k) do { if (IN(k) && IN((k) + 1)) { XcdBarrier b2_ = bar; asm volatile("" : "+s"(b2_.bar), "+s"(b2_.x)); xcd_barrier(b2_); } } while (0)
#define PH KArgs ka = kargs(); unsigned char* ws = ka->ws; (void)ws; Frame Fp; Fp.lds = F0lds; Fp.wave = F0wave; Fp.vcu = F0vcu; Fp.G = F0G; Fp.bx = F0bx; asm volatile("" : "+s"(Fp.wave), "+s"(Fp.vcu), "+s"(Fp.G), "+s"(Fp.bx)); \
    Fp.lane = (int)lane_id_fresh(); Fp.tid = Fp.wave * 64 + Fp.lane; const Frame& F = Fp; \
    const int bx = Fp.bx; (void)bx; LAS unsigned char* glds = F.lds; (void)glds; \
    bf16_t* RA = (bf16_t*)(ws + WS_A); bf16_t* RB = (bf16_t*)(ws + WS_B); bf16_t* RC = (bf16_t*)(ws + WS_C); bf16_t* RD = (bf16_t*)(ws + WS_D); bf16_t* WB = (bf16_t*)(ws + WS_WB); \
    (void)RA; (void)RB; (void)RC; (void)RD; (void)WB;
#define PHC PH const int cb = L == 0 ? 12 : 28; (void)cb; bf16_t* WBl = WB + WB_LAYER + (size_t)L * WL_SIZE; (void)WBl; \
    bf16_t *X1 = RB, *Qb, *Ob, *Y2, *X2, *HS = RB, *DS = RD, *X3; if (L == 0) { Qb = RA; Ob = RC; Y2 = RA; X2 = RC; X3 = RA; } else { Qb = RC; Ob = RD; Y2 = RC; X2 = RA; X3 = nullptr; } \
    (void)X1; (void)Qb; (void)Ob; (void)Y2; (void)X2; (void)HS; (void)DS; (void)X3;
#ifndef DOUBLE_MASK
#define DOUBLE_MASK 0u
#endif
#if DOUBLE_MASK != 0
#define REP(k) for (int rep_ = 0, nrep_ = 1 + (int)((DOUBLE_MASK >> (k)) & 1u); rep_ < nrep_; ++rep_)
#else
#define REP(k)
#endif
#define INF(i) ((const float*)ka->in[i])
#define WSI(off) ((int*)(ws + (off)))
#define WSF(off) ((float*)(ws + (off)))

    for (int L = 0; L < 2; ++L) {
        const int pb = 13 * L;
        if (L == 0) {
            if (IN(0)) REP(0) { PH
                LAS float* scr = (LAS float*)(F.lds + F.wave * 16384);
                const int gw = F.vcu * NWAVES + F.wave, NGW = F.G * NWAVES;
                constexpr int NITEMS = 896 + 512 + 512 + 128 + 512 + 2 * (512 + 1024 + 512 + 3 * 4096);
                for (int it = gw; it < NITEMS; it += NGW) {
                    int r = it;
#define JOB(MAP, src, K_, N_, dst, dstb, cnt) if (r < (cnt)) { transpose_job_item<MAP>((const float*)(src), K_, N_, dst, dstb, r, scr, F.lane); continue; } r -= (cnt);
                    JOB(0, ka->in[5], 1024, 1792, WB + WB_IN0, 0, 896)
                    JOB(0, ka->in[11], 1024, 1024, WB + WB_OUT0, 0, 512)
                    JOB(0, ka->in[24], 1024, 1024, WB + WB_IN1, 0, 512)
                    if (r < 128) { transpose_job_item<0>((const float*)ka->in[25], 256, 256, WB + WB_POOL, (size_t)256 * 256, r, scr, F.lane, (const float*)ka->in[26]); continue; } r -= 128;
                    JOB(0, ka->in[27], 1024, 1024, WB + WB_OUT1, 0, 512)
#define LAYER_JOBS(l, c2) { bf16_t* Wl = WB + WB_LAYER + (size_t)(l) * WL_SIZE; \
                        JOB(0, ka->in[(c2) + 2], 1024, 1024, Wl + WL_XQ, 0, 512) \
                        JOB(0, ka->in[(c2) + 3], 1024, 2048, Wl + WL_XKV, 0, 1024) \
                        JOB(0, ka->in[(c2) + 4], 1024, 1024, Wl + WL_XO, 0, 512) \
                        JOB(1, ka->in[(c2) + 7], 1024, 512, Wl + WL_GU, (size_t)1024 * 1024, 4096) \
                        JOB(2, ka->in[(c2) + 8], 1024, 512, Wl + WL_GU, (size_t)1024 * 1024, 4096) \
                        JOB(0, ka->in[(c2) + 9], 512, 1024, Wl + WL_DN, (size_t)1024 * 512, 4096) }
                    LAYER_JOBS(0, 12)
                    LAYER_JOBS(1, 28)
#undef LAYER_JOBS
#undef JOB
                }
                const int gt = F.vcu * NTHREADS + F.tid, NGT = F.G * NTHREADS;
                { const float4* x4 = (const float4*)ka->in[0]; v2u* o = (v2u*)RA;
                  for (int i = gt; i < T * D / 4; i += NGT) { const float4 v = x4[i]; v2u w; w.x = pk2(v.x, v.y); w.y = pk2(v.z, v.w); o[i] = w; } }
                { const float4* m4 = (const float4*)ka->in[1]; v2u* o = (v2u*)(ws + WS_MEMB);
                  for (int i = gt; i < B * MEM * D / 4; i += NGT) { const float4 v = m4[i]; v2u w; w.x = pk2(v.x, v.y); w.y = pk2(v.z, v.w); o[i] = w; } }
                { const int* positions = (const int*)ka->in[2]; float* ropew = WSF(WS_ROPE);
                  for (int t = gt; t < T; t += NGT) { const float p = (float)positions[t];
#pragma unroll
                      for (int j = 0; j < 8; ++j) { const float ang = p * ka->inv.f[j]; double rev = (double)ang * 0.15915494309189535; rev -= rint(rev); const float rr = (float)rev;
                          ropew[(size_t)t * 16 + j] = __builtin_amdgcn_cosf(rr); ropew[(size_t)t * 16 + 8 + j] = __builtin_amdgcn_sinf(rr); } } }
                { const float* sw = INF(9); bf16_t* o = WB + WB_SGUW;
                  for (int i = gt; i < 8 * 128 * 128; i += NGT) { const int s = i & 127, t = (i >> 7) & 127; o[i] = f2bf(s <= t ? sw[i] : 0.f); } }
            }
            SEAM(0);
            if (IN(1)) REP(1) { PH float* rope = WSF(WS_ROPE); bf16_t* MEMB = (bf16_t*)(ws + WS_MEMB);
#pragma unroll 1
                for (int l = 0; l < 2; ++l) {
                    bf16_t* Wl = WB + WB_LAYER + (size_t)l * WL_SIZE;
                    pg8::Gemm g{MEMB, Wl + WL_XKV, nullptr};
                    const int c2 = bx - 128 - 32 * l;
                    pg8::StaticOrder S; S.init(B * MEM, 2048, F.G, (c2 >= 0 && c2 < 32) ? c2 : (1 << 20));
                    pg8::EpiKV E{(bf16_t*)(ws + WS_MEMKV) + (size_t)l * B * MEM * 2048, (bf16_t*)(ws + WS_MEMVT) + (size_t)l * B * MEM * 1024};
                    pg8::gemm_phase<pg8::EpiKV, pg8::StaticOrder, true, true, false, D, D, D, 0>(glds, F.tid, g, S, E);
                }
                {
                    pg8::Gemm g{RA, WB + WB_IN0, nullptr};
                    pg8::StaticOrder S; S.init(T, NIN0, F.G, bx);
                    pg8::EpiInproj0 E{RD, rope};
                    pg8::gemm_phase<pg8::EpiInproj0, pg8::StaticOrder, true, true, false, D, D, D, 0>(glds, F.tid, g, S, E);
                }
            }
            SEAM(1);
            if (IN(2)) REP(2) { PH
#if MK_HAVE_SWA
                phase_swa_sgu(F, RD, INF(6), INF(7), INF(8), WB + WB_SGUW, INF(10), RB);
#endif
            }
            SEAM(2);
            if (IN(3)) REP(3) { PH
                pg8::Gemm g{RB, WB + WB_OUT0, nullptr};
                pg8::StaticOrder S; S.init(T, D, F.G, bx);
                pg8::EpiBf16 E{RC, D, 1.f};
                pg8::gemm_phase<pg8::EpiBf16, pg8::StaticOrder, true, true, false, D, D, D, 0>(glds, F.tid, g, S, E);
            }
            SEAM(3);
            if (IN(4)) REP(4) { PH phase_ln_add(F, RA, RC, INF(12), INF(13), RB); }
            SEAM(4);
        } else {
            if (IN(13)) REP(13) { PH
                pg8::Gemm g{RA, WB + WB_IN1, nullptr};
                pg8::StaticOrder S; S.init(T, D, F.G, bx);
                pg8::EpiBf16 E{RB, D, 1.f};
                pg8::gemm_phase<pg8::EpiBf16, pg8::StaticOrder, true, true, false, D, D, D, 0>(glds, F.tid, g, S, E);
            }
            SEAM(13);
            if (IN(14)) REP(14) { PH phase_pool(F, RB, RC); }
            SEAM(14);
            if (IN(15)) REP(15) { PH
                pg8::Gemm g{RC, WB + WB_POOL, nullptr};
                pg8::StaticOrder S; S.init(T, D, F.G, bx);
                pg8::EpiBf16 E{RD, D, 1.f};
                pg8::gemm_phase<pg8::EpiBf16, pg8::StaticOrder, true, true, false, D, 256, 256, 256>(glds, F.tid, g, S, E);
            }
            SEAM(15);
            if (IN(16)) REP(16) { PH
                pg8::Gemm g{RD, WB + WB_OUT1, nullptr};
                pg8::StaticOrder S; S.init(T, D, F.G, bx);
                pg8::EpiBf16 E{RC, D, 1.f};
                pg8::gemm_phase<pg8::EpiBf16, pg8::StaticOrder, true, true, false, D, D, D, 0>(glds, F.tid, g, S, E);
            }
            SEAM(16);
            if (IN(17)) REP(17) { PH phase_ln_add(F, RA, RC, INF(28), INF(29), RB); }
            SEAM(17);
        }
        if (IN(pb + 5)) REP(pb + 5) { PHC
            pg8::Gemm g{X1, WBl + WL_XQ, nullptr};
            pg8::StaticOrder S; S.init(T, D, F.G, bx);
            pg8::EpiBf16 E{Qb, D, QSCALE};
            pg8::gemm_phase<pg8::EpiBf16, pg8::StaticOrder, true, true, false, D, D, D, 0>(glds, F.tid, g, S, E);
        }
        SEAM(pb + 5);
        if (IN(pb + 6)) REP(pb + 6) { PHC bf16_t* Kb = (bf16_t*)(ws + WS_MEMKV) + (size_t)L * B * MEM * 2048; bf16_t* Vt = (bf16_t*)(ws + WS_MEMVT) + (size_t)L * B * MEM * 1024; (void)Kb; (void)Vt;
#if MK_HAVE_XATTN
            phase_xattn(F, Qb, Kb, Vt, Ob);
#endif
        }
        SEAM(pb + 6);
        if (IN(pb + 7)) REP(pb + 7) { PHC
            pg8::Gemm g{Ob, WBl + WL_XO, nullptr};
            pg8::StaticOrder S; S.init(T, D, F.G, bx);
            pg8::EpiBf16 E{Y2, D, 1.f};
            pg8::gemm_phase<pg8::EpiBf16, pg8::StaticOrder, true, true, false, D, D, D, 0>(glds, F.tid, g, S, E);
        }
        SEAM(pb + 7);
        if (IN(pb + 8)) REP(pb + 8) { PHC phase_ln_router(F, X1, Y2, INF(cb + 5), INF(cb + 6), X2, INF(3), INF(4), WSI(WS_EIDX), WSF(WS_EWGT), WSI(WS_BCNT)); }
        SEAM(pb + 8);
        if (IN(pb + 9)) REP(pb + 9) { PHC phase_moe_book(F, WSI(WS_EIDX), WSI(WS_BCNT), WSI(WS_TOK), WSI(WS_POS), WSI(WS_TILE)); }
        SEAM(pb + 9);
        if (IN(pb + 10)) REP(pb + 10) { PHC const int* tile_e = WSI(WS_TILE); const int* tok = WSI(WS_TOK);
            const int ntiles = __builtin_amdgcn_readfirstlane(tile_e[NTILE]);
            pg8::Gemm g{X2, WBl + WL_GU, tok};
            pg8::MoeOrder S; S.init(ntiles, tile_e, F.G, bx);
            pg8::EpiGU E{HS};
            pg8::gemm_phase<pg8::EpiGU, pg8::MoeOrder, true, true, true, D, D, D, 0>(glds, F.tid, g, S, E);
        }
        SEAM(pb + 10);
        if (IN(pb + 11)) REP(pb + 11) { PHC const int* tile_e = WSI(WS_TILE);
            const int ntiles = __builtin_amdgcn_readfirstlane(tile_e[NTILE]);
            pg8::Gemm g{HS, WBl + WL_DN, nullptr};
            pg8::MoeOrder S; S.init(ntiles, tile_e, F.G, bx);
            pg8::EpiBf16 E{DS, D, 1.f};
            pg8::gemm_phase<pg8::EpiBf16, pg8::MoeOrder, true, true, false, DE, DE, DE, 0>(glds, F.tid, g, S, E);
        }
        SEAM(pb + 11);
        if (IN(pb + 12)) REP(pb + 12) { PHC phase_ln_moe(F, X2, DS, WSI(WS_POS), WSF(WS_EWGT), INF(cb + 10), INF(cb + 11), X3, L == 1 ? ka->out : nullptr); }
        SEAM(pb + 12);
    }
#undef IN
#undef SEAM
#undef INF
#undef PH
#undef PHC
#undef WSI
#undef WSF
}
}
namespace nv {
template <class Epi>
__global__ __launch_bounds__(256) void k_gemm(const bf16_t* A, int lda, const float* W, int ldw, int K, Epi epi, const int* tile_e, size_t w_stride, const int* arow) {
    __shared__ float As[16][68];
    __shared__ float Bs[16][68];
    const int bm = blockIdx.y * 64, bn = blockIdx.x * 64;
    const float* Wp = W;
    if (tile_e) { const int e = tile_e[bm >> 8]; if (e < 0) return; Wp += (size_t)e * w_stride; }
    const int tid = threadIdx.x, tx = tid & 15, ty = tid >> 4;
    float acc[4][4];
#pragma unroll
    for (int i = 0; i < 4; ++i)
#pragma unroll
        for (int j = 0; j < 4; ++j) acc[i][j] = 0.f;
    for (int k0 = 0; k0 < K; k0 += 16) {
        {
            const int r = tid >> 2, kk = (tid & 3) * 4;
            const int ar = arow ? arow[bm + r] : bm + r;
            const ushort4 v = *(const ushort4*)(A + (size_t)ar * lda + k0 + kk);
            As[kk + 0][r] = bf2f(v.x); As[kk + 1][r] = bf2f(v.y); As[kk + 2][r] = bf2f(v.z); As[kk + 3][r] = bf2f(v.w);
        }
        {
            const int kk = tid >> 4, n = (tid & 15) * 4;
            const float4 v = *(const float4*)(Wp + (size_t)(k0 + kk) * ldw + bn + n);
            Bs[kk][n + 0] = v.x; Bs[kk][n + 1] = v.y; Bs[kk][n + 2] = v.z; Bs[kk][n + 3] = v.w;
        }
        __syncthreads();
#pragma unroll
        for (int kk = 0; kk < 16; ++kk) {
            float a[4], b[4];
#pragma unroll
            for (int i = 0; i < 4; ++i) a[i] = As[kk][ty * 4 + i];
#pragma unroll
            for (int j = 0; j < 4; ++j) b[j] = Bs[kk][tx * 4 + j];
#pragma unroll
            for (int i = 0; i < 4; ++i)
#pragma unroll
                for (int j = 0; j < 4; ++j) acc[i][j] += a[i] * b[j];
        }
        __syncthreads();
    }
#pragma unroll
    for (int i = 0; i < 4; ++i)
#pragma unroll
        for (int j = 0; j < 4; ++j) epi(bm + ty * 4 + i, bn + tx * 4 + j, acc[i][j]);
}

struct EpiBf16 { bf16_t* O; int ldo; float scale; __device__ void operator()(int r, int c, float v) const { O[(size_t)r * ldo + c] = f2bf(v * scale); } };
struct EpiInproj0 { bf16_t* O; __device__ void operator()(int r, int c, float v) const { if (c >= 768) v = gelu_tanh(v); O[(size_t)r * NIN0 + c] = f2bf(v); } };
struct EpiF32 { float* O; int ldo; __device__ void operator()(int r, int c, float v) const { O[(size_t)r * ldo + c] = v; } };
struct EpiSiluMul { const float* G; bf16_t* HS; __device__ void operator()(int r, int c, float v) const { HS[(size_t)r * DE + c] = f2bf(silu(G[(size_t)r * DE + c]) * v); } };
struct EpiKV { bf16_t* Kb; bf16_t* Vt; __device__ void operator()(int r, int c, float v) const {
    Kb[(size_t)r * 2048 + c] = f2bf(v);
    if (c >= 1024) { const int d = c - 1024, h = d >> 8, dd = d & 255, b = r >> 8, key = r & 255; Vt[((size_t)(b * XH + h) * XHD + dd) * MEM + key] = f2bf(v); } } };
struct EpiPoolMap { bf16_t* O; const float* scale; int coff; __device__ void operator()(int r, int c, float v) const { O[(size_t)r * D + coff + c] = f2bf(v * scale[coff + c]); } };

__global__ void k_cvt_x(const float* x, bf16_t* xb, size_t n4) {
    for (size_t i = (size_t)blockIdx.x * blockDim.x + threadIdx.x; i < n4; i += (size_t)gridDim.x * blockDim.x) {
        const float4 v = ((const float4*)x)[i];
        ushort4 o; o.x = f2bf(v.x); o.y = f2bf(v.y); o.z = f2bf(v.z); o.w = f2bf(v.w);
        ((ushort4*)xb)[i] = o;
    }
}
struct InvFreq { float f[8]; };
__global__ void k_rope_table(const int* positions, float* tab, InvFreq inv) {
    const int t = blockIdx.x * blockDim.x + threadIdx.x;
    if (t >= T) return;
    const float p = (float)positions[t];
#pragma unroll
    for (int j = 0; j < 8; ++j) {
        const float ang = p * inv.f[j];
        double rev = (double)ang * 0.15915494309189535; rev -= rint(rev);
        const float r = (float)rev;
        tab[(size_t)t * 16 + j] = __builtin_amdgcn_cosf(r);
        tab[(size_t)t * 16 + 8 + j] = __builtin_amdgcn_sinf(r);
    }
}
__global__ void k_rope_apply(bf16_t* H0, const float* tab) {
    const int i = blockIdx.x * blockDim.x + threadIdx.x;
    if (i >= T * 80) return;
    const int t = i / 80, r = i % 80, hd = r >> 3, j = r & 7;
    bf16_t* p = H0 + (size_t)t * NIN0 + hd * 64;
    const float t1 = bf2f(p[j]), t2 = bf2f(p[j + 8]);
    const float c = tab[(size_t)t * 16 + j], s = tab[(size_t)t * 16 + 8 + j];
    p[j] = f2bf(t1 * c - t2 * s); p[j + 8] = f2bf(t2 * c + t1 * s);
}

__global__ __launch_bounds__(128) void k_swa(const bf16_t* H0, const float* sinks, bf16_t* MIX) {
    __shared__ float Ks[256][65];
    __shared__ float Vs[256][65];
    const int head = blockIdx.x & 7, bn = blockIdx.x >> 3, n = bn & 63, b = bn >> 6;
    const int kvh = head >> 2;
    const int tid = threadIdx.x;
    const size_t row0 = (size_t)b * S + (size_t)n * 128;
    for (int idx = tid; idx < 256 * 64; idx += 128) {
        const int kj = idx >> 6, d = idx & 63;
        float kv = 0.f, vv = 0.f;
        if (n > 0 || kj >= 128) {
            const size_t row = row0 - 128 + kj;
            kv = bf2f(H0[row * NIN0 + 512 + kvh * 64 + d]);
            vv = bf2f(H0[row * NIN0 + 640 + kvh * 64 + d]);
        }
        Ks[kj][d] = kv; Vs[kj][d] = vv;
    }
    __syncthreads();
    float q[64], o[64];
    const bf16_t* qp = H0 + (row0 + tid) * NIN0 + head * 64;
#pragma unroll
    for (int d = 0; d < 64; ++d) { q[d] = bf2f(qp[d]) * ASCALE; o[d] = 0.f; }
    const float sink = sinks[head] * 1.4426950408889634f;
    float m = sink, l = 1.f;
    for (int kj = tid + 1; kj <= tid + 128; ++kj) {
        if (n == 0 && kj < 128) continue;
        float s = 0.f;
#pragma unroll
        for (int d = 0; d < 64; ++d) s += q[d] * Ks[kj][d];
        const float mn = fmaxf(m, s), sc = exp2f(m - mn), p = exp2f(s - mn);
        l = l * sc + p; m = mn;
#pragma unroll
        for (int d = 0; d < 64; ++d) o[d] = o[d] * sc + p * Vs[kj][d];
    }
    const float inv = 1.f / l;
    bf16_t* op = MIX + (row0 + tid) * D + head * 64;
#pragma unroll
    for (int d = 0; d < 64; ++d) op[d] = f2bf(o[d] * inv);
}

__global__ void k_sgu_ln(const bf16_t* H0, const float* lg, const float* lb, bf16_t* VG) {
    const int i = blockIdx.x * blockDim.x + threadIdx.x;
    if (i >= T * 8) return;
    const int t = i >> 3, g = i & 7;
    const bf16_t* p = H0 + (size_t)t * NIN0 + 1280 + g * 64;
    float s = 0.f;
    for (int c = 0; c < 64; ++c) s += bf2f(p[c]);
    const float mu = s * (1.f / 64.f);
    float q = 0.f;
    for (int c = 0; c < 64; ++c) { const float d = bf2f(p[c]) - mu; q += d * d; }
    const float rstd = 1.f / sqrtf(q * (1.f / 64.f) + LN_EPS);
    for (int c = 0; c < 64; ++c) VG[(size_t)t * 512 + g * 64 + c] = f2bf((bf2f(p[c]) - mu) * rstd * lg[g * 64 + c] + lb[g * 64 + c]);
}
__global__ void k_sgu_mix(const bf16_t* H0, const bf16_t* VG, const float* w, const float* bs, bf16_t* MIX) {
    const size_t i = (size_t)blockIdx.x * blockDim.x + threadIdx.x;
    if (i >= (size_t)T * 512) return;
    const int t = (int)(i >> 9), ch = (int)(i & 511), g = ch >> 6, tl = t & 127;
    const size_t c0 = (size_t)(t - tl);
    const float* wr = w + ((size_t)g * 128 + tl) * 128;
    float acc = 0.f;
    for (int s = 0; s <= tl; ++s) acc += wr[s] * bf2f(VG[(c0 + s) * 512 + ch]);
    acc += bs[g * 128 + tl];
    MIX[(size_t)t * D + 512 + ch] = f2bf(bf2f(H0[(size_t)t * NIN0 + 768 + ch]) * acc);
}

struct Row16 { float v[4][4]; };
__device__ __forceinline__ void load_row_bf16(const bf16_t* p, int lane, Row16& r) {
#pragma unroll
    for (int j = 0; j < 4; ++j) { const ushort4 u = *(const ushort4*)(p + 256 * j + 4 * lane); r.v[j][0] = bf2f(u.x); r.v[j][1] = bf2f(u.y); r.v[j][2] = bf2f(u.z); r.v[j][3] = bf2f(u.w); }
}
__device__ __forceinline__ void ln_row(Row16& z, const float* g, const float* b, int lane) {
    float s = 0.f;
#pragma unroll
    for (int j = 0; j < 4; ++j)
#pragma unroll
        for (int i = 0; i < 4; ++i) s += z.v[j][i];
    const float mu = wave_sum(s) * (1.f / D);
    float q = 0.f;
#pragma unroll
    for (int j = 0; j < 4; ++j)
#pragma unroll
        for (int i = 0; i < 4; ++i) { z.v[j][i] -= mu; q += z.v[j][i] * z.v[j][i]; }
    const float rstd = 1.f / sqrtf(wave_sum(q) * (1.f / D) + LN_EPS);
#pragma unroll
    for (int j = 0; j < 4; ++j) { const float4 gg = *(const float4*)(g + 256 * j + 4 * lane), bb = *(const float4*)(b + 256 * j + 4 * lane);
        z.v[j][0] = z.v[j][0] * rstd * gg.x + bb.x; z.v[j][1] = z.v[j][1] * rstd * gg.y + bb.y; z.v[j][2] = z.v[j][2] * rstd * gg.z + bb.z; z.v[j][3] = z.v[j][3] * rstd * gg.w + bb.w; }
}
__device__ __forceinline__ void store_row_bf16(bf16_t* p, int lane, const Row16& r) {
#pragma unroll
    for (int j = 0; j < 4; ++j) { ushort4 u; u.x = f2bf(r.v[j][0]); u.y = f2bf(r.v[j][1]); u.z = f2bf(r.v[j][2]); u.w = f2bf(r.v[j][3]); *(ushort4*)(p + 256 * j + 4 * lane) = u; }
}
__global__ __launch_bounds__(256) void k_ln_add(const bf16_t* X, const bf16_t* Y, const float* g, const float* b, bf16_t* out) {
    const int lane = threadIdx.x & 63, row = blockIdx.x * 4 + (threadIdx.x >> 6);
    Row16 x, y; load_row_bf16(X + (size_t)row * D, lane, x); load_row_bf16(Y + (size_t)row * D, lane, y);
#pragma unroll
    for (int j = 0; j < 4; ++j)
#pragma unroll
        for (int i = 0; i < 4; ++i) x.v[j][i] = ALPHA * x.v[j][i] + y.v[j][i];
    ln_row(x, g, b, lane);
    store_row_bf16(out + (size_t)row * D, lane, x);
}
__global__ __launch_bounds__(256) void k_ln_router(const bf16_t* X, const bf16_t* Y, const float* g, const float* b, bf16_t* out, const float* rw, const float* rbias, int* eidx, float* ewgt) {
    const int lane = threadIdx.x & 63, row = blockIdx.x * 4 + (threadIdx.x >> 6);
    Row16 x, y; load_row_bf16(X + (size_t)row * D, lane, x); load_row_bf16(Y + (size_t)row * D, lane, y);
#pragma unroll
    for (int j = 0; j < 4; ++j)
#pragma unroll
        for (int i = 0; i < 4; ++i) x.v[j][i] = ALPHA * x.v[j][i] + y.v[j][i];
    ln_row(x, g, b, lane);
    store_row_bf16(out + (size_t)row * D, lane, x);
    float lg[16];
#pragma unroll
    for (int e = 0; e < 16; ++e) lg[e] = 0.f;
#pragma unroll
    for (int j = 0; j < 4; ++j)
#pragma unroll
        for (int i = 0; i < 4; ++i) {
            const float* wr = rw + (size_t)(256 * j + 4 * lane + i) * 16;
            const float xv = x.v[j][i];
#pragma unroll
            for (int e4 = 0; e4 < 4; ++e4) { const float4 w4 = *(const float4*)(wr + 4 * e4); lg[4 * e4 + 0] += xv * w4.x; lg[4 * e4 + 1] += xv * w4.y; lg[4 * e4 + 2] += xv * w4.z; lg[4 * e4 + 3] += xv * w4.w; }
        }
#pragma unroll
    for (int e = 0; e < 16; ++e) lg[e] = wave_sum(lg[e]);
    float mx = lg[0];
#pragma unroll
    for (int e = 1; e < 16; ++e) mx = fmaxf(mx, lg[e]);
    float sc[16], sum = 0.f;
#pragma unroll
    for (int e = 0; e < 16; ++e) { sc[e] = expf(lg[e] - mx); sum += sc[e]; }
    const float isum = 1.f / sum;
    float bz[16];
#pragma unroll
    for (int e = 0; e < 16; ++e) { sc[e] *= isum; bz[e] = sc[e] + rbias[e]; }
    float gs[4]; int gi1[4], gi2[4];
#pragma unroll
    for (int gq = 0; gq < 4; ++gq) {
        float m1 = bz[4 * gq]; int i1 = 0;
#pragma unroll
        for (int j = 1; j < 4; ++j) if (bz[4 * gq + j] > m1) { m1 = bz[4 * gq + j]; i1 = j; }
        float m2 = -INFINITY; int i2 = 0;
#pragma unroll
        for (int j = 0; j < 4; ++j) if (j != i1 && bz[4 * gq + j] > m2) { m2 = bz[4 * gq + j]; i2 = j; }
        gs[gq] = m1 + m2; gi1[gq] = i1; gi2[gq] = i2;
    }
    int gsel = 0; float gm = gs[0];
#pragma unroll
    for (int gq = 1; gq < 4; ++gq) if (gs[gq] > gm) { gm = gs[gq]; gsel = gq; }
    int i1 = gi1[0], i2 = gi2[0];
#pragma unroll
    for (int gq = 1; gq < 4; ++gq) if (gsel == gq) { i1 = gi1[gq]; i2 = gi2[gq]; }
    const int e1 = gsel * 4 + i1, e2 = gsel * 4 + i2;
    float s1 = 0.f, s2 = 0.f;
#pragma unroll
    for (int e = 0; e < 16; ++e) { if (e == e1) s1 = sc[e]; if (e == e2) s2 = sc[e]; }
    const float inv = 1.f / (s1 + s2);
    if (lane == 0) { eidx[2 * row] = e1; eidx[2 * row + 1] = e2; ewgt[2 * row] = s1 * inv; ewgt[2 * row + 1] = s2 * inv; }
}
__global__ __launch_bounds__(256) void k_ln_moe(const bf16_t* X, const bf16_t* DS, const int* pos, const float* ewgt, const float* g, const float* b, bf16_t* outb, float* outf) {
    const int lane = threadIdx.x & 63, row = blockIdx.x * 4 + (threadIdx.x >> 6);
    Row16 x, y1, y2; load_row_bf16(X + (size_t)row * D, lane, x);
    const int r1 = pos[2 * row], r2 = pos[2 * row + 1]; const float w1 = ewgt[2 * row], w2 = ewgt[2 * row + 1];
    load_row_bf16(DS + (size_t)r1 * D, lane, y1); load_row_bf16(DS + (size_t)r2 * D, lane, y2);
#pragma unroll
    for (int j = 0; j < 4; ++j)
#pragma unroll
        for (int i = 0; i < 4; ++i) x.v[j][i] = ALPHA * x.v[j][i] + (w1 * y1.v[j][i] + w2 * y2.v[j][i]);
    ln_row(x, g, b, lane);
    if (outb) store_row_bf16(outb + (size_t)row * D, lane, x);
    if (outf) {
#pragma unroll
        for (int j = 0; j < 4; ++j) *(float4*)(outf + (size_t)row * D + 256 * j + 4 * lane) = make_float4(x.v[j][0], x.v[j][1], x.v[j][2], x.v[j][3]);
    }
}

__global__ __launch_bounds__(256) void k_xattn(const bf16_t* Q, const bf16_t* Kb, const bf16_t* Vt, bf16_t* O) {
    const int lane = threadIdx.x & 63;
    const int w = blockIdx.x * 4 + (threadIdx.x >> 6);
    const int t = w >> 2, h = w & 3, b = t / S;
    float q[4];
    { const ushort4 u = *(const ushort4*)(Q + (size_t)t * D + h * 256 + 4 * lane); q[0] = bf2f(u.x); q[1] = bf2f(u.y); q[2] = bf2f(u.z); q[3] = bf2f(u.w); }
    float sc[4];
#pragma unroll
    for (int jj = 0; jj < 4; ++jj) {
        sc[jj] = 0.f;
        for (int jl = 0; jl < 64; ++jl) {
            const int key = jj * 64 + jl;
            const ushort4 u = *(const ushort4*)(Kb + (size_t)(b * MEM + key) * 2048 + h * 256 + 4 * lane);
            float p = q[0] * bf2f(u.x) + q[1] * bf2f(u.y) + q[2] * bf2f(u.z) + q[3] * bf2f(u.w);
            p = wave_sum(p);
            if (lane == jl) sc[jj] = p;
        }
    }
    float m = fmaxf(fmaxf(sc[0], sc[1]), fmaxf(sc[2], sc[3])); m = wave_max(m);
    float l = 0.f;
#pragma unroll
    for (int jj = 0; jj < 4; ++jj) { sc[jj] = exp2f(sc[jj] - m); l += sc[jj]; }
    l = wave_sum(l);
    const float inv = 1.f / l;
    float o[4] = {0.f, 0.f, 0.f, 0.f};
    (void)Vt;
#pragma unroll
    for (int jj = 0; jj < 4; ++jj)
        for (int jl = 0; jl < 64; ++jl) {
            const float p = __shfl(sc[jj], jl);
            const int key = jj * 64 + jl;
            const ushort4 u = *(const ushort4*)(Kb + (size_t)(b * MEM + key) * 2048 + 1024 + h * 256 + 4 * lane);
            o[0] += p * bf2f(u.x); o[1] += p * bf2f(u.y); o[2] += p * bf2f(u.z); o[3] += p * bf2f(u.w);
        }
    ushort4 u; u.x = f2bf(o[0] * inv); u.y = f2bf(o[1] * inv); u.z = f2bf(o[2] * inv); u.w = f2bf(o[3] * inv);
    *(ushort4*)(O + (size_t)t * D + h * 256 + 4 * lane) = u;
}

__global__ __launch_bounds__(256) void k_moe_hist(const int* eidx, int* bcnt) {
    __shared__ int h[16];
    if (threadIdx.x < 16) h[threadIdx.x] = 0;
    __syncthreads();
    const int e = eidx[blockIdx.x * 256 + threadIdx.x];
    atomicAdd(&h[e], 1);
    __syncthreads();
    if (threadIdx.x < 16) bcnt[blockIdx.x * 16 + threadIdx.x] = h[threadIdx.x];
}
__global__ __launch_bounds__(256) void k_moe_scatter(const int* eidx, const int* bcnt, int* tok, int* pos, int* tile_e) {
    __shared__ int es[256], dst[256], off[17], base[16], tot[16];
    const int tid = threadIdx.x, blk = blockIdx.x;
    if (tid < 16) {
        int t = 0, bs = 0;
        for (int b2 = 0; b2 < 256; ++b2) { const int c = bcnt[b2 * 16 + tid]; t += c; if (b2 < blk) bs += c; }
        tot[tid] = t; base[tid] = bs;
    }
    es[tid] = eidx[blk * 256 + tid];
    __syncthreads();
    if (tid == 0) { int o = 0; for (int e = 0; e < 16; ++e) { off[e] = o; o += (tot[e] + 255) & ~255; } off[16] = o; }
    __syncthreads();
    {
        const int e = es[tid]; int rank = 0;
        for (int j = 0; j < tid; ++j) rank += (es[j] == e) ? 1 : 0;
        const int r = off[e] + base[e] + rank;
        dst[tid] = r; pos[blk * 256 + tid] = r; tok[r] = blk * 128 + (tid >> 1);
    }
    if (blk < 16) {
        const int e = blk, r0 = off[e] + tot[e], r1 = off[e + 1];
        for (int r = r0 + tid; r < r1; r += 256) tok[r] = 0;
    }
    if (blk == 16) {
        for (int tl = tid; tl < NTILE; tl += 256) { int e = -1; for (int k = 0; k < 16; ++k) if (tl * 256 >= off[k] && tl * 256 < off[k + 1]) e = k; tile_e[tl] = e; }
        if (tid == 0) tile_e[NTILE] = off[16] >> 8;
    }
}

__global__ void k_pool(const bf16_t* HP, bf16_t* PO) {
    const size_t i = (size_t)blockIdx.x * blockDim.x + threadIdx.x;
    if (i >= (size_t)T * D) return;
    const int t = (int)(i >> 10), c = (int)(i & 1023), g = c >> 8, win = 2 << g, ts = t & (S - 1);
    const int n = ts + 1 < win ? ts + 1 : win;
    float s = 0.f;
    for (int k = 0; k < n; ++k) s += bf2f(HP[(size_t)(t - k) * D + c]);
    PO[i] = f2bf(s / (float)n - bf2f(HP[i]));
}
}

using namespace nv;
template <class Epi>
static void ngemm(hipStream_t st, const bf16_t* A, int lda, const float* W, int ldw, int M, int N, int K, Epi epi, const int* tile_e = nullptr, size_t w_stride = 0, const int* arow = nullptr) {
    hipLaunchKernelGGL((k_gemm<Epi>), dim3(N / 64, M / 64), dim3(256), 0, st, A, lda, W, ldw, K, epi, tile_e, w_stride, arow);
}

#ifndef MEGA_MASK
#define MEGA_MASK 0x3ffffffu
#endif

extern "C" void kernel_launch(void* const* d_in, const int* in_sizes, int n_in, void* d_out, int out_size, void* d_ws, size_t ws_size, hipStream_t stream) {
    (void)in_sizes; (void)out_size;
    if (ws_size < WS_END || n_in != 40) return;
    static int grid = 0;
    if (grid == 0) {
        int dev = 0, cus = 0;
        if (hipGetDevice(&dev) != hipSuccess || hipDeviceGetAttribute(&cus, hipDeviceAttributeMultiprocessorCount, dev) != hipSuccess) { grid = -1; return; }
        if (hipFuncSetAttribute((const void*)mk::mega, hipFuncAttributeMaxDynamicSharedMemorySize, mk::LDS_BYTES) != hipSuccess) { grid = -1; return; }
        int per_cu = 0;
        if (hipOccupancyMaxActiveBlocksPerMultiprocessor(&per_cu, (const void*)mk::mega, mk::NTHREADS, mk::LDS_BYTES) != hipSuccess || per_cu < 1) { (void)hipGetLastError(); }
        grid = cus;
    }
    if (grid < 0) return;
    unsigned char* ws = (unsigned char*)d_ws;
    (void)hipMemsetAsync(ws + WS_CTL, 0, 512 * 1024, stream);
    mk::Args a{};
    for (int i = 0; i < 40; ++i) a.in[i] = d_in[i];
    a.out = (float*)d_out; a.ws = ws;
    for (int j = 0; j < 8; ++j) a.inv.f[j] = (float)pow(500000.0, -(double)((float)j * 2.0f / 16.0f));
    auto F = [&](int i) { return (const float*)d_in[i]; };
    const float* router_w = F(3); const float* router_b = F(4);
    float* rope = (float*)(ws + WS_ROPE); int* eidx = (int*)(ws + WS_EIDX); float* ewgt = (float*)(ws + WS_EWGT); int* pos = (int*)(ws + WS_POS);
    int* bcnt = (int*)(ws + WS_BCNT); int* tile_e = (int*)(ws + WS_TILE); int* tok = (int*)(ws + WS_TOK);
    bf16_t* RA = (bf16_t*)(ws + WS_A); bf16_t* RB = (bf16_t*)(ws + WS_B); bf16_t* RC = (bf16_t*)(ws + WS_C); bf16_t* RD = (bf16_t*)(ws + WS_D);
    bf16_t* MEMB = (bf16_t*)(ws + WS_MEMB);
    const unsigned mask = MEGA_MASK;
    int p = 0;
    while (p < mk::NPHASE) {
        if (mask & (1u << p)) {
            int q = p; while (q < mk::NPHASE && (mask & (1u << q))) ++q;
            a.ph_lo = p; a.ph_hi = q;
            hipLaunchKernelGGL(mk::mega, dim3(grid), dim3(mk::NTHREADS), mk::LDS_BYTES, stream, a);
            p = q; continue;
        }
        const int L = p / 13, lp = p % 13, cb = L == 0 ? 12 : 28;
        bf16_t* Kb = (bf16_t*)(ws + WS_MEMKV) + (size_t)L * B * MEM * 2048; bf16_t* Vt = (bf16_t*)(ws + WS_MEMVT) + (size_t)L * B * MEM * 1024;
        bf16_t *X1 = RB, *Qb, *Ob, *Y2, *X2, *HS = RB, *DS = RD, *X3; float* G = (float*)RD;
        if (L == 0) { Qb = RA; Ob = RC; Y2 = RA; X2 = RC; X3 = RA; } else { Qb = RC; Ob = RD; Y2 = RC; X2 = RA; X3 = nullptr; }
        if (L == 0 && lp == 0) {
            hipLaunchKernelGGL(k_cvt_x, dim3(2048), dim3(256), 0, stream, F(0), RA, (size_t)T * D / 4);
            hipLaunchKernelGGL(k_cvt_x, dim3(256), dim3(256), 0, stream, F(1), MEMB, (size_t)B * MEM * D / 4);
            nv::InvFreq inv; for (int j = 0; j < 8; ++j) inv.f[j] = a.inv.f[j];
            hipLaunchKernelGGL(k_rope_table, dim3(T / 256), dim3(256), 0, stream, (const int*)d_in[2], rope, inv);
        } else if (L == 0 && lp == 1) {
            for (int l = 0; l < 2; ++l) ngemm(stream, MEMB, D, F((l == 0 ? 12 : 28) + 3), 2048, B * MEM, 2048, D, nv::EpiKV{(bf16_t*)(ws + WS_MEMKV) + (size_t)l * B * MEM * 2048, (bf16_t*)(ws + WS_MEMVT) + (size_t)l * B * MEM * 1024});
            ngemm(stream, RA, D, F(5), NIN0, T, NIN0, D, nv::EpiInproj0{RD});
            hipLaunchKernelGGL(k_rope_apply, dim3(T * 80 / 256), dim3(256), 0, stream, RD, rope);
        } else if (L == 0 && lp == 2) {
            hipLaunchKernelGGL(k_swa, dim3(B * 64 * 8), dim3(128), 0, stream, RD, F(6), RB);
            hipLaunchKernelGGL(k_sgu_ln, dim3(T * 8 / 256), dim3(256), 0, stream, RD, F(7), F(8), RC);
            hipLaunchKernelGGL(k_sgu_mix, dim3(T * 512 / 256), dim3(256), 0, stream, RD, RC, F(9), F(10), RB);
        } else if (L == 0 && lp == 3) { ngemm(stream, RB, D, F(11), D, T, D, D, nv::EpiBf16{RC, D, 1.f});
        } else if (L == 0 && lp == 4) { hipLaunchKernelGGL(k_ln_add, dim3(T / 4), dim3(256), 0, stream, RA, RC, F(12), F(13), RB);
        } else if (L == 1 && lp == 0) { ngemm(stream, RA, D, F(24), D, T, D, D, nv::EpiBf16{RB, D, 1.f});
        } else if (L == 1 && lp == 1) { hipLaunchKernelGGL(k_pool, dim3(T * D / 256), dim3(256), 0, stream, RB, RC);
        } else if (L == 1 && lp == 2) { for (int g = 0; g < 4; ++g) ngemm(stream, RC + g * 256, D, F(25) + (size_t)g * 256 * 256, 256, T, 256, 256, nv::EpiPoolMap{RD, F(26), g * 256});
        } else if (L == 1 && lp == 3) { ngemm(stream, RD, D, F(27), D, T, D, D, nv::EpiBf16{RC, D, 1.f});
        } else if (L == 1 && lp == 4) { hipLaunchKernelGGL(k_ln_add, dim3(T / 4), dim3(256), 0, stream, RA, RC, F(28), F(29), RB);
        } else if (lp == 5) { ngemm(stream, X1, D, F(cb + 2), D, T, D, D, nv::EpiBf16{Qb, D, QSCALE});
        } else if (lp == 6) { hipLaunchKernelGGL(k_xattn, dim3(T * XH / 4), dim3(256), 0, stream, Qb, Kb, Vt, Ob);
        } else if (lp == 7) { ngemm(stream, Ob, D, F(cb + 4), D, T, D, D, nv::EpiBf16{Y2, D, 1.f});
        } else if (lp == 8) {
            hipLaunchKernelGGL(k_ln_router, dim3(T / 4), dim3(256), 0, stream, X1, Y2, F(cb + 5), F(cb + 6), X2, router_w, router_b, eidx, ewgt);
            hipLaunchKernelGGL(k_moe_hist, dim3(256), dim3(256), 0, stream, eidx, bcnt);
        } else if (lp == 9) { hipLaunchKernelGGL(k_moe_scatter, dim3(256), dim3(256), 0, stream, eidx, bcnt, tok, pos, tile_e);
        } else if (lp == 10) {
            ngemm(stream, X2, D, F(cb + 7), DE, MPAD, DE, D, nv::EpiF32{G, DE}, tile_e, (size_t)D * DE, tok);
            ngemm(stream, X2, D, F(cb + 8), DE, MPAD, DE, D, nv::EpiSiluMul{G, HS}, tile_e, (size_t)D * DE, tok);
        } else if (lp == 11) { ngemm(stream, HS, DE, F(cb + 9), D, MPAD, D, DE, nv::EpiBf16{DS, D, 1.f}, tile_e, (size_t)DE * D);
        } else if (lp == 12) { hipLaunchKernelGGL(k_ln_moe, dim3(T / 4), dim3(256), 0, stream, X2, DS, pos, ewgt, F(cb + 10), F(cb + 11), X3, L == 1 ? (float*)d_out : nullptr);
        }
        ++p;
    }
}
```

```cpp
#include <hip/hip_runtime.h>
#include <stdint.h>
#include <math.h>

typedef unsigned short bf16_t;

namespace nv {
constexpr int B = 4, S = 8192, T = B * S, D = 1024;
constexpr int NIN0 = 1792;
constexpr int MEM = 256, XH = 4, XHD = 256;
constexpr int NE = 16, DE = 512;
constexpr int MPAD = 65536 + 16 * 256;
constexpr int NTILE = MPAD / 256;
constexpr float ALPHA = 1.4142135623730951f;
constexpr float LN_EPS = 1e-5f;
constexpr float QSCALE = 0.0625f * 1.4426950408889634f;
constexpr float ASCALE = 0.125f * 1.4426950408889634f;

constexpr size_t MiB = 1u << 20;
constexpr size_t WS_CTL = 0;
constexpr size_t WS_ROPE = 2 * MiB;
constexpr size_t WS_EIDX = 4 * MiB;
constexpr size_t WS_EWGT = 5 * MiB;
constexpr size_t WS_POS = 6 * MiB;
constexpr size_t WS_BCNT = 7 * MiB;
constexpr size_t WS_TILE = 7 * MiB + 65536;
constexpr size_t WS_TOK = 7 * MiB + 131072;
constexpr size_t WS_MEMKV = 8 * MiB;
constexpr size_t WS_MEMVT = 16 * MiB;
constexpr size_t WS_MEMB = 20 * MiB;
constexpr size_t WS_WB = 24 * MiB;
constexpr size_t WS_A = 152 * MiB, WS_B = 220 * MiB, WS_C = 288 * MiB, WS_D = 356 * MiB, WS_END = 492 * MiB;
constexpr size_t WB_IN0 = 0;
constexpr size_t WB_OUT0 = WB_IN0 + (size_t)1792 * 1024;
constexpr size_t WB_IN1 = WB_OUT0 + (size_t)1024 * 1024;
constexpr size_t WB_POOL = WB_IN1 + (size_t)1024 * 1024;
constexpr size_t WB_OUT1 = WB_POOL + (size_t)1024 * 256;
constexpr size_t WB_SGUW = WB_OUT1 + (size_t)1024 * 1024;
constexpr size_t WB_LAYER = WB_SGUW + (size_t)8 * 128 * 128;
constexpr size_t WL_XQ = 0;
constexpr size_t WL_XKV = WL_XQ + (size_t)1024 * 1024;
constexpr size_t WL_XO = WL_XKV + (size_t)2048 * 1024;
constexpr size_t WL_GU = WL_XO + (size_t)1024 * 1024;
constexpr size_t WL_DN = WL_GU + (size_t)16 * 1024 * 1024;
constexpr size_t WL_SIZE = WL_DN + (size_t)16 * 1024 * 512;
static_assert((WB_LAYER + 2 * WL_SIZE) * 2 <= 128 * MiB, "bf16 weight region");

__device__ __forceinline__ float bf2f(bf16_t v) { return __uint_as_float((unsigned)v << 16); }
__device__ __forceinline__ bf16_t f2bf(float f) { unsigned u = __float_as_uint(f); return (bf16_t)((u + 0x7fffu + ((u >> 16) & 1u)) >> 16); }
__device__ __forceinline__ float gelu_tanh(float x) { const float u = 0.7978845608028654f * (x + 0.044715f * x * x * x); const float e = __expf(2.f * u); const float th = 1.f - 2.f / (e + 1.f); return 0.5f * x * (1.f + th); }
__device__ __forceinline__ float silu(float x) { return x / (1.f + __expf(-x)); }
template <int M> __device__ __forceinline__ float swz_xor(float v) { return __int_as_float(__builtin_amdgcn_ds_swizzle(__float_as_int(v), (M << 10) | 0x1f)); }
__device__ __forceinline__ float wave_sum(float v) {
    v += swz_xor<1>(v); v += swz_xor<2>(v); v += swz_xor<4>(v); v += swz_xor<8>(v); v += swz_xor<16>(v);
    const auto r = __builtin_amdgcn_permlane32_swap(__float_as_uint(v), __float_as_uint(v), false, false);
    return __uint_as_float(r[0]) + __uint_as_float(r[1]);
}
__device__ __forceinline__ float wave_max(float v) {
    v = fmaxf(v, swz_xor<1>(v)); v = fmaxf(v, swz_xor<2>(v)); v = fmaxf(v, swz_xor<4>(v)); v = fmaxf(v, swz_xor<8>(v)); v = fmaxf(v, swz_xor<16>(v));
    const auto r = __builtin_amdgcn_permlane32_swap(__float_as_uint(v), __float_as_uint(v), false, false);
    return fmaxf(__uint_as_float(r[0]), __uint_as_float(r[1]));
}
}

namespace pg8 {
#define PG8_LAS __attribute__((address_space(3)))
typedef short bf16x8 __attribute__((ext_vector_type(8)));
typedef float f32x4 __attribute__((ext_vector_type(4)));
typedef float f32x2 __attribute__((ext_vector_type(2)));
typedef unsigned u32x4 __attribute__((ext_vector_type(4)));
typedef unsigned u32x2 __attribute__((ext_vector_type(2)));
constexpr int BM = 256, BK = 64, HALF = 128, HTB = HALF * BK * 2  , STAGE_BYTES = 8 * HTB, NXCD = 8, WGM = 8;

__host__ __device__ __forceinline__ int lds_byte(int r, int c) { const int st = (r >> 4) * 2 + (c >> 5), rr = r & 15, cc = c & 31, ob = rr * 64 + cc * 2; return st * 1024 + (ob ^ (((ob >> 9) & 1) << 5)); }
__host__ __device__ __forceinline__ void stage_rc(int b, int& R, int& C) { const int st = b / 1024, sb = b % 1024, swz = sb ^ (((sb >> 9) & 1) << 5); R = (st >> 1) * 16 + swz / 64; C = (st & 1) * 32 + (swz % 64) / 2; }
__host__ __device__ __forceinline__ int perm32(int rho) { const int n = rho >> 4, i = rho & 15; return 8 * (i >> 2) + 4 * n + (i & 3); }

struct Unit { int pm, pn, pb; };
struct Gemm { const bf16_t* A; const bf16_t* Bt; const int* arow; };

struct StaticOrder {
    int nM, nN, nwg, G, c;
    __device__ void init(int M, int N, int G_, int c_) { nM = M / BM; nN = N / BM; nwg = nM * nN; G = G_; c = c_; }
    __device__ bool next(int i, Unit& u) const {
        const long L = (long)i * G + c; if (L >= nwg) return false;
        int wgid = (int)L; { const int q = nwg / NXCD, r = nwg % NXCD, xcd = wgid % NXCD, off = wgid / NXCD; wgid = (xcd < r ? xcd * (q + 1) : r * (q + 1) + (xcd - r) * q) + off; }
        const int nig = WGM * nN, gid = wgid / nig, fm = gid * WGM, gsz = (nM - fm) < WGM ? (nM - fm) : WGM;
        u.pm = fm + ((wgid % nig) % gsz); u.pn = (wgid % nig) / gsz; u.pb = u.pn; return true;
    }
};
struct MoeOrder {
    int nM, nwg, G, c; const int* tile_e;
    __device__ void init(int ntiles, const int* te, int G_, int c_) { nM = ntiles; nwg = nM * 4; G = G_; c = c_; tile_e = te; }
    __device__ bool next(int i, Unit& u) const {
        const long L = (long)i * G + c; if (L >= nwg) return false;
        int wgid = (int)L; { const int q = nwg / NXCD, r = nwg % NXCD, xcd = wgid % NXCD, off = wgid / NXCD; wgid = (xcd < r ? xcd * (q + 1) : r * (q + 1) + (xcd - r) * q) + off; }
        const int nig = WGM * 4, gid = wgid / nig, fm = gid * WGM, gsz = (nM - fm) < WGM ? (nM - fm) : WGM;
        u.pm = fm + ((wgid % nig) % gsz); u.pn = (wgid % nig) / gsz;
        const int e = __builtin_amdgcn_readfirstlane(tile_e[u.pm]); u.pb = e * 4 + u.pn; return true;
    }
};

__device__ __forceinline__ unsigned cvt_pk_bf16(float lo, float hi) { unsigned r; asm volatile("v_cvt_pk_bf16_f32 %0, %1, %2" : "=v"(r) : "v"(lo), "v"(hi)); return r; }


template <class Epi, class Sched, bool ALIGN_EPI, bool SP2, bool GATHER, int LDA, int LDB, int KK, int APN>
__device__ __forceinline__ void gemm_phase(PG8_LAS unsigned char* lds, int tid_in, const Gemm g, const Sched& S, const Epi& E) {
    int tid_ = tid_in; asm volatile("" : "+v"(tid_));
    const int tid = tid_, wid = __builtin_amdgcn_readfirstlane(tid >> 6), lane = tid & 63, wr = wid >> 2, wc = wid & 3, fr = lane & 15, fq = lane >> 4;
    constexpr int K = KK, nt = K / BK, lda = LDA, ldb = LDB; (void)K;
    unsigned voffA[2], voffB[2]; int rowA[2];
#pragma unroll
    for (int i = 0; i < 2; ++i) { int R, C; stage_rc(tid * 16 + i * 8192, R, C); const int Rb = Epi::PERM ? ((R & ~31) + perm32(R & 31)) : R;
        voffA[i] = GATHER ? (unsigned)C * 2u : (unsigned)(R * lda + C) * 2u; voffB[i] = (unsigned)(Rb * ldb + C) * 2u; rowA[i] = R; }
    const size_t kstep = (size_t)(BK * 2);
    const size_t hstepA = GATHER ? 0 : (size_t)HALF * lda * 2, hstepB = (size_t)HALF * ldb * 2;
    const size_t tstepA = (size_t)BM * lda * 2, tstepB = 2 * hstepB;
    const unsigned ldsw = (unsigned)wid * 1024u;
    const int aoff = lds_byte(wr * 64 + fr, fq * 8), boff = lds_byte(wc * 32 + fr, fq * 8);
    unsigned cg[2][2], ng[2][2];
#define PG8_SA(b, h) (((b) * 2 + (h)) * HTB)
#define PG8_SB(b, h) ((4 + (b) * 2 + (h)) * HTB)
#define PG8_STAGE(bufoff, gbase, voff) do { _Pragma("unroll") for (int _i = 0; _i < 2; ++_i) \
        __builtin_amdgcn_global_load_lds((const unsigned*)((const char*)(gbase) + (voff)[_i]), (PG8_LAS unsigned*)(lds + (bufoff) + ldsw + _i * 8192), 16, 0, 0); } while (0)
#define PG8_STAGE_A(bufoff, abase, h, GO) do { _Pragma("unroll") for (int _i = 0; _i < 2; ++_i) { \
        const char* _s = GATHER ? (const char*)(abase) + (size_t)GO[h][_i] : (const char*)(abase) + ((h) ? hstepA : (size_t)0) + voffA[_i]; \
        __builtin_amdgcn_global_load_lds((const unsigned*)_s, (PG8_LAS unsigned*)(lds + (bufoff) + ldsw + _i * 8192), 16, 0, 0); } } while (0)
#define PG8_GLOAD(dst, pm_) do { _Pragma("unroll") for (int _h = 0; _h < 2; ++_h) _Pragma("unroll") for (int _i = 0; _i < 2; ++_i) \
        dst[_h][_i] = (unsigned)g.arow[(pm_) * BM + _h * HALF + rowA[_i]] * (unsigned)(lda * 2) + voffA[_i]; } while (0)
#define PG8_GSWITCH do { if constexpr (GATHER) { _Pragma("unroll") for (int _h = 0; _h < 2; ++_h) _Pragma("unroll") for (int _i = 0; _i < 2; ++_i) cg[_h][_i] = last ? ng[_h][_i] : cg[_h][_i]; } } while (0)
#define PG8_LDA(dst, b, h) do { _Pragma("unroll") for (int m = 0; m < 4; ++m) _Pragma("unroll") for (int k = 0; k < 2; ++k) dst[m][k] = *(const PG8_LAS bf16x8*)(lds + PG8_SA(b, h) + aoff + m * 2048 + k * 1024); } while (0)
#define PG8_LDB(dst, b, h) do { _Pragma("unroll") for (int n = 0; n < 2; ++n) _Pragma("unroll") for (int k = 0; k < 2; ++k) dst[n][k] = *(const PG8_LAS bf16x8*)(lds + PG8_SB(b, h) + boff + n * 2048 + k * 1024); } while (0)
#define PG8_MMA(ai, bj, At, Bt) do { __builtin_amdgcn_s_setprio(1); _Pragma("unroll") for (int m = 0; m < 4; ++m) _Pragma("unroll") for (int n = 0; n < 2; ++n) _Pragma("unroll") for (int k = 0; k < 2; ++k) \
        acc[ai][bj][m][n] = __builtin_amdgcn_mfma_f32_16x16x32_bf16(Bt[n][k], At[m][k], acc[ai][bj][m][n], 0, 0, 0); __builtin_amdgcn_s_setprio(0); } while (0)
#define PG8_WAIT_V(n) asm volatile("s_waitcnt vmcnt(" #n ")" ::: "memory")
#define PG8_WAIT_L(n) asm volatile("s_waitcnt lgkmcnt(" #n ")" ::: "memory")
#define PG8_BAR __builtin_amdgcn_s_barrier()
#define PG8_SCHED __builtin_amdgcn_sched_barrier(0)
    Unit cur, nxt; int ui = 0;
    if (!S.next(0, cur)) return;
    f32x4 acc[2][2][4][2];
#pragma unroll
    for (int a = 0; a < 2; ++a)
#pragma unroll
        for (int b = 0; b < 2; ++b)
#pragma unroll
            for (int m = 0; m < 4; ++m)
#pragma unroll
                for (int n = 0; n < 2; ++n) acc[a][b][m][n] = (f32x4){0.f, 0.f, 0.f, 0.f};
    bf16x8 At[4][2], B0[2][2], B1[2][2];
    const char* cA = GATHER ? (const char*)g.A : (const char*)g.A + (size_t)cur.pm * tstepA + (size_t)cur.pn * APN * 2; const char* cB = (const char*)g.Bt + (size_t)cur.pb * tstepB;
    if constexpr (GATHER) { PG8_GLOAD(cg, cur.pm); }
    if constexpr (SP2) {
        PG8_STAGE(PG8_SB(0, 0), cB, voffB); PG8_STAGE(PG8_SB(0, 1), cB + hstepB, voffB); PG8_STAGE_A(PG8_SA(0, 0), cA, 0, cg); PG8_STAGE_A(PG8_SA(0, 1), cA, 1, cg);
        if (wr == 1) PG8_BAR;
        PG8_WAIT_V(2); PG8_BAR;
        PG8_STAGE(PG8_SB(1, 0), cB + kstep, voffB); PG8_STAGE_A(PG8_SA(1, 0), cA + kstep, 0, cg); PG8_STAGE(PG8_SB(1, 1), cB + hstepB + kstep, voffB);
        PG8_WAIT_V(6); PG8_BAR;
    } else {
        PG8_STAGE(PG8_SB(0, 0), cB, voffB); PG8_STAGE_A(PG8_SA(0, 0), cA, 0, cg); PG8_STAGE(PG8_SB(0, 1), cB + hstepB, voffB); PG8_STAGE_A(PG8_SA(0, 1), cA, 1, cg);
        if (wr == 1) PG8_BAR;
        PG8_WAIT_V(4); PG8_BAR;
        PG8_STAGE(PG8_SB(1, 0), cB + kstep, voffB); PG8_STAGE_A(PG8_SA(1, 0), cA + kstep, 0, cg); PG8_STAGE(PG8_SB(1, 1), cB + hstepB + kstep, voffB);
        PG8_WAIT_V(6); PG8_BAR;
    }
    for (;;) {
        const bool has_next = S.next(ui + 1, nxt);
        const char* nA = GATHER ? (const char*)g.A : (has_next ? (const char*)g.A + (size_t)nxt.pm * tstepA + (size_t)nxt.pn * APN * 2 : cA);
        const char* nB = has_next ? (const char*)g.Bt + (size_t)nxt.pb * tstepB : cB;
        if constexpr (GATHER) { if (has_next) { PG8_GLOAD(ng, nxt.pm); } else {
#pragma unroll
            for (int _h = 0; _h < 2; ++_h)
#pragma unroll
                for (int _i = 0; _i < 2; ++_i) ng[_h][_i] = cg[_h][_i]; } }
#pragma unroll 1
        for (int t = 0; t < nt; t += 2) {
            const bool last = (t == nt - 2);
            const char* a1 = cA + (size_t)(t + 1) * kstep;
            const char* a2 = last ? nA : cA + (size_t)(t + 2) * kstep; const char* b2 = last ? nB : cB + (size_t)(t + 2) * kstep;
            const char* a3 = a2 + kstep; const char* b3 = b2 + kstep;
            if constexpr (SP2) {
            PG8_LDB(B0, 0, 0); PG8_LDB(B1, 0, 1); PG8_SCHED; PG8_LDA(At, 0, 0); PG8_STAGE_A(PG8_SA(1, 1), a1, 1, cg); PG8_GSWITCH;
            PG8_WAIT_V(8); PG8_WAIT_L(0); PG8_BAR; PG8_MMA(0, 0, At, B0); PG8_MMA(0, 1, At, B1); PG8_BAR; PG8_SCHED;
            PG8_LDA(At, 0, 1); PG8_STAGE(PG8_SB(0, 0), b2, voffB); PG8_STAGE(PG8_SB(0, 1), b2 + hstepB, voffB); PG8_STAGE_A(PG8_SA(0, 0), a2, 0, cg);
            PG8_WAIT_V(8); PG8_WAIT_L(0); PG8_BAR; PG8_MMA(1, 0, At, B0); PG8_MMA(1, 1, At, B1); PG8_BAR; PG8_SCHED;
            PG8_LDB(B0, 1, 0); PG8_LDB(B1, 1, 1); PG8_SCHED; PG8_LDA(At, 1, 0); PG8_STAGE_A(PG8_SA(0, 1), a2, 1, cg);
            PG8_WAIT_V(8); PG8_WAIT_L(0); PG8_BAR; PG8_MMA(0, 0, At, B0); PG8_MMA(0, 1, At, B1); PG8_BAR; PG8_SCHED;
            PG8_LDA(At, 1, 1); PG8_STAGE(PG8_SB(1, 0), b3, voffB); PG8_STAGE(PG8_SB(1, 1), b3 + hstepB, voffB); PG8_STAGE_A(PG8_SA(1, 0), a3, 0, cg);
            PG8_WAIT_V(8); PG8_WAIT_L(0); PG8_BAR; PG8_MMA(1, 0, At, B0); PG8_MMA(1, 1, At, B1); PG8_BAR; PG8_SCHED;
            } else {
            PG8_LDB(B0, 0, 0); PG8_SCHED; PG8_LDA(At, 0, 0); PG8_STAGE_A(PG8_SA(1, 1), a1, 1, cg); PG8_GSWITCH;
            PG8_WAIT_L(8); PG8_BAR; PG8_WAIT_L(0); PG8_MMA(0, 0, At, B0); PG8_BAR; PG8_SCHED;
            PG8_LDB(B1, 0, 1); PG8_STAGE(PG8_SB(0, 0), b2, voffB);
            PG8_BAR; PG8_WAIT_L(0); PG8_MMA(0, 1, At, B1); PG8_BAR;
            PG8_LDA(At, 0, 1); PG8_STAGE_A(PG8_SA(0, 0), a2, 0, cg);
            PG8_BAR; PG8_WAIT_L(0); PG8_MMA(1, 0, At, B0); PG8_BAR; PG8_SCHED;
            PG8_STAGE(PG8_SB(0, 1), b2 + hstepB, voffB);
            PG8_WAIT_V(6); PG8_BAR; PG8_MMA(1, 1, At, B1); PG8_BAR;
            PG8_LDB(B0, 1, 0); PG8_SCHED; PG8_LDA(At, 1, 0); PG8_STAGE_A(PG8_SA(0, 1), a2, 1, cg);
            PG8_WAIT_L(8); PG8_BAR; PG8_WAIT_L(0); PG8_MMA(0, 0, At, B0); PG8_BAR; PG8_SCHED;
            PG8_LDB(B1, 1, 1); PG8_STAGE(PG8_SB(1, 0), b3, voffB);
            PG8_BAR; PG8_WAIT_L(0); PG8_MMA(0, 1, At, B1); PG8_BAR;
            PG8_LDA(At, 1, 1); PG8_STAGE_A(PG8_SA(1, 0), a3, 0, cg);
            PG8_BAR; PG8_WAIT_L(0); PG8_MMA(1, 0, At, B0); PG8_BAR; PG8_SCHED;
            PG8_STAGE(PG8_SB(1, 1), b3 + hstepB, voffB);
            PG8_WAIT_V(6); PG8_BAR; PG8_MMA(1, 1, At, B1); PG8_BAR;
            }
        }
        if constexpr (ALIGN_EPI) { if (wr == 0) PG8_BAR; }
        E(acc, cur, wr, wc, fr, fq);
        if (!has_next) break;
#pragma unroll
        for (int a = 0; a < 2; ++a)
#pragma unroll
            for (int b = 0; b < 2; ++b)
#pragma unroll
                for (int m = 0; m < 4; ++m)
#pragma unroll
                    for (int n = 0; n < 2; ++n) acc[a][b][m][n] = (f32x4){0.f, 0.f, 0.f, 0.f};
        cur = nxt; cA = nA; cB = nB; ++ui;
        if constexpr (GATHER) {
#pragma unroll
            for (int _h = 0; _h < 2; ++_h)
#pragma unroll
                for (int _i = 0; _i < 2; ++_i) cg[_h][_i] = ng[_h][_i]; }
        if constexpr (ALIGN_EPI) { if (wr == 1) PG8_BAR; }
    }
    PG8_WAIT_V(0);
    if constexpr (!ALIGN_EPI) { if (wr == 0) PG8_BAR; }
    PG8_BAR;
#undef PG8_SA
#undef PG8_SB
#undef PG8_STAGE
#undef PG8_STAGE_A
#undef PG8_GLOAD
#undef PG8_GSWITCH
#undef PG8_LDA
#undef PG8_LDB
#undef PG8_MMA
#undef PG8_WAIT_V
#undef PG8_WAIT_L
#undef PG8_BAR
#undef PG8_SCHED
}
}
namespace pg8 {

__device__ __forceinline__ float fast_sigmoid_mul(float x, float z) { return x * __builtin_amdgcn_rcpf(1.f + __builtin_amdgcn_exp2f(-1.4426950408889634f * z)); }
__device__ __forceinline__ float gelu_t(float x) { const float u = 0.7978845608028654f * (x + 0.044715f * x * x * x); return fast_sigmoid_mul(x, 2.f * u); }
__device__ __forceinline__ float silu_f(float x) { return fast_sigmoid_mul(x, x); }
__device__ __forceinline__ u32x4 pack8(const f32x4 v0, const f32x4 v1) { u32x4 w; w.x = cvt_pk_bf16(v0[0], v0[1]); w.y = cvt_pk_bf16(v0[2], v0[3]); w.z = cvt_pk_bf16(v1[0], v1[1]); w.w = cvt_pk_bf16(v1[2], v1[3]); return w; }

struct EpiBf16 {
    static constexpr bool PERM = true;
    bf16_t* O; int ldo; float scale;
    __device__ __forceinline__ void operator()(const f32x4 (&acc)[2][2][4][2], const Unit& u, int wr, int wc, int fr, int fq) const {
        const int row0 = u.pm * BM + wr * 64 + fr, col0 = u.pn * BM + wc * 32 + 8 * fq;
#pragma unroll
        for (int ai = 0; ai < 2; ++ai)
#pragma unroll
            for (int m = 0; m < 4; ++m) { bf16_t* rowp = O + (size_t)(row0 + ai * HALF + m * 16) * ldo + col0;
#pragma unroll
                for (int bj = 0; bj < 2; ++bj) *(u32x4*)(rowp + bj * HALF) = pack8(acc[ai][bj][m][0] * scale, acc[ai][bj][m][1] * scale); }
    }
};
struct EpiPoolMap {
    static constexpr bool PERM = true;
    bf16_t* O; const float* cscale;
    __device__ __forceinline__ void operator()(const f32x4 (&acc)[2][2][4][2], const Unit& u, int wr, int wc, int fr, int fq) const {
        const int row0 = u.pm * BM + wr * 64 + fr, col0 = u.pn * BM + wc * 32 + 8 * fq;
        f32x4 sc[2][2];
#pragma unroll
        for (int bj = 0; bj < 2; ++bj)
#pragma unroll
            for (int n = 0; n < 2; ++n) sc[bj][n] = *(const f32x4*)(cscale + col0 + bj * HALF + 4 * n);
#pragma unroll
        for (int ai = 0; ai < 2; ++ai)
#pragma unroll
            for (int m = 0; m < 4; ++m) { bf16_t* rowp = O + (size_t)(row0 + ai * HALF + m * 16) * nv::D + col0;
#pragma unroll
                for (int bj = 0; bj < 2; ++bj) *(u32x4*)(rowp + bj * HALF) = pack8(acc[ai][bj][m][0] * sc[bj][0], acc[ai][bj][m][1] * sc[bj][1]); }
    }
};
struct EpiGU {
    static constexpr bool PERM = true;
    bf16_t* HS;
    __device__ __forceinline__ void operator()(const f32x4 (&acc)[2][2][4][2], const Unit& u, int wr, int wc, int fr, int fq) const {
        const int row0 = u.pm * BM + wr * 64 + fr, col0 = u.pn * HALF + wc * 32 + 8 * fq;
#pragma unroll
        for (int ai = 0; ai < 2; ++ai)
#pragma unroll
            for (int m = 0; m < 4; ++m) { bf16_t* rowp = HS + (size_t)(row0 + ai * HALF + m * 16) * nv::DE + col0;
                f32x4 h0, h1;
#pragma unroll
                for (int j = 0; j < 4; ++j) { h0[j] = silu_f(acc[ai][0][m][0][j]) * acc[ai][1][m][0][j]; h1[j] = silu_f(acc[ai][0][m][1][j]) * acc[ai][1][m][1][j]; }
                *(u32x4*)rowp = pack8(h0, h1); }
    }
};
struct EpiKV {
    static constexpr bool PERM = true;
    bf16_t* Kb; bf16_t* Vt;
    __device__ __forceinline__ void operator()(const f32x4 (&acc)[2][2][4][2], const Unit& u, int wr, int wc, int fr, int fq) const {
        const int row0 = u.pm * BM + wr * 64 + fr, col0 = u.pn * BM + wc * 32 + 8 * fq;
#pragma unroll
        for (int ai = 0; ai < 2; ++ai)
#pragma unroll
            for (int m = 0; m < 4; ++m) { bf16_t* rowp = Kb + (size_t)(row0 + ai * HALF + m * 16) * 2048 + col0;
#pragma unroll
                for (int bj = 0; bj < 2; ++bj) *(u32x4*)(rowp + bj * HALF) = pack8(acc[ai][bj][m][0], acc[ai][bj][m][1]); }
        if (u.pn >= 4) {
            const int h = u.pn - 4, b = u.pm;
            bf16_t* vb = Vt + (size_t)(b * nv::XH + h) * nv::XHD * nv::MEM;
#pragma unroll
            for (int ai = 0; ai < 2; ++ai)
#pragma unroll
                for (int m = 0; m < 4; ++m) { const int key = ai * HALF + wr * 64 + m * 16 + fr;
#pragma unroll
                    for (int bj = 0; bj < 2; ++bj)
#pragma unroll
                        for (int n = 0; n < 2; ++n)
#pragma unroll
                            for (int j = 0; j < 4; ++j) { const int dd = bj * HALF + wc * 32 + 8 * fq + 4 * n + j; vb[(size_t)dd * nv::MEM + key] = nv::f2bf(acc[ai][bj][m][n][j]); } }
        }
    }
};
struct EpiInproj0 {
    static constexpr bool PERM = true;
    bf16_t* O; const float* rope;
    __device__ __forceinline__ void operator()(const f32x4 (&acc)[2][2][4][2], const Unit& u, int wr, int wc, int fr, int fq) const {
        const int row0 = u.pm * BM + wr * 64 + fr, col0 = u.pn * BM + wc * 32 + 8 * fq;
        if (u.pn >= 3) {
#pragma unroll
            for (int ai = 0; ai < 2; ++ai)
#pragma unroll
                for (int m = 0; m < 4; ++m) { bf16_t* rowp = O + (size_t)(row0 + ai * HALF + m * 16) * nv::NIN0 + col0;
#pragma unroll
                    for (int bj = 0; bj < 2; ++bj) { f32x4 v0 = acc[ai][bj][m][0], v1 = acc[ai][bj][m][1];
#pragma unroll
                        for (int j = 0; j < 4; ++j) { v0[j] = gelu_t(v0[j]); v1[j] = gelu_t(v1[j]); }
                        *(u32x4*)(rowp + bj * HALF) = pack8(v0, v1); } }
        } else {
            const bool wave_rope = (wc & 1) == 0;
            const float sgn = fq == 0 ? -1.f : 1.f;
#pragma unroll
            for (int ai = 0; ai < 2; ++ai)
#pragma unroll
                for (int m = 0; m < 4; ++m) { const int row = row0 + ai * HALF + m * 16; bf16_t* rowp = O + (size_t)row * nv::NIN0 + col0;
                    f32x4 c0, c1, s0, s1;
                    if (wave_rope) { const float* rp = rope + (size_t)row * 16; c0 = *(const f32x4*)rp; c1 = *(const f32x4*)(rp + 4); s0 = *(const f32x4*)(rp + 8); s1 = *(const f32x4*)(rp + 12); }
#pragma unroll
                    for (int bj = 0; bj < 2; ++bj) { f32x4 v0 = acc[ai][bj][m][0], v1 = acc[ai][bj][m][1];
                        if (wave_rope && (u.pn < 2 || bj == 0)) {
                            f32x4 p0, p1;
#pragma unroll
                            for (int j = 0; j < 4; ++j) { p0[j] = nv::swz_xor<16>(v0[j]); p1[j] = nv::swz_xor<16>(v1[j]); }
                            if (fq < 2) {
#pragma unroll
                                for (int j = 0; j < 4; ++j) { v0[j] = v0[j] * c0[j] + sgn * p0[j] * s0[j]; v1[j] = v1[j] * c1[j] + sgn * p1[j] * s1[j]; } }
                        }
                        *(u32x4*)(rowp + bj * HALF) = pack8(v0, v1); } }
        }
    }
};
}

#define LAS __attribute__((address_space(3)))
#define GAS __attribute__((address_space(1)))
typedef GAS unsigned gu32;
#define RLX_AGENT __ATOMIC_RELAXED, __HIP_MEMORY_SCOPE_AGENT
#define LDS_WAIT() asm volatile("s_waitcnt lgkmcnt(0)" ::: "memory")
#define VM_WAIT() asm volatile("s_waitcnt vmcnt(0)" ::: "memory")

#define XB_TMO      128
#define XB_XCNT(j)  (256  + 64 * (j))
#define XB_XSUB(j)  (1280 + 64 * (j))
#define XB_XGEN(j)  (2304 + 64 * (j))
#define XB_TOP      3328
#define XB_TOPGEN   3392
#define XCD_BAR_WORDS 3456
#define XB_SPIN_CAP (1u << 18)
__device__ __forceinline__ unsigned xb_ld(unsigned* p)              { return __hip_atomic_load(p, __ATOMIC_RELAXED, __HIP_MEMORY_SCOPE_AGENT); }
__device__ __forceinline__ unsigned xb_add(unsigned* p, unsigned v) { return __hip_atomic_fetch_add(p, v, __ATOMIC_RELAXED, __HIP_MEMORY_SCOPE_AGENT); }
__device__ __forceinline__ unsigned xb_xcc_id() { return (unsigned)__builtin_amdgcn_s_getreg((3 << 11) | 20) & 0xFu; }
#define XB_SPIN(cond, bar) do { unsigned _sp = 0; while (cond) { __builtin_amdgcn_s_sleep(1); \
    if ((++_sp & 255u) == 0u) { if (xb_ld(&(bar)[XB_TMO])) break; if (_sp > XB_SPIN_CAP) { atomicAdd(&(bar)[XB_TMO], 1u); break; } } } } while (0)
struct XcdBarrier { unsigned* bar; unsigned x; volatile LAS unsigned* st; int wave; };
__device__ __forceinline__ unsigned lane_id_fresh() { unsigned m = ~0u; asm volatile("" : "+s"(m)); return __builtin_amdgcn_mbcnt_hi(m, __builtin_amdgcn_mbcnt_lo(m, 0u)); }
__device__ __forceinline__ bool xb_thread0(int wave) { return wave == 0 && lane_id_fresh() == 0u; }
__device__ __forceinline__ XcdBarrier xcd_barrier_post(unsigned* bar, volatile LAS unsigned* st, int wave) {
    XcdBarrier b; b.bar = bar; b.x = xb_xcc_id(); b.st = st; b.wave = wave;
    if (xb_thread0(wave)) (void)xb_add(&bar[XB_XCNT(b.x)], 1u);
    return b;
}
__device__ __forceinline__ void xcd_barrier_complete(unsigned* bar, unsigned x, unsigned& nloc, unsigned& nx) {
    const unsigned G = gridDim.x * gridDim.y * gridDim.z;
    unsigned sum, cnt, mine, sp = 0u;
    for (;;) {
        sum = 0u; cnt = 0u; mine = 0u;
#pragma unroll
        for (unsigned j = 0; j < 16; ++j) { const unsigned c = xb_ld(&bar[XB_XCNT(j)]); sum += c; cnt += (c > 0u) ? 1u : 0u; mine = (j == x) ? c : mine; }
        if (sum == G) break;
        __builtin_amdgcn_s_sleep(1);
        if ((++sp & 255u) == 0u) { if (xb_ld(&bar[XB_TMO])) break; if (sp > XB_SPIN_CAP) { atomicAdd(&bar[XB_TMO], 1u); break; } }
    }
    nloc = mine > 0u ? mine : 1u; nx = cnt > 0u ? cnt : 1u;
}
__device__ __forceinline__ void xcd_barrier(const XcdBarrier& b) {
    asm volatile("s_waitcnt vmcnt(0)" ::: "memory");
    __syncthreads();
    if (xb_thread0(b.wave)) {
        unsigned* bar = b.bar;
        __builtin_amdgcn_s_waitcnt(0);
        unsigned nloc = b.st[0], nx = b.st[1];
        if (nloc == 0u) { xcd_barrier_complete(bar, b.x, nloc, nx); b.st[0] = nloc; b.st[1] = nx; }
        const unsigned old = xb_add(&bar[XB_XSUB(b.x)], 1u);
        const unsigned gen = old / nloc;
        if (old + 1u == (gen + 1u) * nloc) {
            __builtin_amdgcn_fence(__ATOMIC_RELEASE, "agent");
            asm volatile("s_waitcnt vmcnt(0)" ::: "memory");
            const unsigned og = xb_add(&bar[XB_TOP], 1u);
            const unsigned tg = og / nx;
            if (og + 1u == (tg + 1u) * nx) xb_add(&bar[XB_TOPGEN], 1u);
            else XB_SPIN(xb_ld(&bar[XB_TOPGEN]) == tg, bar);
            __builtin_amdgcn_fence(__ATOMIC_ACQUIRE, "agent");
            xb_add(&bar[XB_XGEN(b.x)], 1u);
            asm volatile("s_waitcnt vmcnt(0)" ::: "memory");
        } else {
            XB_SPIN(xb_ld(&bar[XB_XGEN(b.x)]) == gen, bar);
            __builtin_amdgcn_fence(__ATOMIC_ACQUIRE, "agent");
            asm volatile("s_waitcnt vmcnt(0)" ::: "memory");
        }
    }
    __syncthreads();
}

namespace mk {
using namespace nv;
typedef unsigned v4u __attribute__((ext_vector_type(4)));
typedef unsigned v2u __attribute__((ext_vector_type(2)));
typedef float f32x4 __attribute__((ext_vector_type(4)));
constexpr int NWAVES = 8, NTHREADS = 512;
constexpr int LDS_BYTES = 160 * 1024;
constexpr int MISC_OFF = LDS_BYTES - 256;
constexpr int CW_BAR = 4096;
constexpr size_t CTL_ZERO_BYTES = 64 * 1024;

__device__ __forceinline__ unsigned pk2(float lo, float hi) { return (unsigned)f2bf(lo) | ((unsigned)f2bf(hi) << 16); }

struct Frame {
    LAS unsigned char* lds; int tid, lane, wave, vcu, G, bx;
};

__device__ __forceinline__ void transpose_item(const float* W, int ldw, bf16_t* WT, int ldt, int k0, int n0, int dest_row0, LAS float* scr, int lane, const float* nscale = nullptr) {
    const float sc = nscale ? nscale[n0 + (lane & 31)] : 1.f;
#pragma unroll 8
    for (int i = 0; i < 32; ++i) { const int kk = 2 * i + (lane >> 5); scr[kk * 33 + (lane & 31)] = W[(size_t)(k0 + kk) * ldw + n0 + (lane & 31)] * sc; }
    LDS_WAIT(); asm volatile("" ::: "memory");
    const int c = lane & 7;
#pragma unroll
    for (int j = 0; j < 4; ++j) { const int n = (lane >> 3) + 8 * j; const LAS float* s = scr + (8 * c) * 33 + n;
        v4u o; o.x = pk2(s[0 * 33], s[1 * 33]); o.y = pk2(s[2 * 33], s[3 * 33]); o.z = pk2(s[4 * 33], s[5 * 33]); o.w = pk2(s[6 * 33], s[7 * 33]);
        *(v4u*)(WT + (size_t)(dest_row0 + n) * ldt + k0 + 8 * c) = o; }
    LDS_WAIT(); asm volatile("" ::: "memory");
}
template <int MAP>
__device__ __forceinline__ void transpose_job_item(const float* src, int K, int N, bf16_t* dst, size_t dstb, int r, LAS float* scr, int lane, const float* nscale = nullptr) {
    const int nblk = N / 32, per = (K / 64) * nblk, bi = r / per, it = r % per, kb = it / nblk, nb = it % nblk, n0 = 32 * nb;
    int dr = n0; if (MAP == 1) dr = (n0 >> 7) * 256 + (n0 & 127); if (MAP == 2) dr = (n0 >> 7) * 256 + 128 + (n0 & 127);
    transpose_item(src + (size_t)bi * K * N, N, dst + (size_t)bi * dstb, K, 64 * kb, n0, dr, scr, lane, nscale ? nscale + (size_t)bi * N : nullptr);
}

struct InvFreq { float f[8]; };
struct Args {
    const void* in[40]; float* out; unsigned char* ws; InvFreq inv; int ph_lo, ph_hi;
};

struct RowV { float v[16]; };
__device__ __forceinline__ void unpk8(const v4u u, float* x) {
    x[0] = __uint_as_float(u.x << 16); x[1] = __uint_as_float(u.x & 0xffff0000u); x[2] = __uint_as_float(u.y << 16); x[3] = __uint_as_float(u.y & 0xffff0000u);
    x[4] = __uint_as_float(u.z << 16); x[5] = __uint_as_float(u.z & 0xffff0000u); x[6] = __uint_as_float(u.w << 16); x[7] = __uint_as_float(u.w & 0xffff0000u);
}
struct RowRaw { v4u a, b; };
__device__ __forceinline__ RowRaw load_raw(const bf16_t* p, int lane) { RowRaw r; r.a = *(const v4u*)(p + 8 * lane); r.b = *(const v4u*)(p + 512 + 8 * lane); return r; }
__device__ __forceinline__ void unpack_row(const RowRaw& r, RowV& x) { unpk8(r.a, x.v); unpk8(r.b, x.v + 8); }
struct GB { float g[16], b[16]; };
__device__ __forceinline__ void load_gb(const float* g, const float* b, int lane, GB& o) {
#pragma unroll
    for (int hh = 0; hh < 2; ++hh)
#pragma unroll
        for (int q = 0; q < 2; ++q) { const float4 gg = *(const float4*)(g + 512 * hh + 8 * lane + 4 * q), bb = *(const float4*)(b + 512 * hh + 8 * lane + 4 * q);
            o.g[8 * hh + 4 * q + 0] = gg.x; o.g[8 * hh + 4 * q + 1] = gg.y; o.g[8 * hh + 4 * q + 2] = gg.z; o.g[8 * hh + 4 * q + 3] = gg.w;
            o.b[8 * hh + 4 * q + 0] = bb.x; o.b[8 * hh + 4 * q + 1] = bb.y; o.b[8 * hh + 4 * q + 2] = bb.z; o.b[8 * hh + 4 * q + 3] = bb.w; }
}
__device__ __forceinline__ void ln_rowv(RowV& z, const GB& gb) {
    float s = 0.f;
#pragma unroll
    for (int i = 0; i < 16; ++i) s += z.v[i];
    const float mu = wave_sum(s) * (1.f / D);
    float q = 0.f;
#pragma unroll
    for (int i = 0; i < 16; ++i) { z.v[i] -= mu; q += z.v[i] * z.v[i]; }
    const float rstd = 1.f / sqrtf(wave_sum(q) * (1.f / D) + LN_EPS);
#pragma unroll
    for (int i = 0; i < 16; ++i) z.v[i] = z.v[i] * rstd * gb.g[i] + gb.b[i];
}
__device__ __forceinline__ void store_rowv_bf16(bf16_t* p, int lane, const RowV& r) {
    v4u a, b; a.x = pk2(r.v[0], r.v[1]); a.y = pk2(r.v[2], r.v[3]); a.z = pk2(r.v[4], r.v[5]); a.w = pk2(r.v[6], r.v[7]);
    b.x = pk2(r.v[8], r.v[9]); b.y = pk2(r.v[10], r.v[11]); b.z = pk2(r.v[12], r.v[13]); b.w = pk2(r.v[14], r.v[15]);
    *(v4u*)(p + 8 * lane) = a; *(v4u*)(p + 512 + 8 * lane) = b;
}
constexpr int LNR = 4;

__device__ __forceinline__ void phase_ln_add(const Frame& F, const bf16_t* X, const bf16_t* Y, const float* g, const float* b, bf16_t* out) {
    const int gw = F.vcu * NWAVES + F.wave, NGW = F.G * NWAVES;
    GB gb; load_gb(g, b, F.lane, gb);
    for (int row = gw; row < T; row += LNR * NGW) {
        RowRaw rx[LNR], ry[LNR];
#pragma unroll
        for (int k = 0; k < LNR; ++k) { const int rr = row + k * NGW; if (rr < T) { rx[k] = load_raw(X + (size_t)rr * D, F.lane); ry[k] = load_raw(Y + (size_t)rr * D, F.lane); } }
#pragma unroll
        for (int k = 0; k < LNR; ++k) { const int rr = row + k * NGW; if (rr < T) {
            RowV x, y; unpack_row(rx[k], x); unpack_row(ry[k], y);
#pragma unroll
            for (int i = 0; i < 16; ++i) x.v[i] = ALPHA * x.v[i] + y.v[i];
            ln_rowv(x, gb);
            store_rowv_bf16(out + (size_t)rr * D, F.lane, x); } }
    }
}
__device__ __forceinline__ void phase_ln_moe(const Frame& F, const bf16_t* X, const bf16_t* DS, const int* pos, const float* ewgt, const float* g, const float* b, bf16_t* outb, float* outf) {
    const int gw = F.vcu * NWAVES + F.wave, NGW = F.G * NWAVES;
    GB gb; load_gb(g, b, F.lane, gb);
    for (int row = gw; row < T; row += LNR * NGW) {
        RowRaw rx[LNR], r1[LNR], r2[LNR]; float w1[LNR], w2[LNR];
#pragma unroll
        for (int k = 0; k < LNR; ++k) { const int rr = row + k * NGW; if (rr < T) {
            const int2 pp = *(const int2*)(pos + 2 * rr); const float2 ww = *(const float2*)(ewgt + 2 * rr); w1[k] = ww.x; w2[k] = ww.y;
            rx[k] = load_raw(X + (size_t)rr * D, F.lane); r1[k] = load_raw(DS + (size_t)pp.x * D, F.lane); r2[k] = load_raw(DS + (size_t)pp.y * D, F.lane); } }
#pragma unroll
        for (int k = 0; k < LNR; ++k) { const int rr = row + k * NGW; if (rr < T) {
            RowV x, y1, y2; unpack_row(rx[k], x); unpack_row(r1[k], y1); unpack_row(r2[k], y2);
#pragma unroll
            for (int i = 0; i < 16; ++i) x.v[i] = ALPHA * x.v[i] + (w1[k] * y1.v[i] + w2[k] * y2.v[i]);
            ln_rowv(x, gb);
            if (outb) store_rowv_bf16(outb + (size_t)rr * D, F.lane, x);
            if (outf) { float* o = outf + (size_t)rr * D + 8 * F.lane;
                *(float4*)(o) = make_float4(x.v[0], x.v[1], x.v[2], x.v[3]); *(float4*)(o + 4) = make_float4(x.v[4], x.v[5], x.v[6], x.v[7]);
                *(float4*)(o + 512) = make_float4(x.v[8], x.v[9], x.v[10], x.v[11]); *(float4*)(o + 516) = make_float4(x.v[12], x.v[13], x.v[14], x.v[15]); } } }
    }
}
constexpr int RW_LD = 20;
__device__ __forceinline__ void phase_ln_router(const Frame& F, const bf16_t* X, const bf16_t* Y, const float* g, const float* b, bf16_t* out, const float* rw, const float* rbias, int* eidx, float* ewgt, int* bcnt) {
    LAS float* rwl = (LAS float*)F.lds;
    LAS int* hist = (LAS int*)(F.lds + 1024 * RW_LD * 4);
    LAS float* lgs = (LAS float*)(F.lds + 1024 * RW_LD * 4 + 256) + F.wave * 64;
    for (int i = F.tid; i < 1024 * 4; i += NTHREADS) { const int k = i >> 2, q = i & 3; const float4 v = *(const float4*)(rw + (size_t)k * 16 + 4 * q);
        const int j = (k >> 9) * 8 + (k & 7), l = (k >> 3) & 63; LAS float* d = rwl + (j * 64 + l) * RW_LD + 4 * q; d[0] = v.x; d[1] = v.y; d[2] = v.z; d[3] = v.w; }
    GB gb; load_gb(g, b, F.lane, gb);
    const int lane = F.lane;
    for (int vb = F.vcu; vb < T / 128; vb += F.G) {
        if (F.tid < 16) hist[F.tid] = 0;
        __syncthreads();
#pragma unroll 1
        for (int it = 0; it < 4; ++it) {
            const int row0 = vb * 128 + F.wave * 16 + it * 4;
            RowRaw rx[4], ry[4];
#pragma unroll
            for (int k = 0; k < 4; ++k) { rx[k] = load_raw(X + (size_t)(row0 + k) * D, lane); ry[k] = load_raw(Y + (size_t)(row0 + k) * D, lane); }
            RowV x[4];
#pragma unroll
            for (int k = 0; k < 4; ++k) { RowV y; unpack_row(rx[k], x[k]); unpack_row(ry[k], y);
#pragma unroll
                for (int i = 0; i < 16; ++i) x[k].v[i] = ALPHA * x[k].v[i] + y.v[i];
                ln_rowv(x[k], gb);
                store_rowv_bf16(out + (size_t)(row0 + k) * D, lane, x[k]); }
            float val[64];
#pragma unroll
            for (int i = 0; i < 64; ++i) val[i] = 0.f;
#pragma unroll
            for (int j = 0; j < 16; ++j) { const LAS float* wr = rwl + (j * 64 + lane) * RW_LD;
#pragma unroll
                for (int e4 = 0; e4 < 4; ++e4) { const f32x4 w4 = *(const LAS f32x4*)(wr + 4 * e4);
#pragma unroll
                    for (int k = 0; k < 4; ++k) { const float xv = x[k].v[j];
                        val[16 * k + 4 * e4 + 0] += xv * w4[0]; val[16 * k + 4 * e4 + 1] += xv * w4[1]; val[16 * k + 4 * e4 + 2] += xv * w4[2]; val[16 * k + 4 * e4 + 3] += xv * w4[3]; } } }
#pragma unroll
            for (int i = 0; i < 32; ++i) { const auto rr = __builtin_amdgcn_permlane32_swap(__float_as_uint(val[i]), __float_as_uint(val[i + 32]), false, false); val[i] = __uint_as_float(rr[0]) + __uint_as_float(rr[1]); }
            { const bool bt = (lane & 16) != 0;
#pragma unroll
              for (int i = 0; i < 16; ++i) { const float keep = bt ? val[i + 16] : val[i], send = bt ? val[i] : val[i + 16]; val[i] = keep + swz_xor<16>(send); } }
            { const bool bt = (lane & 8) != 0;
#pragma unroll
              for (int i = 0; i < 8; ++i) { const float keep = bt ? val[i + 8] : val[i], send = bt ? val[i] : val[i + 8]; val[i] = keep + swz_xor<8>(send); } }
            { const bool bt = (lane & 4) != 0;
#pragma unroll
              for (int i = 0; i < 4; ++i) { const float keep = bt ? val[i + 4] : val[i], send = bt ? val[i] : val[i + 4]; val[i] = keep + swz_xor<4>(send); } }
            { const bool bt = (lane & 2) != 0;
#pragma unroll
              for (int i = 0; i < 2; ++i) { const float keep = bt ? val[i + 2] : val[i], send = bt ? val[i] : val[i + 2]; val[i] = keep + swz_xor<2>(send); } }
            { const bool bt = (lane & 1) != 0; const float keep = bt ? val[1] : val[0], send = bt ? val[0] : val[1]; val[0] = keep + swz_xor<1>(send); }
            lgs[lane] = val[0];
            LDS_WAIT();
            if (lane < 4) {
                const int row = row0 + lane;
                float lg[16];
#pragma unroll
                for (int e4 = 0; e4 < 4; ++e4) { const f32x4 t4 = *(const LAS f32x4*)(lgs + 16 * lane + 4 * e4); lg[4 * e4] = t4[0]; lg[4 * e4 + 1] = t4[1]; lg[4 * e4 + 2] = t4[2]; lg[4 * e4 + 3] = t4[3]; }
                float mx = lg[0];
#pragma unroll
                for (int e = 1; e < 16; ++e) mx = fmaxf(mx, lg[e]);
                float sc[16], sum = 0.f;
#pragma unroll
                for (int e = 0; e < 16; ++e) { sc[e] = __expf(lg[e] - mx); sum += sc[e]; }
                const float isum = 1.f / sum;
                float bz[16];
#pragma unroll
                for (int e = 0; e < 16; ++e) { sc[e] *= isum; bz[e] = sc[e] + rbias[e]; }
                float gs[4]; int gi1[4], gi2[4];
#pragma unroll
                for (int gq = 0; gq < 4; ++gq) {
                    float m1 = bz[4 * gq]; int i1 = 0;
#pragma unroll
                    for (int j = 1; j < 4; ++j) if (bz[4 * gq + j] > m1) { m1 = bz[4 * gq + j]; i1 = j; }
                    float m2 = -INFINITY; int i2 = 0;
#pragma unroll
                    for (int j = 0; j < 4; ++j) if (j != i1 && bz[4 * gq + j] > m2) { m2 = bz[4 * gq + j]; i2 = j; }
                    gs[gq] = m1 + m2; gi1[gq] = i1; gi2[gq] = i2;
                }
                int gsel = 0; float gm = gs[0];
#pragma unroll
                for (int gq = 1; gq < 4; ++gq) if (gs[gq] > gm) { gm = gs[gq]; gsel = gq; }
                int i1 = gi1[0], i2 = gi2[0];
#pragma unroll
                for (int gq = 1; gq < 4; ++gq) if (gsel == gq) { i1 = gi1[gq]; i2 = gi2[gq]; }
                const int e1 = gsel * 4 + i1, e2 = gsel * 4 + i2;
                float s1 = 0.f, s2 = 0.f;
#pragma unroll
                for (int e = 0; e < 16; ++e) { if (e == e1) s1 = sc[e]; if (e == e2) s2 = sc[e]; }
                const float inv = 1.f / (s1 + s2);
                *(int2*)(eidx + 2 * row) = make_int2(e1, e2); *(float2*)(ewgt + 2 * row) = make_float2(s1 * inv, s2 * inv);
                atomicAdd((int*)&hist[e1], 1); atomicAdd((int*)&hist[e2], 1);
            }
        }
        __syncthreads();
        if (F.tid < 16) bcnt[vb * 16 + F.tid] = hist[F.tid];
        __syncthreads();
    }
}
__device__ __forceinline__ void phase_moe_book(const Frame& F, const int* eidx, const int* bcnt, int* tok, int* pos, int* tile_e) {
    LAS int* bc = (LAS int*)F.lds;
    LAS int* es = bc + 4096;
    LAS int* off = es + 256;
    LAS int* base = off + 32;
    LAS int* tot = base + 16;
    for (int i = F.tid; i < 4096; i += NTHREADS) bc[i] = bcnt[i];
    __syncthreads();
    for (int vb = F.vcu; vb < T / 128; vb += F.G) {
        if (F.tid < 16) { int t = 0, bs = 0; for (int b2 = 0; b2 < 256; ++b2) { const int c = bc[b2 * 16 + F.tid]; t += c; if (b2 < vb) bs += c; } tot[F.tid] = t; base[F.tid] = bs; }
        if (F.tid < 256) es[F.tid] = eidx[vb * 256 + F.tid];
        __syncthreads();
        if (F.tid == 0) { int o = 0; for (int e = 0; e < 16; ++e) { off[e] = o; o += (tot[e] + 255) & ~255; } off[16] = o; }
        __syncthreads();
        if (F.tid < 256) {
            const int e = es[F.tid]; int rank = 0;
            for (int j = 0; j < F.tid; ++j) rank += (es[j] == e) ? 1 : 0;
            const int r = off[e] + base[e] + rank;
            pos[vb * 256 + F.tid] = r; tok[r] = vb * 128 + (F.tid >> 1);
        }
        if (vb < 16) { const int e = vb, r0 = off[e] + tot[e], r1 = off[e + 1]; for (int r = r0 + F.tid; r < r1; r += NTHREADS) tok[r] = 0; }
        if (vb == 16) {
            for (int tl = F.tid; tl < NTILE; tl += NTHREADS) { int e = -1; for (int k = 0; k < 16; ++k) if (tl * 256 >= off[k] && tl * 256 < off[k + 1]) e = k; tile_e[tl] = e; }
            if (F.tid == 0) tile_e[NTILE] = off[16] >> 8;
        }
        __syncthreads();
    }
}
__device__ __forceinline__ void phase_pool(const Frame& F, const bf16_t* HP, bf16_t* PO) {
    constexpr int RUN = 32;
    const int gt = F.vcu * NTHREADS + F.tid, NGT = F.G * NTHREADS;
    for (int it = gt; it < (T / RUN) * (D / 8); it += NGT) {
        const int c8 = it & 127, run = it >> 7, g = c8 >> 5, win = 2 << g, t0 = run * RUN, ts0 = t0 & (S - 1);
        const bf16_t* hp = HP + (size_t)t0 * D + c8 * 8; bf16_t* po = PO + (size_t)t0 * D + c8 * 8;
        float s[8];
#pragma unroll
        for (int q = 0; q < 8; ++q) s[q] = 0.f;
        for (int k = 1; k < win; ++k) if (ts0 - k >= 0) { float v[8]; unpk8(*(const v4u*)(hp - (ptrdiff_t)k * D), v);
#pragma unroll
            for (int q = 0; q < 8; ++q) s[q] += v[q]; }
#pragma unroll 4
        for (int i = 0; i < RUN; ++i) {
            float hn[8]; unpk8(*(const v4u*)(hp + (size_t)i * D), hn);
            const int ts = ts0 + i;
#pragma unroll
            for (int q = 0; q < 8; ++q) s[q] += hn[q];
            const float inv = 1.f / (float)(ts + 1 < win ? ts + 1 : win);
            v4u o; o.x = pk2(s[0] * inv - hn[0], s[1] * inv - hn[1]); o.y = pk2(s[2] * inv - hn[2], s[3] * inv - hn[3]); o.z = pk2(s[4] * inv - hn[4], s[5] * inv - hn[5]); o.w = pk2(s[6] * inv - hn[6], s[7] * inv - hn[7]);
            *(v4u*)(po + (size_t)i * D) = o;
            if (ts + 1 >= win) { float ho[8]; unpk8(*(const v4u*)(hp + (ptrdiff_t)(i + 1 - win) * D), ho);
#pragma unroll
                for (int q = 0; q < 8; ++q) s[q] -= ho[q]; }
        }
    }
}
}
namespace mk {
typedef short bf16x8 __attribute__((ext_vector_type(8)));
typedef float f32x16 __attribute__((ext_vector_type(16)));
#define MFMA32(a, b, c) __builtin_amdgcn_mfma_f32_32x32x16_bf16((a), (b), (c), 0, 0, 0)
__device__ __forceinline__ int crow(int i, int h) { return (i & 3) + 8 * (i >> 2) + 4 * h; }
__device__ __forceinline__ float swap32_max(float v) { const auto r = __builtin_amdgcn_permlane32_swap(__float_as_uint(v), __float_as_uint(v), false, false); return fmaxf(__uint_as_float(r[0]), __uint_as_float(r[1])); }
__device__ __forceinline__ float swap32_sum(float v) { const auto r = __builtin_amdgcn_permlane32_swap(__float_as_uint(v), __float_as_uint(v), false, false); return __uint_as_float(r[0]) + __uint_as_float(r[1]); }
__device__ __forceinline__ unsigned pkbf(float lo, float hi) { unsigned r; asm volatile("v_cvt_pk_bf16_f32 %0, %1, %2" : "=v"(r) : "v"(lo), "v"(hi)); return r; }
__device__ __forceinline__ bf16x8 pack_step(const f32x16& x, int s) {
    v4u p; p.x = pkbf(x[8 * s + 0], x[8 * s + 1]); p.y = pkbf(x[8 * s + 2], x[8 * s + 3]); p.z = pkbf(x[8 * s + 4], x[8 * s + 5]); p.w = pkbf(x[8 * s + 6], x[8 * s + 7]);
    return __builtin_bit_cast(bf16x8, p);
}
__device__ __forceinline__ bf16x8 lds_frag2x8(const LAS unsigned char* p) {
    const v2u a = *(const LAS v2u*)p, b = *(const LAS v2u*)(p + 16);
    v4u q; q.x = a.x; q.y = a.y; q.z = b.x; q.w = b.y; return __builtin_bit_cast(bf16x8, q);
}
__device__ __forceinline__ void unpack8(const v4u u, float (&x)[8]) {
    x[0] = __uint_as_float(u.x << 16); x[1] = __uint_as_float(u.x & 0xffff0000u); x[2] = __uint_as_float(u.y << 16); x[3] = __uint_as_float(u.y & 0xffff0000u);
    x[4] = __uint_as_float(u.z << 16); x[5] = __uint_as_float(u.z & 0xffff0000u); x[6] = __uint_as_float(u.w << 16); x[7] = __uint_as_float(u.w & 0xffff0000u);
}

__device__ __forceinline__ void phase_swa_sgu(const Frame& F, const bf16_t* H0, const float* sinks, const float* lng, const float* lnb, const bf16_t* SW, const float* bs, bf16_t* MIX) {
    constexpr int KSTR = 272, VSTR = 520, VT_OFF = 256 * KSTR, VGSTR = 272, VGW = 64 * VGSTR;
    LAS unsigned char* KS = F.lds; LAS unsigned char* VT = F.lds + VT_OFF;
    const int lane = F.lane, r = lane & 31, h = lane >> 5, w = F.wave, kvh = w >> 2;
    const float NEG = -INFINITY;
    for (int vb = F.vcu; vb < T / 128; vb += F.G) {
        const int n = vb & 63; const size_t row0 = (size_t)vb * 128;
#pragma unroll
        for (int i = 0; i < 8; ++i) { const int p = F.tid + NTHREADS * i, row = p >> 4, c16 = p & 15; v4u v = (v4u){0u, 0u, 0u, 0u};
            if (n > 0 || row >= 128) v = *(const v4u*)(H0 + (row0 + row - 128) * NIN0 + 512 + c16 * 8);
            *(LAS v4u*)(KS + row * KSTR + c16 * 16) = v; }
#pragma unroll
        for (int i = 0; i < 8; ++i) { const int p = F.tid + NTHREADS * i, c16 = p >> 8, row = p & 255; v4u v = (v4u){0u, 0u, 0u, 0u};
            if (n > 0 || row >= 128) v = *(const v4u*)(H0 + (row0 + row - 128) * NIN0 + 640 + c16 * 8);
            LAS bf16_t* d = (LAS bf16_t*)(VT + (c16 * 8) * VSTR + row * 2);
            d[0 * (VSTR / 2)] = (bf16_t)(v.x & 0xffffu); d[1 * (VSTR / 2)] = (bf16_t)(v.x >> 16); d[2 * (VSTR / 2)] = (bf16_t)(v.y & 0xffffu); d[3 * (VSTR / 2)] = (bf16_t)(v.y >> 16);
            d[4 * (VSTR / 2)] = (bf16_t)(v.z & 0xffffu); d[5 * (VSTR / 2)] = (bf16_t)(v.z >> 16); d[6 * (VSTR / 2)] = (bf16_t)(v.w & 0xffffu); d[7 * (VSTR / 2)] = (bf16_t)(v.w >> 16); }
        __syncthreads();
        const float sink2 = sinks[w] * 1.4426950408889634f;
#pragma unroll 1
        for (int qg = 0; qg < 4; ++qg) {
            bf16x8 qf[4];
            { const bf16_t* qp = H0 + (row0 + 32 * qg + r) * NIN0 + w * 64 + 8 * h;
#pragma unroll
              for (int ks = 0; ks < 4; ++ks) qf[ks] = *(const bf16x8*)(qp + 16 * ks); }
            f32x16 st[5];
#pragma unroll
            for (int kt = 0; kt < 5; ++kt) {
#pragma unroll
                for (int i = 0; i < 16; ++i) st[kt][i] = 0.f;
                const LAS unsigned char* kp = KS + (32 * qg + 32 * kt + r) * KSTR + (kvh * 64 + 8 * h) * 2;
#pragma unroll
                for (int ks = 0; ks < 4; ++ks) { const bf16x8 kf = *(const LAS bf16x8*)(kp + 32 * ks); st[kt] = MFMA32(kf, qf[ks], st[kt]); }
            }
            float m = sink2;
#pragma unroll
            for (int kt = 0; kt < 5; ++kt)
#pragma unroll
                for (int i = 0; i < 16; ++i) { const int dk = 32 * kt + crow(i, h) - r;
                    const bool valid = dk >= 1 && dk <= 128 && (n > 0 || (32 * qg + 32 * kt + crow(i, h)) >= 128);
                    const float s = valid ? st[kt][i] * ASCALE : NEG; st[kt][i] = s; m = fmaxf(m, s); }
            m = swap32_max(m);
            float l = 0.f;
#pragma unroll
            for (int kt = 0; kt < 5; ++kt)
#pragma unroll
                for (int i = 0; i < 16; ++i) { const float p = __builtin_amdgcn_exp2f(st[kt][i] - m); st[kt][i] = p; l += p; }
            l = swap32_sum(l) + __builtin_amdgcn_exp2f(sink2 - m);
            f32x16 o[2];
#pragma unroll
            for (int i = 0; i < 16; ++i) { o[0][i] = 0.f; o[1][i] = 0.f; }
#pragma unroll
            for (int kt = 0; kt < 5; ++kt)
#pragma unroll
                for (int s = 0; s < 2; ++s) { const bf16x8 pf = pack_step(st[kt], s);
#pragma unroll
                    for (int dt = 0; dt < 2; ++dt) { const bf16x8 vf = lds_frag2x8(VT + (kvh * 64 + 32 * dt + r) * VSTR + (32 * qg + 32 * kt + 16 * s + 4 * h) * 2); o[dt] = MFMA32(vf, pf, o[dt]); } }
            const float inv = 1.f / l;
            bf16_t* op = MIX + (row0 + 32 * qg + r) * D + w * 64 + 4 * h;
#pragma unroll
            for (int dt = 0; dt < 2; ++dt)
#pragma unroll
                for (int g4 = 0; g4 < 4; ++g4) { v2u u; u.x = pkbf(o[dt][4 * g4 + 0] * inv, o[dt][4 * g4 + 1] * inv); u.y = pkbf(o[dt][4 * g4 + 2] * inv, o[dt][4 * g4 + 3] * inv); *(v2u*)(op + 32 * dt + 8 * g4) = u; }
        }
        __syncthreads();
        {
            LAS unsigned char* VG = F.lds + w * VGW; const int g = w;
#pragma unroll 1
            for (int it = 0; it < 2; ++it) { const int s = 64 * it + lane; const bf16_t* vp = H0 + (row0 + s) * NIN0 + 1280 + g * 64;
                float x[8][8]; float sum = 0.f;
#pragma unroll
                for (int cq = 0; cq < 8; ++cq) { unpack8(*(const v4u*)(vp + 8 * cq), x[cq]);
#pragma unroll
                    for (int e = 0; e < 8; ++e) sum += x[cq][e]; }
                const float mu = sum * (1.f / 64.f); float q = 0.f;
#pragma unroll
                for (int cq = 0; cq < 8; ++cq)
#pragma unroll
                    for (int e = 0; e < 8; ++e) { x[cq][e] -= mu; q += x[cq][e] * x[cq][e]; }
                const float rstd = 1.f / sqrtf(q * (1.f / 64.f) + LN_EPS);
#pragma unroll
                for (int cq = 0; cq < 8; ++cq)
#pragma unroll
                    for (int e = 0; e < 8; ++e) { const int c = 8 * cq + e; *(LAS bf16_t*)(VG + c * VGSTR + s * 2) = f2bf(x[cq][e] * rstd * lng[g * 64 + c] + lnb[g * 64 + c]); }
            }
            LDS_WAIT();
#pragma unroll 1
            for (int tt = 0; tt < 4; ++tt) {
                f32x16 acc[2];
#pragma unroll
                for (int i = 0; i < 16; ++i) { acc[0][i] = 0.f; acc[1][i] = 0.f; }
                const bf16_t* wp = SW + ((size_t)(g * 128 + 32 * tt + r) * 128 + 8 * h);
                for (int ks = 0; ks < 2 * (tt + 1); ++ks) { const bf16x8 bfr = *(const bf16x8*)(wp + 16 * ks);
#pragma unroll
                    for (int ct = 0; ct < 2; ++ct) { const bf16x8 af = *(const LAS bf16x8*)(VG + (32 * ct + r) * VGSTR + (16 * ks + 8 * h) * 2); acc[ct] = MFMA32(af, bfr, acc[ct]); } }
                const int t = 32 * tt + r; const float bias = bs[g * 128 + t];
                const bf16_t* up = H0 + (row0 + t) * NIN0 + 768 + g * 64 + 4 * h; bf16_t* op = MIX + (row0 + t) * D + 512 + g * 64 + 4 * h;
#pragma unroll
                for (int ct = 0; ct < 2; ++ct)
#pragma unroll
                    for (int g4 = 0; g4 < 4; ++g4) { const v2u uu = *(const v2u*)(up + 32 * ct + 8 * g4);
                        const float u0 = __uint_as_float(uu.x << 16), u1 = __uint_as_float(uu.x & 0xffff0000u), u2 = __uint_as_float(uu.y << 16), u3 = __uint_as_float(uu.y & 0xffff0000u);
                        v2u o2; o2.x = pkbf(u0 * (acc[ct][4 * g4 + 0] + bias), u1 * (acc[ct][4 * g4 + 1] + bias)); o2.y = pkbf(u2 * (acc[ct][4 * g4 + 2] + bias), u3 * (acc[ct][4 * g4 + 3] + bias));
                        *(v2u*)(op + 32 * ct + 8 * g4) = o2; }
            }
        }
        __syncthreads();
    }
}

#define SBAR0() __builtin_amdgcn_sched_barrier(0)
__device__ __forceinline__ void phase_xattn(const Frame& F, const bf16_t* Qb, const bf16_t* Kb, const bf16_t* Vt, bf16_t* Ob) {
    constexpr int KSTR = 528, VSTR = 520;
    LAS unsigned char* KS = F.lds;
    const int lane = F.lane, r = lane & 31, h5 = lane >> 5, w = F.wave;
    for (int u = F.vcu; u < B * XH * (S / 256); u += F.G) {
        const int b = u >> 7, hd = (u >> 5) & 3, qt = u & 31;
        const size_t qrow = (size_t)b * S + qt * 256 + 32 * w + r;
        const bf16_t* qp = Qb + qrow * D + hd * 256 + 8 * h5;
        bf16x8 qf[4];
#pragma unroll
        for (int i = 0; i < 4; ++i) qf[i] = *(const bf16x8*)(qp + 16 * i);
#pragma unroll
        for (int i = 0; i < 16; ++i) { const int p = F.tid + NTHREADS * i, row = p >> 5, c = p & 31;
            const v4u v = *(const v4u*)(Kb + (size_t)(b * MEM + row) * 2048 + hd * 256 + c * 8); *(LAS v4u*)(KS + row * KSTR + c * 16) = v; }
        __syncthreads();
        f32x16 st[8];
#pragma unroll
        for (int kt = 0; kt < 8; ++kt)
#pragma unroll
            for (int i = 0; i < 16; ++i) st[kt][i] = 0.f;
        {
            const LAS unsigned char* kb = KS + r * KSTR + 16 * h5;
            bf16x8 kbuf[2][4];
#pragma unroll
            for (int j = 0; j < 4; ++j) kbuf[0][j] = *(const LAS bf16x8*)(kb + (32 * j) * KSTR);
            SBAR0();
#pragma unroll
            for (int t = 0; t < 32; ++t) {
                const int ks = t >> 1, hf = t & 1;
                if (t + 1 < 32) { const int ks2 = (t + 1) >> 1, hf2 = (t + 1) & 1;
#pragma unroll
                    for (int j = 0; j < 4; ++j) kbuf[(t + 1) & 1][j] = *(const LAS bf16x8*)(kb + (32 * (4 * hf2 + j)) * KSTR + 32 * ks2); }
                SBAR0();
#pragma unroll
                for (int j = 0; j < 4; ++j) st[4 * hf + j] = MFMA32(kbuf[t & 1][j], qf[ks & 3], st[4 * hf + j]);
                if (hf == 1 && ks + 4 < 16) qf[ks & 3] = *(const bf16x8*)(qp + 16 * (ks + 4));
                SBAR0();
            }
        }
        float m = -INFINITY;
#pragma unroll
        for (int kt = 0; kt < 8; ++kt)
#pragma unroll
            for (int i = 0; i < 16; ++i) m = fmaxf(m, st[kt][i]);
        m = swap32_max(m);
        float l = 0.f;
#pragma unroll
        for (int kt = 0; kt < 8; ++kt)
#pragma unroll
            for (int i = 0; i < 16; ++i) { const float p = __builtin_amdgcn_exp2f(st[kt][i] - m); st[kt][i] = p; l += p; }
        l = swap32_sum(l);
        bf16x8 pf[8][2];
#pragma unroll
        for (int kt = 0; kt < 8; ++kt) { pf[kt][0] = pack_step(st[kt], 0); pf[kt][1] = pack_step(st[kt], 1); }
        __syncthreads();
        { const bf16_t* vsrc = Vt + (size_t)(b * XH + hd) * XHD * MEM; int tid2 = F.tid; asm volatile("" : "+v"(tid2));
#pragma unroll
          for (int i = 0; i < 16; ++i) { const int p = tid2 + NTHREADS * i, row = p >> 5, c = p & 31;
              const v4u v = *(const v4u*)(vsrc + (size_t)row * MEM + c * 8); LAS v2u* d = (LAS v2u*)(KS + row * VSTR + c * 16); d[0] = (v2u){v.x, v.y}; d[1] = (v2u){v.z, v.w}; } }
        __syncthreads();
        const float inv = 1.f / l;
        bf16_t* op = Ob + qrow * D + hd * 256 + 4 * h5;
#pragma unroll 1
        for (int half = 0; half < 2; ++half) {
            f32x16 o[4];
#pragma unroll
            for (int dt = 0; dt < 4; ++dt)
#pragma unroll
                for (int i = 0; i < 16; ++i) o[dt][i] = 0.f;
            const LAS unsigned char* vb = KS + (128 * half + r) * VSTR + 8 * h5;
            bf16x8 vbuf[2][4];
#pragma unroll
            for (int dt = 0; dt < 4; ++dt) vbuf[0][dt] = lds_frag2x8(vb + (32 * dt) * VSTR);
            SBAR0();
#pragma unroll
            for (int t = 0; t < 16; ++t) {
                if (t + 1 < 16) {
#pragma unroll
                    for (int dt = 0; dt < 4; ++dt) vbuf[(t + 1) & 1][dt] = lds_frag2x8(vb + (32 * dt) * VSTR + 32 * (t + 1)); }
                SBAR0();
#pragma unroll
                for (int dt = 0; dt < 4; ++dt) o[dt] = MFMA32(vbuf[t & 1][dt], pf[t >> 1][t & 1], o[dt]);
                SBAR0();
            }
#pragma unroll
            for (int dt = 0; dt < 4; ++dt)
#pragma unroll
                for (int g4 = 0; g4 < 4; ++g4) { v2u uu; uu.x = pkbf(o[dt][4 * g4 + 0] * inv, o[dt][4 * g4 + 1] * inv); uu.y = pkbf(o[dt][4 * g4 + 2] * inv, o[dt][4 * g4 + 3] * inv); *(v2u*)(op + 128 * half + 32 * dt + 8 * g4) = uu; }
        }
        __syncthreads();
    }
}
}
namespace mk {
#ifndef MK_HAVE_SWA
#define MK_HAVE_SWA 1
#endif
#ifndef MK_HAVE_XATTN
#define MK_HAVE_XATTN 1
#endif
constexpr int NPHASE = 26;

typedef const __attribute__((address_space(4))) Args* KArgs;
__device__ __forceinline__ KArgs kargs() { KArgs p = (KArgs)__builtin_amdgcn_kernarg_segment_ptr(); asm volatile("" : "+s"(p)); return p; }

__device__ __forceinline__ bool in_range(int k) { KArgs ka = kargs(); return ka->ph_lo <= k && k < ka->ph_hi; }

__global__ void __launch_bounds__(NTHREADS, 2) mega(Args a) {
    extern __shared__ __attribute__((aligned(16))) unsigned char lds_raw[];
    LAS unsigned char* const F0lds = (LAS unsigned char*)lds_raw;
    const int F0wave = __builtin_amdgcn_readfirstlane((int)threadIdx.x >> 6);
    const int F0G = gridDim.x, F0bx = blockIdx.x, F0vcu = (F0G % 8 == 0) ? (F0bx % 8) * (F0G / 8) + F0bx / 8 : F0bx;
    volatile LAS unsigned* MISC = (volatile LAS unsigned*)(F0lds + MISC_OFF);
    if (threadIdx.x < 64) MISC[threadIdx.x] = 0u;
    __syncthreads();
    unsigned* ctl = (unsigned*)(a.ws + WS_CTL);
    XcdBarrier bar = xcd_barrier_post(ctl + CW_BAR + a.ph_lo * XCD_BAR_WORDS, MISC + 8, F0wave);
#define IN(k) in_range(k)
#define SEAM(k) do { if (IN(k) && IN((k) + 1)) { XcdBarrier b2_ = bar; asm volatile("" : "+s"(b2_.bar), "+s"(b2_.x)); xcd_barrier(b2_); } } while (0)
#define PH KArgs ka = kargs(); unsigned char* ws = ka->ws; (void)ws; Frame Fp; Fp.lds = F0lds; Fp.wave = F0wave; Fp.vcu = F0vcu; Fp.G = F0G; Fp.bx = F0bx; asm volatile("" : "+s"(Fp.wave), "+s"(Fp.vcu), "+s"(Fp.G), "+s"(Fp.bx)); \
    Fp.lane = (int)lane_id_fresh(); Fp.tid = Fp.wave * 64 + Fp.lane; const Frame& F = Fp; \
    const int bx = Fp.bx; (void)bx; LAS unsigned char* glds = F.lds; (void)glds; \
    bf16_t* RA = (bf16_t*)(ws + WS_A); bf16_t* RB = (bf16_t*)(ws + WS_B); bf16_t* RC = (bf16_t*)(ws + WS_C); bf16_t* RD = (bf16_t*)(ws + WS_D); bf16_t* WB = (bf16_t*)(ws + WS_WB); \
    (void)RA; (void)RB; (void)RC; (void)RD; (void)WB;
#define PHC PH const int cb = L == 0 ? 12 : 28; (void)cb; bf16_t* WBl = WB + WB_LAYER + (size_t)L * WL_SIZE; (void)WBl; \
    bf16_t *X1 = RB, *Qb, *Ob, *Y2, *X2, *HS = RB, *DS = RD, *X3; if (L == 0) { Qb = RA; Ob = RC; Y2 = RA; X2 = RC; X3 = RA; } else { Qb = RC; Ob = RD; Y2 = RC; X2 = RA; X3 = nullptr; } \
    (void)X1; (void)Qb; (void)Ob; (void)Y2; (void)X2; (void)HS; (void)DS; (void)X3;
#ifndef DOUBLE_MASK
#define DOUBLE_MASK 0u
#endif
#if DOUBLE_MASK != 0
#define REP(k) for (int rep_ = 0, nrep_ = 1 + (int)((DOUBLE_MASK >> (k)) & 1u); rep_ < nrep_; ++rep_)
#else
#define REP(k)
#endif
#define INF(i) ((const float*)ka->in[i])
#define WSI(off) ((int*)(ws + (off)))
#define WSF(off) ((float*)(ws + (off)))

    for (int L = 0; L < 2; ++L) {
        const int pb = 13 * L;
        if (L == 0) {
            if (IN(0)) REP(0) { PH
                LAS float* scr = (LAS float*)(F.lds + F.wave * 16384);
                const int gw = F.vcu * NWAVES + F.wave, NGW = F.G * NWAVES;
                constexpr int NITEMS = 896 + 512 + 512 + 128 + 512 + 2 * (512 + 1024 + 512 + 3 * 4096);
                for (int it = gw; it < NITEMS; it += NGW) {
                    int r = it;
#define JOB(MAP, src, K_, N_, dst, dstb, cnt) if (r < (cnt)) { transpose_job_item<MAP>((const float*)(src), K_, N_, dst, dstb, r, scr, F.lane); continue; } r -= (cnt);
                    JOB(0, ka->in[5], 1024, 1792, WB + WB_IN0, 0, 896)
                    JOB(0, ka->in[11], 1024, 1024, WB + WB_OUT0, 0, 512)
                    JOB(0, ka->in[24], 1024, 1024, WB + WB_IN1, 0, 512)
                    if (r < 128) { transpose_job_item<0>((const float*)ka->in[25], 256, 256, WB + WB_POOL, (size_t)256 * 256, r, scr, F.lane, (const float*)ka->in[26]); continue; } r -= 128;
                    JOB(0, ka->in[27], 1024, 1024, WB + WB_OUT1, 0, 512)
#define LAYER_JOBS(l, c2) { bf16_t* Wl = WB + WB_LAYER + (size_t)(l) * WL_SIZE; \
                        JOB(0, ka->in[(c2) + 2], 1024, 1024, Wl + WL_XQ, 0, 512) \
                        JOB(0, ka->in[(c2) + 3], 1024, 2048, Wl + WL_XKV, 0, 1024) \
                        JOB(0, ka->in[(c2) + 4], 1024, 1024, Wl + WL_XO, 0, 512) \
                        JOB(1, ka->in[(c2) + 7], 1024, 512, Wl + WL_GU, (size_t)1024 * 1024, 4096) \
                        JOB(2, ka->in[(c2) + 8], 1024, 512, Wl + WL_GU, (size_t)1024 * 1024, 4096) \
                        JOB(0, ka->in[(c2) + 9], 512, 1024, Wl + WL_DN, (size_t)1024 * 512, 4096) }
                    LAYER_JOBS(0, 12)
                    LAYER_JOBS(1, 28)
#undef LAYER_JOBS
#undef JOB
                }
                const int gt = F.vcu * NTHREADS + F.tid, NGT = F.G * NTHREADS;
                { const float4* x4 = (const float4*)ka->in[0]; v2u* o = (v2u*)RA;
                  for (int i = gt; i < T * D / 4; i += NGT) { const float4 v = x4[i]; v2u w; w.x = pk2(v.x, v.y); w.y = pk2(v.z, v.w); o[i] = w; } }
                { const float4* m4 = (const float4*)ka->in[1]; v2u* o = (v2u*)(ws + WS_MEMB);
                  for (int i = gt; i < B * MEM * D / 4; i += NGT) { const float4 v = m4[i]; v2u w; w.x = pk2(v.x, v.y); w.y = pk2(v.z, v.w); o[i] = w; } }
                { const int* positions = (const int*)ka->in[2]; float* ropew = WSF(WS_ROPE);
                  for (int t = gt; t < T; t += NGT) { const float p = (float)positions[t];
#pragma unroll
                      for (int j = 0; j < 8; ++j) { const float ang = p * ka->inv.f[j]; double rev = (double)ang * 0.15915494309189535; rev -= rint(rev); const float rr = (float)rev;
                          ropew[(size_t)t * 16 + j] = __builtin_amdgcn_cosf(rr); ropew[(size_t)t * 16 + 8 + j] = __builtin_amdgcn_sinf(rr); } } }
                { const float* sw = INF(9); bf16_t* o = WB + WB_SGUW;
                  for (int i = gt; i < 8 * 128 * 128; i += NGT) { const int s = i & 127, t = (i >> 7) & 127; o[i] = f2bf(s <= t ? sw[i] : 0.f); } }
            }
            SEAM(0);
            if (IN(1)) REP(1) { PH float* rope = WSF(WS_ROPE); bf16_t* MEMB = (bf16_t*)(ws + WS_MEMB);
#pragma unroll 1
                for (int l = 0; l < 2; ++l) {
                    bf16_t* Wl = WB + WB_LAYER + (size_t)l * WL_SIZE;
                    pg8::Gemm g{MEMB, Wl + WL_XKV, nullptr};
                    const int c2 = bx - 128 - 32 * l;
                    pg8::StaticOrder S; S.init(B * MEM, 2048, F.G, (c2 >= 0 && c2 < 32) ? c2 : (1 << 20));
                    pg8::EpiKV E{(bf16_t*)(ws + WS_MEMKV) + (size_t)l * B * MEM * 2048, (bf16_t*)(ws + WS_MEMVT) + (size_t)l * B * MEM * 1024};
                    pg8::gemm_phase<pg8::EpiKV, pg8::StaticOrder, true, true, false, D, D, D, 0>(glds, F.tid, g, S, E);
                }
                {
                    pg8::Gemm g{RA, WB + WB_IN0, nullptr};
                    pg8::StaticOrder S; S.init(T, NIN0, F.G, bx);
                    pg8::EpiInproj0 E{RD, rope};
                    pg8::gemm_phase<pg8::EpiInproj0, pg8::StaticOrder, true, true, false, D, D, D, 0>(glds, F.tid, g, S, E);
                }
            }
            SEAM(1);
            if (IN(2)) REP(2) { PH
#if MK_HAVE_SWA
                phase_swa_sgu(F, RD, INF(6), INF(7), INF(8), WB + WB_SGUW, INF(10), RB);
#endif
            }
            SEAM(2);
            if (IN(3)) REP(3) { PH
                pg8::Gemm g{RB, WB + WB_OUT0, nullptr};
                pg8::StaticOrder S; S.init(T, D, F.G, bx);
                pg8::EpiBf16 E{RC, D, 1.f};
                pg8::gemm_phase<pg8::EpiBf16, pg8::StaticOrder, true, true, false, D, D, D, 0>(glds, F.tid, g, S, E);
            }
            SEAM(3);
            if (IN(4)) REP(4) { PH phase_ln_add(F, RA, RC, INF(12), INF(13), RB); }
            SEAM(4);
        } else {
            if (IN(13)) REP(13) { PH
                pg8::Gemm g{RA, WB + WB_IN1, nullptr};
                pg8::StaticOrder S; S.init(T, D, F.G, bx);
                pg8::EpiBf16 E{RB, D, 1.f};
                pg8::gemm_phase<pg8::EpiBf16, pg8::StaticOrder, true, true, false, D, D, D, 0>(glds, F.tid, g, S, E);
            }
            SEAM(13);
            if (IN(14)) REP(14) { PH phase_pool(F, RB, RC); }
            SEAM(14);
            if (IN(15)) REP(15) { PH
                pg8::Gemm g{RC, WB + WB_POOL, nullptr};
                pg8::StaticOrder S; S.init(T, D, F.G, bx);
                pg8::EpiBf16 E{RD, D, 1.f};
                pg8::gemm_phase<pg8::EpiBf16, pg8::StaticOrder, true, true, false, D, 256, 256, 256>(glds, F.tid, g, S, E);
            }
            SEAM(15);
            if (IN(16)) REP(16) { PH
                pg8::Gemm g{RD, WB + WB_OUT1, nullptr};
                pg8::StaticOrder S; S.init(T, D, F.G, bx);
                pg8::EpiBf16 E{RC, D, 1.f};
                pg8::gemm_phase<pg8::EpiBf16, pg8::StaticOrder, true, true, false, D, D, D, 0>(glds, F.tid, g, S, E);
            }
            SEAM(16);
            if (IN(17)) REP(17) { PH phase_ln_add(F, RA, RC, INF(28), INF(29), RB); }
            SEAM(17);
        }
        if (IN(pb + 5)) REP(pb + 5) { PHC
            pg8::Gemm g{X1, WBl + WL_XQ, nullptr};
            pg8::StaticOrder S; S.init(T, D, F.G, bx);
            pg8::EpiBf16 E{Qb, D, QSCALE};
            pg8::gemm_phase<pg8::EpiBf16, pg8::StaticOrder, true, true, false, D, D, D, 0>(glds, F.tid, g, S, E);
        }
        SEAM(pb + 5);
        if (IN(pb + 6)) REP(pb + 6) { PHC bf16_t* Kb = (bf16_t*)(ws + WS_MEMKV) + (size_t)L * B * MEM * 2048; bf16_t* Vt = (bf16_t*)(ws + WS_MEMVT) + (size_t)L * B * MEM * 1024; (void)Kb; (void)Vt;
#if MK_HAVE_XATTN
            phase_xattn(F, Qb, Kb, Vt, Ob);
#endif
        }
        SEAM(pb + 6);
        if (IN(pb + 7)) REP(pb + 7) { PHC
            pg8::Gemm g{Ob, WBl + WL_XO, nullptr};
            pg8::StaticOrder S; S.init(T, D, F.G, bx);
            pg8::EpiBf16 E{Y2, D, 1.f};
            pg8::gemm_phase<pg8::EpiBf16, pg8::StaticOrder, true, true, false, D, D, D, 0>(glds, F.tid, g, S, E);
        }
        SEAM(pb + 7);
        if (IN(pb + 8)) REP(pb + 8) { PHC phase_ln_router(F, X1, Y2, INF(cb + 5), INF(cb + 6), X2, INF(3), INF(4), WSI(WS_EIDX), WSF(WS_EWGT), WSI(WS_BCNT)); }
        SEAM(pb + 8);
        if (IN(pb + 9)) REP(pb + 9) { PHC phase_moe_book(F, WSI(WS_EIDX), WSI(WS_BCNT), WSI(WS_TOK), WSI(WS_POS), WSI(WS_TILE)); }
        SEAM(pb + 9);
        if (IN(pb + 10)) REP(pb + 10) { PHC const int* tile_e = WSI(WS_TILE); const int* tok = WSI(WS_TOK);
            const int ntiles = __builtin_amdgcn_readfirstlane(tile_e[NTILE]);
            pg8::Gemm g{X2, WBl + WL_GU, tok};
            pg8::MoeOrder S; S.init(ntiles, tile_e, F.G, bx);
            pg8::EpiGU E{HS};
            pg8::gemm_phase<pg8::EpiGU, pg8::MoeOrder, true, true, true, D, D, D, 0>(glds, F.tid, g, S, E);
        }
        SEAM(pb + 10);
        if (IN(pb + 11)) REP(pb + 11) { PHC const int* tile_e = WSI(WS_TILE);
            const int ntiles = __builtin_amdgcn_readfirstlane(tile_e[NTILE]);
            pg8::Gemm g{HS, WBl + WL_DN, nullptr};
            pg8::MoeOrder S; S.init(ntiles, tile_e, F.G, bx);
            pg8::EpiBf16 E{DS, D, 1.f};
            pg8::gemm_phase<pg8::EpiBf16, pg8::MoeOrder, true, true, false, DE, DE, DE, 0>(glds, F.tid, g, S, E);
        }
        SEAM(pb + 11);
        if (IN(pb + 12)) REP(pb + 12) { PHC phase_ln_moe(F, X2, DS, WSI(WS_POS), WSF(WS_EWGT), INF(cb + 10), INF(cb + 11), X3, L == 1 ? ka->out : nullptr); }
        SEAM(pb + 12);
    }
#undef IN
#undef SEAM
#undef INF
#undef PH
#undef PHC
#undef WSI
#undef WSF
}
}
namespace nv {
template <class Epi>
__global__ __launch_bounds__(256) void k_gemm(const bf16_t* A, int lda, const float* W, int ldw, int K, Epi epi, const int* tile_e, size_t w_stride, const int* arow) {
    __shared__ float As[16][68];
    __shared__ float Bs[16][68];
    const int bm = blockIdx.y * 64, bn = blockIdx.x * 64;
    const float* Wp = W;
    if (tile_e) { const int e = tile_e[bm >> 8]; if (e < 0) return; Wp += (size_t)e * w_stride; }
    const int tid = threadIdx.x, tx = tid & 15, ty = tid >> 4;
    float acc[4][4];
#pragma unroll
    for (int i = 0; i < 4; ++i)
#pragma unroll
        for (int j = 0; j < 4; ++j) acc[i][j] = 0.f;
    for (int k0 = 0; k0 < K; k0 += 16) {
        {
            const int r = tid >> 2, kk = (tid & 3) * 4;
            const int ar = arow ? arow[bm + r] : bm + r;
            const ushort4 v = *(const ushort4*)(A + (size_t)ar * lda + k0 + kk);
            As[kk + 0][r] = bf2f(v.x); As[kk + 1][r] = bf2f(v.y); As[kk + 2][r] = bf2f(v.z); As[kk + 3][r] = bf2f(v.w);
        }
        {
            const int kk = tid >> 4, n = (tid & 15) * 4;
            const float4 v = *(const float4*)(Wp + (size_t)(k0 + kk) * ldw + bn + n);
            Bs[kk][n + 0] = v.x; Bs[kk][n + 1] = v.y; Bs[kk][n + 2] = v.z; Bs[kk][n + 3] = v.w;
        }
        __syncthreads();
#pragma unroll
        for (int kk = 0; kk < 16; ++kk) {
            float a[4], b[4];
#pragma unroll
            for (int i = 0; i < 4; ++i) a[i] = As[kk][ty * 4 + i];
#pragma unroll
            for (int j = 0; j < 4; ++j) b[j] = Bs[kk][tx * 4 + j];
#pragma unroll
            for (int i = 0; i < 4; ++i)
#pragma unroll
                for (int j = 0; j < 4; ++j) acc[i][j] += a[i] * b[j];
        }
        __syncthreads();
    }
#pragma unroll
    for (int i = 0; i < 4; ++i)
#pragma unroll
        for (int j = 0; j < 4; ++j) epi(bm + ty * 4 + i, bn + tx * 4 + j, acc[i][j]);
}

struct EpiBf16 { bf16_t* O; int ldo; float scale; __device__ void operator()(int r, int c, float v) const { O[(size_t)r * ldo + c] = f2bf(v * scale); } };
struct EpiInproj0 { bf16_t* O; __device__ void operator()(int r, int c, float v) const { if (c >= 768) v = gelu_tanh(v); O[(size_t)r * NIN0 + c] = f2bf(v); } };
struct EpiF32 { float* O; int ldo; __device__ void operator()(int r, int c, float v) const { O[(size_t)r * ldo + c] = v; } };
struct EpiSiluMul { const float* G; bf16_t* HS; __device__ void operator()(int r, int c, float v) const { HS[(size_t)r * DE + c] = f2bf(silu(G[(size_t)r * DE + c]) * v); } };
struct EpiKV { bf16_t* Kb; bf16_t* Vt; __device__ void operator()(int r, int c, float v) const {
    Kb[(size_t)r * 2048 + c] = f2bf(v);
    if (c >= 1024) { const int d = c - 1024, h = d >> 8, dd = d & 255, b = r >> 8, key = r & 255; Vt[((size_t)(b * XH + h) * XHD + dd) * MEM + key] = f2bf(v); } } };
struct EpiPoolMap { bf16_t* O; const float* scale; int coff; __device__ void operator()(int r, int c, float v) const { O[(size_t)r * D + coff + c] = f2bf(v * scale[coff + c]); } };

__global__ void k_cvt_x(const float* x, bf16_t* xb, size_t n4) {
    for (size_t i = (size_t)blockIdx.x * blockDim.x + threadIdx.x; i < n4; i += (size_t)gridDim.x * blockDim.x) {
        const float4 v = ((const float4*)x)[i];
        ushort4 o; o.x = f2bf(v.x); o.y = f2bf(v.y); o.z = f2bf(v.z); o.w = f2bf(v.w);
        ((ushort4*)xb)[i] = o;
    }
}
struct InvFreq { float f[8]; };
__global__ void k_rope_table(const int* positions, float* tab, InvFreq inv) {
    const int t = blockIdx.x * blockDim.x + threadIdx.x;
    if (t >= T) return;
    const float p = (float)positions[t];
#pragma unroll
    for (int j = 0; j < 8; ++j) {
        const float ang = p * inv.f[j];
        double rev = (double)ang * 0.15915494309189535; rev -= rint(rev);
        const float r = (float)rev;
        tab[(size_t)t * 16 + j] = __builtin_amdgcn_cosf(r);
        tab[(size_t)t * 16 + 8 + j] = __builtin_amdgcn_sinf(r);
    }
}
__global__ void k_rope_apply(bf16_t* H0, const float* tab) {
    const int i = blockIdx.x * blockDim.x + threadIdx.x;
    if (i >= T * 80) return;
    const int t = i / 80, r = i % 80, hd = r >> 3, j = r & 7;
    bf16_t* p = H0 + (size_t)t * NIN0 + hd * 64;
    const float t1 = bf2f(p[j]), t2 = bf2f(p[j + 8]);
    const float c = tab[(size_t)t * 16 + j], s = tab[(size_t)t * 16 + 8 + j];
    p[j] = f2bf(t1 * c - t2 * s); p[j + 8] = f2bf(t2 * c + t1 * s);
}

__global__ __launch_bounds__(128) void k_swa(const bf16_t* H0, const float* sinks, bf16_t* MIX) {
    __shared__ float Ks[256][65];
    __shared__ float Vs[256][65];
    const int head = blockIdx.x & 7, bn = blockIdx.x >> 3, n = bn & 63, b = bn >> 6;
    const int kvh = head >> 2;
    const int tid = threadIdx.x;
    const size_t row0 = (size_t)b * S + (size_t)n * 128;
    for (int idx = tid; idx < 256 * 64; idx += 128) {
        const int kj = idx >> 6, d = idx & 63;
        float kv = 0.f, vv = 0.f;
        if (n > 0 || kj >= 128) {
            const size_t row = row0 - 128 + kj;
            kv = bf2f(H0[row * NIN0 + 512 + kvh * 64 + d]);
            vv = bf2f(H0[row * NIN0 + 640 + kvh * 64 + d]);
        }
        Ks[kj][d] = kv; Vs[kj][d] = vv;
    }
    __syncthreads();
    float q[64], o[64];
    const bf16_t* qp = H0 + (row0 + tid) * NIN0 + head * 64;
#pragma unroll
    for (int d = 0; d < 64; ++d) { q[d] = bf2f(qp[d]) * ASCALE; o[d] = 0.f; }
    const float sink = sinks[head] * 1.4426950408889634f;
    float m = sink, l = 1.f;
    for (int kj = tid + 1; kj <= tid + 128; ++kj) {
        if (n == 0 && kj < 128) continue;
        float s = 0.f;
#pragma unroll
        for (int d = 0; d < 64; ++d) s += q[d] * Ks[kj][d];
        const float mn = fmaxf(m, s), sc = exp2f(m - mn), p = exp2f(s - mn);
        l = l * sc + p; m = mn;
#pragma unroll
        for (int d = 0; d < 64; ++d) o[d] = o[d] * sc + p * Vs[kj][d];
    }
    const float inv = 1.f / l;
    bf16_t* op = MIX + (row0 + tid) * D + head * 64;
#pragma unroll
    for (int d = 0; d < 64; ++d) op[d] = f2bf(o[d] * inv);
}

__global__ void k_sgu_ln(const bf16_t* H0, const float* lg, const float* lb, bf16_t* VG) {
    const int i = blockIdx.x * blockDim.x + threadIdx.x;
    if (i >= T * 8) return;
    const int t = i >> 3, g = i & 7;
    const bf16_t* p = H0 + (size_t)t * NIN0 + 1280 + g * 64;
    float s = 0.f;
    for (int c = 0; c < 64; ++c) s += bf2f(p[c]);
    const float mu = s * (1.f / 64.f);
    float q = 0.f;
    for (int c = 0; c < 64; ++c) { const float d = bf2f(p[c]) - mu; q += d * d; }
    const float rstd = 1.f / sqrtf(q * (1.f / 64.f) + LN_EPS);
    for (int c = 0; c < 64; ++c) VG[(size_t)t * 512 + g * 64 + c] = f2bf((bf2f(p[c]) - mu) * rstd * lg[g * 64 + c] + lb[g * 64 + c]);
}
__global__ void k_sgu_mix(const bf16_t* H0, const bf16_t* VG, const float* w, const float* bs, bf16_t* MIX) {
    const size_t i = (size_t)blockIdx.x * blockDim.x + threadIdx.x;
    if (i >= (size_t)T * 512) return;
    const int t = (int)(i >> 9), ch = (int)(i & 511), g = ch >> 6, tl = t & 127;
    const size_t c0 = (size_t)(t - tl);
    const float* wr = w + ((size_t)g * 128 + tl) * 128;
    float acc = 0.f;
    for (int s = 0; s <= tl; ++s) acc += wr[s] * bf2f(VG[(c0 + s) * 512 + ch]);
    acc += bs[g * 128 + tl];
    MIX[(size_t)t * D + 512 + ch] = f2bf(bf2f(H0[(size_t)t * NIN0 + 768 + ch]) * acc);
}

struct Row16 { float v[4][4]; };
__device__ __forceinline__ void load_row_bf16(const bf16_t* p, int lane, Row16& r) {
#pragma unroll
    for (int j = 0; j < 4; ++j) { const ushort4 u = *(const ushort4*)(p + 256 * j + 4 * lane); r.v[j][0] = bf2f(u.x); r.v[j][1] = bf2f(u.y); r.v[j][2] = bf2f(u.z); r.v[j][3] = bf2f(u.w); }
}
__device__ __forceinline__ void ln_row(Row16& z, const float* g, const float* b, int lane) {
    float s = 0.f;
#pragma unroll
    for (int j = 0; j < 4; ++j)
#pragma unroll
        for (int i = 0; i < 4; ++i) s += z.v[j][i];
    const float mu = wave_sum(s) * (1.f / D);
    float q = 0.f;
#pragma unroll
    for (int j = 0; j < 4; ++j)
#pragma unroll
        for (int i = 0; i < 4; ++i) { z.v[j][i] -= mu; q += z.v[j][i] * z.v[j][i]; }
    const float rstd = 1.f / sqrtf(wave_sum(q) * (1.f / D) + LN_EPS);
#pragma unroll
    for (int j = 0; j < 4; ++j) { const float4 gg = *(const float4*)(g + 256 * j + 4 * lane), bb = *(const float4*)(b + 256 * j + 4 * lane);
        z.v[j][0] = z.v[j][0] * rstd * gg.x + bb.x; z.v[j][1] = z.v[j][1] * rstd * gg.y + bb.y; z.v[j][2] = z.v[j][2] * rstd * gg.z + bb.z; z.v[j][3] = z.v[j][3] * rstd * gg.w + bb.w; }
}
__device__ __forceinline__ void store_row_bf16(bf16_t* p, int lane, const Row16& r) {
#pragma unroll
    for (int j = 0; j < 4; ++j) { ushort4 u; u.x = f2bf(r.v[j][0]); u.y = f2bf(r.v[j][1]); u.z = f2bf(r.v[j][2]); u.w = f2bf(r.v[j][3]); *(ushort4*)(p + 256 * j + 4 * lane) = u; }
}
__global__ __launch_bounds__(256) void k_ln_add(const bf16_t* X, const bf16_t* Y, const float* g, const float* b, bf16_t* out) {
    const int lane = threadIdx.x & 63, row = blockIdx.x * 4 + (threadIdx.x >> 6);
    Row16 x, y; load_row_bf16(X + (size_t)row * D, lane, x); load_row_bf16(Y + (size_t)row * D, lane, y);
#pragma unroll
    for (int j = 0; j < 4; ++j)
#pragma unroll
        for (int i = 0; i < 4; ++i) x.v[j][i] = ALPHA * x.v[j][i] + y.v[j][i];
    ln_row(x, g, b, lane);
    store_row_bf16(out + (size_t)row * D, lane, x);
}
__global__ __launch_bounds__(256) void k_ln_router(const bf16_t* X, const bf16_t* Y, const float* g, const float* b, bf16_t* out, const float* rw, const float* rbias, int* eidx, float* ewgt) {
    const int lane = threadIdx.x & 63, row = blockIdx.x * 4 + (threadIdx.x >> 6);
    Row16 x, y; load_row_bf16(X + (size_t)row * D, lane, x); load_row_bf16(Y + (size_t)row * D, lane, y);
#pragma unroll
    for (int j = 0; j < 4; ++j)
#pragma unroll
        for (int i = 0; i < 4; ++i) x.v[j][i] = ALPHA * x.v[j][i] + y.v[j][i];
    ln_row(x, g, b, lane);
    store_row_bf16(out + (size_t)row * D, lane, x);
    float lg[16];
#pragma unroll
    for (int e = 0; e < 16; ++e) lg[e] = 0.f;
#pragma unroll
    for (int j = 0; j < 4; ++j)
#pragma unroll
        for (int i = 0; i < 4; ++i) {
            const float* wr = rw + (size_t)(256 * j + 4 * lane + i) * 16;
            const float xv = x.v[j][i];
#pragma unroll
            for (int e4 = 0; e4 < 4; ++e4) { const float4 w4 = *(const float4*)(wr + 4 * e4); lg[4 * e4 + 0] += xv * w4.x; lg[4 * e4 + 1] += xv * w4.y; lg[4 * e4 + 2] += xv * w4.z; lg[4 * e4 + 3] += xv * w4.w; }
        }
#pragma unroll
    for (int e = 0; e < 16; ++e) lg[e] = wave_sum(lg[e]);
    float mx = lg[0];
#pragma unroll
    for (int e = 1; e < 16; ++e) mx = fmaxf(mx, lg[e]);
    float sc[16], sum = 0.f;
#pragma unroll
    for (int e = 0; e < 16; ++e) { sc[e] = expf(lg[e] - mx); sum += sc[e]; }
    const float isum = 1.f / sum;
    float bz[16];
#pragma unroll
    for (int e = 0; e < 16; ++e) { sc[e] *= isum; bz[e] = sc[e] + rbias[e]; }
    float gs[4]; int gi1[4], gi2[4];
#pragma unroll
    for (int gq = 0; gq < 4; ++gq) {
        float m1 = bz[4 * gq]; int i1 = 0;
#pragma unroll
        for (int j = 1; j < 4; ++j) if (bz[4 * gq + j] > m1) { m1 = bz[4 * gq + j]; i1 = j; }
        float m2 = -INFINITY; int i2 = 0;
#pragma unroll
        for (int j = 0; j < 4; ++j) if (j != i1 && bz[4 * gq + j] > m2) { m2 = bz[4 * gq + j]; i2 = j; }
        gs[gq] = m1 + m2; gi1[gq] = i1; gi2[gq] = i2;
    }
    int gsel = 0; float gm = gs[0];
#pragma unroll
    for (int gq = 1; gq < 4; ++gq) if (gs[gq] > gm) { gm = gs[gq]; gsel = gq; }
    int i1 = gi1[0], i2 = gi2[0];
#pragma unroll
    for (int gq = 1; gq < 4; ++gq) if (gsel == gq) { i1 = gi1[gq]; i2 = gi2[gq]; }
    const int e1 = gsel * 4 + i1, e2 = gsel * 4 + i2;
    float s1 = 0.f, s2 = 0.f;
#pragma unroll
    for (int e = 0; e < 16; ++e) { if (e == e1) s1 = sc[e]; if (e == e2) s2 = sc[e]; }
    const float inv = 1.f / (s1 + s2);
    if (lane == 0) { eidx[2 * row] = e1; eidx[2 * row + 1] = e2; ewgt[2 * row] = s1 * inv; ewgt[2 * row + 1] = s2 * inv; }
}
__global__ __launch_bounds__(256) void k_ln_moe(const bf16_t* X, const bf16_t* DS, const int* pos, const float* ewgt, const float* g, const float* b, bf16_t* outb, float* outf) {
    const int lane = threadIdx.x & 63, row = blockIdx.x * 4 + (threadIdx.x >> 6);
    Row16 x, y1, y2; load_row_bf16(X + (size_t)row * D, lane, x);
    const int r1 = pos[2 * row], r2 = pos[2 * row + 1]; const float w1 = ewgt[2 * row], w2 = ewgt[2 * row + 1];
    load_row_bf16(DS + (size_t)r1 * D, lane, y1); load_row_bf16(DS + (size_t)r2 * D, lane, y2);
#pragma unroll
    for (int j = 0; j < 4; ++j)
#pragma unroll
        for (int i = 0; i < 4; ++i) x.v[j][i] = ALPHA * x.v[j][i] + (w1 * y1.v[j][i] + w2 * y2.v[j][i]);
    ln_row(x, g, b, lane);
    if (outb) store_row_bf16(outb + (size_t)row * D, lane, x);
    if (outf) {
#pragma unroll
        for (int j = 0; j < 4; ++j) *(float4*)(outf + (size_t)row * D + 256 * j + 4 * lane) = make_float4(x.v[j][0], x.v[j][1], x.v[j][2], x.v[j][3]);
    }
}

__global__ __launch_bounds__(256) void k_xattn(const bf16_t* Q, const bf16_t* Kb, const bf16_t* Vt, bf16_t* O) {
    const int lane = threadIdx.x & 63;
    const int w = blockIdx.x * 4 + (threadIdx.x >> 6);
    const int t = w >> 2, h = w & 3, b = t / S;
    float q[4];
    { const ushort4 u = *(const ushort4*)(Q + (size_t)t * D + h * 256 + 4 * lane); q[0] = bf2f(u.x); q[1] = bf2f(u.y); q[2] = bf2f(u.z); q[3] = bf2f(u.w); }
    float sc[4];
#pragma unroll
    for (int jj = 0; jj < 4; ++jj) {
        sc[jj] = 0.f;
        for (int jl = 0; jl < 64; ++jl) {
            const int key = jj * 64 + jl;
            const ushort4 u = *(const ushort4*)(Kb + (size_t)(b * MEM + key) * 2048 + h * 256 + 4 * lane);
            float p = q[0] * bf2f(u.x) + q[1] * bf2f(u.y) + q[2] * bf2f(u.z) + q[3] * bf2f(u.w);
            p = wave_sum(p);
            if (lane == jl) sc[jj] = p;
        }
    }
    float m = fmaxf(fmaxf(sc[0], sc[1]), fmaxf(sc[2], sc[3])); m = wave_max(m);
    float l = 0.f;
#pragma unroll
    for (int jj = 0; jj < 4; ++jj) { sc[jj] = exp2f(sc[jj] - m); l += sc[jj]; }
    l = wave_sum(l);
    const float inv = 1.f / l;
    float o[4] = {0.f, 0.f, 0.f, 0.f};
    (void)Vt;
#pragma unroll
    for (int jj = 0; jj < 4; ++jj)
        for (int jl = 0; jl < 64; ++jl) {
            const float p = __shfl(sc[jj], jl);
            const int key = jj * 64 + jl;
            const ushort4 u = *(const ushort4*)(Kb + (size_t)(b * MEM + key) * 2048 + 1024 + h * 256 + 4 * lane);
            o[0] += p * bf2f(u.x); o[1] += p * bf2f(u.y); o[2] += p * bf2f(u.z); o[3] += p * bf2f(u.w);
        }
    ushort4 u; u.x = f2bf(o[0] * inv); u.y = f2bf(o[1] * inv); u.z = f2bf(o[2] * inv); u.w = f2bf(o[3] * inv);
    *(ushort4*)(O + (size_t)t * D + h * 256 + 4 * lane) = u;
}

__global__ __launch_bounds__(256) void k_moe_hist(const int* eidx, int* bcnt) {
    __shared__ int h[16];
    if (threadIdx.x < 16) h[threadIdx.x] = 0;
    __syncthreads();
    const int e = eidx[blockIdx.x * 256 + threadIdx.x];
    atomicAdd(&h[e], 1);
    __syncthreads();
    if (threadIdx.x < 16) bcnt[blockIdx.x * 16 + threadIdx.x] = h[threadIdx.x];
}
__global__ __launch_bounds__(256) void k_moe_scatter(const int* eidx, const int* bcnt, int* tok, int* pos, int* tile_e) {
    __shared__ int es[256], dst[256], off[17], base[16], tot[16];
    const int tid = threadIdx.x, blk = blockIdx.x;
    if (tid < 16) {
        int t = 0, bs = 0;
        for (int b2 = 0; b2 < 256; ++b2) { const int c = bcnt[b2 * 16 + tid]; t += c; if (b2 < blk) bs += c; }
        tot[tid] = t; base[tid] = bs;
    }
    es[tid] = eidx[blk * 256 + tid];
    __syncthreads();
    if (tid == 0) { int o = 0; for (int e = 0; e < 16; ++e) { off[e] = o; o += (tot[e] + 255) & ~255; } off[16] = o; }
    __syncthreads();
    {
        const int e = es[tid]; int rank = 0;
        for (int j = 0; j < tid; ++j) rank += (es[j] == e) ? 1 : 0;
        const int r = off[e] + base[e] + rank;
        dst[tid] = r; pos[blk * 256 + tid] = r; tok[r] = blk * 128 + (tid >> 1);
    }
    if (blk < 16) {
        const int e = blk, r0 = off[e] + tot[e], r1 = off[e + 1];
        for (int r = r0 + tid; r < r1; r += 256) tok[r] = 0;
    }
    if (blk == 16) {
        for (int tl = tid; tl < NTILE; tl += 256) { int e = -1; for (int k = 0; k < 16; ++k) if (tl * 256 >= off[k] && tl * 256 < off[k + 1]) e = k; tile_e[tl] = e; }
        if (tid == 0) tile_e[NTILE] = off[16] >> 8;
    }
}

__global__ void k_pool(const bf16_t* HP, bf16_t* PO) {
    const size_t i = (size_t)blockIdx.x * blockDim.x + threadIdx.x;
    if (i >= (size_t)T * D) return;
    const int t = (int)(i >> 10), c = (int)(i & 1023), g = c >> 8, win = 2 << g, ts = t & (S - 1);
    const int n = ts + 1 < win ? ts + 1 : win;
    float s = 0.f;
    for (int k = 0; k < n; ++k) s += bf2f(HP[(size_t)(t - k) * D + c]);
    PO[i] = f2bf(s / (float)n - bf2f(HP[i]));
}
}

using namespace nv;
template <class Epi>
static void ngemm(hipStream_t st, const bf16_t* A, int lda, const float* W, int ldw, int M, int N, int K, Epi epi, const int* tile_e = nullptr, size_t w_stride = 0, const int* arow = nullptr) {
    hipLaunchKernelGGL((k_gemm<Epi>), dim3(N / 64, M / 64), dim3(256), 0, st, A, lda, W, ldw, K, epi, tile_e, w_stride, arow);
}

#ifndef MEGA_MASK
#define MEGA_MASK 0x3ffffffu
#endif

extern "C" void kernel_launch(void* const* d_in, const int* in_sizes, int n_in, void* d_out, int out_size, void* d_ws, size_t ws_size, hipStream_t stream) {
    (void)in_sizes; (void)out_size;
    if (ws_size < WS_END || n_in != 40) return;
    static int grid = 0;
    if (grid == 0) {
        int dev = 0, cus = 0;
        if (hipGetDevice(&dev) != hipSuccess || hipDeviceGetAttribute(&cus, hipDeviceAttributeMultiprocessorCount, dev) != hipSuccess) { grid = -1; return; }
        if (hipFuncSetAttribute((const void*)mk::mega, hipFuncAttributeMaxDynamicSharedMemorySize, mk::LDS_BYTES) != hipSuccess) { grid = -1; return; }
        int per_cu = 0;
        if (hipOccupancyMaxActiveBlocksPerMultiprocessor(&per_cu, (const void*)mk::mega, mk::NTHREADS, mk::LDS_BYTES) != hipSuccess || per_cu < 1) { (void)hipGetLastError(); }
        grid = cus;
    }
    if (grid < 0) return;
    unsigned char* ws = (unsigned char*)d_ws;
    (void)hipMemsetAsync(ws + WS_CTL, 0, 512 * 1024, stream);
    mk::Args a{};
    for (int i = 0; i < 40; ++i) a.in[i] = d_in[i];
    a.out = (float*)d_out; a.ws = ws;
    for (int j = 0; j < 8; ++j) a.inv.f[j] = (float)pow(500000.0, -(double)((float)j * 2.0f / 16.0f));
    auto F = [&](int i) { return (const float*)d_in[i]; };
    const float* router_w = F(3); const float* router_b = F(4);
    float* rope = (float*)(ws + WS_ROPE); int* eidx = (int*)(ws + WS_EIDX); float* ewgt = (float*)(ws + WS_EWGT); int* pos = (int*)(ws + WS_POS);
    int* bcnt = (int*)(ws + WS_BCNT); int* tile_e = (int*)(ws + WS_TILE); int* tok = (int*)(ws + WS_TOK);
    bf16_t* RA = (bf16_t*)(ws + WS_A); bf16_t* RB = (bf16_t*)(ws + WS_B); bf16_t* RC = (bf16_t*)(ws + WS_C); bf16_t* RD = (bf16_t*)(ws + WS_D);
    bf16_t* MEMB = (bf16_t*)(ws + WS_MEMB);
    const unsigned mask = MEGA_MASK;
    int p = 0;
    while (p < mk::NPHASE) {
        if (mask & (1u << p)) {
            int q = p; while (q < mk::NPHASE && (mask & (1u << q))) ++q;
            a.ph_lo = p; a.ph_hi = q;
            hipLaunchKernelGGL(mk::mega, dim3(grid), dim3(mk::NTHREADS), mk::LDS_BYTES, stream, a);
            p = q; continue;
        }
        const int L = p / 13, lp = p % 13, cb = L == 0 ? 12 : 28;
        bf16_t* Kb = (bf16_t*)(ws + WS_MEMKV) + (size_t)L * B * MEM * 2048; bf16_t* Vt = (bf16_t*)(ws + WS_MEMVT) + (size_t)L * B * MEM * 1024;
        bf16_t *X1 = RB, *Qb, *Ob, *Y2, *X2, *HS = RB, *DS = RD, *X3; float* G = (float*)RD;
        if (L == 0) { Qb = RA; Ob = RC; Y2 = RA; X2 = RC; X3 = RA; } else { Qb = RC; Ob = RD; Y2 = RC; X2 = RA; X3 = nullptr; }
        if (L == 0 && lp == 0) {
            hipLaunchKernelGGL(k_cvt_x, dim3(2048), dim3(256), 0, stream, F(0), RA, (size_t)T * D / 4);
            hipLaunchKernelGGL(k_cvt_x, dim3(256), dim3(256), 0, stream, F(1), MEMB, (size_t)B * MEM * D / 4);
            nv::InvFreq inv; for (int j = 0; j < 8; ++j) inv.f[j] = a.inv.f[j];
            hipLaunchKernelGGL(k_rope_table, dim3(T / 256), dim3(256), 0, stream, (const int*)d_in[2], rope, inv);
        } else if (L == 0 && lp == 1) {
            for (int l = 0; l < 2; ++l) ngemm(stream, MEMB, D, F((l == 0 ? 12 : 28) + 3), 2048, B * MEM, 2048, D, nv::EpiKV{(bf16_t*)(ws + WS_MEMKV) + (size_t)l * B * MEM * 2048, (bf16_t*)(ws + WS_MEMVT) + (size_t)l * B * MEM * 1024});
            ngemm(stream, RA, D, F(5), NIN0, T, NIN0, D, nv::EpiInproj0{RD});
            hipLaunchKernelGGL(k_rope_apply, dim3(T * 80 / 256), dim3(256), 0, stream, RD, rope);
        } else if (L == 0 && lp == 2) {
            hipLaunchKernelGGL(k_swa, dim3(B * 64 * 8), dim3(128), 0, stream, RD, F(6), RB);
            hipLaunchKernelGGL(k_sgu_ln, dim3(T * 8 / 256), dim3(256), 0, stream, RD, F(7), F(8), RC);
            hipLaunchKernelGGL(k_sgu_mix, dim3(T * 512 / 256), dim3(256), 0, stream, RD, RC, F(9), F(10), RB);
        } else if (L == 0 && lp == 3) { ngemm(stream, RB, D, F(11), D, T, D, D, nv::EpiBf16{RC, D, 1.f});
        } else if (L == 0 && lp == 4) { hipLaunchKernelGGL(k_ln_add, dim3(T / 4), dim3(256), 0, stream, RA, RC, F(12), F(13), RB);
        } else if (L == 1 && lp == 0) { ngemm(stream, RA, D, F(24), D, T, D, D, nv::EpiBf16{RB, D, 1.f});
        } else if (L == 1 && lp == 1) { hipLaunchKernelGGL(k_pool, dim3(T * D / 256), dim3(256), 0, stream, RB, RC);
        } else if (L == 1 && lp == 2) { for (int g = 0; g < 4; ++g) ngemm(stream, RC + g * 256, D, F(25) + (size_t)g * 256 * 256, 256, T, 256, 256, nv::EpiPoolMap{RD, F(26), g * 256});
        } else if (L == 1 && lp == 3) { ngemm(stream, RD, D, F(27), D, T, D, D, nv::EpiBf16{RC, D, 1.f});
        } else if (L == 1 && lp == 4) { hipLaunchKernelGGL(k_ln_add, dim3(T / 4), dim3(256), 0, stream, RA, RC, F(28), F(29), RB);
        } else if (lp == 5) { ngemm(stream, X1, D, F(cb + 2), D, T, D, D, nv::EpiBf16{Qb, D, QSCALE});
        } else if (lp == 6) { hipLaunchKernelGGL(k_xattn, dim3(T * XH / 4), dim3(256), 0, stream, Qb, Kb, Vt, Ob);
        } else if (lp == 7) { ngemm(stream, Ob, D, F(cb + 4), D, T, D, D, nv::EpiBf16{Y2, D, 1.f});
        } else if (lp == 8) {
            hipLaunchKernelGGL(k_ln_router, dim3(T / 4), dim3(256), 0, stream, X1, Y2, F(cb + 5), F(cb + 6), X2, router_w, router_b, eidx, ewgt);
            hipLaunchKernelGGL(k_moe_hist, dim3(256), dim3(256), 0, stream, eidx, bcnt);
        } else if (lp == 9) { hipLaunchKernelGGL(k_moe_scatter, dim3(256), dim3(256), 0, stream, eidx, bcnt, tok, pos, tile_e);
        } else if (lp == 10) {
            ngemm(stream, X2, D, F(cb + 7), DE, MPAD, DE, D, nv::EpiF32{G, DE}, tile_e, (size_t)D * DE, tok);
            ngemm(stream, X2, D, F(cb + 8), DE, MPAD, DE, D, nv::EpiSiluMul{G, HS}, tile_e, (size_t)D * DE, tok);
        } else if (lp == 11) { ngemm(stream, HS, DE, F(cb + 9), D, MPAD, D, DE, nv::EpiBf16{DS, D, 1.f}, tile_e, (size_t)DE * D);
        } else if (lp == 12) { hipLaunchKernelGGL(k_ln_moe, dim3(T / 4), dim3(256), 0, stream, X2, DS, pos, ewgt, F(cb + 10), F(cb + 11), X3, L == 1 ? (float*)d_out : nullptr);
        }
        ++p;
    }
}
```

```cpp
#include <hip/hip_runtime.h>
#include <stdint.h>
#include <math.h>

typedef unsigned short bf16_t;

namespace nv {
constexpr int B = 4, S = 8192, T = B * S, D = 1024;
constexpr int NIN0 = 1792;
constexpr int MEM = 256, XH = 4, XHD = 256;
constexpr int NE = 16, DE = 512;
constexpr int MPAD = 65536 + 16 * 256;
constexpr int NTILE = MPAD / 256;
constexpr float ALPHA = 1.4142135623730951f;
constexpr float LN_EPS = 1e-5f;
constexpr float QSCALE = 0.0625f * 1.4426950408889634f;
constexpr float ASCALE = 0.125f * 1.4426950408889634f;

constexpr size_t MiB = 1u << 20;
constexpr size_t WS_CTL = 0;
constexpr size_t WS_ROPE = 2 * MiB;
constexpr size_t WS_EIDX = 4 * MiB;
constexpr size_t WS_EWGT = 5 * MiB;
constexpr size_t WS_POS = 6 * MiB;
constexpr size_t WS_BCNT = 7 * MiB;
constexpr size_t WS_TILE = 7 * MiB + 65536;
constexpr size_t WS_TOK = 7 * MiB + 131072;
constexpr size_t WS_MEMKV = 8 * MiB;
constexpr size_t WS_MEMB = 20 * MiB;
constexpr size_t WS_WB = 24 * MiB;
constexpr size_t WS_A = 152 * MiB, WS_B = 220 * MiB, WS_C = 288 * MiB, WS_D = 356 * MiB;
constexpr size_t WS_MT = 492 * MiB;
constexpr size_t WS_NT = 500 * MiB;
constexpr size_t WS_END = 508 * MiB;
constexpr size_t WB_IN0 = 0;
constexpr size_t WB_OUT0 = WB_IN0 + (size_t)1792 * 1024;
constexpr size_t WB_IN1 = WB_OUT0 + (size_t)1024 * 1024;
constexpr size_t WB_POOL = WB_IN1 + (size_t)1024 * 1024;
constexpr size_t WB_OUT1 = WB_POOL + (size_t)1024 * 256;
constexpr size_t WB_WEFF = WB_OUT1 + (size_t)1024 * 1024;
constexpr size_t WB_SGUW = WB_WEFF + (size_t)1024 * 1024;
constexpr size_t WB_LAYER = WB_SGUW + (size_t)8 * 128 * 128;
constexpr size_t WL_XQ = 0;
constexpr size_t WL_XKV = WL_XQ + (size_t)1024 * 1024;
constexpr size_t WL_XO = WL_XKV + (size_t)2048 * 1024;
constexpr size_t WL_GU = WL_XO + (size_t)1024 * 1024;
constexpr size_t WL_DN = WL_GU + (size_t)16 * 1024 * 1024;
constexpr size_t WL_SIZE = WL_DN + (size_t)16 * 1024 * 512;
static_assert((WB_LAYER + 2 * WL_SIZE) * 2 <= 128 * MiB, "bf16 weight region");

__device__ __forceinline__ float bf2f(bf16_t v) { return __uint_as_float((unsigned)v << 16); }
__device__ __forceinline__ bf16_t f2bf(float f) { unsigned u = __float_as_uint(f); return (bf16_t)((u + 0x7fffu + ((u >> 16) & 1u)) >> 16); }
__device__ __forceinline__ float gelu_tanh(float x) { const float u = 0.7978845608028654f * (x + 0.044715f * x * x * x); const float e = __expf(2.f * u); const float th = 1.f - 2.f / (e + 1.f); return 0.5f * x * (1.f + th); }
__device__ __forceinline__ float silu(float x) { return x / (1.f + __expf(-x)); }
template <int M> __device__ __forceinline__ float swz_xor(float v) { return __int_as_float(__builtin_amdgcn_ds_swizzle(__float_as_int(v), (M << 10) | 0x1f)); }
__device__ __forceinline__ float wave_sum(float v) {
    v += swz_xor<1>(v); v += swz_xor<2>(v); v += swz_xor<4>(v); v += swz_xor<8>(v); v += swz_xor<16>(v);
    const auto r = __builtin_amdgcn_permlane32_swap(__float_as_uint(v), __float_as_uint(v), false, false);
    return __uint_as_float(r[0]) + __uint_as_float(r[1]);
}
__device__ __forceinline__ float wave_max(float v) {
    v = fmaxf(v, swz_xor<1>(v)); v = fmaxf(v, swz_xor<2>(v)); v = fmaxf(v, swz_xor<4>(v)); v = fmaxf(v, swz_xor<8>(v)); v = fmaxf(v, swz_xor<16>(v));
    const auto r = __builtin_amdgcn_permlane32_swap(__float_as_uint(v), __float_as_uint(v), false, false);
    return fmaxf(__uint_as_float(r[0]), __uint_as_float(r[1]));
}
}

namespace pg8 {
#define PG8_LAS __attribute__((address_space(3)))
typedef short bf16x8 __attribute__((ext_vector_type(8)));
typedef float f32x4 __attribute__((ext_vector_type(4)));
typedef float f32x2 __attribute__((ext_vector_type(2)));
typedef unsigned u32x4 __attribute__((ext_vector_type(4)));
typedef unsigned u32x2 __attribute__((ext_vector_type(2)));
constexpr int BM = 256, BK = 64, HALF = 128, HTB = HALF * BK * 2  , STAGE_BYTES = 8 * HTB, NXCD = 8, WGM = 8;

__host__ __device__ __forceinline__ int lds_byte(int r, int c) { const int st = (r >> 4) * 2 + (c >> 5), rr = r & 15, cc = c & 31, ob = rr * 64 + cc * 2; return st * 1024 + (ob ^ (((ob >> 9) & 1) << 5)); }
__host__ __device__ __forceinline__ void stage_rc(int b, int& R, int& C) { const int st = b / 1024, sb = b % 1024, swz = sb ^ (((sb >> 9) & 1) << 5); R = (st >> 1) * 16 + swz / 64; C = (st & 1) * 32 + (swz % 64) / 2; }
__host__ __device__ __forceinline__ int perm32(int rho) { const int n = rho >> 4, i = rho & 15; return 8 * (i >> 2) + 4 * n + (i & 3); }

struct Unit { int pm, pn, ao, bo; };
struct Gemm { const bf16_t* A; const bf16_t* Bt; const int* arow; };

template <bool BATCHED = false>
struct StaticOrderT {
    int nM, nN, nwg, G, c, lda, ldb, apn;
    __device__ void init(int M, int N, int G_, int c_, int lda_, int ldb_, int apn_ = 0) { nM = M / BM; nN = N / BM; nwg = nM * nN; G = G_; c = c_; lda = lda_; ldb = ldb_; apn = apn_; }
    __device__ bool next(int i, Unit& u) const {
        const long L = (long)i * G + c; if (L >= nwg) return false;
        int wgid = (int)L; { const int q = nwg / NXCD, r = nwg % NXCD, xcd = wgid % NXCD, off = wgid / NXCD; wgid = (xcd < r ? xcd * (q + 1) : r * (q + 1) + (xcd - r) * q) + off; }
        const int nig = WGM * nN, gid = wgid / nig, fm = gid * WGM, gsz = (nM - fm) < WGM ? (nM - fm) : WGM;
        u.pm = fm + ((wgid % nig) % gsz); u.pn = (wgid % nig) / gsz;
        u.ao = u.pm * BM * lda + u.pn * apn; u.bo = (BATCHED ? ((u.pm >> 5) * 4 + u.pn) : u.pn) * BM * ldb; return true;
    }
};
typedef StaticOrderT<false> StaticOrder;
typedef StaticOrderT<true> BatchOrder;
struct MoeOrder {
    int nM, nwg, G, c, lda, ldb; const int* tile_e;
    __device__ void init(int ntiles, const int* te, int G_, int c_, int lda_, int ldb_) { nM = ntiles; nwg = nM * 4; G = G_; c = c_; tile_e = te; lda = lda_; ldb = ldb_; }
    __device__ bool next(int i, Unit& u) const {
        const long L = (long)i * G + c; if (L >= nwg) return false;
        int wgid = (int)L; { const int q = nwg / NXCD, r = nwg % NXCD, xcd = wgid % NXCD, off = wgid / NXCD; wgid = (xcd < r ? xcd * (q + 1) : r * (q + 1) + (xcd - r) * q) + off; }
        const int nig = WGM * 4, gid = wgid / nig, fm = gid * WGM, gsz = (nM - fm) < WGM ? (nM - fm) : WGM;
        u.pm = fm + ((wgid % nig) % gsz); u.pn = (wgid % nig) / gsz;
        const int e = __builtin_amdgcn_readfirstlane(tile_e[u.pm]); u.ao = u.pm * BM * lda; u.bo = (e * 4 + u.pn) * BM * ldb; return true;
    }
};
template <int KIND>
struct SetupOrder {
    int idx, n;
    __device__ void init(int c, int c0, int n_) { idx = c - c0; n = n_; }
    __device__ bool next(int i, Unit& u) const {
        if (i != 0 || idx < 0 || idx >= n) return false;
        const int x = idx >> 4, y = (idx >> 2) & 3, z = idx & 3;
        if (KIND == 0) { u.pm = x * 4 + y; u.pn = z; u.ao = (x * 256) * 2048 + y * 256; u.bo = z * 256 * 1024 + y * 256; }
        if (KIND == 1) { u.pm = x * 4 + y; u.pn = z; u.ao = y * 256 * 1024 + z * 256; u.bo = (x * 256) * 2048 + 1024 + z * 256; }
        if (KIND == 2) { u.pm = y; u.pn = z; u.ao = y * 256 * 1024 + z * 256; u.bo = z * 256 * 256; }
        return true;
    }
};

__device__ __forceinline__ unsigned cvt_pk_bf16(float lo, float hi) { unsigned r; asm volatile("v_cvt_pk_bf16_f32 %0, %1, %2" : "=v"(r) : "v"(lo), "v"(hi)); return r; }


template <class Epi, class Sched, bool ALIGN_EPI, bool SP2, bool GATHER, int LDA, int LDB, int KK>
__device__ __forceinline__ void gemm_phase(PG8_LAS unsigned char* lds, int tid_in, const Gemm g, const Sched& S, const Epi& E) {
    int tid_ = tid_in; asm volatile("" : "+v"(tid_));
    const int tid = tid_, wid = __builtin_amdgcn_readfirstlane(tid >> 6), lane = tid & 63, wr = wid >> 2, wc = wid & 3, fr = lane & 15, fq = lane >> 4;
    constexpr int K = KK, nt = K / BK, lda = LDA, ldb = LDB; (void)K;
    unsigned voffA[2], voffB[2]; int rowA[2];
#pragma unroll
    for (int i = 0; i < 2; ++i) { int R, C; stage_rc(tid * 16 + i * 8192, R, C); const int Rb = Epi::PERM ? ((R & ~31) + perm32(R & 31)) : R;
        voffA[i] = GATHER ? (unsigned)C * 2u : (unsigned)(R * lda + C) * 2u; voffB[i] = (unsigned)(Rb * ldb + C) * 2u; rowA[i] = R; }
    const size_t kstep = (size_t)(BK * 2);
    const size_t hstepA = GATHER ? 0 : (size_t)HALF * lda * 2, hstepB = (size_t)HALF * ldb * 2;
    const unsigned ldsw = (unsigned)wid * 1024u;
    const int aoff = lds_byte(wr * 64 + fr, fq * 8), boff = lds_byte(wc * 32 + fr, fq * 8);
    unsigned cg[2][2], ng[2][2];
#define PG8_SA(b, h) (((b) * 2 + (h)) * HTB)
#define PG8_SB(b, h) ((4 + (b) * 2 + (h)) * HTB)
#define PG8_STAGE(bufoff, gbase, voff) do { _Pragma("unroll") for (int _i = 0; _i < 2; ++_i) \
        __builtin_amdgcn_global_load_lds((const unsigned*)((const char*)(gbase) + (voff)[_i]), (PG8_LAS unsigned*)(lds + (bufoff) + ldsw + _i * 8192), 16, 0, 0); } while (0)
#define PG8_STAGE_A(bufoff, abase, h, GO) do { _Pragma("unroll") for (int _i = 0; _i < 2; ++_i) { \
        const char* _s = GATHER ? (const char*)(abase) + (size_t)GO[h][_i] : (const char*)(abase) + ((h) ? hstepA : (size_t)0) + voffA[_i]; \
        __builtin_amdgcn_global_load_lds((const unsigned*)_s, (PG8_LAS unsigned*)(lds + (bufoff) + ldsw + _i * 8192), 16, 0, 0); } } while (0)
#define PG8_GLOAD(dst, pm_) do { _Pragma("unroll") for (int _h = 0; _h < 2; ++_h) _Pragma("unroll") for (int _i = 0; _i < 2; ++_i) \
        dst[_h][_i] = (unsigned)g.arow[(pm_) * BM + _h * HALF + rowA[_i]] * (unsigned)(lda * 2) + voffA[_i]; } while (0)
#define PG8_GSWITCH do { if constexpr (GATHER) { _Pragma("unroll") for (int _h = 0; _h < 2; ++_h) _Pragma("unroll") for (int _i = 0; _i < 2; ++_i) cg[_h][_i] = last ? ng[_h][_i] : cg[_h][_i]; } } while (0)
#define PG8_LDA(dst, b, h) do { _Pragma("unroll") for (int m = 0; m < 4; ++m) _Pragma("unroll") for (int k = 0; k < 2; ++k) dst[m][k] = *(const PG8_LAS bf16x8*)(lds + PG8_SA(b, h) + aoff + m * 2048 + k * 1024); } while (0)
#define PG8_LDB(dst, b, h) do { _Pragma("unroll") for (int n = 0; n < 2; ++n) _Pragma("unroll") for (int k = 0; k < 2; ++k) dst[n][k] = *(const PG8_LAS bf16x8*)(lds + PG8_SB(b, h) + boff + n * 2048 + k * 1024); } while (0)
#define PG8_MMA(ai, bj, At, Bt) do { __builtin_amdgcn_s_setprio(1); _Pragma("unroll") for (int m = 0; m < 4; ++m) _Pragma("unroll") for (int n = 0; n < 2; ++n) _Pragma("unroll") for (int k = 0; k < 2; ++k) \
        acc[ai][bj][m][n] = __builtin_amdgcn_mfma_f32_16x16x32_bf16(Bt[n][k], At[m][k], acc[ai][bj][m][n], 0, 0, 0); __builtin_amdgcn_s_setprio(0); } while (0)
#define PG8_WAIT_V(n) asm volatile("s_waitcnt vmcnt(" #n ")" ::: "memory")
#define PG8_WAIT_L(n) asm volatile("s_waitcnt lgkmcnt(" #n ")" ::: "memory")
#define PG8_BAR __builtin_amdgcn_s_barrier()
#define PG8_SCHED __builtin_amdgcn_sched_barrier(0)
    Unit cur, nxt; int ui = 0;
    if (!S.next(0, cur)) return;
    f32x4 acc[2][2][4][2];
#pragma unroll
    for (int a = 0; a < 2; ++a)
#pragma unroll
        for (int b = 0; b < 2; ++b)
#pragma unroll
            for (int m = 0; m < 4; ++m)
#pragma unroll
                for (int n = 0; n < 2; ++n) acc[a][b][m][n] = (f32x4){0.f, 0.f, 0.f, 0.f};
    bf16x8 At[4][2], B0[2][2], B1[2][2];
    const char* cA = GATHER ? (const char*)g.A : (const char*)g.A + (size_t)cur.ao * 2; const char* cB = (const char*)g.Bt + (size_t)cur.bo * 2;
    if constexpr (GATHER) { PG8_GLOAD(cg, cur.pm); }
    if constexpr (SP2) {
        PG8_STAGE(PG8_SB(0, 0), cB, voffB); PG8_STAGE(PG8_SB(0, 1), cB + hstepB, voffB); PG8_STAGE_A(PG8_SA(0, 0), cA, 0, cg); PG8_STAGE_A(PG8_SA(0, 1), cA, 1, cg);
        if (wr == 1) PG8_BAR;
        PG8_WAIT_V(2); PG8_BAR;
        PG8_STAGE(PG8_SB(1, 0), cB + kstep, voffB); PG8_STAGE_A(PG8_SA(1, 0), cA + kstep, 0, cg); PG8_STAGE(PG8_SB(1, 1), cB + hstepB + kstep, voffB);
        PG8_WAIT_V(6); PG8_BAR;
    } else {
        PG8_STAGE(PG8_SB(0, 0), cB, voffB); PG8_STAGE_A(PG8_SA(0, 0), cA, 0, cg); PG8_STAGE(PG8_SB(0, 1), cB + hstepB, voffB); PG8_STAGE_A(PG8_SA(0, 1), cA, 1, cg);
        if (wr == 1) PG8_BAR;
        PG8_WAIT_V(4); PG8_BAR;
        PG8_STAGE(PG8_SB(1, 0), cB + kstep, voffB); PG8_STAGE_A(PG8_SA(1, 0), cA + kstep, 0, cg); PG8_STAGE(PG8_SB(1, 1), cB + hstepB + kstep, voffB);
        PG8_WAIT_V(6); PG8_BAR;
    }
    for (;;) {
        const bool has_next = S.next(ui + 1, nxt);
        const char* nA = GATHER ? (const char*)g.A : (has_next ? (const char*)g.A + (size_t)nxt.ao * 2 : cA);
        const char* nB = has_next ? (const char*)g.Bt + (size_t)nxt.bo * 2 : cB;
        if constexpr (GATHER) { if (has_next) { PG8_GLOAD(ng, nxt.pm); } else {
#pragma unroll
            for (int _h = 0; _h < 2; ++_h)
#pragma unroll
                for (int _i = 0; _i < 2; ++_i) ng[_h][_i] = cg[_h][_i]; } }
#pragma unroll 1
        for (int t = 0; t < nt; t += 2) {
            const bool last = (t == nt - 2);
            const char* a1 = cA + (size_t)(t + 1) * kstep;
            const char* a2 = last ? nA : cA + (size_t)(t + 2) * kstep; const char* b2 = last ? nB : cB + (size_t)(t + 2) * kstep;
            const char* a3 = a2 + kstep; const char* b3 = b2 + kstep;
            if constexpr (SP2) {
            PG8_LDB(B0, 0, 0); PG8_LDB(B1, 0, 1); PG8_SCHED; PG8_LDA(At, 0, 0); PG8_STAGE_A(PG8_SA(1, 1), a1, 1, cg); PG8_GSWITCH;
            PG8_WAIT_V(8); PG8_WAIT_L(0); PG8_BAR; PG8_MMA(0, 0, At, B0); PG8_MMA(0, 1, At, B1); PG8_BAR; PG8_SCHED;
            PG8_LDA(At, 0, 1); PG8_STAGE(PG8_SB(0, 0), b2, voffB); PG8_STAGE(PG8_SB(0, 1), b2 + hstepB, voffB); PG8_STAGE_A(PG8_SA(0, 0), a2, 0, cg);
            PG8_WAIT_V(8); PG8_WAIT_L(0); PG8_BAR; PG8_MMA(1, 0, At, B0); PG8_MMA(1, 1, At, B1); PG8_BAR; PG8_SCHED;
            PG8_LDB(B0, 1, 0); PG8_LDB(B1, 1, 1); PG8_SCHED; PG8_LDA(At, 1, 0); PG8_STAGE_A(PG8_SA(0, 1), a2, 1, cg);
            PG8_WAIT_V(8); PG8_WAIT_L(0); PG8_BAR; PG8_MMA(0, 0, At, B0); PG8_MMA(0, 1, At, B1); PG8_BAR; PG8_SCHED;
            PG8_LDA(At, 1, 1); PG8_STAGE(PG8_SB(1, 0), b3, voffB); PG8_STAGE(PG8_SB(1, 1), b3 + hstepB, voffB); PG8_STAGE_A(PG8_SA(1, 0), a3, 0, cg);
            PG8_WAIT_V(8); PG8_WAIT_L(0); PG8_BAR; PG8_MMA(1, 0, At, B0); PG8_MMA(1, 1, At, B1); PG8_BAR; PG8_SCHED;
            } else {
            PG8_LDB(B0, 0, 0); PG8_SCHED; PG8_LDA(At, 0, 0); PG8_STAGE_A(PG8_SA(1, 1), a1, 1, cg); PG8_GSWITCH;
            PG8_WAIT_L(8); PG8_BAR; PG8_WAIT_L(0); PG8_MMA(0, 0, At, B0); PG8_BAR; PG8_SCHED;
            PG8_LDB(B1, 0, 1); PG8_STAGE(PG8_SB(0, 0), b2, voffB);
            PG8_BAR; PG8_WAIT_L(0); PG8_MMA(0, 1, At, B1); PG8_BAR;
            PG8_LDA(At, 0, 1); PG8_STAGE_A(PG8_SA(0, 0), a2, 0, cg);
            PG8_BAR; PG8_WAIT_L(0); PG8_MMA(1, 0, At, B0); PG8_BAR; PG8_SCHED;
            PG8_STAGE(PG8_SB(0, 1), b2 + hstepB, voffB);
            PG8_WAIT_V(6); PG8_BAR; PG8_MMA(1, 1, At, B1); PG8_BAR;
            PG8_LDB(B0, 1, 0); PG8_SCHED; PG8_LDA(At, 1, 0); PG8_STAGE_A(PG8_SA(0, 1), a2, 1, cg);
            PG8_WAIT_L(8); PG8_BAR; PG8_WAIT_L(0); PG8_MMA(0, 0, At, B0); PG8_BAR; PG8_SCHED;
            PG8_LDB(B1, 1, 1); PG8_STAGE(PG8_SB(1, 0), b3, voffB);
            PG8_BAR; PG8_WAIT_L(0); PG8_MMA(0, 1, At, B1); PG8_BAR;
            PG8_LDA(At, 1, 1); PG8_STAGE_A(PG8_SA(1, 0), a3, 0, cg);
            PG8_BAR; PG8_WAIT_L(0); PG8_MMA(1, 0, At, B0); PG8_BAR; PG8_SCHED;
            PG8_STAGE(PG8_SB(1, 1), b3 + hstepB, voffB);
            PG8_WAIT_V(6); PG8_BAR; PG8_MMA(1, 1, At, B1); PG8_BAR;
            }
        }
        if constexpr (ALIGN_EPI) { if (wr == 0) PG8_BAR; }
        E(acc, cur, wr, wc, fr, fq);
        if (!has_next) break;
#pragma unroll
        for (int a = 0; a < 2; ++a)
#pragma unroll
            for (int b = 0; b < 2; ++b)
#pragma unroll
                for (int m = 0; m < 4; ++m)
#pragma unroll
                    for (int n = 0; n < 2; ++n) acc[a][b][m][n] = (f32x4){0.f, 0.f, 0.f, 0.f};
        cur = nxt; cA = nA; cB = nB; ++ui;
        if constexpr (GATHER) {
#pragma unroll
            for (int _h = 0; _h < 2; ++_h)
#pragma unroll
                for (int _i = 0; _i < 2; ++_i) cg[_h][_i] = ng[_h][_i]; }
        if constexpr (ALIGN_EPI) { if (wr == 1) PG8_BAR; }
    }
    PG8_WAIT_V(0);
    if constexpr (!ALIGN_EPI) { if (wr == 0) PG8_BAR; }
    PG8_BAR;
#undef PG8_SA
#undef PG8_SB
#undef PG8_STAGE
#undef PG8_STAGE_A
#undef PG8_GLOAD
#undef PG8_GSWITCH
#undef PG8_LDA
#undef PG8_LDB
#undef PG8_MMA
#undef PG8_WAIT_V
#undef PG8_WAIT_L
#undef PG8_BAR
#undef PG8_SCHED
}
}
namespace pg8 {

__device__ __forceinline__ float fast_sigmoid_mul(float x, float z) { return x * __builtin_amdgcn_rcpf(1.f + __builtin_amdgcn_exp2f(-1.4426950408889634f * z)); }
__device__ __forceinline__ float gelu_t(float x) { const float u = 0.7978845608028654f * (x + 0.044715f * x * x * x); return fast_sigmoid_mul(x, 2.f * u); }
__device__ __forceinline__ float silu_f(float x) { return fast_sigmoid_mul(x, x); }
__device__ __forceinline__ u32x4 pack8(const f32x4 v0, const f32x4 v1) { u32x4 w; w.x = cvt_pk_bf16(v0[0], v0[1]); w.y = cvt_pk_bf16(v0[2], v0[3]); w.z = cvt_pk_bf16(v1[0], v1[1]); w.w = cvt_pk_bf16(v1[2], v1[3]); return w; }

struct EpiBf16 {
    static constexpr bool PERM = true;
    bf16_t* O; int ldo; float scale;
    __device__ __forceinline__ void operator()(f32x4 (&acc)[2][2][4][2], const Unit& u, int wr, int wc, int fr, int fq) const {
        const int row0 = u.pm * BM + wr * 64 + fr, col0 = u.pn * BM + wc * 32 + 8 * fq;
#pragma unroll
        for (int ai = 0; ai < 2; ++ai)
#pragma unroll
            for (int m = 0; m < 4; ++m) { bf16_t* rowp = O + (size_t)(row0 + ai * HALF + m * 16) * ldo + col0;
#pragma unroll
                for (int bj = 0; bj < 2; ++bj) *(u32x4*)(rowp + bj * HALF) = pack8(acc[ai][bj][m][0] * scale, acc[ai][bj][m][1] * scale); }
    }
};
struct EpiGU {
    static constexpr bool PERM = true;
    bf16_t* HS;
    __device__ __forceinline__ void operator()(f32x4 (&acc)[2][2][4][2], const Unit& u, int wr, int wc, int fr, int fq) const {
        const int row0 = u.pm * BM + wr * 64 + fr, col0 = u.pn * HALF + wc * 32 + 8 * fq;
#pragma unroll
        for (int ai = 0; ai < 2; ++ai)
#pragma unroll
            for (int m = 0; m < 4; ++m) { bf16_t* rowp = HS + (size_t)(row0 + ai * HALF + m * 16) * nv::DE + col0;
                f32x4 h0, h1;
#pragma unroll
                for (int j = 0; j < 4; ++j) { h0[j] = silu_f(acc[ai][0][m][0][j]) * acc[ai][1][m][0][j]; h1[j] = silu_f(acc[ai][0][m][1][j]) * acc[ai][1][m][1][j]; }
                *(u32x4*)rowp = pack8(h0, h1); }
    }
};
struct EpiSoftmax {
    static constexpr bool PERM = true;
    bf16_t* O; PG8_LAS float* tbl;
    __device__ __forceinline__ void operator()(f32x4 (&acc)[2][2][4][2], const Unit& u, int wr, int wc, int fr, int fq) const {
        const int row0 = u.pm * BM + wr * 64 + fr, col0 = u.pn * BM + wc * 32 + 8 * fq;
#pragma unroll
        for (int ai = 0; ai < 2; ++ai)
#pragma unroll
            for (int m = 0; m < 4; ++m) { float mx = -INFINITY;
#pragma unroll
                for (int bj = 0; bj < 2; ++bj)
#pragma unroll
                    for (int n = 0; n < 2; ++n)
#pragma unroll
                        for (int j = 0; j < 4; ++j) mx = fmaxf(mx, acc[ai][bj][m][n][j]);
                mx = fmaxf(mx, nv::swz_xor<16>(mx));
                { const auto r = __builtin_amdgcn_permlane32_swap(__float_as_uint(mx), __float_as_uint(mx), false, false); mx = fmaxf(__uint_as_float(r[0]), __uint_as_float(r[1])); }
                if (fq == 0) tbl[(ai * HALF + wr * 64 + m * 16 + fr) * 4 + wc] = mx; }
        asm volatile("s_waitcnt lgkmcnt(0)" ::: "memory"); __builtin_amdgcn_s_barrier(); asm volatile("" ::: "memory");
#pragma unroll
        for (int ai = 0; ai < 2; ++ai)
#pragma unroll
            for (int m = 0; m < 4; ++m) { const f32x4 t4 = *(const PG8_LAS f32x4*)(tbl + (ai * HALF + wr * 64 + m * 16 + fr) * 4);
                const float M = fmaxf(fmaxf(t4[0], t4[1]), fmaxf(t4[2], t4[3])); float s = 0.f;
#pragma unroll
                for (int bj = 0; bj < 2; ++bj)
#pragma unroll
                    for (int n = 0; n < 2; ++n)
#pragma unroll
                        for (int j = 0; j < 4; ++j) { const float p = __builtin_amdgcn_exp2f(acc[ai][bj][m][n][j] - M); acc[ai][bj][m][n][j] = p; s += p; }
                s += nv::swz_xor<16>(s);
                { const auto r = __builtin_amdgcn_permlane32_swap(__float_as_uint(s), __float_as_uint(s), false, false); s = __uint_as_float(r[0]) + __uint_as_float(r[1]); }
                if (fq == 0) tbl[1024 + (ai * HALF + wr * 64 + m * 16 + fr) * 4 + wc] = s; }
        asm volatile("s_waitcnt lgkmcnt(0)" ::: "memory"); __builtin_amdgcn_s_barrier(); asm volatile("" ::: "memory");
#pragma unroll
        for (int ai = 0; ai < 2; ++ai)
#pragma unroll
            for (int m = 0; m < 4; ++m) { const f32x4 t4 = *(const PG8_LAS f32x4*)(tbl + 1024 + (ai * HALF + wr * 64 + m * 16 + fr) * 4);
                const float inv = 1.f / ((t4[0] + t4[1]) + (t4[2] + t4[3]));
                bf16_t* rowp = O + (size_t)(row0 + ai * HALF + m * 16) * nv::D + col0;
#pragma unroll
                for (int bj = 0; bj < 2; ++bj) *(u32x4*)(rowp + bj * HALF) = pack8(acc[ai][bj][m][0] * inv, acc[ai][bj][m][1] * inv); }
    }
};
struct EpiInproj0 {
    static constexpr bool PERM = true;
    bf16_t* O; const float* rope;
    __device__ __forceinline__ void operator()(f32x4 (&acc)[2][2][4][2], const Unit& u, int wr, int wc, int fr, int fq) const {
        const int row0 = u.pm * BM + wr * 64 + fr, col0 = u.pn * BM + wc * 32 + 8 * fq;
        if (u.pn >= 3) {
#pragma unroll
            for (int ai = 0; ai < 2; ++ai)
#pragma unroll
                for (int m = 0; m < 4; ++m) { bf16_t* rowp = O + (size_t)(row0 + ai * HALF + m * 16) * nv::NIN0 + col0;
#pragma unroll
                    for (int bj = 0; bj < 2; ++bj) { f32x4 v0 = acc[ai][bj][m][0], v1 = acc[ai][bj][m][1];
#pragma unroll
                        for (int j = 0; j < 4; ++j) { v0[j] = gelu_t(v0[j]); v1[j] = gelu_t(v1[j]); }
                        *(u32x4*)(rowp + bj * HALF) = pack8(v0, v1); } }
        } else {
            const bool wave_rope = (wc & 1) == 0;
            const float sgn = fq == 0 ? -1.f : 1.f;
#pragma unroll
            for (int ai = 0; ai < 2; ++ai)
#pragma unroll
                for (int m = 0; m < 4; ++m) { const int row = row0 + ai * HALF + m * 16; bf16_t* rowp = O + (size_t)row * nv::NIN0 + col0;
                    f32x4 c0, c1, s0, s1;
                    if (wave_rope) { const float* rp = rope + (size_t)row * 16; c0 = *(const f32x4*)rp; c1 = *(const f32x4*)(rp + 4); s0 = *(const f32x4*)(rp + 8); s1 = *(const f32x4*)(rp + 12); }
#pragma unroll
                    for (int bj = 0; bj < 2; ++bj) { f32x4 v0 = acc[ai][bj][m][0], v1 = acc[ai][bj][m][1];
                        if (wave_rope && (u.pn < 2 || bj == 0)) {
                            f32x4 p0, p1;
#pragma unroll
                            for (int j = 0; j < 4; ++j) { p0[j] = nv::swz_xor<16>(v0[j]); p1[j] = nv::swz_xor<16>(v1[j]); }
                            if (fq < 2) {
#pragma unroll
                                for (int j = 0; j < 4; ++j) { v0[j] = v0[j] * c0[j] + sgn * p0[j] * s0[j]; v1[j] = v1[j] * c1[j] + sgn * p1[j] * s1[j]; } }
                        }
                        *(u32x4*)(rowp + bj * HALF) = pack8(v0, v1); } }
        }
    }
};
}

#define LAS __attribute__((address_space(3)))
#define GAS __attribute__((address_space(1)))
typedef GAS unsigned gu32;
#define RLX_AGENT __ATOMIC_RELAXED, __HIP_MEMORY_SCOPE_AGENT
#define LDS_WAIT() asm volatile("s_waitcnt lgkmcnt(0)" ::: "memory")
#define VM_WAIT() asm volatile("s_waitcnt vmcnt(0)" ::: "memory")

#define XB_TMO      128
#define XB_XCNT(j)  (256  + 64 * (j))
#define XB_XSUB(j)  (1280 + 64 * (j))
#define XB_XGEN(j)  (2304 + 64 * (j))
#define XB_TOP      3328
#define XB_TOPGEN   3392
#define XCD_BAR_WORDS 3456
#define XB_SPIN_CAP (1u << 18)
__device__ __forceinline__ unsigned xb_ld(unsigned* p)              { return __hip_atomic_load(p, __ATOMIC_RELAXED, __HIP_MEMORY_SCOPE_AGENT); }
__device__ __forceinline__ unsigned xb_add(unsigned* p, unsigned v) { return __hip_atomic_fetch_add(p, v, __ATOMIC_RELAXED, __HIP_MEMORY_SCOPE_AGENT); }
__device__ __forceinline__ unsigned xb_xcc_id() { return (unsigned)__builtin_amdgcn_s_getreg((3 << 11) | 20) & 0xFu; }
#define XB_SPIN(cond, bar) do { unsigned _sp = 0; while (cond) { __builtin_amdgcn_s_sleep(1); \
    if ((++_sp & 255u) == 0u) { if (xb_ld(&(bar)[XB_TMO])) break; if (_sp > XB_SPIN_CAP) { atomicAdd(&(bar)[XB_TMO], 1u); break; } } } } while (0)
struct XcdBarrier { unsigned* bar; unsigned x; volatile LAS unsigned* st; int wave; };
__device__ __forceinline__ unsigned lane_id_fresh() { unsigned m = ~0u; asm volatile("" : "+s"(m)); return __builtin_amdgcn_mbcnt_hi(m, __builtin_amdgcn_mbcnt_lo(m, 0u)); }
__device__ __forceinline__ bool xb_thread0(int wave) { return wave == 0 && lane_id_fresh() == 0u; }
__device__ __forceinline__ XcdBarrier xcd_barrier_post(unsigned* bar, volatile LAS unsigned* st, int wave) {
    XcdBarrier b; b.bar = bar; b.x = xb_xcc_id(); b.st = st; b.wave = wave;
    if (xb_thread0(wave)) (void)xb_add(&bar[XB_XCNT(b.x)], 1u);
    return b;
}
__device__ __forceinline__ void xcd_barrier_complete(unsigned* bar, unsigned x, unsigned& nloc, unsigned& nx) {
    const unsigned G = gridDim.x * gridDim.y * gridDim.z;
    unsigned sum, cnt, mine, sp = 0u;
    for (;;) {
        sum = 0u; cnt = 0u; mine = 0u;
#pragma unroll
        for (unsigned j = 0; j < 16; ++j) { const unsigned c = xb_ld(&bar[XB_XCNT(j)]); sum += c; cnt += (c > 0u) ? 1u : 0u; mine = (j == x) ? c : mine; }
        if (sum == G) break;
        __builtin_amdgcn_s_sleep(1);
        if ((++sp & 255u) == 0u) { if (xb_ld(&bar[XB_TMO])) break; if (sp > XB_SPIN_CAP) { atomicAdd(&bar[XB_TMO], 1u); break; } }
    }
    nloc = mine > 0u ? mine : 1u; nx = cnt > 0u ? cnt : 1u;
}
__device__ __forceinline__ void xcd_barrier(const XcdBarrier& b) {
    asm volatile("s_waitcnt vmcnt(0)" ::: "memory");
    __syncthreads();
    if (xb_thread0(b.wave)) {
        unsigned* bar = b.bar;
        __builtin_amdgcn_s_waitcnt(0);
        unsigned nloc = b.st[0], nx = b.st[1];
        if (nloc == 0u) { xcd_barrier_complete(bar, b.x, nloc, nx); b.st[0] = nloc; b.st[1] = nx; }
        const unsigned old = xb_add(&bar[XB_XSUB(b.x)], 1u);
        const unsigned gen = old / nloc;
        if (old + 1u == (gen + 1u) * nloc) {
            __builtin_amdgcn_fence(__ATOMIC_RELEASE, "agent");
            asm volatile("s_waitcnt vmcnt(0)" ::: "memory");
            const unsigned og = xb_add(&bar[XB_TOP], 1u);
            const unsigned tg = og / nx;
            if (og + 1u == (tg + 1u) * nx) xb_add(&bar[XB_TOPGEN], 1u);
            else XB_SPIN(xb_ld(&bar[XB_TOPGEN]) == tg, bar);
            __builtin_amdgcn_fence(__ATOMIC_ACQUIRE, "agent");
            xb_add(&bar[XB_XGEN(b.x)], 1u);
            asm volatile("s_waitcnt vmcnt(0)" ::: "memory");
        } else {
            XB_SPIN(xb_ld(&bar[XB_XGEN(b.x)]) == gen, bar);
            __builtin_amdgcn_fence(__ATOMIC_ACQUIRE, "agent");
            asm volatile("s_waitcnt vmcnt(0)" ::: "memory");
        }
    }
    __syncthreads();
}

namespace mk {
using namespace nv;
typedef unsigned v4u __attribute__((ext_vector_type(4)));
typedef unsigned v2u __attribute__((ext_vector_type(2)));
typedef float f32x4 __attribute__((ext_vector_type(4)));
constexpr int NWAVES = 8, NTHREADS = 512;
constexpr int LDS_BYTES = 160 * 1024;
constexpr int MISC_OFF = LDS_BYTES - 256;
constexpr int CW_BAR = 4096;
constexpr size_t CTL_ZERO_BYTES = 64 * 1024;

__device__ __forceinline__ unsigned pk2(float lo, float hi) { return (unsigned)f2bf(lo) | ((unsigned)f2bf(hi) << 16); }

struct Frame {
    LAS unsigned char* lds; int tid, lane, wave, vcu, G, bx;
};

__device__ __forceinline__ void transpose_item(const float* W, int ldw, bf16_t* WT, int ldt, int k0, int n0, int dest_row0, LAS float* scr, int lane, const float* nscale = nullptr) {
    const float sc = nscale ? nscale[n0 + (lane & 31)] : 1.f;
#pragma unroll 8
    for (int i = 0; i < 32; ++i) { const int kk = 2 * i + (lane >> 5); scr[kk * 33 + (lane & 31)] = W[(size_t)(k0 + kk) * ldw + n0 + (lane & 31)] * sc; }
    LDS_WAIT(); asm volatile("" ::: "memory");
    const int c = lane & 7;
#pragma unroll
    for (int j = 0; j < 4; ++j) { const int n = (lane >> 3) + 8 * j; const LAS float* s = scr + (8 * c) * 33 + n;
        v4u o; o.x = pk2(s[0 * 33], s[1 * 33]); o.y = pk2(s[2 * 33], s[3 * 33]); o.z = pk2(s[4 * 33], s[5 * 33]); o.w = pk2(s[6 * 33], s[7 * 33]);
        *(v4u*)(WT + (size_t)(dest_row0 + n) * ldt + k0 + 8 * c) = o; }
    LDS_WAIT(); asm volatile("" ::: "memory");
}
template <int MAP>
__device__ __forceinline__ void transpose_job_item(const float* src, int K, int N, bf16_t* dst, size_t dstb, int r, LAS float* scr, int lane, const float* nscale = nullptr) {
    const int nblk = N / 32, per = (K / 64) * nblk, bi = r / per, it = r % per, kb = it / nblk, nb = it % nblk, n0 = 32 * nb;
    int dr = n0; if (MAP == 1) dr = (n0 >> 7) * 256 + (n0 & 127); if (MAP == 2) dr = (n0 >> 7) * 256 + 128 + (n0 & 127);
    transpose_item(src + (size_t)bi * K * N, N, dst + (size_t)bi * dstb, K, 64 * kb, n0, dr, scr, lane, nscale ? nscale + (size_t)bi * N : nullptr);
}

struct InvFreq { float f[8]; };
struct Args {
    const void* in[40]; float* out; unsigned char* ws; InvFreq inv; int ph_lo, ph_hi;
};

struct RowV { float v[16]; };
__device__ __forceinline__ void unpk8(const v4u u, float* x) {
    x[0] = __uint_as_float(u.x << 16); x[1] = __uint_as_float(u.x & 0xffff0000u); x[2] = __uint_as_float(u.y << 16); x[3] = __uint_as_float(u.y & 0xffff0000u);
    x[4] = __uint_as_float(u.z << 16); x[5] = __uint_as_float(u.z & 0xffff0000u); x[6] = __uint_as_float(u.w << 16); x[7] = __uint_as_float(u.w & 0xffff0000u);
}
struct RowRaw { v4u a, b; };
__device__ __forceinline__ RowRaw load_raw(const bf16_t* p, int lane) { RowRaw r; r.a = *(const v4u*)(p + 8 * lane); r.b = *(const v4u*)(p + 512 + 8 * lane); return r; }
__device__ __forceinline__ void unpack_row(const RowRaw& r, RowV& x) { unpk8(r.a, x.v); unpk8(r.b, x.v + 8); }
struct GB { float g[16], b[16]; };
__device__ __forceinline__ void load_gb(const float* g, const float* b, int lane, GB& o) {
#pragma unroll
    for (int hh = 0; hh < 2; ++hh)
#pragma unroll
        for (int q = 0; q < 2; ++q) { const float4 gg = *(const float4*)(g + 512 * hh + 8 * lane + 4 * q), bb = *(const float4*)(b + 512 * hh + 8 * lane + 4 * q);
            o.g[8 * hh + 4 * q + 0] = gg.x; o.g[8 * hh + 4 * q + 1] = gg.y; o.g[8 * hh + 4 * q + 2] = gg.z; o.g[8 * hh + 4 * q + 3] = gg.w;
            o.b[8 * hh + 4 * q + 0] = bb.x; o.b[8 * hh + 4 * q + 1] = bb.y; o.b[8 * hh + 4 * q + 2] = bb.z; o.b[8 * hh + 4 * q + 3] = bb.w; }
}
__device__ __forceinline__ void ln_rowv(RowV& z, const GB& gb) {
    float s = 0.f;
#pragma unroll
    for (int i = 0; i < 16; ++i) s += z.v[i];
    const float mu = wave_sum(s) * (1.f / D);
    float q = 0.f;
#pragma unroll
    for (int i = 0; i < 16; ++i) { z.v[i] -= mu; q += z.v[i] * z.v[i]; }
    const float rstd = 1.f / sqrtf(wave_sum(q) * (1.f / D) + LN_EPS);
#pragma unroll
    for (int i = 0; i < 16; ++i) z.v[i] = z.v[i] * rstd * gb.g[i] + gb.b[i];
}
__device__ __forceinline__ void store_rowv_bf16(bf16_t* p, int lane, const RowV& r) {
    v4u a, b; a.x = pk2(r.v[0], r.v[1]); a.y = pk2(r.v[2], r.v[3]); a.z = pk2(r.v[4], r.v[5]); a.w = pk2(r.v[6], r.v[7]);
    b.x = pk2(r.v[8], r.v[9]); b.y = pk2(r.v[10], r.v[11]); b.z = pk2(r.v[12], r.v[13]); b.w = pk2(r.v[14], r.v[15]);
    *(v4u*)(p + 8 * lane) = a; *(v4u*)(p + 512 + 8 * lane) = b;
}
constexpr int LNR = 4;

__device__ __forceinline__ void phase_ln_add(const Frame& F, const bf16_t* X, const bf16_t* Y, const float* g, const float* b, bf16_t* out) {
    const int gw = F.vcu * NWAVES + F.wave, NGW = F.G * NWAVES;
    GB gb; load_gb(g, b, F.lane, gb);
    for (int row = gw; row < T; row += LNR * NGW) {
        RowRaw rx[LNR], ry[LNR];
#pragma unroll
        for (int k = 0; k < LNR; ++k) { const int rr = row + k * NGW; if (rr < T) { rx[k] = load_raw(X + (size_t)rr * D, F.lane); ry[k] = load_raw(Y + (size_t)rr * D, F.lane); } }
#pragma unroll
        for (int k = 0; k < LNR; ++k) { const int rr = row + k * NGW; if (rr < T) {
            RowV x, y; unpack_row(rx[k], x); unpack_row(ry[k], y);
#pragma unroll
            for (int i = 0; i < 16; ++i) x.v[i] = ALPHA * x.v[i] + y.v[i];
            ln_rowv(x, gb);
            store_rowv_bf16(out + (size_t)rr * D, F.lane, x); } }
    }
}
__device__ __forceinline__ void phase_ln_moe(const Frame& F, const bf16_t* X, const bf16_t* DS, const int* pos, const float* ewgt, const float* g, const float* b, bf16_t* outb, float* outf) {
    const int gw = F.vcu * NWAVES + F.wave, NGW = F.G * NWAVES;
    GB gb; load_gb(g, b, F.lane, gb);
    for (int row = gw; row < T; row += LNR * NGW) {
        RowRaw rx[LNR], r1[LNR], r2[LNR]; float w1[LNR], w2[LNR];
#pragma unroll
        for (int k = 0; k < LNR; ++k) { const int rr = row + k * NGW; if (rr < T) {
            const int2 pp = *(const int2*)(pos + 2 * rr); const float2 ww = *(const float2*)(ewgt + 2 * rr); w1[k] = ww.x; w2[k] = ww.y;
            rx[k] = load_raw(X + (size_t)rr * D, F.lane); r1[k] = load_raw(DS + (size_t)pp.x * D, F.lane); r2[k] = load_raw(DS + (size_t)pp.y * D, F.lane); } }
#pragma unroll
        for (int k = 0; k < LNR; ++k) { const int rr = row + k * NGW; if (rr < T) {
            RowV x, y1, y2; unpack_row(rx[k], x); unpack_row(r1[k], y1); unpack_row(r2[k], y2);
#pragma unroll
            for (int i = 0; i < 16; ++i) x.v[i] = ALPHA * x.v[i] + (w1[k] * y1.v[i] + w2[k] * y2.v[i]);
            ln_rowv(x, gb);
            if (outb) store_rowv_bf16(outb + (size_t)rr * D, F.lane, x);
            if (outf) { float* o = outf + (size_t)rr * D + 8 * F.lane;
                *(float4*)(o) = make_float4(x.v[0], x.v[1], x.v[2], x.v[3]); *(float4*)(o + 4) = make_float4(x.v[4], x.v[5], x.v[6], x.v[7]);
                *(float4*)(o + 512) = make_float4(x.v[8], x.v[9], x.v[10], x.v[11]); *(float4*)(o + 516) = make_float4(x.v[12], x.v[13], x.v[14], x.v[15]); } } }
    }
}
constexpr int RW_LD = 20;
__device__ __forceinline__ void phase_ln_router(const Frame& F, const bf16_t* X, const bf16_t* Y, const float* g, const float* b, bf16_t* out, const float* rw, const float* rbias, int* eidx, float* ewgt, int* bcnt) {
    LAS float* rwl = (LAS float*)F.lds;
    LAS int* hist = (LAS int*)(F.lds + 1024 * RW_LD * 4);
    LAS float* lgs = (LAS float*)(F.lds + 1024 * RW_LD * 4 + 256) + F.wave * 64;
    for (int i = F.tid; i < 1024 * 4; i += NTHREADS) { const int k = i >> 2, q = i & 3; const float4 v = *(const float4*)(rw + (size_t)k * 16 + 4 * q);
        const int j = (k >> 9) * 8 + (k & 7), l = (k >> 3) & 63; LAS float* d = rwl + (j * 64 + l) * RW_LD + 4 * q; d[0] = v.x; d[1] = v.y; d[2] = v.z; d[3] = v.w; }
    GB gb; load_gb(g, b, F.lane, gb);
    const int lane = F.lane;
    for (int vb = F.vcu; vb < T / 128; vb += F.G) {
        if (F.tid < 16) hist[F.tid] = 0;
        __syncthreads();
#pragma unroll 1
        for (int it = 0; it < 4; ++it) {
            const int row0 = vb * 128 + F.wave * 16 + it * 4;
            RowRaw rx[4], ry[4];
#pragma unroll
            for (int k = 0; k < 4; ++k) { rx[k] = load_raw(X + (size_t)(row0 + k) * D, lane); ry[k] = load_raw(Y + (size_t)(row0 + k) * D, lane); }
            RowV x[4];
#pragma unroll
            for (int k = 0; k < 4; ++k) { RowV y; unpack_row(rx[k], x[k]); unpack_row(ry[k], y);
#pragma unroll
                for (int i = 0; i < 16; ++i) x[k].v[i] = ALPHA * x[k].v[i] + y.v[i];
                ln_rowv(x[k], gb);
                store_rowv_bf16(out + (size_t)(row0 + k) * D, lane, x[k]); }
            float val[64];
#pragma unroll
            for (int i = 0; i < 64; ++i) val[i] = 0.f;
#pragma unroll
            for (int j = 0; j < 16; ++j) { const LAS float* wr = rwl + (j * 64 + lane) * RW_LD;
#pragma unroll
                for (int e4 = 0; e4 < 4; ++e4) { const f32x4 w4 = *(const LAS f32x4*)(wr + 4 * e4);
#pragma unroll
                    for (int k = 0; k < 4; ++k) { const float xv = x[k].v[j];
                        val[16 * k + 4 * e4 + 0] += xv * w4[0]; val[16 * k + 4 * e4 + 1] += xv * w4[1]; val[16 * k + 4 * e4 + 2] += xv * w4[2]; val[16 * k + 4 * e4 + 3] += xv * w4[3]; } } }
#pragma unroll
            for (int i = 0; i < 32; ++i) { const auto rr = __builtin_amdgcn_permlane32_swap(__float_as_uint(val[i]), __float_as_uint(val[i + 32]), false, false); val[i] = __uint_as_float(rr[0]) + __uint_as_float(rr[1]); }
            { const bool bt = (lane & 16) != 0;
#pragma unroll
              for (int i = 0; i < 16; ++i) { const float keep = bt ? val[i + 16] : val[i], send = bt ? val[i] : val[i + 16]; val[i] = keep + swz_xor<16>(send); } }
            { const bool bt = (lane & 8) != 0;
#pragma unroll
              for (int i = 0; i < 8; ++i) { const float keep = bt ? val[i + 8] : val[i], send = bt ? val[i] : val[i + 8]; val[i] = keep + swz_xor<8>(send); } }
            { const bool bt = (lane & 4) != 0;
#pragma unroll
              for (int i = 0; i < 4; ++i) { const float keep = bt ? val[i + 4] : val[i], send = bt ? val[i] : val[i + 4]; val[i] = keep + swz_xor<4>(send); } }
            { const bool bt = (lane & 2) != 0;
#pragma unroll
              for (int i = 0; i < 2; ++i) { const float keep = bt ? val[i + 2] : val[i], send = bt ? val[i] : val[i + 2]; val[i] = keep + swz_xor<2>(send); } }
            { const bool bt = (lane & 1) != 0; const float keep = bt ? val[1] : val[0], send = bt ? val[0] : val[1]; val[0] = keep + swz_xor<1>(send); }
            lgs[lane] = val[0];
            LDS_WAIT();
            if (lane < 4) {
                const int row = row0 + lane;
                float lg[16];
#pragma unroll
                for (int e4 = 0; e4 < 4; ++e4) { const f32x4 t4 = *(const LAS f32x4*)(lgs + 16 * lane + 4 * e4); lg[4 * e4] = t4[0]; lg[4 * e4 + 1] = t4[1]; lg[4 * e4 + 2] = t4[2]; lg[4 * e4 + 3] = t4[3]; }
                float mx = lg[0];
#pragma unroll
                for (int e = 1; e < 16; ++e) mx = fmaxf(mx, lg[e]);
                float sc[16], sum = 0.f;
#pragma unroll
                for (int e = 0; e < 16; ++e) { sc[e] = __expf(lg[e] - mx); sum += sc[e]; }
                const float isum = 1.f / sum;
                float bz[16];
#pragma unroll
                for (int e = 0; e < 16; ++e) { sc[e] *= isum; bz[e] = sc[e] + rbias[e]; }
                float gs[4]; int gi1[4], gi2[4];
#pragma unroll
                for (int gq = 0; gq < 4; ++gq) {
                    float m1 = bz[4 * gq]; int i1 = 0;
#pragma unroll
                    for (int j = 1; j < 4; ++j) if (bz[4 * gq + j] > m1) { m1 = bz[4 * gq + j]; i1 = j; }
                    float m2 = -INFINITY; int i2 = 0;
#pragma unroll
                    for (int j = 0; j < 4; ++j) if (j != i1 && bz[4 * gq + j] > m2) { m2 = bz[4 * gq + j]; i2 = j; }
                    gs[gq] = m1 + m2; gi1[gq] = i1; gi2[gq] = i2;
                }
                int gsel = 0; float gm = gs[0];
#pragma unroll
                for (int gq = 1; gq < 4; ++gq) if (gs[gq] > gm) { gm = gs[gq]; gsel = gq; }
                int i1 = gi1[0], i2 = gi2[0];
#pragma unroll
                for (int gq = 1; gq < 4; ++gq) if (gsel == gq) { i1 = gi1[gq]; i2 = gi2[gq]; }
                const int e1 = gsel * 4 + i1, e2 = gsel * 4 + i2;
                float s1 = 0.f, s2 = 0.f;
#pragma unroll
                for (int e = 0; e < 16; ++e) { if (e == e1) s1 = sc[e]; if (e == e2) s2 = sc[e]; }
                const float inv = 1.f / (s1 + s2);
                *(int2*)(eidx + 2 * row) = make_int2(e1, e2); *(float2*)(ewgt + 2 * row) = make_float2(s1 * inv, s2 * inv);
                atomicAdd((int*)&hist[e1], 1); atomicAdd((int*)&hist[e2], 1);
            }
        }
        __syncthreads();
        if (F.tid < 16) bcnt[vb * 16 + F.tid] = hist[F.tid];
        __syncthreads();
    }
}
__device__ __forceinline__ void phase_moe_book(const Frame& F, const int* eidx, const int* bcnt, int* tok, int* pos, int* tile_e) {
    LAS int* bc = (LAS int*)F.lds;
    LAS int* es = bc + 4096;
    LAS int* off = es + 256;
    LAS int* base = off + 32;
    LAS int* tot = base + 16;
    for (int i = F.tid; i < 4096; i += NTHREADS) bc[i] = bcnt[i];
    __syncthreads();
    for (int vb = F.vcu; vb < T / 128; vb += F.G) {
        if (F.tid < 16) { int t = 0, bs = 0; for (int b2 = 0; b2 < 256; ++b2) { const int c = bc[b2 * 16 + F.tid]; t += c; if (b2 < vb) bs += c; } tot[F.tid] = t; base[F.tid] = bs; }
        if (F.tid < 256) es[F.tid] = eidx[vb * 256 + F.tid];
        __syncthreads();
        if (F.tid == 0) { int o = 0; for (int e = 0; e < 16; ++e) { off[e] = o; o += (tot[e] + 255) & ~255; } off[16] = o; }
        __syncthreads();
        if (F.tid < 256) {
            const int e = es[F.tid]; int rank = 0;
            for (int j = 0; j < F.tid; ++j) rank += (es[j] == e) ? 1 : 0;
            const int r = off[e] + base[e] + rank;
            pos[vb * 256 + F.tid] = r; tok[r] = vb * 128 + (F.tid >> 1);
        }
        if (vb < 16) { const int e = vb, r0 = off[e] + tot[e], r1 = off[e + 1]; for (int r = r0 + F.tid; r < r1; r += NTHREADS) tok[r] = 0; }
        if (vb == 16) {
            for (int tl = F.tid; tl < NTILE; tl += NTHREADS) { int e = -1; for (int k = 0; k < 16; ++k) if (tl * 256 >= off[k] && tl * 256 < off[k + 1]) e = k; tile_e[tl] = e; }
            if (F.tid == 0) tile_e[NTILE] = off[16] >> 8;
        }
        __syncthreads();
    }
}
__device__ __forceinline__ void phase_pool(const Frame& F, const bf16_t* HP, bf16_t* PO) {
    constexpr int RUN = 32;
    const int gt = F.vcu * NTHREADS + F.tid, NGT = F.G * NTHREADS;
    for (int it = gt; it < (T / RUN) * (D / 8); it += NGT) {
        const int c8 = it & 127, run = it >> 7, g = c8 >> 5, win = 2 << g, t0 = run * RUN, ts0 = t0 & (S - 1);
        const bf16_t* hp = HP + (size_t)t0 * D + c8 * 8; bf16_t* po = PO + (size_t)t0 * D + c8 * 8;
        float s[8];
#pragma unroll
        for (int q = 0; q < 8; ++q) s[q] = 0.f;
        for (int k = 1; k < win; ++k) if (ts0 - k >= 0) { float v[8]; unpk8(*(const v4u*)(hp - (ptrdiff_t)k * D), v);
#pragma unroll
            for (int q = 0; q < 8; ++q) s[q] += v[q]; }
#pragma unroll 4
        for (int i = 0; i < RUN; ++i) {
            float hn[8]; unpk8(*(const v4u*)(hp + (size_t)i * D), hn);
            const int ts = ts0 + i;
#pragma unroll
            for (int q = 0; q < 8; ++q) s[q] += hn[q];
            const float inv = 1.f / (float)(ts + 1 < win ? ts + 1 : win);
            v4u o; o.x = pk2(s[0] * inv - hn[0], s[1] * inv - hn[1]); o.y = pk2(s[2] * inv - hn[2], s[3] * inv - hn[3]); o.z = pk2(s[4] * inv - hn[4], s[5] * inv - hn[5]); o.w = pk2(s[6] * inv - hn[6], s[7] * inv - hn[7]);
            *(v4u*)(po + (size_t)i * D) = o;
            if (ts + 1 >= win) { float ho[8]; unpk8(*(const v4u*)(hp + (ptrdiff_t)(i + 1 - win) * D), ho);
#pragma unroll
                for (int q = 0; q < 8; ++q) s[q] -= ho[q]; }
        }
    }
}
}
namespace mk {
typedef short bf16x8 __attribute__((ext_vector_type(8)));
typedef float f32x16 __attribute__((ext_vector_type(16)));
#define MFMA32(a, b, c) __builtin_amdgcn_mfma_f32_32x32x16_bf16((a), (b), (c), 0, 0, 0)
__device__ __forceinline__ int crow(int i, int h) { return (i & 3) + 8 * (i >> 2) + 4 * h; }
__device__ __forceinline__ float swap32_max(float v) { const auto r = __builtin_amdgcn_permlane32_swap(__float_as_uint(v), __float_as_uint(v), false, false); return fmaxf(__uint_as_float(r[0]), __uint_as_float(r[1])); }
__device__ __forceinline__ float swap32_sum(float v) { const auto r = __builtin_amdgcn_permlane32_swap(__float_as_uint(v), __float_as_uint(v), false, false); return __uint_as_float(r[0]) + __uint_as_float(r[1]); }
__device__ __forceinline__ unsigned pkbf(float lo, float hi) { unsigned r; asm volatile("v_cvt_pk_bf16_f32 %0, %1, %2" : "=v"(r) : "v"(lo), "v"(hi)); return r; }
__device__ __forceinline__ bf16x8 pack_step(const f32x16& x, int s) {
    v4u p; p.x = pkbf(x[8 * s + 0], x[8 * s + 1]); p.y = pkbf(x[8 * s + 2], x[8 * s + 3]); p.z = pkbf(x[8 * s + 4], x[8 * s + 5]); p.w = pkbf(x[8 * s + 6], x[8 * s + 7]);
    return __builtin_bit_cast(bf16x8, p);
}
__device__ __forceinline__ bf16x8 lds_frag2x8(const LAS unsigned char* p) {
    const v2u a = *(const LAS v2u*)p, b = *(const LAS v2u*)(p + 16);
    v4u q; q.x = a.x; q.y = a.y; q.z = b.x; q.w = b.y; return __builtin_bit_cast(bf16x8, q);
}
__device__ __forceinline__ void unpack8(const v4u u, float (&x)[8]) {
    x[0] = __uint_as_float(u.x << 16); x[1] = __uint_as_float(u.x & 0xffff0000u); x[2] = __uint_as_float(u.y << 16); x[3] = __uint_as_float(u.y & 0xffff0000u);
    x[4] = __uint_as_float(u.z << 16); x[5] = __uint_as_float(u.z & 0xffff0000u); x[6] = __uint_as_float(u.w << 16); x[7] = __uint_as_float(u.w & 0xffff0000u);
}

__device__ __forceinline__ void phase_swa_sgu(const Frame& F, const bf16_t* H0, const float* sinks, const float* lng, const float* lnb, const bf16_t* SW, const float* bs, bf16_t* MIX) {
    constexpr int KSTR = 272, VSTR = 520, VT_OFF = 256 * KSTR, VGSTR = 272, VGW = 64 * VGSTR;
    LAS unsigned char* KS = F.lds; LAS unsigned char* VT = F.lds + VT_OFF;
    const int lane = F.lane, r = lane & 31, h = lane >> 5, w = F.wave, kvh = w >> 2;
    const float NEG = -INFINITY;
    for (int vb = F.vcu; vb < T / 128; vb += F.G) {
        const int n = vb & 63; const size_t row0 = (size_t)vb * 128;
#pragma unroll
        for (int i = 0; i < 8; ++i) { const int p = F.tid + NTHREADS * i, row = p >> 4, c16 = p & 15; v4u v = (v4u){0u, 0u, 0u, 0u};
            if (n > 0 || row >= 128) v = *(const v4u*)(H0 + (row0 + row - 128) * NIN0 + 512 + c16 * 8);
            *(LAS v4u*)(KS + row * KSTR + c16 * 16) = v; }
#pragma unroll
        for (int i = 0; i < 8; ++i) { const int p = F.tid + NTHREADS * i, c16 = p >> 8, row = p & 255; v4u v = (v4u){0u, 0u, 0u, 0u};
            if (n > 0 || row >= 128) v = *(const v4u*)(H0 + (row0 + row - 128) * NIN0 + 640 + c16 * 8);
            LAS bf16_t* d = (LAS bf16_t*)(VT + (c16 * 8) * VSTR + row * 2);
            d[0 * (VSTR / 2)] = (bf16_t)(v.x & 0xffffu); d[1 * (VSTR / 2)] = (bf16_t)(v.x >> 16); d[2 * (VSTR / 2)] = (bf16_t)(v.y & 0xffffu); d[3 * (VSTR / 2)] = (bf16_t)(v.y >> 16);
            d[4 * (VSTR / 2)] = (bf16_t)(v.z & 0xffffu); d[5 * (VSTR / 2)] = (bf16_t)(v.z >> 16); d[6 * (VSTR / 2)] = (bf16_t)(v.w & 0xffffu); d[7 * (VSTR / 2)] = (bf16_t)(v.w >> 16); }
        __syncthreads();
        const float sink2 = sinks[w] * 1.4426950408889634f;
#pragma unroll 1
        for (int qg = 0; qg < 4; ++qg) {
            bf16x8 qf[4];
            { const bf16_t* qp = H0 + (row0 + 32 * qg + r) * NIN0 + w * 64 + 8 * h;
#pragma unroll
              for (int ks = 0; ks < 4; ++ks) qf[ks] = *(const bf16x8*)(qp + 16 * ks); }
            f32x16 st[5];
#pragma unroll
            for (int kt = 0; kt < 5; ++kt) {
#pragma unroll
                for (int i = 0; i < 16; ++i) st[kt][i] = 0.f;
                const LAS unsigned char* kp = KS + (32 * qg + 32 * kt + r) * KSTR + (kvh * 64 + 8 * h) * 2;
#pragma unroll
                for (int ks = 0; ks < 4; ++ks) { const bf16x8 kf = *(const LAS bf16x8*)(kp + 32 * ks); st[kt] = MFMA32(kf, qf[ks], st[kt]); }
            }
            float m = sink2;
#pragma unroll
            for (int kt = 0; kt < 5; ++kt)
#pragma unroll
                for (int i = 0; i < 16; ++i) { const int dk = 32 * kt + crow(i, h) - r;
                    const bool valid = dk >= 1 && dk <= 128 && (n > 0 || (32 * qg + 32 * kt + crow(i, h)) >= 128);
                    const float s = valid ? st[kt][i] * ASCALE : NEG; st[kt][i] = s; m = fmaxf(m, s); }
            m = swap32_max(m);
            float l = 0.f;
#pragma unroll
            for (int kt = 0; kt < 5; ++kt)
#pragma unroll
                for (int i = 0; i < 16; ++i) { const float p = __builtin_amdgcn_exp2f(st[kt][i] - m); st[kt][i] = p; l += p; }
            l = swap32_sum(l) + __builtin_amdgcn_exp2f(sink2 - m);
            f32x16 o[2];
#pragma unroll
            for (int i = 0; i < 16; ++i) { o[0][i] = 0.f; o[1][i] = 0.f; }
#pragma unroll
            for (int kt = 0; kt < 5; ++kt)
#pragma unroll
                for (int s = 0; s < 2; ++s) { const bf16x8 pf = pack_step(st[kt], s);
#pragma unroll
                    for (int dt = 0; dt < 2; ++dt) { const bf16x8 vf = lds_frag2x8(VT + (kvh * 64 + 32 * dt + r) * VSTR + (32 * qg + 32 * kt + 16 * s + 4 * h) * 2); o[dt] = MFMA32(vf, pf, o[dt]); } }
            const float inv = 1.f / l;
            bf16_t* op = MIX + (row0 + 32 * qg + r) * D + w * 64 + 4 * h;
#pragma unroll
            for (int dt = 0; dt < 2; ++dt)
#pragma unroll
                for (int g4 = 0; g4 < 4; ++g4) { v2u u; u.x = pkbf(o[dt][4 * g4 + 0] * inv, o[dt][4 * g4 + 1] * inv); u.y = pkbf(o[dt][4 * g4 + 2] * inv, o[dt][4 * g4 + 3] * inv); *(v2u*)(op + 32 * dt + 8 * g4) = u; }
        }
        __syncthreads();
        {
            LAS unsigned char* VG = F.lds + w * VGW; const int g = w;
#pragma unroll 1
            for (int it = 0; it < 2; ++it) { const int s = 64 * it + lane; const bf16_t* vp = H0 + (row0 + s) * NIN0 + 1280 + g * 64;
                float x[8][8]; float sum = 0.f;
#pragma unroll
                for (int cq = 0; cq < 8; ++cq) { unpack8(*(const v4u*)(vp + 8 * cq), x[cq]);
#pragma unroll
                    for (int e = 0; e < 8; ++e) sum += x[cq][e]; }
                const float mu = sum * (1.f / 64.f); float q = 0.f;
#pragma unroll
                for (int cq = 0; cq < 8; ++cq)
#pragma unroll
                    for (int e = 0; e < 8; ++e) { x[cq][e] -= mu; q += x[cq][e] * x[cq][e]; }
                const float rstd = 1.f / sqrtf(q * (1.f / 64.f) + LN_EPS);
#pragma unroll
                for (int cq = 0; cq < 8; ++cq)
#pragma unroll
                    for (int e = 0; e < 8; ++e) { const int c = 8 * cq + e; *(LAS bf16_t*)(VG + c * VGSTR + s * 2) = f2bf(x[cq][e] * rstd * lng[g * 64 + c] + lnb[g * 64 + c]); }
            }
            LDS_WAIT();
#pragma unroll 1
            for (int tt = 0; tt < 4; ++tt) {
                f32x16 acc[2];
#pragma unroll
                for (int i = 0; i < 16; ++i) { acc[0][i] = 0.f; acc[1][i] = 0.f; }
                const bf16_t* wp = SW + ((size_t)(g * 128 + 32 * tt + r) * 128 + 8 * h);
                for (int ks = 0; ks < 2 * (tt + 1); ++ks) { const bf16x8 bfr = *(const bf16x8*)(wp + 16 * ks);
#pragma unroll
                    for (int ct = 0; ct < 2; ++ct) { const bf16x8 af = *(const LAS bf16x8*)(VG + (32 * ct + r) * VGSTR + (16 * ks + 8 * h) * 2); acc[ct] = MFMA32(af, bfr, acc[ct]); } }
                const int t = 32 * tt + r; const float bias = bs[g * 128 + t];
                const bf16_t* up = H0 + (row0 + t) * NIN0 + 768 + g * 64 + 4 * h; bf16_t* op = MIX + (row0 + t) * D + 512 + g * 64 + 4 * h;
#pragma unroll
                for (int ct = 0; ct < 2; ++ct)
#pragma unroll
                    for (int g4 = 0; g4 < 4; ++g4) { const v2u uu = *(const v2u*)(up + 32 * ct + 8 * g4);
                        const float u0 = __uint_as_float(uu.x << 16), u1 = __uint_as_float(uu.x & 0xffff0000u), u2 = __uint_as_float(uu.y << 16), u3 = __uint_as_float(uu.y & 0xffff0000u);
                        v2u o2; o2.x = pkbf(u0 * (acc[ct][4 * g4 + 0] + bias), u1 * (acc[ct][4 * g4 + 1] + bias)); o2.y = pkbf(u2 * (acc[ct][4 * g4 + 2] + bias), u3 * (acc[ct][4 * g4 + 3] + bias));
                        *(v2u*)(op + 32 * ct + 8 * g4) = o2; }
            }
        }
        __syncthreads();
    }
}

}
namespace mk {
constexpr int NPHASE = 23;

typedef const __attribute__((address_space(4))) Args* KArgs;
__device__ __forceinline__ KArgs kargs() { KArgs p = (KArgs)__builtin_amdgcn_kernarg_segment_ptr(); asm volatile("" : "+s"(p)); return p; }

__device__ __forceinline__ bool in_range(int k) { KArgs ka = kargs(); return ka->ph_lo <= k && k < ka->ph_hi; }

__global__ void __launch_bounds__(NTHREADS, 2) mega(Args a) {
    extern __shared__ __attribute__((aligned(16))) unsigned char lds_raw[];
    LAS unsigned char* const F0lds = (LAS unsigned char*)lds_raw;
    const int F0wave = __builtin_amdgcn_readfirstlane((int)threadIdx.x >> 6);
    const int F0G = gridDim.x, F0bx = blockIdx.x, F0vcu = (F0G % 8 == 0) ? (F0bx % 8) * (F0G / 8) + F0bx / 8 : F0bx;
    volatile LAS unsigned* MISC = (volatile LAS unsigned*)(F0lds + MISC_OFF);
    if (threadIdx.x < 64) MISC[threadIdx.x] = 0u;
    __syncthreads();
    unsigned* ctl = (unsigned*)(a.ws + WS_CTL);
    XcdBarrier bar = xcd_barrier_post(ctl + CW_BAR + a.ph_lo * XCD_BAR_WORDS, MISC + 8, F0wave);
#define IN(k) in_range(k)
#define SEAM(k) do { if (IN(k) && IN((k) + 1)) { XcdBarrier b2_ = bar; asm volatile("" : "+s"(b2_.bar), "+s"(b2_.x)); xcd_barrier(b2_); } } while (0)
#define PH KArgs ka = kargs(); unsigned char* ws = ka->ws; (void)ws; Frame Fp; Fp.lds = F0lds; Fp.wave = F0wave; Fp.vcu = F0vcu; Fp.G = F0G; Fp.bx = F0bx; asm volatile("" : "+s"(Fp.wave), "+s"(Fp.vcu), "+s"(Fp.G), "+s"(Fp.bx)); \
    Fp.lane = (int)lane_id_fresh(); Fp.tid = Fp.wave * 64 + Fp.lane; const Frame& F = Fp; \
    const int bx = Fp.bx; (void)bx; LAS unsigned char* glds = F.lds; (void)glds; \
    bf16_t* RA = (bf16_t*)(ws + WS_A); bf16_t* RB = (bf16_t*)(ws + WS_B); bf16_t* RC = (bf16_t*)(ws + WS_C); bf16_t* RD = (bf16_t*)(ws + WS_D); bf16_t* WB = (bf16_t*)(ws + WS_WB); \
    (void)RA; (void)RB; (void)RC; (void)RD; (void)WB;
#define PHC PH const int cb = L == 0 ? 12 : 28; (void)cb; bf16_t* WBl = WB + WB_LAYER + (size_t)L * WL_SIZE; (void)WBl; \
    bf16_t *X1 = RB, *Qb, *Y2, *X2, *HS = RB, *DS = RD, *X3; Qb = RA; Y2 = RC; X2 = RA; X3 = L == 0 ? RC : nullptr; \
    (void)X1; (void)Qb; (void)Y2; (void)X2; (void)HS; (void)DS; (void)X3;
#ifndef DOUBLE_MASK
#define DOUBLE_MASK 0u
#endif
#if DOUBLE_MASK != 0
#define REP(k) for (int rep_ = 0, nrep_ = 1 + (int)((DOUBLE_MASK >> (k)) & 1u); rep_ < nrep_; ++rep_)
#else
#define REP(k)
#endif
#define INF(i) ((const float*)ka->in[i])
#define WSI(off) ((int*)(ws + (off)))
#define WSF(off) ((float*)(ws + (off)))

#define GEMM_STD(EPI, ORD, LDA_, LDB_, K_) pg8::gemm_phase<EPI, ORD, true, true, false, LDA_, LDB_, K_>(glds, F.tid, g, S, E)
    for (int L = 0; L < 2; ++L) {
        const int cbp = L == 0 ? 0 : 11;
        if (L == 0) {
            if (IN(0)) REP(0) { PH
                LAS float* scr = (LAS float*)(F.lds + F.wave * 16384);
                const int gw = F.vcu * NWAVES + F.wave, NGW = F.G * NWAVES;
                constexpr int NITEMS = 896 + 512 + 512 + 512 + 2 * (1024 + 512 + 3 * 4096);
                for (int it = gw; it < NITEMS; it += NGW) {
                    int r = it;
#define JOB(MAP, src, K_, N_, dst, dstb, cnt) if (r < (cnt)) { transpose_job_item<MAP>((const float*)(src), K_, N_, dst, dstb, r, scr, F.lane); continue; } r -= (cnt);
                    JOB(0, ka->in[5], 1024, 1792, WB + WB_IN0, 0, 896)
                    JOB(0, ka->in[11], 1024, 1024, WB + WB_OUT0, 0, 512)
                    JOB(0, ka->in[24], 1024, 1024, WB + WB_IN1, 0, 512)
                    JOB(0, ka->in[27], 1024, 1024, WB + WB_OUT1, 0, 512)
#define LAYER_JOBS(l, c2) { bf16_t* Wl = WB + WB_LAYER + (size_t)(l) * WL_SIZE; \
                        JOB(0, ka->in[(c2) + 3], 1024, 2048, Wl + WL_XKV, 0, 1024) \
                        JOB(0, ka->in[(c2) + 4], 1024, 1024, Wl + WL_XO, 0, 512) \
                        JOB(1, ka->in[(c2) + 7], 1024, 512, Wl + WL_GU, (size_t)1024 * 1024, 4096) \
                        JOB(2, ka->in[(c2) + 8], 1024, 512, Wl + WL_GU, (size_t)1024 * 1024, 4096) \
                        JOB(0, ka->in[(c2) + 9], 512, 1024, Wl + WL_DN, (size_t)1024 * 512, 4096) }
                    LAYER_JOBS(0, 12)
                    LAYER_JOBS(1, 28)
#undef LAYER_JOBS
#undef JOB
                }
                const int gt = F.vcu * NTHREADS + F.tid, NGT = F.G * NTHREADS;
                { const float4* x4 = (const float4*)ka->in[0]; v2u* o = (v2u*)RA;
                  for (int i = gt; i < T * D / 4; i += NGT) { const float4 v = x4[i]; v2u w; w.x = pk2(v.x, v.y); w.y = pk2(v.z, v.w); o[i] = w; } }
                { const float4* m4 = (const float4*)ka->in[1]; v2u* o = (v2u*)(ws + WS_MEMB);
                  for (int i = gt; i < B * MEM * D / 4; i += NGT) { const float4 v = m4[i]; v2u w; w.x = pk2(v.x, v.y); w.y = pk2(v.z, v.w); o[i] = w; } }
#pragma unroll
                for (int l = 0; l < 2; ++l) { const float4* q4 = (const float4*)ka->in[l == 0 ? 14 : 30]; v2u* o = (v2u*)(WB + WB_LAYER + (size_t)l * WL_SIZE + WL_XQ);
                  for (int i = gt; i < D * D / 4; i += NGT) { const float4 v = q4[i]; v2u w; w.x = pk2(v.x, v.y); w.y = pk2(v.z, v.w); o[i] = w; } }
                { const float4* p4 = (const float4*)ka->in[25]; const float4* s4 = (const float4*)ka->in[26]; v2u* o = (v2u*)(WB + WB_POOL);
                  for (int i = gt; i < 4 * 256 * 256 / 4; i += NGT) { const float4 v = p4[i]; const float4 sc = s4[(i >> 14) * 64 + (i & 63)]; v2u w; w.x = pk2(v.x * sc.x, v.y * sc.y); w.y = pk2(v.z * sc.z, v.w * sc.w); o[i] = w; } }
                { const int* positions = (const int*)ka->in[2]; float* ropew = WSF(WS_ROPE);
                  for (int t = gt; t < T; t += NGT) { const float p = (float)positions[t];
#pragma unroll
                      for (int j = 0; j < 8; ++j) { const float ang = p * ka->inv.f[j]; double rev = (double)ang * 0.15915494309189535; rev -= rint(rev); const float rr = (float)rev;
                          ropew[(size_t)t * 16 + j] = __builtin_amdgcn_cosf(rr); ropew[(size_t)t * 16 + 8 + j] = __builtin_amdgcn_sinf(rr); } } }
                { const float* sw = INF(9); bf16_t* o = WB + WB_SGUW;
                  for (int i = gt; i < 8 * 128 * 128; i += NGT) { const int s2 = i & 127, t = (i >> 7) & 127; o[i] = f2bf(s2 <= t ? sw[i] : 0.f); } }
            }
            SEAM(0);
            if (IN(1)) REP(1) { PH float* rope = WSF(WS_ROPE); bf16_t* MEMB = (bf16_t*)(ws + WS_MEMB);
#pragma unroll 1
                for (int l = 0; l < 2; ++l) {
                    bf16_t* Wl = WB + WB_LAYER + (size_t)l * WL_SIZE;
                    pg8::Gemm g{MEMB, Wl + WL_XKV, nullptr};
                    const int c2 = bx - 128 - 32 * l;
                    pg8::StaticOrder S; S.init(B * MEM, 2048, F.G, (c2 >= 0 && c2 < 32) ? c2 : (1 << 20), D, D);
                    pg8::EpiBf16 E{(bf16_t*)(ws + WS_MEMKV) + (size_t)l * B * MEM * 2048, 2048, 1.f};
                    GEMM_STD(pg8::EpiBf16, pg8::StaticOrder, D, D, D);
                }
                {
                    pg8::Gemm g{RA, WB + WB_IN0, nullptr};
                    pg8::StaticOrder S; S.init(T, NIN0, F.G, bx, D, D);
                    pg8::EpiInproj0 E{RD, rope};
                    GEMM_STD(pg8::EpiInproj0, pg8::StaticOrder, D, D, D);
                }
            }
            SEAM(1);
            if (IN(2)) REP(2) { PH
                { bf16_t* Wl = WB + WB_LAYER; const bf16_t* KV = (const bf16_t*)(ws + WS_MEMKV);
                  { pg8::Gemm g{KV, Wl + WL_XQ, nullptr}; pg8::SetupOrder<0> S; S.init(bx, 0, 64); pg8::EpiBf16 E{(bf16_t*)(ws + WS_MT), D, QSCALE}; GEMM_STD(pg8::EpiBf16, pg8::SetupOrder<0>, 2048, 1024, 256); }
                  { pg8::Gemm g{Wl + WL_XO, KV, nullptr}; pg8::SetupOrder<1> S; S.init(bx, 64, 64); pg8::EpiBf16 E{(bf16_t*)(ws + WS_NT), D, 1.f}; GEMM_STD(pg8::EpiBf16, pg8::SetupOrder<1>, 1024, 2048, 256); }
                  { pg8::Gemm g{WB + WB_OUT1, WB + WB_POOL, nullptr}; pg8::SetupOrder<2> S; S.init(bx, 128, 16); pg8::EpiBf16 E{WB + WB_WEFF, D, 1.f}; GEMM_STD(pg8::EpiBf16, pg8::SetupOrder<2>, 1024, 256, 256); } }
                phase_swa_sgu(F, RD, INF(6), INF(7), INF(8), WB + WB_SGUW, INF(10), RB);
            }
            SEAM(2);
            if (IN(3)) REP(3) { PH
                pg8::Gemm g{RB, WB + WB_OUT0, nullptr};
                pg8::StaticOrder S; S.init(T, D, F.G, bx, D, D);
                pg8::EpiBf16 E{RC, D, 1.f};
                GEMM_STD(pg8::EpiBf16, pg8::StaticOrder, D, D, D);
            }
            SEAM(3);
            if (IN(4)) REP(4) { PH phase_ln_add(F, RA, RC, INF(12), INF(13), RB); }
            SEAM(4);
        } else {
            if (IN(12)) REP(12) { PH
                pg8::Gemm g{RC, WB + WB_IN1, nullptr};
                pg8::StaticOrder S; S.init(T, D, F.G, bx, D, D);
                pg8::EpiBf16 E{RB, D, 1.f};
                GEMM_STD(pg8::EpiBf16, pg8::StaticOrder, D, D, D);
            }
            SEAM(12);
            if (IN(13)) REP(13) { PH
                { bf16_t* Wl = WB + WB_LAYER + WL_SIZE; const bf16_t* KV = (const bf16_t*)(ws + WS_MEMKV) + (size_t)B * MEM * 2048;
                  { pg8::Gemm g{KV, Wl + WL_XQ, nullptr}; pg8::SetupOrder<0> S; S.init(bx, 0, 64); pg8::EpiBf16 E{(bf16_t*)(ws + WS_MT), D, QSCALE}; GEMM_STD(pg8::EpiBf16, pg8::SetupOrder<0>, 2048, 1024, 256); }
                  { pg8::Gemm g{Wl + WL_XO, KV, nullptr}; pg8::SetupOrder<1> S; S.init(bx, 64, 64); pg8::EpiBf16 E{(bf16_t*)(ws + WS_NT), D, 1.f}; GEMM_STD(pg8::EpiBf16, pg8::SetupOrder<1>, 1024, 2048, 256); } }
                phase_pool(F, RB, RA);
            }
            SEAM(13);
            if (IN(14)) REP(14) { PH
                pg8::Gemm g{RA, WB + WB_WEFF, nullptr};
                pg8::StaticOrder S; S.init(T, D, F.G, bx, D, D);
                pg8::EpiBf16 E{RD, D, 1.f};
                GEMM_STD(pg8::EpiBf16, pg8::StaticOrder, D, D, D);
            }
            SEAM(14);
            if (IN(15)) REP(15) { PH phase_ln_add(F, RC, RD, INF(28), INF(29), RB); }
            SEAM(15);
        }
        if (IN(cbp + 5)) REP(cbp + 5) { PHC
            pg8::Gemm g{X1, (const bf16_t*)(ws + WS_MT), nullptr};
            pg8::BatchOrder S; S.init(T, D, F.G, bx, D, D);
            pg8::EpiSoftmax E{Qb, (LAS float*)(F.lds + 131072)};
            GEMM_STD(pg8::EpiSoftmax, pg8::BatchOrder, D, D, D);
        }
        SEAM(cbp + 5);
        if (IN(cbp + 6)) REP(cbp + 6) { PHC
            pg8::Gemm g{Qb, (const bf16_t*)(ws + WS_NT), nullptr};
            pg8::BatchOrder S; S.init(T, D, F.G, bx, D, D);
            pg8::EpiBf16 E{Y2, D, 1.f};
            GEMM_STD(pg8::EpiBf16, pg8::BatchOrder, D, D, D);
        }
        SEAM(cbp + 6);
        if (IN(cbp + 7)) REP(cbp + 7) { PHC phase_ln_router(F, X1, Y2, INF(cb + 5), INF(cb + 6), X2, INF(3), INF(4), WSI(WS_EIDX), WSF(WS_EWGT), WSI(WS_BCNT)); }
        SEAM(cbp + 7);
        if (IN(cbp + 8)) REP(cbp + 8) { PHC phase_moe_book(F, WSI(WS_EIDX), WSI(WS_BCNT), WSI(WS_TOK), WSI(WS_POS), WSI(WS_TILE)); }
        SEAM(cbp + 8);
        if (IN(cbp + 9)) REP(cbp + 9) { PHC const int* tile_e = WSI(WS_TILE); const int* tok = WSI(WS_TOK);
            const int ntiles = __builtin_amdgcn_readfirstlane(tile_e[NTILE]);
            pg8::Gemm g{X2, WBl + WL_GU, tok};
            pg8::MoeOrder S; S.init(ntiles, tile_e, F.G, bx, D, D);
            pg8::EpiGU E{HS};
            pg8::gemm_phase<pg8::EpiGU, pg8::MoeOrder, true, true, true, D, D, D>(glds, F.tid, g, S, E);
        }
        SEAM(cbp + 9);
        if (IN(cbp + 10)) REP(cbp + 10) { PHC const int* tile_e = WSI(WS_TILE);
            const int ntiles = __builtin_amdgcn_readfirstlane(tile_e[NTILE]);
            pg8::Gemm g{HS, WBl + WL_DN, nullptr};
            pg8::MoeOrder S; S.init(ntiles, tile_e, F.G, bx, DE, DE);
            pg8::EpiBf16 E{DS, D, 1.f};
            GEMM_STD(pg8::EpiBf16, pg8::MoeOrder, DE, DE, DE);
        }
        SEAM(cbp + 10);
        if (IN(cbp + 11)) REP(cbp + 11) { PHC phase_ln_moe(F, X2, DS, WSI(WS_POS), WSF(WS_EWGT), INF(cb + 10), INF(cb + 11), X3, L == 1 ? ka->out : nullptr); }
        SEAM(cbp + 11);
    }
#undef GEMM_STD
#undef IN
#undef SEAM
#undef INF
#undef PH
#undef PHC
#undef WSI
#undef WSF
}
}
using namespace nv;
extern "C" void kernel_launch(void* const* d_in, const int* in_sizes, int n_in, void* d_out, int out_size, void* d_ws, size_t ws_size, hipStream_t stream) {
    (void)in_sizes; (void)out_size;
    if (ws_size < WS_END || n_in != 40) return;
    static int grid = 0;
    if (grid == 0) {
        int dev = 0, cus = 0;
        if (hipGetDevice(&dev) != hipSuccess || hipDeviceGetAttribute(&cus, hipDeviceAttributeMultiprocessorCount, dev) != hipSuccess) { grid = -1; return; }
        if (hipFuncSetAttribute((const void*)mk::mega, hipFuncAttributeMaxDynamicSharedMemorySize, mk::LDS_BYTES) != hipSuccess) { grid = -1; return; }
        int per_cu = 0;
        if (hipOccupancyMaxActiveBlocksPerMultiprocessor(&per_cu, (const void*)mk::mega, mk::NTHREADS, mk::LDS_BYTES) != hipSuccess || per_cu < 1) { (void)hipGetLastError(); }
        grid = cus;
    }
    if (grid < 0) return;
    unsigned char* ws = (unsigned char*)d_ws;
    (void)hipMemsetAsync(ws + WS_CTL, 0, 512 * 1024, stream);
    mk::Args a{};
    for (int i = 0; i < 40; ++i) a.in[i] = d_in[i];
    a.out = (float*)d_out; a.ws = ws;
    for (int j = 0; j < 8; ++j) a.inv.f[j] = (float)pow(500000.0, -(double)((float)j * 2.0f / 16.0f));
    a.ph_lo = 0; a.ph_hi = mk::NPHASE;
    hipLaunchKernelGGL(mk::mega, dim3(grid), dim3(mk::NTHREADS), mk::LDS_BYTES, stream, a);
}
```

```cpp
#include <hip/hip_runtime.h>
#include <stdint.h>
#include <math.h>

typedef unsigned short bf16_t;

namespace nv {
constexpr int B = 4, S = 8192, T = B * S, D = 1024;
constexpr int NIN0 = 1792;
constexpr int MEM = 256, XH = 4, XHD = 256;
constexpr int NE = 16, DE = 512;
constexpr int MPAD = 65536 + 16 * 256;
constexpr int NTILE = MPAD / 256;
constexpr float ALPHA = 1.4142135623730951f;
constexpr float LN_EPS = 1e-5f;
constexpr float QSCALE = 0.0625f * 1.4426950408889634f;
constexpr float ASCALE = 0.125f * 1.4426950408889634f;

constexpr size_t MiB = 1u << 20;
constexpr size_t WS_CTL = 0;
constexpr size_t WS_ROPE = 2 * MiB;
constexpr size_t WS_EIDX = 4 * MiB;
constexpr size_t WS_EWGT = 5 * MiB;
constexpr size_t WS_POS = 6 * MiB;
constexpr size_t WS_BCNT = 7 * MiB;
constexpr size_t WS_TILE = 7 * MiB + 65536;
constexpr size_t WS_TOK = 7 * MiB + 131072;
constexpr size_t WS_MEMKV = 8 * MiB;
constexpr size_t WS_MEMB = 20 * MiB;
constexpr size_t WS_WB = 24 * MiB;
constexpr size_t WS_A = 152 * MiB, WS_B = 220 * MiB, WS_C = 288 * MiB, WS_D = 356 * MiB;
constexpr size_t WS_MT = 492 * MiB;
constexpr size_t WS_NT = 500 * MiB;
constexpr size_t WS_END = 508 * MiB;
constexpr size_t WB_IN0 = 0;
constexpr size_t WB_OUT0 = WB_IN0 + (size_t)1792 * 1024;
constexpr size_t WB_IN1 = WB_OUT0 + (size_t)1024 * 1024;
constexpr size_t WB_POOL = WB_IN1 + (size_t)1024 * 1024;
constexpr size_t WB_OUT1 = WB_POOL + (size_t)1024 * 256;
constexpr size_t WB_WEFF = WB_OUT1 + (size_t)1024 * 1024;
constexpr size_t WB_SGUW = WB_WEFF + (size_t)1024 * 1024;
constexpr size_t WB_LAYER = WB_SGUW + (size_t)8 * 128 * 128;
constexpr size_t WL_XQ = 0;
constexpr size_t WL_XKV = WL_XQ + (size_t)1024 * 1024;
constexpr size_t WL_XO = WL_XKV + (size_t)2048 * 1024;
constexpr size_t WL_GU = WL_XO + (size_t)1024 * 1024;
constexpr size_t WL_DN = WL_GU + (size_t)16 * 1024 * 1024;
constexpr size_t WL_SIZE = WL_DN + (size_t)16 * 1024 * 512;
static_assert((WB_LAYER + 2 * WL_SIZE) * 2 <= 128 * MiB, "bf16 weight region");

__device__ __forceinline__ float bf2f(bf16_t v) { return __uint_as_float((unsigned)v << 16); }
__device__ __forceinline__ bf16_t f2bf(float f) { unsigned u = __float_as_uint(f); return (bf16_t)((u + 0x7fffu + ((u >> 16) & 1u)) >> 16); }
__device__ __forceinline__ float gelu_tanh(float x) { const float u = 0.7978845608028654f * (x + 0.044715f * x * x * x); const float e = __expf(2.f * u); const float th = 1.f - 2.f / (e + 1.f); return 0.5f * x * (1.f + th); }
__device__ __forceinline__ float silu(float x) { return x / (1.f + __expf(-x)); }
template <int M> __device__ __forceinline__ float swz_xor(float v) { return __int_as_float(__builtin_amdgcn_ds_swizzle(__float_as_int(v), (M << 10) | 0x1f)); }
__device__ __forceinline__ float wave_sum(float v) {
    v += swz_xor<1>(v); v += swz_xor<2>(v); v += swz_xor<4>(v); v += swz_xor<8>(v); v += swz_xor<16>(v);
    const auto r = __builtin_amdgcn_permlane32_swap(__float_as_uint(v), __float_as_uint(v), false, false);
    return __uint_as_float(r[0]) + __uint_as_float(r[1]);
}
__device__ __forceinline__ float wave_max(float v) {
    v = fmaxf(v, swz_xor<1>(v)); v = fmaxf(v, swz_xor<2>(v)); v = fmaxf(v, swz_xor<4>(v)); v = fmaxf(v, swz_xor<8>(v)); v = fmaxf(v, swz_xor<16>(v));
    const auto r = __builtin_amdgcn_permlane32_swap(__float_as_uint(v), __float_as_uint(v), false, false);
    return fmaxf(__uint_as_float(r[0]), __uint_as_float(r[1]));
}
}

namespace pg8 {
#define PG8_LAS __attribute__((address_space(3)))
typedef short bf16x8 __attribute__((ext_vector_type(8)));
typedef float f32x4 __attribute__((ext_vector_type(4)));
typedef float f32x2 __attribute__((ext_vector_type(2)));
typedef unsigned u32x4 __attribute__((ext_vector_type(4)));
typedef unsigned u32x2 __attribute__((ext_vector_type(2)));
typedef int i32x8 __attribute__((ext_vector_type(8)));
constexpr int BM = 256, BK = 64, HALF = 128, HTB = HALF * BK * 2  , STAGE_BYTES = 8 * HTB, NXCD = 8, WGM = 8;

__host__ __device__ __forceinline__ int lds_byte(int r, int c) { const int st = (r >> 4) * 2 + (c >> 5), rr = r & 15, cc = c & 31, ob = rr * 64 + cc * 2; return st * 1024 + (ob ^ (((ob >> 9) & 1) << 5)); }
__host__ __device__ __forceinline__ void stage_rc(int b, int& R, int& C) { const int st = b / 1024, sb = b % 1024, swz = sb ^ (((sb >> 9) & 1) << 5); R = (st >> 1) * 16 + swz / 64; C = (st & 1) * 32 + (swz % 64) / 2; }
__host__ __device__ __forceinline__ int perm32(int rho) { const int n = rho >> 4, i = rho & 15; return 8 * (i >> 2) + 4 * n + (i & 3); }

struct Unit { int pm, pn, ao, bo; };
struct Gemm { const bf16_t* A; const bf16_t* Bt; const int* arow; };

template <bool BATCHED = false>
struct StaticOrderT {
    int nM, nN, nwg, G, c, lda, ldb, apn;
    __device__ void init(int M, int N, int G_, int c_, int lda_, int ldb_, int apn_ = 0) { nM = M / BM; nN = N / BM; nwg = nM * nN; G = G_; c = c_; lda = lda_; ldb = ldb_; apn = apn_; }
    __device__ bool next(int i, Unit& u) const {
        const long L = (long)i * G + c; if (L >= nwg) return false;
        int wgid = (int)L; { const int q = nwg / NXCD, r = nwg % NXCD, xcd = wgid % NXCD, off = wgid / NXCD; wgid = (xcd < r ? xcd * (q + 1) : r * (q + 1) + (xcd - r) * q) + off; }
        const int nig = WGM * nN, gid = wgid / nig, fm = gid * WGM, gsz = (nM - fm) < WGM ? (nM - fm) : WGM;
        u.pm = fm + ((wgid % nig) % gsz); u.pn = (wgid % nig) / gsz;
        u.ao = u.pm * BM * lda + u.pn * apn; u.bo = (BATCHED ? ((u.pm >> 5) * 4 + u.pn) : u.pn) * BM * ldb; return true;
    }
};
typedef StaticOrderT<false> StaticOrder;
typedef StaticOrderT<true> BatchOrder;
struct MoeOrder {
    int nM, nwg, G, c, lda, ldb; const int* tile_e;
    __device__ void init(int ntiles, const int* te, int G_, int c_, int lda_, int ldb_) { nM = ntiles; nwg = nM * 4; G = G_; c = c_; tile_e = te; lda = lda_; ldb = ldb_; }
    __device__ bool next(int i, Unit& u) const {
        const long L = (long)i * G + c; if (L >= nwg) return false;
        int wgid = (int)L; { const int q = nwg / NXCD, r = nwg % NXCD, xcd = wgid % NXCD, off = wgid / NXCD; wgid = (xcd < r ? xcd * (q + 1) : r * (q + 1) + (xcd - r) * q) + off; }
        const int nig = WGM * 4, gid = wgid / nig, fm = gid * WGM, gsz = (nM - fm) < WGM ? (nM - fm) : WGM;
        u.pm = fm + ((wgid % nig) % gsz); u.pn = (wgid % nig) / gsz;
        const int e = __builtin_amdgcn_readfirstlane(tile_e[u.pm]); u.ao = u.pm * BM * lda; u.bo = (e * 4 + u.pn) * BM * ldb; return true;
    }
};
template <int KIND>
struct SetupOrder {
    int idx, n;
    __device__ void init(int c, int c0, int n_) { idx = c - c0; n = n_; }
    __device__ bool next(int i, Unit& u) const {
        if (i != 0 || idx < 0 || idx >= n) return false;
        const int x = idx >> 4, y = (idx >> 2) & 3, z = idx & 3;
        if (KIND == 0) { u.pm = x * 4 + y; u.pn = z; u.ao = (x * 256) * 2048 + y * 256; u.bo = z * 256 * 1024 + y * 256; }
        if (KIND == 1) { u.pm = x * 4 + y; u.pn = z; u.ao = y * 256 * 1024 + z * 256; u.bo = (x * 256) * 2048 + 1024 + z * 256; }
        if (KIND == 2) { u.pm = y; u.pn = z; u.ao = y * 256 * 1024 + z * 256; u.bo = z * 256 * 256; }
        return true;
    }
};

__device__ __forceinline__ int fresh_lane() { unsigned m = ~0u; asm volatile("" : "+s"(m)); return (int)__builtin_amdgcn_mbcnt_hi(m, __builtin_amdgcn_mbcnt_lo(m, 0u)); }
__device__ __forceinline__ unsigned cvt_pk_bf16(float lo, float hi) { unsigned r; asm volatile("v_cvt_pk_bf16_f32 %0, %1, %2" : "=v"(r) : "v"(lo), "v"(hi)); return r; }


template <class Epi, class Sched, bool ALIGN_EPI, bool SP2, bool GATHER, int LDA, int LDB, int KK, bool FP8 = false>
__device__ __forceinline__ void gemm_phase(PG8_LAS unsigned char* lds, int tid_in, const Gemm g, const Sched& S, const Epi& E) {
    int tid_ = tid_in; asm volatile("" : "+v"(tid_));
    const int tid = tid_, wid = __builtin_amdgcn_readfirstlane(tid >> 6), lane = tid & 63, wr = wid >> 2, wc = wid & 3, fr = lane & 15, fq = lane >> 4;
    constexpr int ELT = FP8 ? 1 : 2, K = KK, nt = K * ELT / (BK * 2), lda = LDA * ELT, ldb = LDB * ELT; (void)K;
    unsigned voffA[2], voffB[2];
#pragma unroll
    for (int i = 0; i < 2; ++i) { int R, C; stage_rc(tid * 16 + i * 8192, R, C); const int Rb = Epi::PERM ? ((R & ~31) + perm32(R & 31)) : R;
        voffA[i] = GATHER ? (unsigned)C * 2u : (unsigned)(R * lda + C * 2); voffB[i] = (unsigned)(Rb * ldb + C * 2); }
    const size_t kstep = (size_t)(BK * 2);
    const size_t hstepA = GATHER ? 0 : (size_t)HALF * lda, hstepB = (size_t)HALF * ldb;
    const unsigned ldsw = (unsigned)wid * 1024u, ldsbase = (unsigned)(size_t)lds;
    const int aoff = lds_byte(wr * 64 + fr, fq * 8), boff = lds_byte(wc * 32 + fr, fq * 8);
    unsigned cg[2][2];
#define PG8_SA(b, h) (((b) * 2 + (h)) * HTB)
#define PG8_SB(b, h) ((4 + (b) * 2 + (h)) * HTB)
#define PG8_GLDS(sbase, voff32, ldsaddr) asm volatile("s_mov_b32 m0, %2\n\ts_nop 0\n\tglobal_load_lds_dwordx4 %0, %1" :: "v"(voff32), "s"(sbase), "s"(ldsaddr) : "memory", "m0")
#define PG8_STAGE(bufoff, gbase, voff) do { const char* _sb = (const char*)(gbase); _Pragma("unroll") for (int _i = 0; _i < 2; ++_i) \
        PG8_GLDS(_sb, (voff)[_i], (unsigned)(ldsbase + (bufoff) + ldsw + _i * 8192)); } while (0)
#define PG8_STAGE_A(bufoff, abase, h, GO) do { const char* _sb = GATHER ? (const char*)(abase) : (const char*)(abase) + ((h) ? hstepA : (size_t)0); _Pragma("unroll") for (int _i = 0; _i < 2; ++_i) \
        PG8_GLDS(_sb, (GATHER ? GO[h][_i] : voffA[_i]), (unsigned)(ldsbase + (bufoff) + ldsw + _i * 8192)); } while (0)
#define PG8_GLOAD(dst, pm_) do { const int _t = wid * 64 + fresh_lane(); int rowA_[2]; unsigned colA_[2]; _Pragma("unroll") for (int _i = 0; _i < 2; ++_i) { int _R, _C; stage_rc(_t * 16 + _i * 8192, _R, _C); rowA_[_i] = _R; colA_[_i] = (unsigned)_C * 2u; }   \
        _Pragma("unroll") for (int _h = 0; _h < 2; ++_h) _Pragma("unroll") for (int _i = 0; _i < 2; ++_i) \
        dst[_h][_i] = (unsigned)g.arow[(pm_) * BM + _h * HALF + rowA_[_i]] * (unsigned)lda + colA_[_i]; } while (0)
#define PG8_GSWITCH do { if constexpr (GATHER) { if (last && has_next) { PG8_GLOAD(cg, nxt.pm); } } } while (0)
#define PG8_LDA(dst, b, h) do { _Pragma("unroll") for (int m = 0; m < 4; ++m) { if constexpr (FP8) { typedef int i32x4_ __attribute__((ext_vector_type(4))); \
        dst##8[m] = __builtin_shufflevector(*(const PG8_LAS i32x4_*)(lds + PG8_SA(b, h) + aoff + m * 2048), *(const PG8_LAS i32x4_*)(lds + PG8_SA(b, h) + aoff + m * 2048 + 1024), 0, 1, 2, 3, 4, 5, 6, 7); } \
        else { _Pragma("unroll") for (int k = 0; k < 2; ++k) dst[m][k] = *(const PG8_LAS bf16x8*)(lds + PG8_SA(b, h) + aoff + m * 2048 + k * 1024); } } } while (0)
#define PG8_LDB(dst, b, h) do { _Pragma("unroll") for (int n = 0; n < 2; ++n) { if constexpr (FP8) { typedef int i32x4_ __attribute__((ext_vector_type(4))); \
        dst##8[n] = __builtin_shufflevector(*(const PG8_LAS i32x4_*)(lds + PG8_SB(b, h) + boff + n * 2048), *(const PG8_LAS i32x4_*)(lds + PG8_SB(b, h) + boff + n * 2048 + 1024), 0, 1, 2, 3, 4, 5, 6, 7); } \
        else { _Pragma("unroll") for (int k = 0; k < 2; ++k) dst[n][k] = *(const PG8_LAS bf16x8*)(lds + PG8_SB(b, h) + boff + n * 2048 + k * 1024); } } } while (0)
#define PG8_MMA(ai, bj, At, Bt) do { __builtin_amdgcn_s_setprio(1); _Pragma("unroll") for (int m = 0; m < 4; ++m) _Pragma("unroll") for (int n = 0; n < 2; ++n) { \
        if constexpr (FP8) acc[ai][bj][m][n] = __builtin_amdgcn_mfma_scale_f32_16x16x128_f8f6f4(Bt##8[n], At##8[m], acc[ai][bj][m][n], 0, 0, 0, 0x7f7f7f7f, 0, 0x7f7f7f7f); \
        else { _Pragma("unroll") for (int k = 0; k < 2; ++k) acc[ai][bj][m][n] = __builtin_amdgcn_mfma_f32_16x16x32_bf16(Bt[n][k], At[m][k], acc[ai][bj][m][n], 0, 0, 0); } } \
        __builtin_amdgcn_s_setprio(0); } while (0)
#define PG8_WAIT_V(n) asm volatile("s_waitcnt vmcnt(" #n ")" ::: "memory")
#define PG8_WAIT_L(n) asm volatile("s_waitcnt lgkmcnt(" #n ")" ::: "memory")
#define PG8_BAR __builtin_amdgcn_s_barrier()
#define PG8_SCHED __builtin_amdgcn_sched_barrier(0)
    Unit cur, nxt; int ui = 0;
    if (!S.next(0, cur)) return;
    f32x4 acc[2][2][4][2];
#pragma unroll
    for (int a = 0; a < 2; ++a)
#pragma unroll
        for (int b = 0; b < 2; ++b)
#pragma unroll
            for (int m = 0; m < 4; ++m)
#pragma unroll
                for (int n = 0; n < 2; ++n) acc[a][b][m][n] = (f32x4){0.f, 0.f, 0.f, 0.f};
    bf16x8 At[4][2], B0[2][2], B1[2][2]; i32x8 At8[4], B08[2], B18[2];
    const char* cA = GATHER ? (const char*)g.A : (const char*)g.A + (size_t)cur.ao * ELT; const char* cB = (const char*)g.Bt + (size_t)cur.bo * ELT;
    if constexpr (GATHER) { PG8_GLOAD(cg, cur.pm); }
    if constexpr (SP2) {
        PG8_STAGE(PG8_SB(0, 0), cB, voffB); PG8_STAGE(PG8_SB(0, 1), cB + hstepB, voffB); PG8_STAGE_A(PG8_SA(0, 0), cA, 0, cg); PG8_STAGE_A(PG8_SA(0, 1), cA, 1, cg);
        if (wr == 1) PG8_BAR;
        PG8_WAIT_V(2); PG8_BAR;
        PG8_STAGE(PG8_SB(1, 0), cB + kstep, voffB); PG8_STAGE_A(PG8_SA(1, 0), cA + kstep, 0, cg); PG8_STAGE(PG8_SB(1, 1), cB + hstepB + kstep, voffB);
        PG8_WAIT_V(6); PG8_BAR;
    } else {
        PG8_STAGE(PG8_SB(0, 0), cB, voffB); PG8_STAGE_A(PG8_SA(0, 0), cA, 0, cg); PG8_STAGE(PG8_SB(0, 1), cB + hstepB, voffB); PG8_STAGE_A(PG8_SA(0, 1), cA, 1, cg);
        if (wr == 1) PG8_BAR;
        PG8_WAIT_V(4); PG8_BAR;
        PG8_STAGE(PG8_SB(1, 0), cB + kstep, voffB); PG8_STAGE_A(PG8_SA(1, 0), cA + kstep, 0, cg); PG8_STAGE(PG8_SB(1, 1), cB + hstepB + kstep, voffB);
        PG8_WAIT_V(6); PG8_BAR;
    }
    for (;;) {
        const bool has_next = S.next(ui + 1, nxt);
        const char* nA = GATHER ? (const char*)g.A : (has_next ? (const char*)g.A + (size_t)nxt.ao * ELT : cA);
        const char* nB = has_next ? (const char*)g.Bt + (size_t)nxt.bo * ELT : cB;
#pragma unroll 1
        for (int t = 0; t < nt; t += 2) {
            const bool last = (t == nt - 2);
            const char* a1 = cA + (size_t)(t + 1) * kstep;
            const char* a2 = last ? nA : cA + (size_t)(t + 2) * kstep; const char* b2 = last ? nB : cB + (size_t)(t + 2) * kstep;
            const char* a3 = a2 + kstep; const char* b3 = b2 + kstep;
            if constexpr (SP2) {
            PG8_LDB(B0, 0, 0); PG8_LDB(B1, 0, 1); PG8_SCHED; PG8_LDA(At, 0, 0); PG8_STAGE_A(PG8_SA(1, 1), a1, 1, cg); PG8_GSWITCH;
            PG8_WAIT_V(8); PG8_WAIT_L(0); PG8_BAR; PG8_MMA(0, 0, At, B0); PG8_MMA(0, 1, At, B1); PG8_BAR; PG8_SCHED;
            PG8_LDA(At, 0, 1); PG8_STAGE(PG8_SB(0, 0), b2, voffB); PG8_STAGE(PG8_SB(0, 1), b2 + hstepB, voffB); PG8_STAGE_A(PG8_SA(0, 0), a2, 0, cg);
            PG8_WAIT_V(8); PG8_WAIT_L(0); PG8_BAR; PG8_MMA(1, 0, At, B0); PG8_MMA(1, 1, At, B1); PG8_BAR; PG8_SCHED;
            PG8_LDB(B0, 1, 0); PG8_LDB(B1, 1, 1); PG8_SCHED; PG8_LDA(At, 1, 0); PG8_STAGE_A(PG8_SA(0, 1), a2, 1, cg);
            PG8_WAIT_V(8); PG8_WAIT_L(0); PG8_BAR; PG8_MMA(0, 0, At, B0); PG8_MMA(0, 1, At, B1); PG8_BAR; PG8_SCHED;
            PG8_LDA(At, 1, 1); PG8_STAGE(PG8_SB(1, 0), b3, voffB); PG8_STAGE(PG8_SB(1, 1), b3 + hstepB, voffB); PG8_STAGE_A(PG8_SA(1, 0), a3, 0, cg);
            PG8_WAIT_V(8); PG8_WAIT_L(0); PG8_BAR; PG8_MMA(1, 0, At, B0); PG8_MMA(1, 1, At, B1); PG8_BAR; PG8_SCHED;
            } else {
            PG8_LDB(B0, 0, 0); PG8_SCHED; PG8_LDA(At, 0, 0); PG8_STAGE_A(PG8_SA(1, 1), a1, 1, cg); PG8_GSWITCH;
            PG8_WAIT_L(8); PG8_BAR; PG8_WAIT_L(0); PG8_MMA(0, 0, At, B0); PG8_BAR; PG8_SCHED;
            PG8_LDB(B1, 0, 1); PG8_STAGE(PG8_SB(0, 0), b2, voffB);
            PG8_BAR; PG8_WAIT_L(0); PG8_MMA(0, 1, At, B1); PG8_BAR;
            PG8_LDA(At, 0, 1); PG8_STAGE_A(PG8_SA(0, 0), a2, 0, cg);
            PG8_BAR; PG8_WAIT_L(0); PG8_MMA(1, 0, At, B0); PG8_BAR; PG8_SCHED;
            PG8_STAGE(PG8_SB(0, 1), b2 + hstepB, voffB);
            PG8_WAIT_V(6); PG8_BAR; PG8_MMA(1, 1, At, B1); PG8_BAR;
            PG8_LDB(B0, 1, 0); PG8_SCHED; PG8_LDA(At, 1, 0); PG8_STAGE_A(PG8_SA(0, 1), a2, 1, cg);
            PG8_WAIT_L(8); PG8_BAR; PG8_WAIT_L(0); PG8_MMA(0, 0, At, B0); PG8_BAR; PG8_SCHED;
            PG8_LDB(B1, 1, 1); PG8_STAGE(PG8_SB(1, 0), b3, voffB);
            PG8_BAR; PG8_WAIT_L(0); PG8_MMA(0, 1, At, B1); PG8_BAR;
            PG8_LDA(At, 1, 1); PG8_STAGE_A(PG8_SA(1, 0), a3, 0, cg);
            PG8_BAR; PG8_WAIT_L(0); PG8_MMA(1, 0, At, B0); PG8_BAR; PG8_SCHED;
            PG8_STAGE(PG8_SB(1, 1), b3 + hstepB, voffB);
            PG8_WAIT_V(6); PG8_BAR; PG8_MMA(1, 1, At, B1); PG8_BAR;
            }
        }
        if constexpr (ALIGN_EPI) { if (wr == 0) PG8_BAR; }
        { const int _l = fresh_lane(); E(acc, cur, wr, wc, _l & 15, _l >> 4); }
        if (!has_next) break;
#pragma unroll
        for (int a = 0; a < 2; ++a)
#pragma unroll
            for (int b = 0; b < 2; ++b)
#pragma unroll
                for (int m = 0; m < 4; ++m)
#pragma unroll
                    for (int n = 0; n < 2; ++n) acc[a][b][m][n] = (f32x4){0.f, 0.f, 0.f, 0.f};
        cur = nxt; cA = nA; cB = nB; ++ui;
        if constexpr (ALIGN_EPI) { if (wr == 1) PG8_BAR; }
    }
    PG8_WAIT_V(0);
    if constexpr (!ALIGN_EPI) { if (wr == 0) PG8_BAR; }
    PG8_BAR;
#undef PG8_SA
#undef PG8_SB
#undef PG8_STAGE
#undef PG8_GLDS
#undef PG8_STAGE_A
#undef PG8_GLOAD
#undef PG8_GSWITCH
#undef PG8_LDA
#undef PG8_LDB
#undef PG8_MMA
#undef PG8_WAIT_V
#undef PG8_WAIT_L
#undef PG8_BAR
#undef PG8_SCHED
}
}
namespace pg8 {

__device__ __forceinline__ float fast_sigmoid_mul(float x, float z) { return x * __builtin_amdgcn_rcpf(1.f + __builtin_amdgcn_exp2f(-1.4426950408889634f * z)); }
__device__ __forceinline__ float gelu_t(float x) { const float u = 0.7978845608028654f * (x + 0.044715f * x * x * x); return fast_sigmoid_mul(x, 2.f * u); }
__device__ __forceinline__ float silu_f(float x) { return fast_sigmoid_mul(x, x); }
__device__ __forceinline__ u32x4 pack8(const f32x4 v0, const f32x4 v1) { u32x4 w; w.x = cvt_pk_bf16(v0[0], v0[1]); w.y = cvt_pk_bf16(v0[2], v0[3]); w.z = cvt_pk_bf16(v1[0], v1[1]); w.w = cvt_pk_bf16(v1[2], v1[3]); return w; }

struct EpiBf16 {
    static constexpr bool PERM = true;
    bf16_t* O; int ldo; float scale;
    __device__ __forceinline__ void operator()(f32x4 (&acc)[2][2][4][2], const Unit& u, int wr, int wc, int fr, int fq) const {
        const int row0 = u.pm * BM + wr * 64 + fr, col0 = u.pn * BM + wc * 32 + 8 * fq;
#pragma unroll
        for (int ai = 0; ai < 2; ++ai)
#pragma unroll
            for (int m = 0; m < 4; ++m) { bf16_t* rowp = O + (size_t)(row0 + ai * HALF + m * 16) * ldo + col0;
#pragma unroll
                for (int bj = 0; bj < 2; ++bj) *(u32x4*)(rowp + bj * HALF) = pack8(acc[ai][bj][m][0] * scale, acc[ai][bj][m][1] * scale); }
    }
};
__device__ __forceinline__ unsigned pk4_fp8(float a, float b, float c, float d) {
    a = __builtin_amdgcn_fmed3f(a, -448.f, 448.f); b = __builtin_amdgcn_fmed3f(b, -448.f, 448.f); c = __builtin_amdgcn_fmed3f(c, -448.f, 448.f); d = __builtin_amdgcn_fmed3f(d, -448.f, 448.f);
    unsigned p = 0u; p = (unsigned)__builtin_amdgcn_cvt_pk_fp8_f32(a, b, (int)p, false); p = (unsigned)__builtin_amdgcn_cvt_pk_fp8_f32(c, d, (int)p, true); return p;
}
constexpr float F8_XS = 16.f, F8_WS = 64.f, F8_HS = 8.f;
struct EpiGU8 {
    static constexpr bool PERM = true;
    unsigned char* HS8;
    __device__ __forceinline__ void operator()(f32x4 (&acc)[2][2][4][2], const Unit& u, int wr, int wc, int fr, int fq) const {
        const int row0 = u.pm * BM + wr * 64 + fr, col0 = u.pn * HALF + wc * 32 + 8 * fq;
        constexpr float s = 1.f / (F8_XS * F8_WS);
#pragma unroll
        for (int ai = 0; ai < 2; ++ai)
#pragma unroll
            for (int m = 0; m < 4; ++m) { unsigned char* rowp = HS8 + (size_t)(row0 + ai * HALF + m * 16) * nv::DE + col0;
                f32x4 h0, h1;
#pragma unroll
                for (int j = 0; j < 4; ++j) { h0[j] = silu_f(acc[ai][0][m][0][j] * s) * (acc[ai][1][m][0][j] * (s * F8_HS)); h1[j] = silu_f(acc[ai][0][m][1][j] * s) * (acc[ai][1][m][1][j] * (s * F8_HS)); }
                u32x2 w; w.x = pk4_fp8(h0[0], h0[1], h0[2], h0[3]); w.y = pk4_fp8(h1[0], h1[1], h1[2], h1[3]); *(u32x2*)rowp = w; }
    }
};
struct EpiGU {
    static constexpr bool PERM = true;
    bf16_t* HS;
    __device__ __forceinline__ void operator()(f32x4 (&acc)[2][2][4][2], const Unit& u, int wr, int wc, int fr, int fq) const {
        const int row0 = u.pm * BM + wr * 64 + fr, col0 = u.pn * HALF + wc * 32 + 8 * fq;
#pragma unroll
        for (int ai = 0; ai < 2; ++ai)
#pragma unroll
            for (int m = 0; m < 4; ++m) { bf16_t* rowp = HS + (size_t)(row0 + ai * HALF + m * 16) * nv::DE + col0;
                f32x4 h0, h1;
#pragma unroll
                for (int j = 0; j < 4; ++j) { h0[j] = silu_f(acc[ai][0][m][0][j]) * acc[ai][1][m][0][j]; h1[j] = silu_f(acc[ai][0][m][1][j]) * acc[ai][1][m][1][j]; }
                *(u32x4*)rowp = pack8(h0, h1); }
    }
};
struct EpiSoftmax {
    static constexpr bool PERM = true;
    bf16_t* O; PG8_LAS float* tbl;
    __device__ __forceinline__ void operator()(f32x4 (&acc)[2][2][4][2], const Unit& u, int wr, int wc, int fr, int fq) const {
        const int row0 = u.pm * BM + wr * 64 + fr, col0 = u.pn * BM + wc * 32 + 8 * fq;
#pragma unroll
        for (int ai = 0; ai < 2; ++ai)
#pragma unroll
            for (int m = 0; m < 4; ++m) { float mx = -INFINITY;
#pragma unroll
                for (int bj = 0; bj < 2; ++bj)
#pragma unroll
                    for (int n = 0; n < 2; ++n)
#pragma unroll
                        for (int j = 0; j < 4; ++j) mx = fmaxf(mx, acc[ai][bj][m][n][j]);
                mx = fmaxf(mx, nv::swz_xor<16>(mx));
                { const auto r = __builtin_amdgcn_permlane32_swap(__float_as_uint(mx), __float_as_uint(mx), false, false); mx = fmaxf(__uint_as_float(r[0]), __uint_as_float(r[1])); }
                if (fq == 0) tbl[(ai * HALF + wr * 64 + m * 16 + fr) * 4 + wc] = mx; }
        asm volatile("s_waitcnt lgkmcnt(0)" ::: "memory"); __builtin_amdgcn_s_barrier(); asm volatile("" ::: "memory");
#pragma unroll
        for (int ai = 0; ai < 2; ++ai)
#pragma unroll
            for (int m = 0; m < 4; ++m) { const f32x4 t4 = *(const PG8_LAS f32x4*)(tbl + (ai * HALF + wr * 64 + m * 16 + fr) * 4);
                const float M = fmaxf(fmaxf(t4[0], t4[1]), fmaxf(t4[2], t4[3])); float s = 0.f;
#pragma unroll
                for (int bj = 0; bj < 2; ++bj)
#pragma unroll
                    for (int n = 0; n < 2; ++n)
#pragma unroll
                        for (int j = 0; j < 4; ++j) { const float p = __builtin_amdgcn_exp2f(acc[ai][bj][m][n][j] - M); acc[ai][bj][m][n][j] = p; s += p; }
                s += nv::swz_xor<16>(s);
                { const auto r = __builtin_amdgcn_permlane32_swap(__float_as_uint(s), __float_as_uint(s), false, false); s = __uint_as_float(r[0]) + __uint_as_float(r[1]); }
                if (fq == 0) tbl[1024 + (ai * HALF + wr * 64 + m * 16 + fr) * 4 + wc] = s; }
        asm volatile("s_waitcnt lgkmcnt(0)" ::: "memory"); __builtin_amdgcn_s_barrier(); asm volatile("" ::: "memory");
#pragma unroll
        for (int ai = 0; ai < 2; ++ai)
#pragma unroll
            for (int m = 0; m < 4; ++m) { const f32x4 t4 = *(const PG8_LAS f32x4*)(tbl + 1024 + (ai * HALF + wr * 64 + m * 16 + fr) * 4);
                const float inv = 1.f / ((t4[0] + t4[1]) + (t4[2] + t4[3]));
                bf16_t* rowp = O + (size_t)(row0 + ai * HALF + m * 16) * nv::D + col0;
#pragma unroll
                for (int bj = 0; bj < 2; ++bj) *(u32x4*)(rowp + bj * HALF) = pack8(acc[ai][bj][m][0] * inv, acc[ai][bj][m][1] * inv); }
    }
};
struct EpiInproj0 {
    static constexpr bool PERM = true;
    bf16_t* O; const float* rope;
    __device__ __forceinline__ void operator()(f32x4 (&acc)[2][2][4][2], const Unit& u, int wr, int wc, int fr, int fq) const {
        const int row0 = u.pm * BM + wr * 64 + fr, col0 = u.pn * BM + wc * 32 + 8 * fq;
        if (u.pn >= 3) {
#pragma unroll
            for (int ai = 0; ai < 2; ++ai)
#pragma unroll
                for (int m = 0; m < 4; ++m) { bf16_t* rowp = O + (size_t)(row0 + ai * HALF + m * 16) * nv::NIN0 + col0;
#pragma unroll
                    for (int bj = 0; bj < 2; ++bj) { f32x4 v0 = acc[ai][bj][m][0], v1 = acc[ai][bj][m][1];
#pragma unroll
                        for (int j = 0; j < 4; ++j) { v0[j] = gelu_t(v0[j]); v1[j] = gelu_t(v1[j]); }
                        *(u32x4*)(rowp + bj * HALF) = pack8(v0, v1); } }
        } else {
            const bool wave_rope = (wc & 1) == 0;
            const float sgn = fq == 0 ? -1.f : 1.f;
#pragma unroll
            for (int ai = 0; ai < 2; ++ai)
#pragma unroll
                for (int m = 0; m < 4; ++m) { const int row = row0 + ai * HALF + m * 16; bf16_t* rowp = O + (size_t)row * nv::NIN0 + col0;
                    f32x4 c0, c1, s0, s1;
                    if (wave_rope) { const float* rp = rope + (size_t)row * 16; c0 = *(const f32x4*)rp; c1 = *(const f32x4*)(rp + 4); s0 = *(const f32x4*)(rp + 8); s1 = *(const f32x4*)(rp + 12); }
#pragma unroll
                    for (int bj = 0; bj < 2; ++bj) { f32x4 v0 = acc[ai][bj][m][0], v1 = acc[ai][bj][m][1];
                        if (wave_rope && (u.pn < 2 || bj == 0)) {
                            f32x4 p0, p1;
#pragma unroll
                            for (int j = 0; j < 4; ++j) { p0[j] = nv::swz_xor<16>(v0[j]); p1[j] = nv::swz_xor<16>(v1[j]); }
                            if (fq < 2) {
#pragma unroll
                                for (int j = 0; j < 4; ++j) { v0[j] = v0[j] * c0[j] + sgn * p0[j] * s0[j]; v1[j] = v1[j] * c1[j] + sgn * p1[j] * s1[j]; } }
                        }
                        *(u32x4*)(rowp + bj * HALF) = pack8(v0, v1); } }
        }
    }
};
}

#define LAS __attribute__((address_space(3)))
#define GAS __attribute__((address_space(1)))
typedef GAS unsigned gu32;
#define RLX_AGENT __ATOMIC_RELAXED, __HIP_MEMORY_SCOPE_AGENT
#define LDS_WAIT() asm volatile("s_waitcnt lgkmcnt(0)" ::: "memory")
#define VM_WAIT() asm volatile("s_waitcnt vmcnt(0)" ::: "memory")

#define XB_TMO      128
#define XB_XCNT(j)  (256  + 64 * (j))
#define XB_XSUB(j)  (1280 + 64 * (j))
#define XB_XGEN(j)  (2304 + 64 * (j))
#define XB_TOP      3328
#define XB_TOPGEN   3392
#define XCD_BAR_WORDS 3456
#define XB_SPIN_CAP (1u << 18)
__device__ __forceinline__ unsigned xb_ld(unsigned* p)              { return __hip_atomic_load(p, __ATOMIC_RELAXED, __HIP_MEMORY_SCOPE_AGENT); }
__device__ __forceinline__ unsigned xb_add(unsigned* p, unsigned v) { return __hip_atomic_fetch_add(p, v, __ATOMIC_RELAXED, __HIP_MEMORY_SCOPE_AGENT); }
__device__ __forceinline__ unsigned xb_xcc_id() { return (unsigned)__builtin_amdgcn_s_getreg((3 << 11) | 20) & 0xFu; }
#define XB_SPIN(cond, bar) do { unsigned _sp = 0; while (cond) { __builtin_amdgcn_s_sleep(1); \
    if ((++_sp & 255u) == 0u) { if (xb_ld(&(bar)[XB_TMO])) break; if (_sp > XB_SPIN_CAP) { atomicAdd(&(bar)[XB_TMO], 1u); break; } } } } while (0)
struct XcdBarrier { unsigned* bar; unsigned x; volatile LAS unsigned* st; int wave; };
__device__ __forceinline__ unsigned lane_id_fresh() { unsigned m = ~0u; asm volatile("" : "+s"(m)); return __builtin_amdgcn_mbcnt_hi(m, __builtin_amdgcn_mbcnt_lo(m, 0u)); }
__device__ __forceinline__ bool xb_thread0(int wave) { return wave == 0 && lane_id_fresh() == 0u; }
__device__ __forceinline__ XcdBarrier xcd_barrier_post(unsigned* bar, volatile LAS unsigned* st, int wave) {
    XcdBarrier b; b.bar = bar; b.x = xb_xcc_id(); b.st = st; b.wave = wave;
    if (xb_thread0(wave)) (void)xb_add(&bar[XB_XCNT(b.x)], 1u);
    return b;
}
__device__ __forceinline__ void xcd_barrier_complete(unsigned* bar, unsigned x, unsigned& nloc, unsigned& nx) {
    const unsigned G = gridDim.x * gridDim.y * gridDim.z;
    unsigned sum, cnt, mine, sp = 0u;
    for (;;) {
        sum = 0u; cnt = 0u; mine = 0u;
#pragma unroll
        for (unsigned j = 0; j < 16; ++j) { const unsigned c = xb_ld(&bar[XB_XCNT(j)]); sum += c; cnt += (c > 0u) ? 1u : 0u; mine = (j == x) ? c : mine; }
        if (sum == G) break;
        __builtin_amdgcn_s_sleep(1);
        if ((++sp & 255u) == 0u) { if (xb_ld(&bar[XB_TMO])) break; if (sp > XB_SPIN_CAP) { atomicAdd(&bar[XB_TMO], 1u); break; } }
    }
    nloc = mine > 0u ? mine : 1u; nx = cnt > 0u ? cnt : 1u;
}
__device__ __forceinline__ void xcd_barrier(const XcdBarrier& b) {
    asm volatile("s_waitcnt vmcnt(0)" ::: "memory");
    __syncthreads();
    if (xb_thread0(b.wave)) {
        unsigned* bar = b.bar;
        __builtin_amdgcn_s_waitcnt(0);
        unsigned nloc = b.st[0], nx = b.st[1];
        if (nloc == 0u) { xcd_barrier_complete(bar, b.x, nloc, nx); b.st[0] = nloc; b.st[1] = nx; }
        const unsigned old = xb_add(&bar[XB_XSUB(b.x)], 1u);
        const unsigned gen = old / nloc;
        if (old + 1u == (gen + 1u) * nloc) {
            __builtin_amdgcn_fence(__ATOMIC_RELEASE, "agent");
            asm volatile("s_waitcnt vmcnt(0)" ::: "memory");
            const unsigned og = xb_add(&bar[XB_TOP], 1u);
            const unsigned tg = og / nx;
            if (og + 1u == (tg + 1u) * nx) xb_add(&bar[XB_TOPGEN], 1u);
            else XB_SPIN(xb_ld(&bar[XB_TOPGEN]) == tg, bar);
            __builtin_amdgcn_fence(__ATOMIC_ACQUIRE, "agent");
            xb_add(&bar[XB_XGEN(b.x)], 1u);
            asm volatile("s_waitcnt vmcnt(0)" ::: "memory");
        } else {
            XB_SPIN(xb_ld(&bar[XB_XGEN(b.x)]) == gen, bar);
            __builtin_amdgcn_fence(__ATOMIC_ACQUIRE, "agent");
            asm volatile("s_waitcnt vmcnt(0)" ::: "memory");
        }
    }
    __syncthreads();
}

namespace mk {
using namespace nv;
typedef unsigned v4u __attribute__((ext_vector_type(4)));
typedef unsigned v2u __attribute__((ext_vector_type(2)));
typedef float f32x4 __attribute__((ext_vector_type(4)));
constexpr int NWAVES = 8, NTHREADS = 512;
constexpr int LDS_BYTES = 160 * 1024;
constexpr int MISC_OFF = LDS_BYTES - 256;
constexpr int CW_BAR = 4096;
constexpr size_t CTL_ZERO_BYTES = 64 * 1024;

__device__ __forceinline__ unsigned pk2(float lo, float hi) { return (unsigned)f2bf(lo) | ((unsigned)f2bf(hi) << 16); }

struct Frame {
    LAS unsigned char* lds; int tid, lane, wave, vcu, G, bx;
};

template <bool F8>
__device__ __forceinline__ void transpose_item(const float* W, int ldw, void* WT, int ldt, int k0, int n0, int dest_row0, LAS float* scr, int lane, float wscale) {
#pragma unroll 8
    for (int i = 0; i < 32; ++i) { const int kk = 2 * i + (lane >> 5); scr[kk * 33 + (lane & 31)] = W[(size_t)(k0 + kk) * ldw + n0 + (lane & 31)] * wscale; }
    LDS_WAIT(); asm volatile("" ::: "memory");
    const int c = lane & 7;
#pragma unroll
    for (int j = 0; j < 4; ++j) { const int n = (lane >> 3) + 8 * j; const LAS float* s = scr + (8 * c) * 33 + n;
        if constexpr (F8) { v2u o; o.x = pg8::pk4_fp8(s[0 * 33], s[1 * 33], s[2 * 33], s[3 * 33]); o.y = pg8::pk4_fp8(s[4 * 33], s[5 * 33], s[6 * 33], s[7 * 33]);
            *(v2u*)((unsigned char*)WT + (size_t)(dest_row0 + n) * ldt + k0 + 8 * c) = o; }
        else { v4u o; o.x = pk2(s[0 * 33], s[1 * 33]); o.y = pk2(s[2 * 33], s[3 * 33]); o.z = pk2(s[4 * 33], s[5 * 33]); o.w = pk2(s[6 * 33], s[7 * 33]);
            *(v4u*)((bf16_t*)WT + (size_t)(dest_row0 + n) * ldt + k0 + 8 * c) = o; } }
    LDS_WAIT(); asm volatile("" ::: "memory");
}
template <int MAP, bool F8>
__device__ __forceinline__ void transpose_job_item(const float* src, int K, int N, void* dst, size_t dstb, int r, LAS float* scr, int lane) {
    const int nblk = N / 32, per = (K / 64) * nblk, bi = r / per, it = r % per, kb = it / nblk, nb = it % nblk, n0 = 32 * nb;
    int dr = n0; if (MAP == 1) dr = (n0 >> 7) * 256 + (n0 & 127); if (MAP == 2) dr = (n0 >> 7) * 256 + 128 + (n0 & 127);
    transpose_item<F8>(src + (size_t)bi * K * N, N, (unsigned char*)dst + (size_t)bi * dstb * (F8 ? 1 : 2), K, 64 * kb, n0, dr, scr, lane, F8 ? pg8::F8_WS : 1.f);
}

struct InvFreq { float f[8]; };
struct Args {
    const void* in[40]; float* out; unsigned char* ws; InvFreq inv; int ph_lo, ph_hi;
};

struct RowV { float v[16]; };
__device__ __forceinline__ void unpk8(const v4u u, float* x) {
    x[0] = __uint_as_float(u.x << 16); x[1] = __uint_as_float(u.x & 0xffff0000u); x[2] = __uint_as_float(u.y << 16); x[3] = __uint_as_float(u.y & 0xffff0000u);
    x[4] = __uint_as_float(u.z << 16); x[5] = __uint_as_float(u.z & 0xffff0000u); x[6] = __uint_as_float(u.w << 16); x[7] = __uint_as_float(u.w & 0xffff0000u);
}
struct RowRaw { v4u a, b; };
__device__ __forceinline__ RowRaw load_raw(const bf16_t* p, int lane) { RowRaw r; r.a = *(const v4u*)(p + 8 * lane); r.b = *(const v4u*)(p + 512 + 8 * lane); return r; }
__device__ __forceinline__ void unpack_row(const RowRaw& r, RowV& x) { unpk8(r.a, x.v); unpk8(r.b, x.v + 8); }
struct GB { float g[16], b[16]; };
__device__ __forceinline__ void load_gb(const float* g, const float* b, int lane, GB& o) {
#pragma unroll
    for (int hh = 0; hh < 2; ++hh)
#pragma unroll
        for (int q = 0; q < 2; ++q) { const float4 gg = *(const float4*)(g + 512 * hh + 8 * lane + 4 * q), bb = *(const float4*)(b + 512 * hh + 8 * lane + 4 * q);
            o.g[8 * hh + 4 * q + 0] = gg.x; o.g[8 * hh + 4 * q + 1] = gg.y; o.g[8 * hh + 4 * q + 2] = gg.z; o.g[8 * hh + 4 * q + 3] = gg.w;
            o.b[8 * hh + 4 * q + 0] = bb.x; o.b[8 * hh + 4 * q + 1] = bb.y; o.b[8 * hh + 4 * q + 2] = bb.z; o.b[8 * hh + 4 * q + 3] = bb.w; }
}
__device__ __forceinline__ void ln_rowv(RowV& z, const GB& gb) {
    float s = 0.f;
#pragma unroll
    for (int i = 0; i < 16; ++i) s += z.v[i];
    const float mu = wave_sum(s) * (1.f / D);
    float q = 0.f;
#pragma unroll
    for (int i = 0; i < 16; ++i) { z.v[i] -= mu; q += z.v[i] * z.v[i]; }
    const float rstd = 1.f / sqrtf(wave_sum(q) * (1.f / D) + LN_EPS);
#pragma unroll
    for (int i = 0; i < 16; ++i) z.v[i] = z.v[i] * rstd * gb.g[i] + gb.b[i];
}
__device__ __forceinline__ void store_rowv_bf16(bf16_t* p, int lane, const RowV& r) {
    v4u a, b; a.x = pk2(r.v[0], r.v[1]); a.y = pk2(r.v[2], r.v[3]); a.z = pk2(r.v[4], r.v[5]); a.w = pk2(r.v[6], r.v[7]);
    b.x = pk2(r.v[8], r.v[9]); b.y = pk2(r.v[10], r.v[11]); b.z = pk2(r.v[12], r.v[13]); b.w = pk2(r.v[14], r.v[15]);
    *(v4u*)(p + 8 * lane) = a; *(v4u*)(p + 512 + 8 * lane) = b;
}
constexpr int LNR = 4;

__device__ __forceinline__ void phase_ln_add(const Frame& F, const bf16_t* X, const bf16_t* Y, const float* g, const float* b, bf16_t* out) {
    const int gw = F.vcu * NWAVES + F.wave, NGW = F.G * NWAVES;
    GB gb; load_gb(g, b, F.lane, gb);
    for (int row = gw; row < T; row += LNR * NGW) {
        RowRaw rx[LNR], ry[LNR];
#pragma unroll
        for (int k = 0; k < LNR; ++k) { const int rr = row + k * NGW; if (rr < T) { rx[k] = load_raw(X + (size_t)rr * D, F.lane); ry[k] = load_raw(Y + (size_t)rr * D, F.lane); } }
#pragma unroll
        for (int k = 0; k < LNR; ++k) { const int rr = row + k * NGW; if (rr < T) {
            RowV x, y; unpack_row(rx[k], x); unpack_row(ry[k], y);
#pragma unroll
            for (int i = 0; i < 16; ++i) x.v[i] = ALPHA * x.v[i] + y.v[i];
            ln_rowv(x, gb);
            store_rowv_bf16(out + (size_t)rr * D, F.lane, x); } }
    }
}
__device__ __forceinline__ void phase_ln_moe(const Frame& F, const bf16_t* X, const bf16_t* DS, const int* pos, const float* ewgt, const float* g, const float* b, bf16_t* outb, float* outf) {
    const int gw = F.vcu * NWAVES + F.wave, NGW = F.G * NWAVES;
    GB gb; load_gb(g, b, F.lane, gb);
    for (int row = gw; row < T; row += LNR * NGW) {
        RowRaw rx[LNR], r1[LNR], r2[LNR]; float w1[LNR], w2[LNR];
#pragma unroll
        for (int k = 0; k < LNR; ++k) { const int rr = row + k * NGW; if (rr < T) {
            const int2 pp = *(const int2*)(pos + 2 * rr); const float2 ww = *(const float2*)(ewgt + 2 * rr); w1[k] = ww.x; w2[k] = ww.y;
            rx[k] = load_raw(X + (size_t)rr * D, F.lane); r1[k] = load_raw(DS + (size_t)pp.x * D, F.lane); r2[k] = load_raw(DS + (size_t)pp.y * D, F.lane); } }
#pragma unroll
        for (int k = 0; k < LNR; ++k) { const int rr = row + k * NGW; if (rr < T) {
            RowV x, y1, y2; unpack_row(rx[k], x); unpack_row(r1[k], y1); unpack_row(r2[k], y2);
#pragma unroll
            for (int i = 0; i < 16; ++i) x.v[i] = ALPHA * x.v[i] + (w1[k] * y1.v[i] + w2[k] * y2.v[i]);
            ln_rowv(x, gb);
            if (outb) store_rowv_bf16(outb + (size_t)rr * D, F.lane, x);
            if (outf) { float* o = outf + (size_t)rr * D + 8 * F.lane;
                *(float4*)(o) = make_float4(x.v[0], x.v[1], x.v[2], x.v[3]); *(float4*)(o + 4) = make_float4(x.v[4], x.v[5], x.v[6], x.v[7]);
                *(float4*)(o + 512) = make_float4(x.v[8], x.v[9], x.v[10], x.v[11]); *(float4*)(o + 516) = make_float4(x.v[12], x.v[13], x.v[14], x.v[15]); } } }
    }
}
constexpr int RW_LD = 20;
__device__ __forceinline__ void store_rowv_fp8(unsigned char* p, int lane, const RowV& r, float s) {
    v2u a, b; a.x = pg8::pk4_fp8(r.v[0] * s, r.v[1] * s, r.v[2] * s, r.v[3] * s); a.y = pg8::pk4_fp8(r.v[4] * s, r.v[5] * s, r.v[6] * s, r.v[7] * s);
    b.x = pg8::pk4_fp8(r.v[8] * s, r.v[9] * s, r.v[10] * s, r.v[11] * s); b.y = pg8::pk4_fp8(r.v[12] * s, r.v[13] * s, r.v[14] * s, r.v[15] * s);
    *(v2u*)(p + 8 * lane) = a; *(v2u*)(p + 512 + 8 * lane) = b;
}
__device__ __forceinline__ void phase_ln_router(const Frame& F, const bf16_t* X, const bf16_t* Y, const float* g, const float* b, bf16_t* out, unsigned char* out8, const float* rw, const float* rbias, int* eidx, float* ewgt, int* bcnt) {
    LAS float* rwl = (LAS float*)F.lds;
    LAS int* hist = (LAS int*)(F.lds + 1024 * RW_LD * 4);
    LAS float* lgs = (LAS float*)(F.lds + 1024 * RW_LD * 4 + 256) + F.wave * 64;
    for (int i = F.tid; i < 1024 * 4; i += NTHREADS) { const int k = i >> 2, q = i & 3; const float4 v = *(const float4*)(rw + (size_t)k * 16 + 4 * q);
        const int j = (k >> 9) * 8 + (k & 7), l = (k >> 3) & 63; LAS float* d = rwl + (j * 64 + l) * RW_LD + 4 * q; d[0] = v.x; d[1] = v.y; d[2] = v.z; d[3] = v.w; }
    GB gb; load_gb(g, b, F.lane, gb);
    const int lane = F.lane;
    for (int vb = F.vcu; vb < T / 128; vb += F.G) {
        if (F.tid < 16) hist[F.tid] = 0;
        __syncthreads();
#pragma unroll 1
        for (int it = 0; it < 4; ++it) {
            const int row0 = vb * 128 + F.wave * 16 + it * 4;
            RowRaw rx[4], ry[4];
#pragma unroll
            for (int k = 0; k < 4; ++k) { rx[k] = load_raw(X + (size_t)(row0 + k) * D, lane); ry[k] = load_raw(Y + (size_t)(row0 + k) * D, lane); }
            RowV x[4];
#pragma unroll
            for (int k = 0; k < 4; ++k) { RowV y; unpack_row(rx[k], x[k]); unpack_row(ry[k], y);
#pragma unroll
                for (int i = 0; i < 16; ++i) x[k].v[i] = ALPHA * x[k].v[i] + y.v[i];
                ln_rowv(x[k], gb);
                store_rowv_bf16(out + (size_t)(row0 + k) * D, lane, x[k]);
                store_rowv_fp8(out8 + (size_t)(row0 + k) * D, lane, x[k], pg8::F8_XS); }
            float val[64];
#pragma unroll
            for (int i = 0; i < 64; ++i) val[i] = 0.f;
#pragma unroll
            for (int j = 0; j < 16; ++j) { const LAS float* wr = rwl + (j * 64 + lane) * RW_LD;
#pragma unroll
                for (int e4 = 0; e4 < 4; ++e4) { const f32x4 w4 = *(const LAS f32x4*)(wr + 4 * e4);
#pragma unroll
                    for (int k = 0; k < 4; ++k) { const float xv = x[k].v[j];
                        val[16 * k + 4 * e4 + 0] += xv * w4[0]; val[16 * k + 4 * e4 + 1] += xv * w4[1]; val[16 * k + 4 * e4 + 2] += xv * w4[2]; val[16 * k + 4 * e4 + 3] += xv * w4[3]; } } }
#pragma unroll
            for (int i = 0; i < 32; ++i) { const auto rr = __builtin_amdgcn_permlane32_swap(__float_as_uint(val[i]), __float_as_uint(val[i + 32]), false, false); val[i] = __uint_as_float(rr[0]) + __uint_as_float(rr[1]); }
            { const bool bt = (lane & 16) != 0;
#pragma unroll
              for (int i = 0; i < 16; ++i) { const float keep = bt ? val[i + 16] : val[i], send = bt ? val[i] : val[i + 16]; val[i] = keep + swz_xor<16>(send); } }
            { const bool bt = (lane & 8) != 0;
#pragma unroll
              for (int i = 0; i < 8; ++i) { const float keep = bt ? val[i + 8] : val[i], send = bt ? val[i] : val[i + 8]; val[i] = keep + swz_xor<8>(send); } }
            { const bool bt = (lane & 4) != 0;
#pragma unroll
              for (int i = 0; i < 4; ++i) { const float keep = bt ? val[i + 4] : val[i], send = bt ? val[i] : val[i + 4]; val[i] = keep + swz_xor<4>(send); } }
            { const bool bt = (lane & 2) != 0;
#pragma unroll
              for (int i = 0; i < 2; ++i) { const float keep = bt ? val[i + 2] : val[i], send = bt ? val[i] : val[i + 2]; val[i] = keep + swz_xor<2>(send); } }
            { const bool bt = (lane & 1) != 0; const float keep = bt ? val[1] : val[0], send = bt ? val[0] : val[1]; val[0] = keep + swz_xor<1>(send); }
            lgs[lane] = val[0];
            LDS_WAIT();
            if (lane < 4) {
                const int row = row0 + lane;
                float lg[16];
#pragma unroll
                for (int e4 = 0; e4 < 4; ++e4) { const f32x4 t4 = *(const LAS f32x4*)(lgs + 16 * lane + 4 * e4); lg[4 * e4] = t4[0]; lg[4 * e4 + 1] = t4[1]; lg[4 * e4 + 2] = t4[2]; lg[4 * e4 + 3] = t4[3]; }
                float mx = lg[0];
#pragma unroll
                for (int e = 1; e < 16; ++e) mx = fmaxf(mx, lg[e]);
                float sc[16], sum = 0.f;
#pragma unroll
                for (int e = 0; e < 16; ++e) { sc[e] = __expf(lg[e] - mx); sum += sc[e]; }
                const float isum = 1.f / sum;
                float bz[16];
#pragma unroll
                for (int e = 0; e < 16; ++e) { sc[e] *= isum; bz[e] = sc[e] + rbias[e]; }
                float gs[4]; int gi1[4], gi2[4];
#pragma unroll
                for (int gq = 0; gq < 4; ++gq) {
                    float m1 = bz[4 * gq]; int i1 = 0;
#pragma unroll
                    for (int j = 1; j < 4; ++j) if (bz[4 * gq + j] > m1) { m1 = bz[4 * gq + j]; i1 = j; }
                    float m2 = -INFINITY; int i2 = 0;
#pragma unroll
                    for (int j = 0; j < 4; ++j) if (j != i1 && bz[4 * gq + j] > m2) { m2 = bz[4 * gq + j]; i2 = j; }
                    gs[gq] = m1 + m2; gi1[gq] = i1; gi2[gq] = i2;
                }
                int gsel = 0; float gm = gs[0];
#pragma unroll
                for (int gq = 1; gq < 4; ++gq) if (gs[gq] > gm) { gm = gs[gq]; gsel = gq; }
                int i1 = gi1[0], i2 = gi2[0];
#pragma unroll
                for (int gq = 1; gq < 4; ++gq) if (gsel == gq) { i1 = gi1[gq]; i2 = gi2[gq]; }
                const int e1 = gsel * 4 + i1, e2 = gsel * 4 + i2;
                float s1 = 0.f, s2 = 0.f;
#pragma unroll
                for (int e = 0; e < 16; ++e) { if (e == e1) s1 = sc[e]; if (e == e2) s2 = sc[e]; }
                const float inv = 1.f / (s1 + s2);
                *(int2*)(eidx + 2 * row) = make_int2(e1, e2); *(float2*)(ewgt + 2 * row) = make_float2(s1 * inv, s2 * inv);
                atomicAdd((int*)&hist[e1], 1); atomicAdd((int*)&hist[e2], 1);
            }
        }
        __syncthreads();
        if (F.tid < 16) bcnt[vb * 16 + F.tid] = hist[F.tid];
        __syncthreads();
    }
}
__device__ __forceinline__ void phase_moe_book(const Frame& F, const int* eidx, const int* bcnt, int* tok, int* pos, int* tile_e) {
    LAS int* bc = (LAS int*)F.lds;
    LAS int* es = bc + 4096;
    LAS int* off = es + 256;
    LAS int* base = off + 32;
    LAS int* tot = base + 16;
    for (int i = F.tid; i < 4096; i += NTHREADS) bc[i] = bcnt[i];
    __syncthreads();
    for (int vb = F.vcu; vb < T / 128; vb += F.G) {
        if (F.tid < 16) { int t = 0, bs = 0; for (int b2 = 0; b2 < 256; ++b2) { const int c = bc[b2 * 16 + F.tid]; t += c; if (b2 < vb) bs += c; } tot[F.tid] = t; base[F.tid] = bs; }
        if (F.tid < 256) es[F.tid] = eidx[vb * 256 + F.tid];
        __syncthreads();
        if (F.tid == 0) { int o = 0; for (int e = 0; e < 16; ++e) { off[e] = o; o += (tot[e] + 255) & ~255; } off[16] = o; }
        __syncthreads();
        if (F.tid < 256) {
            const int e = es[F.tid]; int rank = 0;
            for (int j = 0; j < F.tid; ++j) rank += (es[j] == e) ? 1 : 0;
            const int r = off[e] + base[e] + rank;
            pos[vb * 256 + F.tid] = r; tok[r] = vb * 128 + (F.tid >> 1);
        }
        if (vb < 16) { const int e = vb, r0 = off[e] + tot[e], r1 = off[e + 1]; for (int r = r0 + F.tid; r < r1; r += NTHREADS) tok[r] = 0; }
        if (vb == 16) {
            for (int tl = F.tid; tl < NTILE; tl += NTHREADS) { int e = -1; for (int k = 0; k < 16; ++k) if (tl * 256 >= off[k] && tl * 256 < off[k + 1]) e = k; tile_e[tl] = e; }
            if (F.tid == 0) tile_e[NTILE] = off[16] >> 8;
        }
        __syncthreads();
    }
}
__device__ __forceinline__ void phase_pool(const Frame& F, const bf16_t* HP, bf16_t* PO) {
    constexpr int RUN = 32;
    const int gt = F.vcu * NTHREADS + F.tid, NGT = F.G * NTHREADS;
    for (int it = gt; it < (T / RUN) * (D / 8); it += NGT) {
        const int c8 = it & 127, run = it >> 7, g = c8 >> 5, win = 2 << g, t0 = run * RUN, ts0 = t0 & (S - 1);
        const bf16_t* hp = HP + (size_t)t0 * D + c8 * 8; bf16_t* po = PO + (size_t)t0 * D + c8 * 8;
        float s[8];
#pragma unroll
        for (int q = 0; q < 8; ++q) s[q] = 0.f;
        for (int k = 1; k < win; ++k) if (ts0 - k >= 0) { float v[8]; unpk8(*(const v4u*)(hp - (ptrdiff_t)k * D), v);
#pragma unroll
            for (int q = 0; q < 8; ++q) s[q] += v[q]; }
#pragma unroll 4
        for (int i = 0; i < RUN; ++i) {
            float hn[8]; unpk8(*(const v4u*)(hp + (size_t)i * D), hn);
            const int ts = ts0 + i;
#pragma unroll
            for (int q = 0; q < 8; ++q) s[q] += hn[q];
            const float inv = 1.f / (float)(ts + 1 < win ? ts + 1 : win);
            v4u o; o.x = pk2(s[0] * inv - hn[0], s[1] * inv - hn[1]); o.y = pk2(s[2] * inv - hn[2], s[3] * inv - hn[3]); o.z = pk2(s[4] * inv - hn[4], s[5] * inv - hn[5]); o.w = pk2(s[6] * inv - hn[6], s[7] * inv - hn[7]);
            *(v4u*)(po + (size_t)i * D) = o;
            if (ts + 1 >= win) { float ho[8]; unpk8(*(const v4u*)(hp + (ptrdiff_t)(i + 1 - win) * D), ho);
#pragma unroll
                for (int q = 0; q < 8; ++q) s[q] -= ho[q]; }
        }
    }
}
}
namespace mk {
typedef short bf16x8 __attribute__((ext_vector_type(8)));
typedef float f32x16 __attribute__((ext_vector_type(16)));
#define MFMA32(a, b, c) __builtin_amdgcn_mfma_f32_32x32x16_bf16((a), (b), (c), 0, 0, 0)
__device__ __forceinline__ int crow(int i, int h) { return (i & 3) + 8 * (i >> 2) + 4 * h; }
__device__ __forceinline__ float swap32_max(float v) { const auto r = __builtin_amdgcn_permlane32_swap(__float_as_uint(v), __float_as_uint(v), false, false); return fmaxf(__uint_as_float(r[0]), __uint_as_float(r[1])); }
__device__ __forceinline__ float swap32_sum(float v) { const auto r = __builtin_amdgcn_permlane32_swap(__float_as_uint(v), __float_as_uint(v), false, false); return __uint_as_float(r[0]) + __uint_as_float(r[1]); }
__device__ __forceinline__ unsigned pkbf(float lo, float hi) { unsigned r; asm volatile("v_cvt_pk_bf16_f32 %0, %1, %2" : "=v"(r) : "v"(lo), "v"(hi)); return r; }
__device__ __forceinline__ bf16x8 pack_step(const f32x16& x, int s) {
    v4u p; p.x = pkbf(x[8 * s + 0], x[8 * s + 1]); p.y = pkbf(x[8 * s + 2], x[8 * s + 3]); p.z = pkbf(x[8 * s + 4], x[8 * s + 5]); p.w = pkbf(x[8 * s + 6], x[8 * s + 7]);
    return __builtin_bit_cast(bf16x8, p);
}
__device__ __forceinline__ bf16x8 lds_frag2x8(const LAS unsigned char* p) {
    const v2u a = *(const LAS v2u*)p, b = *(const LAS v2u*)(p + 16);
    v4u q; q.x = a.x; q.y = a.y; q.z = b.x; q.w = b.y; return __builtin_bit_cast(bf16x8, q);
}
__device__ __forceinline__ void unpack8(const v4u u, float (&x)[8]) {
    x[0] = __uint_as_float(u.x << 16); x[1] = __uint_as_float(u.x & 0xffff0000u); x[2] = __uint_as_float(u.y << 16); x[3] = __uint_as_float(u.y & 0xffff0000u);
    x[4] = __uint_as_float(u.z << 16); x[5] = __uint_as_float(u.z & 0xffff0000u); x[6] = __uint_as_float(u.w << 16); x[7] = __uint_as_float(u.w & 0xffff0000u);
}

__device__ __forceinline__ void phase_swa_sgu(const Frame& F, const bf16_t* H0, const float* sinks, const float* lng, const float* lnb, const bf16_t* SW, const float* bs, bf16_t* MIX) {
    constexpr int KSTR = 272, VSTR = 520, VT_OFF = 256 * KSTR, VGSTR = 272, VGW = 64 * VGSTR;
    LAS unsigned char* KS = F.lds; LAS unsigned char* VT = F.lds + VT_OFF;
    const int lane = F.lane, r = lane & 31, h = lane >> 5, w = F.wave, kvh = w >> 2;
    const float NEG = -INFINITY;
    for (int vb = F.vcu; vb < T / 128; vb += F.G) {
        const int n = vb & 63; const size_t row0 = (size_t)vb * 128;
#pragma unroll
        for (int i = 0; i < 8; ++i) { const int p = F.tid + NTHREADS * i, row = p >> 4, c16 = p & 15; v4u v = (v4u){0u, 0u, 0u, 0u};
            if (n > 0 || row >= 128) v = *(const v4u*)(H0 + (row0 + row - 128) * NIN0 + 512 + c16 * 8);
            *(LAS v4u*)(KS + row * KSTR + c16 * 16) = v; }
#pragma unroll
        for (int i = 0; i < 8; ++i) { const int p = F.tid + NTHREADS * i, c16 = p >> 8, row = p & 255; v4u v = (v4u){0u, 0u, 0u, 0u};
            if (n > 0 || row >= 128) v = *(const v4u*)(H0 + (row0 + row - 128) * NIN0 + 640 + c16 * 8);
            LAS bf16_t* d = (LAS bf16_t*)(VT + (c16 * 8) * VSTR + row * 2);
            d[0 * (VSTR / 2)] = (bf16_t)(v.x & 0xffffu); d[1 * (VSTR / 2)] = (bf16_t)(v.x >> 16); d[2 * (VSTR / 2)] = (bf16_t)(v.y & 0xffffu); d[3 * (VSTR / 2)] = (bf16_t)(v.y >> 16);
            d[4 * (VSTR / 2)] = (bf16_t)(v.z & 0xffffu); d[5 * (VSTR / 2)] = (bf16_t)(v.z >> 16); d[6 * (VSTR / 2)] = (bf16_t)(v.w & 0xffffu); d[7 * (VSTR / 2)] = (bf16_t)(v.w >> 16); }
        __syncthreads();
        const float sink2 = sinks[w] * 1.4426950408889634f;
#pragma unroll 1
        for (int qg = 0; qg < 4; ++qg) {
            bf16x8 qf[4];
            { const bf16_t* qp = H0 + (row0 + 32 * qg + r) * NIN0 + w * 64 + 8 * h;
#pragma unroll
              for (int ks = 0; ks < 4; ++ks) qf[ks] = *(const bf16x8*)(qp + 16 * ks); }
            f32x16 st[5];
#pragma unroll
            for (int kt = 0; kt < 5; ++kt) {
#pragma unroll
                for (int i = 0; i < 16; ++i) st[kt][i] = 0.f;
                const LAS unsigned char* kp = KS + (32 * qg + 32 * kt + r) * KSTR + (kvh * 64 + 8 * h) * 2;
#pragma unroll
                for (int ks = 0; ks < 4; ++ks) { const bf16x8 kf = *(const LAS bf16x8*)(kp + 32 * ks); st[kt] = MFMA32(kf, qf[ks], st[kt]); }
            }
            float m = sink2;
            int rq = r; asm volatile("" : "+v"(rq));
#pragma unroll
            for (int kt = 0; kt < 5; ++kt)
#pragma unroll
                for (int i = 0; i < 16; ++i) { const int dk = 32 * kt + crow(i, h) - rq;
                    const bool valid = dk >= 1 && dk <= 128 && (n > 0 || (32 * qg + 32 * kt + crow(i, h)) >= 128);
                    const float s = valid ? st[kt][i] * ASCALE : NEG; st[kt][i] = s; m = fmaxf(m, s); }
            m = swap32_max(m);
            float l = 0.f;
#pragma unroll
            for (int kt = 0; kt < 5; ++kt)
#pragma unroll
                for (int i = 0; i < 16; ++i) { const float p = __builtin_amdgcn_exp2f(st[kt][i] - m); st[kt][i] = p; l += p; }
            l = swap32_sum(l) + __builtin_amdgcn_exp2f(sink2 - m);
            f32x16 o[2];
#pragma unroll
            for (int i = 0; i < 16; ++i) { o[0][i] = 0.f; o[1][i] = 0.f; }
#pragma unroll
            for (int kt = 0; kt < 5; ++kt)
#pragma unroll
                for (int s = 0; s < 2; ++s) { const bf16x8 pf = pack_step(st[kt], s);
#pragma unroll
                    for (int dt = 0; dt < 2; ++dt) { const bf16x8 vf = lds_frag2x8(VT + (kvh * 64 + 32 * dt + r) * VSTR + (32 * qg + 32 * kt + 16 * s + 4 * h) * 2); o[dt] = MFMA32(vf, pf, o[dt]); } }
            const float inv = 1.f / l;
            bf16_t* op = MIX + (row0 + 32 * qg + r) * D + w * 64 + 4 * h;
#pragma unroll
            for (int dt = 0; dt < 2; ++dt)
#pragma unroll
                for (int g4 = 0; g4 < 4; ++g4) { v2u u; u.x = pkbf(o[dt][4 * g4 + 0] * inv, o[dt][4 * g4 + 1] * inv); u.y = pkbf(o[dt][4 * g4 + 2] * inv, o[dt][4 * g4 + 3] * inv); *(v2u*)(op + 32 * dt + 8 * g4) = u; }
        }
        __syncthreads();
        {
            LAS unsigned char* VG = F.lds + w * VGW; const int g = w; int vz = 0; asm volatile("" : "+v"(vz));
#pragma unroll 1
            for (int it = 0; it < 2; ++it) { const int s = 64 * it + lane; const bf16_t* vp = H0 + (row0 + s) * NIN0 + 1280 + g * 64;
                float x[8][8]; float sum = 0.f;
#pragma unroll
                for (int cq = 0; cq < 8; ++cq) { unpack8(*(const v4u*)(vp + 8 * cq), x[cq]);
#pragma unroll
                    for (int e = 0; e < 8; ++e) sum += x[cq][e]; }
                const float mu = sum * (1.f / 64.f); float q = 0.f;
#pragma unroll
                for (int cq = 0; cq < 8; ++cq)
#pragma unroll
                    for (int e = 0; e < 8; ++e) { x[cq][e] -= mu; q += x[cq][e] * x[cq][e]; }
                const float rstd = 1.f / sqrtf(q * (1.f / 64.f) + LN_EPS);
#pragma unroll
                for (int cq = 0; cq < 8; ++cq)
#pragma unroll
                    for (int e = 0; e < 8; ++e) { const int c = 8 * cq + e; *(LAS bf16_t*)(VG + c * VGSTR + s * 2) = f2bf(x[cq][e] * rstd * lng[g * 64 + c + vz] + lnb[g * 64 + c + vz]); }
            }
            LDS_WAIT();
#pragma unroll 1
            for (int tt = 0; tt < 4; ++tt) {
                f32x16 acc[2];
#pragma unroll
                for (int i = 0; i < 16; ++i) { acc[0][i] = 0.f; acc[1][i] = 0.f; }
                const bf16_t* wp = SW + ((size_t)(g * 128 + 32 * tt + r) * 128 + 8 * h);
                for (int ks = 0; ks < 2 * (tt + 1); ++ks) { const bf16x8 bfr = *(const bf16x8*)(wp + 16 * ks);
#pragma unroll
                    for (int ct = 0; ct < 2; ++ct) { const bf16x8 af = *(const LAS bf16x8*)(VG + (32 * ct + r) * VGSTR + (16 * ks + 8 * h) * 2); acc[ct] = MFMA32(af, bfr, acc[ct]); } }
                const int t = 32 * tt + r; const float bias = bs[g * 128 + t];
                const bf16_t* up = H0 + (row0 + t) * NIN0 + 768 + g * 64 + 4 * h; bf16_t* op = MIX + (row0 + t) * D + 512 + g * 64 + 4 * h;
#pragma unroll
                for (int ct = 0; ct < 2; ++ct)
#pragma unroll
                    for (int g4 = 0; g4 < 4; ++g4) { const v2u uu = *(const v2u*)(up + 32 * ct + 8 * g4);
                        const float u0 = __uint_as_float(uu.x << 16), u1 = __uint_as_float(uu.x & 0xffff0000u), u2 = __uint_as_float(uu.y << 16), u3 = __uint_as_float(uu.y & 0xffff0000u);
                        v2u o2; o2.x = pkbf(u0 * (acc[ct][4 * g4 + 0] + bias), u1 * (acc[ct][4 * g4 + 1] + bias)); o2.y = pkbf(u2 * (acc[ct][4 * g4 + 2] + bias), u3 * (acc[ct][4 * g4 + 3] + bias));
                        *(v2u*)(op + 32 * ct + 8 * g4) = o2; }
            }
        }
        __syncthreads();
    }
}

}
namespace mk {
constexpr int NPHASE = 23;

typedef const __attribute__((address_space(4))) Args* KArgs;
__device__ __forceinline__ KArgs kargs() { KArgs p = (KArgs)__builtin_amdgcn_kernarg_segment_ptr(); asm volatile("" : "+s"(p)); return p; }

__device__ __forceinline__ bool in_range(int k) { KArgs ka = kargs(); return ka->ph_lo <= k && k < ka->ph_hi; }

__global__ void __launch_bounds__(NTHREADS, 2) mega(Args a) {
    extern __shared__ __attribute__((aligned(16))) unsigned char lds_raw[];
    LAS unsigned char* const F0lds = (LAS unsigned char*)lds_raw;
    const int F0wave = __builtin_amdgcn_readfirstlane((int)threadIdx.x >> 6);
    const int F0G = gridDim.x, F0bx = blockIdx.x, F0vcu = (F0G % 8 == 0) ? (F0bx % 8) * (F0G / 8) + F0bx / 8 : F0bx;
    volatile LAS unsigned* MISC = (volatile LAS unsigned*)(F0lds + MISC_OFF);
    if (threadIdx.x < 64) MISC[threadIdx.x] = 0u;
    __syncthreads();
    unsigned* ctl = (unsigned*)(a.ws + WS_CTL);
    XcdBarrier bar = xcd_barrier_post(ctl + CW_BAR + a.ph_lo * XCD_BAR_WORDS, MISC + 8, F0wave);
#define IN(k) in_range(k)
#define SEAM(k) do { if (IN(k) && IN((k) + 1)) { XcdBarrier b2_ = bar; asm volatile("" : "+s"(b2_.bar), "+s"(b2_.x)); xcd_barrier(b2_); } } while (0)
#define PH KArgs ka = kargs(); unsigned char* ws = ka->ws; (void)ws; Frame Fp; Fp.lds = F0lds; Fp.wave = F0wave; Fp.vcu = F0vcu; Fp.G = F0G; Fp.bx = F0bx; asm volatile("" : "+s"(Fp.wave), "+s"(Fp.vcu), "+s"(Fp.G), "+s"(Fp.bx)); \
    Fp.lane = (int)lane_id_fresh(); Fp.tid = Fp.wave * 64 + Fp.lane; const Frame& F = Fp; \
    const int bx = Fp.bx; (void)bx; LAS unsigned char* glds = F.lds; (void)glds; \
    bf16_t* RA = (bf16_t*)(ws + WS_A); bf16_t* RB = (bf16_t*)(ws + WS_B); bf16_t* RC = (bf16_t*)(ws + WS_C); bf16_t* RD = (bf16_t*)(ws + WS_D); bf16_t* WB = (bf16_t*)(ws + WS_WB); \
    (void)RA; (void)RB; (void)RC; (void)RD; (void)WB;
#define PHC PH const int cb = L == 0 ? 12 : 28; (void)cb; bf16_t* WBl = WB + WB_LAYER + (size_t)L * WL_SIZE; (void)WBl; \
    bf16_t *X1 = RB, *Qb, *Y2, *X2, *HS = RB, *DS = RD, *X3; Qb = RA; Y2 = RC; X2 = RA; X3 = L == 0 ? RC : nullptr; \
    (void)X1; (void)Qb; (void)Y2; (void)X2; (void)HS; (void)DS; (void)X3;
#ifndef DOUBLE_MASK
#define DOUBLE_MASK 0u
#endif
#if DOUBLE_MASK != 0
#define REP(k) for (int rep_ = 0, nrep_ = 1 + (int)((DOUBLE_MASK >> (k)) & 1u); rep_ < nrep_; ++rep_)
#else
#define REP(k)
#endif
#define INF(i) ((const float*)ka->in[i])
#define WSI(off) ((int*)(ws + (off)))
#define WSF(off) ((float*)(ws + (off)))

#define GEMM_STD(EPI, ORD, LDA_, LDB_, K_) pg8::gemm_phase<EPI, ORD, true, true, false, LDA_, LDB_, K_>(glds, F.tid, g, S, E)
    for (int L = 0; L < 2; ++L) {
        const int cbp = L == 0 ? 0 : 11;
        if (L == 0) {
            if (IN(0)) REP(0) { PH
                LAS float* scr = (LAS float*)(F.lds + F.wave * 16384);
                const int gw = F.vcu * NWAVES + F.wave, NGW = F.G * NWAVES;
                constexpr int NITEMS = 896 + 512 + 512 + 512 + 2 * (1024 + 512 + 3 * 4096);
                for (int it = gw; it < NITEMS; it += NGW) {
                    int r = it;
#define JOB(MAP, src, K_, N_, dst, dstb, cnt) if (r < (cnt)) { transpose_job_item<MAP, false>((const float*)(src), K_, N_, dst, dstb, r, scr, F.lane); continue; } r -= (cnt);
#define JOB8(MAP, src, K_, N_, dst, dstb, cnt) if (r < (cnt)) { transpose_job_item<MAP, true>((const float*)(src), K_, N_, dst, dstb, r, scr, F.lane); continue; } r -= (cnt);
                    JOB(0, ka->in[5], 1024, 1792, WB + WB_IN0, 0, 896)
                    JOB(0, ka->in[11], 1024, 1024, WB + WB_OUT0, 0, 512)
                    JOB(0, ka->in[24], 1024, 1024, WB + WB_IN1, 0, 512)
                    JOB(0, ka->in[27], 1024, 1024, WB + WB_OUT1, 0, 512)
#define LAYER_JOBS(l, c2) { bf16_t* Wl = WB + WB_LAYER + (size_t)(l) * WL_SIZE; \
                        JOB(0, ka->in[(c2) + 3], 1024, 2048, Wl + WL_XKV, 0, 1024) \
                        JOB(0, ka->in[(c2) + 4], 1024, 1024, Wl + WL_XO, 0, 512) \
                        JOB8(1, ka->in[(c2) + 7], 1024, 512, Wl + WL_GU, (size_t)1024 * 1024, 4096) \
                        JOB8(2, ka->in[(c2) + 8], 1024, 512, Wl + WL_GU, (size_t)1024 * 1024, 4096) \
                        JOB8(0, ka->in[(c2) + 9], 512, 1024, Wl + WL_DN, (size_t)1024 * 512, 4096) }
                    LAYER_JOBS(0, 12)
                    LAYER_JOBS(1, 28)
#undef LAYER_JOBS
#undef JOB
#undef JOB8
                }
                const int gt = F.vcu * NTHREADS + F.tid, NGT = F.G * NTHREADS;
                { const float4* x4 = (const float4*)ka->in[0]; v2u* o = (v2u*)RA;
                  for (int i = gt; i < T * D / 4; i += NGT) { const float4 v = x4[i]; v2u w; w.x = pk2(v.x, v.y); w.y = pk2(v.z, v.w); o[i] = w; } }
                { const float4* m4 = (const float4*)ka->in[1]; v2u* o = (v2u*)(ws + WS_MEMB);
                  for (int i = gt; i < B * MEM * D / 4; i += NGT) { const float4 v = m4[i]; v2u w; w.x = pk2(v.x, v.y); w.y = pk2(v.z, v.w); o[i] = w; } }
#pragma unroll
                for (int l = 0; l < 2; ++l) { const float4* q4 = (const float4*)ka->in[l == 0 ? 14 : 30]; v2u* o = (v2u*)(WB + WB_LAYER + (size_t)l * WL_SIZE + WL_XQ);
                  for (int i = gt; i < D * D / 4; i += NGT) { const float4 v = q4[i]; v2u w; w.x = pk2(v.x, v.y); w.y = pk2(v.z, v.w); o[i] = w; } }
                { const float4* p4 = (const float4*)ka->in[25]; const float4* s4 = (const float4*)ka->in[26]; v2u* o = (v2u*)(WB + WB_POOL);
                  for (int i = gt; i < 4 * 256 * 256 / 4; i += NGT) { const float4 v = p4[i]; const float4 sc = s4[(i >> 14) * 64 + (i & 63)]; v2u w; w.x = pk2(v.x * sc.x, v.y * sc.y); w.y = pk2(v.z * sc.z, v.w * sc.w); o[i] = w; } }
                { const int* positions = (const int*)ka->in[2]; float* ropew = WSF(WS_ROPE);
                  for (int t = gt; t < T; t += NGT) { const float p = (float)positions[t];
#pragma unroll
                      for (int j = 0; j < 8; ++j) { const float ang = p * ka->inv.f[j]; double rev = (double)ang * 0.15915494309189535; rev -= rint(rev); const float rr = (float)rev;
                          ropew[(size_t)t * 16 + j] = __builtin_amdgcn_cosf(rr); ropew[(size_t)t * 16 + 8 + j] = __builtin_amdgcn_sinf(rr); } } }
                { const float* sw = INF(9); bf16_t* o = WB + WB_SGUW;
                  for (int i = gt; i < 8 * 128 * 128; i += NGT) { const int s2 = i & 127, t = (i >> 7) & 127; o[i] = f2bf(s2 <= t ? sw[i] : 0.f); } }
            }
            SEAM(0);
            if (IN(1)) REP(1) { PH float* rope = WSF(WS_ROPE); bf16_t* MEMB = (bf16_t*)(ws + WS_MEMB);
#pragma unroll 1
                for (int l = 0; l < 2; ++l) {
                    bf16_t* Wl = WB + WB_LAYER + (size_t)l * WL_SIZE;
                    pg8::Gemm g{MEMB, Wl + WL_XKV, nullptr};
                    const int c2 = bx - 128 - 32 * l;
                    pg8::StaticOrder S; S.init(B * MEM, 2048, F.G, (c2 >= 0 && c2 < 32) ? c2 : (1 << 20), D, D);
                    pg8::EpiBf16 E{(bf16_t*)(ws + WS_MEMKV) + (size_t)l * B * MEM * 2048, 2048, 1.f};
                    GEMM_STD(pg8::EpiBf16, pg8::StaticOrder, D, D, D);
                }
                {
                    pg8::Gemm g{RA, WB + WB_IN0, nullptr};
                    pg8::StaticOrder S; S.init(T, NIN0, F.G, bx, D, D);
                    pg8::EpiInproj0 E{RD, rope};
                    GEMM_STD(pg8::EpiInproj0, pg8::StaticOrder, D, D, D);
                }
            }
            SEAM(1);
            if (IN(2)) REP(2) { PH
                { bf16_t* Wl = WB + WB_LAYER; const bf16_t* KV = (const bf16_t*)(ws + WS_MEMKV);
                  { pg8::Gemm g{KV, Wl + WL_XQ, nullptr}; pg8::SetupOrder<0> S; S.init(bx, 0, 64); pg8::EpiBf16 E{(bf16_t*)(ws + WS_MT), D, QSCALE}; GEMM_STD(pg8::EpiBf16, pg8::SetupOrder<0>, 2048, 1024, 256); }
                  { pg8::Gemm g{Wl + WL_XO, KV, nullptr}; pg8::SetupOrder<1> S; S.init(bx, 64, 64); pg8::EpiBf16 E{(bf16_t*)(ws + WS_NT), D, 1.f}; GEMM_STD(pg8::EpiBf16, pg8::SetupOrder<1>, 1024, 2048, 256); }
                  { pg8::Gemm g{WB + WB_OUT1, WB + WB_POOL, nullptr}; pg8::SetupOrder<2> S; S.init(bx, 128, 16); pg8::EpiBf16 E{WB + WB_WEFF, D, 1.f}; GEMM_STD(pg8::EpiBf16, pg8::SetupOrder<2>, 1024, 256, 256); } }
                phase_swa_sgu(F, RD, INF(6), INF(7), INF(8), WB + WB_SGUW, INF(10), RB);
            }
            SEAM(2);
            if (IN(3)) REP(3) { PH
                pg8::Gemm g{RB, WB + WB_OUT0, nullptr};
                pg8::StaticOrder S; S.init(T, D, F.G, bx, D, D);
                pg8::EpiBf16 E{RC, D, 1.f};
                GEMM_STD(pg8::EpiBf16, pg8::StaticOrder, D, D, D);
            }
            SEAM(3);
            if (IN(4)) REP(4) { PH phase_ln_add(F, RA, RC, INF(12), INF(13), RB); }
            SEAM(4);
        } else {
            if (IN(12)) REP(12) { PH
                pg8::Gemm g{RC, WB + WB_IN1, nullptr};
                pg8::StaticOrder S; S.init(T, D, F.G, bx, D, D);
                pg8::EpiBf16 E{RB, D, 1.f};
                GEMM_STD(pg8::EpiBf16, pg8::StaticOrder, D, D, D);
            }
            SEAM(12);
            if (IN(13)) REP(13) { PH
                { bf16_t* Wl = WB + WB_LAYER + WL_SIZE; const bf16_t* KV = (const bf16_t*)(ws + WS_MEMKV) + (size_t)B * MEM * 2048;
                  { pg8::Gemm g{KV, Wl + WL_XQ, nullptr}; pg8::SetupOrder<0> S; S.init(bx, 0, 64); pg8::EpiBf16 E{(bf16_t*)(ws + WS_MT), D, QSCALE}; GEMM_STD(pg8::EpiBf16, pg8::SetupOrder<0>, 2048, 1024, 256); }
                  { pg8::Gemm g{Wl + WL_XO, KV, nullptr}; pg8::SetupOrder<1> S; S.init(bx, 64, 64); pg8::EpiBf16 E{(bf16_t*)(ws + WS_NT), D, 1.f}; GEMM_STD(pg8::EpiBf16, pg8::SetupOrder<1>, 1024, 2048, 256); } }
                phase_pool(F, RB, RA);
            }
            SEAM(13);
            if (IN(14)) REP(14) { PH
                pg8::Gemm g{RA, WB + WB_WEFF, nullptr};
                pg8::StaticOrder S; S.init(T, D, F.G, bx, D, D);
                pg8::EpiBf16 E{RD, D, 1.f};
                GEMM_STD(pg8::EpiBf16, pg8::StaticOrder, D, D, D);
            }
            SEAM(14);
            if (IN(15)) REP(15) { PH phase_ln_add(F, RC, RD, INF(28), INF(29), RB); }
            SEAM(15);
        }
        if (IN(cbp + 5)) REP(cbp + 5) { PHC
            pg8::Gemm g{X1, (const bf16_t*)(ws + WS_MT), nullptr};
            pg8::BatchOrder S; S.init(T, D, F.G, bx, D, D);
            pg8::EpiSoftmax E{Qb, (LAS float*)(F.lds + 131072)};
            GEMM_STD(pg8::EpiSoftmax, pg8::BatchOrder, D, D, D);
        }
        SEAM(cbp + 5);
        if (IN(cbp + 6)) REP(cbp + 6) { PHC
            pg8::Gemm g{Qb, (const bf16_t*)(ws + WS_NT), nullptr};
            pg8::BatchOrder S; S.init(T, D, F.G, bx, D, D);
            pg8::EpiBf16 E{Y2, D, 1.f};
            GEMM_STD(pg8::EpiBf16, pg8::BatchOrder, D, D, D);
        }
        SEAM(cbp + 6);
        if (IN(cbp + 7)) REP(cbp + 7) { PHC phase_ln_router(F, X1, Y2, INF(cb + 5), INF(cb + 6), X2, (unsigned char*)RD, INF(3), INF(4), WSI(WS_EIDX), WSF(WS_EWGT), WSI(WS_BCNT)); }
        SEAM(cbp + 7);
        if (IN(cbp + 8)) REP(cbp + 8) { PHC phase_moe_book(F, WSI(WS_EIDX), WSI(WS_BCNT), WSI(WS_TOK), WSI(WS_POS), WSI(WS_TILE)); }
        SEAM(cbp + 8);
        if (IN(cbp + 9)) REP(cbp + 9) { PHC const int* tile_e = WSI(WS_TILE); const int* tok = WSI(WS_TOK);
            const int ntiles = __builtin_amdgcn_readfirstlane(tile_e[NTILE]);
            pg8::Gemm g{RD, WBl + WL_GU, tok};
            pg8::MoeOrder S; S.init(ntiles, tile_e, F.G, bx, D, D);
            pg8::EpiGU8 E{(unsigned char*)HS};
            pg8::gemm_phase<pg8::EpiGU8, pg8::MoeOrder, true, true, true, D, D, D, true>(glds, F.tid, g, S, E);
        }
        SEAM(cbp + 9);
        if (IN(cbp + 10)) REP(cbp + 10) { PHC const int* tile_e = WSI(WS_TILE);
            const int ntiles = __builtin_amdgcn_readfirstlane(tile_e[NTILE]);
            pg8::Gemm g{HS, WBl + WL_DN, nullptr};
            pg8::MoeOrder S; S.init(ntiles, tile_e, F.G, bx, DE, DE);
            pg8::EpiBf16 E{DS, D, 1.f / (pg8::F8_HS * pg8::F8_WS)};
            pg8::gemm_phase<pg8::EpiBf16, pg8::MoeOrder, true, true, false, DE, DE, DE, true>(glds, F.tid, g, S, E);
        }
        SEAM(cbp + 10);
        if (IN(cbp + 11)) REP(cbp + 11) { PHC phase_ln_moe(F, X2, DS, WSI(WS_POS), WSF(WS_EWGT), INF(cb + 10), INF(cb + 11), X3, L == 1 ? ka->out : nullptr); }
        SEAM(cbp + 11);
    }
#undef GEMM_STD
#undef IN
#undef SEAM
#undef INF
#undef PH
#undef PHC
#undef WSI
#undef WSF
}
}
using namespace nv;
extern "C" void kernel_launch(void* const* d_in, const int* in_sizes, int n_in, void* d_out, int out_size, void* d_ws, size_t ws_size, hipStream_t stream) {
    (void)in_sizes; (void)out_size;
    if (ws_size < WS_END || n_in != 40) return;
    static int grid = 0;
    if (grid == 0) {
        int dev = 0, cus = 0;
        if (hipGetDevice(&dev) != hipSuccess || hipDeviceGetAttribute(&cus, hipDeviceAttributeMultiprocessorCount, dev) != hipSuccess) { grid = -1; return; }
        if (hipFuncSetAttribute((const void*)mk::mega, hipFuncAttributeMaxDynamicSharedMemorySize, mk::LDS_BYTES) != hipSuccess) { grid = -1; return; }
        int per_cu = 0;
        if (hipOccupancyMaxActiveBlocksPerMultiprocessor(&per_cu, (const void*)mk::mega, mk::NTHREADS, mk::LDS_BYTES) != hipSuccess || per_cu < 1) { (void)hipGetLastError(); }
        grid = cus;
    }
    if (grid < 0) return;
    unsigned char* ws = (unsigned char*)d_ws;
    (void)hipMemsetAsync(ws + WS_CTL, 0, 512 * 1024, stream);
    mk::Args a{};
    for (int i = 0; i < 40; ++i) a.in[i] = d_in[i];
    a.out = (float*)d_out; a.ws = ws;
    for (int j = 0; j < 8; ++j) a.inv.f[j] = (float)pow(500000.0, -(double)((float)j * 2.0f / 16.0f));
    a.ph_lo = 0; a.ph_hi = mk::NPHASE;
    hipLaunchKernelGGL(mk::mega, dim3(grid), dim3(mk::NTHREADS), mk::LDS_BYTES, stream, a);
}
```

```cpp
#include <hip/hip_runtime.h>
#include <stdint.h>
#include <math.h>

typedef unsigned short bf16_t;

namespace nv {
constexpr int B = 4, S = 8192, T = B * S, D = 1024;
constexpr int NIN0 = 1792;
constexpr int MEM = 256, XH = 4, XHD = 256;
constexpr int NE = 16, DE = 512;
constexpr int MPAD = 65536 + 16 * 256;
constexpr int NTILE = MPAD / 256;
constexpr float ALPHA = 1.4142135623730951f;
constexpr float LN_EPS = 1e-5f;
constexpr float QSCALE = 0.0625f * 1.4426950408889634f;
constexpr float ASCALE = 0.125f * 1.4426950408889634f;

constexpr size_t MiB = 1u << 20;
constexpr size_t WS_CTL = 0;
constexpr size_t WS_ROPE = 2 * MiB;
constexpr size_t WS_EIDX = 4 * MiB;
constexpr size_t WS_EWGT = 5 * MiB;
constexpr size_t WS_POS = 6 * MiB;
constexpr size_t WS_BCNT = 7 * MiB;
constexpr size_t WS_TILE = 7 * MiB + 65536;
constexpr size_t WS_TOK = 7 * MiB + 131072;
constexpr size_t WS_MEMKV = 8 * MiB;
constexpr size_t WS_MEMB = 20 * MiB;
constexpr size_t WS_WB = 24 * MiB;
constexpr size_t WS_A = 152 * MiB, WS_B = 220 * MiB, WS_C = 288 * MiB, WS_D = 356 * MiB;
constexpr size_t WS_MT = 492 * MiB;
constexpr size_t WS_NT = 500 * MiB;
constexpr size_t WS_END = 508 * MiB;
constexpr size_t WB_IN0 = 0;
constexpr size_t WB_OUT0 = WB_IN0 + (size_t)1792 * 1024;
constexpr size_t WB_IN1 = WB_OUT0 + (size_t)1024 * 1024;
constexpr size_t WB_POOL = WB_IN1 + (size_t)1024 * 1024;
constexpr size_t WB_OUT1 = WB_POOL + (size_t)1024 * 256;
constexpr size_t WB_WEFF = WB_OUT1 + (size_t)1024 * 1024;
constexpr size_t WB_SGUW = WB_WEFF + (size_t)1024 * 1024;
constexpr size_t WB_LAYER = WB_SGUW + (size_t)8 * 128 * 128;
constexpr size_t WL_XQ = 0;
constexpr size_t WL_XKV = WL_XQ + (size_t)1024 * 1024;
constexpr size_t WL_XO = WL_XKV + (size_t)2048 * 1024;
constexpr size_t WL_GU = WL_XO + (size_t)1024 * 1024;
constexpr size_t WL_DN = WL_GU + (size_t)16 * 1024 * 1024;
constexpr size_t WL_SIZE = WL_DN + (size_t)16 * 1024 * 512;
static_assert((WB_LAYER + 2 * WL_SIZE) * 2 <= 128 * MiB, "bf16 weight region");

__device__ __forceinline__ float bf2f(bf16_t v) { return __uint_as_float((unsigned)v << 16); }
__device__ __forceinline__ bf16_t f2bf(float f) { unsigned u = __float_as_uint(f); return (bf16_t)((u + 0x7fffu + ((u >> 16) & 1u)) >> 16); }
__device__ __forceinline__ float gelu_tanh(float x) { const float u = 0.7978845608028654f * (x + 0.044715f * x * x * x); const float e = __expf(2.f * u); const float th = 1.f - 2.f / (e + 1.f); return 0.5f * x * (1.f + th); }
__device__ __forceinline__ float silu(float x) { return x / (1.f + __expf(-x)); }
template <int M> __device__ __forceinline__ float swz_xor(float v) { return __int_as_float(__builtin_amdgcn_ds_swizzle(__float_as_int(v), (M << 10) | 0x1f)); }
__device__ __forceinline__ float wave_sum(float v) {
    v += swz_xor<1>(v); v += swz_xor<2>(v); v += swz_xor<4>(v); v += swz_xor<8>(v); v += swz_xor<16>(v);
    const auto r = __builtin_amdgcn_permlane32_swap(__float_as_uint(v), __float_as_uint(v), false, false);
    return __uint_as_float(r[0]) + __uint_as_float(r[1]);
}
__device__ __forceinline__ float wave_max(float v) {
    v = fmaxf(v, swz_xor<1>(v)); v = fmaxf(v, swz_xor<2>(v)); v = fmaxf(v, swz_xor<4>(v)); v = fmaxf(v, swz_xor<8>(v)); v = fmaxf(v, swz_xor<16>(v));
    const auto r = __builtin_amdgcn_permlane32_swap(__float_as_uint(v), __float_as_uint(v), false, false);
    return fmaxf(__uint_as_float(r[0]), __uint_as_float(r[1]));
}
}

namespace pg8 {
#define PG8_LAS __attribute__((address_space(3)))
typedef short bf16x8 __attribute__((ext_vector_type(8)));
typedef float f32x4 __attribute__((ext_vector_type(4)));
typedef float f32x2 __attribute__((ext_vector_type(2)));
typedef unsigned u32x4 __attribute__((ext_vector_type(4)));
typedef unsigned u32x2 __attribute__((ext_vector_type(2)));
typedef int i32x8 __attribute__((ext_vector_type(8)));
constexpr int BM = 256, BK = 64, HALF = 128, HTB = HALF * BK * 2  , STAGE_BYTES = 8 * HTB, NXCD = 8, WGM = 8;

__host__ __device__ __forceinline__ int lds_byte(int r, int c) { const int st = (r >> 4) * 2 + (c >> 5), rr = r & 15, cc = c & 31, ob = rr * 64 + cc * 2; return st * 1024 + (ob ^ (((ob >> 9) & 1) << 5)); }
__host__ __device__ __forceinline__ void stage_rc(int b, int& R, int& C) { const int st = b / 1024, sb = b % 1024, swz = sb ^ (((sb >> 9) & 1) << 5); R = (st >> 1) * 16 + swz / 64; C = (st & 1) * 32 + (swz % 64) / 2; }
__host__ __device__ __forceinline__ int perm32(int rho) { const int n = rho >> 4, i = rho & 15; return 8 * (i >> 2) + 4 * n + (i & 3); }

struct Unit { int pm, pn, ao, bo; };
struct Gemm { const bf16_t* A; const bf16_t* Bt; const int* arow; };

template <bool BATCHED = false>
struct StaticOrderT {
    int nM, nN, nwg, G, c, lda, ldb, apn;
    __device__ void init(int M, int N, int G_, int c_, int lda_, int ldb_, int apn_ = 0) { nM = M / BM; nN = N / BM; nwg = nM * nN; G = G_; c = c_; lda = lda_; ldb = ldb_; apn = apn_; }
    __device__ bool next(int i, Unit& u) const {
        const long L = (long)i * G + c; if (L >= nwg) return false;
        int wgid = (int)L; { const int q = nwg / NXCD, r = nwg % NXCD, xcd = wgid % NXCD, off = wgid / NXCD; wgid = (xcd < r ? xcd * (q + 1) : r * (q + 1) + (xcd - r) * q) + off; }
        const int nig = WGM * nN, gid = wgid / nig, fm = gid * WGM, gsz = (nM - fm) < WGM ? (nM - fm) : WGM;
        u.pm = fm + ((wgid % nig) % gsz); u.pn = (wgid % nig) / gsz;
        u.ao = u.pm * BM * lda + u.pn * apn; u.bo = (BATCHED ? ((u.pm >> 5) * 4 + u.pn) : u.pn) * BM * ldb; return true;
    }
};
typedef StaticOrderT<false> StaticOrder;
typedef StaticOrderT<true> BatchOrder;
struct MoeOrder {
    int nM, nwg, G, c, lda, ldb; const int* tile_e;
    __device__ void init(int ntiles, const int* te, int G_, int c_, int lda_, int ldb_) { nM = ntiles; nwg = nM * 4; G = G_; c = c_; tile_e = te; lda = lda_; ldb = ldb_; }
    __device__ bool next(int i, Unit& u) const {
        const long L = (long)i * G + c; if (L >= nwg) return false;
        int wgid = (int)L; { const int q = nwg / NXCD, r = nwg % NXCD, xcd = wgid % NXCD, off = wgid / NXCD; wgid = (xcd < r ? xcd * (q + 1) : r * (q + 1) + (xcd - r) * q) + off; }
        const int nig = WGM * 4, gid = wgid / nig, fm = gid * WGM, gsz = (nM - fm) < WGM ? (nM - fm) : WGM;
        u.pm = fm + ((wgid % nig) % gsz); u.pn = (wgid % nig) / gsz;
        const int e = __builtin_amdgcn_readfirstlane(tile_e[u.pm]); u.ao = u.pm * BM * lda; u.bo = (e * 4 + u.pn) * BM * ldb; return true;
    }
};
template <int KIND>
struct SetupOrder {
    int idx, n;
    __device__ void init(int c, int c0, int n_) { idx = c - c0; n = n_; }
    __device__ bool next(int i, Unit& u) const {
        if (i != 0 || idx < 0 || idx >= n) return false;
        const int x = idx >> 4, y = (idx >> 2) & 3, z = idx & 3;
        if (KIND == 0) { u.pm = x * 4 + y; u.pn = z; u.ao = (x * 256) * 2048 + y * 256; u.bo = z * 256 * 1024 + y * 256; }
        if (KIND == 1) { u.pm = x * 4 + y; u.pn = z; u.ao = y * 256 * 1024 + z * 256; u.bo = (x * 256) * 2048 + 1024 + z * 256; }
        if (KIND == 2) { u.pm = y; u.pn = z; u.ao = y * 256 * 1024 + z * 256; u.bo = z * 256 * 256; }
        return true;
    }
};

__device__ __forceinline__ int fresh_lane() { unsigned m = ~0u; asm volatile("" : "+s"(m)); return (int)__builtin_amdgcn_mbcnt_hi(m, __builtin_amdgcn_mbcnt_lo(m, 0u)); }
__device__ __forceinline__ unsigned cvt_pk_bf16(float lo, float hi) { unsigned r; asm volatile("v_cvt_pk_bf16_f32 %0, %1, %2" : "=v"(r) : "v"(lo), "v"(hi)); return r; }


template <class Epi, class Sched, bool ALIGN_EPI, bool SP2, bool GATHER, int LDA, int LDB, int KK, bool FP8 = false>
__device__ __forceinline__ void gemm_phase(PG8_LAS unsigned char* lds, int tid_in, const Gemm g, const Sched& S, const Epi& E) {
    int tid_ = tid_in; asm volatile("" : "+v"(tid_));
    const int tid = tid_, wid = __builtin_amdgcn_readfirstlane(tid >> 6), lane = tid & 63, wr = wid >> 2, wc = wid & 3, fr = lane & 15, fq = lane >> 4;
    constexpr int ELT = FP8 ? 1 : 2, K = KK, nt = K * ELT / (BK * 2), lda = LDA * ELT, ldb = LDB * ELT; (void)K;
    unsigned voffA[2], voffB[2];
#pragma unroll
    for (int i = 0; i < 2; ++i) { int R, C; stage_rc(tid * 16 + i * 8192, R, C); const int Rb = Epi::PERM ? ((R & ~31) + perm32(R & 31)) : R;
        voffA[i] = GATHER ? (unsigned)C * 2u : (unsigned)(R * lda + C * 2); voffB[i] = (unsigned)(Rb * ldb + C * 2); }
    const size_t kstep = (size_t)(BK * 2);
    const size_t hstepA = GATHER ? 0 : (size_t)HALF * lda, hstepB = (size_t)HALF * ldb;
    const unsigned ldsw = (unsigned)wid * 1024u, ldsbase = (unsigned)(size_t)lds;
    const int aoff = lds_byte(wr * 64 + fr, fq * 8), boff = lds_byte(wc * 32 + fr, fq * 8);
    unsigned cg[2][2];
#define PG8_SA(b, h) (((b) * 2 + (h)) * HTB)
#define PG8_SB(b, h) ((4 + (b) * 2 + (h)) * HTB)
#define PG8_GLDS(sbase, voff32, ldsaddr) asm volatile("s_mov_b32 m0, %2\n\ts_nop 0\n\tglobal_load_lds_dwordx4 %0, %1" :: "v"(voff32), "s"(sbase), "s"(ldsaddr) : "memory", "m0")
#define PG8_STAGE(bufoff, gbase, voff) do { const char* _sb = (const char*)(gbase); _Pragma("unroll") for (int _i = 0; _i < 2; ++_i) \
        PG8_GLDS(_sb, (voff)[_i], (unsigned)(ldsbase + (bufoff) + ldsw + _i * 8192)); } while (0)
#define PG8_STAGE_A(bufoff, abase, h, GO) do { const char* _sb = GATHER ? (const char*)(abase) : (const char*)(abase) + ((h) ? hstepA : (size_t)0); _Pragma("unroll") for (int _i = 0; _i < 2; ++_i) \
        PG8_GLDS(_sb, (GATHER ? GO[h][_i] : voffA[_i]), (unsigned)(ldsbase + (bufoff) + ldsw + _i * 8192)); } while (0)
#define PG8_GLOAD(dst, pm_) do { const int _t = wid * 64 + fresh_lane(); int rowA_[2]; unsigned colA_[2]; _Pragma("unroll") for (int _i = 0; _i < 2; ++_i) { int _R, _C; stage_rc(_t * 16 + _i * 8192, _R, _C); rowA_[_i] = _R; colA_[_i] = (unsigned)_C * 2u; }   \
        _Pragma("unroll") for (int _h = 0; _h < 2; ++_h) _Pragma("unroll") for (int _i = 0; _i < 2; ++_i) \
        dst[_h][_i] = (unsigned)g.arow[(pm_) * BM + _h * HALF + rowA_[_i]] * (unsigned)lda + colA_[_i]; } while (0)
#define PG8_GSWITCH do { if constexpr (GATHER) { if (last && has_next) { PG8_GLOAD(cg, nxt.pm); } } } while (0)
#define PG8_LDA(dst, b, h) do { _Pragma("unroll") for (int m = 0; m < 4; ++m) { if constexpr (FP8) { typedef int i32x4_ __attribute__((ext_vector_type(4))); \
        dst##8[m] = __builtin_shufflevector(*(const PG8_LAS i32x4_*)(lds + PG8_SA(b, h) + aoff + m * 2048), *(const PG8_LAS i32x4_*)(lds + PG8_SA(b, h) + aoff + m * 2048 + 1024), 0, 1, 2, 3, 4, 5, 6, 7); } \
        else { _Pragma("unroll") for (int k = 0; k < 2; ++k) dst[m][k] = *(const PG8_LAS bf16x8*)(lds + PG8_SA(b, h) + aoff + m * 2048 + k * 1024); } } } while (0)
#define PG8_LDB(dst, b, h) do { _Pragma("unroll") for (int n = 0; n < 2; ++n) { if constexpr (FP8) { typedef int i32x4_ __attribute__((ext_vector_type(4))); \
        dst##8[n] = __builtin_shufflevector(*(const PG8_LAS i32x4_*)(lds + PG8_SB(b, h) + boff + n * 2048), *(const PG8_LAS i32x4_*)(lds + PG8_SB(b, h) + boff + n * 2048 + 1024), 0, 1, 2, 3, 4, 5, 6, 7); } \
        else { _Pragma("unroll") for (int k = 0; k < 2; ++k) dst[n][k] = *(const PG8_LAS bf16x8*)(lds + PG8_SB(b, h) + boff + n * 2048 + k * 1024); } } } while (0)
#define PG8_MMA(ai, bj, At, Bt) do { __builtin_amdgcn_s_setprio(1); _Pragma("unroll") for (int m = 0; m < 4; ++m) _Pragma("unroll") for (int n = 0; n < 2; ++n) { \
        if constexpr (FP8) acc[ai][bj][m][n] = __builtin_amdgcn_mfma_scale_f32_16x16x128_f8f6f4(Bt##8[n], At##8[m], acc[ai][bj][m][n], 0, 0, 0, 0x7f7f7f7f, 0, 0x7f7f7f7f); \
        else { _Pragma("unroll") for (int k = 0; k < 2; ++k) acc[ai][bj][m][n] = __builtin_amdgcn_mfma_f32_16x16x32_bf16(Bt[n][k], At[m][k], acc[ai][bj][m][n], 0, 0, 0); } } \
        __builtin_amdgcn_s_setprio(0); } while (0)
#define PG8_WAIT_V(n) asm volatile("s_waitcnt vmcnt(" #n ")" ::: "memory")
#define PG8_WAIT_L(n) asm volatile("s_waitcnt lgkmcnt(" #n ")" ::: "memory")
#define PG8_BAR __builtin_amdgcn_s_barrier()
#define PG8_SCHED __builtin_amdgcn_sched_barrier(0)
    Unit cur, nxt; int ui = 0;
    if (!S.next(0, cur)) return;
    f32x4 acc[2][2][4][2];
#pragma unroll
    for (int a = 0; a < 2; ++a)
#pragma unroll
        for (int b = 0; b < 2; ++b)
#pragma unroll
            for (int m = 0; m < 4; ++m)
#pragma unroll
                for (int n = 0; n < 2; ++n) acc[a][b][m][n] = (f32x4){0.f, 0.f, 0.f, 0.f};
    bf16x8 At[4][2], B0[2][2], B1[2][2]; i32x8 At8[4], B08[2], B18[2];
    const char* cA = GATHER ? (const char*)g.A : (const char*)g.A + (size_t)cur.ao * ELT; const char* cB = (const char*)g.Bt + (size_t)cur.bo * ELT;
    if constexpr (GATHER) { PG8_GLOAD(cg, cur.pm); }
    if constexpr (SP2) {
        PG8_STAGE(PG8_SB(0, 0), cB, voffB); PG8_STAGE(PG8_SB(0, 1), cB + hstepB, voffB); PG8_STAGE_A(PG8_SA(0, 0), cA, 0, cg); PG8_STAGE_A(PG8_SA(0, 1), cA, 1, cg);
        if (wr == 1) PG8_BAR;
        PG8_WAIT_V(2); PG8_BAR;
        PG8_STAGE(PG8_SB(1, 0), cB + kstep, voffB); PG8_STAGE_A(PG8_SA(1, 0), cA + kstep, 0, cg); PG8_STAGE(PG8_SB(1, 1), cB + hstepB + kstep, voffB);
        PG8_WAIT_V(6); PG8_BAR;
    } else {
        PG8_STAGE(PG8_SB(0, 0), cB, voffB); PG8_STAGE_A(PG8_SA(0, 0), cA, 0, cg); PG8_STAGE(PG8_SB(0, 1), cB + hstepB, voffB); PG8_STAGE_A(PG8_SA(0, 1), cA, 1, cg);
        if (wr == 1) PG8_BAR;
        PG8_WAIT_V(4); PG8_BAR;
        PG8_STAGE(PG8_SB(1, 0), cB + kstep, voffB); PG8_STAGE_A(PG8_SA(1, 0), cA + kstep, 0, cg); PG8_STAGE(PG8_SB(1, 1), cB + hstepB + kstep, voffB);
        PG8_WAIT_V(6); PG8_BAR;
    }
    for (;;) {
        const bool has_next = S.next(ui + 1, nxt);
        const char* nA = GATHER ? (const char*)g.A : (has_next ? (const char*)g.A + (size_t)nxt.ao * ELT : cA);
        const char* nB = has_next ? (const char*)g.Bt + (size_t)nxt.bo * ELT : cB;
#pragma unroll 1
        for (int t = 0; t < nt; t += 2) {
            const bool last = (t == nt - 2);
            const char* a1 = cA + (size_t)(t + 1) * kstep;
            const char* a2 = last ? nA : cA + (size_t)(t + 2) * kstep; const char* b2 = last ? nB : cB + (size_t)(t + 2) * kstep;
            const char* a3 = a2 + kstep; const char* b3 = b2 + kstep;
            if constexpr (SP2) {
            PG8_LDB(B0, 0, 0); PG8_LDB(B1, 0, 1); PG8_SCHED; PG8_LDA(At, 0, 0); PG8_STAGE_A(PG8_SA(1, 1), a1, 1, cg); PG8_GSWITCH;
            PG8_WAIT_V(8); PG8_WAIT_L(0); PG8_BAR; PG8_MMA(0, 0, At, B0); PG8_MMA(0, 1, At, B1); PG8_BAR; PG8_SCHED;
            PG8_LDA(At, 0, 1); PG8_STAGE(PG8_SB(0, 0), b2, voffB); PG8_STAGE(PG8_SB(0, 1), b2 + hstepB, voffB); PG8_STAGE_A(PG8_SA(0, 0), a2, 0, cg);
            PG8_WAIT_V(8); PG8_WAIT_L(0); PG8_BAR; PG8_MMA(1, 0, At, B0); PG8_MMA(1, 1, At, B1); PG8_BAR; PG8_SCHED;
            PG8_LDB(B0, 1, 0); PG8_LDB(B1, 1, 1); PG8_SCHED; PG8_LDA(At, 1, 0); PG8_STAGE_A(PG8_SA(0, 1), a2, 1, cg);
            PG8_WAIT_V(8); PG8_WAIT_L(0); PG8_BAR; PG8_MMA(0, 0, At, B0); PG8_MMA(0, 1, At, B1); PG8_BAR; PG8_SCHED;
            PG8_LDA(At, 1, 1); PG8_STAGE(PG8_SB(1, 0), b3, voffB); PG8_STAGE(PG8_SB(1, 1), b3 + hstepB, voffB); PG8_STAGE_A(PG8_SA(1, 0), a3, 0, cg);
            PG8_WAIT_V(8); PG8_WAIT_L(0); PG8_BAR; PG8_MMA(1, 0, At, B0); PG8_MMA(1, 1, At, B1); PG8_BAR; PG8_SCHED;
            } else {
            PG8_LDB(B0, 0, 0); PG8_SCHED; PG8_LDA(At, 0, 0); PG8_STAGE_A(PG8_SA(1, 1), a1, 1, cg); PG8_GSWITCH;
            PG8_WAIT_L(8); PG8_BAR; PG8_WAIT_L(0); PG8_MMA(0, 0, At, B0); PG8_BAR; PG8_SCHED;
            PG8_LDB(B1, 0, 1); PG8_STAGE(PG8_SB(0, 0), b2, voffB);
            PG8_BAR; PG8_WAIT_L(0); PG8_MMA(0, 1, At, B1); PG8_BAR;
            PG8_LDA(At, 0, 1); PG8_STAGE_A(PG8_SA(0, 0), a2, 0, cg);
            PG8_BAR; PG8_WAIT_L(0); PG8_MMA(1, 0, At, B0); PG8_BAR; PG8_SCHED;
            PG8_STAGE(PG8_SB(0, 1), b2 + hstepB, voffB);
            PG8_WAIT_V(6); PG8_BAR; PG8_MMA(1, 1, At, B1); PG8_BAR;
            PG8_LDB(B0, 1, 0); PG8_SCHED; PG8_LDA(At, 1, 0); PG8_STAGE_A(PG8_SA(0, 1), a2, 1, cg);
            PG8_WAIT_L(8); PG8_BAR; PG8_WAIT_L(0); PG8_MMA(0, 0, At, B0); PG8_BAR; PG8_SCHED;
            PG8_LDB(B1, 1, 1); PG8_STAGE(PG8_SB(1, 0), b3, voffB);
            PG8_BAR; PG8_WAIT_L(0); PG8_MMA(0, 1, At, B1); PG8_BAR;
            PG8_LDA(At, 1, 1); PG8_STAGE_A(PG8_SA(1, 0), a3, 0, cg);
            PG8_BAR; PG8_WAIT_L(0); PG8_MMA(1, 0, At, B0); PG8_BAR; PG8_SCHED;
            PG8_STAGE(PG8_SB(1, 1), b3 + hstepB, voffB);
            PG8_WAIT_V(6); PG8_BAR; PG8_MMA(1, 1, At, B1); PG8_BAR;
            }
        }
        if constexpr (ALIGN_EPI) { if (wr == 0) PG8_BAR; }
        { const int _l = fresh_lane(); E(acc, cur, wr, wc, _l & 15, _l >> 4); }
        if (!has_next) break;
#pragma unroll
        for (int a = 0; a < 2; ++a)
#pragma unroll
            for (int b = 0; b < 2; ++b)
#pragma unroll
                for (int m = 0; m < 4; ++m)
#pragma unroll
                    for (int n = 0; n < 2; ++n) acc[a][b][m][n] = (f32x4){0.f, 0.f, 0.f, 0.f};
        cur = nxt; cA = nA; cB = nB; ++ui;
        if constexpr (ALIGN_EPI) { if (wr == 1) PG8_BAR; }
    }
    PG8_WAIT_V(0);
    if constexpr (!ALIGN_EPI) { if (wr == 0) PG8_BAR; }
    PG8_BAR;
#undef PG8_SA
#undef PG8_SB
#undef PG8_STAGE
#undef PG8_GLDS
#undef PG8_STAGE_A
#undef PG8_GLOAD
#undef PG8_GSWITCH
#undef PG8_LDA
#undef PG8_LDB
#undef PG8_MMA
#undef PG8_WAIT_V
#undef PG8_WAIT_L
#undef PG8_BAR
#undef PG8_SCHED
}
}
namespace pg8 {

__device__ __forceinline__ float fast_sigmoid_mul(float x, float z) { return x * __builtin_amdgcn_rcpf(1.f + __builtin_amdgcn_exp2f(-1.4426950408889634f * z)); }
__device__ __forceinline__ float gelu_t(float x) { const float u = 0.7978845608028654f * (x + 0.044715f * x * x * x); return fast_sigmoid_mul(x, 2.f * u); }
__device__ __forceinline__ float silu_f(float x) { return fast_sigmoid_mul(x, x); }
__device__ __forceinline__ u32x4 pack8(const f32x4 v0, const f32x4 v1) { u32x4 w; w.x = cvt_pk_bf16(v0[0], v0[1]); w.y = cvt_pk_bf16(v0[2], v0[3]); w.z = cvt_pk_bf16(v1[0], v1[1]); w.w = cvt_pk_bf16(v1[2], v1[3]); return w; }

struct EpiBf16 {
    static constexpr bool PERM = true;
    bf16_t* O; int ldo; float scale;
    __device__ __forceinline__ void operator()(f32x4 (&acc)[2][2][4][2], const Unit& u, int wr, int wc, int fr, int fq) const {
        const int row0 = u.pm * BM + wr * 64 + fr, col0 = u.pn * BM + wc * 32 + 8 * fq;
#pragma unroll
        for (int ai = 0; ai < 2; ++ai)
#pragma unroll
            for (int m = 0; m < 4; ++m) { bf16_t* rowp = O + (size_t)(row0 + ai * HALF + m * 16) * ldo + col0;
#pragma unroll
                for (int bj = 0; bj < 2; ++bj) *(u32x4*)(rowp + bj * HALF) = pack8(acc[ai][bj][m][0] * scale, acc[ai][bj][m][1] * scale); }
    }
};
__device__ __forceinline__ unsigned pk4_fp8(float a, float b, float c, float d) {
    a = __builtin_amdgcn_fmed3f(a, -448.f, 448.f); b = __builtin_amdgcn_fmed3f(b, -448.f, 448.f); c = __builtin_amdgcn_fmed3f(c, -448.f, 448.f); d = __builtin_amdgcn_fmed3f(d, -448.f, 448.f);
    unsigned p = 0u; p = (unsigned)__builtin_amdgcn_cvt_pk_fp8_f32(a, b, (int)p, false); p = (unsigned)__builtin_amdgcn_cvt_pk_fp8_f32(c, d, (int)p, true); return p;
}
constexpr float F8_XS = 16.f, F8_WS = 64.f, F8_HS = 8.f;
struct EpiF8 {
    static constexpr bool PERM = true;
    unsigned char* O; int ldo; float scale;
    __device__ __forceinline__ void operator()(f32x4 (&acc)[2][2][4][2], const Unit& u, int wr, int wc, int fr, int fq) const {
        const int row0 = u.pm * BM + wr * 64 + fr, col0 = u.pn * BM + wc * 32 + 8 * fq;
#pragma unroll
        for (int ai = 0; ai < 2; ++ai)
#pragma unroll
            for (int m = 0; m < 4; ++m) { unsigned char* rowp = O + (size_t)(row0 + ai * HALF + m * 16) * ldo + col0;
#pragma unroll
                for (int bj = 0; bj < 2; ++bj) { const f32x4 v0 = acc[ai][bj][m][0] * scale, v1 = acc[ai][bj][m][1] * scale;
                    u32x2 w; w.x = pk4_fp8(v0[0], v0[1], v0[2], v0[3]); w.y = pk4_fp8(v1[0], v1[1], v1[2], v1[3]); *(u32x2*)(rowp + bj * HALF) = w; } }
    }
};
constexpr float F8_MS = 64.f, F8_PS = 256.f, F8_NS = 16.f;
struct EpiGU8 {
    static constexpr bool PERM = true;
    unsigned char* HS8;
    __device__ __forceinline__ void operator()(f32x4 (&acc)[2][2][4][2], const Unit& u, int wr, int wc, int fr, int fq) const {
        const int row0 = u.pm * BM + wr * 64 + fr, col0 = u.pn * HALF + wc * 32 + 8 * fq;
        constexpr float s = 1.f / (F8_XS * F8_WS);
#pragma unroll
        for (int ai = 0; ai < 2; ++ai)
#pragma unroll
            for (int m = 0; m < 4; ++m) { unsigned char* rowp = HS8 + (size_t)(row0 + ai * HALF + m * 16) * nv::DE + col0;
                f32x4 h0, h1;
#pragma unroll
                for (int j = 0; j < 4; ++j) { h0[j] = silu_f(acc[ai][0][m][0][j] * s) * (acc[ai][1][m][0][j] * (s * F8_HS)); h1[j] = silu_f(acc[ai][0][m][1][j] * s) * (acc[ai][1][m][1][j] * (s * F8_HS)); }
                u32x2 w; w.x = pk4_fp8(h0[0], h0[1], h0[2], h0[3]); w.y = pk4_fp8(h1[0], h1[1], h1[2], h1[3]); *(u32x2*)rowp = w; }
    }
};
struct EpiGU {
    static constexpr bool PERM = true;
    bf16_t* HS;
    __device__ __forceinline__ void operator()(f32x4 (&acc)[2][2][4][2], const Unit& u, int wr, int wc, int fr, int fq) const {
        const int row0 = u.pm * BM + wr * 64 + fr, col0 = u.pn * HALF + wc * 32 + 8 * fq;
#pragma unroll
        for (int ai = 0; ai < 2; ++ai)
#pragma unroll
            for (int m = 0; m < 4; ++m) { bf16_t* rowp = HS + (size_t)(row0 + ai * HALF + m * 16) * nv::DE + col0;
                f32x4 h0, h1;
#pragma unroll
                for (int j = 0; j < 4; ++j) { h0[j] = silu_f(acc[ai][0][m][0][j]) * acc[ai][1][m][0][j]; h1[j] = silu_f(acc[ai][0][m][1][j]) * acc[ai][1][m][1][j]; }
                *(u32x4*)rowp = pack8(h0, h1); }
    }
};
template <bool OUT8>
struct EpiSoftmaxT {
    static constexpr bool PERM = true;
    void* O; PG8_LAS float* tbl; float in_scale;
    __device__ __forceinline__ void operator()(f32x4 (&acc)[2][2][4][2], const Unit& u, int wr, int wc, int fr, int fq) const {
        const int row0 = u.pm * BM + wr * 64 + fr, col0 = u.pn * BM + wc * 32 + 8 * fq;
#pragma unroll
        for (int ai = 0; ai < 2; ++ai)
#pragma unroll
            for (int m = 0; m < 4; ++m) { float mx = -INFINITY;
#pragma unroll
                for (int bj = 0; bj < 2; ++bj)
#pragma unroll
                    for (int n = 0; n < 2; ++n)
#pragma unroll
                        for (int j = 0; j < 4; ++j) { acc[ai][bj][m][n][j] *= in_scale; mx = fmaxf(mx, acc[ai][bj][m][n][j]); }
                mx = fmaxf(mx, nv::swz_xor<16>(mx));
                { const auto r = __builtin_amdgcn_permlane32_swap(__float_as_uint(mx), __float_as_uint(mx), false, false); mx = fmaxf(__uint_as_float(r[0]), __uint_as_float(r[1])); }
                if (fq == 0) tbl[(ai * HALF + wr * 64 + m * 16 + fr) * 4 + wc] = mx; }
        asm volatile("s_waitcnt lgkmcnt(0)" ::: "memory"); __builtin_amdgcn_s_barrier(); asm volatile("" ::: "memory");
#pragma unroll
        for (int ai = 0; ai < 2; ++ai)
#pragma unroll
            for (int m = 0; m < 4; ++m) { const f32x4 t4 = *(const PG8_LAS f32x4*)(tbl + (ai * HALF + wr * 64 + m * 16 + fr) * 4);
                const float M = fmaxf(fmaxf(t4[0], t4[1]), fmaxf(t4[2], t4[3])); float s = 0.f;
#pragma unroll
                for (int bj = 0; bj < 2; ++bj)
#pragma unroll
                    for (int n = 0; n < 2; ++n)
#pragma unroll
                        for (int j = 0; j < 4; ++j) { const float p = __builtin_amdgcn_exp2f(acc[ai][bj][m][n][j] - M); acc[ai][bj][m][n][j] = p; s += p; }
                s += nv::swz_xor<16>(s);
                { const auto r = __builtin_amdgcn_permlane32_swap(__float_as_uint(s), __float_as_uint(s), false, false); s = __uint_as_float(r[0]) + __uint_as_float(r[1]); }
                if (fq == 0) tbl[1024 + (ai * HALF + wr * 64 + m * 16 + fr) * 4 + wc] = s; }
        asm volatile("s_waitcnt lgkmcnt(0)" ::: "memory"); __builtin_amdgcn_s_barrier(); asm volatile("" ::: "memory");
#pragma unroll
        for (int ai = 0; ai < 2; ++ai)
#pragma unroll
            for (int m = 0; m < 4; ++m) { const f32x4 t4 = *(const PG8_LAS f32x4*)(tbl + 1024 + (ai * HALF + wr * 64 + m * 16 + fr) * 4);
                const float inv = 1.f / ((t4[0] + t4[1]) + (t4[2] + t4[3]));
                if constexpr (OUT8) { unsigned char* rowp = (unsigned char*)O + (size_t)(row0 + ai * HALF + m * 16) * nv::D + col0; const float s8 = inv * F8_PS;
#pragma unroll
                    for (int bj = 0; bj < 2; ++bj) { const f32x4 v0 = acc[ai][bj][m][0] * s8, v1 = acc[ai][bj][m][1] * s8;
                        u32x2 w; w.x = pk4_fp8(v0[0], v0[1], v0[2], v0[3]); w.y = pk4_fp8(v1[0], v1[1], v1[2], v1[3]); *(u32x2*)(rowp + bj * HALF) = w; } }
                else { bf16_t* rowp = (bf16_t*)O + (size_t)(row0 + ai * HALF + m * 16) * nv::D + col0;
#pragma unroll
                    for (int bj = 0; bj < 2; ++bj) *(u32x4*)(rowp + bj * HALF) = pack8(acc[ai][bj][m][0] * inv, acc[ai][bj][m][1] * inv); } }
    }
};
struct EpiInproj0 {
    static constexpr bool PERM = true;
    bf16_t* O; const float* rope;
    __device__ __forceinline__ void operator()(f32x4 (&acc)[2][2][4][2], const Unit& u, int wr, int wc, int fr, int fq) const {
        const int row0 = u.pm * BM + wr * 64 + fr, col0 = u.pn * BM + wc * 32 + 8 * fq;
        if (u.pn >= 3) {
#pragma unroll
            for (int ai = 0; ai < 2; ++ai)
#pragma unroll
                for (int m = 0; m < 4; ++m) { bf16_t* rowp = O + (size_t)(row0 + ai * HALF + m * 16) * nv::NIN0 + col0;
#pragma unroll
                    for (int bj = 0; bj < 2; ++bj) { f32x4 v0 = acc[ai][bj][m][0], v1 = acc[ai][bj][m][1];
#pragma unroll
                        for (int j = 0; j < 4; ++j) { v0[j] = gelu_t(v0[j]); v1[j] = gelu_t(v1[j]); }
                        *(u32x4*)(rowp + bj * HALF) = pack8(v0, v1); } }
        } else {
            const bool wave_rope = (wc & 1) == 0;
            const float sgn = fq == 0 ? -1.f : 1.f;
#pragma unroll
            for (int ai = 0; ai < 2; ++ai)
#pragma unroll
                for (int m = 0; m < 4; ++m) { const int row = row0 + ai * HALF + m * 16; bf16_t* rowp = O + (size_t)row * nv::NIN0 + col0;
                    f32x4 c0, c1, s0, s1;
                    if (wave_rope) { const float* rp = rope + (size_t)row * 16; c0 = *(const f32x4*)rp; c1 = *(const f32x4*)(rp + 4); s0 = *(const f32x4*)(rp + 8); s1 = *(const f32x4*)(rp + 12); }
#pragma unroll
                    for (int bj = 0; bj < 2; ++bj) { f32x4 v0 = acc[ai][bj][m][0], v1 = acc[ai][bj][m][1];
                        if (wave_rope && (u.pn < 2 || bj == 0)) {
                            f32x4 p0, p1;
#pragma unroll
                            for (int j = 0; j < 4; ++j) { p0[j] = nv::swz_xor<16>(v0[j]); p1[j] = nv::swz_xor<16>(v1[j]); }
                            if (fq < 2) {
#pragma unroll
                                for (int j = 0; j < 4; ++j) { v0[j] = v0[j] * c0[j] + sgn * p0[j] * s0[j]; v1[j] = v1[j] * c1[j] + sgn * p1[j] * s1[j]; } }
                        }
                        *(u32x4*)(rowp + bj * HALF) = pack8(v0, v1); } }
        }
    }
};
}

#define LAS __attribute__((address_space(3)))
#define GAS __attribute__((address_space(1)))
typedef GAS unsigned gu32;
#define RLX_AGENT __ATOMIC_RELAXED, __HIP_MEMORY_SCOPE_AGENT
#define LDS_WAIT() asm volatile("s_waitcnt lgkmcnt(0)" ::: "memory")
#define VM_WAIT() asm volatile("s_waitcnt vmcnt(0)" ::: "memory")

#define XB_TMO      128
#define XB_XCNT(j)  (256  + 64 * (j))
#define XB_XSUB(j)  (1280 + 64 * (j))
#define XB_XGEN(j)  (2304 + 64 * (j))
#define XB_TOP      3328
#define XB_TOPGEN   3392
#define XCD_BAR_WORDS 3456
#define XB_SPIN_CAP (1u << 18)
__device__ __forceinline__ unsigned xb_ld(unsigned* p)              { return __hip_atomic_load(p, __ATOMIC_RELAXED, __HIP_MEMORY_SCOPE_AGENT); }
__device__ __forceinline__ unsigned xb_add(unsigned* p, unsigned v) { return __hip_atomic_fetch_add(p, v, __ATOMIC_RELAXED, __HIP_MEMORY_SCOPE_AGENT); }
__device__ __forceinline__ unsigned xb_xcc_id() { return (unsigned)__builtin_amdgcn_s_getreg((3 << 11) | 20) & 0xFu; }
#define XB_SPIN(cond, bar) do { unsigned _sp = 0; while (cond) { __builtin_amdgcn_s_sleep(1); \
    if ((++_sp & 255u) == 0u) { if (xb_ld(&(bar)[XB_TMO])) break; if (_sp > XB_SPIN_CAP) { atomicAdd(&(bar)[XB_TMO], 1u); break; } } } } while (0)
struct XcdBarrier { unsigned* bar; unsigned x; volatile LAS unsigned* st; int wave; };
__device__ __forceinline__ unsigned lane_id_fresh() { unsigned m = ~0u; asm volatile("" : "+s"(m)); return __builtin_amdgcn_mbcnt_hi(m, __builtin_amdgcn_mbcnt_lo(m, 0u)); }
__device__ __forceinline__ bool xb_thread0(int wave) { return wave == 0 && lane_id_fresh() == 0u; }
__device__ __forceinline__ XcdBarrier xcd_barrier_post(unsigned* bar, volatile LAS unsigned* st, int wave) {
    XcdBarrier b; b.bar = bar; b.x = xb_xcc_id(); b.st = st; b.wave = wave;
    if (xb_thread0(wave)) (void)xb_add(&bar[XB_XCNT(b.x)], 1u);
    return b;
}
__device__ __forceinline__ void xcd_barrier_complete(unsigned* bar, unsigned x, unsigned& nloc, unsigned& nx) {
    const unsigned G = gridDim.x * gridDim.y * gridDim.z;
    unsigned sum, cnt, mine, sp = 0u;
    for (;;) {
        sum = 0u; cnt = 0u; mine = 0u;
#pragma unroll
        for (unsigned j = 0; j < 16; ++j) { const unsigned c = xb_ld(&bar[XB_XCNT(j)]); sum += c; cnt += (c > 0u) ? 1u : 0u; mine = (j == x) ? c : mine; }
        if (sum == G) break;
        __builtin_amdgcn_s_sleep(1);
        if ((++sp & 255u) == 0u) { if (xb_ld(&bar[XB_TMO])) break; if (sp > XB_SPIN_CAP) { atomicAdd(&bar[XB_TMO], 1u); break; } }
    }
    nloc = mine > 0u ? mine : 1u; nx = cnt > 0u ? cnt : 1u;
}
__device__ __forceinline__ void xcd_barrier(const XcdBarrier& b) {
    asm volatile("s_waitcnt vmcnt(0)" ::: "memory");
    __syncthreads();
    if (xb_thread0(b.wave)) {
        unsigned* bar = b.bar;
        __builtin_amdgcn_s_waitcnt(0);
        unsigned nloc = b.st[0], nx = b.st[1];
        if (nloc == 0u) { xcd_barrier_complete(bar, b.x, nloc, nx); b.st[0] = nloc; b.st[1] = nx; }
        const unsigned old = xb_add(&bar[XB_XSUB(b.x)], 1u);
        const unsigned gen = old / nloc;
        if (old + 1u == (gen + 1u) * nloc) {
            __builtin_amdgcn_fence(__ATOMIC_RELEASE, "agent");
            asm volatile("s_waitcnt vmcnt(0)" ::: "memory");
            const unsigned og = xb_add(&bar[XB_TOP], 1u);
            const unsigned tg = og / nx;
            if (og + 1u == (tg + 1u) * nx) xb_add(&bar[XB_TOPGEN], 1u);
            else XB_SPIN(xb_ld(&bar[XB_TOPGEN]) == tg, bar);
            __builtin_amdgcn_fence(__ATOMIC_ACQUIRE, "agent");
            xb_add(&bar[XB_XGEN(b.x)], 1u);
            asm volatile("s_waitcnt vmcnt(0)" ::: "memory");
        } else {
            XB_SPIN(xb_ld(&bar[XB_XGEN(b.x)]) == gen, bar);
            __builtin_amdgcn_fence(__ATOMIC_ACQUIRE, "agent");
            asm volatile("s_waitcnt vmcnt(0)" ::: "memory");
        }
    }
    __syncthreads();
}

namespace mk {
using namespace nv;
typedef unsigned v4u __attribute__((ext_vector_type(4)));
typedef unsigned v2u __attribute__((ext_vector_type(2)));
typedef float f32x4 __attribute__((ext_vector_type(4)));
constexpr int NWAVES = 8, NTHREADS = 512;
constexpr int LDS_BYTES = 160 * 1024;
constexpr int MISC_OFF = LDS_BYTES - 256;
constexpr int CW_BAR = 4096;
constexpr size_t CTL_ZERO_BYTES = 64 * 1024;

__device__ __forceinline__ unsigned pk2(float lo, float hi) { return (unsigned)f2bf(lo) | ((unsigned)f2bf(hi) << 16); }

struct Frame {
    LAS unsigned char* lds; int tid, lane, wave, vcu, G, bx;
};

template <bool F8>
__device__ __forceinline__ void transpose_item(const float* W, int ldw, void* WT, int ldt, int k0, int n0, int dest_row0, LAS float* scr, int lane, float wscale) {
#pragma unroll 8
    for (int i = 0; i < 32; ++i) { const int kk = 2 * i + (lane >> 5); scr[kk * 33 + (lane & 31)] = W[(size_t)(k0 + kk) * ldw + n0 + (lane & 31)] * wscale; }
    LDS_WAIT(); asm volatile("" ::: "memory");
    const int c = lane & 7;
#pragma unroll
    for (int j = 0; j < 4; ++j) { const int n = (lane >> 3) + 8 * j; const LAS float* s = scr + (8 * c) * 33 + n;
        if constexpr (F8) { v2u o; o.x = pg8::pk4_fp8(s[0 * 33], s[1 * 33], s[2 * 33], s[3 * 33]); o.y = pg8::pk4_fp8(s[4 * 33], s[5 * 33], s[6 * 33], s[7 * 33]);
            *(v2u*)((unsigned char*)WT + (size_t)(dest_row0 + n) * ldt + k0 + 8 * c) = o; }
        else { v4u o; o.x = pk2(s[0 * 33], s[1 * 33]); o.y = pk2(s[2 * 33], s[3 * 33]); o.z = pk2(s[4 * 33], s[5 * 33]); o.w = pk2(s[6 * 33], s[7 * 33]);
            *(v4u*)((bf16_t*)WT + (size_t)(dest_row0 + n) * ldt + k0 + 8 * c) = o; } }
    LDS_WAIT(); asm volatile("" ::: "memory");
}
template <int MAP, bool F8>
__device__ __forceinline__ void transpose_job_item(const float* src, int K, int N, void* dst, size_t dstb, int r, LAS float* scr, int lane) {
    const int nblk = N / 32, per = (K / 64) * nblk, bi = r / per, it = r % per, kb = it / nblk, nb = it % nblk, n0 = 32 * nb;
    int dr = n0; if (MAP == 1) dr = (n0 >> 7) * 256 + (n0 & 127); if (MAP == 2) dr = (n0 >> 7) * 256 + 128 + (n0 & 127);
    transpose_item<F8>(src + (size_t)bi * K * N, N, (unsigned char*)dst + (size_t)bi * dstb * (F8 ? 1 : 2), K, 64 * kb, n0, dr, scr, lane, F8 ? pg8::F8_WS : 1.f);
}

struct InvFreq { float f[8]; };
struct Args {
    const void* in[40]; float* out; unsigned char* ws; InvFreq inv; int ph_lo, ph_hi;
};

struct RowV { float v[16]; };
__device__ __forceinline__ void unpk8(const v4u u, float* x) {
    x[0] = __uint_as_float(u.x << 16); x[1] = __uint_as_float(u.x & 0xffff0000u); x[2] = __uint_as_float(u.y << 16); x[3] = __uint_as_float(u.y & 0xffff0000u);
    x[4] = __uint_as_float(u.z << 16); x[5] = __uint_as_float(u.z & 0xffff0000u); x[6] = __uint_as_float(u.w << 16); x[7] = __uint_as_float(u.w & 0xffff0000u);
}
struct RowRaw { v4u a, b; };
__device__ __forceinline__ RowRaw load_raw(const bf16_t* p, int lane) { RowRaw r; r.a = *(const v4u*)(p + 8 * lane); r.b = *(const v4u*)(p + 512 + 8 * lane); return r; }
__device__ __forceinline__ void unpack_row(const RowRaw& r, RowV& x) { unpk8(r.a, x.v); unpk8(r.b, x.v + 8); }
struct GB { float g[16], b[16]; };
__device__ __forceinline__ void load_gb(const float* g, const float* b, int lane, GB& o) {
#pragma unroll
    for (int hh = 0; hh < 2; ++hh)
#pragma unroll
        for (int q = 0; q < 2; ++q) { const float4 gg = *(const float4*)(g + 512 * hh + 8 * lane + 4 * q), bb = *(const float4*)(b + 512 * hh + 8 * lane + 4 * q);
            o.g[8 * hh + 4 * q + 0] = gg.x; o.g[8 * hh + 4 * q + 1] = gg.y; o.g[8 * hh + 4 * q + 2] = gg.z; o.g[8 * hh + 4 * q + 3] = gg.w;
            o.b[8 * hh + 4 * q + 0] = bb.x; o.b[8 * hh + 4 * q + 1] = bb.y; o.b[8 * hh + 4 * q + 2] = bb.z; o.b[8 * hh + 4 * q + 3] = bb.w; }
}
__device__ __forceinline__ void ln_rowv(RowV& z, const GB& gb) {
    float s = 0.f;
#pragma unroll
    for (int i = 0; i < 16; ++i) s += z.v[i];
    const float mu = wave_sum(s) * (1.f / D);
    float q = 0.f;
#pragma unroll
    for (int i = 0; i < 16; ++i) { z.v[i] -= mu; q += z.v[i] * z.v[i]; }
    const float rstd = 1.f / sqrtf(wave_sum(q) * (1.f / D) + LN_EPS);
#pragma unroll
    for (int i = 0; i < 16; ++i) z.v[i] = z.v[i] * rstd * gb.g[i] + gb.b[i];
}
__device__ __forceinline__ void store_rowv_bf16(bf16_t* p, int lane, const RowV& r) {
    v4u a, b; a.x = pk2(r.v[0], r.v[1]); a.y = pk2(r.v[2], r.v[3]); a.z = pk2(r.v[4], r.v[5]); a.w = pk2(r.v[6], r.v[7]);
    b.x = pk2(r.v[8], r.v[9]); b.y = pk2(r.v[10], r.v[11]); b.z = pk2(r.v[12], r.v[13]); b.w = pk2(r.v[14], r.v[15]);
    *(v4u*)(p + 8 * lane) = a; *(v4u*)(p + 512 + 8 * lane) = b;
}
__device__ __forceinline__ void store_rowv_fp8(unsigned char* p, int lane, const RowV& r, float s) {
    v2u a, b; a.x = pg8::pk4_fp8(r.v[0] * s, r.v[1] * s, r.v[2] * s, r.v[3] * s); a.y = pg8::pk4_fp8(r.v[4] * s, r.v[5] * s, r.v[6] * s, r.v[7] * s);
    b.x = pg8::pk4_fp8(r.v[8] * s, r.v[9] * s, r.v[10] * s, r.v[11] * s); b.y = pg8::pk4_fp8(r.v[12] * s, r.v[13] * s, r.v[14] * s, r.v[15] * s);
    *(v2u*)(p + 8 * lane) = a; *(v2u*)(p + 512 + 8 * lane) = b;
}
constexpr int LNR = 4;

__device__ __forceinline__ void phase_ln_add(const Frame& F, const bf16_t* X, const bf16_t* Y, const float* g, const float* b, bf16_t* out, unsigned char* out8) {
    const int gw = F.vcu * NWAVES + F.wave, NGW = F.G * NWAVES;
    GB gb; load_gb(g, b, F.lane, gb);
    for (int row = gw; row < T; row += LNR * NGW) {
        RowRaw rx[LNR], ry[LNR];
#pragma unroll
        for (int k = 0; k < LNR; ++k) { const int rr = row + k * NGW; if (rr < T) { rx[k] = load_raw(X + (size_t)rr * D, F.lane); ry[k] = load_raw(Y + (size_t)rr * D, F.lane); } }
#pragma unroll
        for (int k = 0; k < LNR; ++k) { const int rr = row + k * NGW; if (rr < T) {
            RowV x, y; unpack_row(rx[k], x); unpack_row(ry[k], y);
#pragma unroll
            for (int i = 0; i < 16; ++i) x.v[i] = ALPHA * x.v[i] + y.v[i];
            ln_rowv(x, gb);
            store_rowv_bf16(out + (size_t)rr * D, F.lane, x);
            store_rowv_fp8(out8 + (size_t)rr * D, F.lane, x, pg8::F8_XS); } }
    }
}
__device__ __forceinline__ void phase_ln_moe(const Frame& F, const bf16_t* X, const bf16_t* DS, const int* pos, const float* ewgt, const float* g, const float* b, bf16_t* outb, float* outf) {
    const int gw = F.vcu * NWAVES + F.wave, NGW = F.G * NWAVES;
    GB gb; load_gb(g, b, F.lane, gb);
    for (int row = gw; row < T; row += LNR * NGW) {
        RowRaw rx[LNR], r1[LNR], r2[LNR]; float w1[LNR], w2[LNR];
#pragma unroll
        for (int k = 0; k < LNR; ++k) { const int rr = row + k * NGW; if (rr < T) {
            const int2 pp = *(const int2*)(pos + 2 * rr); const float2 ww = *(const float2*)(ewgt + 2 * rr); w1[k] = ww.x; w2[k] = ww.y;
            rx[k] = load_raw(X + (size_t)rr * D, F.lane); r1[k] = load_raw(DS + (size_t)pp.x * D, F.lane); r2[k] = load_raw(DS + (size_t)pp.y * D, F.lane); } }
#pragma unroll
        for (int k = 0; k < LNR; ++k) { const int rr = row + k * NGW; if (rr < T) {
            RowV x, y1, y2; unpack_row(rx[k], x); unpack_row(r1[k], y1); unpack_row(r2[k], y2);
#pragma unroll
            for (int i = 0; i < 16; ++i) x.v[i] = ALPHA * x.v[i] + (w1[k] * y1.v[i] + w2[k] * y2.v[i]);
            ln_rowv(x, gb);
            if (outb) store_rowv_bf16(outb + (size_t)rr * D, F.lane, x);
            if (outf) { float* o = outf + (size_t)rr * D + 8 * F.lane;
                *(float4*)(o) = make_float4(x.v[0], x.v[1], x.v[2], x.v[3]); *(float4*)(o + 4) = make_float4(x.v[4], x.v[5], x.v[6], x.v[7]);
                *(float4*)(o + 512) = make_float4(x.v[8], x.v[9], x.v[10], x.v[11]); *(float4*)(o + 516) = make_float4(x.v[12], x.v[13], x.v[14], x.v[15]); } } }
    }
}
constexpr int RW_LD = 20;
__device__ __forceinline__ void phase_ln_router(const Frame& F, const bf16_t* X, const bf16_t* Y, const float* g, const float* b, bf16_t* out, unsigned char* out8, const float* rw, const float* rbias, int* eidx, float* ewgt, int* bcnt) {
    LAS float* rwl = (LAS float*)F.lds;
    LAS int* hist = (LAS int*)(F.lds + 1024 * RW_LD * 4);
    LAS float* lgs = (LAS float*)(F.lds + 1024 * RW_LD * 4 + 256) + F.wave * 64;
    for (int i = F.tid; i < 1024 * 4; i += NTHREADS) { const int k = i >> 2, q = i & 3; const float4 v = *(const float4*)(rw + (size_t)k * 16 + 4 * q);
        const int j = (k >> 9) * 8 + (k & 7), l = (k >> 3) & 63; LAS float* d = rwl + (j * 64 + l) * RW_LD + 4 * q; d[0] = v.x; d[1] = v.y; d[2] = v.z; d[3] = v.w; }
    GB gb; load_gb(g, b, F.lane, gb);
    const int lane = F.lane;
    for (int vb = F.vcu; vb < T / 128; vb += F.G) {
        if (F.tid < 16) hist[F.tid] = 0;
        __syncthreads();
#pragma unroll 1
        for (int it = 0; it < 4; ++it) {
            const int row0 = vb * 128 + F.wave * 16 + it * 4;
            RowRaw rx[4], ry[4];
#pragma unroll
            for (int k = 0; k < 4; ++k) { rx[k] = load_raw(X + (size_t)(row0 + k) * D, lane); ry[k] = load_raw(Y + (size_t)(row0 + k) * D, lane); }
            RowV x[4];
#pragma unroll
            for (int k = 0; k < 4; ++k) { RowV y; unpack_row(rx[k], x[k]); unpack_row(ry[k], y);
#pragma unroll
                for (int i = 0; i < 16; ++i) x[k].v[i] = ALPHA * x[k].v[i] + y.v[i];
                ln_rowv(x[k], gb);
                store_rowv_bf16(out + (size_t)(row0 + k) * D, lane, x[k]);
                store_rowv_fp8(out8 + (size_t)(row0 + k) * D, lane, x[k], pg8::F8_XS); }
            float val[64];
#pragma unroll
            for (int i = 0; i < 64; ++i) val[i] = 0.f;
#pragma unroll
            for (int j = 0; j < 16; ++j) { const LAS float* wr = rwl + (j * 64 + lane) * RW_LD;
#pragma unroll
                for (int e4 = 0; e4 < 4; ++e4) { const f32x4 w4 = *(const LAS f32x4*)(wr + 4 * e4);
#pragma unroll
                    for (int k = 0; k < 4; ++k) { const float xv = x[k].v[j];
                        val[16 * k + 4 * e4 + 0] += xv * w4[0]; val[16 * k + 4 * e4 + 1] += xv * w4[1]; val[16 * k + 4 * e4 + 2] += xv * w4[2]; val[16 * k + 4 * e4 + 3] += xv * w4[3]; } } }
#pragma unroll
            for (int i = 0; i < 32; ++i) { const auto rr = __builtin_amdgcn_permlane32_swap(__float_as_uint(val[i]), __float_as_uint(val[i + 32]), false, false); val[i] = __uint_as_float(rr[0]) + __uint_as_float(rr[1]); }
            { const bool bt = (lane & 16) != 0;
#pragma unroll
              for (int i = 0; i < 16; ++i) { const float keep = bt ? val[i + 16] : val[i], send = bt ? val[i] : val[i + 16]; val[i] = keep + swz_xor<16>(send); } }
            { const bool bt = (lane & 8) != 0;
#pragma unroll
              for (int i = 0; i < 8; ++i) { const float keep = bt ? val[i + 8] : val[i], send = bt ? val[i] : val[i + 8]; val[i] = keep + swz_xor<8>(send); } }
            { const bool bt = (lane & 4) != 0;
#pragma unroll
              for (int i = 0; i < 4; ++i) { const float keep = bt ? val[i + 4] : val[i], send = bt ? val[i] : val[i + 4]; val[i] = keep + swz_xor<4>(send); } }
            { const bool bt = (lane & 2) != 0;
#pragma unroll
              for (int i = 0; i < 2; ++i) { const float keep = bt ? val[i + 2] : val[i], send = bt ? val[i] : val[i + 2]; val[i] = keep + swz_xor<2>(send); } }
            { const bool bt = (lane & 1) != 0; const float keep = bt ? val[1] : val[0], send = bt ? val[0] : val[1]; val[0] = keep + swz_xor<1>(send); }
            lgs[lane] = val[0];
            LDS_WAIT();
            if (lane < 4) {
                const int row = row0 + lane;
                float lg[16];
#pragma unroll
                for (int e4 = 0; e4 < 4; ++e4) { const f32x4 t4 = *(const LAS f32x4*)(lgs + 16 * lane + 4 * e4); lg[4 * e4] = t4[0]; lg[4 * e4 + 1] = t4[1]; lg[4 * e4 + 2] = t4[2]; lg[4 * e4 + 3] = t4[3]; }
                float mx = lg[0];
#pragma unroll
                for (int e = 1; e < 16; ++e) mx = fmaxf(mx, lg[e]);
                float sc[16], sum = 0.f;
#pragma unroll
                for (int e = 0; e < 16; ++e) { sc[e] = __expf(lg[e] - mx); sum += sc[e]; }
                const float isum = 1.f / sum;
                float bz[16];
#pragma unroll
                for (int e = 0; e < 16; ++e) { sc[e] *= isum; bz[e] = sc[e] + rbias[e]; }
                float gs[4]; int gi1[4], gi2[4];
#pragma unroll
                for (int gq = 0; gq < 4; ++gq) {
                    float m1 = bz[4 * gq]; int i1 = 0;
#pragma unroll
                    for (int j = 1; j < 4; ++j) if (bz[4 * gq + j] > m1) { m1 = bz[4 * gq + j]; i1 = j; }
                    float m2 = -INFINITY; int i2 = 0;
#pragma unroll
                    for (int j = 0; j < 4; ++j) if (j != i1 && bz[4 * gq + j] > m2) { m2 = bz[4 * gq + j]; i2 = j; }
                    gs[gq] = m1 + m2; gi1[gq] = i1; gi2[gq] = i2;
                }
                int gsel = 0; float gm = gs[0];
#pragma unroll
                for (int gq = 1; gq < 4; ++gq) if (gs[gq] > gm) { gm = gs[gq]; gsel = gq; }
                int i1 = gi1[0], i2 = gi2[0];
#pragma unroll
                for (int gq = 1; gq < 4; ++gq) if (gsel == gq) { i1 = gi1[gq]; i2 = gi2[gq]; }
                const int e1 = gsel * 4 + i1, e2 = gsel * 4 + i2;
                float s1 = 0.f, s2 = 0.f;
#pragma unroll
                for (int e = 0; e < 16; ++e) { if (e == e1) s1 = sc[e]; if (e == e2) s2 = sc[e]; }
                const float inv = 1.f / (s1 + s2);
                *(int2*)(eidx + 2 * row) = make_int2(e1, e2); *(float2*)(ewgt + 2 * row) = make_float2(s1 * inv, s2 * inv);
                atomicAdd((int*)&hist[e1], 1); atomicAdd((int*)&hist[e2], 1);
            }
        }
        __syncthreads();
        if (F.tid < 16) bcnt[vb * 16 + F.tid] = hist[F.tid];
        __syncthreads();
    }
}
__device__ __forceinline__ void phase_moe_book(const Frame& F, const int* eidx, const int* bcnt, int* tok, int* pos, int* tile_e) {
    LAS int* bc = (LAS int*)F.lds;
    LAS int* es = bc + 4096;
    LAS int* off = es + 256;
    LAS int* base = off + 32;
    LAS int* tot = base + 16;
    for (int i = F.tid; i < 4096; i += NTHREADS) bc[i] = bcnt[i];
    __syncthreads();
    for (int vb = F.vcu; vb < T / 128; vb += F.G) {
        if (F.tid < 16) { int t = 0, bs = 0; for (int b2 = 0; b2 < 256; ++b2) { const int c = bc[b2 * 16 + F.tid]; t += c; if (b2 < vb) bs += c; } tot[F.tid] = t; base[F.tid] = bs; }
        if (F.tid < 256) es[F.tid] = eidx[vb * 256 + F.tid];
        __syncthreads();
        if (F.tid == 0) { int o = 0; for (int e = 0; e < 16; ++e) { off[e] = o; o += (tot[e] + 255) & ~255; } off[16] = o; }
        __syncthreads();
        if (F.tid < 256) {
            const int e = es[F.tid]; int rank = 0;
            for (int j = 0; j < F.tid; ++j) rank += (es[j] == e) ? 1 : 0;
            const int r = off[e] + base[e] + rank;
            pos[vb * 256 + F.tid] = r; tok[r] = vb * 128 + (F.tid >> 1);
        }
        if (vb < 16) { const int e = vb, r0 = off[e] + tot[e], r1 = off[e + 1]; for (int r = r0 + F.tid; r < r1; r += NTHREADS) tok[r] = 0; }
        if (vb == 16) {
            for (int tl = F.tid; tl < NTILE; tl += NTHREADS) { int e = -1; for (int k = 0; k < 16; ++k) if (tl * 256 >= off[k] && tl * 256 < off[k + 1]) e = k; tile_e[tl] = e; }
            if (F.tid == 0) tile_e[NTILE] = off[16] >> 8;
        }
        __syncthreads();
    }
}
__device__ __forceinline__ void phase_pool(const Frame& F, const bf16_t* HP, bf16_t* PO) {
    constexpr int RUN = 32;
    const int gt = F.vcu * NTHREADS + F.tid, NGT = F.G * NTHREADS;
    for (int it = gt; it < (T / RUN) * (D / 8); it += NGT) {
        const int c8 = it & 127, run = it >> 7, g = c8 >> 5, win = 2 << g, t0 = run * RUN, ts0 = t0 & (S - 1);
        const bf16_t* hp = HP + (size_t)t0 * D + c8 * 8; bf16_t* po = PO + (size_t)t0 * D + c8 * 8;
        float s[8];
#pragma unroll
        for (int q = 0; q < 8; ++q) s[q] = 0.f;
        for (int k = 1; k < win; ++k) if (ts0 - k >= 0) { float v[8]; unpk8(*(const v4u*)(hp - (ptrdiff_t)k * D), v);
#pragma unroll
            for (int q = 0; q < 8; ++q) s[q] += v[q]; }
#pragma unroll 4
        for (int i = 0; i < RUN; ++i) {
            float hn[8]; unpk8(*(const v4u*)(hp + (size_t)i * D), hn);
            const int ts = ts0 + i;
#pragma unroll
            for (int q = 0; q < 8; ++q) s[q] += hn[q];
            const float inv = 1.f / (float)(ts + 1 < win ? ts + 1 : win);
            v4u o; o.x = pk2(s[0] * inv - hn[0], s[1] * inv - hn[1]); o.y = pk2(s[2] * inv - hn[2], s[3] * inv - hn[3]); o.z = pk2(s[4] * inv - hn[4], s[5] * inv - hn[5]); o.w = pk2(s[6] * inv - hn[6], s[7] * inv - hn[7]);
            *(v4u*)(po + (size_t)i * D) = o;
            if (ts + 1 >= win) { float ho[8]; unpk8(*(const v4u*)(hp + (ptrdiff_t)(i + 1 - win) * D), ho);
#pragma unroll
                for (int q = 0; q < 8; ++q) s[q] -= ho[q]; }
        }
    }
}
}
namespace mk {
typedef short bf16x8 __attribute__((ext_vector_type(8)));
typedef float f32x16 __attribute__((ext_vector_type(16)));
#define MFMA32(a, b, c) __builtin_amdgcn_mfma_f32_32x32x16_bf16((a), (b), (c), 0, 0, 0)
__device__ __forceinline__ int crow(int i, int h) { return (i & 3) + 8 * (i >> 2) + 4 * h; }
__device__ __forceinline__ float swap32_max(float v) { const auto r = __builtin_amdgcn_permlane32_swap(__float_as_uint(v), __float_as_uint(v), false, false); return fmaxf(__uint_as_float(r[0]), __uint_as_float(r[1])); }
__device__ __forceinline__ float swap32_sum(float v) { const auto r = __builtin_amdgcn_permlane32_swap(__float_as_uint(v), __float_as_uint(v), false, false); return __uint_as_float(r[0]) + __uint_as_float(r[1]); }
__device__ __forceinline__ unsigned pkbf(float lo, float hi) { unsigned r; asm volatile("v_cvt_pk_bf16_f32 %0, %1, %2" : "=v"(r) : "v"(lo), "v"(hi)); return r; }
__device__ __forceinline__ bf16x8 pack_step(const f32x16& x, int s) {
    v4u p; p.x = pkbf(x[8 * s + 0], x[8 * s + 1]); p.y = pkbf(x[8 * s + 2], x[8 * s + 3]); p.z = pkbf(x[8 * s + 4], x[8 * s + 5]); p.w = pkbf(x[8 * s + 6], x[8 * s + 7]);
    return __builtin_bit_cast(bf16x8, p);
}
__device__ __forceinline__ bf16x8 lds_frag2x8(const LAS unsigned char* p) {
    const v2u a = *(const LAS v2u*)p, b = *(const LAS v2u*)(p + 16);
    v4u q; q.x = a.x; q.y = a.y; q.z = b.x; q.w = b.y; return __builtin_bit_cast(bf16x8, q);
}
__device__ __forceinline__ void unpack8(const v4u u, float (&x)[8]) {
    x[0] = __uint_as_float(u.x << 16); x[1] = __uint_as_float(u.x & 0xffff0000u); x[2] = __uint_as_float(u.y << 16); x[3] = __uint_as_float(u.y & 0xffff0000u);
    x[4] = __uint_as_float(u.z << 16); x[5] = __uint_as_float(u.z & 0xffff0000u); x[6] = __uint_as_float(u.w << 16); x[7] = __uint_as_float(u.w & 0xffff0000u);
}

__device__ __forceinline__ void phase_swa_sgu(const Frame& F, const bf16_t* H0, const float* sinks, const float* lng, const float* lnb, const bf16_t* SW, const float* bs, bf16_t* MIX) {
    constexpr int KSTR = 272, VSTR = 520, VT_OFF = 256 * KSTR, VGSTR = 272, VGW = 64 * VGSTR;
    LAS unsigned char* KS = F.lds; LAS unsigned char* VT = F.lds + VT_OFF;
    const int lane = F.lane, r = lane & 31, h = lane >> 5, w = F.wave, kvh = w >> 2;
    const float NEG = -INFINITY;
    for (int vb = F.vcu; vb < T / 128; vb += F.G) {
        const int n = vb & 63; const size_t row0 = (size_t)vb * 128;
#pragma unroll
        for (int i = 0; i < 8; ++i) { const int p = F.tid + NTHREADS * i, row = p >> 4, c16 = p & 15; v4u v = (v4u){0u, 0u, 0u, 0u};
            if (n > 0 || row >= 128) v = *(const v4u*)(H0 + (row0 + row - 128) * NIN0 + 512 + c16 * 8);
            *(LAS v4u*)(KS + row * KSTR + c16 * 16) = v; }
#pragma unroll
        for (int i = 0; i < 8; ++i) { const int p = F.tid + NTHREADS * i, c16 = p >> 8, row = p & 255; v4u v = (v4u){0u, 0u, 0u, 0u};
            if (n > 0 || row >= 128) v = *(const v4u*)(H0 + (row0 + row - 128) * NIN0 + 640 + c16 * 8);
            LAS bf16_t* d = (LAS bf16_t*)(VT + (c16 * 8) * VSTR + row * 2);
            d[0 * (VSTR / 2)] = (bf16_t)(v.x & 0xffffu); d[1 * (VSTR / 2)] = (bf16_t)(v.x >> 16); d[2 * (VSTR / 2)] = (bf16_t)(v.y & 0xffffu); d[3 * (VSTR / 2)] = (bf16_t)(v.y >> 16);
            d[4 * (VSTR / 2)] = (bf16_t)(v.z & 0xffffu); d[5 * (VSTR / 2)] = (bf16_t)(v.z >> 16); d[6 * (VSTR / 2)] = (bf16_t)(v.w & 0xffffu); d[7 * (VSTR / 2)] = (bf16_t)(v.w >> 16); }
        __syncthreads();
        const float sink2 = sinks[w] * 1.4426950408889634f;
#pragma unroll 1
        for (int qg = 0; qg < 4; ++qg) {
            bf16x8 qf[4];
            { const bf16_t* qp = H0 + (row0 + 32 * qg + r) * NIN0 + w * 64 + 8 * h;
#pragma unroll
              for (int ks = 0; ks < 4; ++ks) qf[ks] = *(const bf16x8*)(qp + 16 * ks); }
            f32x16 st[5];
#pragma unroll
            for (int kt = 0; kt < 5; ++kt) {
#pragma unroll
                for (int i = 0; i < 16; ++i) st[kt][i] = 0.f;
                const LAS unsigned char* kp = KS + (32 * qg + 32 * kt + r) * KSTR + (kvh * 64 + 8 * h) * 2;
#pragma unroll
                for (int ks = 0; ks < 4; ++ks) { const bf16x8 kf = *(const LAS bf16x8*)(kp + 32 * ks); st[kt] = MFMA32(kf, qf[ks], st[kt]); }
            }
            float m = sink2;
            int rq = r; asm volatile("" : "+v"(rq));
#pragma unroll
            for (int kt = 0; kt < 5; ++kt)
#pragma unroll
                for (int i = 0; i < 16; ++i) { const int dk = 32 * kt + crow(i, h) - rq;
                    const bool valid = dk >= 1 && dk <= 128 && (n > 0 || (32 * qg + 32 * kt + crow(i, h)) >= 128);
                    const float s = valid ? st[kt][i] * ASCALE : NEG; st[kt][i] = s; m = fmaxf(m, s); }
            m = swap32_max(m);
            float l = 0.f;
#pragma unroll
            for (int kt = 0; kt < 5; ++kt)
#pragma unroll
                for (int i = 0; i < 16; ++i) { const float p = __builtin_amdgcn_exp2f(st[kt][i] - m); st[kt][i] = p; l += p; }
            l = swap32_sum(l) + __builtin_amdgcn_exp2f(sink2 - m);
            f32x16 o[2];
#pragma unroll
            for (int i = 0; i < 16; ++i) { o[0][i] = 0.f; o[1][i] = 0.f; }
#pragma unroll
            for (int kt = 0; kt < 5; ++kt)
#pragma unroll
                for (int s = 0; s < 2; ++s) { const bf16x8 pf = pack_step(st[kt], s);
#pragma unroll
                    for (int dt = 0; dt < 2; ++dt) { const bf16x8 vf = lds_frag2x8(VT + (kvh * 64 + 32 * dt + r) * VSTR + (32 * qg + 32 * kt + 16 * s + 4 * h) * 2); o[dt] = MFMA32(vf, pf, o[dt]); } }
            const float inv = 1.f / l;
            bf16_t* op = MIX + (row0 + 32 * qg + r) * D + w * 64 + 4 * h;
#pragma unroll
            for (int dt = 0; dt < 2; ++dt)
#pragma unroll
                for (int g4 = 0; g4 < 4; ++g4) { v2u u; u.x = pkbf(o[dt][4 * g4 + 0] * inv, o[dt][4 * g4 + 1] * inv); u.y = pkbf(o[dt][4 * g4 + 2] * inv, o[dt][4 * g4 + 3] * inv); *(v2u*)(op + 32 * dt + 8 * g4) = u; }
        }
        __syncthreads();
        {
            LAS unsigned char* VG = F.lds + w * VGW; const int g = w; int vz = 0; asm volatile("" : "+v"(vz));
#pragma unroll 1
            for (int it = 0; it < 2; ++it) { const int s = 64 * it + lane; const bf16_t* vp = H0 + (row0 + s) * NIN0 + 1280 + g * 64;
                float x[8][8]; float sum = 0.f;
#pragma unroll
                for (int cq = 0; cq < 8; ++cq) { unpack8(*(const v4u*)(vp + 8 * cq), x[cq]);
#pragma unroll
                    for (int e = 0; e < 8; ++e) sum += x[cq][e]; }
                const float mu = sum * (1.f / 64.f); float q = 0.f;
#pragma unroll
                for (int cq = 0; cq < 8; ++cq)
#pragma unroll
                    for (int e = 0; e < 8; ++e) { x[cq][e] -= mu; q += x[cq][e] * x[cq][e]; }
                const float rstd = 1.f / sqrtf(q * (1.f / 64.f) + LN_EPS);
#pragma unroll
                for (int cq = 0; cq < 8; ++cq)
#pragma unroll
                    for (int e = 0; e < 8; ++e) { const int c = 8 * cq + e; *(LAS bf16_t*)(VG + c * VGSTR + s * 2) = f2bf(x[cq][e] * rstd * lng[g * 64 + c + vz] + lnb[g * 64 + c + vz]); }
            }
            LDS_WAIT();
#pragma unroll 1
            for (int tt = 0; tt < 4; ++tt) {
                f32x16 acc[2];
#pragma unroll
                for (int i = 0; i < 16; ++i) { acc[0][i] = 0.f; acc[1][i] = 0.f; }
                const bf16_t* wp = SW + ((size_t)(g * 128 + 32 * tt + r) * 128 + 8 * h);
                for (int ks = 0; ks < 2 * (tt + 1); ++ks) { const bf16x8 bfr = *(const bf16x8*)(wp + 16 * ks);
#pragma unroll
                    for (int ct = 0; ct < 2; ++ct) { const bf16x8 af = *(const LAS bf16x8*)(VG + (32 * ct + r) * VGSTR + (16 * ks + 8 * h) * 2); acc[ct] = MFMA32(af, bfr, acc[ct]); } }
                const int t = 32 * tt + r; const float bias = bs[g * 128 + t];
                const bf16_t* up = H0 + (row0 + t) * NIN0 + 768 + g * 64 + 4 * h; bf16_t* op = MIX + (row0 + t) * D + 512 + g * 64 + 4 * h;
#pragma unroll
                for (int ct = 0; ct < 2; ++ct)
#pragma unroll
                    for (int g4 = 0; g4 < 4; ++g4) { const v2u uu = *(const v2u*)(up + 32 * ct + 8 * g4);
                        const float u0 = __uint_as_float(uu.x << 16), u1 = __uint_as_float(uu.x & 0xffff0000u), u2 = __uint_as_float(uu.y << 16), u3 = __uint_as_float(uu.y & 0xffff0000u);
                        v2u o2; o2.x = pkbf(u0 * (acc[ct][4 * g4 + 0] + bias), u1 * (acc[ct][4 * g4 + 1] + bias)); o2.y = pkbf(u2 * (acc[ct][4 * g4 + 2] + bias), u3 * (acc[ct][4 * g4 + 3] + bias));
                        *(v2u*)(op + 32 * ct + 8 * g4) = o2; }
            }
        }
        __syncthreads();
    }
}

}
namespace mk {
constexpr int NPHASE = 23;

typedef const __attribute__((address_space(4))) Args* KArgs;
__device__ __forceinline__ KArgs kargs() { KArgs p = (KArgs)__builtin_amdgcn_kernarg_segment_ptr(); asm volatile("" : "+s"(p)); return p; }

__device__ __forceinline__ bool in_range(int k) { KArgs ka = kargs(); return ka->ph_lo <= k && k < ka->ph_hi; }

__global__ void __launch_bounds__(NTHREADS, 2) mega(Args a) {
    extern __shared__ __attribute__((aligned(16))) unsigned char lds_raw[];
    LAS unsigned char* const F0lds = (LAS unsigned char*)lds_raw;
    const int F0wave = __builtin_amdgcn_readfirstlane((int)threadIdx.x >> 6);
    const int F0G = gridDim.x, F0bx = blockIdx.x, F0vcu = (F0G % 8 == 0) ? (F0bx % 8) * (F0G / 8) + F0bx / 8 : F0bx;
    volatile LAS unsigned* MISC = (volatile LAS unsigned*)(F0lds + MISC_OFF);
    if (threadIdx.x < 64) MISC[threadIdx.x] = 0u;
    __syncthreads();
    unsigned* ctl = (unsigned*)(a.ws + WS_CTL);
    XcdBarrier bar = xcd_barrier_post(ctl + CW_BAR + a.ph_lo * XCD_BAR_WORDS, MISC + 8, F0wave);
#define IN(k) in_range(k)
#define SEAM(k) do { if (IN(k) && IN((k) + 1)) { XcdBarrier b2_ = bar; asm volatile("" : "+s"(b2_.bar), "+s"(b2_.x)); xcd_barrier(b2_); } } while (0)
#define PH KArgs ka = kargs(); unsigned char* ws = ka->ws; (void)ws; Frame Fp; Fp.lds = F0lds; Fp.wave = F0wave; Fp.vcu = F0vcu; Fp.G = F0G; Fp.bx = F0bx; asm volatile("" : "+s"(Fp.wave), "+s"(Fp.vcu), "+s"(Fp.G), "+s"(Fp.bx)); \
    Fp.lane = (int)lane_id_fresh(); Fp.tid = Fp.wave * 64 + Fp.lane; const Frame& F = Fp; \
    const int bx = Fp.bx; (void)bx; LAS unsigned char* glds = F.lds; (void)glds; \
    bf16_t* RA = (bf16_t*)(ws + WS_A); bf16_t* RB = (bf16_t*)(ws + WS_B); bf16_t* RC = (bf16_t*)(ws + WS_C); bf16_t* RD = (bf16_t*)(ws + WS_D); bf16_t* WB = (bf16_t*)(ws + WS_WB); \
    (void)RA; (void)RB; (void)RC; (void)RD; (void)WB;
#define PHC PH const int cb = L == 0 ? 12 : 28; (void)cb; bf16_t* WBl = WB + WB_LAYER + (size_t)L * WL_SIZE; (void)WBl; \
    bf16_t *X1 = RB, *X2 = RA, *HS = RB, *DS = RD, *X3 = L == 0 ? RC : nullptr;   unsigned char *X1_8 = (unsigned char*)(L == 0 ? RD : RA), *P8 = (unsigned char*)(L == 0 ? RA : RC), *X2_8 = (unsigned char*)(L == 0 ? RD : RC); bf16_t* Y2 = L == 0 ? RC : RD; \
    (void)X1; (void)P8; (void)X1_8; (void)X2_8; (void)Y2; (void)X2; (void)HS; (void)DS; (void)X3;
#ifndef DOUBLE_MASK
#define DOUBLE_MASK 0u
#endif
#if DOUBLE_MASK != 0
#define REP(k) for (int rep_ = 0, nrep_ = 1 + (int)((DOUBLE_MASK >> (k)) & 1u); rep_ < nrep_; ++rep_)
#else
#define REP(k)
#endif
#define INF(i) ((const float*)ka->in[i])
#define WSI(off) ((int*)(ws + (off)))
#define WSF(off) ((float*)(ws + (off)))

#define GEMM_STD(EPI, ORD, LDA_, LDB_, K_) pg8::gemm_phase<EPI, ORD, true, true, false, LDA_, LDB_, K_>(glds, F.tid, g, S, E)
    for (int L = 0; L < 2; ++L) {
        const int cbp = L == 0 ? 0 : 11;
        if (L == 0) {
            if (IN(0)) REP(0) { PH
                LAS float* scr = (LAS float*)(F.lds + F.wave * 16384);
                const int gw = F.vcu * NWAVES + F.wave, NGW = F.G * NWAVES;
                constexpr int NITEMS = 896 + 512 + 512 + 512 + 2 * (1024 + 512 + 3 * 4096);
                for (int it = gw; it < NITEMS; it += NGW) {
                    int r = it;
#define JOB(MAP, src, K_, N_, dst, dstb, cnt) if (r < (cnt)) { transpose_job_item<MAP, false>((const float*)(src), K_, N_, dst, dstb, r, scr, F.lane); continue; } r -= (cnt);
#define JOB8(MAP, src, K_, N_, dst, dstb, cnt) if (r < (cnt)) { transpose_job_item<MAP, true>((const float*)(src), K_, N_, dst, dstb, r, scr, F.lane); continue; } r -= (cnt);
                    JOB(0, ka->in[5], 1024, 1792, WB + WB_IN0, 0, 896)
                    JOB(0, ka->in[11], 1024, 1024, WB + WB_OUT0, 0, 512)
                    JOB(0, ka->in[24], 1024, 1024, WB + WB_IN1, 0, 512)
                    JOB(0, ka->in[27], 1024, 1024, WB + WB_OUT1, 0, 512)
#define LAYER_JOBS(l, c2) { bf16_t* Wl = WB + WB_LAYER + (size_t)(l) * WL_SIZE; \
                        JOB(0, ka->in[(c2) + 3], 1024, 2048, Wl + WL_XKV, 0, 1024) \
                        JOB(0, ka->in[(c2) + 4], 1024, 1024, Wl + WL_XO, 0, 512) \
                        JOB8(1, ka->in[(c2) + 7], 1024, 512, Wl + WL_GU, (size_t)1024 * 1024, 4096) \
                        JOB8(2, ka->in[(c2) + 8], 1024, 512, Wl + WL_GU, (size_t)1024 * 1024, 4096) \
                        JOB8(0, ka->in[(c2) + 9], 512, 1024, Wl + WL_DN, (size_t)1024 * 512, 4096) }
                    LAYER_JOBS(0, 12)
                    LAYER_JOBS(1, 28)
#undef LAYER_JOBS
#undef JOB
#undef JOB8
                }
                const int gt = F.vcu * NTHREADS + F.tid, NGT = F.G * NTHREADS;
                { const float4* x4 = (const float4*)ka->in[0]; v2u* o = (v2u*)RA;
                  for (int i = gt; i < T * D / 4; i += NGT) { const float4 v = x4[i]; v2u w; w.x = pk2(v.x, v.y); w.y = pk2(v.z, v.w); o[i] = w; } }
                { const float4* m4 = (const float4*)ka->in[1]; v2u* o = (v2u*)(ws + WS_MEMB);
                  for (int i = gt; i < B * MEM * D / 4; i += NGT) { const float4 v = m4[i]; v2u w; w.x = pk2(v.x, v.y); w.y = pk2(v.z, v.w); o[i] = w; } }
#pragma unroll
                for (int l = 0; l < 2; ++l) { const float4* q4 = (const float4*)ka->in[l == 0 ? 14 : 30]; v2u* o = (v2u*)(WB + WB_LAYER + (size_t)l * WL_SIZE + WL_XQ);
                  for (int i = gt; i < D * D / 4; i += NGT) { const float4 v = q4[i]; v2u w; w.x = pk2(v.x, v.y); w.y = pk2(v.z, v.w); o[i] = w; } }
                { const float4* p4 = (const float4*)ka->in[25]; const float4* s4 = (const float4*)ka->in[26]; v2u* o = (v2u*)(WB + WB_POOL);
                  for (int i = gt; i < 4 * 256 * 256 / 4; i += NGT) { const float4 v = p4[i]; const float4 sc = s4[(i >> 14) * 64 + (i & 63)]; v2u w; w.x = pk2(v.x * sc.x, v.y * sc.y); w.y = pk2(v.z * sc.z, v.w * sc.w); o[i] = w; } }
                { const int* positions = (const int*)ka->in[2]; float* ropew = WSF(WS_ROPE);
                  for (int t = gt; t < T; t += NGT) { const float p = (float)positions[t];
#pragma unroll
                      for (int j = 0; j < 8; ++j) { const float ang = p * ka->inv.f[j]; double rev = (double)ang * 0.15915494309189535; rev -= rint(rev); const float rr = (float)rev;
                          ropew[(size_t)t * 16 + j] = __builtin_amdgcn_cosf(rr); ropew[(size_t)t * 16 + 8 + j] = __builtin_amdgcn_sinf(rr); } } }
                { const float* sw = INF(9); bf16_t* o = WB + WB_SGUW;
                  for (int i = gt; i < 8 * 128 * 128; i += NGT) { const int s2 = i & 127, t = (i >> 7) & 127; o[i] = f2bf(s2 <= t ? sw[i] : 0.f); } }
            }
            SEAM(0);
            if (IN(1)) REP(1) { PH float* rope = WSF(WS_ROPE); bf16_t* MEMB = (bf16_t*)(ws + WS_MEMB);
#pragma unroll 1
                for (int l = 0; l < 2; ++l) {
                    bf16_t* Wl = WB + WB_LAYER + (size_t)l * WL_SIZE;
                    pg8::Gemm g{MEMB, Wl + WL_XKV, nullptr};
                    const int c2 = bx - 128 - 32 * l;
                    pg8::StaticOrder S; S.init(B * MEM, 2048, F.G, (c2 >= 0 && c2 < 32) ? c2 : (1 << 20), D, D);
                    pg8::EpiBf16 E{(bf16_t*)(ws + WS_MEMKV) + (size_t)l * B * MEM * 2048, 2048, 1.f};
                    GEMM_STD(pg8::EpiBf16, pg8::StaticOrder, D, D, D);
                }
                {
                    pg8::Gemm g{RA, WB + WB_IN0, nullptr};
                    pg8::StaticOrder S; S.init(T, NIN0, F.G, bx, D, D);
                    pg8::EpiInproj0 E{RD, rope};
                    GEMM_STD(pg8::EpiInproj0, pg8::StaticOrder, D, D, D);
                }
            }
            SEAM(1);
            if (IN(2)) REP(2) { PH
                { bf16_t* Wl = WB + WB_LAYER; const bf16_t* KV = (const bf16_t*)(ws + WS_MEMKV);
                  { pg8::Gemm g{KV, Wl + WL_XQ, nullptr}; pg8::SetupOrder<0> S; S.init(bx, 0, 64); pg8::EpiF8 E{ws + WS_MT, D, QSCALE * pg8::F8_MS}; GEMM_STD(pg8::EpiF8, pg8::SetupOrder<0>, 2048, 1024, 256); }
                  { pg8::Gemm g{Wl + WL_XO, KV, nullptr}; pg8::SetupOrder<1> S; S.init(bx, 64, 64); pg8::EpiF8 E{ws + WS_NT, D, pg8::F8_NS}; GEMM_STD(pg8::EpiF8, pg8::SetupOrder<1>, 1024, 2048, 256); }
                  { pg8::Gemm g{WB + WB_OUT1, WB + WB_POOL, nullptr}; pg8::SetupOrder<2> S; S.init(bx, 128, 16); pg8::EpiBf16 E{WB + WB_WEFF, D, 1.f}; GEMM_STD(pg8::EpiBf16, pg8::SetupOrder<2>, 1024, 256, 256); } }
                phase_swa_sgu(F, RD, INF(6), INF(7), INF(8), WB + WB_SGUW, INF(10), RB);
            }
            SEAM(2);
            if (IN(3)) REP(3) { PH
                pg8::Gemm g{RB, WB + WB_OUT0, nullptr};
                pg8::StaticOrder S; S.init(T, D, F.G, bx, D, D);
                pg8::EpiBf16 E{RC, D, 1.f};
                GEMM_STD(pg8::EpiBf16, pg8::StaticOrder, D, D, D);
            }
            SEAM(3);
            if (IN(4)) REP(4) { PH phase_ln_add(F, RA, RC, INF(12), INF(13), RB, (unsigned char*)RD); }
            SEAM(4);
        } else {
            if (IN(12)) REP(12) { PH
                pg8::Gemm g{RC, WB + WB_IN1, nullptr};
                pg8::StaticOrder S; S.init(T, D, F.G, bx, D, D);
                pg8::EpiBf16 E{RB, D, 1.f};
                GEMM_STD(pg8::EpiBf16, pg8::StaticOrder, D, D, D);
            }
            SEAM(12);
            if (IN(13)) REP(13) { PH
                { bf16_t* Wl = WB + WB_LAYER + WL_SIZE; const bf16_t* KV = (const bf16_t*)(ws + WS_MEMKV) + (size_t)B * MEM * 2048;
                  { pg8::Gemm g{KV, Wl + WL_XQ, nullptr}; pg8::SetupOrder<0> S; S.init(bx, 0, 64); pg8::EpiF8 E{ws + WS_MT, D, QSCALE * pg8::F8_MS}; GEMM_STD(pg8::EpiF8, pg8::SetupOrder<0>, 2048, 1024, 256); }
                  { pg8::Gemm g{Wl + WL_XO, KV, nullptr}; pg8::SetupOrder<1> S; S.init(bx, 64, 64); pg8::EpiF8 E{ws + WS_NT, D, pg8::F8_NS}; GEMM_STD(pg8::EpiF8, pg8::SetupOrder<1>, 1024, 2048, 256); } }
                phase_pool(F, RB, RA);
            }
            SEAM(13);
            if (IN(14)) REP(14) { PH
                pg8::Gemm g{RA, WB + WB_WEFF, nullptr};
                pg8::StaticOrder S; S.init(T, D, F.G, bx, D, D);
                pg8::EpiBf16 E{RD, D, 1.f};
                GEMM_STD(pg8::EpiBf16, pg8::StaticOrder, D, D, D);
            }
            SEAM(14);
            if (IN(15)) REP(15) { PH phase_ln_add(F, RC, RD, INF(28), INF(29), RB, (unsigned char*)RA); }
            SEAM(15);
        }
        if (IN(cbp + 5)) REP(cbp + 5) { PHC
            pg8::Gemm g{(const bf16_t*)X1_8, (const bf16_t*)(ws + WS_MT), nullptr};
            pg8::BatchOrder S; S.init(T, D, F.G, bx, D, D);
            pg8::EpiSoftmaxT<true> E{P8, (LAS float*)(F.lds + 131072), 1.f / (pg8::F8_XS * pg8::F8_MS)};
            pg8::gemm_phase<pg8::EpiSoftmaxT<true>, pg8::BatchOrder, true, true, false, D, D, D, true>(glds, F.tid, g, S, E);
        }
        SEAM(cbp + 5);
        if (IN(cbp + 6)) REP(cbp + 6) { PHC
            pg8::Gemm g{(const bf16_t*)P8, (const bf16_t*)(ws + WS_NT), nullptr};
            pg8::BatchOrder S; S.init(T, D, F.G, bx, D, D);
            pg8::EpiBf16 E{Y2, D, 1.f / (pg8::F8_PS * pg8::F8_NS)};
            pg8::gemm_phase<pg8::EpiBf16, pg8::BatchOrder, true, true, false, D, D, D, true>(glds, F.tid, g, S, E);
        }
        SEAM(cbp + 6);
        if (IN(cbp + 7)) REP(cbp + 7) { PHC phase_ln_router(F, X1, Y2, INF(cb + 5), INF(cb + 6), X2, X2_8, INF(3), INF(4), WSI(WS_EIDX), WSF(WS_EWGT), WSI(WS_BCNT)); }
        SEAM(cbp + 7);
        if (IN(cbp + 8)) REP(cbp + 8) { PHC phase_moe_book(F, WSI(WS_EIDX), WSI(WS_BCNT), WSI(WS_TOK), WSI(WS_POS), WSI(WS_TILE)); }
        SEAM(cbp + 8);
        if (IN(cbp + 9)) REP(cbp + 9) { PHC const int* tile_e = WSI(WS_TILE); const int* tok = WSI(WS_TOK);
            const int ntiles = __builtin_amdgcn_readfirstlane(tile_e[NTILE]);
            pg8::Gemm g{(const bf16_t*)X2_8, WBl + WL_GU, tok};
            pg8::MoeOrder S; S.init(ntiles, tile_e, F.G, bx, D, D);
            pg8::EpiGU8 E{(unsigned char*)HS};
            pg8::gemm_phase<pg8::EpiGU8, pg8::MoeOrder, true, true, true, D, D, D, true>(glds, F.tid, g, S, E);
        }
        SEAM(cbp + 9);
        if (IN(cbp + 10)) REP(cbp + 10) { PHC const int* tile_e = WSI(WS_TILE);
            const int ntiles = __builtin_amdgcn_readfirstlane(tile_e[NTILE]);
            pg8::Gemm g{HS, WBl + WL_DN, nullptr};
            pg8::MoeOrder S; S.init(ntiles, tile_e, F.G, bx, DE, DE);
            pg8::EpiBf16 E{DS, D, 1.f / (pg8::F8_HS * pg8::F8_WS)};
            pg8::gemm_phase<pg8::EpiBf16, pg8::MoeOrder, true, true, false, DE, DE, DE, true>(glds, F.tid, g, S, E);
        }
        SEAM(cbp + 10);
        if (IN(cbp + 11)) REP(cbp + 11) { PHC phase_ln_moe(F, X2, DS, WSI(WS_POS), WSF(WS_EWGT), INF(cb + 10), INF(cb + 11), X3, L == 1 ? ka->out : nullptr); }
        SEAM(cbp + 11);
    }
#undef GEMM_STD
#undef IN
#undef SEAM
#undef INF
#undef PH
#undef PHC
#undef WSI
#undef WSF
}
}
using namespace nv;
extern "C" void kernel_launch(void* const* d_in, const int* in_sizes, int n_in, void* d_out, int out_size, void* d_ws, size_t ws_size, hipStream_t stream) {
    (void)in_sizes; (void)out_size;
    if (ws_size < WS_END || n_in != 40) return;
    static int grid = 0;
    if (grid == 0) {
        int dev = 0, cus = 0;
        if (hipGetDevice(&dev) != hipSuccess || hipDeviceGetAttribute(&cus, hipDeviceAttributeMultiprocessorCount, dev) != hipSuccess) { grid = -1; return; }
        if (hipFuncSetAttribute((const void*)mk::mega, hipFuncAttributeMaxDynamicSharedMemorySize, mk::LDS_BYTES) != hipSuccess) { grid = -1; return; }
        int per_cu = 0;
        if (hipOccupancyMaxActiveBlocksPerMultiprocessor(&per_cu, (const void*)mk::mega, mk::NTHREADS, mk::LDS_BYTES) != hipSuccess || per_cu < 1) { (void)hipGetLastError(); }
        grid = cus;
    }
    if (grid < 0) return;
    unsigned char* ws = (unsigned char*)d_ws;
    (void)hipMemsetAsync(ws + WS_CTL, 0, 512 * 1024, stream);
    mk::Args a{};
    for (int i = 0; i < 40; ++i) a.in[i] = d_in[i];
    a.out = (float*)d_out; a.ws = ws;
    for (int j = 0; j < 8; ++j) a.inv.f[j] = (float)pow(500000.0, -(double)((float)j * 2.0f / 16.0f));
    a.ph_lo = 0; a.ph_hi = mk::NPHASE;
    hipLaunchKernelGGL(mk::mega, dim3(grid), dim3(mk::NTHREADS), mk::LDS_BYTES, stream, a);
}
```

```cpp
#include <hip/hip_runtime.h>
#include <stdint.h>
#include <math.h>

typedef unsigned short bf16_t;

namespace nv {
constexpr int B = 4, S = 8192, T = B * S, D = 1024;
constexpr int NIN0 = 1792;
constexpr int MEM = 256, XH = 4, XHD = 256;
constexpr int NE = 16, DE = 512;
constexpr int MPAD = 65536 + 16 * 256;
constexpr int NTILE = MPAD / 256;
constexpr float ALPHA = 1.4142135623730951f;
constexpr float LN_EPS = 1e-5f;
constexpr float QSCALE = 0.0625f * 1.4426950408889634f;
constexpr float ASCALE = 0.125f * 1.4426950408889634f;

constexpr size_t MiB = 1u << 20;
constexpr size_t WS_CTL = 0;
constexpr size_t WS_ROPE = 2 * MiB;
constexpr size_t WS_EIDX = 4 * MiB;
constexpr size_t WS_EWGT = 5 * MiB;
constexpr size_t WS_POS = 6 * MiB;
constexpr size_t WS_BCNT = 7 * MiB;
constexpr size_t WS_TILE = 7 * MiB + 65536;
constexpr size_t WS_TOK = 7 * MiB + 131072;
constexpr size_t WS_MEMKV = 8 * MiB;
constexpr size_t WS_MEMB = 20 * MiB;
constexpr size_t WS_WB = 24 * MiB;
constexpr size_t WS_A = 152 * MiB, WS_B = 220 * MiB, WS_C = 288 * MiB, WS_D = 356 * MiB;
constexpr size_t WS_MT = 492 * MiB;
constexpr size_t WS_NT = 500 * MiB;
constexpr size_t WS_END = 508 * MiB;
constexpr size_t WB_IN0 = 0;
constexpr size_t WB_OUT0 = WB_IN0 + (size_t)1792 * 1024;
constexpr size_t WB_IN1 = WB_OUT0 + (size_t)1024 * 1024;
constexpr size_t WB_POOL = WB_IN1 + (size_t)1024 * 1024;
constexpr size_t WB_OUT1 = WB_POOL + (size_t)1024 * 256;
constexpr size_t WB_WEFF = WB_OUT1 + (size_t)1024 * 1024;
constexpr size_t WB_SGUW = WB_WEFF + (size_t)1024 * 1024;
constexpr size_t WB_LAYER = WB_SGUW + (size_t)8 * 128 * 128;
constexpr size_t WL_XQ = 0;
constexpr size_t WL_XKV = WL_XQ + (size_t)1024 * 1024;
constexpr size_t WL_XO = WL_XKV + (size_t)2048 * 1024;
constexpr size_t WL_GU = WL_XO + (size_t)1024 * 1024;
constexpr size_t WL_DN = WL_GU + (size_t)16 * 1024 * 1024;
constexpr size_t WL_SIZE = WL_DN + (size_t)16 * 1024 * 512;
static_assert((WB_LAYER + 2 * WL_SIZE) * 2 <= 128 * MiB, "bf16 weight region");

__device__ __forceinline__ float bf2f(bf16_t v) { return __uint_as_float((unsigned)v << 16); }
__device__ __forceinline__ bf16_t f2bf(float f) { unsigned u = __float_as_uint(f); return (bf16_t)((u + 0x7fffu + ((u >> 16) & 1u)) >> 16); }
__device__ __forceinline__ float gelu_tanh(float x) { const float u = 0.7978845608028654f * (x + 0.044715f * x * x * x); const float e = __expf(2.f * u); const float th = 1.f - 2.f / (e + 1.f); return 0.5f * x * (1.f + th); }
__device__ __forceinline__ float silu(float x) { return x / (1.f + __expf(-x)); }
template <int M> __device__ __forceinline__ float swz_xor(float v) { return __int_as_float(__builtin_amdgcn_ds_swizzle(__float_as_int(v), (M << 10) | 0x1f)); }
__device__ __forceinline__ float wave_sum(float v) {
    v += swz_xor<1>(v); v += swz_xor<2>(v); v += swz_xor<4>(v); v += swz_xor<8>(v); v += swz_xor<16>(v);
    const auto r = __builtin_amdgcn_permlane32_swap(__float_as_uint(v), __float_as_uint(v), false, false);
    return __uint_as_float(r[0]) + __uint_as_float(r[1]);
}
__device__ __forceinline__ float wave_max(float v) {
    v = fmaxf(v, swz_xor<1>(v)); v = fmaxf(v, swz_xor<2>(v)); v = fmaxf(v, swz_xor<4>(v)); v = fmaxf(v, swz_xor<8>(v)); v = fmaxf(v, swz_xor<16>(v));
    const auto r = __builtin_amdgcn_permlane32_swap(__float_as_uint(v), __float_as_uint(v), false, false);
    return fmaxf(__uint_as_float(r[0]), __uint_as_float(r[1]));
}
}

namespace pg8 {
#define PG8_LAS __attribute__((address_space(3)))
typedef short bf16x8 __attribute__((ext_vector_type(8)));
typedef float f32x4 __attribute__((ext_vector_type(4)));
typedef float f32x2 __attribute__((ext_vector_type(2)));
typedef unsigned u32x4 __attribute__((ext_vector_type(4)));
typedef unsigned u32x2 __attribute__((ext_vector_type(2)));
typedef int i32x8 __attribute__((ext_vector_type(8)));
constexpr int BM = 256, BK = 64, HALF = 128, HTB = HALF * BK * 2  , STAGE_BYTES = 8 * HTB, NXCD = 8, WGM = 8;

__host__ __device__ __forceinline__ int lds_byte(int r, int c) { const int st = (r >> 4) * 2 + (c >> 5), rr = r & 15, cc = c & 31, ob = rr * 64 + cc * 2; return st * 1024 + (ob ^ (((ob >> 9) & 1) << 5)); }
__host__ __device__ __forceinline__ void stage_rc(int b, int& R, int& C) { const int st = b / 1024, sb = b % 1024, swz = sb ^ (((sb >> 9) & 1) << 5); R = (st >> 1) * 16 + swz / 64; C = (st & 1) * 32 + (swz % 64) / 2; }
__host__ __device__ __forceinline__ int perm32(int rho) { const int n = rho >> 4, i = rho & 15; return 8 * (i >> 2) + 4 * n + (i & 3); }

struct Unit { int pm, pn, ao, bo; };
struct Gemm { const bf16_t* A; const bf16_t* Bt; const int* arow; };

template <bool BATCHED = false>
struct StaticOrderT {
    int nM, nN, nwg, G, c, lda, ldb, apn;
    __device__ void init(int M, int N, int G_, int c_, int lda_, int ldb_, int apn_ = 0) { nM = M / BM; nN = N / BM; nwg = nM * nN; G = G_; c = c_; lda = lda_; ldb = ldb_; apn = apn_; }
    __device__ bool next(int i, Unit& u) const {
        const long L = (long)i * G + c; if (L >= nwg) return false;
        int wgid = (int)L; { const int q = nwg / NXCD, r = nwg % NXCD, xcd = wgid % NXCD, off = wgid / NXCD; wgid = (xcd < r ? xcd * (q + 1) : r * (q + 1) + (xcd - r) * q) + off; }
        const int nig = WGM * nN, gid = wgid / nig, fm = gid * WGM, gsz = (nM - fm) < WGM ? (nM - fm) : WGM;
        u.pm = fm + ((wgid % nig) % gsz); u.pn = (wgid % nig) / gsz;
        u.ao = u.pm * BM * lda + u.pn * apn; u.bo = (BATCHED ? ((u.pm >> 5) * 4 + u.pn) : u.pn) * BM * ldb; return true;
    }
};
typedef StaticOrderT<false> StaticOrder;
typedef StaticOrderT<true> BatchOrder;
struct MoeOrder {
    int nM, nwg, G, c, lda, ldb; const int* tile_e;
    __device__ void init(int ntiles, const int* te, int G_, int c_, int lda_, int ldb_) { nM = ntiles; nwg = nM * 4; G = G_; c = c_; tile_e = te; lda = lda_; ldb = ldb_; }
    __device__ bool next(int i, Unit& u) const {
        const long L = (long)i * G + c; if (L >= nwg) return false;
        int wgid = (int)L; { const int q = nwg / NXCD, r = nwg % NXCD, xcd = wgid % NXCD, off = wgid / NXCD; wgid = (xcd < r ? xcd * (q + 1) : r * (q + 1) + (xcd - r) * q) + off; }
        const int nig = WGM * 4, gid = wgid / nig, fm = gid * WGM, gsz = (nM - fm) < WGM ? (nM - fm) : WGM;
        u.pm = fm + ((wgid % nig) % gsz); u.pn = (wgid % nig) / gsz;
        const int e = __builtin_amdgcn_readfirstlane(tile_e[u.pm]); u.ao = u.pm * BM * lda; u.bo = (e * 4 + u.pn) * BM * ldb; return true;
    }
};
template <int KIND>
struct SetupOrder {
    int idx, n;
    __device__ void init(int c, int c0, int n_) { idx = c - c0; n = n_; }
    __device__ bool next(int i, Unit& u) const {
        if (i != 0 || idx < 0 || idx >= n) return false;
        const int x = idx >> 4, y = (idx >> 2) & 3, z = idx & 3;
        if (KIND == 0) { u.pm = x * 4 + y; u.pn = z; u.ao = (x * 256) * 2048 + y * 256; u.bo = z * 256 * 1024 + y * 256; }
        if (KIND == 1) { u.pm = x * 4 + y; u.pn = z; u.ao = y * 256 * 1024 + z * 256; u.bo = (x * 256) * 2048 + 1024 + z * 256; }
        if (KIND == 2) { u.pm = y; u.pn = z; u.ao = y * 256 * 1024 + z * 256; u.bo = z * 256 * 256; }
        return true;
    }
};

__device__ __forceinline__ int fresh_lane() { unsigned m = ~0u; asm volatile("" : "+s"(m)); return (int)__builtin_amdgcn_mbcnt_hi(m, __builtin_amdgcn_mbcnt_lo(m, 0u)); }
__device__ __forceinline__ unsigned cvt_pk_bf16(float lo, float hi) { unsigned r; asm volatile("v_cvt_pk_bf16_f32 %0, %1, %2" : "=v"(r) : "v"(lo), "v"(hi)); return r; }


template <class Epi, class Sched, bool ALIGN_EPI, bool SP2, bool GATHER, int LDA, int LDB, int KK, bool FP8 = false>
__device__ __forceinline__ void gemm_phase(PG8_LAS unsigned char* lds, int tid_in, const Gemm g, const Sched& S, const Epi& E) {
    int tid_ = tid_in; asm volatile("" : "+v"(tid_));
    const int tid = tid_, wid = __builtin_amdgcn_readfirstlane(tid >> 6), lane = tid & 63, wr = wid >> 2, wc = wid & 3, fr = lane & 15, fq = lane >> 4;
    constexpr int ELT = FP8 ? 1 : 2, K = KK, nt = K * ELT / (BK * 2), lda = LDA * ELT, ldb = LDB * ELT; (void)K;
    unsigned voffA[2], voffB[2];
#pragma unroll
    for (int i = 0; i < 2; ++i) { int R, C; stage_rc(tid * 16 + i * 8192, R, C); const int Rb = Epi::PERM ? ((R & ~31) + perm32(R & 31)) : R;
        voffA[i] = GATHER ? (unsigned)C * 2u : (unsigned)(R * lda + C * 2); voffB[i] = (unsigned)(Rb * ldb + C * 2); }
    const size_t kstep = (size_t)(BK * 2);
    const size_t hstepA = GATHER ? 0 : (size_t)HALF * lda, hstepB = (size_t)HALF * ldb;
    const unsigned ldsw = (unsigned)wid * 1024u, ldsbase = (unsigned)(size_t)lds;
    const int aoff = lds_byte(wr * 64 + fr, fq * 8), boff = lds_byte(wc * 32 + fr, fq * 8);
    unsigned cg[2][2];
#define PG8_SA(b, h) (((b) * 2 + (h)) * HTB)
#define PG8_SB(b, h) ((4 + (b) * 2 + (h)) * HTB)
#define PG8_GLDS(sbase, voff32, ldsaddr) asm volatile("s_mov_b32 m0, %2\n\ts_nop 0\n\tglobal_load_lds_dwordx4 %0, %1" :: "v"(voff32), "s"(sbase), "s"(ldsaddr) : "memory", "m0")
#define PG8_STAGE(bufoff, gbase, voff) do { const char* _sb = (const char*)(gbase); _Pragma("unroll") for (int _i = 0; _i < 2; ++_i) \
        PG8_GLDS(_sb, (voff)[_i], (unsigned)(ldsbase + (bufoff) + ldsw + _i * 8192)); } while (0)
#define PG8_STAGE_A(bufoff, abase, h, GO) do { const char* _sb = GATHER ? (const char*)(abase) : (const char*)(abase) + ((h) ? hstepA : (size_t)0); _Pragma("unroll") for (int _i = 0; _i < 2; ++_i) \
        PG8_GLDS(_sb, (GATHER ? GO[h][_i] : voffA[_i]), (unsigned)(ldsbase + (bufoff) + ldsw + _i * 8192)); } while (0)
#define PG8_GLOAD(dst, pm_) do { const int _t = wid * 64 + fresh_lane(); int rowA_[2]; unsigned colA_[2]; _Pragma("unroll") for (int _i = 0; _i < 2; ++_i) { int _R, _C; stage_rc(_t * 16 + _i * 8192, _R, _C); rowA_[_i] = _R; colA_[_i] = (unsigned)_C * 2u; }   \
        _Pragma("unroll") for (int _h = 0; _h < 2; ++_h) _Pragma("unroll") for (int _i = 0; _i < 2; ++_i) \
        dst[_h][_i] = (unsigned)g.arow[(pm_) * BM + _h * HALF + rowA_[_i]] * (unsigned)lda + colA_[_i]; } while (0)
#define PG8_GSWITCH do { if constexpr (GATHER) { if (last && has_next) { PG8_GLOAD(cg, nxt.pm); } } } while (0)
#define PG8_LDA(dst, b, h) do { _Pragma("unroll") for (int m = 0; m < 4; ++m) { if constexpr (FP8) { typedef int i32x4_ __attribute__((ext_vector_type(4))); \
        dst##8[m] = __builtin_shufflevector(*(const PG8_LAS i32x4_*)(lds + PG8_SA(b, h) + aoff + m * 2048), *(const PG8_LAS i32x4_*)(lds + PG8_SA(b, h) + aoff + m * 2048 + 1024), 0, 1, 2, 3, 4, 5, 6, 7); } \
        else { _Pragma("unroll") for (int k = 0; k < 2; ++k) dst[m][k] = *(const PG8_LAS bf16x8*)(lds + PG8_SA(b, h) + aoff + m * 2048 + k * 1024); } } } while (0)
#define PG8_LDB(dst, b, h) do { _Pragma("unroll") for (int n = 0; n < 2; ++n) { if constexpr (FP8) { typedef int i32x4_ __attribute__((ext_vector_type(4))); \
        dst##8[n] = __builtin_shufflevector(*(const PG8_LAS i32x4_*)(lds + PG8_SB(b, h) + boff + n * 2048), *(const PG8_LAS i32x4_*)(lds + PG8_SB(b, h) + boff + n * 2048 + 1024), 0, 1, 2, 3, 4, 5, 6, 7); } \
        else { _Pragma("unroll") for (int k = 0; k < 2; ++k) dst[n][k] = *(const PG8_LAS bf16x8*)(lds + PG8_SB(b, h) + boff + n * 2048 + k * 1024); } } } while (0)
#define PG8_MMA(ai, bj, At, Bt) do { __builtin_amdgcn_s_setprio(1); _Pragma("unroll") for (int m = 0; m < 4; ++m) _Pragma("unroll") for (int n = 0; n < 2; ++n) { \
        if constexpr (FP8) acc[ai][bj][m][n] = __builtin_amdgcn_mfma_scale_f32_16x16x128_f8f6f4(Bt##8[n], At##8[m], acc[ai][bj][m][n], 0, 0, 0, 0x7f7f7f7f, 0, 0x7f7f7f7f); \
        else { _Pragma("unroll") for (int k = 0; k < 2; ++k) acc[ai][bj][m][n] = __builtin_amdgcn_mfma_f32_16x16x32_bf16(Bt[n][k], At[m][k], acc[ai][bj][m][n], 0, 0, 0); } } \
        __builtin_amdgcn_s_setprio(0); } while (0)
#define PG8_WAIT_V(n) asm volatile("s_waitcnt vmcnt(" #n ")" ::: "memory")
#define PG8_WAIT_L(n) asm volatile("s_waitcnt lgkmcnt(" #n ")" ::: "memory")
#define PG8_BAR __builtin_amdgcn_s_barrier()
#define PG8_SCHED __builtin_amdgcn_sched_barrier(0)
    Unit cur, nxt; int ui = 0;
    if (!S.next(0, cur)) return;
    f32x4 acc[2][2][4][2];
#pragma unroll
    for (int a = 0; a < 2; ++a)
#pragma unroll
        for (int b = 0; b < 2; ++b)
#pragma unroll
            for (int m = 0; m < 4; ++m)
#pragma unroll
                for (int n = 0; n < 2; ++n) acc[a][b][m][n] = (f32x4){0.f, 0.f, 0.f, 0.f};
    bf16x8 At[4][2], B0[2][2], B1[2][2]; i32x8 At8[4], B08[2], B18[2];
    const char* cA = GATHER ? (const char*)g.A : (const char*)g.A + (size_t)cur.ao * ELT; const char* cB = (const char*)g.Bt + (size_t)cur.bo * ELT;
    if constexpr (GATHER) { PG8_GLOAD(cg, cur.pm); }
    if constexpr (SP2) {
        PG8_STAGE(PG8_SB(0, 0), cB, voffB); PG8_STAGE(PG8_SB(0, 1), cB + hstepB, voffB); PG8_STAGE_A(PG8_SA(0, 0), cA, 0, cg); PG8_STAGE_A(PG8_SA(0, 1), cA, 1, cg);
        if (wr == 1) PG8_BAR;
        PG8_WAIT_V(2); PG8_BAR;
        PG8_STAGE(PG8_SB(1, 0), cB + kstep, voffB); PG8_STAGE_A(PG8_SA(1, 0), cA + kstep, 0, cg); PG8_STAGE(PG8_SB(1, 1), cB + hstepB + kstep, voffB);
        PG8_WAIT_V(6); PG8_BAR;
    } else {
        PG8_STAGE(PG8_SB(0, 0), cB, voffB); PG8_STAGE_A(PG8_SA(0, 0), cA, 0, cg); PG8_STAGE(PG8_SB(0, 1), cB + hstepB, voffB); PG8_STAGE_A(PG8_SA(0, 1), cA, 1, cg);
        if (wr == 1) PG8_BAR;
        PG8_WAIT_V(4); PG8_BAR;
        PG8_STAGE(PG8_SB(1, 0), cB + kstep, voffB); PG8_STAGE_A(PG8_SA(1, 0), cA + kstep, 0, cg); PG8_STAGE(PG8_SB(1, 1), cB + hstepB + kstep, voffB);
        PG8_WAIT_V(6); PG8_BAR;
    }
    for (;;) {
        const bool has_next = S.next(ui + 1, nxt);
        const char* nA = GATHER ? (const char*)g.A : (has_next ? (const char*)g.A + (size_t)nxt.ao * ELT : cA);
        const char* nB = has_next ? (const char*)g.Bt + (size_t)nxt.bo * ELT : cB;
#pragma unroll 1
        for (int t = 0; t < nt; t += 2) {
            const bool last = (t == nt - 2);
            const char* a1 = cA + (size_t)(t + 1) * kstep;
            const char* a2 = last ? nA : cA + (size_t)(t + 2) * kstep; const char* b2 = last ? nB : cB + (size_t)(t + 2) * kstep;
            const char* a3 = a2 + kstep; const char* b3 = b2 + kstep;
            if constexpr (SP2) {
            PG8_LDB(B0, 0, 0); PG8_LDB(B1, 0, 1); PG8_SCHED; PG8_LDA(At, 0, 0); PG8_STAGE_A(PG8_SA(1, 1), a1, 1, cg); PG8_GSWITCH;
            PG8_WAIT_V(8); PG8_WAIT_L(0); PG8_BAR; PG8_MMA(0, 0, At, B0); PG8_MMA(0, 1, At, B1); PG8_BAR; PG8_SCHED;
            PG8_LDA(At, 0, 1); PG8_STAGE(PG8_SB(0, 0), b2, voffB); PG8_STAGE(PG8_SB(0, 1), b2 + hstepB, voffB); PG8_STAGE_A(PG8_SA(0, 0), a2, 0, cg);
            PG8_WAIT_V(8); PG8_WAIT_L(0); PG8_BAR; PG8_MMA(1, 0, At, B0); PG8_MMA(1, 1, At, B1); PG8_BAR; PG8_SCHED;
            PG8_LDB(B0, 1, 0); PG8_LDB(B1, 1, 1); PG8_SCHED; PG8_LDA(At, 1, 0); PG8_STAGE_A(PG8_SA(0, 1), a2, 1, cg);
            PG8_WAIT_V(8); PG8_WAIT_L(0); PG8_BAR; PG8_MMA(0, 0, At, B0); PG8_MMA(0, 1, At, B1); PG8_BAR; PG8_SCHED;
            PG8_LDA(At, 1, 1); PG8_STAGE(PG8_SB(1, 0), b3, voffB); PG8_STAGE(PG8_SB(1, 1), b3 + hstepB, voffB); PG8_STAGE_A(PG8_SA(1, 0), a3, 0, cg);
            PG8_WAIT_V(8); PG8_WAIT_L(0); PG8_BAR; PG8_MMA(1, 0, At, B0); PG8_MMA(1, 1, At, B1); PG8_BAR; PG8_SCHED;
            } else {
            PG8_LDB(B0, 0, 0); PG8_SCHED; PG8_LDA(At, 0, 0); PG8_STAGE_A(PG8_SA(1, 1), a1, 1, cg); PG8_GSWITCH;
            PG8_WAIT_L(8); PG8_BAR; PG8_WAIT_L(0); PG8_MMA(0, 0, At, B0); PG8_BAR; PG8_SCHED;
            PG8_LDB(B1, 0, 1); PG8_STAGE(PG8_SB(0, 0), b2, voffB);
            PG8_BAR; PG8_WAIT_L(0); PG8_MMA(0, 1, At, B1); PG8_BAR;
            PG8_LDA(At, 0, 1); PG8_STAGE_A(PG8_SA(0, 0), a2, 0, cg);
            PG8_BAR; PG8_WAIT_L(0); PG8_MMA(1, 0, At, B0); PG8_BAR; PG8_SCHED;
            PG8_STAGE(PG8_SB(0, 1), b2 + hstepB, voffB);
            PG8_WAIT_V(6); PG8_BAR; PG8_MMA(1, 1, At, B1); PG8_BAR;
            PG8_LDB(B0, 1, 0); PG8_SCHED; PG8_LDA(At, 1, 0); PG8_STAGE_A(PG8_SA(0, 1), a2, 1, cg);
            PG8_WAIT_L(8); PG8_BAR; PG8_WAIT_L(0); PG8_MMA(0, 0, At, B0); PG8_BAR; PG8_SCHED;
            PG8_LDB(B1, 1, 1); PG8_STAGE(PG8_SB(1, 0), b3, voffB);
            PG8_BAR; PG8_WAIT_L(0); PG8_MMA(0, 1, At, B1); PG8_BAR;
            PG8_LDA(At, 1, 1); PG8_STAGE_A(PG8_SA(1, 0), a3, 0, cg);
            PG8_BAR; PG8_WAIT_L(0); PG8_MMA(1, 0, At, B0); PG8_BAR; PG8_SCHED;
            PG8_STAGE(PG8_SB(1, 1), b3 + hstepB, voffB);
            PG8_WAIT_V(6); PG8_BAR; PG8_MMA(1, 1, At, B1); PG8_BAR;
            }
        }
        if constexpr (ALIGN_EPI) { if (wr == 0) PG8_BAR; }
        { const int _l = fresh_lane(); E(acc, cur, wr, wc, _l & 15, _l >> 4); }
        if (!has_next) break;
#pragma unroll
        for (int a = 0; a < 2; ++a)
#pragma unroll
            for (int b = 0; b < 2; ++b)
#pragma unroll
                for (int m = 0; m < 4; ++m)
#pragma unroll
                    for (int n = 0; n < 2; ++n) acc[a][b][m][n] = (f32x4){0.f, 0.f, 0.f, 0.f};
        cur = nxt; cA = nA; cB = nB; ++ui;
        if constexpr (ALIGN_EPI) { if (wr == 1) PG8_BAR; }
    }
    PG8_WAIT_V(0);
    if constexpr (!ALIGN_EPI) { if (wr == 0) PG8_BAR; }
    PG8_BAR;
#undef PG8_SA
#undef PG8_SB
#undef PG8_STAGE
#undef PG8_GLDS
#undef PG8_STAGE_A
#undef PG8_GLOAD
#undef PG8_GSWITCH
#undef PG8_LDA
#undef PG8_LDB
#undef PG8_MMA
#undef PG8_WAIT_V
#undef PG8_WAIT_L
#undef PG8_BAR
#undef PG8_SCHED
}
}
namespace pg8 {

__device__ __forceinline__ float fast_sigmoid_mul(float x, float z) { return x * __builtin_amdgcn_rcpf(1.f + __builtin_amdgcn_exp2f(-1.4426950408889634f * z)); }
__device__ __forceinline__ float gelu_t(float x) { const float u = 0.7978845608028654f * (x + 0.044715f * x * x * x); return fast_sigmoid_mul(x, 2.f * u); }
__device__ __forceinline__ float silu_f(float x) { return fast_sigmoid_mul(x, x); }
__device__ __forceinline__ u32x4 pack8(const f32x4 v0, const f32x4 v1) { u32x4 w; w.x = cvt_pk_bf16(v0[0], v0[1]); w.y = cvt_pk_bf16(v0[2], v0[3]); w.z = cvt_pk_bf16(v1[0], v1[1]); w.w = cvt_pk_bf16(v1[2], v1[3]); return w; }

struct EpiBf16 {
    static constexpr bool PERM = true;
    bf16_t* O; int ldo; float scale;
    __device__ __forceinline__ void operator()(f32x4 (&acc)[2][2][4][2], const Unit& u, int wr, int wc, int fr, int fq) const {
        const int row0 = u.pm * BM + wr * 64 + fr, col0 = u.pn * BM + wc * 32 + 8 * fq;
#pragma unroll
        for (int ai = 0; ai < 2; ++ai)
#pragma unroll
            for (int m = 0; m < 4; ++m) { bf16_t* rowp = O + (size_t)(row0 + ai * HALF + m * 16) * ldo + col0;
#pragma unroll
                for (int bj = 0; bj < 2; ++bj) *(u32x4*)(rowp + bj * HALF) = pack8(acc[ai][bj][m][0] * scale, acc[ai][bj][m][1] * scale); }
    }
};
__device__ __forceinline__ unsigned pk4_fp8(float a, float b, float c, float d) {
    a = __builtin_amdgcn_fmed3f(a, -448.f, 448.f); b = __builtin_amdgcn_fmed3f(b, -448.f, 448.f); c = __builtin_amdgcn_fmed3f(c, -448.f, 448.f); d = __builtin_amdgcn_fmed3f(d, -448.f, 448.f);
    unsigned p = 0u; p = (unsigned)__builtin_amdgcn_cvt_pk_fp8_f32(a, b, (int)p, false); p = (unsigned)__builtin_amdgcn_cvt_pk_fp8_f32(c, d, (int)p, true); return p;
}
constexpr float F8_XS = 16.f, F8_WS = 64.f, F8_HS = 8.f;
struct EpiF8 {
    static constexpr bool PERM = true;
    unsigned char* O; int ldo; float scale;
    __device__ __forceinline__ void operator()(f32x4 (&acc)[2][2][4][2], const Unit& u, int wr, int wc, int fr, int fq) const {
        const int row0 = u.pm * BM + wr * 64 + fr, col0 = u.pn * BM + wc * 32 + 8 * fq;
#pragma unroll
        for (int ai = 0; ai < 2; ++ai)
#pragma unroll
            for (int m = 0; m < 4; ++m) { unsigned char* rowp = O + (size_t)(row0 + ai * HALF + m * 16) * ldo + col0;
#pragma unroll
                for (int bj = 0; bj < 2; ++bj) { const f32x4 v0 = acc[ai][bj][m][0] * scale, v1 = acc[ai][bj][m][1] * scale;
                    u32x2 w; w.x = pk4_fp8(v0[0], v0[1], v0[2], v0[3]); w.y = pk4_fp8(v1[0], v1[1], v1[2], v1[3]); *(u32x2*)(rowp + bj * HALF) = w; } }
    }
};
constexpr float F8_MS = 64.f, F8_PS = 256.f, F8_NS = 16.f;
struct EpiGU8 {
    static constexpr bool PERM = true;
    unsigned char* HS8;
    __device__ __forceinline__ void operator()(f32x4 (&acc)[2][2][4][2], const Unit& u, int wr, int wc, int fr, int fq) const {
        const int row0 = u.pm * BM + wr * 64 + fr, col0 = u.pn * HALF + wc * 32 + 8 * fq;
        constexpr float s = 1.f / (F8_XS * F8_WS);
#pragma unroll
        for (int ai = 0; ai < 2; ++ai)
#pragma unroll
            for (int m = 0; m < 4; ++m) { unsigned char* rowp = HS8 + (size_t)(row0 + ai * HALF + m * 16) * nv::DE + col0;
                f32x4 h0, h1;
#pragma unroll
                for (int j = 0; j < 4; ++j) { h0[j] = silu_f(acc[ai][0][m][0][j] * s) * (acc[ai][1][m][0][j] * (s * F8_HS)); h1[j] = silu_f(acc[ai][0][m][1][j] * s) * (acc[ai][1][m][1][j] * (s * F8_HS)); }
                u32x2 w; w.x = pk4_fp8(h0[0], h0[1], h0[2], h0[3]); w.y = pk4_fp8(h1[0], h1[1], h1[2], h1[3]); *(u32x2*)rowp = w; }
    }
};
struct EpiGU {
    static constexpr bool PERM = true;
    bf16_t* HS;
    __device__ __forceinline__ void operator()(f32x4 (&acc)[2][2][4][2], const Unit& u, int wr, int wc, int fr, int fq) const {
        const int row0 = u.pm * BM + wr * 64 + fr, col0 = u.pn * HALF + wc * 32 + 8 * fq;
#pragma unroll
        for (int ai = 0; ai < 2; ++ai)
#pragma unroll
            for (int m = 0; m < 4; ++m) { bf16_t* rowp = HS + (size_t)(row0 + ai * HALF + m * 16) * nv::DE + col0;
                f32x4 h0, h1;
#pragma unroll
                for (int j = 0; j < 4; ++j) { h0[j] = silu_f(acc[ai][0][m][0][j]) * acc[ai][1][m][0][j]; h1[j] = silu_f(acc[ai][0][m][1][j]) * acc[ai][1][m][1][j]; }
                *(u32x4*)rowp = pack8(h0, h1); }
    }
};
template <bool OUT8>
struct EpiSoftmaxT {
    static constexpr bool PERM = true;
    void* O; PG8_LAS float* tbl; float in_scale;
    __device__ __forceinline__ void operator()(f32x4 (&acc)[2][2][4][2], const Unit& u, int wr, int wc, int fr, int fq) const {
        const int row0 = u.pm * BM + wr * 64 + fr, col0 = u.pn * BM + wc * 32 + 8 * fq;
#pragma unroll
        for (int ai = 0; ai < 2; ++ai)
#pragma unroll
            for (int m = 0; m < 4; ++m) { float mx = -INFINITY;
#pragma unroll
                for (int bj = 0; bj < 2; ++bj)
#pragma unroll
                    for (int n = 0; n < 2; ++n)
#pragma unroll
                        for (int j = 0; j < 4; ++j) { acc[ai][bj][m][n][j] *= in_scale; mx = fmaxf(mx, acc[ai][bj][m][n][j]); }
                mx = fmaxf(mx, nv::swz_xor<16>(mx));
                { const auto r = __builtin_amdgcn_permlane32_swap(__float_as_uint(mx), __float_as_uint(mx), false, false); mx = fmaxf(__uint_as_float(r[0]), __uint_as_float(r[1])); }
                if (fq == 0) tbl[(ai * HALF + wr * 64 + m * 16 + fr) * 4 + wc] = mx; }
        asm volatile("s_waitcnt lgkmcnt(0)" ::: "memory"); __builtin_amdgcn_s_barrier(); asm volatile("" ::: "memory");
#pragma unroll
        for (int ai = 0; ai < 2; ++ai)
#pragma unroll
            for (int m = 0; m < 4; ++m) { const f32x4 t4 = *(const PG8_LAS f32x4*)(tbl + (ai * HALF + wr * 64 + m * 16 + fr) * 4);
                const float M = fmaxf(fmaxf(t4[0], t4[1]), fmaxf(t4[2], t4[3])); float s = 0.f;
#pragma unroll
                for (int bj = 0; bj < 2; ++bj)
#pragma unroll
                    for (int n = 0; n < 2; ++n)
#pragma unroll
                        for (int j = 0; j < 4; ++j) { const float p = __builtin_amdgcn_exp2f(acc[ai][bj][m][n][j] - M); acc[ai][bj][m][n][j] = p; s += p; }
                s += nv::swz_xor<16>(s);
                { const auto r = __builtin_amdgcn_permlane32_swap(__float_as_uint(s), __float_as_uint(s), false, false); s = __uint_as_float(r[0]) + __uint_as_float(r[1]); }
                if (fq == 0) tbl[1024 + (ai * HALF + wr * 64 + m * 16 + fr) * 4 + wc] = s; }
        asm volatile("s_waitcnt lgkmcnt(0)" ::: "memory"); __builtin_amdgcn_s_barrier(); asm volatile("" ::: "memory");
#pragma unroll
        for (int ai = 0; ai < 2; ++ai)
#pragma unroll
            for (int m = 0; m < 4; ++m) { const f32x4 t4 = *(const PG8_LAS f32x4*)(tbl + 1024 + (ai * HALF + wr * 64 + m * 16 + fr) * 4);
                const float inv = 1.f / ((t4[0] + t4[1]) + (t4[2] + t4[3]));
                if constexpr (OUT8) { unsigned char* rowp = (unsigned char*)O + (size_t)(row0 + ai * HALF + m * 16) * nv::D + col0; const float s8 = inv * F8_PS;
#pragma unroll
                    for (int bj = 0; bj < 2; ++bj) { const f32x4 v0 = acc[ai][bj][m][0] * s8, v1 = acc[ai][bj][m][1] * s8;
                        u32x2 w; w.x = pk4_fp8(v0[0], v0[1], v0[2], v0[3]); w.y = pk4_fp8(v1[0], v1[1], v1[2], v1[3]); *(u32x2*)(rowp + bj * HALF) = w; } }
                else { bf16_t* rowp = (bf16_t*)O + (size_t)(row0 + ai * HALF + m * 16) * nv::D + col0;
#pragma unroll
                    for (int bj = 0; bj < 2; ++bj) *(u32x4*)(rowp + bj * HALF) = pack8(acc[ai][bj][m][0] * inv, acc[ai][bj][m][1] * inv); } }
    }
};
struct EpiInproj0 {
    static constexpr bool PERM = true;
    bf16_t* O; const float* rope; float in_scale;
    __device__ __forceinline__ void operator()(f32x4 (&acc)[2][2][4][2], const Unit& u, int wr, int wc, int fr, int fq) const {
        const int row0 = u.pm * BM + wr * 64 + fr, col0 = u.pn * BM + wc * 32 + 8 * fq;
#pragma unroll
        for (int ai = 0; ai < 2; ++ai)
#pragma unroll
            for (int bj = 0; bj < 2; ++bj)
#pragma unroll
                for (int m = 0; m < 4; ++m) { acc[ai][bj][m][0] *= in_scale; acc[ai][bj][m][1] *= in_scale; }
        if (u.pn >= 3) {
#pragma unroll
            for (int ai = 0; ai < 2; ++ai)
#pragma unroll
                for (int m = 0; m < 4; ++m) { bf16_t* rowp = O + (size_t)(row0 + ai * HALF + m * 16) * nv::NIN0 + col0;
#pragma unroll
                    for (int bj = 0; bj < 2; ++bj) { f32x4 v0 = acc[ai][bj][m][0], v1 = acc[ai][bj][m][1];
#pragma unroll
                        for (int j = 0; j < 4; ++j) { v0[j] = gelu_t(v0[j]); v1[j] = gelu_t(v1[j]); }
                        *(u32x4*)(rowp + bj * HALF) = pack8(v0, v1); } }
        } else {
            const bool wave_rope = (wc & 1) == 0;
            const float sgn = fq == 0 ? -1.f : 1.f;
#pragma unroll
            for (int ai = 0; ai < 2; ++ai)
#pragma unroll
                for (int m = 0; m < 4; ++m) { const int row = row0 + ai * HALF + m * 16; bf16_t* rowp = O + (size_t)row * nv::NIN0 + col0;
                    f32x4 c0, c1, s0, s1;
                    if (wave_rope) { const float* rp = rope + (size_t)row * 16; c0 = *(const f32x4*)rp; c1 = *(const f32x4*)(rp + 4); s0 = *(const f32x4*)(rp + 8); s1 = *(const f32x4*)(rp + 12); }
#pragma unroll
                    for (int bj = 0; bj < 2; ++bj) { f32x4 v0 = acc[ai][bj][m][0], v1 = acc[ai][bj][m][1];
                        if (wave_rope && (u.pn < 2 || bj == 0)) {
                            f32x4 p0, p1;
#pragma unroll
                            for (int j = 0; j < 4; ++j) { p0[j] = nv::swz_xor<16>(v0[j]); p1[j] = nv::swz_xor<16>(v1[j]); }
                            if (fq < 2) {
#pragma unroll
                                for (int j = 0; j < 4; ++j) { v0[j] = v0[j] * c0[j] + sgn * p0[j] * s0[j]; v1[j] = v1[j] * c1[j] + sgn * p1[j] * s1[j]; } }
                        }
                        *(u32x4*)(rowp + bj * HALF) = pack8(v0, v1); } }
        }
    }
};
}

#define LAS __attribute__((address_space(3)))
#define GAS __attribute__((address_space(1)))
typedef GAS unsigned gu32;
#define RLX_AGENT __ATOMIC_RELAXED, __HIP_MEMORY_SCOPE_AGENT
#define LDS_WAIT() asm volatile("s_waitcnt lgkmcnt(0)" ::: "memory")
#define VM_WAIT() asm volatile("s_waitcnt vmcnt(0)" ::: "memory")

#define XB_TMO      128
#define XB_XCNT(j)  (256  + 64 * (j))
#define XB_XSUB(j)  (1280 + 64 * (j))
#define XB_XGEN(j)  (2304 + 64 * (j))
#define XB_TOP      3328
#define XB_TOPGEN   3392
#define XCD_BAR_WORDS 3456
#define XB_SPIN_CAP (1u << 18)
__device__ __forceinline__ unsigned xb_ld(unsigned* p)              { return __hip_atomic_load(p, __ATOMIC_RELAXED, __HIP_MEMORY_SCOPE_AGENT); }
__device__ __forceinline__ unsigned xb_add(unsigned* p, unsigned v) { return __hip_atomic_fetch_add(p, v, __ATOMIC_RELAXED, __HIP_MEMORY_SCOPE_AGENT); }
__device__ __forceinline__ unsigned xb_xcc_id() { return (unsigned)__builtin_amdgcn_s_getreg((3 << 11) | 20) & 0xFu; }
#define XB_SPIN(cond, bar) do { unsigned _sp = 0; while (cond) { __builtin_amdgcn_s_sleep(1); \
    if ((++_sp & 255u) == 0u) { if (xb_ld(&(bar)[XB_TMO])) break; if (_sp > XB_SPIN_CAP) { atomicAdd(&(bar)[XB_TMO], 1u); break; } } } } while (0)
struct XcdBarrier { unsigned* bar; unsigned x; volatile LAS unsigned* st; int wave; };
__device__ __forceinline__ unsigned lane_id_fresh() { unsigned m = ~0u; asm volatile("" : "+s"(m)); return __builtin_amdgcn_mbcnt_hi(m, __builtin_amdgcn_mbcnt_lo(m, 0u)); }
__device__ __forceinline__ bool xb_thread0(int wave) { return wave == 0 && lane_id_fresh() == 0u; }
__device__ __forceinline__ XcdBarrier xcd_barrier_post(unsigned* bar, volatile LAS unsigned* st, int wave) {
    XcdBarrier b; b.bar = bar; b.x = xb_xcc_id(); b.st = st; b.wave = wave;
    if (xb_thread0(wave)) (void)xb_add(&bar[XB_XCNT(b.x)], 1u);
    return b;
}
__device__ __forceinline__ void xcd_barrier_complete(unsigned* bar, unsigned x, unsigned& nloc, unsigned& nx) {
    const unsigned G = gridDim.x * gridDim.y * gridDim.z;
    unsigned sum, cnt, mine, sp = 0u;
    for (;;) {
        sum = 0u; cnt = 0u; mine = 0u;
#pragma unroll
        for (unsigned j = 0; j < 16; ++j) { const unsigned c = xb_ld(&bar[XB_XCNT(j)]); sum += c; cnt += (c > 0u) ? 1u : 0u; mine = (j == x) ? c : mine; }
        if (sum == G) break;
        __builtin_amdgcn_s_sleep(1);
        if ((++sp & 255u) == 0u) { if (xb_ld(&bar[XB_TMO])) break; if (sp > XB_SPIN_CAP) { atomicAdd(&bar[XB_TMO], 1u); break; } }
    }
    nloc = mine > 0u ? mine : 1u; nx = cnt > 0u ? cnt : 1u;
}
__device__ __forceinline__ void xcd_barrier(const XcdBarrier& b) {
    asm volatile("s_waitcnt vmcnt(0)" ::: "memory");
    __syncthreads();
    if (xb_thread0(b.wave)) {
        unsigned* bar = b.bar;
        __builtin_amdgcn_s_waitcnt(0);
        unsigned nloc = b.st[0], nx = b.st[1];
        if (nloc == 0u) { xcd_barrier_complete(bar, b.x, nloc, nx); b.st[0] = nloc; b.st[1] = nx; }
        const unsigned old = xb_add(&bar[XB_XSUB(b.x)], 1u);
        const unsigned gen = old / nloc;
        if (old + 1u == (gen + 1u) * nloc) {
            __builtin_amdgcn_fence(__ATOMIC_RELEASE, "agent");
            asm volatile("s_waitcnt vmcnt(0)" ::: "memory");
            const unsigned og = xb_add(&bar[XB_TOP], 1u);
            const unsigned tg = og / nx;
            if (og + 1u == (tg + 1u) * nx) xb_add(&bar[XB_TOPGEN], 1u);
            else XB_SPIN(xb_ld(&bar[XB_TOPGEN]) == tg, bar);
            __builtin_amdgcn_fence(__ATOMIC_ACQUIRE, "agent");
            xb_add(&bar[XB_XGEN(b.x)], 1u);
            asm volatile("s_waitcnt vmcnt(0)" ::: "memory");
        } else {
            XB_SPIN(xb_ld(&bar[XB_XGEN(b.x)]) == gen, bar);
            __builtin_amdgcn_fence(__ATOMIC_ACQUIRE, "agent");
            asm volatile("s_waitcnt vmcnt(0)" ::: "memory");
        }
    }
    __syncthreads();
}

namespace mk {
using namespace nv;
typedef unsigned v4u __attribute__((ext_vector_type(4)));
typedef unsigned v2u __attribute__((ext_vector_type(2)));
typedef float f32x4 __attribute__((ext_vector_type(4)));
constexpr int NWAVES = 8, NTHREADS = 512;
constexpr int LDS_BYTES = 160 * 1024;
constexpr int MISC_OFF = LDS_BYTES - 256;
constexpr int CW_BAR = 4096;
constexpr size_t CTL_ZERO_BYTES = 64 * 1024;

__device__ __forceinline__ unsigned pk2(float lo, float hi) { return (unsigned)f2bf(lo) | ((unsigned)f2bf(hi) << 16); }

struct Frame {
    LAS unsigned char* lds; int tid, lane, wave, vcu, G, bx;
};

template <bool F8>
__device__ __forceinline__ void transpose_item(const float* W, int ldw, void* WT, int ldt, int k0, int n0, int dest_row0, LAS float* scr, int lane, float wscale) {
#pragma unroll 8
    for (int i = 0; i < 32; ++i) { const int kk = 2 * i + (lane >> 5); scr[kk * 33 + (lane & 31)] = W[(size_t)(k0 + kk) * ldw + n0 + (lane & 31)] * wscale; }
    LDS_WAIT(); asm volatile("" ::: "memory");
    const int c = lane & 7;
#pragma unroll
    for (int j = 0; j < 4; ++j) { const int n = (lane >> 3) + 8 * j; const LAS float* s = scr + (8 * c) * 33 + n;
        if constexpr (F8) { v2u o; o.x = pg8::pk4_fp8(s[0 * 33], s[1 * 33], s[2 * 33], s[3 * 33]); o.y = pg8::pk4_fp8(s[4 * 33], s[5 * 33], s[6 * 33], s[7 * 33]);
            *(v2u*)((unsigned char*)WT + (size_t)(dest_row0 + n) * ldt + k0 + 8 * c) = o; }
        else { v4u o; o.x = pk2(s[0 * 33], s[1 * 33]); o.y = pk2(s[2 * 33], s[3 * 33]); o.z = pk2(s[4 * 33], s[5 * 33]); o.w = pk2(s[6 * 33], s[7 * 33]);
            *(v4u*)((bf16_t*)WT + (size_t)(dest_row0 + n) * ldt + k0 + 8 * c) = o; } }
    LDS_WAIT(); asm volatile("" ::: "memory");
}
template <int MAP, bool F8>
__device__ __forceinline__ void transpose_job_item(const float* src, int K, int N, void* dst, size_t dstb, int r, LAS float* scr, int lane) {
    const int nblk = N / 32, per = (K / 64) * nblk, bi = r / per, it = r % per, kb = it / nblk, nb = it % nblk, n0 = 32 * nb;
    int dr = n0; if (MAP == 1) dr = (n0 >> 7) * 256 + (n0 & 127); if (MAP == 2) dr = (n0 >> 7) * 256 + 128 + (n0 & 127);
    transpose_item<F8>(src + (size_t)bi * K * N, N, (unsigned char*)dst + (size_t)bi * dstb * (F8 ? 1 : 2), K, 64 * kb, n0, dr, scr, lane, F8 ? pg8::F8_WS : 1.f);
}

struct InvFreq { float f[8]; };
struct Args {
    const void* in[40]; float* out; unsigned char* ws; InvFreq inv; int ph_lo, ph_hi;
};

struct RowV { float v[16]; };
__device__ __forceinline__ void unpk8(const v4u u, float* x) {
    x[0] = __uint_as_float(u.x << 16); x[1] = __uint_as_float(u.x & 0xffff0000u); x[2] = __uint_as_float(u.y << 16); x[3] = __uint_as_float(u.y & 0xffff0000u);
    x[4] = __uint_as_float(u.z << 16); x[5] = __uint_as_float(u.z & 0xffff0000u); x[6] = __uint_as_float(u.w << 16); x[7] = __uint_as_float(u.w & 0xffff0000u);
}
struct RowRaw { v4u a, b; };
__device__ __forceinline__ RowRaw load_raw(const bf16_t* p, int lane) { RowRaw r; r.a = *(const v4u*)(p + 8 * lane); r.b = *(const v4u*)(p + 512 + 8 * lane); return r; }
__device__ __forceinline__ void unpack_row(const RowRaw& r, RowV& x) { unpk8(r.a, x.v); unpk8(r.b, x.v + 8); }
struct GB { float g[16], b[16]; };
__device__ __forceinline__ void load_gb(const float* g, const float* b, int lane, GB& o) {
#pragma unroll
    for (int hh = 0; hh < 2; ++hh)
#pragma unroll
        for (int q = 0; q < 2; ++q) { const float4 gg = *(const float4*)(g + 512 * hh + 8 * lane + 4 * q), bb = *(const float4*)(b + 512 * hh + 8 * lane + 4 * q);
            o.g[8 * hh + 4 * q + 0] = gg.x; o.g[8 * hh + 4 * q + 1] = gg.y; o.g[8 * hh + 4 * q + 2] = gg.z; o.g[8 * hh + 4 * q + 3] = gg.w;
            o.b[8 * hh + 4 * q + 0] = bb.x; o.b[8 * hh + 4 * q + 1] = bb.y; o.b[8 * hh + 4 * q + 2] = bb.z; o.b[8 * hh + 4 * q + 3] = bb.w; }
}
__device__ __forceinline__ void ln_rowv(RowV& z, const GB& gb) {
    float s = 0.f;
#pragma unroll
    for (int i = 0; i < 16; ++i) s += z.v[i];
    const float mu = wave_sum(s) * (1.f / D);
    float q = 0.f;
#pragma unroll
    for (int i = 0; i < 16; ++i) { z.v[i] -= mu; q += z.v[i] * z.v[i]; }
    const float rstd = 1.f / sqrtf(wave_sum(q) * (1.f / D) + LN_EPS);
#pragma unroll
    for (int i = 0; i < 16; ++i) z.v[i] = z.v[i] * rstd * gb.g[i] + gb.b[i];
}
__device__ __forceinline__ void store_rowv_bf16(bf16_t* p, int lane, const RowV& r) {
    v4u a, b; a.x = pk2(r.v[0], r.v[1]); a.y = pk2(r.v[2], r.v[3]); a.z = pk2(r.v[4], r.v[5]); a.w = pk2(r.v[6], r.v[7]);
    b.x = pk2(r.v[8], r.v[9]); b.y = pk2(r.v[10], r.v[11]); b.z = pk2(r.v[12], r.v[13]); b.w = pk2(r.v[14], r.v[15]);
    *(v4u*)(p + 8 * lane) = a; *(v4u*)(p + 512 + 8 * lane) = b;
}
__device__ __forceinline__ void store_rowv_fp8(unsigned char* p, int lane, const RowV& r, float s) {
    v2u a, b; a.x = pg8::pk4_fp8(r.v[0] * s, r.v[1] * s, r.v[2] * s, r.v[3] * s); a.y = pg8::pk4_fp8(r.v[4] * s, r.v[5] * s, r.v[6] * s, r.v[7] * s);
    b.x = pg8::pk4_fp8(r.v[8] * s, r.v[9] * s, r.v[10] * s, r.v[11] * s); b.y = pg8::pk4_fp8(r.v[12] * s, r.v[13] * s, r.v[14] * s, r.v[15] * s);
    *(v2u*)(p + 8 * lane) = a; *(v2u*)(p + 512 + 8 * lane) = b;
}
constexpr int LNR = 4;

__device__ __forceinline__ void phase_ln_add(const Frame& F, const bf16_t* X, const bf16_t* Y, const float* g, const float* b, bf16_t* out, unsigned char* out8) {
    const int gw = F.vcu * NWAVES + F.wave, NGW = F.G * NWAVES;
    GB gb; load_gb(g, b, F.lane, gb);
    for (int row = gw; row < T; row += LNR * NGW) {
        RowRaw rx[LNR], ry[LNR];
#pragma unroll
        for (int k = 0; k < LNR; ++k) { const int rr = row + k * NGW; if (rr < T) { rx[k] = load_raw(X + (size_t)rr * D, F.lane); ry[k] = load_raw(Y + (size_t)rr * D, F.lane); } }
#pragma unroll
        for (int k = 0; k < LNR; ++k) { const int rr = row + k * NGW; if (rr < T) {
            RowV x, y; unpack_row(rx[k], x); unpack_row(ry[k], y);
#pragma unroll
            for (int i = 0; i < 16; ++i) x.v[i] = ALPHA * x.v[i] + y.v[i];
            ln_rowv(x, gb);
            store_rowv_bf16(out + (size_t)rr * D, F.lane, x);
            store_rowv_fp8(out8 + (size_t)rr * D, F.lane, x, pg8::F8_XS); } }
    }
}
__device__ __forceinline__ void phase_ln_moe(const Frame& F, const bf16_t* X, const bf16_t* DS, const int* pos, const float* ewgt, const float* g, const float* b, bf16_t* outb, float* outf) {
    const int gw = F.vcu * NWAVES + F.wave, NGW = F.G * NWAVES;
    GB gb; load_gb(g, b, F.lane, gb);
    for (int row = gw; row < T; row += LNR * NGW) {
        RowRaw rx[LNR], r1[LNR], r2[LNR]; float w1[LNR], w2[LNR];
#pragma unroll
        for (int k = 0; k < LNR; ++k) { const int rr = row + k * NGW; if (rr < T) {
            const int2 pp = *(const int2*)(pos + 2 * rr); const float2 ww = *(const float2*)(ewgt + 2 * rr); w1[k] = ww.x; w2[k] = ww.y;
            rx[k] = load_raw(X + (size_t)rr * D, F.lane); r1[k] = load_raw(DS + (size_t)pp.x * D, F.lane); r2[k] = load_raw(DS + (size_t)pp.y * D, F.lane); } }
#pragma unroll
        for (int k = 0; k < LNR; ++k) { const int rr = row + k * NGW; if (rr < T) {
            RowV x, y1, y2; unpack_row(rx[k], x); unpack_row(r1[k], y1); unpack_row(r2[k], y2);
#pragma unroll
            for (int i = 0; i < 16; ++i) x.v[i] = ALPHA * x.v[i] + (w1[k] * y1.v[i] + w2[k] * y2.v[i]);
            ln_rowv(x, gb);
            if (outb) store_rowv_bf16(outb + (size_t)rr * D, F.lane, x);
            if (outf) { float* o = outf + (size_t)rr * D + 8 * F.lane;
                *(float4*)(o) = make_float4(x.v[0], x.v[1], x.v[2], x.v[3]); *(float4*)(o + 4) = make_float4(x.v[4], x.v[5], x.v[6], x.v[7]);
                *(float4*)(o + 512) = make_float4(x.v[8], x.v[9], x.v[10], x.v[11]); *(float4*)(o + 516) = make_float4(x.v[12], x.v[13], x.v[14], x.v[15]); } } }
    }
}
constexpr int RW_LD = 20;
__device__ __forceinline__ void phase_ln_router(const Frame& F, const bf16_t* X, const bf16_t* Y, const float* g, const float* b, bf16_t* out, unsigned char* out8, const float* rw, const float* rbias, int* eidx, float* ewgt, int* bcnt) {
    LAS float* rwl = (LAS float*)F.lds;
    LAS int* hist = (LAS int*)(F.lds + 1024 * RW_LD * 4);
    LAS float* lgs = (LAS float*)(F.lds + 1024 * RW_LD * 4 + 256) + F.wave * 64;
    for (int i = F.tid; i < 1024 * 4; i += NTHREADS) { const int k = i >> 2, q = i & 3; const float4 v = *(const float4*)(rw + (size_t)k * 16 + 4 * q);
        const int j = (k >> 9) * 8 + (k & 7), l = (k >> 3) & 63; LAS float* d = rwl + (j * 64 + l) * RW_LD + 4 * q; d[0] = v.x; d[1] = v.y; d[2] = v.z; d[3] = v.w; }
    GB gb; load_gb(g, b, F.lane, gb);
    const int lane = F.lane;
    for (int vb = F.vcu; vb < T / 128; vb += F.G) {
        if (F.tid < 16) hist[F.tid] = 0;
        __syncthreads();
#pragma unroll 1
        for (int it = 0; it < 4; ++it) {
            const int row0 = vb * 128 + F.wave * 16 + it * 4;
            RowRaw rx[4], ry[4];
#pragma unroll
            for (int k = 0; k < 4; ++k) { rx[k] = load_raw(X + (size_t)(row0 + k) * D, lane); ry[k] = load_raw(Y + (size_t)(row0 + k) * D, lane); }
            RowV x[4];
#pragma unroll
            for (int k = 0; k < 4; ++k) { RowV y; unpack_row(rx[k], x[k]); unpack_row(ry[k], y);
#pragma unroll
                for (int i = 0; i < 16; ++i) x[k].v[i] = ALPHA * x[k].v[i] + y.v[i];
                ln_rowv(x[k], gb);
                store_rowv_bf16(out + (size_t)(row0 + k) * D, lane, x[k]);
                store_rowv_fp8(out8 + (size_t)(row0 + k) * D, lane, x[k], pg8::F8_XS); }
            float val[64];
#pragma unroll
            for (int i = 0; i < 64; ++i) val[i] = 0.f;
#pragma unroll
            for (int j = 0; j < 16; ++j) { const LAS float* wr = rwl + (j * 64 + lane) * RW_LD;
#pragma unroll
                for (int e4 = 0; e4 < 4; ++e4) { const f32x4 w4 = *(const LAS f32x4*)(wr + 4 * e4);
#pragma unroll
                    for (int k = 0; k < 4; ++k) { const float xv = x[k].v[j];
                        val[16 * k + 4 * e4 + 0] += xv * w4[0]; val[16 * k + 4 * e4 + 1] += xv * w4[1]; val[16 * k + 4 * e4 + 2] += xv * w4[2]; val[16 * k + 4 * e4 + 3] += xv * w4[3]; } } }
#pragma unroll
            for (int i = 0; i < 32; ++i) { const auto rr = __builtin_amdgcn_permlane32_swap(__float_as_uint(val[i]), __float_as_uint(val[i + 32]), false, false); val[i] = __uint_as_float(rr[0]) + __uint_as_float(rr[1]); }
            { const bool bt = (lane & 16) != 0;
#pragma unroll
              for (int i = 0; i < 16; ++i) { const float keep = bt ? val[i + 16] : val[i], send = bt ? val[i] : val[i + 16]; val[i] = keep + swz_xor<16>(send); } }
            { const bool bt = (lane & 8) != 0;
#pragma unroll
              for (int i = 0; i < 8; ++i) { const float keep = bt ? val[i + 8] : val[i], send = bt ? val[i] : val[i + 8]; val[i] = keep + swz_xor<8>(send); } }
            { const bool bt = (lane & 4) != 0;
#pragma unroll
              for (int i = 0; i < 4; ++i) { const float keep = bt ? val[i + 4] : val[i], send = bt ? val[i] : val[i + 4]; val[i] = keep + swz_xor<4>(send); } }
            { const bool bt = (lane & 2) != 0;
#pragma unroll
              for (int i = 0; i < 2; ++i) { const float keep = bt ? val[i + 2] : val[i], send = bt ? val[i] : val[i + 2]; val[i] = keep + swz_xor<2>(send); } }
            { const bool bt = (lane & 1) != 0; const float keep = bt ? val[1] : val[0], send = bt ? val[0] : val[1]; val[0] = keep + swz_xor<1>(send); }
            lgs[lane] = val[0];
            LDS_WAIT();
            if (lane < 4) {
                const int row = row0 + lane;
                float lg[16];
#pragma unroll
                for (int e4 = 0; e4 < 4; ++e4) { const f32x4 t4 = *(const LAS f32x4*)(lgs + 16 * lane + 4 * e4); lg[4 * e4] = t4[0]; lg[4 * e4 + 1] = t4[1]; lg[4 * e4 + 2] = t4[2]; lg[4 * e4 + 3] = t4[3]; }
                float mx = lg[0];
#pragma unroll
                for (int e = 1; e < 16; ++e) mx = fmaxf(mx, lg[e]);
                float sc[16], sum = 0.f;
#pragma unroll
                for (int e = 0; e < 16; ++e) { sc[e] = __expf(lg[e] - mx); sum += sc[e]; }
                const float isum = 1.f / sum;
                float bz[16];
#pragma unroll
                for (int e = 0; e < 16; ++e) { sc[e] *= isum; bz[e] = sc[e] + rbias[e]; }
                float gs[4]; int gi1[4], gi2[4];
#pragma unroll
                for (int gq = 0; gq < 4; ++gq) {
                    float m1 = bz[4 * gq]; int i1 = 0;
#pragma unroll
                    for (int j = 1; j < 4; ++j) if (bz[4 * gq + j] > m1) { m1 = bz[4 * gq + j]; i1 = j; }
                    float m2 = -INFINITY; int i2 = 0;
#pragma unroll
                    for (int j = 0; j < 4; ++j) if (j != i1 && bz[4 * gq + j] > m2) { m2 = bz[4 * gq + j]; i2 = j; }
                    gs[gq] = m1 + m2; gi1[gq] = i1; gi2[gq] = i2;
                }
                int gsel = 0; float gm = gs[0];
#pragma unroll
                for (int gq = 1; gq < 4; ++gq) if (gs[gq] > gm) { gm = gs[gq]; gsel = gq; }
                int i1 = gi1[0], i2 = gi2[0];
#pragma unroll
                for (int gq = 1; gq < 4; ++gq) if (gsel == gq) { i1 = gi1[gq]; i2 = gi2[gq]; }
                const int e1 = gsel * 4 + i1, e2 = gsel * 4 + i2;
                float s1 = 0.f, s2 = 0.f;
#pragma unroll
                for (int e = 0; e < 16; ++e) { if (e == e1) s1 = sc[e]; if (e == e2) s2 = sc[e]; }
                const float inv = 1.f / (s1 + s2);
                *(int2*)(eidx + 2 * row) = make_int2(e1, e2); *(float2*)(ewgt + 2 * row) = make_float2(s1 * inv, s2 * inv);
                atomicAdd((int*)&hist[e1], 1); atomicAdd((int*)&hist[e2], 1);
            }
        }
        __syncthreads();
        if (F.tid < 16) bcnt[vb * 16 + F.tid] = hist[F.tid];
        __syncthreads();
    }
}
__device__ __forceinline__ void phase_moe_book(const Frame& F, const int* eidx, const int* bcnt, int* tok, int* pos, int* tile_e) {
    LAS int* bc = (LAS int*)F.lds;
    LAS int* es = bc + 4096;
    LAS int* off = es + 256;
    LAS int* base = off + 32;
    LAS int* tot = base + 16;
    for (int i = F.tid; i < 4096; i += NTHREADS) bc[i] = bcnt[i];
    __syncthreads();
    for (int vb = F.vcu; vb < T / 128; vb += F.G) {
        if (F.tid < 16) { int t = 0, bs = 0; for (int b2 = 0; b2 < 256; ++b2) { const int c = bc[b2 * 16 + F.tid]; t += c; if (b2 < vb) bs += c; } tot[F.tid] = t; base[F.tid] = bs; }
        if (F.tid < 256) es[F.tid] = eidx[vb * 256 + F.tid];
        __syncthreads();
        if (F.tid == 0) { int o = 0; for (int e = 0; e < 16; ++e) { off[e] = o; o += (tot[e] + 255) & ~255; } off[16] = o; }
        __syncthreads();
        if (F.tid < 256) {
            const int e = es[F.tid]; int rank = 0;
            for (int j = 0; j < F.tid; ++j) rank += (es[j] == e) ? 1 : 0;
            const int r = off[e] + base[e] + rank;
            pos[vb * 256 + F.tid] = r; tok[r] = vb * 128 + (F.tid >> 1);
        }
        if (vb < 16) { const int e = vb, r0 = off[e] + tot[e], r1 = off[e + 1]; for (int r = r0 + F.tid; r < r1; r += NTHREADS) tok[r] = 0; }
        if (vb == 16) {
            for (int tl = F.tid; tl < NTILE; tl += NTHREADS) { int e = -1; for (int k = 0; k < 16; ++k) if (tl * 256 >= off[k] && tl * 256 < off[k + 1]) e = k; tile_e[tl] = e; }
            if (F.tid == 0) tile_e[NTILE] = off[16] >> 8;
        }
        __syncthreads();
    }
}
__device__ __forceinline__ void phase_pool(const Frame& F, const bf16_t* HP, bf16_t* PO) {
    constexpr int RUN = 32;
    const int gt = F.vcu * NTHREADS + F.tid, NGT = F.G * NTHREADS;
    for (int it = gt; it < (T / RUN) * (D / 8); it += NGT) {
        const int c8 = it & 127, run = it >> 7, g = c8 >> 5, win = 2 << g, t0 = run * RUN, ts0 = t0 & (S - 1);
        const bf16_t* hp = HP + (size_t)t0 * D + c8 * 8; bf16_t* po = PO + (size_t)t0 * D + c8 * 8;
        float s[8];
#pragma unroll
        for (int q = 0; q < 8; ++q) s[q] = 0.f;
        for (int k = 1; k < win; ++k) if (ts0 - k >= 0) { float v[8]; unpk8(*(const v4u*)(hp - (ptrdiff_t)k * D), v);
#pragma unroll
            for (int q = 0; q < 8; ++q) s[q] += v[q]; }
#pragma unroll 4
        for (int i = 0; i < RUN; ++i) {
            float hn[8]; unpk8(*(const v4u*)(hp + (size_t)i * D), hn);
            const int ts = ts0 + i;
#pragma unroll
            for (int q = 0; q < 8; ++q) s[q] += hn[q];
            const float inv = 1.f / (float)(ts + 1 < win ? ts + 1 : win);
            v4u o; o.x = pk2(s[0] * inv - hn[0], s[1] * inv - hn[1]); o.y = pk2(s[2] * inv - hn[2], s[3] * inv - hn[3]); o.z = pk2(s[4] * inv - hn[4], s[5] * inv - hn[5]); o.w = pk2(s[6] * inv - hn[6], s[7] * inv - hn[7]);
            *(v4u*)(po + (size_t)i * D) = o;
            if (ts + 1 >= win) { float ho[8]; unpk8(*(const v4u*)(hp + (ptrdiff_t)(i + 1 - win) * D), ho);
#pragma unroll
                for (int q = 0; q < 8; ++q) s[q] -= ho[q]; }
        }
    }
}
}
namespace mk {
typedef short bf16x8 __attribute__((ext_vector_type(8)));
typedef float f32x16 __attribute__((ext_vector_type(16)));
#define MFMA32(a, b, c) __builtin_amdgcn_mfma_f32_32x32x16_bf16((a), (b), (c), 0, 0, 0)
__device__ __forceinline__ int crow(int i, int h) { return (i & 3) + 8 * (i >> 2) + 4 * h; }
__device__ __forceinline__ float swap32_max(float v) { const auto r = __builtin_amdgcn_permlane32_swap(__float_as_uint(v), __float_as_uint(v), false, false); return fmaxf(__uint_as_float(r[0]), __uint_as_float(r[1])); }
__device__ __forceinline__ float swap32_sum(float v) { const auto r = __builtin_amdgcn_permlane32_swap(__float_as_uint(v), __float_as_uint(v), false, false); return __uint_as_float(r[0]) + __uint_as_float(r[1]); }
__device__ __forceinline__ unsigned pkbf(float lo, float hi) { unsigned r; asm volatile("v_cvt_pk_bf16_f32 %0, %1, %2" : "=v"(r) : "v"(lo), "v"(hi)); return r; }
__device__ __forceinline__ bf16x8 pack_step(const f32x16& x, int s) {
    v4u p; p.x = pkbf(x[8 * s + 0], x[8 * s + 1]); p.y = pkbf(x[8 * s + 2], x[8 * s + 3]); p.z = pkbf(x[8 * s + 4], x[8 * s + 5]); p.w = pkbf(x[8 * s + 6], x[8 * s + 7]);
    return __builtin_bit_cast(bf16x8, p);
}
__device__ __forceinline__ bf16x8 lds_frag2x8(const LAS unsigned char* p) {
    const v2u a = *(const LAS v2u*)p, b = *(const LAS v2u*)(p + 16);
    v4u q; q.x = a.x; q.y = a.y; q.z = b.x; q.w = b.y; return __builtin_bit_cast(bf16x8, q);
}
__device__ __forceinline__ void unpack8(const v4u u, float (&x)[8]) {
    x[0] = __uint_as_float(u.x << 16); x[1] = __uint_as_float(u.x & 0xffff0000u); x[2] = __uint_as_float(u.y << 16); x[3] = __uint_as_float(u.y & 0xffff0000u);
    x[4] = __uint_as_float(u.z << 16); x[5] = __uint_as_float(u.z & 0xffff0000u); x[6] = __uint_as_float(u.w << 16); x[7] = __uint_as_float(u.w & 0xffff0000u);
}

__device__ __forceinline__ void phase_swa_sgu(const Frame& F, const bf16_t* H0, const float* sinks, const float* lng, const float* lnb, const bf16_t* SW, const float* bs, bf16_t* MIX) {
    constexpr int KSTR = 272, VSTR = 520, VT_OFF = 256 * KSTR, VGSTR = 272, VGW = 64 * VGSTR;
    LAS unsigned char* KS = F.lds; LAS unsigned char* VT = F.lds + VT_OFF;
    const int lane = F.lane, r = lane & 31, h = lane >> 5, w = F.wave, kvh = w >> 2;
    const float NEG = -INFINITY;
    for (int vb = F.vcu; vb < T / 128; vb += F.G) {
        const int n = vb & 63; const size_t row0 = (size_t)vb * 128;
#pragma unroll
        for (int i = 0; i < 8; ++i) { const int p = F.tid + NTHREADS * i, row = p >> 4, c16 = p & 15; v4u v = (v4u){0u, 0u, 0u, 0u};
            if (n > 0 || row >= 128) v = *(const v4u*)(H0 + (row0 + row - 128) * NIN0 + 512 + c16 * 8);
            *(LAS v4u*)(KS + row * KSTR + c16 * 16) = v; }
#pragma unroll
        for (int i = 0; i < 8; ++i) { const int p = F.tid + NTHREADS * i, c16 = p >> 8, row = p & 255; v4u v = (v4u){0u, 0u, 0u, 0u};
            if (n > 0 || row >= 128) v = *(const v4u*)(H0 + (row0 + row - 128) * NIN0 + 640 + c16 * 8);
            LAS bf16_t* d = (LAS bf16_t*)(VT + (c16 * 8) * VSTR + row * 2);
            d[0 * (VSTR / 2)] = (bf16_t)(v.x & 0xffffu); d[1 * (VSTR / 2)] = (bf16_t)(v.x >> 16); d[2 * (VSTR / 2)] = (bf16_t)(v.y & 0xffffu); d[3 * (VSTR / 2)] = (bf16_t)(v.y >> 16);
            d[4 * (VSTR / 2)] = (bf16_t)(v.z & 0xffffu); d[5 * (VSTR / 2)] = (bf16_t)(v.z >> 16); d[6 * (VSTR / 2)] = (bf16_t)(v.w & 0xffffu); d[7 * (VSTR / 2)] = (bf16_t)(v.w >> 16); }
        __syncthreads();
        const float sink2 = sinks[w] * 1.4426950408889634f;
#pragma unroll 1
        for (int qg = 0; qg < 4; ++qg) {
            bf16x8 qf[4];
            { const bf16_t* qp = H0 + (row0 + 32 * qg + r) * NIN0 + w * 64 + 8 * h;
#pragma unroll
              for (int ks = 0; ks < 4; ++ks) qf[ks] = *(const bf16x8*)(qp + 16 * ks); }
            f32x16 st[5];
#pragma unroll
            for (int kt = 0; kt < 5; ++kt) {
#pragma unroll
                for (int i = 0; i < 16; ++i) st[kt][i] = 0.f;
                const LAS unsigned char* kp = KS + (32 * qg + 32 * kt + r) * KSTR + (kvh * 64 + 8 * h) * 2;
#pragma unroll
                for (int ks = 0; ks < 4; ++ks) { const bf16x8 kf = *(const LAS bf16x8*)(kp + 32 * ks); st[kt] = MFMA32(kf, qf[ks], st[kt]); }
            }
            float m = sink2;
            int rq = r; asm volatile("" : "+v"(rq));
#pragma unroll
            for (int kt = 0; kt < 5; ++kt)
#pragma unroll
                for (int i = 0; i < 16; ++i) { const int dk = 32 * kt + crow(i, h) - rq;
                    const bool valid = dk >= 1 && dk <= 128 && (n > 0 || (32 * qg + 32 * kt + crow(i, h)) >= 128);
                    const float s = valid ? st[kt][i] * ASCALE : NEG; st[kt][i] = s; m = fmaxf(m, s); }
            m = swap32_max(m);
            float l = 0.f;
#pragma unroll
            for (int kt = 0; kt < 5; ++kt)
#pragma unroll
                for (int i = 0; i < 16; ++i) { const float p = __builtin_amdgcn_exp2f(st[kt][i] - m); st[kt][i] = p; l += p; }
            l = swap32_sum(l) + __builtin_amdgcn_exp2f(sink2 - m);
            f32x16 o[2];
#pragma unroll
            for (int i = 0; i < 16; ++i) { o[0][i] = 0.f; o[1][i] = 0.f; }
#pragma unroll
            for (int kt = 0; kt < 5; ++kt)
#pragma unroll
                for (int s = 0; s < 2; ++s) { const bf16x8 pf = pack_step(st[kt], s);
#pragma unroll
                    for (int dt = 0; dt < 2; ++dt) { const bf16x8 vf = lds_frag2x8(VT + (kvh * 64 + 32 * dt + r) * VSTR + (32 * qg + 32 * kt + 16 * s + 4 * h) * 2); o[dt] = MFMA32(vf, pf, o[dt]); } }
            const float inv = 1.f / l;
            bf16_t* op = MIX + (row0 + 32 * qg + r) * D + w * 64 + 4 * h;
#pragma unroll
            for (int dt = 0; dt < 2; ++dt)
#pragma unroll
                for (int g4 = 0; g4 < 4; ++g4) { v2u u; u.x = pkbf(o[dt][4 * g4 + 0] * inv, o[dt][4 * g4 + 1] * inv); u.y = pkbf(o[dt][4 * g4 + 2] * inv, o[dt][4 * g4 + 3] * inv); *(v2u*)(op + 32 * dt + 8 * g4) = u; }
        }
        __syncthreads();
        {
            LAS unsigned char* VG = F.lds + w * VGW; const int g = w; int vz = 0; asm volatile("" : "+v"(vz));
#pragma unroll 1
            for (int it = 0; it < 2; ++it) { const int s = 64 * it + lane; const bf16_t* vp = H0 + (row0 + s) * NIN0 + 1280 + g * 64;
                float x[8][8]; float sum = 0.f;
#pragma unroll
                for (int cq = 0; cq < 8; ++cq) { unpack8(*(const v4u*)(vp + 8 * cq), x[cq]);
#pragma unroll
                    for (int e = 0; e < 8; ++e) sum += x[cq][e]; }
                const float mu = sum * (1.f / 64.f); float q = 0.f;
#pragma unroll
                for (int cq = 0; cq < 8; ++cq)
#pragma unroll
                    for (int e = 0; e < 8; ++e) { x[cq][e] -= mu; q += x[cq][e] * x[cq][e]; }
                const float rstd = 1.f / sqrtf(q * (1.f / 64.f) + LN_EPS);
#pragma unroll
                for (int cq = 0; cq < 8; ++cq)
#pragma unroll
                    for (int e = 0; e < 8; ++e) { const int c = 8 * cq + e; *(LAS bf16_t*)(VG + c * VGSTR + s * 2) = f2bf(x[cq][e] * rstd * lng[g * 64 + c + vz] + lnb[g * 64 + c + vz]); }
            }
            LDS_WAIT();
#pragma unroll 1
            for (int tt = 0; tt < 4; ++tt) {
                f32x16 acc[2];
#pragma unroll
                for (int i = 0; i < 16; ++i) { acc[0][i] = 0.f; acc[1][i] = 0.f; }
                const bf16_t* wp = SW + ((size_t)(g * 128 + 32 * tt + r) * 128 + 8 * h);
                for (int ks = 0; ks < 2 * (tt + 1); ++ks) { const bf16x8 bfr = *(const bf16x8*)(wp + 16 * ks);
#pragma unroll
                    for (int ct = 0; ct < 2; ++ct) { const bf16x8 af = *(const LAS bf16x8*)(VG + (32 * ct + r) * VGSTR + (16 * ks + 8 * h) * 2); acc[ct] = MFMA32(af, bfr, acc[ct]); } }
                const int t = 32 * tt + r; const float bias = bs[g * 128 + t];
                const bf16_t* up = H0 + (row0 + t) * NIN0 + 768 + g * 64 + 4 * h; bf16_t* op = MIX + (row0 + t) * D + 512 + g * 64 + 4 * h;
#pragma unroll
                for (int ct = 0; ct < 2; ++ct)
#pragma unroll
                    for (int g4 = 0; g4 < 4; ++g4) { const v2u uu = *(const v2u*)(up + 32 * ct + 8 * g4);
                        const float u0 = __uint_as_float(uu.x << 16), u1 = __uint_as_float(uu.x & 0xffff0000u), u2 = __uint_as_float(uu.y << 16), u3 = __uint_as_float(uu.y & 0xffff0000u);
                        v2u o2; o2.x = pkbf(u0 * (acc[ct][4 * g4 + 0] + bias), u1 * (acc[ct][4 * g4 + 1] + bias)); o2.y = pkbf(u2 * (acc[ct][4 * g4 + 2] + bias), u3 * (acc[ct][4 * g4 + 3] + bias));
                        *(v2u*)(op + 32 * ct + 8 * g4) = o2; }
            }
        }
        __syncthreads();
    }
}

}
namespace mk {
constexpr int NPHASE = 23;

typedef const __attribute__((address_space(4))) Args* KArgs;
__device__ __forceinline__ KArgs kargs() { KArgs p = (KArgs)__builtin_amdgcn_kernarg_segment_ptr(); asm volatile("" : "+s"(p)); return p; }

__device__ __forceinline__ bool in_range(int k) { KArgs ka = kargs(); return ka->ph_lo <= k && k < ka->ph_hi; }

__global__ void __launch_bounds__(NTHREADS, 2) mega(Args a) {
    extern __shared__ __attribute__((aligned(16))) unsigned char lds_raw[];
    LAS unsigned char* const F0lds = (LAS unsigned char*)lds_raw;
    const int F0wave = __builtin_amdgcn_readfirstlane((int)threadIdx.x >> 6);
    const int F0G = gridDim.x, F0bx = blockIdx.x, F0vcu = (F0G % 8 == 0) ? (F0bx % 8) * (F0G / 8) + F0bx / 8 : F0bx;
    volatile LAS unsigned* MISC = (volatile LAS unsigned*)(F0lds + MISC_OFF);
    if (threadIdx.x < 64) MISC[threadIdx.x] = 0u;
    __syncthreads();
    unsigned* ctl = (unsigned*)(a.ws + WS_CTL);
    XcdBarrier bar = xcd_barrier_post(ctl + CW_BAR + a.ph_lo * XCD_BAR_WORDS, MISC + 8, F0wave);
#define IN(k) in_range(k)
#define SEAM(k) do { if (IN(k) && IN((k) + 1)) { XcdBarrier b2_ = bar; asm volatile("" : "+s"(b2_.bar), "+s"(b2_.x)); xcd_barrier(b2_); } } while (0)
#define PH KArgs ka = kargs(); unsigned char* ws = ka->ws; (void)ws; Frame Fp; Fp.lds = F0lds; Fp.wave = F0wave; Fp.vcu = F0vcu; Fp.G = F0G; Fp.bx = F0bx; asm volatile("" : "+s"(Fp.wave), "+s"(Fp.vcu), "+s"(Fp.G), "+s"(Fp.bx)); \
    Fp.lane = (int)lane_id_fresh(); Fp.tid = Fp.wave * 64 + Fp.lane; const Frame& F = Fp; \
    const int bx = Fp.bx; (void)bx; LAS unsigned char* glds = F.lds; (void)glds; \
    bf16_t* RA = (bf16_t*)(ws + WS_A); bf16_t* RB = (bf16_t*)(ws + WS_B); bf16_t* RC = (bf16_t*)(ws + WS_C); bf16_t* RD = (bf16_t*)(ws + WS_D); bf16_t* WB = (bf16_t*)(ws + WS_WB); \
    (void)RA; (void)RB; (void)RC; (void)RD; (void)WB;
#define PHC PH const int cb = L == 0 ? 12 : 28; (void)cb; bf16_t* WBl = WB + WB_LAYER + (size_t)L * WL_SIZE; (void)WBl; \
    bf16_t *X1 = RB, *X2 = RA, *HS = RB, *DS = RD, *X3 = L == 0 ? RC : nullptr;   unsigned char *X1_8 = (unsigned char*)(L == 0 ? RD : RA), *P8 = (unsigned char*)(L == 0 ? RA : RC), *X2_8 = (unsigned char*)(L == 0 ? RD : RC); bf16_t* Y2 = L == 0 ? RC : RD; \
    (void)X1; (void)P8; (void)X1_8; (void)X2_8; (void)Y2; (void)X2; (void)HS; (void)DS; (void)X3;
#ifndef DOUBLE_MASK
#define DOUBLE_MASK 0u
#endif
#if DOUBLE_MASK != 0
#define REP(k) for (int rep_ = 0, nrep_ = 1 + (int)((DOUBLE_MASK >> (k)) & 1u); rep_ < nrep_; ++rep_)
#else
#define REP(k)
#endif
#define INF(i) ((const float*)ka->in[i])
#define WSI(off) ((int*)(ws + (off)))
#define WSF(off) ((float*)(ws + (off)))

#define GEMM_STD(EPI, ORD, LDA_, LDB_, K_) pg8::gemm_phase<EPI, ORD, true, true, false, LDA_, LDB_, K_>(glds, F.tid, g, S, E)
    for (int L = 0; L < 2; ++L) {
        const int cbp = L == 0 ? 0 : 11;
        if (L == 0) {
            if (IN(0)) REP(0) { PH
                LAS float* scr = (LAS float*)(F.lds + F.wave * 16384);
                const int gw = F.vcu * NWAVES + F.wave, NGW = F.G * NWAVES;
                constexpr int NITEMS = 896 + 512 + 512 + 512 + 2 * (1024 + 512 + 3 * 4096);
                for (int it = gw; it < NITEMS; it += NGW) {
                    int r = it;
#define JOB(MAP, src, K_, N_, dst, dstb, cnt) if (r < (cnt)) { transpose_job_item<MAP, false>((const float*)(src), K_, N_, dst, dstb, r, scr, F.lane); continue; } r -= (cnt);
#define JOB8(MAP, src, K_, N_, dst, dstb, cnt) if (r < (cnt)) { transpose_job_item<MAP, true>((const float*)(src), K_, N_, dst, dstb, r, scr, F.lane); continue; } r -= (cnt);
                    JOB8(0, ka->in[5], 1024, 1792, WB + WB_IN0, 0, 896)
                    JOB(0, ka->in[11], 1024, 1024, WB + WB_OUT0, 0, 512)
                    JOB(0, ka->in[24], 1024, 1024, WB + WB_IN1, 0, 512)
                    JOB(0, ka->in[27], 1024, 1024, WB + WB_OUT1, 0, 512)
#define LAYER_JOBS(l, c2) { bf16_t* Wl = WB + WB_LAYER + (size_t)(l) * WL_SIZE; \
                        JOB(0, ka->in[(c2) + 3], 1024, 2048, Wl + WL_XKV, 0, 1024) \
                        JOB(0, ka->in[(c2) + 4], 1024, 1024, Wl + WL_XO, 0, 512) \
                        JOB8(1, ka->in[(c2) + 7], 1024, 512, Wl + WL_GU, (size_t)1024 * 1024, 4096) \
                        JOB8(2, ka->in[(c2) + 8], 1024, 512, Wl + WL_GU, (size_t)1024 * 1024, 4096) \
                        JOB8(0, ka->in[(c2) + 9], 512, 1024, Wl + WL_DN, (size_t)1024 * 512, 4096) }
                    LAYER_JOBS(0, 12)
                    LAYER_JOBS(1, 28)
#undef LAYER_JOBS
#undef JOB
#undef JOB8
                }
                const int gt = F.vcu * NTHREADS + F.tid, NGT = F.G * NTHREADS;
                { const float4* x4 = (const float4*)ka->in[0]; v2u* o = (v2u*)RA; unsigned* o8 = (unsigned*)RB;
                  for (int i = gt; i < T * D / 4; i += NGT) { const float4 v = x4[i]; v2u w; w.x = pk2(v.x, v.y); w.y = pk2(v.z, v.w); o[i] = w;
                      o8[i] = pg8::pk4_fp8(v.x * pg8::F8_XS, v.y * pg8::F8_XS, v.z * pg8::F8_XS, v.w * pg8::F8_XS); } }
                { const float4* m4 = (const float4*)ka->in[1]; v2u* o = (v2u*)(ws + WS_MEMB);
                  for (int i = gt; i < B * MEM * D / 4; i += NGT) { const float4 v = m4[i]; v2u w; w.x = pk2(v.x, v.y); w.y = pk2(v.z, v.w); o[i] = w; } }
#pragma unroll
                for (int l = 0; l < 2; ++l) { const float4* q4 = (const float4*)ka->in[l == 0 ? 14 : 30]; v2u* o = (v2u*)(WB + WB_LAYER + (size_t)l * WL_SIZE + WL_XQ);
                  for (int i = gt; i < D * D / 4; i += NGT) { const float4 v = q4[i]; v2u w; w.x = pk2(v.x, v.y); w.y = pk2(v.z, v.w); o[i] = w; } }
                { const float4* p4 = (const float4*)ka->in[25]; const float4* s4 = (const float4*)ka->in[26]; v2u* o = (v2u*)(WB + WB_POOL);
                  for (int i = gt; i < 4 * 256 * 256 / 4; i += NGT) { const float4 v = p4[i]; const float4 sc = s4[(i >> 14) * 64 + (i & 63)]; v2u w; w.x = pk2(v.x * sc.x, v.y * sc.y); w.y = pk2(v.z * sc.z, v.w * sc.w); o[i] = w; } }
                { const int* positions = (const int*)ka->in[2]; float* ropew = WSF(WS_ROPE);
                  for (int t = gt; t < T; t += NGT) { const float p = (float)positions[t];
#pragma unroll
                      for (int j = 0; j < 8; ++j) { const float ang = p * ka->inv.f[j]; double rev = (double)ang * 0.15915494309189535; rev -= rint(rev); const float rr = (float)rev;
                          ropew[(size_t)t * 16 + j] = __builtin_amdgcn_cosf(rr); ropew[(size_t)t * 16 + 8 + j] = __builtin_amdgcn_sinf(rr); } } }
                { const float* sw = INF(9); bf16_t* o = WB + WB_SGUW;
                  for (int i = gt; i < 8 * 128 * 128; i += NGT) { const int s2 = i & 127, t = (i >> 7) & 127; o[i] = f2bf(s2 <= t ? sw[i] : 0.f); } }
            }
            SEAM(0);
            if (IN(1)) REP(1) { PH float* rope = WSF(WS_ROPE); bf16_t* MEMB = (bf16_t*)(ws + WS_MEMB);
#pragma unroll 1
                for (int l = 0; l < 2; ++l) {
                    bf16_t* Wl = WB + WB_LAYER + (size_t)l * WL_SIZE;
                    pg8::Gemm g{MEMB, Wl + WL_XKV, nullptr};
                    const int c2 = bx - 128 - 32 * l;
                    pg8::StaticOrder S; S.init(B * MEM, 2048, F.G, (c2 >= 0 && c2 < 32) ? c2 : (1 << 20), D, D);
                    pg8::EpiBf16 E{(bf16_t*)(ws + WS_MEMKV) + (size_t)l * B * MEM * 2048, 2048, 1.f};
                    GEMM_STD(pg8::EpiBf16, pg8::StaticOrder, D, D, D);
                }
                {
                    pg8::Gemm g{RB, WB + WB_IN0, nullptr};
                    pg8::StaticOrder S; S.init(T, NIN0, F.G, bx, D, D);
                    pg8::EpiInproj0 E{RD, rope, 1.f / (pg8::F8_XS * pg8::F8_WS)};
                    pg8::gemm_phase<pg8::EpiInproj0, pg8::StaticOrder, true, true, false, D, D, D, true>(glds, F.tid, g, S, E);
                }
            }
            SEAM(1);
            if (IN(2)) REP(2) { PH
                { bf16_t* Wl = WB + WB_LAYER; const bf16_t* KV = (const bf16_t*)(ws + WS_MEMKV);
                  { pg8::Gemm g{KV, Wl + WL_XQ, nullptr}; pg8::SetupOrder<0> S; S.init(bx, 0, 64); pg8::EpiF8 E{ws + WS_MT, D, QSCALE * pg8::F8_MS}; GEMM_STD(pg8::EpiF8, pg8::SetupOrder<0>, 2048, 1024, 256); }
                  { pg8::Gemm g{Wl + WL_XO, KV, nullptr}; pg8::SetupOrder<1> S; S.init(bx, 64, 64); pg8::EpiF8 E{ws + WS_NT, D, pg8::F8_NS}; GEMM_STD(pg8::EpiF8, pg8::SetupOrder<1>, 1024, 2048, 256); }
                  { pg8::Gemm g{WB + WB_OUT1, WB + WB_POOL, nullptr}; pg8::SetupOrder<2> S; S.init(bx, 128, 16); pg8::EpiBf16 E{WB + WB_WEFF, D, 1.f}; GEMM_STD(pg8::EpiBf16, pg8::SetupOrder<2>, 1024, 256, 256); } }
                phase_swa_sgu(F, RD, INF(6), INF(7), INF(8), WB + WB_SGUW, INF(10), RB);
            }
            SEAM(2);
            if (IN(3)) REP(3) { PH
                pg8::Gemm g{RB, WB + WB_OUT0, nullptr};
                pg8::StaticOrder S; S.init(T, D, F.G, bx, D, D);
                pg8::EpiBf16 E{RC, D, 1.f};
                GEMM_STD(pg8::EpiBf16, pg8::StaticOrder, D, D, D);
            }
            SEAM(3);
            if (IN(4)) REP(4) { PH phase_ln_add(F, RA, RC, INF(12), INF(13), RB, (unsigned char*)RD); }
            SEAM(4);
        } else {
            if (IN(12)) REP(12) { PH
                pg8::Gemm g{RC, WB + WB_IN1, nullptr};
                pg8::StaticOrder S; S.init(T, D, F.G, bx, D, D);
                pg8::EpiBf16 E{RB, D, 1.f};
                GEMM_STD(pg8::EpiBf16, pg8::StaticOrder, D, D, D);
            }
            SEAM(12);
            if (IN(13)) REP(13) { PH
                { bf16_t* Wl = WB + WB_LAYER + WL_SIZE; const bf16_t* KV = (const bf16_t*)(ws + WS_MEMKV) + (size_t)B * MEM * 2048;
                  { pg8::Gemm g{KV, Wl + WL_XQ, nullptr}; pg8::SetupOrder<0> S; S.init(bx, 0, 64); pg8::EpiF8 E{ws + WS_MT, D, QSCALE * pg8::F8_MS}; GEMM_STD(pg8::EpiF8, pg8::SetupOrder<0>, 2048, 1024, 256); }
                  { pg8::Gemm g{Wl + WL_XO, KV, nullptr}; pg8::SetupOrder<1> S; S.init(bx, 64, 64); pg8::EpiF8 E{ws + WS_NT, D, pg8::F8_NS}; GEMM_STD(pg8::EpiF8, pg8::SetupOrder<1>, 1024, 2048, 256); } }
                phase_pool(F, RB, RA);
            }
            SEAM(13);
            if (IN(14)) REP(14) { PH
                pg8::Gemm g{RA, WB + WB_WEFF, nullptr};
                pg8::StaticOrder S; S.init(T, D, F.G, bx, D, D);
                pg8::EpiBf16 E{RD, D, 1.f};
                GEMM_STD(pg8::EpiBf16, pg8::StaticOrder, D, D, D);
            }
            SEAM(14);
            if (IN(15)) REP(15) { PH phase_ln_add(F, RC, RD, INF(28), INF(29), RB, (unsigned char*)RA); }
            SEAM(15);
        }
        if (IN(cbp + 5)) REP(cbp + 5) { PHC
            pg8::Gemm g{(const bf16_t*)X1_8, (const bf16_t*)(ws + WS_MT), nullptr};
            pg8::BatchOrder S; S.init(T, D, F.G, bx, D, D);
            pg8::EpiSoftmaxT<true> E{P8, (LAS float*)(F.lds + 131072), 1.f / (pg8::F8_XS * pg8::F8_MS)};
            pg8::gemm_phase<pg8::EpiSoftmaxT<true>, pg8::BatchOrder, true, true, false, D, D, D, true>(glds, F.tid, g, S, E);
        }
        SEAM(cbp + 5);
        if (IN(cbp + 6)) REP(cbp + 6) { PHC
            pg8::Gemm g{(const bf16_t*)P8, (const bf16_t*)(ws + WS_NT), nullptr};
            pg8::BatchOrder S; S.init(T, D, F.G, bx, D, D);
            pg8::EpiBf16 E{Y2, D, 1.f / (pg8::F8_PS * pg8::F8_NS)};
            pg8::gemm_phase<pg8::EpiBf16, pg8::BatchOrder, true, true, false, D, D, D, true>(glds, F.tid, g, S, E);
        }
        SEAM(cbp + 6);
        if (IN(cbp + 7)) REP(cbp + 7) { PHC phase_ln_router(F, X1, Y2, INF(cb + 5), INF(cb + 6), X2, X2_8, INF(3), INF(4), WSI(WS_EIDX), WSF(WS_EWGT), WSI(WS_BCNT)); }
        SEAM(cbp + 7);
        if (IN(cbp + 8)) REP(cbp + 8) { PHC phase_moe_book(F, WSI(WS_EIDX), WSI(WS_BCNT), WSI(WS_TOK), WSI(WS_POS), WSI(WS_TILE)); }
        SEAM(cbp + 8);
        if (IN(cbp + 9)) REP(cbp + 9) { PHC const int* tile_e = WSI(WS_TILE); const int* tok = WSI(WS_TOK);
            const int ntiles = __builtin_amdgcn_readfirstlane(tile_e[NTILE]);
            pg8::Gemm g{(const bf16_t*)X2_8, WBl + WL_GU, tok};
            pg8::MoeOrder S; S.init(ntiles, tile_e, F.G, bx, D, D);
            pg8::EpiGU8 E{(unsigned char*)HS};
            pg8::gemm_phase<pg8::EpiGU8, pg8::MoeOrder, true, true, true, D, D, D, true>(glds, F.tid, g, S, E);
        }
        SEAM(cbp + 9);
        if (IN(cbp + 10)) REP(cbp + 10) { PHC const int* tile_e = WSI(WS_TILE);
            const int ntiles = __builtin_amdgcn_readfirstlane(tile_e[NTILE]);
            pg8::Gemm g{HS, WBl + WL_DN, nullptr};
            pg8::MoeOrder S; S.init(ntiles, tile_e, F.G, bx, DE, DE);
            pg8::EpiBf16 E{DS, D, 1.f / (pg8::F8_HS * pg8::F8_WS)};
            pg8::gemm_phase<pg8::EpiBf16, pg8::MoeOrder, true, true, false, DE, DE, DE, true>(glds, F.tid, g, S, E);
        }
        SEAM(cbp + 10);
        if (IN(cbp + 11)) REP(cbp + 11) { PHC phase_ln_moe(F, X2, DS, WSI(WS_POS), WSF(WS_EWGT), INF(cb + 10), INF(cb + 11), X3, L == 1 ? ka->out : nullptr); }
        SEAM(cbp + 11);
    }
#undef GEMM_STD
#undef IN
#undef SEAM
#undef INF
#undef PH
#undef PHC
#undef WSI
#undef WSF
}
}
using namespace nv;
extern "C" void kernel_launch(void* const* d_in, const int* in_sizes, int n_in, void* d_out, int out_size, void* d_ws, size_t ws_size, hipStream_t stream) {
    (void)in_sizes; (void)out_size;
    if (ws_size < WS_END || n_in != 40) return;
    static int grid = 0;
    if (grid == 0) {
        int dev = 0, cus = 0;
        if (hipGetDevice(&dev) != hipSuccess || hipDeviceGetAttribute(&cus, hipDeviceAttributeMultiprocessorCount, dev) != hipSuccess) { grid = -1; return; }
        if (hipFuncSetAttribute((const void*)mk::mega, hipFuncAttributeMaxDynamicSharedMemorySize, mk::LDS_BYTES) != hipSuccess) { grid = -1; return; }
        int per_cu = 0;
        if (hipOccupancyMaxActiveBlocksPerMultiprocessor(&per_cu, (const void*)mk::mega, mk::NTHREADS, mk::LDS_BYTES) != hipSuccess || per_cu < 1) { (void)hipGetLastError(); }
        grid = cus;
    }
    if (grid < 0) return;
    unsigned char* ws = (unsigned char*)d_ws;
    (void)hipMemsetAsync(ws + WS_CTL, 0, 512 * 1024, stream);
    mk::Args a{};
    for (int i = 0; i < 40; ++i) a.in[i] = d_in[i];
    a.out = (float*)d_out; a.ws = ws;
    for (int j = 0; j < 8; ++j) a.inv.f[j] = (float)pow(500000.0, -(double)((float)j * 2.0f / 16.0f));
    a.ph_lo = 0; a.ph_hi = mk::NPHASE;
    hipLaunchKernelGGL(mk::mega, dim3(grid), dim3(mk::NTHREADS), mk::LDS_BYTES, stream, a);
}
```

```cpp
#include <hip/hip_runtime.h>
#include <stdint.h>
#include <math.h>

typedef unsigned short bf16_t;

namespace nv {
constexpr int B = 4, S = 8192, T = B * S, D = 1024;
constexpr int NIN0 = 1792;
constexpr int MEM = 256, XH = 4, XHD = 256;
constexpr int NE = 16, DE = 512;
constexpr int MPAD = 65536 + 16 * 256;
constexpr int NTILE = MPAD / 256;
constexpr float ALPHA = 1.4142135623730951f;
constexpr float LN_EPS = 1e-5f;
constexpr float QSCALE = 0.0625f * 1.4426950408889634f;
constexpr float ASCALE = 0.125f * 1.4426950408889634f;

constexpr size_t MiB = 1u << 20;
constexpr size_t WS_CTL = 0;
constexpr size_t WS_ROPE = 2 * MiB;
constexpr size_t WS_EIDX = 4 * MiB;
constexpr size_t WS_EWGT = 5 * MiB;
constexpr size_t WS_POS = 6 * MiB;
constexpr size_t WS_BCNT = 7 * MiB;
constexpr size_t WS_TILE = 7 * MiB + 65536;
constexpr size_t WS_TOK = 7 * MiB + 131072;
constexpr size_t WS_MEMKV = 8 * MiB;
constexpr size_t WS_MEMB = 20 * MiB;
constexpr size_t WS_WB = 24 * MiB;
constexpr size_t WS_A = 152 * MiB, WS_B = 220 * MiB, WS_C = 288 * MiB, WS_D = 356 * MiB;
constexpr size_t WS_MT = 492 * MiB;
constexpr size_t WS_NT = 500 * MiB;
constexpr size_t WS_END = 508 * MiB;
constexpr size_t WB_IN0 = 0;
constexpr size_t WB_OUT0 = WB_IN0 + (size_t)1792 * 1024;
constexpr size_t WB_IN1 = WB_OUT0 + (size_t)1024 * 1024;
constexpr size_t WB_POOL = WB_IN1 + (size_t)1024 * 1024;
constexpr size_t WB_OUT1 = WB_POOL + (size_t)1024 * 256;
constexpr size_t WB_WEFF = WB_OUT1 + (size_t)1024 * 1024;
constexpr size_t WB_SGUW = WB_WEFF + (size_t)1024 * 1024;
constexpr size_t WB_LAYER = WB_SGUW + (size_t)8 * 128 * 128;
constexpr size_t WL_XQ = 0;
constexpr size_t WL_XKV = WL_XQ + (size_t)1024 * 1024;
constexpr size_t WL_XO = WL_XKV + (size_t)2048 * 1024;
constexpr size_t WL_GU = WL_XO + (size_t)1024 * 1024;
constexpr size_t WL_DN = WL_GU + (size_t)16 * 1024 * 1024;
constexpr size_t WL_SIZE = WL_DN + (size_t)16 * 1024 * 512;
static_assert((WB_LAYER + 2 * WL_SIZE) * 2 <= 128 * MiB, "bf16 weight region");

__device__ __forceinline__ float bf2f(bf16_t v) { return __uint_as_float((unsigned)v << 16); }
__device__ __forceinline__ bf16_t f2bf(float f) { unsigned u = __float_as_uint(f); return (bf16_t)((u + 0x7fffu + ((u >> 16) & 1u)) >> 16); }
__device__ __forceinline__ float gelu_tanh(float x) { const float u = 0.7978845608028654f * (x + 0.044715f * x * x * x); const float e = __expf(2.f * u); const float th = 1.f - 2.f / (e + 1.f); return 0.5f * x * (1.f + th); }
__device__ __forceinline__ float silu(float x) { return x / (1.f + __expf(-x)); }
template <int M> __device__ __forceinline__ float swz_xor(float v) { return __int_as_float(__builtin_amdgcn_ds_swizzle(__float_as_int(v), (M << 10) | 0x1f)); }
__device__ __forceinline__ float wave_sum(float v) {
    v += swz_xor<1>(v); v += swz_xor<2>(v); v += swz_xor<4>(v); v += swz_xor<8>(v); v += swz_xor<16>(v);
    const auto r = __builtin_amdgcn_permlane32_swap(__float_as_uint(v), __float_as_uint(v), false, false);
    return __uint_as_float(r[0]) + __uint_as_float(r[1]);
}
__device__ __forceinline__ float wave_max(float v) {
    v = fmaxf(v, swz_xor<1>(v)); v = fmaxf(v, swz_xor<2>(v)); v = fmaxf(v, swz_xor<4>(v)); v = fmaxf(v, swz_xor<8>(v)); v = fmaxf(v, swz_xor<16>(v));
    const auto r = __builtin_amdgcn_permlane32_swap(__float_as_uint(v), __float_as_uint(v), false, false);
    return fmaxf(__uint_as_float(r[0]), __uint_as_float(r[1]));
}
}

namespace pg8 {
#define PG8_LAS __attribute__((address_space(3)))
typedef short bf16x8 __attribute__((ext_vector_type(8)));
typedef float f32x4 __attribute__((ext_vector_type(4)));
typedef float f32x2 __attribute__((ext_vector_type(2)));
typedef unsigned u32x4 __attribute__((ext_vector_type(4)));
typedef unsigned u32x2 __attribute__((ext_vector_type(2)));
typedef int i32x8 __attribute__((ext_vector_type(8)));
constexpr int BM = 256, BK = 64, HALF = 128, HTB = HALF * BK * 2  , STAGE_BYTES = 8 * HTB, NXCD = 8, WGM = 8;

__host__ __device__ __forceinline__ int lds_byte(int r, int c) { const int st = (r >> 4) * 2 + (c >> 5), rr = r & 15, cc = c & 31, ob = rr * 64 + cc * 2; return st * 1024 + (ob ^ (((ob >> 9) & 1) << 5)); }
__host__ __device__ __forceinline__ void stage_rc(int b, int& R, int& C) { const int st = b / 1024, sb = b % 1024, swz = sb ^ (((sb >> 9) & 1) << 5); R = (st >> 1) * 16 + swz / 64; C = (st & 1) * 32 + (swz % 64) / 2; }
__host__ __device__ __forceinline__ int perm32(int rho) { const int n = rho >> 4, i = rho & 15; return 8 * (i >> 2) + 4 * n + (i & 3); }

struct Unit { int pm, pn, ao, bo; };
struct Gemm { const bf16_t* A; const bf16_t* Bt; const int* arow; };

template <bool BATCHED = false>
struct StaticOrderT {
    int nM, nN, nwg, G, c, lda, ldb, apn;
    __device__ void init(int M, int N, int G_, int c_, int lda_, int ldb_, int apn_ = 0) { nM = M / BM; nN = N / BM; nwg = nM * nN; G = G_; c = c_; lda = lda_; ldb = ldb_; apn = apn_; }
    __device__ bool next(int i, Unit& u) const {
        const long L = (long)i * G + c; if (L >= nwg) return false;
        int wgid = (int)L; { const int q = nwg / NXCD, r = nwg % NXCD, xcd = wgid % NXCD, off = wgid / NXCD; wgid = (xcd < r ? xcd * (q + 1) : r * (q + 1) + (xcd - r) * q) + off; }
        const int nig = WGM * nN, gid = wgid / nig, fm = gid * WGM, gsz = (nM - fm) < WGM ? (nM - fm) : WGM;
        u.pm = fm + ((wgid % nig) % gsz); u.pn = (wgid % nig) / gsz;
        u.ao = u.pm * BM * lda + u.pn * apn; u.bo = (BATCHED ? ((u.pm >> 5) * 4 + u.pn) : u.pn) * BM * ldb; return true;
    }
};
typedef StaticOrderT<false> StaticOrder;
typedef StaticOrderT<true> BatchOrder;
struct MoeOrder {
    int nM, nwg, G, c, lda, ldb; const int* tile_e;
    __device__ void init(int ntiles, const int* te, int G_, int c_, int lda_, int ldb_) { nM = ntiles; nwg = nM * 4; G = G_; c = c_; tile_e = te; lda = lda_; ldb = ldb_; }
    __device__ bool next(int i, Unit& u) const {
        const long L = (long)i * G + c; if (L >= nwg) return false;
        int wgid = (int)L; { const int q = nwg / NXCD, r = nwg % NXCD, xcd = wgid % NXCD, off = wgid / NXCD; wgid = (xcd < r ? xcd * (q + 1) : r * (q + 1) + (xcd - r) * q) + off; }
        const int nig = WGM * 4, gid = wgid / nig, fm = gid * WGM, gsz = (nM - fm) < WGM ? (nM - fm) : WGM;
        u.pm = fm + ((wgid % nig) % gsz); u.pn = (wgid % nig) / gsz;
        const int e = __builtin_amdgcn_readfirstlane(tile_e[u.pm]); u.ao = u.pm * BM * lda; u.bo = (e * 4 + u.pn) * BM * ldb; return true;
    }
};
template <int KIND>
struct SetupOrder {
    int idx, n;
    __device__ void init(int c, int c0, int n_) { idx = c - c0; n = n_; }
    __device__ bool next(int i, Unit& u) const {
        if (i != 0 || idx < 0 || idx >= n) return false;
        const int x = idx >> 4, y = (idx >> 2) & 3, z = idx & 3;
        if (KIND == 0) { u.pm = x * 4 + y; u.pn = z; u.ao = (x * 256) * 2048 + y * 256; u.bo = z * 256 * 1024 + y * 256; }
        if (KIND == 1) { u.pm = x * 4 + y; u.pn = z; u.ao = y * 256 * 1024 + z * 256; u.bo = (x * 256) * 2048 + 1024 + z * 256; }
        if (KIND == 2) { u.pm = y; u.pn = z; u.ao = y * 256 * 1024 + z * 256; u.bo = z * 256 * 256; }
        return true;
    }
};

__device__ __forceinline__ int fresh_lane() { unsigned m = ~0u; asm volatile("" : "+s"(m)); return (int)__builtin_amdgcn_mbcnt_hi(m, __builtin_amdgcn_mbcnt_lo(m, 0u)); }
__device__ __forceinline__ unsigned cvt_pk_bf16(float lo, float hi) { unsigned r; asm volatile("v_cvt_pk_bf16_f32 %0, %1, %2" : "=v"(r) : "v"(lo), "v"(hi)); return r; }


template <class Epi, class Sched, bool ALIGN_EPI, bool SP2, bool GATHER, int LDA, int LDB, int KK, bool FP8 = false>
__device__ __forceinline__ void gemm_phase(PG8_LAS unsigned char* lds, int tid_in, const Gemm g, const Sched& S, const Epi& E) {
    int tid_ = tid_in; asm volatile("" : "+v"(tid_));
    const int tid = tid_, wid = __builtin_amdgcn_readfirstlane(tid >> 6), lane = tid & 63, wr = wid >> 2, wc = wid & 3, fr = lane & 15, fq = lane >> 4;
    constexpr int ELT = FP8 ? 1 : 2, K = KK, nt = K * ELT / (BK * 2), lda = LDA * ELT, ldb = LDB * ELT; (void)K;
    unsigned voffA[2], voffB[2];
#pragma unroll
    for (int i = 0; i < 2; ++i) { int R, C; stage_rc(tid * 16 + i * 8192, R, C); const int Rb = Epi::PERM ? ((R & ~31) + perm32(R & 31)) : R;
        voffA[i] = GATHER ? (unsigned)C * 2u : (unsigned)(R * lda + C * 2); voffB[i] = (unsigned)(Rb * ldb + C * 2); }
    const size_t kstep = (size_t)(BK * 2);
    const size_t hstepA = GATHER ? 0 : (size_t)HALF * lda, hstepB = (size_t)HALF * ldb;
    const unsigned ldsw = (unsigned)wid * 1024u, ldsbase = (unsigned)(size_t)lds;
    const int aoff = lds_byte(wr * 64 + fr, fq * 8), boff = lds_byte(wc * 32 + fr, fq * 8);
    unsigned cg[2][2];
#define PG8_SA(b, h) (((b) * 2 + (h)) * HTB)
#define PG8_SB(b, h) ((4 + (b) * 2 + (h)) * HTB)
#define PG8_GLDS(sbase, voff32, ldsaddr) asm volatile("s_mov_b32 m0, %2\n\ts_nop 0\n\tglobal_load_lds_dwordx4 %0, %1" :: "v"(voff32), "s"(sbase), "s"(ldsaddr) : "memory", "m0")
#define PG8_STAGE(bufoff, gbase, voff) do { const char* _sb = (const char*)(gbase); _Pragma("unroll") for (int _i = 0; _i < 2; ++_i) \
        PG8_GLDS(_sb + (size_t)_i * 64 * ldb, (voff)[0], (unsigned)(ldsbase + (bufoff) + ldsw + _i * 8192)); } while (0)
#define PG8_STAGE_A(bufoff, abase, h, GO) do { const char* _sb = GATHER ? (const char*)(abase) : (const char*)(abase) + ((h) ? hstepA : (size_t)0); _Pragma("unroll") for (int _i = 0; _i < 2; ++_i) { \
        if constexpr (GATHER) PG8_GLDS(_sb, GO[h][_i], (unsigned)(ldsbase + (bufoff) + ldsw + _i * 8192)); \
        else PG8_GLDS(_sb + (size_t)_i * 64 * lda, voffA[0], (unsigned)(ldsbase + (bufoff) + ldsw + _i * 8192)); } } while (0)
#define PG8_GLOAD(dst, pm_) do { const int _t = wid * 64 + fresh_lane(); int rowA_[2]; unsigned colA_[2]; _Pragma("unroll") for (int _i = 0; _i < 2; ++_i) { int _R, _C; stage_rc(_t * 16 + _i * 8192, _R, _C); rowA_[_i] = _R; colA_[_i] = (unsigned)_C * 2u; }   \
        _Pragma("unroll") for (int _h = 0; _h < 2; ++_h) _Pragma("unroll") for (int _i = 0; _i < 2; ++_i) \
        dst[_h][_i] = (unsigned)g.arow[(pm_) * BM + _h * HALF + rowA_[_i]] * (unsigned)lda + colA_[_i]; } while (0)
#define PG8_GSWITCH do { if constexpr (GATHER) { if (last && has_next) { PG8_GLOAD(cg, nxt.pm); } } } while (0)
#define PG8_LDA(dst, b, h) do { _Pragma("unroll") for (int m = 0; m < 4; ++m) { if constexpr (FP8) { typedef int i32x4_ __attribute__((ext_vector_type(4))); \
        dst##8[m] = __builtin_shufflevector(*(const PG8_LAS i32x4_*)(lds + PG8_SA(b, h) + aoff + m * 2048), *(const PG8_LAS i32x4_*)(lds + PG8_SA(b, h) + aoff + m * 2048 + 1024), 0, 1, 2, 3, 4, 5, 6, 7); } \
        else { _Pragma("unroll") for (int k = 0; k < 2; ++k) dst[m][k] = *(const PG8_LAS bf16x8*)(lds + PG8_SA(b, h) + aoff + m * 2048 + k * 1024); } } } while (0)
#define PG8_LDB(dst, b, h) do { _Pragma("unroll") for (int n = 0; n < 2; ++n) { if constexpr (FP8) { typedef int i32x4_ __attribute__((ext_vector_type(4))); \
        dst##8[n] = __builtin_shufflevector(*(const PG8_LAS i32x4_*)(lds + PG8_SB(b, h) + boff + n * 2048), *(const PG8_LAS i32x4_*)(lds + PG8_SB(b, h) + boff + n * 2048 + 1024), 0, 1, 2, 3, 4, 5, 6, 7); } \
        else { _Pragma("unroll") for (int k = 0; k < 2; ++k) dst[n][k] = *(const PG8_LAS bf16x8*)(lds + PG8_SB(b, h) + boff + n * 2048 + k * 1024); } } } while (0)
#define PG8_MMA(ai, bj, At, Bt) do { __builtin_amdgcn_s_setprio(1); _Pragma("unroll") for (int m = 0; m < 4; ++m) _Pragma("unroll") for (int n = 0; n < 2; ++n) { \
        if constexpr (FP8) acc[ai][bj][m][n] = __builtin_amdgcn_mfma_scale_f32_16x16x128_f8f6f4(Bt##8[n], At##8[m], acc[ai][bj][m][n], 0, 0, 0, 0x7f7f7f7f, 0, 0x7f7f7f7f); \
        else { _Pragma("unroll") for (int k = 0; k < 2; ++k) acc[ai][bj][m][n] = __builtin_amdgcn_mfma_f32_16x16x32_bf16(Bt[n][k], At[m][k], acc[ai][bj][m][n], 0, 0, 0); } } \
        __builtin_amdgcn_s_setprio(0); } while (0)
#define PG8_WAIT_V(n) asm volatile("s_waitcnt vmcnt(" #n ")" ::: "memory")
#define PG8_WAIT_L(n) asm volatile("s_waitcnt lgkmcnt(" #n ")" ::: "memory")
#define PG8_BAR __builtin_amdgcn_s_barrier()
#define PG8_SCHED __builtin_amdgcn_sched_barrier(0)
    Unit cur, nxt; int ui = 0;
    if (!S.next(0, cur)) return;
    f32x4 acc[2][2][4][2];
#pragma unroll
    for (int a = 0; a < 2; ++a)
#pragma unroll
        for (int b = 0; b < 2; ++b)
#pragma unroll
            for (int m = 0; m < 4; ++m)
#pragma unroll
                for (int n = 0; n < 2; ++n) acc[a][b][m][n] = (f32x4){0.f, 0.f, 0.f, 0.f};
    bf16x8 At[4][2], B0[2][2], B1[2][2]; i32x8 At8[4], B08[2], B18[2];
    const char* cA = GATHER ? (const char*)g.A : (const char*)g.A + (size_t)cur.ao * ELT; const char* cB = (const char*)g.Bt + (size_t)cur.bo * ELT;
    if constexpr (GATHER) { PG8_GLOAD(cg, cur.pm); }
    if constexpr (SP2) {
        PG8_STAGE(PG8_SB(0, 0), cB, voffB); PG8_STAGE(PG8_SB(0, 1), cB + hstepB, voffB); PG8_STAGE_A(PG8_SA(0, 0), cA, 0, cg); PG8_STAGE_A(PG8_SA(0, 1), cA, 1, cg);
        if (wr == 1) PG8_BAR;
        PG8_WAIT_V(2); PG8_BAR;
        PG8_STAGE(PG8_SB(1, 0), cB + kstep, voffB); PG8_STAGE_A(PG8_SA(1, 0), cA + kstep, 0, cg); PG8_STAGE(PG8_SB(1, 1), cB + hstepB + kstep, voffB);
        PG8_WAIT_V(6); PG8_BAR;
    } else {
        PG8_STAGE(PG8_SB(0, 0), cB, voffB); PG8_STAGE_A(PG8_SA(0, 0), cA, 0, cg); PG8_STAGE(PG8_SB(0, 1), cB + hstepB, voffB); PG8_STAGE_A(PG8_SA(0, 1), cA, 1, cg);
        if (wr == 1) PG8_BAR;
        PG8_WAIT_V(4); PG8_BAR;
        PG8_STAGE(PG8_SB(1, 0), cB + kstep, voffB); PG8_STAGE_A(PG8_SA(1, 0), cA + kstep, 0, cg); PG8_STAGE(PG8_SB(1, 1), cB + hstepB + kstep, voffB);
        PG8_WAIT_V(6); PG8_BAR;
    }
    for (;;) {
        const bool has_next = S.next(ui + 1, nxt);
        const char* nA = GATHER ? (const char*)g.A : (has_next ? (const char*)g.A + (size_t)nxt.ao * ELT : cA);
        const char* nB = has_next ? (const char*)g.Bt + (size_t)nxt.bo * ELT : cB;
#pragma unroll 1
        for (int t = 0; t < nt; t += 2) {
            const bool last = (t == nt - 2);
            const char* a1 = cA + (size_t)(t + 1) * kstep;
            const char* a2 = last ? nA : cA + (size_t)(t + 2) * kstep; const char* b2 = last ? nB : cB + (size_t)(t + 2) * kstep;
            const char* a3 = a2 + kstep; const char* b3 = b2 + kstep;
            if constexpr (SP2) {
            PG8_LDB(B0, 0, 0); PG8_LDB(B1, 0, 1); PG8_SCHED; PG8_LDA(At, 0, 0); PG8_STAGE_A(PG8_SA(1, 1), a1, 1, cg); PG8_GSWITCH;
            PG8_WAIT_V(8); PG8_WAIT_L(0); PG8_BAR; PG8_MMA(0, 0, At, B0); PG8_MMA(0, 1, At, B1); PG8_BAR; PG8_SCHED;
            PG8_LDA(At, 0, 1); PG8_STAGE(PG8_SB(0, 0), b2, voffB); PG8_STAGE(PG8_SB(0, 1), b2 + hstepB, voffB); PG8_STAGE_A(PG8_SA(0, 0), a2, 0, cg);
            PG8_WAIT_V(8); PG8_WAIT_L(0); PG8_BAR; PG8_MMA(1, 0, At, B0); PG8_MMA(1, 1, At, B1); PG8_BAR; PG8_SCHED;
            PG8_LDB(B0, 1, 0); PG8_LDB(B1, 1, 1); PG8_SCHED; PG8_LDA(At, 1, 0); PG8_STAGE_A(PG8_SA(0, 1), a2, 1, cg);
            PG8_WAIT_V(8); PG8_WAIT_L(0); PG8_BAR; PG8_MMA(0, 0, At, B0); PG8_MMA(0, 1, At, B1); PG8_BAR; PG8_SCHED;
            PG8_LDA(At, 1, 1); PG8_STAGE(PG8_SB(1, 0), b3, voffB); PG8_STAGE(PG8_SB(1, 1), b3 + hstepB, voffB); PG8_STAGE_A(PG8_SA(1, 0), a3, 0, cg);
            PG8_WAIT_V(8); PG8_WAIT_L(0); PG8_BAR; PG8_MMA(1, 0, At, B0); PG8_MMA(1, 1, At, B1); PG8_BAR; PG8_SCHED;
            } else {
            PG8_LDB(B0, 0, 0); PG8_SCHED; PG8_LDA(At, 0, 0); PG8_STAGE_A(PG8_SA(1, 1), a1, 1, cg); PG8_GSWITCH;
            PG8_WAIT_L(8); PG8_BAR; PG8_WAIT_L(0); PG8_MMA(0, 0, At, B0); PG8_BAR; PG8_SCHED;
            PG8_LDB(B1, 0, 1); PG8_STAGE(PG8_SB(0, 0), b2, voffB);
            PG8_BAR; PG8_WAIT_L(0); PG8_MMA(0, 1, At, B1); PG8_BAR;
            PG8_LDA(At, 0, 1); PG8_STAGE_A(PG8_SA(0, 0), a2, 0, cg);
            PG8_BAR; PG8_WAIT_L(0); PG8_MMA(1, 0, At, B0); PG8_BAR; PG8_SCHED;
            PG8_STAGE(PG8_SB(0, 1), b2 + hstepB, voffB);
            PG8_WAIT_V(6); PG8_BAR; PG8_MMA(1, 1, At, B1); PG8_BAR;
            PG8_LDB(B0, 1, 0); PG8_SCHED; PG8_LDA(At, 1, 0); PG8_STAGE_A(PG8_SA(0, 1), a2, 1, cg);
            PG8_WAIT_L(8); PG8_BAR; PG8_WAIT_L(0); PG8_MMA(0, 0, At, B0); PG8_BAR; PG8_SCHED;
            PG8_LDB(B1, 1, 1); PG8_STAGE(PG8_SB(1, 0), b3, voffB);
            PG8_BAR; PG8_WAIT_L(0); PG8_MMA(0, 1, At, B1); PG8_BAR;
            PG8_LDA(At, 1, 1); PG8_STAGE_A(PG8_SA(1, 0), a3, 0, cg);
            PG8_BAR; PG8_WAIT_L(0); PG8_MMA(1, 0, At, B0); PG8_BAR; PG8_SCHED;
            PG8_STAGE(PG8_SB(1, 1), b3 + hstepB, voffB);
            PG8_WAIT_V(6); PG8_BAR; PG8_MMA(1, 1, At, B1); PG8_BAR;
            }
        }
        if constexpr (ALIGN_EPI) { if (wr == 0) PG8_BAR; }
        { const int _l = fresh_lane(); E(acc, cur, wr, wc, _l & 15, _l >> 4); }
        if (!has_next) break;
#pragma unroll
        for (int a = 0; a < 2; ++a)
#pragma unroll
            for (int b = 0; b < 2; ++b)
#pragma unroll
                for (int m = 0; m < 4; ++m)
#pragma unroll
                    for (int n = 0; n < 2; ++n) acc[a][b][m][n] = (f32x4){0.f, 0.f, 0.f, 0.f};
        cur = nxt; cA = nA; cB = nB; ++ui;
        if constexpr (ALIGN_EPI) { if (wr == 1) PG8_BAR; }
    }
    PG8_WAIT_V(0);
    if constexpr (!ALIGN_EPI) { if (wr == 0) PG8_BAR; }
    PG8_BAR;
#undef PG8_SA
#undef PG8_SB
#undef PG8_STAGE
#undef PG8_GLDS
#undef PG8_STAGE_A
#undef PG8_GLOAD
#undef PG8_GSWITCH
#undef PG8_LDA
#undef PG8_LDB
#undef PG8_MMA
#undef PG8_WAIT_V
#undef PG8_WAIT_L
#undef PG8_BAR
#undef PG8_SCHED
}
}
namespace pg8 {

__device__ __forceinline__ float fast_sigmoid_mul(float x, float z) { return x * __builtin_amdgcn_rcpf(1.f + __builtin_amdgcn_exp2f(-1.4426950408889634f * z)); }
__device__ __forceinline__ float gelu_t(float x) { const float u = 0.7978845608028654f * (x + 0.044715f * x * x * x); return fast_sigmoid_mul(x, 2.f * u); }
__device__ __forceinline__ float silu_f(float x) { return fast_sigmoid_mul(x, x); }
__device__ __forceinline__ u32x4 pack8(const f32x4 v0, const f32x4 v1) { u32x4 w; w.x = cvt_pk_bf16(v0[0], v0[1]); w.y = cvt_pk_bf16(v0[2], v0[3]); w.z = cvt_pk_bf16(v1[0], v1[1]); w.w = cvt_pk_bf16(v1[2], v1[3]); return w; }

struct EpiBf16 {
    static constexpr bool PERM = true;
    bf16_t* O; int ldo; float scale;
    __device__ __forceinline__ void operator()(f32x4 (&acc)[2][2][4][2], const Unit& u, int wr, int wc, int fr, int fq) const {
        const int row0 = u.pm * BM + wr * 64 + fr, col0 = u.pn * BM + wc * 32 + 8 * fq;
#pragma unroll
        for (int ai = 0; ai < 2; ++ai)
#pragma unroll
            for (int m = 0; m < 4; ++m) { bf16_t* rowp = O + (size_t)(row0 + ai * HALF + m * 16) * ldo + col0;
#pragma unroll
                for (int bj = 0; bj < 2; ++bj) *(u32x4*)(rowp + bj * HALF) = pack8(acc[ai][bj][m][0] * scale, acc[ai][bj][m][1] * scale); }
    }
};
__device__ __forceinline__ unsigned pk4_fp8(float a, float b, float c, float d) {
    a = __builtin_amdgcn_fmed3f(a, -448.f, 448.f); b = __builtin_amdgcn_fmed3f(b, -448.f, 448.f); c = __builtin_amdgcn_fmed3f(c, -448.f, 448.f); d = __builtin_amdgcn_fmed3f(d, -448.f, 448.f);
    unsigned p = 0u; p = (unsigned)__builtin_amdgcn_cvt_pk_fp8_f32(a, b, (int)p, false); p = (unsigned)__builtin_amdgcn_cvt_pk_fp8_f32(c, d, (int)p, true); return p;
}
constexpr float F8_XS = 16.f, F8_WS = 64.f, F8_HS = 8.f;
struct EpiResBf16 {
    static constexpr bool PERM = true;
    bf16_t* O; float scale; const bf16_t* R;
    __device__ __forceinline__ void operator()(f32x4 (&acc)[2][2][4][2], const Unit& u, int wr, int wc, int fr, int fq) const {
        const int row0 = u.pm * BM + wr * 64 + fr, col0 = u.pn * BM + wc * 32 + 8 * fq;
#pragma unroll
        for (int ai = 0; ai < 2; ++ai)
#pragma unroll
            for (int m = 0; m < 4; ++m) { const size_t off = (size_t)(row0 + ai * HALF + m * 16) * nv::D + col0;
#pragma unroll
                for (int bj = 0; bj < 2; ++bj) { const u32x4 rr = *(const u32x4*)(R + off + bj * HALF);
                    f32x4 r0, r1; r0[0] = __uint_as_float(rr.x << 16); r0[1] = __uint_as_float(rr.x & 0xffff0000u); r0[2] = __uint_as_float(rr.y << 16); r0[3] = __uint_as_float(rr.y & 0xffff0000u);
                    r1[0] = __uint_as_float(rr.z << 16); r1[1] = __uint_as_float(rr.z & 0xffff0000u); r1[2] = __uint_as_float(rr.w << 16); r1[3] = __uint_as_float(rr.w & 0xffff0000u);
                    *(u32x4*)(O + off + bj * HALF) = pack8(r0 * nv::ALPHA + acc[ai][bj][m][0] * scale, r1 * nv::ALPHA + acc[ai][bj][m][1] * scale); }
                asm volatile("" ::: "memory"); }
    }
};
struct EpiF8 {
    static constexpr bool PERM = true;
    unsigned char* O; int ldo; float scale;
    __device__ __forceinline__ void operator()(f32x4 (&acc)[2][2][4][2], const Unit& u, int wr, int wc, int fr, int fq) const {
        const int row0 = u.pm * BM + wr * 64 + fr, col0 = u.pn * BM + wc * 32 + 8 * fq;
#pragma unroll
        for (int ai = 0; ai < 2; ++ai)
#pragma unroll
            for (int m = 0; m < 4; ++m) { unsigned char* rowp = O + (size_t)(row0 + ai * HALF + m * 16) * ldo + col0;
#pragma unroll
                for (int bj = 0; bj < 2; ++bj) { const f32x4 v0 = acc[ai][bj][m][0] * scale, v1 = acc[ai][bj][m][1] * scale;
                    u32x2 w; w.x = pk4_fp8(v0[0], v0[1], v0[2], v0[3]); w.y = pk4_fp8(v1[0], v1[1], v1[2], v1[3]); *(u32x2*)(rowp + bj * HALF) = w; } }
    }
};
constexpr float F8_MS = 64.f, F8_PS = 256.f, F8_NS = 16.f;
struct EpiGU8 {
    static constexpr bool PERM = true;
    unsigned char* HS8;
    __device__ __forceinline__ void operator()(f32x4 (&acc)[2][2][4][2], const Unit& u, int wr, int wc, int fr, int fq) const {
        const int row0 = u.pm * BM + wr * 64 + fr, col0 = u.pn * HALF + wc * 32 + 8 * fq;
        constexpr float s = 1.f / (F8_XS * F8_WS);
#pragma unroll
        for (int ai = 0; ai < 2; ++ai)
#pragma unroll
            for (int m = 0; m < 4; ++m) { unsigned char* rowp = HS8 + (size_t)(row0 + ai * HALF + m * 16) * nv::DE + col0;
                f32x4 h0, h1;
#pragma unroll
                for (int j = 0; j < 4; ++j) { h0[j] = silu_f(acc[ai][0][m][0][j] * s) * (acc[ai][1][m][0][j] * (s * F8_HS)); h1[j] = silu_f(acc[ai][0][m][1][j] * s) * (acc[ai][1][m][1][j] * (s * F8_HS)); }
                u32x2 w; w.x = pk4_fp8(h0[0], h0[1], h0[2], h0[3]); w.y = pk4_fp8(h1[0], h1[1], h1[2], h1[3]); *(u32x2*)rowp = w; }
    }
};
struct EpiGU {
    static constexpr bool PERM = true;
    bf16_t* HS;
    __device__ __forceinline__ void operator()(f32x4 (&acc)[2][2][4][2], const Unit& u, int wr, int wc, int fr, int fq) const {
        const int row0 = u.pm * BM + wr * 64 + fr, col0 = u.pn * HALF + wc * 32 + 8 * fq;
#pragma unroll
        for (int ai = 0; ai < 2; ++ai)
#pragma unroll
            for (int m = 0; m < 4; ++m) { bf16_t* rowp = HS + (size_t)(row0 + ai * HALF + m * 16) * nv::DE + col0;
                f32x4 h0, h1;
#pragma unroll
                for (int j = 0; j < 4; ++j) { h0[j] = silu_f(acc[ai][0][m][0][j]) * acc[ai][1][m][0][j]; h1[j] = silu_f(acc[ai][0][m][1][j]) * acc[ai][1][m][1][j]; }
                *(u32x4*)rowp = pack8(h0, h1); }
    }
};
template <bool OUT8>
struct EpiSoftmaxT {
    static constexpr bool PERM = true;
    void* O; PG8_LAS float* tbl; float in_scale;
    __device__ __forceinline__ void operator()(f32x4 (&acc)[2][2][4][2], const Unit& u, int wr, int wc, int fr, int fq) const {
        const int row0 = u.pm * BM + wr * 64 + fr, col0 = u.pn * BM + wc * 32 + 8 * fq;
#pragma unroll
        for (int ai = 0; ai < 2; ++ai)
#pragma unroll
            for (int m = 0; m < 4; ++m) { float mx = -INFINITY;
#pragma unroll
                for (int bj = 0; bj < 2; ++bj)
#pragma unroll
                    for (int n = 0; n < 2; ++n)
#pragma unroll
                        for (int j = 0; j < 4; ++j) { acc[ai][bj][m][n][j] *= in_scale; mx = fmaxf(mx, acc[ai][bj][m][n][j]); }
                mx = fmaxf(mx, nv::swz_xor<16>(mx));
                { const auto r = __builtin_amdgcn_permlane32_swap(__float_as_uint(mx), __float_as_uint(mx), false, false); mx = fmaxf(__uint_as_float(r[0]), __uint_as_float(r[1])); }
                if (fq == 0) tbl[(ai * HALF + wr * 64 + m * 16 + fr) * 4 + wc] = mx; }
        asm volatile("s_waitcnt lgkmcnt(0)" ::: "memory"); __builtin_amdgcn_s_barrier(); asm volatile("" ::: "memory");
#pragma unroll
        for (int ai = 0; ai < 2; ++ai)
#pragma unroll
            for (int m = 0; m < 4; ++m) { const f32x4 t4 = *(const PG8_LAS f32x4*)(tbl + (ai * HALF + wr * 64 + m * 16 + fr) * 4);
                const float M = fmaxf(fmaxf(t4[0], t4[1]), fmaxf(t4[2], t4[3])); float s = 0.f;
#pragma unroll
                for (int bj = 0; bj < 2; ++bj)
#pragma unroll
                    for (int n = 0; n < 2; ++n)
#pragma unroll
                        for (int j = 0; j < 4; ++j) { const float p = __builtin_amdgcn_exp2f(acc[ai][bj][m][n][j] - M); acc[ai][bj][m][n][j] = p; s += p; }
                s += nv::swz_xor<16>(s);
                { const auto r = __builtin_amdgcn_permlane32_swap(__float_as_uint(s), __float_as_uint(s), false, false); s = __uint_as_float(r[0]) + __uint_as_float(r[1]); }
                if (fq == 0) tbl[1024 + (ai * HALF + wr * 64 + m * 16 + fr) * 4 + wc] = s; }
        asm volatile("s_waitcnt lgkmcnt(0)" ::: "memory"); __builtin_amdgcn_s_barrier(); asm volatile("" ::: "memory");
#pragma unroll
        for (int ai = 0; ai < 2; ++ai)
#pragma unroll
            for (int m = 0; m < 4; ++m) { const f32x4 t4 = *(const PG8_LAS f32x4*)(tbl + 1024 + (ai * HALF + wr * 64 + m * 16 + fr) * 4);
                const float inv = 1.f / ((t4[0] + t4[1]) + (t4[2] + t4[3]));
                if constexpr (OUT8) { unsigned char* rowp = (unsigned char*)O + (size_t)(row0 + ai * HALF + m * 16) * nv::D + col0; const float s8 = inv * F8_PS;
#pragma unroll
                    for (int bj = 0; bj < 2; ++bj) { const f32x4 v0 = acc[ai][bj][m][0] * s8, v1 = acc[ai][bj][m][1] * s8;
                        u32x2 w; w.x = pk4_fp8(v0[0], v0[1], v0[2], v0[3]); w.y = pk4_fp8(v1[0], v1[1], v1[2], v1[3]); *(u32x2*)(rowp + bj * HALF) = w; } }
                else { bf16_t* rowp = (bf16_t*)O + (size_t)(row0 + ai * HALF + m * 16) * nv::D + col0;
#pragma unroll
                    for (int bj = 0; bj < 2; ++bj) *(u32x4*)(rowp + bj * HALF) = pack8(acc[ai][bj][m][0] * inv, acc[ai][bj][m][1] * inv); } }
    }
};
struct EpiInproj0 {
    static constexpr bool PERM = true;
    bf16_t* O; const float* rope; float in_scale;
    __device__ __forceinline__ void operator()(f32x4 (&acc)[2][2][4][2], const Unit& u, int wr, int wc, int fr, int fq) const {
        const int row0 = u.pm * BM + wr * 64 + fr, col0 = u.pn * BM + wc * 32 + 8 * fq;
#pragma unroll
        for (int ai = 0; ai < 2; ++ai)
#pragma unroll
            for (int bj = 0; bj < 2; ++bj)
#pragma unroll
                for (int m = 0; m < 4; ++m) { acc[ai][bj][m][0] *= in_scale; acc[ai][bj][m][1] *= in_scale; }
        if (u.pn >= 3) {
#pragma unroll
            for (int ai = 0; ai < 2; ++ai)
#pragma unroll
                for (int m = 0; m < 4; ++m) { bf16_t* rowp = O + (size_t)(row0 + ai * HALF + m * 16) * nv::NIN0 + col0;
#pragma unroll
                    for (int bj = 0; bj < 2; ++bj) { f32x4 v0 = acc[ai][bj][m][0], v1 = acc[ai][bj][m][1];
#pragma unroll
                        for (int j = 0; j < 4; ++j) { v0[j] = gelu_t(v0[j]); v1[j] = gelu_t(v1[j]); }
                        *(u32x4*)(rowp + bj * HALF) = pack8(v0, v1); } }
        } else {
            const bool wave_rope = (wc & 1) == 0;
            const float sgn = fq == 0 ? -1.f : 1.f;
#pragma unroll
            for (int ai = 0; ai < 2; ++ai)
#pragma unroll
                for (int m = 0; m < 4; ++m) { const int row = row0 + ai * HALF + m * 16; bf16_t* rowp = O + (size_t)row * nv::NIN0 + col0;
                    f32x4 c0, c1, s0, s1;
                    if (wave_rope) { const float* rp = rope + (size_t)row * 16; c0 = *(const f32x4*)rp; c1 = *(const f32x4*)(rp + 4); s0 = *(const f32x4*)(rp + 8); s1 = *(const f32x4*)(rp + 12); }
#pragma unroll
                    for (int bj = 0; bj < 2; ++bj) { f32x4 v0 = acc[ai][bj][m][0], v1 = acc[ai][bj][m][1];
                        if (wave_rope && (u.pn < 2 || bj == 0)) {
                            f32x4 p0, p1;
#pragma unroll
                            for (int j = 0; j < 4; ++j) { p0[j] = nv::swz_xor<16>(v0[j]); p1[j] = nv::swz_xor<16>(v1[j]); }
                            if (fq < 2) {
#pragma unroll
                                for (int j = 0; j < 4; ++j) { v0[j] = v0[j] * c0[j] + sgn * p0[j] * s0[j]; v1[j] = v1[j] * c1[j] + sgn * p1[j] * s1[j]; } }
                        }
                        *(u32x4*)(rowp + bj * HALF) = pack8(v0, v1); } }
        }
    }
};
}

#define LAS __attribute__((address_space(3)))
#define GAS __attribute__((address_space(1)))
typedef GAS unsigned gu32;
#define RLX_AGENT __ATOMIC_RELAXED, __HIP_MEMORY_SCOPE_AGENT
#define LDS_WAIT() asm volatile("s_waitcnt lgkmcnt(0)" ::: "memory")
#define VM_WAIT() asm volatile("s_waitcnt vmcnt(0)" ::: "memory")

#define XB_TMO      128
#define XB_XCNT(j)  (256  + 64 * (j))
#define XB_XSUB(j)  (1280 + 64 * (j))
#define XB_XGEN(j)  (2304 + 64 * (j))
#define XB_TOP      3328
#define XB_TOPGEN   3392
#define XCD_BAR_WORDS 3456
#define XB_SPIN_CAP (1u << 18)
__device__ __forceinline__ unsigned xb_ld(unsigned* p)              { return __hip_atomic_load(p, __ATOMIC_RELAXED, __HIP_MEMORY_SCOPE_AGENT); }
__device__ __forceinline__ unsigned xb_add(unsigned* p, unsigned v) { return __hip_atomic_fetch_add(p, v, __ATOMIC_RELAXED, __HIP_MEMORY_SCOPE_AGENT); }
__device__ __forceinline__ unsigned xb_xcc_id() { return (unsigned)__builtin_amdgcn_s_getreg((3 << 11) | 20) & 0xFu; }
#define XB_SPIN(cond, bar) do { unsigned _sp = 0; while (cond) { __builtin_amdgcn_s_sleep(1); \
    if ((++_sp & 255u) == 0u) { if (xb_ld(&(bar)[XB_TMO])) break; if (_sp > XB_SPIN_CAP) { atomicAdd(&(bar)[XB_TMO], 1u); break; } } } } while (0)
struct XcdBarrier { unsigned* bar; unsigned x; volatile LAS unsigned* st; int wave; };
__device__ __forceinline__ unsigned lane_id_fresh() { unsigned m = ~0u; asm volatile("" : "+s"(m)); return __builtin_amdgcn_mbcnt_hi(m, __builtin_amdgcn_mbcnt_lo(m, 0u)); }
__device__ __forceinline__ bool xb_thread0(int wave) { return wave == 0 && lane_id_fresh() == 0u; }
__device__ __forceinline__ XcdBarrier xcd_barrier_post(unsigned* bar, volatile LAS unsigned* st, int wave) {
    XcdBarrier b; b.bar = bar; b.x = xb_xcc_id(); b.st = st; b.wave = wave;
    if (xb_thread0(wave)) (void)xb_add(&bar[XB_XCNT(b.x)], 1u);
    return b;
}
__device__ __forceinline__ void xcd_barrier_complete(unsigned* bar, unsigned x, unsigned& nloc, unsigned& nx) {
    const unsigned G = gridDim.x * gridDim.y * gridDim.z;
    unsigned sum, cnt, mine, sp = 0u;
    for (;;) {
        sum = 0u; cnt = 0u; mine = 0u;
#pragma unroll
        for (unsigned j = 0; j < 16; ++j) { const unsigned c = xb_ld(&bar[XB_XCNT(j)]); sum += c; cnt += (c > 0u) ? 1u : 0u; mine = (j == x) ? c : mine; }
        if (sum == G) break;
        __builtin_amdgcn_s_sleep(1);
        if ((++sp & 255u) == 0u) { if (xb_ld(&bar[XB_TMO])) break; if (sp > XB_SPIN_CAP) { atomicAdd(&bar[XB_TMO], 1u); break; } }
    }
    nloc = mine > 0u ? mine : 1u; nx = cnt > 0u ? cnt : 1u;
}
__device__ __forceinline__ void xcd_barrier(const XcdBarrier& b) {
    asm volatile("s_waitcnt vmcnt(0)" ::: "memory");
    __syncthreads();
    if (xb_thread0(b.wave)) {
        unsigned* bar = b.bar;
        __builtin_amdgcn_s_waitcnt(0);
        unsigned nloc = b.st[0], nx = b.st[1];
        if (nloc == 0u) { xcd_barrier_complete(bar, b.x, nloc, nx); b.st[0] = nloc; b.st[1] = nx; }
        const unsigned old = xb_add(&bar[XB_XSUB(b.x)], 1u);
        const unsigned gen = old / nloc;
        if (old + 1u == (gen + 1u) * nloc) {
            __builtin_amdgcn_fence(__ATOMIC_RELEASE, "agent");
            asm volatile("s_waitcnt vmcnt(0)" ::: "memory");
            const unsigned og = xb_add(&bar[XB_TOP], 1u);
            const unsigned tg = og / nx;
            if (og + 1u == (tg + 1u) * nx) xb_add(&bar[XB_TOPGEN], 1u);
            else XB_SPIN(xb_ld(&bar[XB_TOPGEN]) == tg, bar);
            __builtin_amdgcn_fence(__ATOMIC_ACQUIRE, "agent");
            xb_add(&bar[XB_XGEN(b.x)], 1u);
            asm volatile("s_waitcnt vmcnt(0)" ::: "memory");
        } else {
            XB_SPIN(xb_ld(&bar[XB_XGEN(b.x)]) == gen, bar);
            __builtin_amdgcn_fence(__ATOMIC_ACQUIRE, "agent");
            asm volatile("s_waitcnt vmcnt(0)" ::: "memory");
        }
    }
    __syncthreads();
}

namespace mk {
using namespace nv;
typedef unsigned v4u __attribute__((ext_vector_type(4)));
typedef unsigned v2u __attribute__((ext_vector_type(2)));
typedef float f32x4 __attribute__((ext_vector_type(4)));
constexpr int NWAVES = 8, NTHREADS = 512;
constexpr int LDS_BYTES = 160 * 1024;
constexpr int MISC_OFF = LDS_BYTES - 256;
constexpr int CW_BAR = 4096;
constexpr size_t CTL_ZERO_BYTES = 64 * 1024;

__device__ __forceinline__ unsigned pk2(float lo, float hi) { return (unsigned)f2bf(lo) | ((unsigned)f2bf(hi) << 16); }

struct Frame {
    LAS unsigned char* lds; int tid, lane, wave, vcu, G, bx;
};

struct TItem { const float* src; unsigned char* dst; int ldw, ldt, k0, n0, dr, f8; };
template <int MAP, bool F8>
__device__ __forceinline__ void titem_fill(TItem& t, const void* srcp, int K, int N, void* dstp, size_t dstb, int r) {
    const int nblk = N / 32, per = (K / 64) * nblk, bi = r / per, it = r % per, kb = it / nblk, nb = it % nblk, n0 = 32 * nb;
    int dr = n0; if (MAP == 1) dr = (n0 >> 7) * 256 + (n0 & 127); if (MAP == 2) dr = (n0 >> 7) * 256 + 128 + (n0 & 127);
    t.src = (const float*)srcp + (size_t)bi * K * N; t.dst = (unsigned char*)dstp + (size_t)bi * dstb * (F8 ? 1 : 2); t.ldw = N; t.ldt = K; t.k0 = 64 * kb; t.n0 = n0; t.dr = dr; t.f8 = F8 ? 1 : 0;
}
struct TRegs { f32x4 v[8]; };
__device__ __forceinline__ void titem_load(const TItem& t, int lane, TRegs& R) {
    const float* p = t.src + (size_t)(t.k0 + (lane >> 3)) * t.ldw + t.n0 + (lane & 7) * 4;
#pragma unroll
    for (int i = 0; i < 8; ++i) R.v[i] = __builtin_nontemporal_load((const f32x4*)(p + (size_t)(8 * i) * t.ldw));
}
__device__ __forceinline__ void titem_finish(const TItem& t, int lane, const TRegs& R, LAS float* scr) {
    const float sc = t.f8 ? pg8::F8_WS : 1.f;
    { LAS float* d = scr + (lane >> 3) * 33 + (lane & 7) * 4;
#pragma unroll
      for (int i = 0; i < 8; ++i) { d[(8 * i) * 33 + 0] = R.v[i][0] * sc; d[(8 * i) * 33 + 1] = R.v[i][1] * sc; d[(8 * i) * 33 + 2] = R.v[i][2] * sc; d[(8 * i) * 33 + 3] = R.v[i][3] * sc; } }
    LDS_WAIT(); asm volatile("" ::: "memory");
    const int c = lane & 7;
#pragma unroll
    for (int j = 0; j < 4; ++j) { const int n = (lane >> 3) + 8 * j; const LAS float* s = scr + (8 * c) * 33 + n;
        if (t.f8) { v2u o; o.x = pg8::pk4_fp8(s[0 * 33], s[1 * 33], s[2 * 33], s[3 * 33]); o.y = pg8::pk4_fp8(s[4 * 33], s[5 * 33], s[6 * 33], s[7 * 33]);
            __builtin_nontemporal_store(o, (v2u*)(t.dst + (size_t)(t.dr + n) * t.ldt + t.k0 + 8 * c)); }
        else { v4u o; o.x = pk2(s[0 * 33], s[1 * 33]); o.y = pk2(s[2 * 33], s[3 * 33]); o.z = pk2(s[4 * 33], s[5 * 33]); o.w = pk2(s[6 * 33], s[7 * 33]);
            __builtin_nontemporal_store(o, (v4u*)((bf16_t*)t.dst + (size_t)(t.dr + n) * t.ldt + t.k0 + 8 * c)); } }
    LDS_WAIT(); asm volatile("" ::: "memory");
}

struct InvFreq { float f[8]; };
struct Args {
    const void* in[40]; float* out; unsigned char* ws; InvFreq inv; int ph_lo, ph_hi;
};

struct RowV { float v[16]; };
__device__ __forceinline__ void unpk8(const v4u u, float* x) {
    x[0] = __uint_as_float(u.x << 16); x[1] = __uint_as_float(u.x & 0xffff0000u); x[2] = __uint_as_float(u.y << 16); x[3] = __uint_as_float(u.y & 0xffff0000u);
    x[4] = __uint_as_float(u.z << 16); x[5] = __uint_as_float(u.z & 0xffff0000u); x[6] = __uint_as_float(u.w << 16); x[7] = __uint_as_float(u.w & 0xffff0000u);
}
struct RowRaw { v4u a, b; };
__device__ __forceinline__ RowRaw load_raw(const bf16_t* p, int lane) { RowRaw r; r.a = *(const v4u*)(p + 8 * lane); r.b = *(const v4u*)(p + 512 + 8 * lane); return r; }
__device__ __forceinline__ void unpack_row(const RowRaw& r, RowV& x) { unpk8(r.a, x.v); unpk8(r.b, x.v + 8); }
struct GB { float g[16], b[16]; };
__device__ __forceinline__ void load_gb(const float* g, const float* b, int lane, GB& o) {
#pragma unroll
    for (int hh = 0; hh < 2; ++hh)
#pragma unroll
        for (int q = 0; q < 2; ++q) { const float4 gg = *(const float4*)(g + 512 * hh + 8 * lane + 4 * q), bb = *(const float4*)(b + 512 * hh + 8 * lane + 4 * q);
            o.g[8 * hh + 4 * q + 0] = gg.x; o.g[8 * hh + 4 * q + 1] = gg.y; o.g[8 * hh + 4 * q + 2] = gg.z; o.g[8 * hh + 4 * q + 3] = gg.w;
            o.b[8 * hh + 4 * q + 0] = bb.x; o.b[8 * hh + 4 * q + 1] = bb.y; o.b[8 * hh + 4 * q + 2] = bb.z; o.b[8 * hh + 4 * q + 3] = bb.w; }
}
__device__ __forceinline__ void ln_rowv(RowV& z, const GB& gb) {
    float s = 0.f;
#pragma unroll
    for (int i = 0; i < 16; ++i) s += z.v[i];
    const float mu = wave_sum(s) * (1.f / D);
    float q = 0.f;
#pragma unroll
    for (int i = 0; i < 16; ++i) { z.v[i] -= mu; q += z.v[i] * z.v[i]; }
    const float rstd = 1.f / sqrtf(wave_sum(q) * (1.f / D) + LN_EPS);
#pragma unroll
    for (int i = 0; i < 16; ++i) z.v[i] = z.v[i] * rstd * gb.g[i] + gb.b[i];
}
__device__ __forceinline__ void store_rowv_bf16(bf16_t* p, int lane, const RowV& r) {
    v4u a, b; a.x = pk2(r.v[0], r.v[1]); a.y = pk2(r.v[2], r.v[3]); a.z = pk2(r.v[4], r.v[5]); a.w = pk2(r.v[6], r.v[7]);
    b.x = pk2(r.v[8], r.v[9]); b.y = pk2(r.v[10], r.v[11]); b.z = pk2(r.v[12], r.v[13]); b.w = pk2(r.v[14], r.v[15]);
    *(v4u*)(p + 8 * lane) = a; *(v4u*)(p + 512 + 8 * lane) = b;
}
__device__ __forceinline__ void store_rowv_fp8(unsigned char* p, int lane, const RowV& r, float s) {
    v2u a, b; a.x = pg8::pk4_fp8(r.v[0] * s, r.v[1] * s, r.v[2] * s, r.v[3] * s); a.y = pg8::pk4_fp8(r.v[4] * s, r.v[5] * s, r.v[6] * s, r.v[7] * s);
    b.x = pg8::pk4_fp8(r.v[8] * s, r.v[9] * s, r.v[10] * s, r.v[11] * s); b.y = pg8::pk4_fp8(r.v[12] * s, r.v[13] * s, r.v[14] * s, r.v[15] * s);
    *(v2u*)(p + 8 * lane) = a; *(v2u*)(p + 512 + 8 * lane) = b;
}
constexpr int LNR = 4;

__device__ __forceinline__ void phase_ln_add(const Frame& F, const bf16_t* X, const bf16_t* Y, const float* g, const float* b, bf16_t* out, unsigned char* out8) {
    const int gw = F.vcu * NWAVES + F.wave, NGW = F.G * NWAVES;
    GB gb; load_gb(g, b, F.lane, gb);
    for (int row = gw; row < T; row += LNR * NGW) {
        RowRaw rx[LNR], ry[LNR];
#pragma unroll
        for (int k = 0; k < LNR; ++k) { const int rr = row + k * NGW; if (rr < T) { rx[k] = load_raw(X + (size_t)rr * D, F.lane); if (Y) ry[k] = load_raw(Y + (size_t)rr * D, F.lane); } }
#pragma unroll
        for (int k = 0; k < LNR; ++k) { const int rr = row + k * NGW; if (rr < T) {
            RowV x; unpack_row(rx[k], x);
            if (Y) { RowV y; unpack_row(ry[k], y);
#pragma unroll
                for (int i = 0; i < 16; ++i) x.v[i] = ALPHA * x.v[i] + y.v[i]; }
            ln_rowv(x, gb);
            store_rowv_bf16(out + (size_t)rr * D, F.lane, x);
            store_rowv_fp8(out8 + (size_t)rr * D, F.lane, x, pg8::F8_XS); } }
    }
}
__device__ __forceinline__ void phase_ln_moe(const Frame& F, const bf16_t* X, const bf16_t* DS, const int* pos, const float* ewgt, const float* g, const float* b, bf16_t* outb, float* outf) {
    const int gw = F.vcu * NWAVES + F.wave, NGW = F.G * NWAVES;
    GB gb; load_gb(g, b, F.lane, gb);
    for (int row = gw; row < T; row += LNR * NGW) {
        RowRaw rx[LNR], r1[LNR], r2[LNR]; float w1[LNR], w2[LNR];
#pragma unroll
        for (int k = 0; k < LNR; ++k) { const int rr = row + k * NGW; if (rr < T) {
            const int2 pp = *(const int2*)(pos + 2 * rr); const float2 ww = *(const float2*)(ewgt + 2 * rr); w1[k] = ww.x; w2[k] = ww.y;
            rx[k] = load_raw(X + (size_t)rr * D, F.lane); r1[k] = load_raw(DS + (size_t)pp.x * D, F.lane); r2[k] = load_raw(DS + (size_t)pp.y * D, F.lane); } }
#pragma unroll
        for (int k = 0; k < LNR; ++k) { const int rr = row + k * NGW; if (rr < T) {
            RowV x, y1, y2; unpack_row(rx[k], x); unpack_row(r1[k], y1); unpack_row(r2[k], y2);
#pragma unroll
            for (int i = 0; i < 16; ++i) x.v[i] = ALPHA * x.v[i] + (w1[k] * y1.v[i] + w2[k] * y2.v[i]);
            ln_rowv(x, gb);
            if (outb) store_rowv_bf16(outb + (size_t)rr * D, F.lane, x);
            if (outf) { float* o = outf + (size_t)rr * D + 8 * F.lane;
                *(float4*)(o) = make_float4(x.v[0], x.v[1], x.v[2], x.v[3]); *(float4*)(o + 4) = make_float4(x.v[4], x.v[5], x.v[6], x.v[7]);
                *(float4*)(o + 512) = make_float4(x.v[8], x.v[9], x.v[10], x.v[11]); *(float4*)(o + 516) = make_float4(x.v[12], x.v[13], x.v[14], x.v[15]); } } }
    }
}
constexpr int RW_LD = 20;
__device__ __forceinline__ void phase_ln_router(const Frame& F, const bf16_t* X, const bf16_t* Y, const float* g, const float* b, bf16_t* out, unsigned char* out8, const float* rw, const float* rbias, int* eidx, float* ewgt, int* bcnt) {
    LAS float* rwl = (LAS float*)F.lds;
    LAS int* hist = (LAS int*)(F.lds + 1024 * RW_LD * 4);
    LAS float* lgs = (LAS float*)(F.lds + 1024 * RW_LD * 4 + 256) + F.wave * 64;
    for (int i = F.tid; i < 1024 * 4; i += NTHREADS) { const int k = i >> 2, q = i & 3; const float4 v = *(const float4*)(rw + (size_t)k * 16 + 4 * q);
        const int j = (k >> 9) * 8 + (k & 7), l = (k >> 3) & 63; LAS float* d = rwl + (j * 64 + l) * RW_LD + 4 * q; d[0] = v.x; d[1] = v.y; d[2] = v.z; d[3] = v.w; }
    GB gb; load_gb(g, b, F.lane, gb);
    const int lane = F.lane;
    for (int vb = F.vcu; vb < T / 128; vb += F.G) {
        if (F.tid < 16) hist[F.tid] = 0;
        __syncthreads();
#pragma unroll 1
        for (int it = 0; it < 4; ++it) {
            const int row0 = vb * 128 + F.wave * 16 + it * 4;
            RowRaw rx[4], ry[4];
#pragma unroll
            for (int k = 0; k < 4; ++k) { rx[k] = load_raw(X + (size_t)(row0 + k) * D, lane); if (Y) ry[k] = load_raw(Y + (size_t)(row0 + k) * D, lane); }
            RowV x[4];
#pragma unroll
            for (int k = 0; k < 4; ++k) { unpack_row(rx[k], x[k]);
                if (Y) { RowV y; unpack_row(ry[k], y);
#pragma unroll
                    for (int i = 0; i < 16; ++i) x[k].v[i] = ALPHA * x[k].v[i] + y.v[i]; }
                ln_rowv(x[k], gb);
                store_rowv_bf16(out + (size_t)(row0 + k) * D, lane, x[k]);
                store_rowv_fp8(out8 + (size_t)(row0 + k) * D, lane, x[k], pg8::F8_XS); }
            float val[64];
#pragma unroll
            for (int i = 0; i < 64; ++i) val[i] = 0.f;
#pragma unroll
            for (int j = 0; j < 16; ++j) { const LAS float* wr = rwl + (j * 64 + lane) * RW_LD;
#pragma unroll
                for (int e4 = 0; e4 < 4; ++e4) { const f32x4 w4 = *(const LAS f32x4*)(wr + 4 * e4);
#pragma unroll
                    for (int k = 0; k < 4; ++k) { const float xv = x[k].v[j];
                        val[16 * k + 4 * e4 + 0] += xv * w4[0]; val[16 * k + 4 * e4 + 1] += xv * w4[1]; val[16 * k + 4 * e4 + 2] += xv * w4[2]; val[16 * k + 4 * e4 + 3] += xv * w4[3]; } } }
#pragma unroll
            for (int i = 0; i < 32; ++i) { const auto rr = __builtin_amdgcn_permlane32_swap(__float_as_uint(val[i]), __float_as_uint(val[i + 32]), false, false); val[i] = __uint_as_float(rr[0]) + __uint_as_float(rr[1]); }
            { const bool bt = (lane & 16) != 0;
#pragma unroll
              for (int i = 0; i < 16; ++i) { const float keep = bt ? val[i + 16] : val[i], send = bt ? val[i] : val[i + 16]; val[i] = keep + swz_xor<16>(send); } }
            { const bool bt = (lane & 8) != 0;
#pragma unroll
              for (int i = 0; i < 8; ++i) { const float keep = bt ? val[i + 8] : val[i], send = bt ? val[i] : val[i + 8]; val[i] = keep + swz_xor<8>(send); } }
            { const bool bt = (lane & 4) != 0;
#pragma unroll
              for (int i = 0; i < 4; ++i) { const float keep = bt ? val[i + 4] : val[i], send = bt ? val[i] : val[i + 4]; val[i] = keep + swz_xor<4>(send); } }
            { const bool bt = (lane & 2) != 0;
#pragma unroll
              for (int i = 0; i < 2; ++i) { const float keep = bt ? val[i + 2] : val[i], send = bt ? val[i] : val[i + 2]; val[i] = keep + swz_xor<2>(send); } }
            { const bool bt = (lane & 1) != 0; const float keep = bt ? val[1] : val[0], send = bt ? val[0] : val[1]; val[0] = keep + swz_xor<1>(send); }
            lgs[lane] = val[0];
            LDS_WAIT();
            if (lane < 4) {
                const int row = row0 + lane;
                float lg[16];
#pragma unroll
                for (int e4 = 0; e4 < 4; ++e4) { const f32x4 t4 = *(const LAS f32x4*)(lgs + 16 * lane + 4 * e4); lg[4 * e4] = t4[0]; lg[4 * e4 + 1] = t4[1]; lg[4 * e4 + 2] = t4[2]; lg[4 * e4 + 3] = t4[3]; }
                float mx = lg[0];
#pragma unroll
                for (int e = 1; e < 16; ++e) mx = fmaxf(mx, lg[e]);
                float sc[16], sum = 0.f;
#pragma unroll
                for (int e = 0; e < 16; ++e) { sc[e] = __expf(lg[e] - mx); sum += sc[e]; }
                const float isum = 1.f / sum;
                float bz[16];
#pragma unroll
                for (int e = 0; e < 16; ++e) { sc[e] *= isum; bz[e] = sc[e] + rbias[e]; }
                float gs[4]; int gi1[4], gi2[4];
#pragma unroll
                for (int gq = 0; gq < 4; ++gq) {
                    float m1 = bz[4 * gq]; int i1 = 0;
#pragma unroll
                    for (int j = 1; j < 4; ++j) if (bz[4 * gq + j] > m1) { m1 = bz[4 * gq + j]; i1 = j; }
                    float m2 = -INFINITY; int i2 = 0;
#pragma unroll
                    for (int j = 0; j < 4; ++j) if (j != i1 && bz[4 * gq + j] > m2) { m2 = bz[4 * gq + j]; i2 = j; }
                    gs[gq] = m1 + m2; gi1[gq] = i1; gi2[gq] = i2;
                }
                int gsel = 0; float gm = gs[0];
#pragma unroll
                for (int gq = 1; gq < 4; ++gq) if (gs[gq] > gm) { gm = gs[gq]; gsel = gq; }
                int i1 = gi1[0], i2 = gi2[0];
#pragma unroll
                for (int gq = 1; gq < 4; ++gq) if (gsel == gq) { i1 = gi1[gq]; i2 = gi2[gq]; }
                const int e1 = gsel * 4 + i1, e2 = gsel * 4 + i2;
                float s1 = 0.f, s2 = 0.f;
#pragma unroll
                for (int e = 0; e < 16; ++e) { if (e == e1) s1 = sc[e]; if (e == e2) s2 = sc[e]; }
                const float inv = 1.f / (s1 + s2);
                *(int2*)(eidx + 2 * row) = make_int2(e1, e2); *(float2*)(ewgt + 2 * row) = make_float2(s1 * inv, s2 * inv);
                atomicAdd((int*)&hist[e1], 1); atomicAdd((int*)&hist[e2], 1);
            }
        }
        __syncthreads();
        if (F.tid < 16) bcnt[vb * 16 + F.tid] = hist[F.tid];
        __syncthreads();
    }
}
__device__ __forceinline__ void phase_moe_book(const Frame& F, const int* eidx, const int* bcnt, int* tok, int* pos, int* tile_e) {
    LAS int* bc = (LAS int*)F.lds;
    LAS int* part = bc + 4096;
    LAS int* off = part + 256;
    LAS int* base = off + 32;
    LAS int* tot = base + 16;
    LAS int* wcnt = tot + 16;
    for (int i = F.tid; i < 4096; i += NTHREADS) bc[i] = bcnt[i];
    __syncthreads();
    if (F.tid < 256) { const int e = F.tid & 15, ch = F.tid >> 4; int s = 0;
#pragma unroll
        for (int j = 0; j < 16; ++j) s += bc[(ch * 16 + j) * 16 + e];
        part[ch * 16 + e] = s; }
    __syncthreads();
    if (F.tid < 16) { int t = 0;
#pragma unroll
        for (int ch = 0; ch < 16; ++ch) t += part[ch * 16 + F.tid];
        tot[F.tid] = t; }
    __syncthreads();
    if (F.tid == 0) { int o = 0;
#pragma unroll
        for (int e = 0; e < 16; ++e) { off[e] = o; o += (tot[e] + 255) & ~255; } off[16] = o; }
    __syncthreads();
    for (int vb = F.vcu; vb < T / 128; vb += F.G) {
        if (F.tid < 16) { const int e = F.tid, chv = vb >> 4; int bs = 0;
            for (int ch = 0; ch < chv; ++ch) bs += part[ch * 16 + e];
            for (int b2 = chv * 16; b2 < vb; ++b2) bs += bc[b2 * 16 + e];
            base[e] = bs; }
        int e = 0, rank = 0;
        if (F.tid < 256) {
            e = eidx[vb * 256 + F.tid];
            const unsigned long long lt = (1ull << F.lane) - 1ull;
#pragma unroll
            for (int k = 0; k < 16; ++k) { const unsigned long long mk = __ballot(e == k); if (e == k) rank = __popcll(mk & lt); if (F.lane == 0) wcnt[F.wave * 16 + k] = __popcll(mk); }
        }
        __syncthreads();
        if (F.tid < 256) {
            for (int w2 = 0; w2 < F.wave; ++w2) rank += wcnt[w2 * 16 + e];
            const int r = off[e] + base[e] + rank;
            pos[vb * 256 + F.tid] = r; tok[r] = vb * 128 + (F.tid >> 1);
        }
        if (vb < 16) { const int e2 = vb, r0 = off[e2] + tot[e2], r1 = off[e2 + 1]; for (int r = r0 + F.tid; r < r1; r += NTHREADS) tok[r] = 0; }
        if (vb == 16) {
            for (int tl = F.tid; tl < NTILE; tl += NTHREADS) { int e3 = -1;
#pragma unroll
                for (int k = 0; k < 16; ++k) if (tl * 256 >= off[k] && tl * 256 < off[k + 1]) e3 = k;
                tile_e[tl] = e3; }
            if (F.tid == 0) tile_e[NTILE] = off[16] >> 8;
        }
        __syncthreads();
    }
}
__device__ __forceinline__ void phase_pool(const Frame& F, const bf16_t* HP, bf16_t* PO) {
    constexpr int RUN = 32;
    const int gt = F.vcu * NTHREADS + F.tid, NGT = F.G * NTHREADS;
    for (int it = gt; it < (T / RUN) * (D / 8); it += NGT) {
        const int c8 = it & 127, run = it >> 7, g = c8 >> 5, win = 2 << g, t0 = run * RUN, ts0 = t0 & (S - 1);
        const bf16_t* hp = HP + (size_t)t0 * D + c8 * 8; bf16_t* po = PO + (size_t)t0 * D + c8 * 8;
        float s[8];
#pragma unroll
        for (int q = 0; q < 8; ++q) s[q] = 0.f;
        for (int k = 1; k < win; ++k) if (ts0 - k >= 0) { float v[8]; unpk8(*(const v4u*)(hp - (ptrdiff_t)k * D), v);
#pragma unroll
            for (int q = 0; q < 8; ++q) s[q] += v[q]; }
#pragma unroll 4
        for (int i = 0; i < RUN; ++i) {
            float hn[8]; unpk8(*(const v4u*)(hp + (size_t)i * D), hn);
            const int ts = ts0 + i;
#pragma unroll
            for (int q = 0; q < 8; ++q) s[q] += hn[q];
            const float inv = 1.f / (float)(ts + 1 < win ? ts + 1 : win);
            v4u o; o.x = pk2(s[0] * inv - hn[0], s[1] * inv - hn[1]); o.y = pk2(s[2] * inv - hn[2], s[3] * inv - hn[3]); o.z = pk2(s[4] * inv - hn[4], s[5] * inv - hn[5]); o.w = pk2(s[6] * inv - hn[6], s[7] * inv - hn[7]);
            *(v4u*)(po + (size_t)i * D) = o;
            if (ts + 1 >= win) { float ho[8]; unpk8(*(const v4u*)(hp + (ptrdiff_t)(i + 1 - win) * D), ho);
#pragma unroll
                for (int q = 0; q < 8; ++q) s[q] -= ho[q]; }
        }
    }
}
}
namespace mk {
typedef short bf16x8 __attribute__((ext_vector_type(8)));
typedef float f32x16 __attribute__((ext_vector_type(16)));
#define MFMA32(a, b, c) __builtin_amdgcn_mfma_f32_32x32x16_bf16((a), (b), (c), 0, 0, 0)
__device__ __forceinline__ int crow(int i, int h) { return (i & 3) + 8 * (i >> 2) + 4 * h; }
__device__ __forceinline__ float swap32_max(float v) { const auto r = __builtin_amdgcn_permlane32_swap(__float_as_uint(v), __float_as_uint(v), false, false); return fmaxf(__uint_as_float(r[0]), __uint_as_float(r[1])); }
__device__ __forceinline__ float swap32_sum(float v) { const auto r = __builtin_amdgcn_permlane32_swap(__float_as_uint(v), __float_as_uint(v), false, false); return __uint_as_float(r[0]) + __uint_as_float(r[1]); }
__device__ __forceinline__ unsigned pkbf(float lo, float hi) { unsigned r; asm volatile("v_cvt_pk_bf16_f32 %0, %1, %2" : "=v"(r) : "v"(lo), "v"(hi)); return r; }
__device__ __forceinline__ bf16x8 pack_step(const f32x16& x, int s) {
    v4u p; p.x = pkbf(x[8 * s + 0], x[8 * s + 1]); p.y = pkbf(x[8 * s + 2], x[8 * s + 3]); p.z = pkbf(x[8 * s + 4], x[8 * s + 5]); p.w = pkbf(x[8 * s + 6], x[8 * s + 7]);
    return __builtin_bit_cast(bf16x8, p);
}
__device__ __forceinline__ bf16x8 lds_frag2x8(const LAS unsigned char* p) {
    const v2u a = *(const LAS v2u*)p, b = *(const LAS v2u*)(p + 16);
    v4u q; q.x = a.x; q.y = a.y; q.z = b.x; q.w = b.y; return __builtin_bit_cast(bf16x8, q);
}
__device__ __forceinline__ void unpack8(const v4u u, float (&x)[8]) {
    x[0] = __uint_as_float(u.x << 16); x[1] = __uint_as_float(u.x & 0xffff0000u); x[2] = __uint_as_float(u.y << 16); x[3] = __uint_as_float(u.y & 0xffff0000u);
    x[4] = __uint_as_float(u.z << 16); x[5] = __uint_as_float(u.z & 0xffff0000u); x[6] = __uint_as_float(u.w << 16); x[7] = __uint_as_float(u.w & 0xffff0000u);
}

__device__ __forceinline__ void phase_swa_sgu(const Frame& F, const bf16_t* H0, const float* sinks, const float* lng, const float* lnb, const bf16_t* SW, const float* bs, bf16_t* MIX) {
    constexpr int KSTR = 272, VSTR = 520, VT_OFF = 256 * KSTR, VGSTR = 272, VGW = 64 * VGSTR;
    LAS unsigned char* KS = F.lds; LAS unsigned char* VT = F.lds + VT_OFF;
    const int lane = F.lane, r = lane & 31, h = lane >> 5, w = F.wave, kvh = w >> 2;
    const float NEG = -INFINITY;
    for (int vb = F.vcu; vb < T / 128; vb += F.G) {
        const int n = vb & 63; const size_t row0 = (size_t)vb * 128;
#pragma unroll
        for (int i = 0; i < 8; ++i) { const int p = F.tid + NTHREADS * i, row = p >> 4, c16 = p & 15; v4u v = (v4u){0u, 0u, 0u, 0u};
            if (n > 0 || row >= 128) v = *(const v4u*)(H0 + (row0 + row - 128) * NIN0 + 512 + c16 * 8);
            *(LAS v4u*)(KS + row * KSTR + c16 * 16) = v; }
#pragma unroll
        for (int i = 0; i < 8; ++i) { const int p = F.tid + NTHREADS * i, c16 = p >> 8, row = p & 255; v4u v = (v4u){0u, 0u, 0u, 0u};
            if (n > 0 || row >= 128) v = *(const v4u*)(H0 + (row0 + row - 128) * NIN0 + 640 + c16 * 8);
            LAS bf16_t* d = (LAS bf16_t*)(VT + (c16 * 8) * VSTR + row * 2);
            d[0 * (VSTR / 2)] = (bf16_t)(v.x & 0xffffu); d[1 * (VSTR / 2)] = (bf16_t)(v.x >> 16); d[2 * (VSTR / 2)] = (bf16_t)(v.y & 0xffffu); d[3 * (VSTR / 2)] = (bf16_t)(v.y >> 16);
            d[4 * (VSTR / 2)] = (bf16_t)(v.z & 0xffffu); d[5 * (VSTR / 2)] = (bf16_t)(v.z >> 16); d[6 * (VSTR / 2)] = (bf16_t)(v.w & 0xffffu); d[7 * (VSTR / 2)] = (bf16_t)(v.w >> 16); }
        __syncthreads();
        const float sink2 = sinks[w] * 1.4426950408889634f;
        bf16x8 qn[4];
        { const bf16_t* qp = H0 + (row0 + r) * NIN0 + w * 64 + 8 * h;
#pragma unroll
          for (int ks = 0; ks < 4; ++ks) qn[ks] = *(const bf16x8*)(qp + 16 * ks); }
#pragma unroll 1
        for (int qg = 0; qg < 4; ++qg) {
            bf16x8 qf[4];
#pragma unroll
            for (int ks = 0; ks < 4; ++ks) qf[ks] = qn[ks];
            if (qg < 3) { const bf16_t* qp = H0 + (row0 + 32 * (qg + 1) + r) * NIN0 + w * 64 + 8 * h;
#pragma unroll
              for (int ks = 0; ks < 4; ++ks) qn[ks] = *(const bf16x8*)(qp + 16 * ks); }
            f32x16 st[5];
#pragma unroll
            for (int kt = 0; kt < 5; ++kt) {
#pragma unroll
                for (int i = 0; i < 16; ++i) st[kt][i] = 0.f;
                const LAS unsigned char* kp = KS + (32 * qg + 32 * kt + r) * KSTR + (kvh * 64 + 8 * h) * 2;
#pragma unroll
                for (int ks = 0; ks < 4; ++ks) { const bf16x8 kf = *(const LAS bf16x8*)(kp + 32 * ks); st[kt] = MFMA32(kf, qf[ks], st[kt]); }
            }
            float m = sink2;
            int rq = r; asm volatile("" : "+v"(rq));
#pragma unroll
            for (int kt = 0; kt < 5; ++kt)
#pragma unroll
                for (int i = 0; i < 16; ++i) { const int dk = 32 * kt + crow(i, h) - rq;
                    float s = st[kt][i] * ASCALE;
                    if (kt == 0) s = dk >= 1 ? s : NEG;
                    if (kt == 4) s = dk <= 128 ? s : NEG;
                    st[kt][i] = s; }
            if (n == 0) {
#pragma unroll
                for (int kt = 0; kt < 5; ++kt)
#pragma unroll
                    for (int i = 0; i < 16; ++i) if (32 * qg + 32 * kt + crow(i, h) < 128) st[kt][i] = NEG; }
#pragma unroll
            for (int kt = 0; kt < 5; ++kt)
#pragma unroll
                for (int i = 0; i < 16; ++i) m = fmaxf(m, st[kt][i]);
            m = swap32_max(m);
            float l = 0.f;
#pragma unroll
            for (int kt = 0; kt < 5; ++kt)
#pragma unroll
                for (int i = 0; i < 16; ++i) { const float p = __builtin_amdgcn_exp2f(st[kt][i] - m); st[kt][i] = p; l += p; }
            l = swap32_sum(l) + __builtin_amdgcn_exp2f(sink2 - m);
            f32x16 o[2];
#pragma unroll
            for (int i = 0; i < 16; ++i) { o[0][i] = 0.f; o[1][i] = 0.f; }
#pragma unroll
            for (int kt = 0; kt < 5; ++kt)
#pragma unroll
                for (int s = 0; s < 2; ++s) { const bf16x8 pf = pack_step(st[kt], s);
#pragma unroll
                    for (int dt = 0; dt < 2; ++dt) { const bf16x8 vf = lds_frag2x8(VT + (kvh * 64 + 32 * dt + r) * VSTR + (32 * qg + 32 * kt + 16 * s + 4 * h) * 2); o[dt] = MFMA32(vf, pf, o[dt]); } }
            const float inv = 1.f / l;
            bf16_t* op = MIX + (row0 + 32 * qg + r) * D + w * 64 + 4 * h;
#pragma unroll
            for (int dt = 0; dt < 2; ++dt)
#pragma unroll
                for (int g4 = 0; g4 < 4; ++g4) { v2u u; u.x = pkbf(o[dt][4 * g4 + 0] * inv, o[dt][4 * g4 + 1] * inv); u.y = pkbf(o[dt][4 * g4 + 2] * inv, o[dt][4 * g4 + 3] * inv); *(v2u*)(op + 32 * dt + 8 * g4) = u; }
        }
        __syncthreads();
        {
            LAS unsigned char* VG = F.lds + w * VGW; const int g = w;
            const int lane2 = (int)lane_id_fresh(), r2 = lane2 & 31, h2 = lane2 >> 5;
#pragma unroll 1
            for (int it = 0; it < 2; ++it) { const int s = 64 * it + lane2; const bf16_t* vp = H0 + (row0 + s) * NIN0 + 1280 + g * 64;
                float x[8][8]; float sum = 0.f;
#pragma unroll
                for (int cq = 0; cq < 8; ++cq) { unpack8(*(const v4u*)(vp + 8 * cq), x[cq]);
#pragma unroll
                    for (int e = 0; e < 8; ++e) sum += x[cq][e]; }
                const float mu = sum * (1.f / 64.f); float q = 0.f;
#pragma unroll
                for (int cq = 0; cq < 8; ++cq)
#pragma unroll
                    for (int e = 0; e < 8; ++e) { x[cq][e] -= mu; q += x[cq][e] * x[cq][e]; }
                const float rstd = 1.f / sqrtf(q * (1.f / 64.f) + LN_EPS);
#pragma unroll
                for (int cq = 0; cq < 8; ++cq) { const float* gp = lng + g * 64 + 8 * cq; const float* bp = lnb + g * 64 + 8 * cq; asm volatile("" : "+s"(gp), "+s"(bp));
#pragma unroll
                    for (int e = 0; e < 8; ++e) { const int c = 8 * cq + e; *(LAS bf16_t*)(VG + c * VGSTR + s * 2) = f2bf(x[cq][e] * rstd * gp[e] + bp[e]); } }
            }
            LDS_WAIT();
#pragma unroll 1
            for (int tt = 0; tt < 4; ++tt) {
                f32x16 acc[2];
#pragma unroll
                for (int i = 0; i < 16; ++i) { acc[0][i] = 0.f; acc[1][i] = 0.f; }
                const bf16_t* wp = SW + ((size_t)(g * 128 + 32 * tt + r2) * 128 + 8 * h2);
                const int nks = 2 * (tt + 1);
                bf16x8 bfr[8];
#pragma unroll
                for (int ks = 0; ks < 8; ++ks) if (ks < nks) bfr[ks] = *(const bf16x8*)(wp + 16 * ks);
                const int t = 32 * tt + r2; const float bias = bs[g * 128 + t];
                const bf16_t* up = H0 + (row0 + t) * NIN0 + 768 + g * 64 + 4 * h2; bf16_t* op = MIX + (row0 + t) * D + 512 + g * 64 + 4 * h2;
                v2u uu[2][4];
#pragma unroll
                for (int ct = 0; ct < 2; ++ct)
#pragma unroll
                    for (int g4 = 0; g4 < 4; ++g4) uu[ct][g4] = *(const v2u*)(up + 32 * ct + 8 * g4);
#pragma unroll
                for (int ks = 0; ks < 8; ++ks) if (ks < nks) {
#pragma unroll
                    for (int ct = 0; ct < 2; ++ct) { const bf16x8 af = *(const LAS bf16x8*)(VG + (32 * ct + r2) * VGSTR + (16 * ks + 8 * h2) * 2); acc[ct] = MFMA32(af, bfr[ks], acc[ct]); } }
#pragma unroll
                for (int ct = 0; ct < 2; ++ct)
#pragma unroll
                    for (int g4 = 0; g4 < 4; ++g4) { const v2u u2 = uu[ct][g4];
                        const float u0 = __uint_as_float(u2.x << 16), u1 = __uint_as_float(u2.x & 0xffff0000u), u2f = __uint_as_float(u2.y << 16), u3 = __uint_as_float(u2.y & 0xffff0000u);
                        v2u o2; o2.x = pkbf(u0 * (acc[ct][4 * g4 + 0] + bias), u1 * (acc[ct][4 * g4 + 1] + bias)); o2.y = pkbf(u2f * (acc[ct][4 * g4 + 2] + bias), u3 * (acc[ct][4 * g4 + 3] + bias));
                        *(v2u*)(op + 32 * ct + 8 * g4) = o2; }
            }
        }
        __syncthreads();
    }
}

}
namespace mk {
constexpr int NPHASE = 23;
constexpr int N_EARLY = 896 + 2 * 1024, NITEMS = N_EARLY + 3 * 512 + 2 * (512 + 3 * 4096);
constexpr int GEMM_CUS_P1 = 160;

typedef const __attribute__((address_space(4))) Args* KArgs;
__device__ __forceinline__ KArgs kargs() { KArgs p = (KArgs)__builtin_amdgcn_kernarg_segment_ptr(); asm volatile("" : "+s"(p)); return p; }

__device__ __forceinline__ void decode_item(KArgs ka, bf16_t* WB, int it, TItem& t) {
                    int r = it;
#define JOB(MAP, F8_, src, K_, N_, dst, dstb, cnt) if (r < (cnt)) { titem_fill<MAP, F8_>(t, src, K_, N_, dst, dstb, r); return; } r -= (cnt);
                    JOB(0, true, ka->in[5], 1024, 1792, WB + WB_IN0, 0, 896)
                    JOB(0, false, ka->in[15], 1024, 2048, WB + WB_LAYER + WL_XKV, 0, 1024)
                    JOB(0, false, ka->in[31], 1024, 2048, WB + WB_LAYER + WL_SIZE + WL_XKV, 0, 1024)
                    JOB(0, false, ka->in[11], 1024, 1024, WB + WB_OUT0, 0, 512)
                    JOB(0, false, ka->in[24], 1024, 1024, WB + WB_IN1, 0, 512)
                    JOB(0, false, ka->in[27], 1024, 1024, WB + WB_OUT1, 0, 512)
#define LAYER_JOBS(l, c2) { bf16_t* Wl = WB + WB_LAYER + (size_t)(l) * WL_SIZE; \
                        JOB(0, false, ka->in[(c2) + 4], 1024, 1024, Wl + WL_XO, 0, 512) \
                        JOB(1, true, ka->in[(c2) + 7], 1024, 512, Wl + WL_GU, (size_t)1024 * 1024, 4096)     \
                        JOB(2, true, ka->in[(c2) + 8], 1024, 512, Wl + WL_GU, (size_t)1024 * 1024, 4096) \
                        JOB(0, true, ka->in[(c2) + 9], 512, 1024, Wl + WL_DN, (size_t)1024 * 512, 4096) }
                    LAYER_JOBS(0, 12)
                    LAYER_JOBS(1, 28)
#undef LAYER_JOBS
#undef JOB
}

__device__ __forceinline__ bool in_range(int k) { KArgs ka = kargs(); return ka->ph_lo <= k && k < ka->ph_hi; }

__global__ void __launch_bounds__(NTHREADS, 2) mega(Args a) {
    extern __shared__ __attribute__((aligned(16))) unsigned char lds_raw[];
    LAS unsigned char* const F0lds = (LAS unsigned char*)lds_raw;
    const int F0wave = __builtin_amdgcn_readfirstlane((int)threadIdx.x >> 6);
    const int F0G = gridDim.x, F0bx = blockIdx.x, F0vcu = (F0G % 8 == 0) ? (F0bx % 8) * (F0G / 8) + F0bx / 8 : F0bx;
    volatile LAS unsigned* MISC = (volatile LAS unsigned*)(F0lds + MISC_OFF);
    if (threadIdx.x < 64) MISC[threadIdx.x] = 0u;
    __syncthreads();
    unsigned* ctl = (unsigned*)(a.ws + WS_CTL);
    XcdBarrier bar = xcd_barrier_post(ctl + CW_BAR + a.ph_lo * XCD_BAR_WORDS, MISC + 8, F0wave);
#define IN(k) in_range(k)
#define SEAM(k) do { if (IN(k) && IN((k) + 1)) { XcdBarrier b2_ = bar; asm volatile("" : "+s"(b2_.bar), "+s"(b2_.x)); xcd_barrier(b2_); } } while (0)
#define PH KArgs ka = kargs(); unsigned char* ws = ka->ws; (void)ws; Frame Fp; Fp.lds = F0lds; Fp.wave = F0wave; Fp.vcu = F0vcu; Fp.G = F0G; Fp.bx = F0bx; asm volatile("" : "+s"(Fp.wave), "+s"(Fp.vcu), "+s"(Fp.G), "+s"(Fp.bx)); \
    Fp.lane = (int)lane_id_fresh(); Fp.tid = Fp.wave * 64 + Fp.lane; const Frame& F = Fp; \
    const int bx = Fp.bx; (void)bx; LAS unsigned char* glds = F.lds; (void)glds; \
    bf16_t* RA = (bf16_t*)(ws + WS_A); bf16_t* RB = (bf16_t*)(ws + WS_B); bf16_t* RC = (bf16_t*)(ws + WS_C); bf16_t* RD = (bf16_t*)(ws + WS_D); bf16_t* WB = (bf16_t*)(ws + WS_WB); \
    (void)RA; (void)RB; (void)RC; (void)RD; (void)WB;
#define PHC PH const int cb = L == 0 ? 12 : 28; (void)cb; bf16_t* WBl = WB + WB_LAYER + (size_t)L * WL_SIZE; (void)WBl; \
    bf16_t *X1 = RB, *X2 = RA, *HS = RB, *DS = RD, *X3 = L == 0 ? RC : nullptr;   unsigned char *X1_8 = (unsigned char*)(L == 0 ? RD : RA), *P8 = (unsigned char*)(L == 0 ? RA : RC), *X2_8 = (unsigned char*)(L == 0 ? RD : RC); bf16_t* Y2 = L == 0 ? RC : RD; \
    (void)X1; (void)P8; (void)X1_8; (void)X2_8; (void)Y2; (void)X2; (void)HS; (void)DS; (void)X3;
#ifndef DOUBLE_MASK
#define DOUBLE_MASK 0u
#endif
#if DOUBLE_MASK != 0
#define REP(k) for (int rep_ = 0, nrep_ = 1 + (int)((DOUBLE_MASK >> (k)) & 1u); rep_ < nrep_; ++rep_)
#else
#define REP(k)
#endif
#define INF(i) ((const float*)ka->in[i])
#define WSI(off) ((int*)(ws + (off)))
#define WSF(off) ((float*)(ws + (off)))

#define GEMM_STD(EPI, ORD, LDA_, LDB_, K_) pg8::gemm_phase<EPI, ORD, true, true, false, LDA_, LDB_, K_>(glds, F.tid, g, S, E)
    for (int L = 0; L < 2; ++L) {
        const int cbp = L == 0 ? 0 : 11;
        if (L == 0) {
            if (IN(0)) REP(0) { PH
                LAS float* scrA = (LAS float*)(F.lds + F.wave * 16896), * scrB = scrA + 64 * 33;
                const int gw = F.vcu * NWAVES + F.wave, NGW = F.G * NWAVES;
                for (int it = gw; it < N_EARLY; it += 2 * NGW) {
                    TItem ta, tb; TRegs ra, rb; const int itb = it + NGW < N_EARLY ? it + NGW : it;
                    decode_item(ka, WB, it, ta); titem_load(ta, F.lane, ra);
                    decode_item(ka, WB, itb, tb); titem_load(tb, F.lane, rb);
                    titem_finish(ta, F.lane, ra, scrA);
                    titem_finish(tb, F.lane, rb, scrB);
                }
                const int gt = F.vcu * NTHREADS + F.tid, NGT = F.G * NTHREADS;
                { const float4* x4 = (const float4*)ka->in[0]; v2u* o = (v2u*)RA; unsigned* o8 = (unsigned*)RB;
                  for (int i = gt; i < T * D / 4; i += 4 * NGT) { float4 v[4];
#pragma unroll
                      for (int k = 0; k < 4; ++k) v[k] = x4[i + k * NGT];
#pragma unroll
                      for (int k = 0; k < 4; ++k) { v2u w; w.x = pk2(v[k].x, v[k].y); w.y = pk2(v[k].z, v[k].w); o[i + k * NGT] = w;
                          o8[i + k * NGT] = pg8::pk4_fp8(v[k].x * pg8::F8_XS, v[k].y * pg8::F8_XS, v[k].z * pg8::F8_XS, v[k].w * pg8::F8_XS); } } }
                { const float4* m4 = (const float4*)ka->in[1]; v2u* o = (v2u*)(ws + WS_MEMB);
                  for (int i = gt; i < B * MEM * D / 4; i += NGT) { const float4 v = m4[i]; v2u w; w.x = pk2(v.x, v.y); w.y = pk2(v.z, v.w); o[i] = w; } }
                { const int* positions = (const int*)ka->in[2]; float* ropew = WSF(WS_ROPE);
                  for (int t = gt; t < T; t += NGT) { const float p = (float)positions[t];
#pragma unroll
                      for (int j = 0; j < 8; ++j) { const float ang = p * ka->inv.f[j]; double rev = (double)ang * 0.15915494309189535; rev -= rint(rev); const float rr = (float)rev;
                          ropew[(size_t)t * 16 + j] = __builtin_amdgcn_cosf(rr); ropew[(size_t)t * 16 + 8 + j] = __builtin_amdgcn_sinf(rr); } } }
            }
            SEAM(0);
            if (IN(1)) REP(1) { PH float* rope = WSF(WS_ROPE); bf16_t* MEMB = (bf16_t*)(ws + WS_MEMB);
              const int GC = F.G >= 256 ? GEMM_CUS_P1 : F.G;
              if (bx >= GC || F.G < 256) {
                const int cid = F.G >= 256 ? bx - GC : bx, NC = F.G >= 256 ? F.G - GC : F.G;
                LAS float* scrA = (LAS float*)(F.lds + F.wave * 16896), * scrB = scrA + 64 * 33;
                const int gw = cid * NWAVES + F.wave, NGW = NC * NWAVES;
#define CLAMP_IT(x) ((x) < NITEMS ? (x) : NITEMS - 1)
                { TItem ta, tb, tc, td; TRegs ra, rb, rc, rd; int it = N_EARLY + gw;
                  decode_item(ka, WB, CLAMP_IT(it), ta); titem_load(ta, F.lane, ra);
                  decode_item(ka, WB, CLAMP_IT(it + NGW), tb); titem_load(tb, F.lane, rb);
                  for (; it < NITEMS; it += 4 * NGW) {
                      decode_item(ka, WB, CLAMP_IT(it + 2 * NGW), tc); titem_load(tc, F.lane, rc);
                      decode_item(ka, WB, CLAMP_IT(it + 3 * NGW), td); titem_load(td, F.lane, rd);
                      titem_finish(ta, F.lane, ra, scrA); titem_finish(tb, F.lane, rb, scrB);
                      decode_item(ka, WB, CLAMP_IT(it + 4 * NGW), ta); titem_load(ta, F.lane, ra);
                      decode_item(ka, WB, CLAMP_IT(it + 5 * NGW), tb); titem_load(tb, F.lane, rb);
                      titem_finish(tc, F.lane, rc, scrA); titem_finish(td, F.lane, rd, scrB);
                  } }
#undef CLAMP_IT
                const int gt = cid * NTHREADS + F.tid, NGT = NC * NTHREADS;
#pragma unroll
                for (int l = 0; l < 2; ++l) { const float4* q4 = (const float4*)ka->in[l == 0 ? 14 : 30]; v2u* o = (v2u*)(WB + WB_LAYER + (size_t)l * WL_SIZE + WL_XQ);
                  for (int i = gt; i < D * D / 4; i += NGT) { const float4 v = q4[i]; v2u w; w.x = pk2(v.x, v.y); w.y = pk2(v.z, v.w); o[i] = w; } }
                { const float4* p4 = (const float4*)ka->in[25]; const float4* s4 = (const float4*)ka->in[26]; v2u* o = (v2u*)(WB + WB_POOL);
                  for (int i = gt; i < 4 * 256 * 256 / 4; i += NGT) { const float4 v = p4[i]; const float4 sc = s4[(i >> 14) * 64 + (i & 63)]; v2u w; w.x = pk2(v.x * sc.x, v.y * sc.y); w.y = pk2(v.z * sc.z, v.w * sc.w); o[i] = w; } }
                { const float* sw = INF(9); bf16_t* o = WB + WB_SGUW;
                  for (int i = gt; i < 8 * 128 * 128; i += NGT) { const int s2 = i & 127, t = (i >> 7) & 127; o[i] = f2bf(s2 <= t ? sw[i] : 0.f); } }
                __syncthreads();
              }
              if (bx < GC) {
#pragma unroll 1
                for (int l = 0; l < 2; ++l) {
                    bf16_t* Wl = WB + WB_LAYER + (size_t)l * WL_SIZE;
                    pg8::Gemm g{MEMB, Wl + WL_XKV, nullptr};
                    const int c2 = bx - 96 - 32 * l;
                    pg8::StaticOrder S; S.init(B * MEM, 2048, GC, (c2 >= 0 && c2 < 32) ? c2 : (1 << 20), D, D);
                    pg8::EpiBf16 E{(bf16_t*)(ws + WS_MEMKV) + (size_t)l * B * MEM * 2048, 2048, 1.f};
                    GEMM_STD(pg8::EpiBf16, pg8::StaticOrder, D, D, D);
                }
                {
                    pg8::Gemm g{RB, WB + WB_IN0, nullptr};
                    pg8::StaticOrder S; S.init(T, NIN0, GC, bx, D, D);
                    pg8::EpiInproj0 E{RD, rope, 1.f / (pg8::F8_XS * pg8::F8_WS)};
                    pg8::gemm_phase<pg8::EpiInproj0, pg8::StaticOrder, true, true, false, D, D, D, true>(glds, F.tid, g, S, E);
                }
              }
            }
            SEAM(1);
            if (IN(2)) REP(2) { PH
                { bf16_t* Wl = WB + WB_LAYER; const bf16_t* KV = (const bf16_t*)(ws + WS_MEMKV);
                  { pg8::Gemm g{KV, Wl + WL_XQ, nullptr}; pg8::SetupOrder<0> S; S.init(bx, 0, 64); pg8::EpiF8 E{ws + WS_MT, D, QSCALE * pg8::F8_MS}; GEMM_STD(pg8::EpiF8, pg8::SetupOrder<0>, 2048, 1024, 256); }
                  { pg8::Gemm g{Wl + WL_XO, KV, nullptr}; pg8::SetupOrder<1> S; S.init(bx, 64, 64); pg8::EpiF8 E{ws + WS_NT, D, pg8::F8_NS}; GEMM_STD(pg8::EpiF8, pg8::SetupOrder<1>, 1024, 2048, 256); }
                  { pg8::Gemm g{WB + WB_OUT1, WB + WB_POOL, nullptr}; pg8::SetupOrder<2> S; S.init(bx, 128, 16); pg8::EpiBf16 E{WB + WB_WEFF, D, 1.f}; GEMM_STD(pg8::EpiBf16, pg8::SetupOrder<2>, 1024, 256, 256); } }
                phase_swa_sgu(F, RD, INF(6), INF(7), INF(8), WB + WB_SGUW, INF(10), RB);
            }
            SEAM(2);
            if (IN(3)) REP(3) { PH
                pg8::Gemm g{RB, WB + WB_OUT0, nullptr};
                pg8::StaticOrder S; S.init(T, D, F.G, bx, D, D);
                pg8::EpiBf16 E{RC, D, 1.f};
                GEMM_STD(pg8::EpiBf16, pg8::StaticOrder, D, D, D);
            }
            SEAM(3);
            if (IN(4)) REP(4) { PH phase_ln_add(F, RA, RC, INF(12), INF(13), RB, (unsigned char*)RD); }
            SEAM(4);
        } else {
            if (IN(12)) REP(12) { PH
                pg8::Gemm g{RC, WB + WB_IN1, nullptr};
                pg8::StaticOrder S; S.init(T, D, F.G, bx, D, D);
                pg8::EpiBf16 E{RB, D, 1.f};
                GEMM_STD(pg8::EpiBf16, pg8::StaticOrder, D, D, D);
            }
            SEAM(12);
            if (IN(13)) REP(13) { PH
                { bf16_t* Wl = WB + WB_LAYER + WL_SIZE; const bf16_t* KV = (const bf16_t*)(ws + WS_MEMKV) + (size_t)B * MEM * 2048;
                  { pg8::Gemm g{KV, Wl + WL_XQ, nullptr}; pg8::SetupOrder<0> S; S.init(bx, 0, 64); pg8::EpiF8 E{ws + WS_MT, D, QSCALE * pg8::F8_MS}; GEMM_STD(pg8::EpiF8, pg8::SetupOrder<0>, 2048, 1024, 256); }
                  { pg8::Gemm g{Wl + WL_XO, KV, nullptr}; pg8::SetupOrder<1> S; S.init(bx, 64, 64); pg8::EpiF8 E{ws + WS_NT, D, pg8::F8_NS}; GEMM_STD(pg8::EpiF8, pg8::SetupOrder<1>, 1024, 2048, 256); } }
                phase_pool(F, RB, RA);
            }
            SEAM(13);
            if (IN(14)) REP(14) { PH
                pg8::Gemm g{RA, WB + WB_WEFF, nullptr};
                pg8::StaticOrder S; S.init(T, D, F.G, bx, D, D);
                pg8::EpiBf16 E{RD, D, 1.f};
                GEMM_STD(pg8::EpiBf16, pg8::StaticOrder, D, D, D);
            }
            SEAM(14);
            if (IN(15)) REP(15) { PH phase_ln_add(F, RC, RD, INF(28), INF(29), RB, (unsigned char*)RA); }
            SEAM(15);
        }
        if (IN(cbp + 5)) REP(cbp + 5) { PHC
            pg8::Gemm g{(const bf16_t*)X1_8, (const bf16_t*)(ws + WS_MT), nullptr};
            pg8::BatchOrder S; S.init(T, D, F.G, bx, D, D);
            pg8::EpiSoftmaxT<true> E{P8, (LAS float*)(F.lds + 131072), 1.f / (pg8::F8_XS * pg8::F8_MS)};
            pg8::gemm_phase<pg8::EpiSoftmaxT<true>, pg8::BatchOrder, true, true, false, D, D, D, true>(glds, F.tid, g, S, E);
        }
        SEAM(cbp + 5);
        if (IN(cbp + 6)) REP(cbp + 6) { PHC
            pg8::Gemm g{(const bf16_t*)P8, (const bf16_t*)(ws + WS_NT), nullptr};
            pg8::BatchOrder S; S.init(T, D, F.G, bx, D, D);
            pg8::EpiBf16 E{Y2, D, 1.f / (pg8::F8_PS * pg8::F8_NS)};
            pg8::gemm_phase<pg8::EpiBf16, pg8::BatchOrder, true, true, false, D, D, D, true>(glds, F.tid, g, S, E);
        }
        SEAM(cbp + 6);
        if (IN(cbp + 7)) REP(cbp + 7) { PHC phase_ln_router(F, X1, Y2, INF(cb + 5), INF(cb + 6), X2, X2_8, INF(3), INF(4), WSI(WS_EIDX), WSF(WS_EWGT), WSI(WS_BCNT)); }
        SEAM(cbp + 7);
        if (IN(cbp + 8)) REP(cbp + 8) { PHC phase_moe_book(F, WSI(WS_EIDX), WSI(WS_BCNT), WSI(WS_TOK), WSI(WS_POS), WSI(WS_TILE)); }
        SEAM(cbp + 8);
        if (IN(cbp + 9)) REP(cbp + 9) { PHC const int* tile_e = WSI(WS_TILE); const int* tok = WSI(WS_TOK);
            const int ntiles = __builtin_amdgcn_readfirstlane(tile_e[NTILE]);
            pg8::Gemm g{(const bf16_t*)X2_8, WBl + WL_GU, tok};
            pg8::MoeOrder S; S.init(ntiles, tile_e, F.G, bx, D, D);
            pg8::EpiGU8 E{(unsigned char*)HS};
            pg8::gemm_phase<pg8::EpiGU8, pg8::MoeOrder, true, true, true, D, D, D, true>(glds, F.tid, g, S, E);
        }
        SEAM(cbp + 9);
        if (IN(cbp + 10)) REP(cbp + 10) { PHC const int* tile_e = WSI(WS_TILE);
            const int ntiles = __builtin_amdgcn_readfirstlane(tile_e[NTILE]);
            pg8::Gemm g{HS, WBl + WL_DN, nullptr};
            pg8::MoeOrder S; S.init(ntiles, tile_e, F.G, bx, DE, DE);
            pg8::EpiBf16 E{DS, D, 1.f / (pg8::F8_HS * pg8::F8_WS)};
            pg8::gemm_phase<pg8::EpiBf16, pg8::MoeOrder, true, true, false, DE, DE, DE, true>(glds, F.tid, g, S, E);
        }
        SEAM(cbp + 10);
        if (IN(cbp + 11)) REP(cbp + 11) { PHC phase_ln_moe(F, X2, DS, WSI(WS_POS), WSF(WS_EWGT), INF(cb + 10), INF(cb + 11), X3, L == 1 ? ka->out : nullptr); }
        SEAM(cbp + 11);
    }
#undef GEMM_STD
#undef IN
#undef SEAM
#undef INF
#undef PH
#undef PHC
#undef WSI
#undef WSF
}
}
using namespace nv;
extern "C" void kernel_launch(void* const* d_in, const int* in_sizes, int n_in, void* d_out, int out_size, void* d_ws, size_t ws_size, hipStream_t stream) {
    (void)in_sizes; (void)out_size;
    if (ws_size < WS_END || n_in != 40) return;
    static int grid = 0;
    if (grid == 0) {
        int dev = 0, cus = 0;
        if (hipGetDevice(&dev) != hipSuccess || hipDeviceGetAttribute(&cus, hipDeviceAttributeMultiprocessorCount, dev) != hipSuccess) { grid = -1; return; }
        if (hipFuncSetAttribute((const void*)mk::mega, hipFuncAttributeMaxDynamicSharedMemorySize, mk::LDS_BYTES) != hipSuccess) { grid = -1; return; }
        int per_cu = 0;
        if (hipOccupancyMaxActiveBlocksPerMultiprocessor(&per_cu, (const void*)mk::mega, mk::NTHREADS, mk::LDS_BYTES) != hipSuccess || per_cu < 1) { (void)hipGetLastError(); }
        grid = cus;
    }
    if (grid < 0) return;
    unsigned char* ws = (unsigned char*)d_ws;
    (void)hipMemsetAsync(ws + WS_CTL, 0, 512 * 1024, stream);
    mk::Args a{};
    for (int i = 0; i < 40; ++i) a.in[i] = d_in[i];
    a.out = (float*)d_out; a.ws = ws;
    for (int j = 0; j < 8; ++j) a.inv.f[j] = (float)pow(500000.0, -(double)((float)j * 2.0f / 16.0f));
    a.ph_lo = 0; a.ph_hi = mk::NPHASE;
    hipLaunchKernelGGL(mk::mega, dim3(grid), dim3(mk::NTHREADS), mk::LDS_BYTES, stream, a);
}
```

```cpp
#include <hip/hip_runtime.h>
#include <stdint.h>
#include <math.h>

typedef unsigned short bf16_t;

namespace nv {
constexpr int B = 4, S = 8192, T = B * S, D = 1024;
constexpr int NIN0 = 1792;
constexpr int MEM = 256, XH = 4, XHD = 256;
constexpr int NE = 16, DE = 512;
constexpr int MPAD = 65536 + 16 * 256;
constexpr int NTILE = MPAD / 256;
constexpr float ALPHA = 1.4142135623730951f;
constexpr float LN_EPS = 1e-5f;
constexpr float QSCALE = 0.0625f * 1.4426950408889634f;
constexpr float ASCALE = 0.125f * 1.4426950408889634f;

constexpr size_t MiB = 1u << 20;
constexpr size_t WS_CTL = 0;
constexpr size_t WS_ROPE = 2 * MiB;
constexpr size_t WS_EIDX = 4 * MiB;
constexpr size_t WS_EWGT = 5 * MiB;
constexpr size_t WS_POS = 6 * MiB;
constexpr size_t WS_BCNT = 7 * MiB;
constexpr size_t WS_TILE = 7 * MiB + 65536;
constexpr size_t WS_TOK = 7 * MiB + 131072;
constexpr size_t WS_MEMKV = 8 * MiB;
constexpr size_t WS_MEMB = 20 * MiB;
constexpr size_t WS_WB = 24 * MiB;
constexpr size_t WS_A = 152 * MiB, WS_B = 220 * MiB, WS_C = 288 * MiB, WS_D = 356 * MiB;
constexpr size_t WS_MT = 492 * MiB;
constexpr size_t WS_NT = 500 * MiB;
constexpr size_t WS_END = 508 * MiB;
constexpr size_t WB_IN0 = 0;
constexpr size_t WB_OUT0 = WB_IN0 + (size_t)1792 * 1024;
constexpr size_t WB_IN1 = WB_OUT0 + (size_t)1024 * 1024;
constexpr size_t WB_POOL = WB_IN1 + (size_t)1024 * 1024;
constexpr size_t WB_OUT1 = WB_POOL + (size_t)1024 * 256;
constexpr size_t WB_WEFF = WB_OUT1 + (size_t)1024 * 1024;
constexpr size_t WB_SGUW = WB_WEFF + (size_t)1024 * 1024;
constexpr size_t WB_LAYER = WB_SGUW + (size_t)8 * 128 * 128;
constexpr size_t WL_XQ = 0;
constexpr size_t WL_XKV = WL_XQ + (size_t)1024 * 1024;
constexpr size_t WL_XO = WL_XKV + (size_t)2048 * 1024;
constexpr size_t WL_GU = WL_XO + (size_t)1024 * 1024;
constexpr size_t WL_DN = WL_GU + (size_t)16 * 1024 * 1024;
constexpr size_t WL_SIZE = WL_DN + (size_t)16 * 1024 * 512;
static_assert((WB_LAYER + 2 * WL_SIZE) * 2 <= 128 * MiB, "bf16 weight region");

__device__ __forceinline__ float bf2f(bf16_t v) { return __uint_as_float((unsigned)v << 16); }
__device__ __forceinline__ bf16_t f2bf(float f) { unsigned u = __float_as_uint(f); return (bf16_t)((u + 0x7fffu + ((u >> 16) & 1u)) >> 16); }
__device__ __forceinline__ float gelu_tanh(float x) { const float u = 0.7978845608028654f * (x + 0.044715f * x * x * x); const float e = __expf(2.f * u); const float th = 1.f - 2.f / (e + 1.f); return 0.5f * x * (1.f + th); }
__device__ __forceinline__ float silu(float x) { return x / (1.f + __expf(-x)); }
template <int M> __device__ __forceinline__ float swz_xor(float v) { return __int_as_float(__builtin_amdgcn_ds_swizzle(__float_as_int(v), (M << 10) | 0x1f)); }
__device__ __forceinline__ float wave_sum(float v) {
    v += swz_xor<1>(v); v += swz_xor<2>(v); v += swz_xor<4>(v); v += swz_xor<8>(v); v += swz_xor<16>(v);
    const auto r = __builtin_amdgcn_permlane32_swap(__float_as_uint(v), __float_as_uint(v), false, false);
    return __uint_as_float(r[0]) + __uint_as_float(r[1]);
}
__device__ __forceinline__ float wave_max(float v) {
    v = fmaxf(v, swz_xor<1>(v)); v = fmaxf(v, swz_xor<2>(v)); v = fmaxf(v, swz_xor<4>(v)); v = fmaxf(v, swz_xor<8>(v)); v = fmaxf(v, swz_xor<16>(v));
    const auto r = __builtin_amdgcn_permlane32_swap(__float_as_uint(v), __float_as_uint(v), false, false);
    return fmaxf(__uint_as_float(r[0]), __uint_as_float(r[1]));
}
}

namespace pg8 {
#define PG8_LAS __attribute__((address_space(3)))
typedef short bf16x8 __attribute__((ext_vector_type(8)));
typedef float f32x4 __attribute__((ext_vector_type(4)));
typedef float f32x2 __attribute__((ext_vector_type(2)));
typedef unsigned u32x4 __attribute__((ext_vector_type(4)));
typedef unsigned u32x2 __attribute__((ext_vector_type(2)));
typedef int i32x8 __attribute__((ext_vector_type(8)));
constexpr int BM = 256, BK = 64, HALF = 128, HTB = HALF * BK * 2  , STAGE_BYTES = 8 * HTB, NXCD = 8, WGM = 8;

__host__ __device__ __forceinline__ int lds_byte(int r, int c) { const int st = (r >> 4) * 2 + (c >> 5), rr = r & 15, cc = c & 31, ob = rr * 64 + cc * 2; return st * 1024 + (ob ^ (((ob >> 9) & 1) << 5)); }
__host__ __device__ __forceinline__ void stage_rc(int b, int& R, int& C) { const int st = b / 1024, sb = b % 1024, swz = sb ^ (((sb >> 9) & 1) << 5); R = (st >> 1) * 16 + swz / 64; C = (st & 1) * 32 + (swz % 64) / 2; }
__host__ __device__ __forceinline__ int perm32(int rho) { const int n = rho >> 4, i = rho & 15; return 8 * (i >> 2) + 4 * n + (i & 3); }

struct Unit { int pm, pn, ao, bo; };
struct Gemm { const bf16_t* A; const bf16_t* Bt; const int* arow; PG8_LAS int* ltab; };

template <bool BATCHED = false>
struct StaticOrderT {
    int nM, nN, nwg, G, c, lda, ldb, apn;
    __device__ void init(int M, int N, int G_, int c_, int lda_, int ldb_, int apn_ = 0) { nM = M / BM; nN = N / BM; nwg = nM * nN; G = G_; c = c_; lda = lda_; ldb = ldb_; apn = apn_; }
    __device__ bool next(int i, Unit& u) const {
        const long L = (long)i * G + c; if (L >= nwg) return false;
        int wgid = (int)L; { const int q = nwg / NXCD, r = nwg % NXCD, xcd = wgid % NXCD, off = wgid / NXCD; wgid = (xcd < r ? xcd * (q + 1) : r * (q + 1) + (xcd - r) * q) + off; }
        const int nig = WGM * nN, gid = wgid / nig, fm = gid * WGM, gsz = (nM - fm) < WGM ? (nM - fm) : WGM;
        u.pm = fm + ((wgid % nig) % gsz); u.pn = (wgid % nig) / gsz;
        u.ao = u.pm * BM * lda + u.pn * apn; u.bo = (BATCHED ? ((u.pm >> 5) * 4 + u.pn) : u.pn) * BM * ldb; return true;
    }
};
typedef StaticOrderT<false> StaticOrder;
typedef StaticOrderT<true> BatchOrder;
struct MoeOrder {
    int nM, nwg, G, c, lda, ldb; const int* tile_e;
    __device__ void init(int ntiles, const int* te, int G_, int c_, int lda_, int ldb_) { nM = ntiles; nwg = nM * 4; G = G_; c = c_; tile_e = te; lda = lda_; ldb = ldb_; }
    __device__ bool next(int i, Unit& u) const {
        const long L = (long)i * G + c; if (L >= nwg) return false;
        int wgid = (int)L; { const int q = nwg / NXCD, r = nwg % NXCD, xcd = wgid % NXCD, off = wgid / NXCD; wgid = (xcd < r ? xcd * (q + 1) : r * (q + 1) + (xcd - r) * q) + off; }
        const int nig = WGM * 4, gid = wgid / nig, fm = gid * WGM, gsz = (nM - fm) < WGM ? (nM - fm) : WGM;
        u.pm = fm + ((wgid % nig) % gsz); u.pn = (wgid % nig) / gsz;
        const int e = __builtin_amdgcn_readfirstlane(tile_e[u.pm]); u.ao = u.pm * BM * lda; u.bo = (e * 4 + u.pn) * BM * ldb; return true;
    }
};
template <int KIND>
struct SetupOrder {
    int idx, n;
    __device__ void init(int c, int c0, int n_) { idx = c - c0; n = n_; }
    __device__ bool next(int i, Unit& u) const {
        if (i != 0 || idx < 0 || idx >= n) return false;
        const int x = idx >> 4, y = (idx >> 2) & 3, z = idx & 3;
        if (KIND == 0) { u.pm = x * 4 + y; u.pn = z; u.ao = (x * 256) * 2048 + y * 256; u.bo = z * 256 * 1024 + y * 256; }
        if (KIND == 1) { u.pm = x * 4 + y; u.pn = z; u.ao = y * 256 * 1024 + z * 256; u.bo = (x * 256) * 2048 + 1024 + z * 256; }
        if (KIND == 2) { u.pm = y; u.pn = z; u.ao = y * 256 * 1024 + z * 256; u.bo = z * 256 * 256; }
        return true;
    }
};

__device__ __forceinline__ int fresh_lane() { unsigned m = ~0u; asm volatile("" : "+s"(m)); return (int)__builtin_amdgcn_mbcnt_hi(m, __builtin_amdgcn_mbcnt_lo(m, 0u)); }
__device__ __forceinline__ unsigned cvt_pk_bf16(float lo, float hi) { unsigned r; asm volatile("v_cvt_pk_bf16_f32 %0, %1, %2" : "=v"(r) : "v"(lo), "v"(hi)); return r; }


template <class Epi, class Sched, bool ALIGN_EPI, bool SP2, bool GATHER, int LDA, int LDB, int KK, bool FP8 = false>
__device__ __forceinline__ void gemm_phase(PG8_LAS unsigned char* lds, int tid_in, const Gemm g, const Sched& S, const Epi& E) {
    int tid_ = tid_in; asm volatile("" : "+v"(tid_));
    const int tid = tid_, wid = __builtin_amdgcn_readfirstlane(tid >> 6), lane = tid & 63, wr = wid >> 2, wc = wid & 3, fr = lane & 15, fq = lane >> 4;
    constexpr int ELT = FP8 ? 1 : 2, K = KK, nt = K * ELT / (BK * 2), lda = LDA * ELT, ldb = LDB * ELT; (void)K;
    unsigned voffA[2], voffB[2];
#pragma unroll
    for (int i = 0; i < 2; ++i) { int R, C; stage_rc(tid * 16 + i * 8192, R, C); const int Rb = Epi::PERM ? ((R & ~31) + perm32(R & 31)) : R;
        voffA[i] = GATHER ? (unsigned)C * 2u : (unsigned)(R * lda + C * 2); voffB[i] = (unsigned)(Rb * ldb + C * 2); }
    const size_t kstep = (size_t)(BK * 2);
    const size_t hstepA = GATHER ? 0 : (size_t)HALF * lda, hstepB = (size_t)HALF * ldb;
    const unsigned ldsw = (unsigned)wid * 1024u, ldsbase = (unsigned)(size_t)lds;
    const int aoff = lds_byte(wr * 64 + fr, fq * 8), boff = lds_byte(wc * 32 + fr, fq * 8);
    const PG8_LAS unsigned char* ldsA = lds + aoff; const PG8_LAS unsigned char* ldsB = lds + 4 * HTB + boff; asm volatile("" : "+v"(ldsA), "+v"(ldsB));
    unsigned cg[2][2];
#define PG8_SA(b, h) (((b) * 2 + (h)) * HTB)
#define PG8_SB(b, h) ((4 + (b) * 2 + (h)) * HTB)
#define PG8_GLDS(sbase, voff32, ldsaddr) asm volatile("s_mov_b32 m0, %2\n\ts_nop 0\n\tglobal_load_lds_dwordx4 %0, %1" :: "v"(voff32), "s"(sbase), "s"(ldsaddr) : "memory", "m0")
#define PG8_STAGE(bufoff, gbase, voff) do { const char* _sb = (const char*)(gbase); _Pragma("unroll") for (int _i = 0; _i < 2; ++_i) \
        PG8_GLDS(_sb + (size_t)_i * 64 * ldb, (voff)[0], (unsigned)(ldsbase + (bufoff) + ldsw + _i * 8192)); } while (0)
#define PG8_STAGE_A(bufoff, abase, h, GO) do { const char* _sb = GATHER ? (const char*)(abase) : (const char*)(abase) + ((h) ? hstepA : (size_t)0); _Pragma("unroll") for (int _i = 0; _i < 2; ++_i) { \
        if constexpr (GATHER) PG8_GLDS(_sb, GO[h][_i], (unsigned)(ldsbase + (bufoff) + ldsw + _i * 8192)); \
        else PG8_GLDS(_sb + (size_t)_i * 64 * lda, voffA[0], (unsigned)(ldsbase + (bufoff) + ldsw + _i * 8192)); } } while (0)
#define PG8_GLOAD(dst, pm_) do { const int _t = wid * 64 + fresh_lane(); int rowA_[2]; unsigned colA_[2]; _Pragma("unroll") for (int _i = 0; _i < 2; ++_i) { int _R, _C; stage_rc(_t * 16 + _i * 8192, _R, _C); rowA_[_i] = _R; colA_[_i] = (unsigned)_C * 2u; }   \
        _Pragma("unroll") for (int _h = 0; _h < 2; ++_h) _Pragma("unroll") for (int _i = 0; _i < 2; ++_i) \
        dst[_h][_i] = (unsigned)g.ltab[(pm_) * BM + _h * HALF + rowA_[_i]] * (unsigned)lda + colA_[_i]; } while (0)
#define PG8_GSWITCH do { if constexpr (GATHER) { if (last && has_next) { PG8_GLOAD(cg, ui + 1); } } } while (0)
#define PG8_LDA(dst, b, h) do { _Pragma("unroll") for (int m = 0; m < 4; ++m) { if constexpr (FP8) { typedef int i32x4_ __attribute__((ext_vector_type(4))); \
        dst##8[m] = __builtin_shufflevector(*(const PG8_LAS i32x4_*)(ldsA + PG8_SA(b, h) + m * 2048), *(const PG8_LAS i32x4_*)(ldsA + PG8_SA(b, h) + m * 2048 + 1024), 0, 1, 2, 3, 4, 5, 6, 7); } \
        else { _Pragma("unroll") for (int k = 0; k < 2; ++k) dst[m][k] = *(const PG8_LAS bf16x8*)(ldsA + PG8_SA(b, h) + m * 2048 + k * 1024); } } } while (0)
#define PG8_LDB(dst, b, h) do { _Pragma("unroll") for (int n = 0; n < 2; ++n) { if constexpr (FP8) { typedef int i32x4_ __attribute__((ext_vector_type(4))); \
        dst##8[n] = __builtin_shufflevector(*(const PG8_LAS i32x4_*)(ldsB + PG8_SA(b, h) + n * 2048), *(const PG8_LAS i32x4_*)(ldsB + PG8_SA(b, h) + n * 2048 + 1024), 0, 1, 2, 3, 4, 5, 6, 7); } \
        else { _Pragma("unroll") for (int k = 0; k < 2; ++k) dst[n][k] = *(const PG8_LAS bf16x8*)(ldsB + PG8_SA(b, h) + n * 2048 + k * 1024); } } } while (0)
#define PG8_MMA(ai, bj, At, Bt) do { __builtin_amdgcn_s_setprio(1); _Pragma("unroll") for (int m = 0; m < 4; ++m) _Pragma("unroll") for (int n = 0; n < 2; ++n) { \
        if constexpr (FP8) acc[ai][bj][m][n] = __builtin_amdgcn_mfma_scale_f32_16x16x128_f8f6f4(Bt##8[n], At##8[m], acc[ai][bj][m][n], 0, 0, 0, 0x7f7f7f7f, 0, 0x7f7f7f7f); \
        else { _Pragma("unroll") for (int k = 0; k < 2; ++k) acc[ai][bj][m][n] = __builtin_amdgcn_mfma_f32_16x16x32_bf16(Bt[n][k], At[m][k], acc[ai][bj][m][n], 0, 0, 0); } } \
        __builtin_amdgcn_s_setprio(0); } while (0)
#define PG8_WAIT_V(n) asm volatile("s_waitcnt vmcnt(" #n ")" ::: "memory")
#define PG8_WAIT_L(n) asm volatile("s_waitcnt lgkmcnt(" #n ")" ::: "memory")
#define PG8_BAR __builtin_amdgcn_s_barrier()
#define PG8_SCHED __builtin_amdgcn_sched_barrier(0)
    Unit cur, nxt; int ui = 0;
    if (!S.next(0, cur)) return;
    f32x4 acc[2][2][4][2];
#pragma unroll
    for (int a = 0; a < 2; ++a)
#pragma unroll
        for (int b = 0; b < 2; ++b)
#pragma unroll
            for (int m = 0; m < 4; ++m)
#pragma unroll
                for (int n = 0; n < 2; ++n) acc[a][b][m][n] = (f32x4){0.f, 0.f, 0.f, 0.f};
    bf16x8 At[4][2], B0[2][2], B1[2][2]; i32x8 At8[4], B08[2], B18[2];
    const char* cA = GATHER ? (const char*)g.A : (const char*)g.A + (size_t)cur.ao * ELT; const char* cB = (const char*)g.Bt + (size_t)cur.bo * ELT;
    if constexpr (GATHER) {
        for (int i = 0; i < 8; ++i) { Unit u_; if (!S.next(i, u_)) break; if (tid < BM) g.ltab[i * BM + tid] = g.arow[u_.pm * BM + tid]; }
        asm volatile("s_waitcnt vmcnt(0) lgkmcnt(0)" ::: "memory"); PG8_BAR; asm volatile("" ::: "memory");
        PG8_GLOAD(cg, 0); }
    if constexpr (SP2) {
        PG8_STAGE(PG8_SB(0, 0), cB, voffB); PG8_STAGE(PG8_SB(0, 1), cB + hstepB, voffB); PG8_STAGE_A(PG8_SA(0, 0), cA, 0, cg); PG8_STAGE_A(PG8_SA(0, 1), cA, 1, cg);
        if (wr == 1) PG8_BAR;
        PG8_WAIT_V(2); PG8_BAR;
        PG8_STAGE(PG8_SB(1, 0), cB + kstep, voffB); PG8_STAGE_A(PG8_SA(1, 0), cA + kstep, 0, cg); PG8_STAGE(PG8_SB(1, 1), cB + hstepB + kstep, voffB);
        PG8_WAIT_V(6); PG8_BAR;
    } else {
        PG8_STAGE(PG8_SB(0, 0), cB, voffB); PG8_STAGE_A(PG8_SA(0, 0), cA, 0, cg); PG8_STAGE(PG8_SB(0, 1), cB + hstepB, voffB); PG8_STAGE_A(PG8_SA(0, 1), cA, 1, cg);
        if (wr == 1) PG8_BAR;
        PG8_WAIT_V(4); PG8_BAR;
        PG8_STAGE(PG8_SB(1, 0), cB + kstep, voffB); PG8_STAGE_A(PG8_SA(1, 0), cA + kstep, 0, cg); PG8_STAGE(PG8_SB(1, 1), cB + hstepB + kstep, voffB);
        PG8_WAIT_V(6); PG8_BAR;
    }
    for (;;) {
        const bool has_next = S.next(ui + 1, nxt);
        const char* nA = GATHER ? (const char*)g.A : (has_next ? (const char*)g.A + (size_t)nxt.ao * ELT : cA);
        const char* nB = has_next ? (const char*)g.Bt + (size_t)nxt.bo * ELT : cB;
#pragma unroll 1
        for (int t = 0; t < nt; t += 2) {
            const bool last = (t == nt - 2);
            const char* a1 = cA + (size_t)(t + 1) * kstep;
            const char* a2 = last ? nA : cA + (size_t)(t + 2) * kstep; const char* b2 = last ? nB : cB + (size_t)(t + 2) * kstep;
            const char* a3 = a2 + kstep; const char* b3 = b2 + kstep;
            if constexpr (SP2) {
            PG8_LDB(B0, 0, 0); PG8_LDB(B1, 0, 1); PG8_SCHED; PG8_LDA(At, 0, 0); PG8_STAGE_A(PG8_SA(1, 1), a1, 1, cg); PG8_GSWITCH;
            PG8_WAIT_V(8); PG8_WAIT_L(0); PG8_BAR; PG8_MMA(0, 0, At, B0); PG8_MMA(0, 1, At, B1); PG8_BAR; PG8_SCHED;
            PG8_LDA(At, 0, 1); PG8_STAGE(PG8_SB(0, 0), b2, voffB); PG8_STAGE(PG8_SB(0, 1), b2 + hstepB, voffB); PG8_STAGE_A(PG8_SA(0, 0), a2, 0, cg);
            PG8_WAIT_V(8); PG8_WAIT_L(0); PG8_BAR; PG8_MMA(1, 0, At, B0); PG8_MMA(1, 1, At, B1); PG8_BAR; PG8_SCHED;
            PG8_LDB(B0, 1, 0); PG8_LDB(B1, 1, 1); PG8_SCHED; PG8_LDA(At, 1, 0); PG8_STAGE_A(PG8_SA(0, 1), a2, 1, cg);
            PG8_WAIT_V(8); PG8_WAIT_L(0); PG8_BAR; PG8_MMA(0, 0, At, B0); PG8_MMA(0, 1, At, B1); PG8_BAR; PG8_SCHED;
            PG8_LDA(At, 1, 1); PG8_STAGE(PG8_SB(1, 0), b3, voffB); PG8_STAGE(PG8_SB(1, 1), b3 + hstepB, voffB); PG8_STAGE_A(PG8_SA(1, 0), a3, 0, cg);
            PG8_WAIT_V(8); PG8_WAIT_L(0); PG8_BAR; PG8_MMA(1, 0, At, B0); PG8_MMA(1, 1, At, B1); PG8_BAR; PG8_SCHED;
            } else {
            PG8_LDB(B0, 0, 0); PG8_SCHED; PG8_LDA(At, 0, 0); PG8_STAGE_A(PG8_SA(1, 1), a1, 1, cg); PG8_GSWITCH;
            PG8_WAIT_L(8); PG8_BAR; PG8_WAIT_L(0); PG8_MMA(0, 0, At, B0); PG8_BAR; PG8_SCHED;
            PG8_LDB(B1, 0, 1); PG8_STAGE(PG8_SB(0, 0), b2, voffB);
            PG8_BAR; PG8_WAIT_L(0); PG8_MMA(0, 1, At, B1); PG8_BAR;
            PG8_LDA(At, 0, 1); PG8_STAGE_A(PG8_SA(0, 0), a2, 0, cg);
            PG8_BAR; PG8_WAIT_L(0); PG8_MMA(1, 0, At, B0); PG8_BAR; PG8_SCHED;
            PG8_STAGE(PG8_SB(0, 1), b2 + hstepB, voffB);
            PG8_WAIT_V(6); PG8_BAR; PG8_MMA(1, 1, At, B1); PG8_BAR;
            PG8_LDB(B0, 1, 0); PG8_SCHED; PG8_LDA(At, 1, 0); PG8_STAGE_A(PG8_SA(0, 1), a2, 1, cg);
            PG8_WAIT_L(8); PG8_BAR; PG8_WAIT_L(0); PG8_MMA(0, 0, At, B0); PG8_BAR; PG8_SCHED;
            PG8_LDB(B1, 1, 1); PG8_STAGE(PG8_SB(1, 0), b3, voffB);
            PG8_BAR; PG8_WAIT_L(0); PG8_MMA(0, 1, At, B1); PG8_BAR;
            PG8_LDA(At, 1, 1); PG8_STAGE_A(PG8_SA(1, 0), a3, 0, cg);
            PG8_BAR; PG8_WAIT_L(0); PG8_MMA(1, 0, At, B0); PG8_BAR; PG8_SCHED;
            PG8_STAGE(PG8_SB(1, 1), b3 + hstepB, voffB);
            PG8_WAIT_V(6); PG8_BAR; PG8_MMA(1, 1, At, B1); PG8_BAR;
            }
        }
        if constexpr (ALIGN_EPI) { if (wr == 0) PG8_BAR; }
        { const int _l = fresh_lane(); E(acc, cur, wr, wc, _l & 15, _l >> 4); }
        if (!has_next) break;
#pragma unroll
        for (int a = 0; a < 2; ++a)
#pragma unroll
            for (int b = 0; b < 2; ++b)
#pragma unroll
                for (int m = 0; m < 4; ++m)
#pragma unroll
                    for (int n = 0; n < 2; ++n) acc[a][b][m][n] = (f32x4){0.f, 0.f, 0.f, 0.f};
        cur = nxt; cA = nA; cB = nB; ++ui;
        if constexpr (ALIGN_EPI) { if (wr == 1) PG8_BAR; }
    }
    PG8_WAIT_V(0);
    if constexpr (!ALIGN_EPI) { if (wr == 0) PG8_BAR; }
    PG8_BAR;
#undef PG8_SA
#undef PG8_SB
#undef PG8_STAGE
#undef PG8_GLDS
#undef PG8_STAGE_A
#undef PG8_GLOAD
#undef PG8_GSWITCH
#undef PG8_LDA
#undef PG8_LDB
#undef PG8_MMA
#undef PG8_WAIT_V
#undef PG8_WAIT_L
#undef PG8_BAR
#undef PG8_SCHED
}
}
namespace pg8 {

__device__ __forceinline__ float fast_sigmoid_mul(float x, float z) { return x * __builtin_amdgcn_rcpf(1.f + __builtin_amdgcn_exp2f(-1.4426950408889634f * z)); }
__device__ __forceinline__ float gelu_t(float x) { const float u = 0.7978845608028654f * (x + 0.044715f * x * x * x); return fast_sigmoid_mul(x, 2.f * u); }
__device__ __forceinline__ float silu_f(float x) { return fast_sigmoid_mul(x, x); }
__device__ __forceinline__ u32x4 pack8(const f32x4 v0, const f32x4 v1) { u32x4 w; w.x = cvt_pk_bf16(v0[0], v0[1]); w.y = cvt_pk_bf16(v0[2], v0[3]); w.z = cvt_pk_bf16(v1[0], v1[1]); w.w = cvt_pk_bf16(v1[2], v1[3]); return w; }

struct EpiBf16 {
    static constexpr bool PERM = true;
    bf16_t* O; int ldo; float scale;
    __device__ __forceinline__ void operator()(f32x4 (&acc)[2][2][4][2], const Unit& u, int wr, int wc, int fr, int fq) const {
        const int row0 = u.pm * BM + wr * 64 + fr, col0 = u.pn * BM + wc * 32 + 8 * fq;
#pragma unroll
        for (int ai = 0; ai < 2; ++ai)
#pragma unroll
            for (int m = 0; m < 4; ++m) { bf16_t* rowp = O + (size_t)(row0 + ai * HALF + m * 16) * ldo + col0;
#pragma unroll
                for (int bj = 0; bj < 2; ++bj) *(u32x4*)(rowp + bj * HALF) = pack8(acc[ai][bj][m][0] * scale, acc[ai][bj][m][1] * scale); }
    }
};
__device__ __forceinline__ unsigned pk4_fp8(float a, float b, float c, float d) {
    a = __builtin_amdgcn_fmed3f(a, -448.f, 448.f); b = __builtin_amdgcn_fmed3f(b, -448.f, 448.f); c = __builtin_amdgcn_fmed3f(c, -448.f, 448.f); d = __builtin_amdgcn_fmed3f(d, -448.f, 448.f);
    unsigned p = 0u; p = (unsigned)__builtin_amdgcn_cvt_pk_fp8_f32(a, b, (int)p, false); p = (unsigned)__builtin_amdgcn_cvt_pk_fp8_f32(c, d, (int)p, true); return p;
}
constexpr float F8_XS = 16.f, F8_WS = 64.f, F8_HS = 8.f;
struct EpiResBf16 {
    static constexpr bool PERM = true;
    bf16_t* O; float scale; const bf16_t* R;
    __device__ __forceinline__ void operator()(f32x4 (&acc)[2][2][4][2], const Unit& u, int wr, int wc, int fr, int fq) const {
        const int row0 = u.pm * BM + wr * 64 + fr, col0 = u.pn * BM + wc * 32 + 8 * fq;
#pragma unroll
        for (int ai = 0; ai < 2; ++ai)
#pragma unroll
            for (int m = 0; m < 4; ++m) { const size_t off = (size_t)(row0 + ai * HALF + m * 16) * nv::D + col0;
#pragma unroll
                for (int bj = 0; bj < 2; ++bj) { const u32x4 rr = *(const u32x4*)(R + off + bj * HALF);
                    f32x4 r0, r1; r0[0] = __uint_as_float(rr.x << 16); r0[1] = __uint_as_float(rr.x & 0xffff0000u); r0[2] = __uint_as_float(rr.y << 16); r0[3] = __uint_as_float(rr.y & 0xffff0000u);
                    r1[0] = __uint_as_float(rr.z << 16); r1[1] = __uint_as_float(rr.z & 0xffff0000u); r1[2] = __uint_as_float(rr.w << 16); r1[3] = __uint_as_float(rr.w & 0xffff0000u);
                    *(u32x4*)(O + off + bj * HALF) = pack8(r0 * nv::ALPHA + acc[ai][bj][m][0] * scale, r1 * nv::ALPHA + acc[ai][bj][m][1] * scale); }
                asm volatile("" ::: "memory"); }
    }
};
struct EpiF8 {
    static constexpr bool PERM = true;
    unsigned char* O; int ldo; float scale;
    __device__ __forceinline__ void operator()(f32x4 (&acc)[2][2][4][2], const Unit& u, int wr, int wc, int fr, int fq) const {
        const int row0 = u.pm * BM + wr * 64 + fr, col0 = u.pn * BM + wc * 32 + 8 * fq;
#pragma unroll
        for (int ai = 0; ai < 2; ++ai)
#pragma unroll
            for (int m = 0; m < 4; ++m) { unsigned char* rowp = O + (size_t)(row0 + ai * HALF + m * 16) * ldo + col0;
#pragma unroll
                for (int bj = 0; bj < 2; ++bj) { const f32x4 v0 = acc[ai][bj][m][0] * scale, v1 = acc[ai][bj][m][1] * scale;
                    u32x2 w; w.x = pk4_fp8(v0[0], v0[1], v0[2], v0[3]); w.y = pk4_fp8(v1[0], v1[1], v1[2], v1[3]); *(u32x2*)(rowp + bj * HALF) = w; } }
    }
};
constexpr float F8_MS = 64.f, F8_PS = 256.f, F8_NS = 16.f;
struct EpiGU8 {
    static constexpr bool PERM = true;
    unsigned char* HS8;
    __device__ __forceinline__ void operator()(f32x4 (&acc)[2][2][4][2], const Unit& u, int wr, int wc, int fr, int fq) const {
        const int row0 = u.pm * BM + wr * 64 + fr, col0 = u.pn * HALF + wc * 32 + 8 * fq;
        constexpr float s = 1.f / (F8_XS * F8_WS);
#pragma unroll
        for (int ai = 0; ai < 2; ++ai)
#pragma unroll
            for (int m = 0; m < 4; ++m) { unsigned char* rowp = HS8 + (size_t)(row0 + ai * HALF + m * 16) * nv::DE + col0;
                f32x4 h0, h1;
#pragma unroll
                for (int j = 0; j < 4; ++j) { h0[j] = silu_f(acc[ai][0][m][0][j] * s) * (acc[ai][1][m][0][j] * (s * F8_HS)); h1[j] = silu_f(acc[ai][0][m][1][j] * s) * (acc[ai][1][m][1][j] * (s * F8_HS)); }
                u32x2 w; w.x = pk4_fp8(h0[0], h0[1], h0[2], h0[3]); w.y = pk4_fp8(h1[0], h1[1], h1[2], h1[3]); *(u32x2*)rowp = w; }
    }
};
struct EpiGU {
    static constexpr bool PERM = true;
    bf16_t* HS;
    __device__ __forceinline__ void operator()(f32x4 (&acc)[2][2][4][2], const Unit& u, int wr, int wc, int fr, int fq) const {
        const int row0 = u.pm * BM + wr * 64 + fr, col0 = u.pn * HALF + wc * 32 + 8 * fq;
#pragma unroll
        for (int ai = 0; ai < 2; ++ai)
#pragma unroll
            for (int m = 0; m < 4; ++m) { bf16_t* rowp = HS + (size_t)(row0 + ai * HALF + m * 16) * nv::DE + col0;
                f32x4 h0, h1;
#pragma unroll
                for (int j = 0; j < 4; ++j) { h0[j] = silu_f(acc[ai][0][m][0][j]) * acc[ai][1][m][0][j]; h1[j] = silu_f(acc[ai][0][m][1][j]) * acc[ai][1][m][1][j]; }
                *(u32x4*)rowp = pack8(h0, h1); }
    }
};
template <bool OUT8>
struct EpiSoftmaxT {
    static constexpr bool PERM = true;
    void* O; PG8_LAS float* tbl; float in_scale;
    __device__ __forceinline__ void operator()(f32x4 (&acc)[2][2][4][2], const Unit& u, int wr, int wc, int fr, int fq) const {
        const int row0 = u.pm * BM + wr * 64 + fr, col0 = u.pn * BM + wc * 32 + 8 * fq;
#pragma unroll
        for (int ai = 0; ai < 2; ++ai)
#pragma unroll
            for (int m = 0; m < 4; ++m) { float mx = -INFINITY;
#pragma unroll
                for (int bj = 0; bj < 2; ++bj)
#pragma unroll
                    for (int n = 0; n < 2; ++n)
#pragma unroll
                        for (int j = 0; j < 4; ++j) { acc[ai][bj][m][n][j] *= in_scale; mx = fmaxf(mx, acc[ai][bj][m][n][j]); }
                mx = fmaxf(mx, nv::swz_xor<16>(mx));
                { const auto r = __builtin_amdgcn_permlane32_swap(__float_as_uint(mx), __float_as_uint(mx), false, false); mx = fmaxf(__uint_as_float(r[0]), __uint_as_float(r[1])); }
                if (fq == 0) tbl[(ai * HALF + wr * 64 + m * 16 + fr) * 4 + wc] = mx; }
        asm volatile("s_waitcnt lgkmcnt(0)" ::: "memory"); __builtin_amdgcn_s_barrier(); asm volatile("" ::: "memory");
#pragma unroll
        for (int ai = 0; ai < 2; ++ai)
#pragma unroll
            for (int m = 0; m < 4; ++m) { const f32x4 t4 = *(const PG8_LAS f32x4*)(tbl + (ai * HALF + wr * 64 + m * 16 + fr) * 4);
                const float M = fmaxf(fmaxf(t4[0], t4[1]), fmaxf(t4[2], t4[3])); float s = 0.f;
#pragma unroll
                for (int bj = 0; bj < 2; ++bj)
#pragma unroll
                    for (int n = 0; n < 2; ++n)
#pragma unroll
                        for (int j = 0; j < 4; ++j) { const float p = __builtin_amdgcn_exp2f(acc[ai][bj][m][n][j] - M); acc[ai][bj][m][n][j] = p; s += p; }
                s += nv::swz_xor<16>(s);
                { const auto r = __builtin_amdgcn_permlane32_swap(__float_as_uint(s), __float_as_uint(s), false, false); s = __uint_as_float(r[0]) + __uint_as_float(r[1]); }
                if (fq == 0) tbl[1024 + (ai * HALF + wr * 64 + m * 16 + fr) * 4 + wc] = s; }
        asm volatile("s_waitcnt lgkmcnt(0)" ::: "memory"); __builtin_amdgcn_s_barrier(); asm volatile("" ::: "memory");
#pragma unroll
        for (int ai = 0; ai < 2; ++ai)
#pragma unroll
            for (int m = 0; m < 4; ++m) { const f32x4 t4 = *(const PG8_LAS f32x4*)(tbl + 1024 + (ai * HALF + wr * 64 + m * 16 + fr) * 4);
                const float inv = 1.f / ((t4[0] + t4[1]) + (t4[2] + t4[3]));
                if constexpr (OUT8) { unsigned char* rowp = (unsigned char*)O + (size_t)(row0 + ai * HALF + m * 16) * nv::D + col0; const float s8 = inv * F8_PS;
#pragma unroll
                    for (int bj = 0; bj < 2; ++bj) { const f32x4 v0 = acc[ai][bj][m][0] * s8, v1 = acc[ai][bj][m][1] * s8;
                        u32x2 w; w.x = pk4_fp8(v0[0], v0[1], v0[2], v0[3]); w.y = pk4_fp8(v1[0], v1[1], v1[2], v1[3]); *(u32x2*)(rowp + bj * HALF) = w; } }
                else { bf16_t* rowp = (bf16_t*)O + (size_t)(row0 + ai * HALF + m * 16) * nv::D + col0;
#pragma unroll
                    for (int bj = 0; bj < 2; ++bj) *(u32x4*)(rowp + bj * HALF) = pack8(acc[ai][bj][m][0] * inv, acc[ai][bj][m][1] * inv); } }
    }
};
struct EpiInproj0 {
    static constexpr bool PERM = true;
    bf16_t* O; const float* rope; float in_scale;
    __device__ __forceinline__ void operator()(f32x4 (&acc)[2][2][4][2], const Unit& u, int wr, int wc, int fr, int fq) const {
        const int row0 = u.pm * BM + wr * 64 + fr, col0 = u.pn * BM + wc * 32 + 8 * fq;
#pragma unroll
        for (int ai = 0; ai < 2; ++ai)
#pragma unroll
            for (int bj = 0; bj < 2; ++bj)
#pragma unroll
                for (int m = 0; m < 4; ++m) { acc[ai][bj][m][0] *= in_scale; acc[ai][bj][m][1] *= in_scale; }
        if (u.pn >= 3) {
#pragma unroll
            for (int ai = 0; ai < 2; ++ai)
#pragma unroll
                for (int m = 0; m < 4; ++m) { bf16_t* rowp = O + (size_t)(row0 + ai * HALF + m * 16) * nv::NIN0 + col0;
#pragma unroll
                    for (int bj = 0; bj < 2; ++bj) { f32x4 v0 = acc[ai][bj][m][0], v1 = acc[ai][bj][m][1];
#pragma unroll
                        for (int j = 0; j < 4; ++j) { v0[j] = gelu_t(v0[j]); v1[j] = gelu_t(v1[j]); }
                        *(u32x4*)(rowp + bj * HALF) = pack8(v0, v1); } }
        } else {
            const bool wave_rope = (wc & 1) == 0;
            const float sgn = fq == 0 ? -1.f : 1.f;
#pragma unroll
            for (int ai = 0; ai < 2; ++ai)
#pragma unroll
                for (int m = 0; m < 4; ++m) { const int row = row0 + ai * HALF + m * 16; bf16_t* rowp = O + (size_t)row * nv::NIN0 + col0;
                    f32x4 c0, c1, s0, s1;
                    if (wave_rope) { const float* rp = rope + (size_t)row * 16; c0 = *(const f32x4*)rp; c1 = *(const f32x4*)(rp + 4); s0 = *(const f32x4*)(rp + 8); s1 = *(const f32x4*)(rp + 12); }
#pragma unroll
                    for (int bj = 0; bj < 2; ++bj) { f32x4 v0 = acc[ai][bj][m][0], v1 = acc[ai][bj][m][1];
                        if (wave_rope && (u.pn < 2 || bj == 0)) {
                            f32x4 p0, p1;
#pragma unroll
                            for (int j = 0; j < 4; ++j) { p0[j] = nv::swz_xor<16>(v0[j]); p1[j] = nv::swz_xor<16>(v1[j]); }
                            if (fq < 2) {
#pragma unroll
                                for (int j = 0; j < 4; ++j) { v0[j] = v0[j] * c0[j] + sgn * p0[j] * s0[j]; v1[j] = v1[j] * c1[j] + sgn * p1[j] * s1[j]; } }
                        }
                        *(u32x4*)(rowp + bj * HALF) = pack8(v0, v1); } }
        }
    }
};
}

#define LAS __attribute__((address_space(3)))
#define GAS __attribute__((address_space(1)))
typedef GAS unsigned gu32;
#define RLX_AGENT __ATOMIC_RELAXED, __HIP_MEMORY_SCOPE_AGENT
#define LDS_WAIT() asm volatile("s_waitcnt lgkmcnt(0)" ::: "memory")
#define VM_WAIT() asm volatile("s_waitcnt vmcnt(0)" ::: "memory")

#define XB_TMO      128
#define XB_XCNT(j)  (256  + 64 * (j))
#define XB_XSUB(j)  (1280 + 64 * (j))
#define XB_XGEN(j)  (2304 + 64 * (j))
#define XB_TOP      3328
#define XB_TOPGEN   3392
#define XCD_BAR_WORDS 3456
#define XB_SPIN_CAP (1u << 18)
__device__ __forceinline__ unsigned xb_ld(unsigned* p)              { return __hip_atomic_load(p, __ATOMIC_RELAXED, __HIP_MEMORY_SCOPE_AGENT); }
__device__ __forceinline__ unsigned xb_add(unsigned* p, unsigned v) { return __hip_atomic_fetch_add(p, v, __ATOMIC_RELAXED, __HIP_MEMORY_SCOPE_AGENT); }
__device__ __forceinline__ unsigned xb_xcc_id() { return (unsigned)__builtin_amdgcn_s_getreg((3 << 11) | 20) & 0xFu; }
#define XB_SPIN(cond, bar) do { unsigned _sp = 0; while (cond) { __builtin_amdgcn_s_sleep(1); \
    if ((++_sp & 255u) == 0u) { if (xb_ld(&(bar)[XB_TMO])) break; if (_sp > XB_SPIN_CAP) { atomicAdd(&(bar)[XB_TMO], 1u); break; } } } } while (0)
struct XcdBarrier { unsigned* bar; unsigned x; volatile LAS unsigned* st; int wave; };
__device__ __forceinline__ unsigned lane_id_fresh() { unsigned m = ~0u; asm volatile("" : "+s"(m)); return __builtin_amdgcn_mbcnt_hi(m, __builtin_amdgcn_mbcnt_lo(m, 0u)); }
__device__ __forceinline__ bool xb_thread0(int wave) { return wave == 0 && lane_id_fresh() == 0u; }
__device__ __forceinline__ XcdBarrier xcd_barrier_post(unsigned* bar, volatile LAS unsigned* st, int wave) {
    XcdBarrier b; b.bar = bar; b.x = xb_xcc_id(); b.st = st; b.wave = wave;
    if (xb_thread0(wave)) (void)xb_add(&bar[XB_XCNT(b.x)], 1u);
    return b;
}
__device__ __forceinline__ void xcd_barrier_complete(unsigned* bar, unsigned x, unsigned& nloc, unsigned& nx) {
    const unsigned G = gridDim.x * gridDim.y * gridDim.z;
    unsigned sum, cnt, mine, sp = 0u;
    for (;;) {
        sum = 0u; cnt = 0u; mine = 0u;
#pragma unroll
        for (unsigned j = 0; j < 16; ++j) { const unsigned c = xb_ld(&bar[XB_XCNT(j)]); sum += c; cnt += (c > 0u) ? 1u : 0u; mine = (j == x) ? c : mine; }
        if (sum == G) break;
        __builtin_amdgcn_s_sleep(1);
        if ((++sp & 255u) == 0u) { if (xb_ld(&bar[XB_TMO])) break; if (sp > XB_SPIN_CAP) { atomicAdd(&bar[XB_TMO], 1u); break; } }
    }
    nloc = mine > 0u ? mine : 1u; nx = cnt > 0u ? cnt : 1u;
}
__device__ __forceinline__ void xcd_barrier(const XcdBarrier& b) {
    asm volatile("s_waitcnt vmcnt(0)" ::: "memory");
    __syncthreads();
    if (xb_thread0(b.wave)) {
        unsigned* bar = b.bar;
        __builtin_amdgcn_s_waitcnt(0);
        unsigned nloc = b.st[0], nx = b.st[1];
        if (nloc == 0u) { xcd_barrier_complete(bar, b.x, nloc, nx); b.st[0] = nloc; b.st[1] = nx; }
        const unsigned old = xb_add(&bar[XB_XSUB(b.x)], 1u);
        const unsigned gen = old / nloc;
        if (old + 1u == (gen + 1u) * nloc) {
            __builtin_amdgcn_fence(__ATOMIC_RELEASE, "agent");
            asm volatile("s_waitcnt vmcnt(0)" ::: "memory");
            const unsigned og = xb_add(&bar[XB_TOP], 1u);
            const unsigned tg = og / nx;
            if (og + 1u == (tg + 1u) * nx) xb_add(&bar[XB_TOPGEN], 1u);
            else XB_SPIN(xb_ld(&bar[XB_TOPGEN]) == tg, bar);
            __builtin_amdgcn_fence(__ATOMIC_ACQUIRE, "agent");
            xb_add(&bar[XB_XGEN(b.x)], 1u);
            asm volatile("s_waitcnt vmcnt(0)" ::: "memory");
        } else {
            XB_SPIN(xb_ld(&bar[XB_XGEN(b.x)]) == gen, bar);
            __builtin_amdgcn_fence(__ATOMIC_ACQUIRE, "agent");
            asm volatile("s_waitcnt vmcnt(0)" ::: "memory");
        }
    }
    __syncthreads();
}

namespace mk {
using namespace nv;
typedef unsigned v4u __attribute__((ext_vector_type(4)));
typedef unsigned v2u __attribute__((ext_vector_type(2)));
typedef float f32x4 __attribute__((ext_vector_type(4)));
constexpr int NWAVES = 8, NTHREADS = 512;
constexpr int LDS_BYTES = 160 * 1024;
constexpr int MISC_OFF = LDS_BYTES - 256;
constexpr int CW_BAR = 4096;
constexpr size_t CTL_ZERO_BYTES = 64 * 1024;

__device__ __forceinline__ unsigned pk2(float lo, float hi) { return (unsigned)f2bf(lo) | ((unsigned)f2bf(hi) << 16); }

struct Frame {
    LAS unsigned char* lds; int tid, lane, wave, vcu, G, bx;
};

struct TItem { const float* src; unsigned char* dst; int ldw, ldt, k0, n0, dr, f8; };
template <int MAP, bool F8>
__device__ __forceinline__ void titem_fill(TItem& t, const void* srcp, int K, int N, void* dstp, size_t dstb, int r) {
    const int nblk = N / 32, per = (K / 64) * nblk, bi = r / per, it = r % per, kb = it / nblk, nb = it % nblk, n0 = 32 * nb;
    int dr = n0; if (MAP == 1) dr = (n0 >> 7) * 256 + (n0 & 127); if (MAP == 2) dr = (n0 >> 7) * 256 + 128 + (n0 & 127);
    t.src = (const float*)srcp + (size_t)bi * K * N; t.dst = (unsigned char*)dstp + (size_t)bi * dstb * (F8 ? 1 : 2); t.ldw = N; t.ldt = K; t.k0 = 64 * kb; t.n0 = n0; t.dr = dr; t.f8 = F8 ? 1 : 0;
}
struct TRegs { f32x4 v[8]; };
__device__ __forceinline__ void titem_load(const TItem& t, int lane, TRegs& R) {
    const float* p = t.src + (size_t)(t.k0 + (lane >> 3)) * t.ldw + t.n0 + (lane & 7) * 4;
#pragma unroll
    for (int i = 0; i < 8; ++i) R.v[i] = __builtin_nontemporal_load((const f32x4*)(p + (size_t)(8 * i) * t.ldw));
}
__device__ __forceinline__ void titem_finish(const TItem& t, int lane, const TRegs& R, LAS float* scr) {
    const float sc = t.f8 ? pg8::F8_WS : 1.f;
    { LAS float* d = scr + (lane >> 3) * 33 + (lane & 7) * 4;
#pragma unroll
      for (int i = 0; i < 8; ++i) { d[(8 * i) * 33 + 0] = R.v[i][0] * sc; d[(8 * i) * 33 + 1] = R.v[i][1] * sc; d[(8 * i) * 33 + 2] = R.v[i][2] * sc; d[(8 * i) * 33 + 3] = R.v[i][3] * sc; } }
    LDS_WAIT(); asm volatile("" ::: "memory");
    const int c = lane & 7;
#pragma unroll
    for (int j = 0; j < 4; ++j) { const int n = (lane >> 3) + 8 * j; const LAS float* s = scr + (8 * c) * 33 + n;
        if (t.f8) { v2u o; o.x = pg8::pk4_fp8(s[0 * 33], s[1 * 33], s[2 * 33], s[3 * 33]); o.y = pg8::pk4_fp8(s[4 * 33], s[5 * 33], s[6 * 33], s[7 * 33]);
            __builtin_nontemporal_store(o, (v2u*)(t.dst + (size_t)(t.dr + n) * t.ldt + t.k0 + 8 * c)); }
        else { v4u o; o.x = pk2(s[0 * 33], s[1 * 33]); o.y = pk2(s[2 * 33], s[3 * 33]); o.z = pk2(s[4 * 33], s[5 * 33]); o.w = pk2(s[6 * 33], s[7 * 33]);
            __builtin_nontemporal_store(o, (v4u*)((bf16_t*)t.dst + (size_t)(t.dr + n) * t.ldt + t.k0 + 8 * c)); } }
    LDS_WAIT(); asm volatile("" ::: "memory");
}

struct InvFreq { float f[8]; };
struct Args {
    const void* in[40]; float* out; unsigned char* ws; InvFreq inv; int ph_lo, ph_hi;
};

struct RowV { float v[16]; };
__device__ __forceinline__ void unpk8(const v4u u, float* x) {
    x[0] = __uint_as_float(u.x << 16); x[1] = __uint_as_float(u.x & 0xffff0000u); x[2] = __uint_as_float(u.y << 16); x[3] = __uint_as_float(u.y & 0xffff0000u);
    x[4] = __uint_as_float(u.z << 16); x[5] = __uint_as_float(u.z & 0xffff0000u); x[6] = __uint_as_float(u.w << 16); x[7] = __uint_as_float(u.w & 0xffff0000u);
}
struct RowRaw { v4u a, b; };
__device__ __forceinline__ RowRaw load_raw(const bf16_t* p, int lane) { RowRaw r; r.a = *(const v4u*)(p + 8 * lane); r.b = *(const v4u*)(p + 512 + 8 * lane); return r; }
__device__ __forceinline__ void unpack_row(const RowRaw& r, RowV& x) { unpk8(r.a, x.v); unpk8(r.b, x.v + 8); }
struct GB { float g[16], b[16]; };
__device__ __forceinline__ void load_gb(const float* g, const float* b, int lane, GB& o) {
#pragma unroll
    for (int hh = 0; hh < 2; ++hh)
#pragma unroll
        for (int q = 0; q < 2; ++q) { const float4 gg = *(const float4*)(g + 512 * hh + 8 * lane + 4 * q), bb = *(const float4*)(b + 512 * hh + 8 * lane + 4 * q);
            o.g[8 * hh + 4 * q + 0] = gg.x; o.g[8 * hh + 4 * q + 1] = gg.y; o.g[8 * hh + 4 * q + 2] = gg.z; o.g[8 * hh + 4 * q + 3] = gg.w;
            o.b[8 * hh + 4 * q + 0] = bb.x; o.b[8 * hh + 4 * q + 1] = bb.y; o.b[8 * hh + 4 * q + 2] = bb.z; o.b[8 * hh + 4 * q + 3] = bb.w; }
}
__device__ __forceinline__ void ln_rowv(RowV& z, const GB& gb) {
    float s = 0.f;
#pragma unroll
    for (int i = 0; i < 16; ++i) s += z.v[i];
    const float mu = wave_sum(s) * (1.f / D);
    float q = 0.f;
#pragma unroll
    for (int i = 0; i < 16; ++i) { z.v[i] -= mu; q += z.v[i] * z.v[i]; }
    const float rstd = 1.f / sqrtf(wave_sum(q) * (1.f / D) + LN_EPS);
#pragma unroll
    for (int i = 0; i < 16; ++i) z.v[i] = z.v[i] * rstd * gb.g[i] + gb.b[i];
}
__device__ __forceinline__ void store_rowv_bf16(bf16_t* p, int lane, const RowV& r) {
    v4u a, b; a.x = pk2(r.v[0], r.v[1]); a.y = pk2(r.v[2], r.v[3]); a.z = pk2(r.v[4], r.v[5]); a.w = pk2(r.v[6], r.v[7]);
    b.x = pk2(r.v[8], r.v[9]); b.y = pk2(r.v[10], r.v[11]); b.z = pk2(r.v[12], r.v[13]); b.w = pk2(r.v[14], r.v[15]);
    *(v4u*)(p + 8 * lane) = a; *(v4u*)(p + 512 + 8 * lane) = b;
}
__device__ __forceinline__ void store_rowv_fp8(unsigned char* p, int lane, const RowV& r, float s) {
    v2u a, b; a.x = pg8::pk4_fp8(r.v[0] * s, r.v[1] * s, r.v[2] * s, r.v[3] * s); a.y = pg8::pk4_fp8(r.v[4] * s, r.v[5] * s, r.v[6] * s, r.v[7] * s);
    b.x = pg8::pk4_fp8(r.v[8] * s, r.v[9] * s, r.v[10] * s, r.v[11] * s); b.y = pg8::pk4_fp8(r.v[12] * s, r.v[13] * s, r.v[14] * s, r.v[15] * s);
    *(v2u*)(p + 8 * lane) = a; *(v2u*)(p + 512 + 8 * lane) = b;
}
constexpr int LNR = 4;

__device__ __forceinline__ void phase_ln_add(const Frame& F, const bf16_t* X, const bf16_t* Y, const float* g, const float* b, bf16_t* out, unsigned char* out8) {
    const int gw = F.vcu * NWAVES + F.wave, NGW = F.G * NWAVES;
    GB gb; load_gb(g, b, F.lane, gb);
    for (int row = gw; row < T; row += LNR * NGW) {
        RowRaw rx[LNR], ry[LNR];
#pragma unroll
        for (int k = 0; k < LNR; ++k) { const int rr = row + k * NGW; if (rr < T) { rx[k] = load_raw(X + (size_t)rr * D, F.lane); if (Y) ry[k] = load_raw(Y + (size_t)rr * D, F.lane); } }
#pragma unroll
        for (int k = 0; k < LNR; ++k) { const int rr = row + k * NGW; if (rr < T) {
            RowV x; unpack_row(rx[k], x);
            if (Y) { RowV y; unpack_row(ry[k], y);
#pragma unroll
                for (int i = 0; i < 16; ++i) x.v[i] = ALPHA * x.v[i] + y.v[i]; }
            ln_rowv(x, gb);
            store_rowv_bf16(out + (size_t)rr * D, F.lane, x);
            store_rowv_fp8(out8 + (size_t)rr * D, F.lane, x, pg8::F8_XS); } }
    }
}
__device__ __forceinline__ void phase_ln_moe(const Frame& F, const bf16_t* X, const bf16_t* DS, const int* pos, const float* ewgt, const float* g, const float* b, bf16_t* outb, float* outf, unsigned char* out8) {
    const int gw = F.vcu * NWAVES + F.wave, NGW = F.G * NWAVES;
    GB gb; load_gb(g, b, F.lane, gb);
    for (int row = gw; row < T; row += LNR * NGW) {
        RowRaw rx[LNR], r1[LNR], r2[LNR]; float w1[LNR], w2[LNR];
#pragma unroll
        for (int k = 0; k < LNR; ++k) { const int rr = row + k * NGW; if (rr < T) {
            const int2 pp = *(const int2*)(pos + 2 * rr); const float2 ww = *(const float2*)(ewgt + 2 * rr); w1[k] = ww.x; w2[k] = ww.y;
            rx[k] = load_raw(X + (size_t)rr * D, F.lane); r1[k] = load_raw(DS + (size_t)pp.x * D, F.lane); r2[k] = load_raw(DS + (size_t)pp.y * D, F.lane); } }
#pragma unroll
        for (int k = 0; k < LNR; ++k) { const int rr = row + k * NGW; if (rr < T) {
            RowV x, y1, y2; unpack_row(rx[k], x); unpack_row(r1[k], y1); unpack_row(r2[k], y2);
#pragma unroll
            for (int i = 0; i < 16; ++i) x.v[i] = ALPHA * x.v[i] + (w1[k] * y1.v[i] + w2[k] * y2.v[i]);
            ln_rowv(x, gb);
            if (outb) store_rowv_bf16(outb + (size_t)rr * D, F.lane, x);
            if (out8) store_rowv_fp8(out8 + (size_t)rr * D, F.lane, x, pg8::F8_XS);
            if (outf) { float* o = outf + (size_t)rr * D + 8 * F.lane;
                *(float4*)(o) = make_float4(x.v[0], x.v[1], x.v[2], x.v[3]); *(float4*)(o + 4) = make_float4(x.v[4], x.v[5], x.v[6], x.v[7]);
                *(float4*)(o + 512) = make_float4(x.v[8], x.v[9], x.v[10], x.v[11]); *(float4*)(o + 516) = make_float4(x.v[12], x.v[13], x.v[14], x.v[15]); } } }
    }
}
constexpr int RW_LD = 20;
__device__ __forceinline__ void phase_ln_router(const Frame& F, const bf16_t* X, const bf16_t* Y, const float* g, const float* b, bf16_t* out, unsigned char* out8, const float* rw, const float* rbias, int* eidx, float* ewgt, int* bcnt) {
    LAS float* rwl = (LAS float*)F.lds;
    LAS int* hist = (LAS int*)(F.lds + 1024 * RW_LD * 4);
    LAS float* lgs = (LAS float*)(F.lds + 1024 * RW_LD * 4 + 256) + F.wave * 64;
    for (int i = F.tid; i < 1024 * 4; i += NTHREADS) { const int k = i >> 2, q = i & 3; const float4 v = *(const float4*)(rw + (size_t)k * 16 + 4 * q);
        const int j = (k >> 9) * 8 + (k & 7), l = (k >> 3) & 63; LAS float* d = rwl + (j * 64 + l) * RW_LD + 4 * q; d[0] = v.x; d[1] = v.y; d[2] = v.z; d[3] = v.w; }
    GB gb; load_gb(g, b, F.lane, gb);
    const int lane = F.lane;
    for (int vb = F.vcu; vb < T / 128; vb += F.G) {
        if (F.tid < 16) hist[F.tid] = 0;
        __syncthreads();
#pragma unroll 1
        for (int it = 0; it < 4; ++it) {
            const int row0 = vb * 128 + F.wave * 16 + it * 4;
            RowRaw rx[4], ry[4];
#pragma unroll
            for (int k = 0; k < 4; ++k) { rx[k] = load_raw(X + (size_t)(row0 + k) * D, lane); if (Y) ry[k] = load_raw(Y + (size_t)(row0 + k) * D, lane); }
            RowV x[4];
#pragma unroll
            for (int k = 0; k < 4; ++k) { unpack_row(rx[k], x[k]);
                if (Y) { RowV y; unpack_row(ry[k], y);
#pragma unroll
                    for (int i = 0; i < 16; ++i) x[k].v[i] = ALPHA * x[k].v[i] + y.v[i]; }
                ln_rowv(x[k], gb);
                store_rowv_bf16(out + (size_t)(row0 + k) * D, lane, x[k]);
                store_rowv_fp8(out8 + (size_t)(row0 + k) * D, lane, x[k], pg8::F8_XS); }
            float val[64];
#pragma unroll
            for (int i = 0; i < 64; ++i) val[i] = 0.f;
#pragma unroll
            for (int j = 0; j < 16; ++j) { const LAS float* wr = rwl + (j * 64 + lane) * RW_LD;
#pragma unroll
                for (int e4 = 0; e4 < 4; ++e4) { const f32x4 w4 = *(const LAS f32x4*)(wr + 4 * e4);
#pragma unroll
                    for (int k = 0; k < 4; ++k) { const float xv = x[k].v[j];
                        val[16 * k + 4 * e4 + 0] += xv * w4[0]; val[16 * k + 4 * e4 + 1] += xv * w4[1]; val[16 * k + 4 * e4 + 2] += xv * w4[2]; val[16 * k + 4 * e4 + 3] += xv * w4[3]; } } }
#pragma unroll
            for (int i = 0; i < 32; ++i) { const auto rr = __builtin_amdgcn_permlane32_swap(__float_as_uint(val[i]), __float_as_uint(val[i + 32]), false, false); val[i] = __uint_as_float(rr[0]) + __uint_as_float(rr[1]); }
            { const bool bt = (lane & 16) != 0;
#pragma unroll
              for (int i = 0; i < 16; ++i) { const float keep = bt ? val[i + 16] : val[i], send = bt ? val[i] : val[i + 16]; val[i] = keep + swz_xor<16>(send); } }
            { const bool bt = (lane & 8) != 0;
#pragma unroll
              for (int i = 0; i < 8; ++i) { const float keep = bt ? val[i + 8] : val[i], send = bt ? val[i] : val[i + 8]; val[i] = keep + swz_xor<8>(send); } }
            { const bool bt = (lane & 4) != 0;
#pragma unroll
              for (int i = 0; i < 4; ++i) { const float keep = bt ? val[i + 4] : val[i], send = bt ? val[i] : val[i + 4]; val[i] = keep + swz_xor<4>(send); } }
            { const bool bt = (lane & 2) != 0;
#pragma unroll
              for (int i = 0; i < 2; ++i) { const float keep = bt ? val[i + 2] : val[i], send = bt ? val[i] : val[i + 2]; val[i] = keep + swz_xor<2>(send); } }
            { const bool bt = (lane & 1) != 0; const float keep = bt ? val[1] : val[0], send = bt ? val[0] : val[1]; val[0] = keep + swz_xor<1>(send); }
            lgs[lane] = val[0];
            LDS_WAIT();
            if (lane < 4) {
                const int row = row0 + lane;
                float lg[16];
#pragma unroll
                for (int e4 = 0; e4 < 4; ++e4) { const f32x4 t4 = *(const LAS f32x4*)(lgs + 16 * lane + 4 * e4); lg[4 * e4] = t4[0]; lg[4 * e4 + 1] = t4[1]; lg[4 * e4 + 2] = t4[2]; lg[4 * e4 + 3] = t4[3]; }
                float mx = lg[0];
#pragma unroll
                for (int e = 1; e < 16; ++e) mx = fmaxf(mx, lg[e]);
                float sc[16], sum = 0.f;
#pragma unroll
                for (int e = 0; e < 16; ++e) { sc[e] = __expf(lg[e] - mx); sum += sc[e]; }
                const float isum = 1.f / sum;
                float bz[16];
#pragma unroll
                for (int e = 0; e < 16; ++e) { sc[e] *= isum; bz[e] = sc[e] + rbias[e]; }
                float gs[4]; int gi1[4], gi2[4];
#pragma unroll
                for (int gq = 0; gq < 4; ++gq) {
                    float m1 = bz[4 * gq]; int i1 = 0;
#pragma unroll
                    for (int j = 1; j < 4; ++j) if (bz[4 * gq + j] > m1) { m1 = bz[4 * gq + j]; i1 = j; }
                    float m2 = -INFINITY; int i2 = 0;
#pragma unroll
                    for (int j = 0; j < 4; ++j) if (j != i1 && bz[4 * gq + j] > m2) { m2 = bz[4 * gq + j]; i2 = j; }
                    gs[gq] = m1 + m2; gi1[gq] = i1; gi2[gq] = i2;
                }
                int gsel = 0; float gm = gs[0];
#pragma unroll
                for (int gq = 1; gq < 4; ++gq) if (gs[gq] > gm) { gm = gs[gq]; gsel = gq; }
                int i1 = gi1[0], i2 = gi2[0];
#pragma unroll
                for (int gq = 1; gq < 4; ++gq) if (gsel == gq) { i1 = gi1[gq]; i2 = gi2[gq]; }
                const int e1 = gsel * 4 + i1, e2 = gsel * 4 + i2;
                float s1 = 0.f, s2 = 0.f;
#pragma unroll
                for (int e = 0; e < 16; ++e) { if (e == e1) s1 = sc[e]; if (e == e2) s2 = sc[e]; }
                const float inv = 1.f / (s1 + s2);
                *(int2*)(eidx + 2 * row) = make_int2(e1, e2); *(float2*)(ewgt + 2 * row) = make_float2(s1 * inv, s2 * inv);
                atomicAdd((int*)&hist[e1], 1); atomicAdd((int*)&hist[e2], 1);
            }
        }
        __syncthreads();
        if (F.tid < 16) bcnt[vb * 16 + F.tid] = hist[F.tid];
        __syncthreads();
    }
}
__device__ __forceinline__ void phase_moe_book(const Frame& F, const int* eidx, const int* bcnt, int* tok, int* pos, int* tile_e) {
    LAS int* bc = (LAS int*)F.lds;
    LAS int* part = bc + 4096;
    LAS int* off = part + 256;
    LAS int* base = off + 32;
    LAS int* tot = base + 16;
    LAS int* wcnt = tot + 16;
    for (int i = F.tid; i < 4096; i += NTHREADS) bc[i] = bcnt[i];
    __syncthreads();
    if (F.tid < 256) { const int e = F.tid & 15, ch = F.tid >> 4; int s = 0;
#pragma unroll
        for (int j = 0; j < 16; ++j) s += bc[(ch * 16 + j) * 16 + e];
        part[ch * 16 + e] = s; }
    __syncthreads();
    if (F.tid < 16) { int t = 0;
#pragma unroll
        for (int ch = 0; ch < 16; ++ch) t += part[ch * 16 + F.tid];
        tot[F.tid] = t; }
    __syncthreads();
    if (F.tid == 0) { int o = 0;
#pragma unroll
        for (int e = 0; e < 16; ++e) { off[e] = o; o += (tot[e] + 255) & ~255; } off[16] = o; }
    __syncthreads();
    for (int vb = F.vcu; vb < T / 128; vb += F.G) {
        if (F.tid < 16) { const int e = F.tid, chv = vb >> 4; int bs = 0;
            for (int ch = 0; ch < chv; ++ch) bs += part[ch * 16 + e];
            for (int b2 = chv * 16; b2 < vb; ++b2) bs += bc[b2 * 16 + e];
            base[e] = bs; }
        int e = 0, rank = 0;
        if (F.tid < 256) {
            e = eidx[vb * 256 + F.tid];
            const unsigned long long lt = (1ull << F.lane) - 1ull;
#pragma unroll
            for (int k = 0; k < 16; ++k) { const unsigned long long mk = __ballot(e == k); if (e == k) rank = __popcll(mk & lt); if (F.lane == 0) wcnt[F.wave * 16 + k] = __popcll(mk); }
        }
        __syncthreads();
        if (F.tid < 256) {
            for (int w2 = 0; w2 < F.wave; ++w2) rank += wcnt[w2 * 16 + e];
            const int r = off[e] + base[e] + rank;
            pos[vb * 256 + F.tid] = r; tok[r] = vb * 128 + (F.tid >> 1);
        }
        if (vb < 16) { const int e2 = vb, r0 = off[e2] + tot[e2], r1 = off[e2 + 1]; for (int r = r0 + F.tid; r < r1; r += NTHREADS) tok[r] = 0; }
        if (vb == 16) {
            for (int tl = F.tid; tl < NTILE; tl += NTHREADS) { int e3 = -1;
#pragma unroll
                for (int k = 0; k < 16; ++k) if (tl * 256 >= off[k] && tl * 256 < off[k + 1]) e3 = k;
                tile_e[tl] = e3; }
            if (F.tid == 0) tile_e[NTILE] = off[16] >> 8;
        }
        __syncthreads();
    }
}
__device__ __forceinline__ void phase_pool(const Frame& F, const bf16_t* HP, unsigned char* PO) {
    constexpr int RUN = 32;
    const int gt = F.vcu * NTHREADS + F.tid, NGT = F.G * NTHREADS;
    for (int it = gt; it < (T / RUN) * (D / 8); it += NGT) {
        const int c8 = it & 127, run = it >> 7, g = c8 >> 5, win = 2 << g, t0 = run * RUN, ts0 = t0 & (S - 1);
        const bf16_t* hp = HP + (size_t)t0 * D + c8 * 8; unsigned char* po = PO + (size_t)t0 * D + c8 * 8;
        float s[8];
#pragma unroll
        for (int q = 0; q < 8; ++q) s[q] = 0.f;
        for (int k = 1; k < win; ++k) if (ts0 - k >= 0) { float v[8]; unpk8(*(const v4u*)(hp - (ptrdiff_t)k * D), v);
#pragma unroll
            for (int q = 0; q < 8; ++q) s[q] += v[q]; }
#pragma unroll 4
        for (int i = 0; i < RUN; ++i) {
            float hn[8]; unpk8(*(const v4u*)(hp + (size_t)i * D), hn);
            const int ts = ts0 + i;
#pragma unroll
            for (int q = 0; q < 8; ++q) s[q] += hn[q];
            const float inv = 1.f / (float)(ts + 1 < win ? ts + 1 : win);
            v2u o; const float xs = pg8::F8_XS; o.x = pg8::pk4_fp8((s[0] * inv - hn[0]) * xs, (s[1] * inv - hn[1]) * xs, (s[2] * inv - hn[2]) * xs, (s[3] * inv - hn[3]) * xs); o.y = pg8::pk4_fp8((s[4] * inv - hn[4]) * xs, (s[5] * inv - hn[5]) * xs, (s[6] * inv - hn[6]) * xs, (s[7] * inv - hn[7]) * xs);
            *(v2u*)(po + (size_t)i * D) = o;
            if (ts + 1 >= win) { float ho[8]; unpk8(*(const v4u*)(hp + (ptrdiff_t)(i + 1 - win) * D), ho);
#pragma unroll
                for (int q = 0; q < 8; ++q) s[q] -= ho[q]; }
        }
    }
}
}
namespace mk {
typedef short bf16x8 __attribute__((ext_vector_type(8)));
typedef float f32x16 __attribute__((ext_vector_type(16)));
#define MFMA32(a, b, c) __builtin_amdgcn_mfma_f32_32x32x16_bf16((a), (b), (c), 0, 0, 0)
__device__ __forceinline__ int crow(int i, int h) { return (i & 3) + 8 * (i >> 2) + 4 * h; }
__device__ __forceinline__ float swap32_max(float v) { const auto r = __builtin_amdgcn_permlane32_swap(__float_as_uint(v), __float_as_uint(v), false, false); return fmaxf(__uint_as_float(r[0]), __uint_as_float(r[1])); }
__device__ __forceinline__ float swap32_sum(float v) { const auto r = __builtin_amdgcn_permlane32_swap(__float_as_uint(v), __float_as_uint(v), false, false); return __uint_as_float(r[0]) + __uint_as_float(r[1]); }
__device__ __forceinline__ unsigned pkbf(float lo, float hi) { unsigned r; asm volatile("v_cvt_pk_bf16_f32 %0, %1, %2" : "=v"(r) : "v"(lo), "v"(hi)); return r; }
__device__ __forceinline__ bf16x8 pack_step(const f32x16& x, int s) {
    v4u p; p.x = pkbf(x[8 * s + 0], x[8 * s + 1]); p.y = pkbf(x[8 * s + 2], x[8 * s + 3]); p.z = pkbf(x[8 * s + 4], x[8 * s + 5]); p.w = pkbf(x[8 * s + 6], x[8 * s + 7]);
    return __builtin_bit_cast(bf16x8, p);
}
__device__ __forceinline__ bf16x8 lds_frag2x8(const LAS unsigned char* p) {
    const v2u a = *(const LAS v2u*)p, b = *(const LAS v2u*)(p + 16);
    v4u q; q.x = a.x; q.y = a.y; q.z = b.x; q.w = b.y; return __builtin_bit_cast(bf16x8, q);
}
__device__ __forceinline__ void unpack8(const v4u u, float (&x)[8]) {
    x[0] = __uint_as_float(u.x << 16); x[1] = __uint_as_float(u.x & 0xffff0000u); x[2] = __uint_as_float(u.y << 16); x[3] = __uint_as_float(u.y & 0xffff0000u);
    x[4] = __uint_as_float(u.z << 16); x[5] = __uint_as_float(u.z & 0xffff0000u); x[6] = __uint_as_float(u.w << 16); x[7] = __uint_as_float(u.w & 0xffff0000u);
}

__device__ __forceinline__ void phase_swa_sgu(const Frame& F, const bf16_t* H0, const float* sinks, const float* lng, const float* lnb, const bf16_t* SW, const float* bs, bf16_t* MIX) {
    constexpr int KSTR = 272, VSTR = 520, VT_OFF = 256 * KSTR, VGSTR = 272, VGW = 64 * VGSTR;
    LAS unsigned char* KS = F.lds; LAS unsigned char* VT = F.lds + VT_OFF;
    const int lane = F.lane, r = lane & 31, h = lane >> 5, w = F.wave, kvh = w >> 2;
    const float NEG = -INFINITY;
    for (int vb = F.vcu; vb < T / 128; vb += F.G) {
        const int n = vb & 63; const size_t row0 = (size_t)vb * 128;
#pragma unroll
        for (int i = 0; i < 8; ++i) { const int p = F.tid + NTHREADS * i, row = p >> 4, c16 = p & 15; v4u v = (v4u){0u, 0u, 0u, 0u};
            if (n > 0 || row >= 128) v = *(const v4u*)(H0 + (row0 + row - 128) * NIN0 + 512 + c16 * 8);
            *(LAS v4u*)(KS + row * KSTR + c16 * 16) = v; }
#pragma unroll
        for (int i = 0; i < 8; ++i) { const int p = F.tid + NTHREADS * i, c16 = p >> 8, row = p & 255; v4u v = (v4u){0u, 0u, 0u, 0u};
            if (n > 0 || row >= 128) v = *(const v4u*)(H0 + (row0 + row - 128) * NIN0 + 640 + c16 * 8);
            LAS bf16_t* d = (LAS bf16_t*)(VT + (c16 * 8) * VSTR + row * 2);
            d[0 * (VSTR / 2)] = (bf16_t)(v.x & 0xffffu); d[1 * (VSTR / 2)] = (bf16_t)(v.x >> 16); d[2 * (VSTR / 2)] = (bf16_t)(v.y & 0xffffu); d[3 * (VSTR / 2)] = (bf16_t)(v.y >> 16);
            d[4 * (VSTR / 2)] = (bf16_t)(v.z & 0xffffu); d[5 * (VSTR / 2)] = (bf16_t)(v.z >> 16); d[6 * (VSTR / 2)] = (bf16_t)(v.w & 0xffffu); d[7 * (VSTR / 2)] = (bf16_t)(v.w >> 16); }
        __syncthreads();
        const float sink2 = sinks[w] * 1.4426950408889634f;
        bf16x8 qn[4];
        { const bf16_t* qp = H0 + (row0 + r) * NIN0 + w * 64 + 8 * h;
#pragma unroll
          for (int ks = 0; ks < 4; ++ks) qn[ks] = *(const bf16x8*)(qp + 16 * ks); }
#pragma unroll 1
        for (int qg = 0; qg < 4; ++qg) {
            bf16x8 qf[4];
#pragma unroll
            for (int ks = 0; ks < 4; ++ks) qf[ks] = qn[ks];
            if (qg < 3) { const bf16_t* qp = H0 + (row0 + 32 * (qg + 1) + r) * NIN0 + w * 64 + 8 * h;
#pragma unroll
              for (int ks = 0; ks < 4; ++ks) qn[ks] = *(const bf16x8*)(qp + 16 * ks); }
            f32x16 st[5];
#pragma unroll
            for (int kt = 0; kt < 5; ++kt) {
#pragma unroll
                for (int i = 0; i < 16; ++i) st[kt][i] = 0.f;
                const LAS unsigned char* kp = KS + (32 * qg + 32 * kt + r) * KSTR + (kvh * 64 + 8 * h) * 2;
#pragma unroll
                for (int ks = 0; ks < 4; ++ks) { const bf16x8 kf = *(const LAS bf16x8*)(kp + 32 * ks); st[kt] = MFMA32(kf, qf[ks], st[kt]); }
            }
            float m = sink2;
            int rq = r; asm volatile("" : "+v"(rq));
#pragma unroll
            for (int kt = 0; kt < 5; ++kt)
#pragma unroll
                for (int i = 0; i < 16; ++i) { const int dk = 32 * kt + crow(i, h) - rq;
                    float s = st[kt][i] * ASCALE;
                    if (kt == 0) s = dk >= 1 ? s : NEG;
                    if (kt == 4) s = dk <= 128 ? s : NEG;
                    st[kt][i] = s; }
            if (n == 0) {
#pragma unroll
                for (int kt = 0; kt < 5; ++kt)
#pragma unroll
                    for (int i = 0; i < 16; ++i) if (32 * qg + 32 * kt + crow(i, h) < 128) st[kt][i] = NEG; }
#pragma unroll
            for (int kt = 0; kt < 5; ++kt)
#pragma unroll
                for (int i = 0; i < 16; ++i) m = fmaxf(m, st[kt][i]);
            m = swap32_max(m);
            float l = 0.f;
#pragma unroll
            for (int kt = 0; kt < 5; ++kt)
#pragma unroll
                for (int i = 0; i < 16; ++i) { const float p = __builtin_amdgcn_exp2f(st[kt][i] - m); st[kt][i] = p; l += p; }
            l = swap32_sum(l) + __builtin_amdgcn_exp2f(sink2 - m);
            f32x16 o[2];
#pragma unroll
            for (int i = 0; i < 16; ++i) { o[0][i] = 0.f; o[1][i] = 0.f; }
#pragma unroll
            for (int kt = 0; kt < 5; ++kt)
#pragma unroll
                for (int s = 0; s < 2; ++s) { const bf16x8 pf = pack_step(st[kt], s);
#pragma unroll
                    for (int dt = 0; dt < 2; ++dt) { const bf16x8 vf = lds_frag2x8(VT + (kvh * 64 + 32 * dt + r) * VSTR + (32 * qg + 32 * kt + 16 * s + 4 * h) * 2); o[dt] = MFMA32(vf, pf, o[dt]); } }
            const float inv = 1.f / l;
            bf16_t* op = MIX + (row0 + 32 * qg + r) * D + w * 64 + 4 * h;
#pragma unroll
            for (int dt = 0; dt < 2; ++dt)
#pragma unroll
                for (int g4 = 0; g4 < 4; ++g4) { v2u u; u.x = pkbf(o[dt][4 * g4 + 0] * inv, o[dt][4 * g4 + 1] * inv); u.y = pkbf(o[dt][4 * g4 + 2] * inv, o[dt][4 * g4 + 3] * inv); *(v2u*)(op + 32 * dt + 8 * g4) = u; }
        }
        __syncthreads();
        {
            LAS unsigned char* VG = F.lds + w * VGW; const int g = w;
            const int lane2 = (int)lane_id_fresh(), r2 = lane2 & 31, h2 = lane2 >> 5;
#pragma unroll 1
            for (int it = 0; it < 2; ++it) { const int s = 64 * it + lane2; const bf16_t* vp = H0 + (row0 + s) * NIN0 + 1280 + g * 64;
                float x[8][8]; float sum = 0.f;
#pragma unroll
                for (int cq = 0; cq < 8; ++cq) { unpack8(*(const v4u*)(vp + 8 * cq), x[cq]);
#pragma unroll
                    for (int e = 0; e < 8; ++e) sum += x[cq][e]; }
                const float mu = sum * (1.f / 64.f); float q = 0.f;
#pragma unroll
                for (int cq = 0; cq < 8; ++cq)
#pragma unroll
                    for (int e = 0; e < 8; ++e) { x[cq][e] -= mu; q += x[cq][e] * x[cq][e]; }
                const float rstd = 1.f / sqrtf(q * (1.f / 64.f) + LN_EPS);
#pragma unroll
                for (int cq = 0; cq < 8; ++cq) { const float* gp = lng + g * 64 + 8 * cq; const float* bp = lnb + g * 64 + 8 * cq; asm volatile("" : "+s"(gp), "+s"(bp));
#pragma unroll
                    for (int e = 0; e < 8; ++e) { const int c = 8 * cq + e; *(LAS bf16_t*)(VG + c * VGSTR + s * 2) = f2bf(x[cq][e] * rstd * gp[e] + bp[e]); } }
            }
            LDS_WAIT();
#pragma unroll 1
            for (int tt = 0; tt < 4; ++tt) {
                f32x16 acc[2];
#pragma unroll
                for (int i = 0; i < 16; ++i) { acc[0][i] = 0.f; acc[1][i] = 0.f; }
                const bf16_t* wp = SW + ((size_t)(g * 128 + 32 * tt + r2) * 128 + 8 * h2);
                const int nks = 2 * (tt + 1);
                bf16x8 bfr[8];
#pragma unroll
                for (int ks = 0; ks < 8; ++ks) if (ks < nks) bfr[ks] = *(const bf16x8*)(wp + 16 * ks);
                const int t = 32 * tt + r2; const float bias = bs[g * 128 + t];
                const bf16_t* up = H0 + (row0 + t) * NIN0 + 768 + g * 64 + 4 * h2; bf16_t* op = MIX + (row0 + t) * D + 512 + g * 64 + 4 * h2;
                v2u uu[2][4];
#pragma unroll
                for (int ct = 0; ct < 2; ++ct)
#pragma unroll
                    for (int g4 = 0; g4 < 4; ++g4) uu[ct][g4] = *(const v2u*)(up + 32 * ct + 8 * g4);
#pragma unroll
                for (int ks = 0; ks < 8; ++ks) if (ks < nks) {
#pragma unroll
                    for (int ct = 0; ct < 2; ++ct) { const bf16x8 af = *(const LAS bf16x8*)(VG + (32 * ct + r2) * VGSTR + (16 * ks + 8 * h2) * 2); acc[ct] = MFMA32(af, bfr[ks], acc[ct]); } }
#pragma unroll
                for (int ct = 0; ct < 2; ++ct)
#pragma unroll
                    for (int g4 = 0; g4 < 4; ++g4) { const v2u u2 = uu[ct][g4];
                        const float u0 = __uint_as_float(u2.x << 16), u1 = __uint_as_float(u2.x & 0xffff0000u), u2f = __uint_as_float(u2.y << 16), u3 = __uint_as_float(u2.y & 0xffff0000u);
                        v2u o2; o2.x = pkbf(u0 * (acc[ct][4 * g4 + 0] + bias), u1 * (acc[ct][4 * g4 + 1] + bias)); o2.y = pkbf(u2f * (acc[ct][4 * g4 + 2] + bias), u3 * (acc[ct][4 * g4 + 3] + bias));
                        *(v2u*)(op + 32 * ct + 8 * g4) = o2; }
            }
        }
        __syncthreads();
    }
}

}
namespace mk {
constexpr int NPHASE = 23;
constexpr int N_EARLY = 896 + 2 * 1024, NITEMS = N_EARLY + 3 * 512 + 2 * (512 + 3 * 4096);
constexpr int GEMM_CUS_P1 = 160;

typedef const __attribute__((address_space(4))) Args* KArgs;
__device__ __forceinline__ KArgs kargs() { KArgs p = (KArgs)__builtin_amdgcn_kernarg_segment_ptr(); asm volatile("" : "+s"(p)); return p; }

__device__ __forceinline__ void decode_item(KArgs ka, bf16_t* WB, int it, TItem& t) {
                    int r = it;
#define JOB(MAP, F8_, src, K_, N_, dst, dstb, cnt) if (r < (cnt)) { titem_fill<MAP, F8_>(t, src, K_, N_, dst, dstb, r); return; } r -= (cnt);
                    JOB(0, true, ka->in[5], 1024, 1792, WB + WB_IN0, 0, 896)
                    JOB(0, false, ka->in[15], 1024, 2048, WB + WB_LAYER + WL_XKV, 0, 1024)
                    JOB(0, false, ka->in[31], 1024, 2048, WB + WB_LAYER + WL_SIZE + WL_XKV, 0, 1024)
                    JOB(0, false, ka->in[11], 1024, 1024, WB + WB_OUT0, 0, 512)
                    JOB(0, true, ka->in[24], 1024, 1024, WB + WB_IN1, 0, 512)
                    JOB(0, false, ka->in[27], 1024, 1024, WB + WB_OUT1, 0, 512)
#define LAYER_JOBS(l, c2) { bf16_t* Wl = WB + WB_LAYER + (size_t)(l) * WL_SIZE; \
                        JOB(0, false, ka->in[(c2) + 4], 1024, 1024, Wl + WL_XO, 0, 512) \
                        JOB(1, true, ka->in[(c2) + 7], 1024, 512, Wl + WL_GU, (size_t)1024 * 1024, 4096)     \
                        JOB(2, true, ka->in[(c2) + 8], 1024, 512, Wl + WL_GU, (size_t)1024 * 1024, 4096) \
                        JOB(0, true, ka->in[(c2) + 9], 512, 1024, Wl + WL_DN, (size_t)1024 * 512, 4096) }
                    LAYER_JOBS(0, 12)
                    LAYER_JOBS(1, 28)
#undef LAYER_JOBS
#undef JOB
}

__device__ __forceinline__ bool in_range(int k) { KArgs ka = kargs(); return ka->ph_lo <= k && k < ka->ph_hi; }

__global__ void __launch_bounds__(NTHREADS, 2) mega(Args a) {
    extern __shared__ __attribute__((aligned(16))) unsigned char lds_raw[];
    LAS unsigned char* const F0lds = (LAS unsigned char*)lds_raw;
    const int F0wave = __builtin_amdgcn_readfirstlane((int)threadIdx.x >> 6);
    const int F0G = gridDim.x, F0bx = blockIdx.x, F0vcu = (F0G % 8 == 0) ? (F0bx % 8) * (F0G / 8) + F0bx / 8 : F0bx;
    volatile LAS unsigned* MISC = (volatile LAS unsigned*)(F0lds + MISC_OFF);
    if (threadIdx.x < 64) MISC[threadIdx.x] = 0u;
    __syncthreads();
    unsigned* ctl = (unsigned*)(a.ws + WS_CTL);
    XcdBarrier bar = xcd_barrier_post(ctl + CW_BAR + a.ph_lo * XCD_BAR_WORDS, MISC + 8, F0wave);
#define IN(k) in_range(k)
#define SEAM(k) do { if (IN(k) && IN((k) + 1)) { XcdBarrier b2_ = bar; asm volatile("" : "+s"(b2_.bar), "+s"(b2_.x)); xcd_barrier(b2_); } } while (0)
#define PH KArgs ka = kargs(); unsigned char* ws = ka->ws; (void)ws; Frame Fp; Fp.lds = F0lds; Fp.wave = F0wave; Fp.vcu = F0vcu; Fp.G = F0G; Fp.bx = F0bx; asm volatile("" : "+s"(Fp.wave), "+s"(Fp.vcu), "+s"(Fp.G), "+s"(Fp.bx)); \
    Fp.lane = (int)lane_id_fresh(); Fp.tid = Fp.wave * 64 + Fp.lane; const Frame& F = Fp; \
    const int bx = Fp.bx; (void)bx; LAS unsigned char* glds = F.lds; (void)glds; \
    bf16_t* RA = (bf16_t*)(ws + WS_A); bf16_t* RB = (bf16_t*)(ws + WS_B); bf16_t* RC = (bf16_t*)(ws + WS_C); bf16_t* RD = (bf16_t*)(ws + WS_D); bf16_t* WB = (bf16_t*)(ws + WS_WB); \
    (void)RA; (void)RB; (void)RC; (void)RD; (void)WB;
#define PHC PH const int cb = L == 0 ? 12 : 28; (void)cb; bf16_t* WBl = WB + WB_LAYER + (size_t)L * WL_SIZE; (void)WBl; \
    bf16_t *X1 = RB, *X2 = RA, *HS = RB, *DS = RD, *X3 = L == 0 ? RC : nullptr;   unsigned char *X1_8 = (unsigned char*)(L == 0 ? RD : RA), *P8 = (unsigned char*)(L == 0 ? RA : RC), *X2_8 = (unsigned char*)(L == 0 ? RD : RC); bf16_t* Y2 = L == 0 ? RC : RD; \
    (void)X1; (void)P8; (void)X1_8; (void)X2_8; (void)Y2; (void)X2; (void)HS; (void)DS; (void)X3;
#ifndef DOUBLE_MASK
#define DOUBLE_MASK 0u
#endif
#if DOUBLE_MASK != 0
#define REP(k) for (int rep_ = 0, nrep_ = 1 + (int)((DOUBLE_MASK >> (k)) & 1u); rep_ < nrep_; ++rep_)
#else
#define REP(k)
#endif
#define INF(i) ((const float*)ka->in[i])
#define WSI(off) ((int*)(ws + (off)))
#define WSF(off) ((float*)(ws + (off)))

#define GEMM_STD(EPI, ORD, LDA_, LDB_, K_) pg8::gemm_phase<EPI, ORD, true, true, false, LDA_, LDB_, K_>(glds, F.tid, g, S, E)
    for (int L = 0; L < 2; ++L) {
        const int cbp = L == 0 ? 0 : 11;
        if (L == 0) {
            if (IN(0)) REP(0) { PH
                LAS float* scrA = (LAS float*)(F.lds + F.wave * 16896), * scrB = scrA + 64 * 33;
                const int gw = F.vcu * NWAVES + F.wave, NGW = F.G * NWAVES;
                for (int it = gw; it < N_EARLY; it += 2 * NGW) {
                    TItem ta, tb; TRegs ra, rb; const int itb = it + NGW < N_EARLY ? it + NGW : it;
                    decode_item(ka, WB, it, ta); titem_load(ta, F.lane, ra);
                    decode_item(ka, WB, itb, tb); titem_load(tb, F.lane, rb);
                    titem_finish(ta, F.lane, ra, scrA);
                    titem_finish(tb, F.lane, rb, scrB);
                }
                const int gt = F.vcu * NTHREADS + F.tid, NGT = F.G * NTHREADS;
                { const float4* x4 = (const float4*)ka->in[0]; v2u* o = (v2u*)RA; unsigned* o8 = (unsigned*)RB;
                  for (int i = gt; i < T * D / 4; i += 4 * NGT) { float4 v[4];
#pragma unroll
                      for (int k = 0; k < 4; ++k) v[k] = x4[i + k * NGT];
#pragma unroll
                      for (int k = 0; k < 4; ++k) { v2u w; w.x = pk2(v[k].x, v[k].y); w.y = pk2(v[k].z, v[k].w); o[i + k * NGT] = w;
                          o8[i + k * NGT] = pg8::pk4_fp8(v[k].x * pg8::F8_XS, v[k].y * pg8::F8_XS, v[k].z * pg8::F8_XS, v[k].w * pg8::F8_XS); } } }
                { const float4* m4 = (const float4*)ka->in[1]; v2u* o = (v2u*)(ws + WS_MEMB);
                  for (int i = gt; i < B * MEM * D / 4; i += NGT) { const float4 v = m4[i]; v2u w; w.x = pk2(v.x, v.y); w.y = pk2(v.z, v.w); o[i] = w; } }
                { const int* positions = (const int*)ka->in[2]; float* ropew = WSF(WS_ROPE);
                  for (int t = gt; t < T; t += NGT) { const float p = (float)positions[t];
#pragma unroll
                      for (int j = 0; j < 8; ++j) { const float ang = p * ka->inv.f[j]; double rev = (double)ang * 0.15915494309189535; rev -= rint(rev); const float rr = (float)rev;
                          ropew[(size_t)t * 16 + j] = __builtin_amdgcn_cosf(rr); ropew[(size_t)t * 16 + 8 + j] = __builtin_amdgcn_sinf(rr); } } }
            }
            SEAM(0);
            if (IN(1)) REP(1) { PH float* rope = WSF(WS_ROPE); bf16_t* MEMB = (bf16_t*)(ws + WS_MEMB);
              const int GC = F.G >= 256 ? GEMM_CUS_P1 : F.G;
              if (bx >= GC || F.G < 256) {
                const int cid = F.G >= 256 ? bx - GC : bx, NC = F.G >= 256 ? F.G - GC : F.G;
                LAS float* scrA = (LAS float*)(F.lds + F.wave * 16896), * scrB = scrA + 64 * 33;
                const int gw = cid * NWAVES + F.wave, NGW = NC * NWAVES;
#define CLAMP_IT(x) ((x) < NITEMS ? (x) : NITEMS - 1)
                { TItem ta, tb, tc, td; TRegs ra, rb, rc, rd; int it = N_EARLY + gw;
                  decode_item(ka, WB, CLAMP_IT(it), ta); titem_load(ta, F.lane, ra);
                  decode_item(ka, WB, CLAMP_IT(it + NGW), tb); titem_load(tb, F.lane, rb);
                  for (; it < NITEMS; it += 4 * NGW) {
                      decode_item(ka, WB, CLAMP_IT(it + 2 * NGW), tc); titem_load(tc, F.lane, rc);
                      decode_item(ka, WB, CLAMP_IT(it + 3 * NGW), td); titem_load(td, F.lane, rd);
                      titem_finish(ta, F.lane, ra, scrA); titem_finish(tb, F.lane, rb, scrB);
                      decode_item(ka, WB, CLAMP_IT(it + 4 * NGW), ta); titem_load(ta, F.lane, ra);
                      decode_item(ka, WB, CLAMP_IT(it + 5 * NGW), tb); titem_load(tb, F.lane, rb);
                      titem_finish(tc, F.lane, rc, scrA); titem_finish(td, F.lane, rd, scrB);
                  } }
#undef CLAMP_IT
                const int gt = cid * NTHREADS + F.tid, NGT = NC * NTHREADS;
#pragma unroll
                for (int l = 0; l < 2; ++l) { const float4* q4 = (const float4*)ka->in[l == 0 ? 14 : 30]; v2u* o = (v2u*)(WB + WB_LAYER + (size_t)l * WL_SIZE + WL_XQ);
                  for (int i = gt; i < D * D / 4; i += NGT) { const float4 v = q4[i]; v2u w; w.x = pk2(v.x, v.y); w.y = pk2(v.z, v.w); o[i] = w; } }
                { const float4* p4 = (const float4*)ka->in[25]; const float4* s4 = (const float4*)ka->in[26]; v2u* o = (v2u*)(WB + WB_POOL);
                  for (int i = gt; i < 4 * 256 * 256 / 4; i += NGT) { const float4 v = p4[i]; const float4 sc = s4[(i >> 14) * 64 + (i & 63)]; v2u w; w.x = pk2(v.x * sc.x, v.y * sc.y); w.y = pk2(v.z * sc.z, v.w * sc.w); o[i] = w; } }
                { const float* sw = INF(9); bf16_t* o = WB + WB_SGUW;
                  for (int i = gt; i < 8 * 128 * 128; i += NGT) { const int s2 = i & 127, t = (i >> 7) & 127; o[i] = f2bf(s2 <= t ? sw[i] : 0.f); } }
                __syncthreads();
              }
              if (bx < GC) {
#pragma unroll 1
                for (int l = 0; l < 2; ++l) {
                    bf16_t* Wl = WB + WB_LAYER + (size_t)l * WL_SIZE;
                    pg8::Gemm g{MEMB, Wl + WL_XKV, nullptr, nullptr};
                    const int c2 = bx - 96 - 32 * l;
                    pg8::StaticOrder S; S.init(B * MEM, 2048, GC, (c2 >= 0 && c2 < 32) ? c2 : (1 << 20), D, D);
                    pg8::EpiBf16 E{(bf16_t*)(ws + WS_MEMKV) + (size_t)l * B * MEM * 2048, 2048, 1.f};
                    GEMM_STD(pg8::EpiBf16, pg8::StaticOrder, D, D, D);
                }
                {
                    pg8::Gemm g{RB, WB + WB_IN0, nullptr, nullptr};
                    pg8::StaticOrder S; S.init(T, NIN0, GC, bx, D, D);
                    pg8::EpiInproj0 E{RD, rope, 1.f / (pg8::F8_XS * pg8::F8_WS)};
                    pg8::gemm_phase<pg8::EpiInproj0, pg8::StaticOrder, true, true, false, D, D, D, true>(glds, F.tid, g, S, E);
                }
              }
            }
            SEAM(1);
            if (IN(2)) REP(2) { PH
                { bf16_t* Wl = WB + WB_LAYER; const bf16_t* KV = (const bf16_t*)(ws + WS_MEMKV);
                  { pg8::Gemm g{KV, Wl + WL_XQ, nullptr, nullptr}; pg8::SetupOrder<0> S; S.init(bx, 0, 64); pg8::EpiF8 E{ws + WS_MT, D, QSCALE * pg8::F8_MS}; GEMM_STD(pg8::EpiF8, pg8::SetupOrder<0>, 2048, 1024, 256); }
                  { pg8::Gemm g{Wl + WL_XO, KV, nullptr, nullptr}; pg8::SetupOrder<1> S; S.init(bx, 64, 64); pg8::EpiF8 E{ws + WS_NT, D, pg8::F8_NS}; GEMM_STD(pg8::EpiF8, pg8::SetupOrder<1>, 1024, 2048, 256); }
                  { pg8::Gemm g{WB + WB_OUT1, WB + WB_POOL, nullptr, nullptr}; pg8::SetupOrder<2> S; S.init(bx, 128, 16); pg8::EpiF8 E{(unsigned char*)(WB + WB_WEFF), D, pg8::F8_WS}; GEMM_STD(pg8::EpiF8, pg8::SetupOrder<2>, 1024, 256, 256); } }
                phase_swa_sgu(F, RD, INF(6), INF(7), INF(8), WB + WB_SGUW, INF(10), RB);
            }
            SEAM(2);
            if (IN(3)) REP(3) { PH
                pg8::Gemm g{RB, WB + WB_OUT0, nullptr, nullptr};
                pg8::StaticOrder S; S.init(T, D, F.G, bx, D, D);
                pg8::EpiBf16 E{RC, D, 1.f};
                GEMM_STD(pg8::EpiBf16, pg8::StaticOrder, D, D, D);
            }
            SEAM(3);
            if (IN(4)) REP(4) { PH phase_ln_add(F, RA, RC, INF(12), INF(13), RB, (unsigned char*)RD); }
            SEAM(4);
        } else {
            if (IN(12)) REP(12) { PH
                pg8::Gemm g{RB, WB + WB_IN1, nullptr, nullptr};
                pg8::StaticOrder S; S.init(T, D, F.G, bx, D, D);
                pg8::EpiBf16 E{RA, D, 1.f / (pg8::F8_XS * pg8::F8_WS)};
                pg8::gemm_phase<pg8::EpiBf16, pg8::StaticOrder, true, true, false, D, D, D, true>(glds, F.tid, g, S, E);
            }
            SEAM(12);
            if (IN(13)) REP(13) { PH
                { bf16_t* Wl = WB + WB_LAYER + WL_SIZE; const bf16_t* KV = (const bf16_t*)(ws + WS_MEMKV) + (size_t)B * MEM * 2048;
                  { pg8::Gemm g{KV, Wl + WL_XQ, nullptr, nullptr}; pg8::SetupOrder<0> S; S.init(bx, 0, 64); pg8::EpiF8 E{ws + WS_MT, D, QSCALE * pg8::F8_MS}; GEMM_STD(pg8::EpiF8, pg8::SetupOrder<0>, 2048, 1024, 256); }
                  { pg8::Gemm g{Wl + WL_XO, KV, nullptr, nullptr}; pg8::SetupOrder<1> S; S.init(bx, 64, 64); pg8::EpiF8 E{ws + WS_NT, D, pg8::F8_NS}; GEMM_STD(pg8::EpiF8, pg8::SetupOrder<1>, 1024, 2048, 256); } }
                phase_pool(F, RA, (unsigned char*)RB);
            }
            SEAM(13);
            if (IN(14)) REP(14) { PH
                pg8::Gemm g{RB, WB + WB_WEFF, nullptr, nullptr};
                pg8::StaticOrder S; S.init(T, D, F.G, bx, D, D);
                pg8::EpiBf16 E{RD, D, 1.f / (pg8::F8_XS * pg8::F8_WS)};
                pg8::gemm_phase<pg8::EpiBf16, pg8::StaticOrder, true, true, false, D, D, D, true>(glds, F.tid, g, S, E);
            }
            SEAM(14);
            if (IN(15)) REP(15) { PH phase_ln_add(F, RC, RD, INF(28), INF(29), RB, (unsigned char*)RA); }
            SEAM(15);
        }
        if (IN(cbp + 5)) REP(cbp + 5) { PHC
            pg8::Gemm g{(const bf16_t*)X1_8, (const bf16_t*)(ws + WS_MT), nullptr, nullptr};
            pg8::BatchOrder S; S.init(T, D, F.G, bx, D, D);
            pg8::EpiSoftmaxT<true> E{P8, (LAS float*)(F.lds + 131072), 1.f / (pg8::F8_XS * pg8::F8_MS)};
            pg8::gemm_phase<pg8::EpiSoftmaxT<true>, pg8::BatchOrder, true, true, false, D, D, D, true>(glds, F.tid, g, S, E);
        }
        SEAM(cbp + 5);
        if (IN(cbp + 6)) REP(cbp + 6) { PHC
            pg8::Gemm g{(const bf16_t*)P8, (const bf16_t*)(ws + WS_NT), nullptr, nullptr};
            pg8::BatchOrder S; S.init(T, D, F.G, bx, D, D);
            pg8::EpiBf16 E{Y2, D, 1.f / (pg8::F8_PS * pg8::F8_NS)};
            pg8::gemm_phase<pg8::EpiBf16, pg8::BatchOrder, true, true, false, D, D, D, true>(glds, F.tid, g, S, E);
        }
        SEAM(cbp + 6);
        if (IN(cbp + 7)) REP(cbp + 7) { PHC phase_ln_router(F, X1, Y2, INF(cb + 5), INF(cb + 6), X2, X2_8, INF(3), INF(4), WSI(WS_EIDX), WSF(WS_EWGT), WSI(WS_BCNT)); }
        SEAM(cbp + 7);
        if (IN(cbp + 8)) REP(cbp + 8) { PHC phase_moe_book(F, WSI(WS_EIDX), WSI(WS_BCNT), WSI(WS_TOK), WSI(WS_POS), WSI(WS_TILE)); }
        SEAM(cbp + 8);
        if (IN(cbp + 9)) REP(cbp + 9) { PHC const int* tile_e = WSI(WS_TILE); const int* tok = WSI(WS_TOK);
            const int ntiles = __builtin_amdgcn_readfirstlane(tile_e[NTILE]);
            pg8::Gemm g{(const bf16_t*)X2_8, WBl + WL_GU, tok, (LAS int*)(F.lds + 131072)};
            pg8::MoeOrder S; S.init(ntiles, tile_e, F.G, bx, D, D);
            pg8::EpiGU8 E{(unsigned char*)HS};
            pg8::gemm_phase<pg8::EpiGU8, pg8::MoeOrder, true, true, true, D, D, D, true>(glds, F.tid, g, S, E);
        }
        SEAM(cbp + 9);
        if (IN(cbp + 10)) REP(cbp + 10) { PHC const int* tile_e = WSI(WS_TILE);
            const int ntiles = __builtin_amdgcn_readfirstlane(tile_e[NTILE]);
            pg8::Gemm g{HS, WBl + WL_DN, nullptr, nullptr};
            pg8::MoeOrder S; S.init(ntiles, tile_e, F.G, bx, DE, DE);
            pg8::EpiBf16 E{DS, D, 1.f / (pg8::F8_HS * pg8::F8_WS)};
            pg8::gemm_phase<pg8::EpiBf16, pg8::MoeOrder, true, true, false, DE, DE, DE, true>(glds, F.tid, g, S, E);
        }
        SEAM(cbp + 10);
        if (IN(cbp + 11)) REP(cbp + 11) { PHC phase_ln_moe(F, X2, DS, WSI(WS_POS), WSF(WS_EWGT), INF(cb + 10), INF(cb + 11), X3, L == 1 ? ka->out : nullptr, L == 0 ? (unsigned char*)RB : nullptr); }
        SEAM(cbp + 11);
    }
#undef GEMM_STD
#undef IN
#undef SEAM
#undef INF
#undef PH
#undef PHC
#undef WSI
#undef WSF
}
}
using namespace nv;
extern "C" void kernel_launch(void* const* d_in, const int* in_sizes, int n_in, void* d_out, int out_size, void* d_ws, size_t ws_size, hipStream_t stream) {
    (void)in_sizes; (void)out_size;
    if (ws_size < WS_END || n_in != 40) return;
    static int grid = 0;
    if (grid == 0) {
        int dev = 0, cus = 0;
        if (hipGetDevice(&dev) != hipSuccess || hipDeviceGetAttribute(&cus, hipDeviceAttributeMultiprocessorCount, dev) != hipSuccess) { grid = -1; return; }
        if (hipFuncSetAttribute((const void*)mk::mega, hipFuncAttributeMaxDynamicSharedMemorySize, mk::LDS_BYTES) != hipSuccess) { grid = -1; return; }
        int per_cu = 0;
        if (hipOccupancyMaxActiveBlocksPerMultiprocessor(&per_cu, (const void*)mk::mega, mk::NTHREADS, mk::LDS_BYTES) != hipSuccess || per_cu < 1) { (void)hipGetLastError(); }
        grid = cus;
    }
    if (grid < 0) return;
    unsigned char* ws = (unsigned char*)d_ws;
    (void)hipMemsetAsync(ws + WS_CTL, 0, 512 * 1024, stream);
    mk::Args a{};
    for (int i = 0; i < 40; ++i) a.in[i] = d_in[i];
    a.out = (float*)d_out; a.ws = ws;
    for (int j = 0; j < 8; ++j) a.inv.f[j] = (float)pow(500000.0, -(double)((float)j * 2.0f / 16.0f));
    a.ph_lo = 0; a.ph_hi = mk::NPHASE;
    hipLaunchKernelGGL(mk::mega, dim3(grid), dim3(mk::NTHREADS), mk::LDS_BYTES, stream, a);
}
```

```cpp
#include <hip/hip_runtime.h>
#include <stdint.h>
#include <math.h>

typedef unsigned short bf16_t;

namespace nv {
constexpr int B = 4, S = 8192, T = B * S, D = 1024;
constexpr int NIN0 = 1792;
constexpr int MEM = 256, XH = 4, XHD = 256;
constexpr int NE = 16, DE = 512;
constexpr int MPAD = 65536 + 16 * 256;
constexpr int NTILE = MPAD / 256;
constexpr float ALPHA = 1.4142135623730951f;
constexpr float LN_EPS = 1e-5f;
constexpr float QSCALE = 0.0625f * 1.4426950408889634f;
constexpr float ASCALE = 0.125f * 1.4426950408889634f;

constexpr size_t MiB = 1u << 20;
constexpr size_t WS_CTL = 0;
constexpr size_t WS_ROPE = 2 * MiB;
constexpr size_t WS_EIDX = 4 * MiB;
constexpr size_t WS_EWGT = 5 * MiB;
constexpr size_t WS_POS = 6 * MiB;
constexpr size_t WS_BCNT = 7 * MiB;
constexpr size_t WS_TILE = 7 * MiB + 65536;
constexpr size_t WS_TOK = 7 * MiB + 131072;
constexpr size_t WS_MEMKV = 8 * MiB;
constexpr size_t WS_MEMB = 20 * MiB;
constexpr size_t WS_WB = 24 * MiB;
constexpr size_t WS_A = 152 * MiB, WS_B = 220 * MiB, WS_C = 288 * MiB, WS_D = 356 * MiB;
constexpr size_t WS_MT = 492 * MiB;
constexpr size_t WS_NT = 500 * MiB;
constexpr size_t WS_END = 508 * MiB;
constexpr size_t WB_IN0 = 0;
constexpr size_t WB_OUT0 = WB_IN0 + (size_t)1792 * 1024;
constexpr size_t WB_IN1 = WB_OUT0 + (size_t)1024 * 1024;
constexpr size_t WB_POOL = WB_IN1 + (size_t)1024 * 1024;
constexpr size_t WB_OUT1 = WB_POOL + (size_t)1024 * 256;
constexpr size_t WB_WEFF = WB_OUT1 + (size_t)1024 * 1024;
constexpr size_t WB_SGUW = WB_WEFF + (size_t)1024 * 1024;
constexpr size_t WB_LAYER = WB_SGUW + (size_t)8 * 128 * 128;
constexpr size_t WL_XQ = 0;
constexpr size_t WL_XKV = WL_XQ + (size_t)1024 * 1024;
constexpr size_t WL_XO = WL_XKV + (size_t)2048 * 1024;
constexpr size_t WL_GU = WL_XO + (size_t)1024 * 1024;
constexpr size_t WL_DN = WL_GU + (size_t)16 * 1024 * 1024;
constexpr size_t WL_SIZE = WL_DN + (size_t)16 * 1024 * 512;
static_assert((WB_LAYER + 2 * WL_SIZE) * 2 <= 128 * MiB, "bf16 weight region");

__device__ __forceinline__ float bf2f(bf16_t v) { return __uint_as_float((unsigned)v << 16); }
__device__ __forceinline__ bf16_t f2bf(float f) { unsigned u = __float_as_uint(f); return (bf16_t)((u + 0x7fffu + ((u >> 16) & 1u)) >> 16); }
__device__ __forceinline__ float gelu_tanh(float x) { const float u = 0.7978845608028654f * (x + 0.044715f * x * x * x); const float e = __expf(2.f * u); const float th = 1.f - 2.f / (e + 1.f); return 0.5f * x * (1.f + th); }
__device__ __forceinline__ float silu(float x) { return x / (1.f + __expf(-x)); }
template <int M> __device__ __forceinline__ float swz_xor(float v) { return __int_as_float(__builtin_amdgcn_ds_swizzle(__float_as_int(v), (M << 10) | 0x1f)); }
__device__ __forceinline__ float wave_sum(float v) {
    v += swz_xor<1>(v); v += swz_xor<2>(v); v += swz_xor<4>(v); v += swz_xor<8>(v); v += swz_xor<16>(v);
    const auto r = __builtin_amdgcn_permlane32_swap(__float_as_uint(v), __float_as_uint(v), false, false);
    return __uint_as_float(r[0]) + __uint_as_float(r[1]);
}
__device__ __forceinline__ float wave_max(float v) {
    v = fmaxf(v, swz_xor<1>(v)); v = fmaxf(v, swz_xor<2>(v)); v = fmaxf(v, swz_xor<4>(v)); v = fmaxf(v, swz_xor<8>(v)); v = fmaxf(v, swz_xor<16>(v));
    const auto r = __builtin_amdgcn_permlane32_swap(__float_as_uint(v), __float_as_uint(v), false, false);
    return fmaxf(__uint_as_float(r[0]), __uint_as_float(r[1]));
}
}

namespace pg8 {
#define PG8_LAS __attribute__((address_space(3)))
typedef short bf16x8 __attribute__((ext_vector_type(8)));
typedef float f32x4 __attribute__((ext_vector_type(4)));
typedef float f32x2 __attribute__((ext_vector_type(2)));
typedef unsigned u32x4 __attribute__((ext_vector_type(4)));
typedef unsigned u32x2 __attribute__((ext_vector_type(2)));
typedef int i32x8 __attribute__((ext_vector_type(8)));
constexpr int BM = 256, BK = 64, HALF = 128, HTB = HALF * BK * 2  , STAGE_BYTES = 8 * HTB, NXCD = 8, WGM = 8;

__host__ __device__ __forceinline__ int lds_byte(int r, int c) { const int st = (r >> 4) * 2 + (c >> 5), rr = r & 15, cc = c & 31, ob = rr * 64 + cc * 2; return st * 1024 + (ob ^ (((ob >> 9) & 1) << 5)); }
__host__ __device__ __forceinline__ void stage_rc(int b, int& R, int& C) { const int st = b / 1024, sb = b % 1024, swz = sb ^ (((sb >> 9) & 1) << 5); R = (st >> 1) * 16 + swz / 64; C = (st & 1) * 32 + (swz % 64) / 2; }
__host__ __device__ __forceinline__ int perm32(int rho) { const int n = rho >> 4, i = rho & 15; return 8 * (i >> 2) + 4 * n + (i & 3); }

struct Unit { int pm, pn, ao, bo; };
struct Gemm { const bf16_t* A; const bf16_t* Bt; const int* arow; PG8_LAS int* ltab; };

template <bool BATCHED = false>
struct StaticOrderT {
    int nM, nN, nwg, G, c, lda, ldb, apn;
    __device__ void init(int M, int N, int G_, int c_, int lda_, int ldb_, int apn_ = 0) { nM = M / BM; nN = N / BM; nwg = nM * nN; G = G_; c = c_; lda = lda_; ldb = ldb_; apn = apn_; }
    __device__ bool next(int i, Unit& u) const {
        const long L = (long)i * G + c; if (L >= nwg) return false;
        int wgid = (int)L; { const int q = nwg / NXCD, r = nwg % NXCD, xcd = wgid % NXCD, off = wgid / NXCD; wgid = (xcd < r ? xcd * (q + 1) : r * (q + 1) + (xcd - r) * q) + off; }
        const int nig = WGM * nN, gid = wgid / nig, fm = gid * WGM, gsz = (nM - fm) < WGM ? (nM - fm) : WGM;
        u.pm = fm + ((wgid % nig) % gsz); u.pn = (wgid % nig) / gsz;
        u.ao = u.pm * BM * lda + u.pn * apn; u.bo = (BATCHED ? ((u.pm >> 5) * 4 + u.pn) : u.pn) * BM * ldb; return true;
    }
};
typedef StaticOrderT<false> StaticOrder;
typedef StaticOrderT<true> BatchOrder;
struct MoeOrder {
    int nM, nwg, G, c, lda, ldb; const int* tile_e;
    __device__ void init(int ntiles, const int* te, int G_, int c_, int lda_, int ldb_) { nM = ntiles; nwg = nM * 4; G = G_; c = c_; tile_e = te; lda = lda_; ldb = ldb_; }
    __device__ bool next(int i, Unit& u) const {
        const long L = (long)i * G + c; if (L >= nwg) return false;
        int wgid = (int)L; { const int q = nwg / NXCD, r = nwg % NXCD, xcd = wgid % NXCD, off = wgid / NXCD; wgid = (xcd < r ? xcd * (q + 1) : r * (q + 1) + (xcd - r) * q) + off; }
        const int nig = WGM * 4, gid = wgid / nig, fm = gid * WGM, gsz = (nM - fm) < WGM ? (nM - fm) : WGM;
        u.pm = fm + ((wgid % nig) % gsz); u.pn = (wgid % nig) / gsz;
        const int e = __builtin_amdgcn_readfirstlane(tile_e[u.pm]); u.ao = u.pm * BM * lda; u.bo = (e * 4 + u.pn) * BM * ldb; return true;
    }
};
template <int KIND>
struct SetupOrder {
    int idx, n;
    __device__ void init(int c, int c0, int n_) { idx = c - c0; n = n_; }
    __device__ bool next(int i, Unit& u) const {
        if (i != 0 || idx < 0 || idx >= n) return false;
        const int x = idx >> 4, y = (idx >> 2) & 3, z = idx & 3;
        if (KIND == 0) { u.pm = x * 4 + y; u.pn = z; u.ao = (x * 256) * 2048 + y * 256; u.bo = z * 256 * 1024 + y * 256; }
        if (KIND == 1) { u.pm = x * 4 + y; u.pn = z; u.ao = y * 256 * 1024 + z * 256; u.bo = (x * 256) * 2048 + 1024 + z * 256; }
        if (KIND == 2) { u.pm = y; u.pn = z; u.ao = y * 256 * 1024 + z * 256; u.bo = z * 256 * 256; }
        return true;
    }
};

__device__ __forceinline__ int fresh_lane() { unsigned m = ~0u; asm volatile("" : "+s"(m)); return (int)__builtin_amdgcn_mbcnt_hi(m, __builtin_amdgcn_mbcnt_lo(m, 0u)); }
__device__ __forceinline__ unsigned cvt_pk_bf16(float lo, float hi) { unsigned r; asm volatile("v_cvt_pk_bf16_f32 %0, %1, %2" : "=v"(r) : "v"(lo), "v"(hi)); return r; }


template <class Epi, class Sched, bool ALIGN_EPI, bool SP2, bool GATHER, int LDA, int LDB, int KK, bool FP8 = false>
__device__ __forceinline__ void gemm_phase(PG8_LAS unsigned char* lds, int tid_in, const Gemm g, const Sched& S, const Epi& E) {
    int tid_ = tid_in; asm volatile("" : "+v"(tid_));
    const int tid = tid_, wid = __builtin_amdgcn_readfirstlane(tid >> 6), lane = tid & 63, wr = wid >> 2, wc = wid & 3, fr = lane & 15, fq = lane >> 4;
    constexpr int ELT = FP8 ? 1 : 2, K = KK, nt = K * ELT / (BK * 2), lda = LDA * ELT, ldb = LDB * ELT; (void)K;
    unsigned voffA[2], voffB[2];
#pragma unroll
    for (int i = 0; i < 2; ++i) { int R, C; stage_rc(tid * 16 + i * 8192, R, C); const int Rb = Epi::PERM ? ((R & ~31) + perm32(R & 31)) : R;
        voffA[i] = GATHER ? (unsigned)C * 2u : (unsigned)(R * lda + C * 2); voffB[i] = (unsigned)(Rb * ldb + C * 2); }
    const size_t kstep = (size_t)(BK * 2);
    const size_t hstepA = GATHER ? 0 : (size_t)HALF * lda, hstepB = (size_t)HALF * ldb;
    const unsigned ldsw = (unsigned)wid * 1024u, ldsbase = (unsigned)(size_t)lds;
    const int aoff = lds_byte(wr * 64 + fr, fq * 8), boff = lds_byte(wc * 32 + fr, fq * 8);
    const PG8_LAS unsigned char* ldsA = lds + aoff; const PG8_LAS unsigned char* ldsB = lds + 4 * HTB + boff; asm volatile("" : "+v"(ldsA), "+v"(ldsB));
    unsigned cg[2][2];
#define PG8_SA(b, h) (((b) * 2 + (h)) * HTB)
#define PG8_SB(b, h) ((4 + (b) * 2 + (h)) * HTB)
#define PG8_GLDS(sbase, voff32, ldsaddr) asm volatile("s_mov_b32 m0, %2\n\ts_nop 0\n\tglobal_load_lds_dwordx4 %0, %1" :: "v"(voff32), "s"(sbase), "s"(ldsaddr) : "memory", "m0")
#define PG8_STAGE(bufoff, gbase, voff) do { const char* _sb = (const char*)(gbase); _Pragma("unroll") for (int _i = 0; _i < 2; ++_i) \
        PG8_GLDS(_sb + (size_t)_i * 64 * ldb, (voff)[0], (unsigned)(ldsbase + (bufoff) + ldsw + _i * 8192)); } while (0)
#define PG8_STAGE_A(bufoff, abase, h, GO) do { const char* _sb = GATHER ? (const char*)(abase) : (const char*)(abase) + ((h) ? hstepA : (size_t)0); _Pragma("unroll") for (int _i = 0; _i < 2; ++_i) { \
        if constexpr (GATHER) PG8_GLDS(_sb, GO[h][_i], (unsigned)(ldsbase + (bufoff) + ldsw + _i * 8192)); \
        else PG8_GLDS(_sb + (size_t)_i * 64 * lda, voffA[0], (unsigned)(ldsbase + (bufoff) + ldsw + _i * 8192)); } } while (0)
#define PG8_GLOAD(dst, pm_) do { const int _t = wid * 64 + fresh_lane(); int rowA_[2]; unsigned colA_[2]; _Pragma("unroll") for (int _i = 0; _i < 2; ++_i) { int _R, _C; stage_rc(_t * 16 + _i * 8192, _R, _C); rowA_[_i] = _R; colA_[_i] = (unsigned)_C * 2u; }   \
        _Pragma("unroll") for (int _h = 0; _h < 2; ++_h) _Pragma("unroll") for (int _i = 0; _i < 2; ++_i) \
        dst[_h][_i] = (unsigned)g.ltab[(pm_) * BM + _h * HALF + rowA_[_i]] * (unsigned)lda + colA_[_i]; } while (0)
#define PG8_GSWITCH do { if constexpr (GATHER) { if (last && has_next) { PG8_GLOAD(cg, ui + 1); } } } while (0)
#define PG8_LDA(dst, b, h) do { _Pragma("unroll") for (int m = 0; m < 4; ++m) { if constexpr (FP8) { typedef int i32x4_ __attribute__((ext_vector_type(4))); \
        dst##8[m] = __builtin_shufflevector(*(const PG8_LAS i32x4_*)(ldsA + PG8_SA(b, h) + m * 2048), *(const PG8_LAS i32x4_*)(ldsA + PG8_SA(b, h) + m * 2048 + 1024), 0, 1, 2, 3, 4, 5, 6, 7); } \
        else { _Pragma("unroll") for (int k = 0; k < 2; ++k) dst[m][k] = *(const PG8_LAS bf16x8*)(ldsA + PG8_SA(b, h) + m * 2048 + k * 1024); } } } while (0)
#define PG8_LDB(dst, b, h) do { _Pragma("unroll") for (int n = 0; n < 2; ++n) { if constexpr (FP8) { typedef int i32x4_ __attribute__((ext_vector_type(4))); \
        dst##8[n] = __builtin_shufflevector(*(const PG8_LAS i32x4_*)(ldsB + PG8_SA(b, h) + n * 2048), *(const PG8_LAS i32x4_*)(ldsB + PG8_SA(b, h) + n * 2048 + 1024), 0, 1, 2, 3, 4, 5, 6, 7); } \
        else { _Pragma("unroll") for (int k = 0; k < 2; ++k) dst[n][k] = *(const PG8_LAS bf16x8*)(ldsB + PG8_SA(b, h) + n * 2048 + k * 1024); } } } while (0)
#define PG8_MMA(ai, bj, At, Bt) do { __builtin_amdgcn_s_setprio(1); _Pragma("unroll") for (int m = 0; m < 4; ++m) _Pragma("unroll") for (int n = 0; n < 2; ++n) { \
        if constexpr (FP8) acc[ai][bj][m][n] = __builtin_amdgcn_mfma_scale_f32_16x16x128_f8f6f4(Bt##8[n], At##8[m], acc[ai][bj][m][n], 0, 0, 0, 0x7f7f7f7f, 0, 0x7f7f7f7f); \
        else { _Pragma("unroll") for (int k = 0; k < 2; ++k) acc[ai][bj][m][n] = __builtin_amdgcn_mfma_f32_16x16x32_bf16(Bt[n][k], At[m][k], acc[ai][bj][m][n], 0, 0, 0); } } \
        __builtin_amdgcn_s_setprio(0); } while (0)
#define PG8_WAIT_V(n) asm volatile("s_waitcnt vmcnt(" #n ")" ::: "memory")
#define PG8_WAIT_L(n) asm volatile("s_waitcnt lgkmcnt(" #n ")" ::: "memory")
#define PG8_BAR __builtin_amdgcn_s_barrier()
#define PG8_SCHED __builtin_amdgcn_sched_barrier(0)
    Unit cur, nxt; int ui = 0;
    if (!S.next(0, cur)) return;
    f32x4 acc[2][2][4][2];
#pragma unroll
    for (int a = 0; a < 2; ++a)
#pragma unroll
        for (int b = 0; b < 2; ++b)
#pragma unroll
            for (int m = 0; m < 4; ++m)
#pragma unroll
                for (int n = 0; n < 2; ++n) acc[a][b][m][n] = (f32x4){0.f, 0.f, 0.f, 0.f};
    bf16x8 At[4][2], B0[2][2], B1[2][2]; i32x8 At8[4], B08[2], B18[2];
    const char* cA = GATHER ? (const char*)g.A : (const char*)g.A + (size_t)cur.ao * ELT; const char* cB = (const char*)g.Bt + (size_t)cur.bo * ELT;
    if constexpr (GATHER) {
        for (int i = 0; i < 8; ++i) { Unit u_; if (!S.next(i, u_)) break; if (tid < BM) g.ltab[i * BM + tid] = g.arow[u_.pm * BM + tid]; }
        asm volatile("s_waitcnt vmcnt(0) lgkmcnt(0)" ::: "memory"); PG8_BAR; asm volatile("" ::: "memory");
        PG8_GLOAD(cg, 0); }
    if constexpr (SP2) {
        PG8_STAGE(PG8_SB(0, 0), cB, voffB); PG8_STAGE(PG8_SB(0, 1), cB + hstepB, voffB); PG8_STAGE_A(PG8_SA(0, 0), cA, 0, cg); PG8_STAGE_A(PG8_SA(0, 1), cA, 1, cg);
        if (wr == 1) PG8_BAR;
        PG8_WAIT_V(2); PG8_BAR;
        PG8_STAGE(PG8_SB(1, 0), cB + kstep, voffB); PG8_STAGE_A(PG8_SA(1, 0), cA + kstep, 0, cg); PG8_STAGE(PG8_SB(1, 1), cB + hstepB + kstep, voffB);
        PG8_WAIT_V(6); PG8_BAR;
    } else {
        PG8_STAGE(PG8_SB(0, 0), cB, voffB); PG8_STAGE_A(PG8_SA(0, 0), cA, 0, cg); PG8_STAGE(PG8_SB(0, 1), cB + hstepB, voffB); PG8_STAGE_A(PG8_SA(0, 1), cA, 1, cg);
        if (wr == 1) PG8_BAR;
        PG8_WAIT_V(4); PG8_BAR;
        PG8_STAGE(PG8_SB(1, 0), cB + kstep, voffB); PG8_STAGE_A(PG8_SA(1, 0), cA + kstep, 0, cg); PG8_STAGE(PG8_SB(1, 1), cB + hstepB + kstep, voffB);
        PG8_WAIT_V(6); PG8_BAR;
    }
    for (;;) {
        const bool has_next = S.next(ui + 1, nxt);
        const char* nA = GATHER ? (const char*)g.A : (has_next ? (const char*)g.A + (size_t)nxt.ao * ELT : cA);
        const char* nB = has_next ? (const char*)g.Bt + (size_t)nxt.bo * ELT : cB;
#pragma unroll 1
        for (int t = 0; t < nt; t += 2) {
            const bool last = (t == nt - 2);
            const char* a1 = cA + (size_t)(t + 1) * kstep;
            const char* a2 = last ? nA : cA + (size_t)(t + 2) * kstep; const char* b2 = last ? nB : cB + (size_t)(t + 2) * kstep;
            const char* a3 = a2 + kstep; const char* b3 = b2 + kstep;
            if constexpr (SP2) {
            PG8_LDB(B0, 0, 0); PG8_LDB(B1, 0, 1); PG8_SCHED; PG8_LDA(At, 0, 0); PG8_STAGE_A(PG8_SA(1, 1), a1, 1, cg); PG8_GSWITCH;
            PG8_WAIT_V(8); PG8_WAIT_L(0); PG8_BAR; PG8_MMA(0, 0, At, B0); PG8_MMA(0, 1, At, B1); PG8_BAR; PG8_SCHED;
            PG8_LDA(At, 0, 1); PG8_STAGE(PG8_SB(0, 0), b2, voffB); PG8_STAGE(PG8_SB(0, 1), b2 + hstepB, voffB); PG8_STAGE_A(PG8_SA(0, 0), a2, 0, cg);
            PG8_WAIT_V(8); PG8_WAIT_L(0); PG8_BAR; PG8_MMA(1, 0, At, B0); PG8_MMA(1, 1, At, B1); PG8_BAR; PG8_SCHED;
            PG8_LDB(B0, 1, 0); PG8_LDB(B1, 1, 1); PG8_SCHED; PG8_LDA(At, 1, 0); PG8_STAGE_A(PG8_SA(0, 1), a2, 1, cg);
            PG8_WAIT_V(8); PG8_WAIT_L(0); PG8_BAR; PG8_MMA(0, 0, At, B0); PG8_MMA(0, 1, At, B1); PG8_BAR; PG8_SCHED;
            PG8_LDA(At, 1, 1); PG8_STAGE(PG8_SB(1, 0), b3, voffB); PG8_STAGE(PG8_SB(1, 1), b3 + hstepB, voffB); PG8_STAGE_A(PG8_SA(1, 0), a3, 0, cg);
            PG8_WAIT_V(8); PG8_WAIT_L(0); PG8_BAR; PG8_MMA(1, 0, At, B0); PG8_MMA(1, 1, At, B1); PG8_BAR; PG8_SCHED;
            } else {
            PG8_LDB(B0, 0, 0); PG8_SCHED; PG8_LDA(At, 0, 0); PG8_STAGE_A(PG8_SA(1, 1), a1, 1, cg); PG8_GSWITCH;
            PG8_WAIT_L(8); PG8_BAR; PG8_WAIT_L(0); PG8_MMA(0, 0, At, B0); PG8_BAR; PG8_SCHED;
            PG8_LDB(B1, 0, 1); PG8_STAGE(PG8_SB(0, 0), b2, voffB);
            PG8_BAR; PG8_WAIT_L(0); PG8_MMA(0, 1, At, B1); PG8_BAR;
            PG8_LDA(At, 0, 1); PG8_STAGE_A(PG8_SA(0, 0), a2, 0, cg);
            PG8_BAR; PG8_WAIT_L(0); PG8_MMA(1, 0, At, B0); PG8_BAR; PG8_SCHED;
            PG8_STAGE(PG8_SB(0, 1), b2 + hstepB, voffB);
            PG8_WAIT_V(6); PG8_BAR; PG8_MMA(1, 1, At, B1); PG8_BAR;
            PG8_LDB(B0, 1, 0); PG8_SCHED; PG8_LDA(At, 1, 0); PG8_STAGE_A(PG8_SA(0, 1), a2, 1, cg);
            PG8_WAIT_L(8); PG8_BAR; PG8_WAIT_L(0); PG8_MMA(0, 0, At, B0); PG8_BAR; PG8_SCHED;
            PG8_LDB(B1, 1, 1); PG8_STAGE(PG8_SB(1, 0), b3, voffB);
            PG8_BAR; PG8_WAIT_L(0); PG8_MMA(0, 1, At, B1); PG8_BAR;
            PG8_LDA(At, 1, 1); PG8_STAGE_A(PG8_SA(1, 0), a3, 0, cg);
            PG8_BAR; PG8_WAIT_L(0); PG8_MMA(1, 0, At, B0); PG8_BAR; PG8_SCHED;
            PG8_STAGE(PG8_SB(1, 1), b3 + hstepB, voffB);
            PG8_WAIT_V(6); PG8_BAR; PG8_MMA(1, 1, At, B1); PG8_BAR;
            }
        }
        if constexpr (ALIGN_EPI) { if (wr == 0) PG8_BAR; }
        { const int _l = fresh_lane(); E(acc, cur, wr, wc, _l & 15, _l >> 4); }
        if (!has_next) break;
#pragma unroll
        for (int a = 0; a < 2; ++a)
#pragma unroll
            for (int b = 0; b < 2; ++b)
#pragma unroll
                for (int m = 0; m < 4; ++m)
#pragma unroll
                    for (int n = 0; n < 2; ++n) acc[a][b][m][n] = (f32x4){0.f, 0.f, 0.f, 0.f};
        cur = nxt; cA = nA; cB = nB; ++ui;
        if constexpr (ALIGN_EPI) { if (wr == 1) PG8_BAR; }
    }
    PG8_WAIT_V(0);
    if constexpr (!ALIGN_EPI) { if (wr == 0) PG8_BAR; }
    PG8_BAR;
#undef PG8_SA
#undef PG8_SB
#undef PG8_STAGE
#undef PG8_GLDS
#undef PG8_STAGE_A
#undef PG8_GLOAD
#undef PG8_GSWITCH
#undef PG8_LDA
#undef PG8_LDB
#undef PG8_MMA
#undef PG8_WAIT_V
#undef PG8_WAIT_L
#undef PG8_BAR
#undef PG8_SCHED
}
}
namespace pg8 {

__device__ __forceinline__ float fast_sigmoid_mul(float x, float z) { return x * __builtin_amdgcn_rcpf(1.f + __builtin_amdgcn_exp2f(-1.4426950408889634f * z)); }
__device__ __forceinline__ float gelu_t(float x) { const float u = 0.7978845608028654f * (x + 0.044715f * x * x * x); return fast_sigmoid_mul(x, 2.f * u); }
__device__ __forceinline__ float silu_f(float x) { return fast_sigmoid_mul(x, x); }
__device__ __forceinline__ u32x4 pack8(const f32x4 v0, const f32x4 v1) { u32x4 w; w.x = cvt_pk_bf16(v0[0], v0[1]); w.y = cvt_pk_bf16(v0[2], v0[3]); w.z = cvt_pk_bf16(v1[0], v1[1]); w.w = cvt_pk_bf16(v1[2], v1[3]); return w; }

struct EpiBf16 {
    static constexpr bool PERM = true;
    bf16_t* O; int ldo; float scale;
    __device__ __forceinline__ void operator()(f32x4 (&acc)[2][2][4][2], const Unit& u, int wr, int wc, int fr, int fq) const {
        const int row0 = u.pm * BM + wr * 64 + fr, col0 = u.pn * BM + wc * 32 + 8 * fq;
#pragma unroll
        for (int ai = 0; ai < 2; ++ai)
#pragma unroll
            for (int m = 0; m < 4; ++m) { bf16_t* rowp = O + (size_t)(row0 + ai * HALF + m * 16) * ldo + col0;
#pragma unroll
                for (int bj = 0; bj < 2; ++bj) *(u32x4*)(rowp + bj * HALF) = pack8(acc[ai][bj][m][0] * scale, acc[ai][bj][m][1] * scale); }
    }
};
__device__ __forceinline__ unsigned pk4_fp8(float a, float b, float c, float d) {
    a = __builtin_amdgcn_fmed3f(a, -448.f, 448.f); b = __builtin_amdgcn_fmed3f(b, -448.f, 448.f); c = __builtin_amdgcn_fmed3f(c, -448.f, 448.f); d = __builtin_amdgcn_fmed3f(d, -448.f, 448.f);
    unsigned p = 0u; p = (unsigned)__builtin_amdgcn_cvt_pk_fp8_f32(a, b, (int)p, false); p = (unsigned)__builtin_amdgcn_cvt_pk_fp8_f32(c, d, (int)p, true); return p;
}
constexpr float F8_XS = 16.f, F8_WS = 64.f, F8_HS = 8.f;
struct EpiResBf16 {
    static constexpr bool PERM = true;
    bf16_t* O; float scale; const bf16_t* R;
    __device__ __forceinline__ void operator()(f32x4 (&acc)[2][2][4][2], const Unit& u, int wr, int wc, int fr, int fq) const {
        const int row0 = u.pm * BM + wr * 64 + fr, col0 = u.pn * BM + wc * 32 + 8 * fq;
#pragma unroll
        for (int ai = 0; ai < 2; ++ai)
#pragma unroll
            for (int m = 0; m < 4; ++m) { const size_t off = (size_t)(row0 + ai * HALF + m * 16) * nv::D + col0;
#pragma unroll
                for (int bj = 0; bj < 2; ++bj) { const u32x4 rr = *(const u32x4*)(R + off + bj * HALF);
                    f32x4 r0, r1; r0[0] = __uint_as_float(rr.x << 16); r0[1] = __uint_as_float(rr.x & 0xffff0000u); r0[2] = __uint_as_float(rr.y << 16); r0[3] = __uint_as_float(rr.y & 0xffff0000u);
                    r1[0] = __uint_as_float(rr.z << 16); r1[1] = __uint_as_float(rr.z & 0xffff0000u); r1[2] = __uint_as_float(rr.w << 16); r1[3] = __uint_as_float(rr.w & 0xffff0000u);
                    *(u32x4*)(O + off + bj * HALF) = pack8(r0 * nv::ALPHA + acc[ai][bj][m][0] * scale, r1 * nv::ALPHA + acc[ai][bj][m][1] * scale); }
                asm volatile("" ::: "memory"); }
    }
};
struct EpiF8 {
    static constexpr bool PERM = true;
    unsigned char* O; int ldo; float scale;
    __device__ __forceinline__ void operator()(f32x4 (&acc)[2][2][4][2], const Unit& u, int wr, int wc, int fr, int fq) const {
        const int row0 = u.pm * BM + wr * 64 + fr, col0 = u.pn * BM + wc * 32 + 8 * fq;
#pragma unroll
        for (int ai = 0; ai < 2; ++ai)
#pragma unroll
            for (int m = 0; m < 4; ++m) { unsigned char* rowp = O + (size_t)(row0 + ai * HALF + m * 16) * ldo + col0;
#pragma unroll
                for (int bj = 0; bj < 2; ++bj) { const f32x4 v0 = acc[ai][bj][m][0] * scale, v1 = acc[ai][bj][m][1] * scale;
                    u32x2 w; w.x = pk4_fp8(v0[0], v0[1], v0[2], v0[3]); w.y = pk4_fp8(v1[0], v1[1], v1[2], v1[3]); *(u32x2*)(rowp + bj * HALF) = w; } }
    }
};
constexpr float F8_MS = 64.f, F8_PS = 256.f, F8_NS = 16.f;
struct EpiGU8 {
    static constexpr bool PERM = true;
    unsigned char* HS8;
    __device__ __forceinline__ void operator()(f32x4 (&acc)[2][2][4][2], const Unit& u, int wr, int wc, int fr, int fq) const {
        const int row0 = u.pm * BM + wr * 64 + fr, col0 = u.pn * HALF + wc * 32 + 8 * fq;
        constexpr float s = 1.f / (F8_XS * F8_WS);
#pragma unroll
        for (int ai = 0; ai < 2; ++ai)
#pragma unroll
            for (int m = 0; m < 4; ++m) { unsigned char* rowp = HS8 + (size_t)(row0 + ai * HALF + m * 16) * nv::DE + col0;
                f32x4 h0, h1;
#pragma unroll
                for (int j = 0; j < 4; ++j) { h0[j] = silu_f(acc[ai][0][m][0][j] * s) * (acc[ai][1][m][0][j] * (s * F8_HS)); h1[j] = silu_f(acc[ai][0][m][1][j] * s) * (acc[ai][1][m][1][j] * (s * F8_HS)); }
                u32x2 w; w.x = pk4_fp8(h0[0], h0[1], h0[2], h0[3]); w.y = pk4_fp8(h1[0], h1[1], h1[2], h1[3]); *(u32x2*)rowp = w; }
    }
};
struct EpiGU {
    static constexpr bool PERM = true;
    bf16_t* HS;
    __device__ __forceinline__ void operator()(f32x4 (&acc)[2][2][4][2], const Unit& u, int wr, int wc, int fr, int fq) const {
        const int row0 = u.pm * BM + wr * 64 + fr, col0 = u.pn * HALF + wc * 32 + 8 * fq;
#pragma unroll
        for (int ai = 0; ai < 2; ++ai)
#pragma unroll
            for (int m = 0; m < 4; ++m) { bf16_t* rowp = HS + (size_t)(row0 + ai * HALF + m * 16) * nv::DE + col0;
                f32x4 h0, h1;
#pragma unroll
                for (int j = 0; j < 4; ++j) { h0[j] = silu_f(acc[ai][0][m][0][j]) * acc[ai][1][m][0][j]; h1[j] = silu_f(acc[ai][0][m][1][j]) * acc[ai][1][m][1][j]; }
                *(u32x4*)rowp = pack8(h0, h1); }
    }
};
template <bool OUT8>
struct EpiSoftmaxT {
    static constexpr bool PERM = true;
    void* O; PG8_LAS float* tbl; float in_scale;
    __device__ __forceinline__ void operator()(f32x4 (&acc)[2][2][4][2], const Unit& u, int wr, int wc, int fr, int fq) const {
        const int row0 = u.pm * BM + wr * 64 + fr, col0 = u.pn * BM + wc * 32 + 8 * fq;
#pragma unroll
        for (int ai = 0; ai < 2; ++ai)
#pragma unroll
            for (int m = 0; m < 4; ++m) { float mx = -INFINITY;
#pragma unroll
                for (int bj = 0; bj < 2; ++bj)
#pragma unroll
                    for (int n = 0; n < 2; ++n)
#pragma unroll
                        for (int j = 0; j < 4; ++j) { acc[ai][bj][m][n][j] *= in_scale; mx = fmaxf(mx, acc[ai][bj][m][n][j]); }
                mx = fmaxf(mx, nv::swz_xor<16>(mx));
                { const auto r = __builtin_amdgcn_permlane32_swap(__float_as_uint(mx), __float_as_uint(mx), false, false); mx = fmaxf(__uint_as_float(r[0]), __uint_as_float(r[1])); }
                if (fq == 0) tbl[(ai * HALF + wr * 64 + m * 16 + fr) * 4 + wc] = mx; }
        asm volatile("s_waitcnt lgkmcnt(0)" ::: "memory"); __builtin_amdgcn_s_barrier(); asm volatile("" ::: "memory");
#pragma unroll
        for (int ai = 0; ai < 2; ++ai)
#pragma unroll
            for (int m = 0; m < 4; ++m) { const f32x4 t4 = *(const PG8_LAS f32x4*)(tbl + (ai * HALF + wr * 64 + m * 16 + fr) * 4);
                const float M = fmaxf(fmaxf(t4[0], t4[1]), fmaxf(t4[2], t4[3])); float s = 0.f;
#pragma unroll
                for (int bj = 0; bj < 2; ++bj)
#pragma unroll
                    for (int n = 0; n < 2; ++n)
#pragma unroll
                        for (int j = 0; j < 4; ++j) { const float p = __builtin_amdgcn_exp2f(acc[ai][bj][m][n][j] - M); acc[ai][bj][m][n][j] = p; s += p; }
                s += nv::swz_xor<16>(s);
                { const auto r = __builtin_amdgcn_permlane32_swap(__float_as_uint(s), __float_as_uint(s), false, false); s = __uint_as_float(r[0]) + __uint_as_float(r[1]); }
                if (fq == 0) tbl[1024 + (ai * HALF + wr * 64 + m * 16 + fr) * 4 + wc] = s; }
        asm volatile("s_waitcnt lgkmcnt(0)" ::: "memory"); __builtin_amdgcn_s_barrier(); asm volatile("" ::: "memory");
#pragma unroll
        for (int ai = 0; ai < 2; ++ai)
#pragma unroll
            for (int m = 0; m < 4; ++m) { const f32x4 t4 = *(const PG8_LAS f32x4*)(tbl + 1024 + (ai * HALF + wr * 64 + m * 16 + fr) * 4);
                const float inv = 1.f / ((t4[0] + t4[1]) + (t4[2] + t4[3]));
                if constexpr (OUT8) { unsigned char* rowp = (unsigned char*)O + (size_t)(row0 + ai * HALF + m * 16) * nv::D + col0; const float s8 = inv * F8_PS;
#pragma unroll
                    for (int bj = 0; bj < 2; ++bj) { const f32x4 v0 = acc[ai][bj][m][0] * s8, v1 = acc[ai][bj][m][1] * s8;
                        u32x2 w; w.x = pk4_fp8(v0[0], v0[1], v0[2], v0[3]); w.y = pk4_fp8(v1[0], v1[1], v1[2], v1[3]); *(u32x2*)(rowp + bj * HALF) = w; } }
                else { bf16_t* rowp = (bf16_t*)O + (size_t)(row0 + ai * HALF + m * 16) * nv::D + col0;
#pragma unroll
                    for (int bj = 0; bj < 2; ++bj) *(u32x4*)(rowp + bj * HALF) = pack8(acc[ai][bj][m][0] * inv, acc[ai][bj][m][1] * inv); } }
    }
};
struct EpiInproj0 {
    static constexpr bool PERM = true;
    bf16_t* O; const float* rope; float in_scale;
    __device__ __forceinline__ void operator()(f32x4 (&acc)[2][2][4][2], const Unit& u, int wr, int wc, int fr, int fq) const {
        const int row0 = u.pm * BM + wr * 64 + fr, col0 = u.pn * BM + wc * 32 + 8 * fq;
#pragma unroll
        for (int ai = 0; ai < 2; ++ai)
#pragma unroll
            for (int bj = 0; bj < 2; ++bj)
#pragma unroll
                for (int m = 0; m < 4; ++m) { acc[ai][bj][m][0] *= in_scale; acc[ai][bj][m][1] *= in_scale; }
        if (u.pn >= 3) {
#pragma unroll
            for (int ai = 0; ai < 2; ++ai)
#pragma unroll
                for (int m = 0; m < 4; ++m) { bf16_t* rowp = O + (size_t)(row0 + ai * HALF + m * 16) * nv::NIN0 + col0;
#pragma unroll
                    for (int bj = 0; bj < 2; ++bj) { f32x4 v0 = acc[ai][bj][m][0], v1 = acc[ai][bj][m][1];
#pragma unroll
                        for (int j = 0; j < 4; ++j) { v0[j] = gelu_t(v0[j]); v1[j] = gelu_t(v1[j]); }
                        *(u32x4*)(rowp + bj * HALF) = pack8(v0, v1); } }
        } else {
            const bool wave_rope = (wc & 1) == 0;
            const float sgn = fq == 0 ? -1.f : 1.f;
#pragma unroll
            for (int ai = 0; ai < 2; ++ai)
#pragma unroll
                for (int m = 0; m < 4; ++m) { const int row = row0 + ai * HALF + m * 16; bf16_t* rowp = O + (size_t)row * nv::NIN0 + col0;
                    f32x4 c0, c1, s0, s1;
                    if (wave_rope) { const float* rp = rope + (size_t)row * 16; c0 = *(const f32x4*)rp; c1 = *(const f32x4*)(rp + 4); s0 = *(const f32x4*)(rp + 8); s1 = *(const f32x4*)(rp + 12); }
#pragma unroll
                    for (int bj = 0; bj < 2; ++bj) { f32x4 v0 = acc[ai][bj][m][0], v1 = acc[ai][bj][m][1];
                        if (wave_rope && (u.pn < 2 || bj == 0)) {
                            f32x4 p0, p1;
#pragma unroll
                            for (int j = 0; j < 4; ++j) { p0[j] = nv::swz_xor<16>(v0[j]); p1[j] = nv::swz_xor<16>(v1[j]); }
                            if (fq < 2) {
#pragma unroll
                                for (int j = 0; j < 4; ++j) { v0[j] = v0[j] * c0[j] + sgn * p0[j] * s0[j]; v1[j] = v1[j] * c1[j] + sgn * p1[j] * s1[j]; } }
                        }
                        *(u32x4*)(rowp + bj * HALF) = pack8(v0, v1); } }
        }
    }
};
}

#define LAS __attribute__((address_space(3)))
#define GAS __attribute__((address_space(1)))
typedef GAS unsigned gu32;
#define RLX_AGENT __ATOMIC_RELAXED, __HIP_MEMORY_SCOPE_AGENT
#define LDS_WAIT() asm volatile("s_waitcnt lgkmcnt(0)" ::: "memory")
#define VM_WAIT() asm volatile("s_waitcnt vmcnt(0)" ::: "memory")

#define XB_TMO      128
#define XB_XCNT(j)  (256  + 64 * (j))
#define XB_XSUB(j)  (1280 + 64 * (j))
#define XB_XGEN(j)  (2304 + 64 * (j))
#define XB_TOP      3328
#define XB_TOPGEN   3392
#define XCD_BAR_WORDS 3456
#define XB_SPIN_CAP (1u << 18)
__device__ __forceinline__ unsigned xb_ld(unsigned* p)              { return __hip_atomic_load(p, __ATOMIC_RELAXED, __HIP_MEMORY_SCOPE_AGENT); }
__device__ __forceinline__ unsigned xb_add(unsigned* p, unsigned v) { return __hip_atomic_fetch_add(p, v, __ATOMIC_RELAXED, __HIP_MEMORY_SCOPE_AGENT); }
__device__ __forceinline__ unsigned xb_xcc_id() { return (unsigned)__builtin_amdgcn_s_getreg((3 << 11) | 20) & 0xFu; }
#define XB_SPIN(cond, bar) do { unsigned _sp = 0; while (cond) { __builtin_amdgcn_s_sleep(1); \
    if ((++_sp & 255u) == 0u) { if (xb_ld(&(bar)[XB_TMO])) break; if (_sp > XB_SPIN_CAP) { atomicAdd(&(bar)[XB_TMO], 1u); break; } } } } while (0)
struct XcdBarrier { unsigned* bar; unsigned x; volatile LAS unsigned* st; int wave; };
__device__ __forceinline__ unsigned lane_id_fresh() { unsigned m = ~0u; asm volatile("" : "+s"(m)); return __builtin_amdgcn_mbcnt_hi(m, __builtin_amdgcn_mbcnt_lo(m, 0u)); }
__device__ __forceinline__ bool xb_thread0(int wave) { return wave == 0 && lane_id_fresh() == 0u; }
__device__ __forceinline__ XcdBarrier xcd_barrier_post(unsigned* bar, volatile LAS unsigned* st, int wave) {
    XcdBarrier b; b.bar = bar; b.x = xb_xcc_id(); b.st = st; b.wave = wave;
    if (xb_thread0(wave)) (void)xb_add(&bar[XB_XCNT(b.x)], 1u);
    return b;
}
__device__ __forceinline__ void xcd_barrier_complete(unsigned* bar, unsigned x, unsigned& nloc, unsigned& nx) {
    const unsigned G = gridDim.x * gridDim.y * gridDim.z;
    unsigned sum, cnt, mine, sp = 0u;
    for (;;) {
        sum = 0u; cnt = 0u; mine = 0u;
#pragma unroll
        for (unsigned j = 0; j < 16; ++j) { const unsigned c = xb_ld(&bar[XB_XCNT(j)]); sum += c; cnt += (c > 0u) ? 1u : 0u; mine = (j == x) ? c : mine; }
        if (sum == G) break;
        __builtin_amdgcn_s_sleep(1);
        if ((++sp & 255u) == 0u) { if (xb_ld(&bar[XB_TMO])) break; if (sp > XB_SPIN_CAP) { atomicAdd(&bar[XB_TMO], 1u); break; } }
    }
    nloc = mine > 0u ? mine : 1u; nx = cnt > 0u ? cnt : 1u;
}
__device__ __forceinline__ void xcd_barrier(const XcdBarrier& b) {
    asm volatile("s_waitcnt vmcnt(0)" ::: "memory");
    __syncthreads();
    if (xb_thread0(b.wave)) {
        unsigned* bar = b.bar;
        __builtin_amdgcn_s_waitcnt(0);
        unsigned nloc = b.st[0], nx = b.st[1];
        if (nloc == 0u) { xcd_barrier_complete(bar, b.x, nloc, nx); b.st[0] = nloc; b.st[1] = nx; }
        const unsigned old = xb_add(&bar[XB_XSUB(b.x)], 1u);
        const unsigned gen = old / nloc;
        if (old + 1u == (gen + 1u) * nloc) {
            __builtin_amdgcn_fence(__ATOMIC_RELEASE, "agent");
            asm volatile("s_waitcnt vmcnt(0)" ::: "memory");
            const unsigned og = xb_add(&bar[XB_TOP], 1u);
            const unsigned tg = og / nx;
            if (og + 1u == (tg + 1u) * nx) xb_add(&bar[XB_TOPGEN], 1u);
            else XB_SPIN(xb_ld(&bar[XB_TOPGEN]) == tg, bar);
            __builtin_amdgcn_fence(__ATOMIC_ACQUIRE, "agent");
            xb_add(&bar[XB_XGEN(b.x)], 1u);
            asm volatile("s_waitcnt vmcnt(0)" ::: "memory");
        } else {
            XB_SPIN(xb_ld(&bar[XB_XGEN(b.x)]) == gen, bar);
            __builtin_amdgcn_fence(__ATOMIC_ACQUIRE, "agent");
            asm volatile("s_waitcnt vmcnt(0)" ::: "memory");
        }
    }
    __syncthreads();
}

namespace mk {
using namespace nv;
typedef unsigned v4u __attribute__((ext_vector_type(4)));
typedef unsigned v2u __attribute__((ext_vector_type(2)));
typedef float f32x4 __attribute__((ext_vector_type(4)));
constexpr int NWAVES = 8, NTHREADS = 512;
constexpr int LDS_BYTES = 160 * 1024;
constexpr int MISC_OFF = LDS_BYTES - 256;
constexpr int CW_BAR = 4096;
constexpr size_t CTL_ZERO_BYTES = 64 * 1024;

__device__ __forceinline__ unsigned pk2(float lo, float hi) { return (unsigned)f2bf(lo) | ((unsigned)f2bf(hi) << 16); }

struct Frame {
    LAS unsigned char* lds; int tid, lane, wave, vcu, G, bx;
};

struct TItem { const float* src; unsigned char* dst; int ldw, ldt, k0, n0, dr, f8; };
template <int MAP, bool F8>
__device__ __forceinline__ void titem_fill(TItem& t, const void* srcp, int K, int N, void* dstp, size_t dstb, int r) {
    const int nblk = N / 32, per = (K / 64) * nblk, bi = r / per, it = r % per, kb = it / nblk, nb = it % nblk, n0 = 32 * nb;
    int dr = n0; if (MAP == 1) dr = (n0 >> 7) * 256 + (n0 & 127); if (MAP == 2) dr = (n0 >> 7) * 256 + 128 + (n0 & 127);
    t.src = (const float*)srcp + (size_t)bi * K * N; t.dst = (unsigned char*)dstp + (size_t)bi * dstb * (F8 ? 1 : 2); t.ldw = N; t.ldt = K; t.k0 = 64 * kb; t.n0 = n0; t.dr = dr; t.f8 = F8 ? 1 : 0;
}
struct TRegs { f32x4 v[8]; };
__device__ __forceinline__ void titem_load(const TItem& t, int lane, TRegs& R) {
    const float* p = t.src + (size_t)(t.k0 + (lane >> 3)) * t.ldw + t.n0 + (lane & 7) * 4;
#pragma unroll
    for (int i = 0; i < 8; ++i) R.v[i] = __builtin_nontemporal_load((const f32x4*)(p + (size_t)(8 * i) * t.ldw));
}
__device__ __forceinline__ void titem_finish(const TItem& t, int lane, const TRegs& R, LAS float* scr) {
    const float sc = t.f8 ? pg8::F8_WS : 1.f;
    { LAS float* d = scr + (lane >> 3) * 33 + (lane & 7) * 4;
#pragma unroll
      for (int i = 0; i < 8; ++i) { d[(8 * i) * 33 + 0] = R.v[i][0] * sc; d[(8 * i) * 33 + 1] = R.v[i][1] * sc; d[(8 * i) * 33 + 2] = R.v[i][2] * sc; d[(8 * i) * 33 + 3] = R.v[i][3] * sc; } }
    LDS_WAIT(); asm volatile("" ::: "memory");
    const int c = lane & 7;
#pragma unroll
    for (int j = 0; j < 4; ++j) { const int n = (lane >> 3) + 8 * j; const LAS float* s = scr + (8 * c) * 33 + n;
        if (t.f8) { v2u o; o.x = pg8::pk4_fp8(s[0 * 33], s[1 * 33], s[2 * 33], s[3 * 33]); o.y = pg8::pk4_fp8(s[4 * 33], s[5 * 33], s[6 * 33], s[7 * 33]);
            __builtin_nontemporal_store(o, (v2u*)(t.dst + (size_t)(t.dr + n) * t.ldt + t.k0 + 8 * c)); }
        else { v4u o; o.x = pk2(s[0 * 33], s[1 * 33]); o.y = pk2(s[2 * 33], s[3 * 33]); o.z = pk2(s[4 * 33], s[5 * 33]); o.w = pk2(s[6 * 33], s[7 * 33]);
            __builtin_nontemporal_store(o, (v4u*)((bf16_t*)t.dst + (size_t)(t.dr + n) * t.ldt + t.k0 + 8 * c)); } }
    LDS_WAIT(); asm volatile("" ::: "memory");
}

struct InvFreq { float f[8]; };
struct Args {
    const void* in[40]; float* out; unsigned char* ws; InvFreq inv; int ph_lo, ph_hi;
};

struct RowV { float v[16]; };
__device__ __forceinline__ void unpk8(const v4u u, float* x) {
    x[0] = __uint_as_float(u.x << 16); x[1] = __uint_as_float(u.x & 0xffff0000u); x[2] = __uint_as_float(u.y << 16); x[3] = __uint_as_float(u.y & 0xffff0000u);
    x[4] = __uint_as_float(u.z << 16); x[5] = __uint_as_float(u.z & 0xffff0000u); x[6] = __uint_as_float(u.w << 16); x[7] = __uint_as_float(u.w & 0xffff0000u);
}
struct RowRaw { v4u a, b; };
__device__ __forceinline__ RowRaw load_raw(const bf16_t* p, int lane) { RowRaw r; r.a = *(const v4u*)(p + 8 * lane); r.b = *(const v4u*)(p + 512 + 8 * lane); return r; }
__device__ __forceinline__ void unpack_row(const RowRaw& r, RowV& x) { unpk8(r.a, x.v); unpk8(r.b, x.v + 8); }
struct GB { float g[16], b[16]; };
__device__ __forceinline__ void load_gb(const float* g, const float* b, int lane, GB& o) {
#pragma unroll
    for (int hh = 0; hh < 2; ++hh)
#pragma unroll
        for (int q = 0; q < 2; ++q) { const float4 gg = *(const float4*)(g + 512 * hh + 8 * lane + 4 * q), bb = *(const float4*)(b + 512 * hh + 8 * lane + 4 * q);
            o.g[8 * hh + 4 * q + 0] = gg.x; o.g[8 * hh + 4 * q + 1] = gg.y; o.g[8 * hh + 4 * q + 2] = gg.z; o.g[8 * hh + 4 * q + 3] = gg.w;
            o.b[8 * hh + 4 * q + 0] = bb.x; o.b[8 * hh + 4 * q + 1] = bb.y; o.b[8 * hh + 4 * q + 2] = bb.z; o.b[8 * hh + 4 * q + 3] = bb.w; }
}
__device__ __forceinline__ void ln_rowv(RowV& z, const GB& gb) {
    float s = 0.f;
#pragma unroll
    for (int i = 0; i < 16; ++i) s += z.v[i];
    const float mu = wave_sum(s) * (1.f / D);
    float q = 0.f;
#pragma unroll
    for (int i = 0; i < 16; ++i) { z.v[i] -= mu; q += z.v[i] * z.v[i]; }
    const float rstd = 1.f / sqrtf(wave_sum(q) * (1.f / D) + LN_EPS);
#pragma unroll
    for (int i = 0; i < 16; ++i) z.v[i] = z.v[i] * rstd * gb.g[i] + gb.b[i];
}
__device__ __forceinline__ void store_rowv_bf16(bf16_t* p, int lane, const RowV& r) {
    v4u a, b; a.x = pk2(r.v[0], r.v[1]); a.y = pk2(r.v[2], r.v[3]); a.z = pk2(r.v[4], r.v[5]); a.w = pk2(r.v[6], r.v[7]);
    b.x = pk2(r.v[8], r.v[9]); b.y = pk2(r.v[10], r.v[11]); b.z = pk2(r.v[12], r.v[13]); b.w = pk2(r.v[14], r.v[15]);
    *(v4u*)(p + 8 * lane) = a; *(v4u*)(p + 512 + 8 * lane) = b;
}
__device__ __forceinline__ void store_rowv_fp8(unsigned char* p, int lane, const RowV& r, float s) {
    v2u a, b; a.x = pg8::pk4_fp8(r.v[0] * s, r.v[1] * s, r.v[2] * s, r.v[3] * s); a.y = pg8::pk4_fp8(r.v[4] * s, r.v[5] * s, r.v[6] * s, r.v[7] * s);
    b.x = pg8::pk4_fp8(r.v[8] * s, r.v[9] * s, r.v[10] * s, r.v[11] * s); b.y = pg8::pk4_fp8(r.v[12] * s, r.v[13] * s, r.v[14] * s, r.v[15] * s);
    *(v2u*)(p + 8 * lane) = a; *(v2u*)(p + 512 + 8 * lane) = b;
}
constexpr int LNR = 4;

__device__ __forceinline__ void phase_ln_add(const Frame& F, const bf16_t* X, const bf16_t* Y, const float* g, const float* b, bf16_t* out, unsigned char* out8) {
    const int gw = F.vcu * NWAVES + F.wave, NGW = F.G * NWAVES;
    GB gb; load_gb(g, b, F.lane, gb);
    for (int row = gw; row < T; row += LNR * NGW) {
        RowRaw rx[LNR], ry[LNR];
#pragma unroll
        for (int k = 0; k < LNR; ++k) { const int rr = row + k * NGW; if (rr < T) { rx[k] = load_raw(X + (size_t)rr * D, F.lane); if (Y) ry[k] = load_raw(Y + (size_t)rr * D, F.lane); } }
#pragma unroll
        for (int k = 0; k < LNR; ++k) { const int rr = row + k * NGW; if (rr < T) {
            RowV x; unpack_row(rx[k], x);
            if (Y) { RowV y; unpack_row(ry[k], y);
#pragma unroll
                for (int i = 0; i < 16; ++i) x.v[i] = ALPHA * x.v[i] + y.v[i]; }
            ln_rowv(x, gb);
            store_rowv_bf16(out + (size_t)rr * D, F.lane, x);
            store_rowv_fp8(out8 + (size_t)rr * D, F.lane, x, pg8::F8_XS); } }
    }
}
__device__ __forceinline__ void phase_ln_moe(const Frame& F, const bf16_t* X, const bf16_t* DS, const int* pos, const float* ewgt, const float* g, const float* b, bf16_t* outb, float* outf, unsigned char* out8) {
    const int gw = F.vcu * NWAVES + F.wave, NGW = F.G * NWAVES;
    GB gb; load_gb(g, b, F.lane, gb);
    for (int row = gw; row < T; row += LNR * NGW) {
        RowRaw rx[LNR], r1[LNR], r2[LNR]; float w1[LNR], w2[LNR];
#pragma unroll
        for (int k = 0; k < LNR; ++k) { const int rr = row + k * NGW; if (rr < T) {
            const int2 pp = *(const int2*)(pos + 2 * rr); const float2 ww = *(const float2*)(ewgt + 2 * rr); w1[k] = ww.x; w2[k] = ww.y;
            rx[k] = load_raw(X + (size_t)rr * D, F.lane); r1[k] = load_raw(DS + (size_t)pp.x * D, F.lane); r2[k] = load_raw(DS + (size_t)pp.y * D, F.lane); } }
#pragma unroll
        for (int k = 0; k < LNR; ++k) { const int rr = row + k * NGW; if (rr < T) {
            RowV x, y1, y2; unpack_row(rx[k], x); unpack_row(r1[k], y1); unpack_row(r2[k], y2);
#pragma unroll
            for (int i = 0; i < 16; ++i) x.v[i] = ALPHA * x.v[i] + (w1[k] * y1.v[i] + w2[k] * y2.v[i]);
            ln_rowv(x, gb);
            if (outb) store_rowv_bf16(outb + (size_t)rr * D, F.lane, x);
            if (out8) store_rowv_fp8(out8 + (size_t)rr * D, F.lane, x, pg8::F8_XS);
            if (outf) { float* o = outf + (size_t)rr * D + 8 * F.lane;
                *(float4*)(o) = make_float4(x.v[0], x.v[1], x.v[2], x.v[3]); *(float4*)(o + 4) = make_float4(x.v[4], x.v[5], x.v[6], x.v[7]);
                *(float4*)(o + 512) = make_float4(x.v[8], x.v[9], x.v[10], x.v[11]); *(float4*)(o + 516) = make_float4(x.v[12], x.v[13], x.v[14], x.v[15]); } } }
    }
}
constexpr int RW_LD = 20;
__device__ __forceinline__ void phase_ln_router(const Frame& F, const bf16_t* X, const bf16_t* Y, const float* g, const float* b, bf16_t* out, unsigned char* out8, const float* rw, const float* rbias, int* eidx, float* ewgt, int* bcnt) {
    LAS float* rwl = (LAS float*)F.lds;
    LAS int* hist = (LAS int*)(F.lds + 1024 * RW_LD * 4);
    LAS float* lgs = (LAS float*)(F.lds + 1024 * RW_LD * 4 + 256) + F.wave * 256;
    for (int i = F.tid; i < 1024 * 4; i += NTHREADS) { const int k = i >> 2, q = i & 3; const float4 v = *(const float4*)(rw + (size_t)k * 16 + 4 * q);
        const int j = (k >> 9) * 8 + (k & 7), l = (k >> 3) & 63; LAS float* d = rwl + (j * 64 + l) * RW_LD + 4 * q; d[0] = v.x; d[1] = v.y; d[2] = v.z; d[3] = v.w; }
    GB gb; load_gb(g, b, F.lane, gb);
    const int lane = F.lane;
    for (int vb = F.vcu; vb < T / 128; vb += F.G) {
        if (F.tid < 16) hist[F.tid] = 0;
        __syncthreads();
#pragma unroll 1
        for (int it = 0; it < 4; ++it) {
            const int row0 = vb * 128 + F.wave * 16 + it * 4;
            RowRaw rx[4], ry[4];
#pragma unroll
            for (int k = 0; k < 4; ++k) { rx[k] = load_raw(X + (size_t)(row0 + k) * D, lane); if (Y) ry[k] = load_raw(Y + (size_t)(row0 + k) * D, lane); }
            RowV x[4];
#pragma unroll
            for (int k = 0; k < 4; ++k) { unpack_row(rx[k], x[k]);
                if (Y) { RowV y; unpack_row(ry[k], y);
#pragma unroll
                    for (int i = 0; i < 16; ++i) x[k].v[i] = ALPHA * x[k].v[i] + y.v[i]; }
                ln_rowv(x[k], gb);
                store_rowv_bf16(out + (size_t)(row0 + k) * D, lane, x[k]);
                store_rowv_fp8(out8 + (size_t)(row0 + k) * D, lane, x[k], pg8::F8_XS); }
            float val[64];
#pragma unroll
            for (int i = 0; i < 64; ++i) val[i] = 0.f;
#pragma unroll
            for (int j = 0; j < 16; ++j) { const LAS float* wr = rwl + (j * 64 + lane) * RW_LD;
#pragma unroll
                for (int e4 = 0; e4 < 4; ++e4) { const f32x4 w4 = *(const LAS f32x4*)(wr + 4 * e4);
#pragma unroll
                    for (int k = 0; k < 4; ++k) { const float xv = x[k].v[j];
                        val[16 * k + 4 * e4 + 0] += xv * w4[0]; val[16 * k + 4 * e4 + 1] += xv * w4[1]; val[16 * k + 4 * e4 + 2] += xv * w4[2]; val[16 * k + 4 * e4 + 3] += xv * w4[3]; } } }
#pragma unroll
            for (int i = 0; i < 32; ++i) { const auto rr = __builtin_amdgcn_permlane32_swap(__float_as_uint(val[i]), __float_as_uint(val[i + 32]), false, false); val[i] = __uint_as_float(rr[0]) + __uint_as_float(rr[1]); }
            { const bool bt = (lane & 16) != 0;
#pragma unroll
              for (int i = 0; i < 16; ++i) { const float keep = bt ? val[i + 16] : val[i], send = bt ? val[i] : val[i + 16]; val[i] = keep + swz_xor<16>(send); } }
            { const bool bt = (lane & 8) != 0;
#pragma unroll
              for (int i = 0; i < 8; ++i) { const float keep = bt ? val[i + 8] : val[i], send = bt ? val[i] : val[i + 8]; val[i] = keep + swz_xor<8>(send); } }
            { const bool bt = (lane & 4) != 0;
#pragma unroll
              for (int i = 0; i < 4; ++i) { const float keep = bt ? val[i + 4] : val[i], send = bt ? val[i] : val[i + 4]; val[i] = keep + swz_xor<4>(send); } }
            { const bool bt = (lane & 2) != 0;
#pragma unroll
              for (int i = 0; i < 2; ++i) { const float keep = bt ? val[i + 2] : val[i], send = bt ? val[i] : val[i + 2]; val[i] = keep + swz_xor<2>(send); } }
            { const bool bt = (lane & 1) != 0; const float keep = bt ? val[1] : val[0], send = bt ? val[0] : val[1]; val[0] = keep + swz_xor<1>(send); }
            lgs[it * 64 + lane] = val[0];
        }
        LDS_WAIT();
        if (lane < 16) {
            {
                const int row = vb * 128 + F.wave * 16 + lane;
                float lg[16];
#pragma unroll
                for (int e4 = 0; e4 < 4; ++e4) { const f32x4 t4 = *(const LAS f32x4*)(lgs + 16 * lane + 4 * e4); lg[4 * e4] = t4[0]; lg[4 * e4 + 1] = t4[1]; lg[4 * e4 + 2] = t4[2]; lg[4 * e4 + 3] = t4[3]; }
                float mx = lg[0];
#pragma unroll
                for (int e = 1; e < 16; ++e) mx = fmaxf(mx, lg[e]);
                float sc[16], sum = 0.f;
#pragma unroll
                for (int e = 0; e < 16; ++e) { sc[e] = __expf(lg[e] - mx); sum += sc[e]; }
                const float isum = 1.f / sum;
                float bz[16];
#pragma unroll
                for (int e = 0; e < 16; ++e) { sc[e] *= isum; bz[e] = sc[e] + rbias[e]; }
                float gs[4]; int gi1[4], gi2[4];
#pragma unroll
                for (int gq = 0; gq < 4; ++gq) {
                    float m1 = bz[4 * gq]; int i1 = 0;
#pragma unroll
                    for (int j = 1; j < 4; ++j) if (bz[4 * gq + j] > m1) { m1 = bz[4 * gq + j]; i1 = j; }
                    float m2 = -INFINITY; int i2 = 0;
#pragma unroll
                    for (int j = 0; j < 4; ++j) if (j != i1 && bz[4 * gq + j] > m2) { m2 = bz[4 * gq + j]; i2 = j; }
                    gs[gq] = m1 + m2; gi1[gq] = i1; gi2[gq] = i2;
                }
                int gsel = 0; float gm = gs[0];
#pragma unroll
                for (int gq = 1; gq < 4; ++gq) if (gs[gq] > gm) { gm = gs[gq]; gsel = gq; }
                int i1 = gi1[0], i2 = gi2[0];
#pragma unroll
                for (int gq = 1; gq < 4; ++gq) if (gsel == gq) { i1 = gi1[gq]; i2 = gi2[gq]; }
                const int e1 = gsel * 4 + i1, e2 = gsel * 4 + i2;
                float s1 = 0.f, s2 = 0.f;
#pragma unroll
                for (int e = 0; e < 16; ++e) { if (e == e1) s1 = sc[e]; if (e == e2) s2 = sc[e]; }
                const float inv = 1.f / (s1 + s2);
                *(int2*)(eidx + 2 * row) = make_int2(e1, e2); *(float2*)(ewgt + 2 * row) = make_float2(s1 * inv, s2 * inv);
                atomicAdd((int*)&hist[e1], 1); atomicAdd((int*)&hist[e2], 1);
            }
        }
        __syncthreads();
        if (F.tid < 16) bcnt[vb * 16 + F.tid] = hist[F.tid];
        __syncthreads();
    }
}
__device__ __forceinline__ void phase_moe_book(const Frame& F, const int* eidx, const int* bcnt, int* tok, int* pos, int* tile_e) {
    LAS int* bc = (LAS int*)F.lds;
    LAS int* part = bc + 4096;
    LAS int* off = part + 256;
    LAS int* base = off + 32;
    LAS int* tot = base + 16;
    LAS int* wcnt = tot + 16;
    for (int i = F.tid; i < 4096; i += NTHREADS) bc[i] = bcnt[i];
    __syncthreads();
    if (F.tid < 256) { const int e = F.tid & 15, ch = F.tid >> 4; int s = 0;
#pragma unroll
        for (int j = 0; j < 16; ++j) s += bc[(ch * 16 + j) * 16 + e];
        part[ch * 16 + e] = s; }
    __syncthreads();
    if (F.tid < 16) { int t = 0;
#pragma unroll
        for (int ch = 0; ch < 16; ++ch) t += part[ch * 16 + F.tid];
        tot[F.tid] = t; }
    __syncthreads();
    if (F.tid == 0) { int o = 0;
#pragma unroll
        for (int e = 0; e < 16; ++e) { off[e] = o; o += (tot[e] + 255) & ~255; } off[16] = o; }
    __syncthreads();
    for (int vb = F.vcu; vb < T / 128; vb += F.G) {
        if (F.tid < 16) { const int e = F.tid, chv = vb >> 4; int bs = 0;
            for (int ch = 0; ch < chv; ++ch) bs += part[ch * 16 + e];
            for (int b2 = chv * 16; b2 < vb; ++b2) bs += bc[b2 * 16 + e];
            base[e] = bs; }
        int e = 0, rank = 0;
        if (F.tid < 256) {
            e = eidx[vb * 256 + F.tid];
            const unsigned long long lt = (1ull << F.lane) - 1ull;
#pragma unroll
            for (int k = 0; k < 16; ++k) { const unsigned long long mk = __ballot(e == k); if (e == k) rank = __popcll(mk & lt); if (F.lane == 0) wcnt[F.wave * 16 + k] = __popcll(mk); }
        }
        __syncthreads();
        if (F.tid < 256) {
            for (int w2 = 0; w2 < F.wave; ++w2) rank += wcnt[w2 * 16 + e];
            const int r = off[e] + base[e] + rank;
            pos[vb * 256 + F.tid] = r; tok[r] = vb * 128 + (F.tid >> 1);
        }
        if (vb < 16) { const int e2 = vb, r0 = off[e2] + tot[e2], r1 = off[e2 + 1]; for (int r = r0 + F.tid; r < r1; r += NTHREADS) tok[r] = 0; }
        if (vb == 16) {
            for (int tl = F.tid; tl < NTILE; tl += NTHREADS) { int e3 = -1;
#pragma unroll
                for (int k = 0; k < 16; ++k) if (tl * 256 >= off[k] && tl * 256 < off[k + 1]) e3 = k;
                tile_e[tl] = e3; }
            if (F.tid == 0) tile_e[NTILE] = off[16] >> 8;
        }
        __syncthreads();
    }
}
__device__ __forceinline__ void phase_pool(const Frame& F, const bf16_t* HP, unsigned char* PO) {
    constexpr int RUN = 32;
    const int gt = F.vcu * NTHREADS + F.tid, NGT = F.G * NTHREADS;
    for (int it = gt; it < (T / RUN) * (D / 8); it += NGT) {
        const int c8 = it & 127, run = it >> 7, g = c8 >> 5, win = 2 << g, t0 = run * RUN, ts0 = t0 & (S - 1);
        const bf16_t* hp = HP + (size_t)t0 * D + c8 * 8; unsigned char* po = PO + (size_t)t0 * D + c8 * 8;
        float s[8];
#pragma unroll
        for (int q = 0; q < 8; ++q) s[q] = 0.f;
        for (int k = 1; k < win; ++k) if (ts0 - k >= 0) { float v[8]; unpk8(*(const v4u*)(hp - (ptrdiff_t)k * D), v);
#pragma unroll
            for (int q = 0; q < 8; ++q) s[q] += v[q]; }
#pragma unroll 4
        for (int i = 0; i < RUN; ++i) {
            float hn[8]; unpk8(*(const v4u*)(hp + (size_t)i * D), hn);
            const int ts = ts0 + i;
#pragma unroll
            for (int q = 0; q < 8; ++q) s[q] += hn[q];
            const float inv = 1.f / (float)(ts + 1 < win ? ts + 1 : win);
            v2u o; const float xs = pg8::F8_XS; o.x = pg8::pk4_fp8((s[0] * inv - hn[0]) * xs, (s[1] * inv - hn[1]) * xs, (s[2] * inv - hn[2]) * xs, (s[3] * inv - hn[3]) * xs); o.y = pg8::pk4_fp8((s[4] * inv - hn[4]) * xs, (s[5] * inv - hn[5]) * xs, (s[6] * inv - hn[6]) * xs, (s[7] * inv - hn[7]) * xs);
            *(v2u*)(po + (size_t)i * D) = o;
            if (ts + 1 >= win) { float ho[8]; unpk8(*(const v4u*)(hp + (ptrdiff_t)(i + 1 - win) * D), ho);
#pragma unroll
                for (int q = 0; q < 8; ++q) s[q] -= ho[q]; }
        }
    }
}
}
namespace mk {
typedef short bf16x8 __attribute__((ext_vector_type(8)));
typedef float f32x16 __attribute__((ext_vector_type(16)));
#define MFMA32(a, b, c) __builtin_amdgcn_mfma_f32_32x32x16_bf16((a), (b), (c), 0, 0, 0)
__device__ __forceinline__ int crow(int i, int h) { return (i & 3) + 8 * (i >> 2) + 4 * h; }
__device__ __forceinline__ float swap32_max(float v) { const auto r = __builtin_amdgcn_permlane32_swap(__float_as_uint(v), __float_as_uint(v), false, false); return fmaxf(__uint_as_float(r[0]), __uint_as_float(r[1])); }
__device__ __forceinline__ float swap32_sum(float v) { const auto r = __builtin_amdgcn_permlane32_swap(__float_as_uint(v), __float_as_uint(v), false, false); return __uint_as_float(r[0]) + __uint_as_float(r[1]); }
__device__ __forceinline__ unsigned pkbf(float lo, float hi) { unsigned r; asm volatile("v_cvt_pk_bf16_f32 %0, %1, %2" : "=v"(r) : "v"(lo), "v"(hi)); return r; }
__device__ __forceinline__ bf16x8 pack_step(const f32x16& x, int s) {
    v4u p; p.x = pkbf(x[8 * s + 0], x[8 * s + 1]); p.y = pkbf(x[8 * s + 2], x[8 * s + 3]); p.z = pkbf(x[8 * s + 4], x[8 * s + 5]); p.w = pkbf(x[8 * s + 6], x[8 * s + 7]);
    return __builtin_bit_cast(bf16x8, p);
}
__device__ __forceinline__ bf16x8 lds_frag2x8(const LAS unsigned char* p) {
    const v2u a = *(const LAS v2u*)p, b = *(const LAS v2u*)(p + 16);
    v4u q; q.x = a.x; q.y = a.y; q.z = b.x; q.w = b.y; return __builtin_bit_cast(bf16x8, q);
}
__device__ __forceinline__ void unpack8(const v4u u, float (&x)[8]) {
    x[0] = __uint_as_float(u.x << 16); x[1] = __uint_as_float(u.x & 0xffff0000u); x[2] = __uint_as_float(u.y << 16); x[3] = __uint_as_float(u.y & 0xffff0000u);
    x[4] = __uint_as_float(u.z << 16); x[5] = __uint_as_float(u.z & 0xffff0000u); x[6] = __uint_as_float(u.w << 16); x[7] = __uint_as_float(u.w & 0xffff0000u);
}

__device__ __forceinline__ void phase_swa_sgu(const Frame& F, const bf16_t* H0, const float* sinks, const float* lng, const float* lnb, const bf16_t* SW, const float* bs, bf16_t* MIX) {
    constexpr int KSTR = 272, VSTR = 520, VT_OFF = 256 * KSTR, VGSTR = 272, VGW = 64 * VGSTR;
    LAS unsigned char* KS = F.lds; LAS unsigned char* VT = F.lds + VT_OFF;
    const int lane = F.lane, r = lane & 31, h = lane >> 5, w = F.wave, kvh = w >> 2;
    const float NEG = -INFINITY;
    for (int vb = F.vcu; vb < T / 128; vb += F.G) {
        const int n = vb & 63; const size_t row0 = (size_t)vb * 128;
#pragma unroll
        for (int i = 0; i < 8; ++i) { const int p = F.tid + NTHREADS * i, row = p >> 4, c16 = p & 15; v4u v = (v4u){0u, 0u, 0u, 0u};
            if (n > 0 || row >= 128) v = *(const v4u*)(H0 + (row0 + row - 128) * NIN0 + 512 + c16 * 8);
            *(LAS v4u*)(KS + row * KSTR + c16 * 16) = v; }
#pragma unroll
        for (int i = 0; i < 8; ++i) { const int p = F.tid + NTHREADS * i, c16 = p >> 8, row = p & 255; v4u v = (v4u){0u, 0u, 0u, 0u};
            if (n > 0 || row >= 128) v = *(const v4u*)(H0 + (row0 + row - 128) * NIN0 + 640 + c16 * 8);
            LAS bf16_t* d = (LAS bf16_t*)(VT + (c16 * 8) * VSTR + row * 2);
            d[0 * (VSTR / 2)] = (bf16_t)(v.x & 0xffffu); d[1 * (VSTR / 2)] = (bf16_t)(v.x >> 16); d[2 * (VSTR / 2)] = (bf16_t)(v.y & 0xffffu); d[3 * (VSTR / 2)] = (bf16_t)(v.y >> 16);
            d[4 * (VSTR / 2)] = (bf16_t)(v.z & 0xffffu); d[5 * (VSTR / 2)] = (bf16_t)(v.z >> 16); d[6 * (VSTR / 2)] = (bf16_t)(v.w & 0xffffu); d[7 * (VSTR / 2)] = (bf16_t)(v.w >> 16); }
        __syncthreads();
        const float sink2 = sinks[w] * 1.4426950408889634f;
        bf16x8 qn[4];
        { const bf16_t* qp = H0 + (row0 + r) * NIN0 + w * 64 + 8 * h;
#pragma unroll
          for (int ks = 0; ks < 4; ++ks) qn[ks] = *(const bf16x8*)(qp + 16 * ks); }
#pragma unroll 1
        for (int qg = 0; qg < 4; ++qg) {
            bf16x8 qf[4];
#pragma unroll
            for (int ks = 0; ks < 4; ++ks) qf[ks] = qn[ks];
            if (qg < 3) { const bf16_t* qp = H0 + (row0 + 32 * (qg + 1) + r) * NIN0 + w * 64 + 8 * h;
#pragma unroll
              for (int ks = 0; ks < 4; ++ks) qn[ks] = *(const bf16x8*)(qp + 16 * ks); }
            f32x16 st[5];
#pragma unroll
            for (int kt = 0; kt < 5; ++kt) {
#pragma unroll
                for (int i = 0; i < 16; ++i) st[kt][i] = 0.f;
                const LAS unsigned char* kp = KS + (32 * qg + 32 * kt + r) * KSTR + (kvh * 64 + 8 * h) * 2;
#pragma unroll
                for (int ks = 0; ks < 4; ++ks) { const bf16x8 kf = *(const LAS bf16x8*)(kp + 32 * ks); st[kt] = MFMA32(kf, qf[ks], st[kt]); }
            }
            float m = sink2;
            int rq = r; asm volatile("" : "+v"(rq));
#pragma unroll
            for (int kt = 0; kt < 5; ++kt)
#pragma unroll
                for (int i = 0; i < 16; ++i) { const int dk = 32 * kt + crow(i, h) - rq;
                    float s = st[kt][i] * ASCALE;
                    if (kt == 0) s = dk >= 1 ? s : NEG;
                    if (kt == 4) s = dk <= 128 ? s : NEG;
                    st[kt][i] = s; }
            if (n == 0) {
#pragma unroll
                for (int kt = 0; kt < 5; ++kt)
#pragma unroll
                    for (int i = 0; i < 16; ++i) if (32 * qg + 32 * kt + crow(i, h) < 128) st[kt][i] = NEG; }
#pragma unroll
            for (int kt = 0; kt < 5; ++kt)
#pragma unroll
                for (int i = 0; i < 16; ++i) m = fmaxf(m, st[kt][i]);
            m = swap32_max(m);
            float l = 0.f;
#pragma unroll
            for (int kt = 0; kt < 5; ++kt)
#pragma unroll
                for (int i = 0; i < 16; ++i) { const float p = __builtin_amdgcn_exp2f(st[kt][i] - m); st[kt][i] = p; l += p; }
            l = swap32_sum(l) + __builtin_amdgcn_exp2f(sink2 - m);
            f32x16 o[2];
#pragma unroll
            for (int i = 0; i < 16; ++i) { o[0][i] = 0.f; o[1][i] = 0.f; }
#pragma unroll
            for (int kt = 0; kt < 5; ++kt)
#pragma unroll
                for (int s = 0; s < 2; ++s) { const bf16x8 pf = pack_step(st[kt], s);
#pragma unroll
                    for (int dt = 0; dt < 2; ++dt) { const bf16x8 vf = lds_frag2x8(VT + (kvh * 64 + 32 * dt + r) * VSTR + (32 * qg + 32 * kt + 16 * s + 4 * h) * 2); o[dt] = MFMA32(vf, pf, o[dt]); } }
            const float inv = 1.f / l;
            bf16_t* op = MIX + (row0 + 32 * qg + r) * D + w * 64 + 4 * h;
#pragma unroll
            for (int dt = 0; dt < 2; ++dt)
#pragma unroll
                for (int g4 = 0; g4 < 4; ++g4) { v2u u; u.x = pkbf(o[dt][4 * g4 + 0] * inv, o[dt][4 * g4 + 1] * inv); u.y = pkbf(o[dt][4 * g4 + 2] * inv, o[dt][4 * g4 + 3] * inv); *(v2u*)(op + 32 * dt + 8 * g4) = u; }
        }
        __syncthreads();
        {
            LAS unsigned char* VG = F.lds + w * VGW; const int g = w;
            const int lane2 = (int)lane_id_fresh(), r2 = lane2 & 31, h2 = lane2 >> 5;
#pragma unroll 1
            for (int it = 0; it < 2; ++it) { const int s = 64 * it + lane2; const bf16_t* vp = H0 + (row0 + s) * NIN0 + 1280 + g * 64;
                float x[8][8]; float sum = 0.f;
#pragma unroll
                for (int cq = 0; cq < 8; ++cq) { unpack8(*(const v4u*)(vp + 8 * cq), x[cq]);
#pragma unroll
                    for (int e = 0; e < 8; ++e) sum += x[cq][e]; }
                const float mu = sum * (1.f / 64.f); float q = 0.f;
#pragma unroll
                for (int cq = 0; cq < 8; ++cq)
#pragma unroll
                    for (int e = 0; e < 8; ++e) { x[cq][e] -= mu; q += x[cq][e] * x[cq][e]; }
                const float rstd = 1.f / sqrtf(q * (1.f / 64.f) + LN_EPS);
#pragma unroll
                for (int cq = 0; cq < 8; ++cq) { const float* gp = lng + g * 64 + 8 * cq; const float* bp = lnb + g * 64 + 8 * cq; asm volatile("" : "+s"(gp), "+s"(bp));
#pragma unroll
                    for (int e = 0; e < 8; ++e) { const int c = 8 * cq + e; *(LAS bf16_t*)(VG + c * VGSTR + s * 2) = f2bf(x[cq][e] * rstd * gp[e] + bp[e]); } }
            }
            LDS_WAIT();
#pragma unroll 1
            for (int tt = 0; tt < 4; ++tt) {
                f32x16 acc[2];
#pragma unroll
                for (int i = 0; i < 16; ++i) { acc[0][i] = 0.f; acc[1][i] = 0.f; }
                const bf16_t* wp = SW + ((size_t)(g * 128 + 32 * tt + r2) * 128 + 8 * h2);
                const int nks = 2 * (tt + 1);
                bf16x8 bfr[8];
#pragma unroll
                for (int ks = 0; ks < 8; ++ks) if (ks < nks) bfr[ks] = *(const bf16x8*)(wp + 16 * ks);
                const int t = 32 * tt + r2; const float bias = bs[g * 128 + t];
                const bf16_t* up = H0 + (row0 + t) * NIN0 + 768 + g * 64 + 4 * h2; bf16_t* op = MIX + (row0 + t) * D + 512 + g * 64 + 4 * h2;
                v2u uu[2][4];
#pragma unroll
                for (int ct = 0; ct < 2; ++ct)
#pragma unroll
                    for (int g4 = 0; g4 < 4; ++g4) uu[ct][g4] = *(const v2u*)(up + 32 * ct + 8 * g4);
#pragma unroll
                for (int ks = 0; ks < 8; ++ks) if (ks < nks) {
#pragma unroll
                    for (int ct = 0; ct < 2; ++ct) { const bf16x8 af = *(const LAS bf16x8*)(VG + (32 * ct + r2) * VGSTR + (16 * ks + 8 * h2) * 2); acc[ct] = MFMA32(af, bfr[ks], acc[ct]); } }
#pragma unroll
                for (int ct = 0; ct < 2; ++ct)
#pragma unroll
                    for (int g4 = 0; g4 < 4; ++g4) { const v2u u2 = uu[ct][g4];
                        const float u0 = __uint_as_float(u2.x << 16), u1 = __uint_as_float(u2.x & 0xffff0000u), u2f = __uint_as_float(u2.y << 16), u3 = __uint_as_float(u2.y & 0xffff0000u);
                        v2u o2; o2.x = pkbf(u0 * (acc[ct][4 * g4 + 0] + bias), u1 * (acc[ct][4 * g4 + 1] + bias)); o2.y = pkbf(u2f * (acc[ct][4 * g4 + 2] + bias), u3 * (acc[ct][4 * g4 + 3] + bias));
                        *(v2u*)(op + 32 * ct + 8 * g4) = o2; }
            }
        }
        __syncthreads();
    }
}

}
namespace mk {
constexpr int NPHASE = 23;
constexpr int N_EARLY = 896 + 2 * 1024, NITEMS = N_EARLY + 3 * 512 + 2 * (512 + 3 * 4096);
constexpr int GEMM_CUS_P1 = 160;

typedef const __attribute__((address_space(4))) Args* KArgs;
__device__ __forceinline__ KArgs kargs() { KArgs p = (KArgs)__builtin_amdgcn_kernarg_segment_ptr(); asm volatile("" : "+s"(p)); return p; }

__device__ __forceinline__ void decode_item(KArgs ka, bf16_t* WB, int it, TItem& t) {
                    int r = it;
#define JOB(MAP, F8_, src, K_, N_, dst, dstb, cnt) if (r < (cnt)) { titem_fill<MAP, F8_>(t, src, K_, N_, dst, dstb, r); return; } r -= (cnt);
                    JOB(0, true, ka->in[5], 1024, 1792, WB + WB_IN0, 0, 896)
                    JOB(0, false, ka->in[15], 1024, 2048, WB + WB_LAYER + WL_XKV, 0, 1024)
                    JOB(0, false, ka->in[31], 1024, 2048, WB + WB_LAYER + WL_SIZE + WL_XKV, 0, 1024)
                    JOB(0, false, ka->in[11], 1024, 1024, WB + WB_OUT0, 0, 512)
                    JOB(0, true, ka->in[24], 1024, 1024, WB + WB_IN1, 0, 512)
                    JOB(0, false, ka->in[27], 1024, 1024, WB + WB_OUT1, 0, 512)
#define LAYER_JOBS(l, c2) { bf16_t* Wl = WB + WB_LAYER + (size_t)(l) * WL_SIZE; \
                        JOB(0, false, ka->in[(c2) + 4], 1024, 1024, Wl + WL_XO, 0, 512) \
                        JOB(1, true, ka->in[(c2) + 7], 1024, 512, Wl + WL_GU, (size_t)1024 * 1024, 4096)     \
                        JOB(2, true, ka->in[(c2) + 8], 1024, 512, Wl + WL_GU, (size_t)1024 * 1024, 4096) \
                        JOB(0, true, ka->in[(c2) + 9], 512, 1024, Wl + WL_DN, (size_t)1024 * 512, 4096) }
                    LAYER_JOBS(0, 12)
                    LAYER_JOBS(1, 28)
#undef LAYER_JOBS
#undef JOB
}

__device__ __forceinline__ bool in_range(int k) { KArgs ka = kargs(); return ka->ph_lo <= k && k < ka->ph_hi; }

__global__ void __launch_bounds__(NTHREADS, 2) mega(Args a) {
    extern __shared__ __attribute__((aligned(16))) unsigned char lds_raw[];
    LAS unsigned char* const F0lds = (LAS unsigned char*)lds_raw;
    const int F0wave = __builtin_amdgcn_readfirstlane((int)threadIdx.x >> 6);
    const int F0G = gridDim.x, F0bx = blockIdx.x, F0vcu = (F0G % 8 == 0) ? (F0bx % 8) * (F0G / 8) + F0bx / 8 : F0bx;
    volatile LAS unsigned* MISC = (volatile LAS unsigned*)(F0lds + MISC_OFF);
    if (threadIdx.x < 64) MISC[threadIdx.x] = 0u;
    __syncthreads();
    unsigned* ctl = (unsigned*)(a.ws + WS_CTL);
    XcdBarrier bar = xcd_barrier_post(ctl + CW_BAR + a.ph_lo * XCD_BAR_WORDS, MISC + 8, F0wave);
#define IN(k) in_range(k)
#define SEAM(k) do { if (IN(k) && IN((k) + 1)) { XcdBarrier b2_ = bar; asm volatile("" : "+s"(b2_.bar), "+s"(b2_.x)); xcd_barrier(b2_); } } while (0)
#define PH KArgs ka = kargs(); unsigned char* ws = ka->ws; (void)ws; Frame Fp; Fp.lds = F0lds; Fp.wave = F0wave; Fp.vcu = F0vcu; Fp.G = F0G; Fp.bx = F0bx; asm volatile("" : "+s"(Fp.wave), "+s"(Fp.vcu), "+s"(Fp.G), "+s"(Fp.bx)); \
    Fp.lane = (int)lane_id_fresh(); Fp.tid = Fp.wave * 64 + Fp.lane; const Frame& F = Fp; \
    const int bx = Fp.bx; (void)bx; LAS unsigned char* glds = F.lds; (void)glds; \
    bf16_t* RA = (bf16_t*)(ws + WS_A); bf16_t* RB = (bf16_t*)(ws + WS_B); bf16_t* RC = (bf16_t*)(ws + WS_C); bf16_t* RD = (bf16_t*)(ws + WS_D); bf16_t* WB = (bf16_t*)(ws + WS_WB); \
    (void)RA; (void)RB; (void)RC; (void)RD; (void)WB;
#define PHC PH const int cb = L == 0 ? 12 : 28; (void)cb; bf16_t* WBl = WB + WB_LAYER + (size_t)L * WL_SIZE; (void)WBl; \
    bf16_t *X1 = RB, *X2 = RA, *HS = RB, *DS = RD, *X3 = L == 0 ? RC : nullptr;   unsigned char *X1_8 = (unsigned char*)(L == 0 ? RD : RA), *P8 = (unsigned char*)(L == 0 ? RA : RC), *X2_8 = (unsigned char*)(L == 0 ? RD : RC); bf16_t* Y2 = L == 0 ? RC : RD; \
    (void)X1; (void)P8; (void)X1_8; (void)X2_8; (void)Y2; (void)X2; (void)HS; (void)DS; (void)X3;
#ifndef DOUBLE_MASK
#define DOUBLE_MASK 0u
#endif
#if DOUBLE_MASK != 0
#define REP(k) for (int rep_ = 0, nrep_ = 1 + (int)((DOUBLE_MASK >> (k)) & 1u); rep_ < nrep_; ++rep_)
#else
#define REP(k)
#endif
#define INF(i) ((const float*)ka->in[i])
#define WSI(off) ((int*)(ws + (off)))
#define WSF(off) ((float*)(ws + (off)))

#define GEMM_STD(EPI, ORD, LDA_, LDB_, K_) pg8::gemm_phase<EPI, ORD, true, true, false, LDA_, LDB_, K_>(glds, F.tid, g, S, E)
    for (int L = 0; L < 2; ++L) {
        const int cbp = L == 0 ? 0 : 11;
        if (L == 0) {
            if (IN(0)) REP(0) { PH
                LAS float* scrA = (LAS float*)(F.lds + F.wave * 16896), * scrB = scrA + 64 * 33;
                const int gw = F.vcu * NWAVES + F.wave, NGW = F.G * NWAVES;
                for (int it = gw; it < N_EARLY; it += 2 * NGW) {
                    TItem ta, tb; TRegs ra, rb; const int itb = it + NGW < N_EARLY ? it + NGW : it;
                    decode_item(ka, WB, it, ta); titem_load(ta, F.lane, ra);
                    decode_item(ka, WB, itb, tb); titem_load(tb, F.lane, rb);
                    titem_finish(ta, F.lane, ra, scrA);
                    titem_finish(tb, F.lane, rb, scrB);
                }
                const int gt = F.vcu * NTHREADS + F.tid, NGT = F.G * NTHREADS;
                { const float4* x4 = (const float4*)ka->in[0]; v2u* o = (v2u*)RA; unsigned* o8 = (unsigned*)RB;
                  for (int i = gt; i < T * D / 4; i += 4 * NGT) { float4 v[4];
#pragma unroll
                      for (int k = 0; k < 4; ++k) v[k] = x4[i + k * NGT];
#pragma unroll
                      for (int k = 0; k < 4; ++k) { v2u w; w.x = pk2(v[k].x, v[k].y); w.y = pk2(v[k].z, v[k].w); o[i + k * NGT] = w;
                          o8[i + k * NGT] = pg8::pk4_fp8(v[k].x * pg8::F8_XS, v[k].y * pg8::F8_XS, v[k].z * pg8::F8_XS, v[k].w * pg8::F8_XS); } } }
                { const float4* m4 = (const float4*)ka->in[1]; v2u* o = (v2u*)(ws + WS_MEMB);
                  for (int i = gt; i < B * MEM * D / 4; i += NGT) { const float4 v = m4[i]; v2u w; w.x = pk2(v.x, v.y); w.y = pk2(v.z, v.w); o[i] = w; } }
                { const int* positions = (const int*)ka->in[2]; float* ropew = WSF(WS_ROPE);
                  for (int t = gt; t < T; t += NGT) { const float p = (float)positions[t];
#pragma unroll
                      for (int j = 0; j < 8; ++j) { const float ang = p * ka->inv.f[j]; double rev = (double)ang * 0.15915494309189535; rev -= rint(rev); const float rr = (float)rev;
                          ropew[(size_t)t * 16 + j] = __builtin_amdgcn_cosf(rr); ropew[(size_t)t * 16 + 8 + j] = __builtin_amdgcn_sinf(rr); } } }
            }
            SEAM(0);
            if (IN(1)) REP(1) { PH float* rope = WSF(WS_ROPE); bf16_t* MEMB = (bf16_t*)(ws + WS_MEMB);
              const int GC = F.G >= 256 ? GEMM_CUS_P1 : F.G;
              if (bx >= GC || F.G < 256) {
                const int cid = F.G >= 256 ? bx - GC : bx, NC = F.G >= 256 ? F.G - GC : F.G;
                LAS float* scrA = (LAS float*)(F.lds + F.wave * 16896), * scrB = scrA + 64 * 33;
                const int gw = cid * NWAVES + F.wave, NGW = NC * NWAVES;
#define CLAMP_IT(x) ((x) < NITEMS ? (x) : NITEMS - 1)
                { TItem ta, tb, tc, td; TRegs ra, rb, rc, rd; int it = N_EARLY + gw;
                  decode_item(ka, WB, CLAMP_IT(it), ta); titem_load(ta, F.lane, ra);
                  decode_item(ka, WB, CLAMP_IT(it + NGW), tb); titem_load(tb, F.lane, rb);
                  for (; it < NITEMS; it += 4 * NGW) {
                      decode_item(ka, WB, CLAMP_IT(it + 2 * NGW), tc); titem_load(tc, F.lane, rc);
                      decode_item(ka, WB, CLAMP_IT(it + 3 * NGW), td); titem_load(td, F.lane, rd);
                      titem_finish(ta, F.lane, ra, scrA); titem_finish(tb, F.lane, rb, scrB);
                      decode_item(ka, WB, CLAMP_IT(it + 4 * NGW), ta); titem_load(ta, F.lane, ra);
                      decode_item(ka, WB, CLAMP_IT(it + 5 * NGW), tb); titem_load(tb, F.lane, rb);
                      titem_finish(tc, F.lane, rc, scrA); titem_finish(td, F.lane, rd, scrB);
                  } }
#undef CLAMP_IT
                const int gt = cid * NTHREADS + F.tid, NGT = NC * NTHREADS;
#pragma unroll
                for (int l = 0; l < 2; ++l) { const float4* q4 = (const float4*)ka->in[l == 0 ? 14 : 30]; v2u* o = (v2u*)(WB + WB_LAYER + (size_t)l * WL_SIZE + WL_XQ);
                  for (int i = gt; i < D * D / 4; i += NGT) { const float4 v = q4[i]; v2u w; w.x = pk2(v.x, v.y); w.y = pk2(v.z, v.w); o[i] = w; } }
                { const float4* p4 = (const float4*)ka->in[25]; const float4* s4 = (const float4*)ka->in[26]; v2u* o = (v2u*)(WB + WB_POOL);
                  for (int i = gt; i < 4 * 256 * 256 / 4; i += NGT) { const float4 v = p4[i]; const float4 sc = s4[(i >> 14) * 64 + (i & 63)]; v2u w; w.x = pk2(v.x * sc.x, v.y * sc.y); w.y = pk2(v.z * sc.z, v.w * sc.w); o[i] = w; } }
                { const float* sw = INF(9); bf16_t* o = WB + WB_SGUW;
                  for (int i = gt; i < 8 * 128 * 128; i += NGT) { const int s2 = i & 127, t = (i >> 7) & 127; o[i] = f2bf(s2 <= t ? sw[i] : 0.f); } }
                __syncthreads();
              }
              if (bx < GC) {
#pragma unroll 1
                for (int l = 0; l < 2; ++l) {
                    bf16_t* Wl = WB + WB_LAYER + (size_t)l * WL_SIZE;
                    pg8::Gemm g{MEMB, Wl + WL_XKV, nullptr, nullptr};
                    const int c2 = bx - 96 - 32 * l;
                    pg8::StaticOrder S; S.init(B * MEM, 2048, GC, (c2 >= 0 && c2 < 32) ? c2 : (1 << 20), D, D);
                    pg8::EpiBf16 E{(bf16_t*)(ws + WS_MEMKV) + (size_t)l * B * MEM * 2048, 2048, 1.f};
                    GEMM_STD(pg8::EpiBf16, pg8::StaticOrder, D, D, D);
                }
                {
                    pg8::Gemm g{RB, WB + WB_IN0, nullptr, nullptr};
                    pg8::StaticOrder S; S.init(T, NIN0, GC, bx, D, D);
                    pg8::EpiInproj0 E{RD, rope, 1.f / (pg8::F8_XS * pg8::F8_WS)};
                    pg8::gemm_phase<pg8::EpiInproj0, pg8::StaticOrder, true, true, false, D, D, D, true>(glds, F.tid, g, S, E);
                }
              }
            }
            SEAM(1);
            if (IN(2)) REP(2) { PH
                { bf16_t* Wl = WB + WB_LAYER; const bf16_t* KV = (const bf16_t*)(ws + WS_MEMKV);
                  { pg8::Gemm g{KV, Wl + WL_XQ, nullptr, nullptr}; pg8::SetupOrder<0> S; S.init(bx, 0, 64); pg8::EpiF8 E{ws + WS_MT, D, QSCALE * pg8::F8_MS}; GEMM_STD(pg8::EpiF8, pg8::SetupOrder<0>, 2048, 1024, 256); }
                  { pg8::Gemm g{Wl + WL_XO, KV, nullptr, nullptr}; pg8::SetupOrder<1> S; S.init(bx, 64, 64); pg8::EpiF8 E{ws + WS_NT, D, pg8::F8_NS}; GEMM_STD(pg8::EpiF8, pg8::SetupOrder<1>, 1024, 2048, 256); }
                  { pg8::Gemm g{WB + WB_OUT1, WB + WB_POOL, nullptr, nullptr}; pg8::SetupOrder<2> S; S.init(bx, 128, 16); pg8::EpiF8 E{(unsigned char*)(WB + WB_WEFF), D, pg8::F8_WS}; GEMM_STD(pg8::EpiF8, pg8::SetupOrder<2>, 1024, 256, 256); } }
                phase_swa_sgu(F, RD, INF(6), INF(7), INF(8), WB + WB_SGUW, INF(10), RB);
            }
            SEAM(2);
            if (IN(3)) REP(3) { PH
                pg8::Gemm g{RB, WB + WB_OUT0, nullptr, nullptr};
                pg8::StaticOrder S; S.init(T, D, F.G, bx, D, D);
                pg8::EpiBf16 E{RC, D, 1.f};
                GEMM_STD(pg8::EpiBf16, pg8::StaticOrder, D, D, D);
            }
            SEAM(3);
            if (IN(4)) REP(4) { PH phase_ln_add(F, RA, RC, INF(12), INF(13), RB, (unsigned char*)RD); }
            SEAM(4);
        } else {
            if (IN(12)) REP(12) { PH
                pg8::Gemm g{RB, WB + WB_IN1, nullptr, nullptr};
                pg8::StaticOrder S; S.init(T, D, F.G, bx, D, D);
                pg8::EpiBf16 E{RA, D, 1.f / (pg8::F8_XS * pg8::F8_WS)};
                pg8::gemm_phase<pg8::EpiBf16, pg8::StaticOrder, true, true, false, D, D, D, true>(glds, F.tid, g, S, E);
            }
            SEAM(12);
            if (IN(13)) REP(13) { PH
                { bf16_t* Wl = WB + WB_LAYER + WL_SIZE; const bf16_t* KV = (const bf16_t*)(ws + WS_MEMKV) + (size_t)B * MEM * 2048;
                  { pg8::Gemm g{KV, Wl + WL_XQ, nullptr, nullptr}; pg8::SetupOrder<0> S; S.init(bx, 0, 64); pg8::EpiF8 E{ws + WS_MT, D, QSCALE * pg8::F8_MS}; GEMM_STD(pg8::EpiF8, pg8::SetupOrder<0>, 2048, 1024, 256); }
                  { pg8::Gemm g{Wl + WL_XO, KV, nullptr, nullptr}; pg8::SetupOrder<1> S; S.init(bx, 64, 64); pg8::EpiF8 E{ws + WS_NT, D, pg8::F8_NS}; GEMM_STD(pg8::EpiF8, pg8::SetupOrder<1>, 1024, 2048, 256); } }
                phase_pool(F, RA, (unsigned char*)RB);
            }
            SEAM(13);
            if (IN(14)) REP(14) { PH
                pg8::Gemm g{RB, WB + WB_WEFF, nullptr, nullptr};
                pg8::StaticOrder S; S.init(T, D, F.G, bx, D, D);
                pg8::EpiBf16 E{RD, D, 1.f / (pg8::F8_XS * pg8::F8_WS)};
                pg8::gemm_phase<pg8::EpiBf16, pg8::StaticOrder, true, true, false, D, D, D, true>(glds, F.tid, g, S, E);
            }
            SEAM(14);
            if (IN(15)) REP(15) { PH phase_ln_add(F, RC, RD, INF(28), INF(29), RB, (unsigned char*)RA); }
            SEAM(15);
        }
        if (IN(cbp + 5)) REP(cbp + 5) { PHC
            pg8::Gemm g{(const bf16_t*)X1_8, (const bf16_t*)(ws + WS_MT), nullptr, nullptr};
            pg8::BatchOrder S; S.init(T, D, F.G, bx, D, D);
            pg8::EpiSoftmaxT<true> E{P8, (LAS float*)(F.lds + 131072), 1.f / (pg8::F8_XS * pg8::F8_MS)};
            pg8::gemm_phase<pg8::EpiSoftmaxT<true>, pg8::BatchOrder, true, true, false, D, D, D, true>(glds, F.tid, g, S, E);
        }
        SEAM(cbp + 5);
        if (IN(cbp + 6)) REP(cbp + 6) { PHC
            pg8::Gemm g{(const bf16_t*)P8, (const bf16_t*)(ws + WS_NT), nullptr, nullptr};
            pg8::BatchOrder S; S.init(T, D, F.G, bx, D, D);
            pg8::EpiBf16 E{Y2, D, 1.f / (pg8::F8_PS * pg8::F8_NS)};
            pg8::gemm_phase<pg8::EpiBf16, pg8::BatchOrder, true, true, false, D, D, D, true>(glds, F.tid, g, S, E);
        }
        SEAM(cbp + 6);
        if (IN(cbp + 7)) REP(cbp + 7) { PHC phase_ln_router(F, X1, Y2, INF(cb + 5), INF(cb + 6), X2, X2_8, INF(3), INF(4), WSI(WS_EIDX), WSF(WS_EWGT), WSI(WS_BCNT)); }
        SEAM(cbp + 7);
        if (IN(cbp + 8)) REP(cbp + 8) { PHC phase_moe_book(F, WSI(WS_EIDX), WSI(WS_BCNT), WSI(WS_TOK), WSI(WS_POS), WSI(WS_TILE)); }
        SEAM(cbp + 8);
        if (IN(cbp + 9)) REP(cbp + 9) { PHC const int* tile_e = WSI(WS_TILE); const int* tok = WSI(WS_TOK);
            const int ntiles = __builtin_amdgcn_readfirstlane(tile_e[NTILE]);
            pg8::Gemm g{(const bf16_t*)X2_8, WBl + WL_GU, tok, (LAS int*)(F.lds + 131072)};
            pg8::MoeOrder S; S.init(ntiles, tile_e, F.G, bx, D, D);
            pg8::EpiGU8 E{(unsigned char*)HS};
            pg8::gemm_phase<pg8::EpiGU8, pg8::MoeOrder, true, true, true, D, D, D, true>(glds, F.tid, g, S, E);
        }
        SEAM(cbp + 9);
        if (IN(cbp + 10)) REP(cbp + 10) { PHC const int* tile_e = WSI(WS_TILE);
            const int ntiles = __builtin_amdgcn_readfirstlane(tile_e[NTILE]);
            pg8::Gemm g{HS, WBl + WL_DN, nullptr, nullptr};
            pg8::MoeOrder S; S.init(ntiles, tile_e, F.G, bx, DE, DE);
            pg8::EpiBf16 E{DS, D, 1.f / (pg8::F8_HS * pg8::F8_WS)};
            pg8::gemm_phase<pg8::EpiBf16, pg8::MoeOrder, true, true, false, DE, DE, DE, true>(glds, F.tid, g, S, E);
        }
        SEAM(cbp + 10);
        if (IN(cbp + 11)) REP(cbp + 11) { PHC phase_ln_moe(F, X2, DS, WSI(WS_POS), WSF(WS_EWGT), INF(cb + 10), INF(cb + 11), X3, L == 1 ? ka->out : nullptr, L == 0 ? (unsigned char*)RB : nullptr); }
        SEAM(cbp + 11);
    }
#undef GEMM_STD
#undef IN
#undef SEAM
#undef INF
#undef PH
#undef PHC
#undef WSI
#undef WSF
}
}
using namespace nv;
extern "C" void kernel_launch(void* const* d_in, const int* in_sizes, int n_in, void* d_out, int out_size, void* d_ws, size_t ws_size, hipStream_t stream) {
    (void)in_sizes; (void)out_size;
    if (ws_size < WS_END || n_in != 40) return;
    static int grid = 0;
    if (grid == 0) {
        int dev = 0, cus = 0;
        if (hipGetDevice(&dev) != hipSuccess || hipDeviceGetAttribute(&cus, hipDeviceAttributeMultiprocessorCount, dev) != hipSuccess) { grid = -1; return; }
        if (hipFuncSetAttribute((const void*)mk::mega, hipFuncAttributeMaxDynamicSharedMemorySize, mk::LDS_BYTES) != hipSuccess) { grid = -1; return; }
        int per_cu = 0;
        if (hipOccupancyMaxActiveBlocksPerMultiprocessor(&per_cu, (const void*)mk::mega, mk::NTHREADS, mk::LDS_BYTES) != hipSuccess || per_cu < 1) { (void)hipGetLastError(); }
        grid = cus;
    }
    if (grid < 0) return;
    unsigned char* ws = (unsigned char*)d_ws;
    (void)hipMemsetAsync(ws + WS_CTL, 0, 512 * 1024, stream);
    mk::Args a{};
    for (int i = 0; i < 40; ++i) a.in[i] = d_in[i];
    a.out = (float*)d_out; a.ws = ws;
    for (int j = 0; j < 8; ++j) a.inv.f[j] = (float)pow(500000.0, -(double)((float)j * 2.0f / 16.0f));
    a.ph_lo = 0; a.ph_hi = mk::NPHASE;
    hipLaunchKernelGGL(mk::mega, dim3(grid), dim3(mk::NTHREADS), mk::LDS_BYTES, stream, a);
}
```

```cpp
#include <hip/hip_runtime.h>
#include <stdint.h>
#include <math.h>

typedef unsigned short bf16_t;

namespace nv {
constexpr int B = 4, S = 8192, T = B * S, D = 1024;
constexpr int NIN0 = 1792;
constexpr int MEM = 256, XH = 4, XHD = 256;
constexpr int NE = 16, DE = 512;
constexpr int MPAD = 65536 + 16 * 256;
constexpr int NTILE = MPAD / 256;
constexpr float ALPHA = 1.4142135623730951f;
constexpr float LN_EPS = 1e-5f;
constexpr float QSCALE = 0.0625f * 1.4426950408889634f;
constexpr float ASCALE = 0.125f * 1.4426950408889634f;

constexpr size_t MiB = 1u << 20;
constexpr size_t WS_CTL = 0;
constexpr size_t WS_ROPE = 2 * MiB;
constexpr size_t WS_EIDX = 4 * MiB;
constexpr size_t WS_EWGT = 5 * MiB;
constexpr size_t WS_POS = 6 * MiB;
constexpr size_t WS_BCNT = 7 * MiB;
constexpr size_t WS_TILE = 7 * MiB + 65536;
constexpr size_t WS_TOK = 7 * MiB + 131072;
constexpr size_t WS_MEMKV = 8 * MiB;
constexpr size_t WS_MEMB = 20 * MiB;
constexpr size_t WS_WB = 24 * MiB;
constexpr size_t WS_A = 152 * MiB, WS_B = 220 * MiB, WS_C = 288 * MiB, WS_D = 356 * MiB;
constexpr size_t WS_MT = 492 * MiB;
constexpr size_t WS_NT = 500 * MiB;
constexpr size_t WS_CV = 496 * MiB;
constexpr size_t WS_PART = 504 * MiB;
constexpr size_t WS_END = 508 * MiB;
constexpr size_t WB_IN0 = 0;
constexpr size_t WB_OUT0 = WB_IN0 + (size_t)1792 * 1024;
constexpr size_t WB_IN1 = WB_OUT0 + (size_t)1024 * 1024;
constexpr size_t WB_POOL = WB_IN1 + (size_t)1024 * 1024;
constexpr size_t WB_OUT1 = WB_POOL + (size_t)1024 * 256;
constexpr size_t WB_WEFF = WB_OUT1 + (size_t)1024 * 1024;
constexpr size_t WB_SGUW = WB_WEFF + (size_t)1024 * 1024;
constexpr size_t WB_LAYER = WB_SGUW + (size_t)8 * 128 * 128;
constexpr size_t WL_XQ = 0;
constexpr size_t WL_XKV = WL_XQ + (size_t)1024 * 1024;
constexpr size_t WL_XO = WL_XKV + (size_t)2048 * 1024;
constexpr size_t WL_GU = WL_XO + (size_t)1024 * 1024;
constexpr size_t WL_DN = WL_GU + (size_t)16 * 1024 * 1024;
constexpr size_t WL_SIZE = WL_DN + (size_t)16 * 1024 * 512;
static_assert((WB_LAYER + 2 * WL_SIZE) * 2 <= 128 * MiB, "bf16 weight region");

__device__ __forceinline__ float bf2f(bf16_t v) { return __uint_as_float((unsigned)v << 16); }
__device__ __forceinline__ bf16_t f2bf(float f) { unsigned u = __float_as_uint(f); return (bf16_t)((u + 0x7fffu + ((u >> 16) & 1u)) >> 16); }
__device__ __forceinline__ float gelu_tanh(float x) { const float u = 0.7978845608028654f * (x + 0.044715f * x * x * x); const float e = __expf(2.f * u); const float th = 1.f - 2.f / (e + 1.f); return 0.5f * x * (1.f + th); }
__device__ __forceinline__ float silu(float x) { return x / (1.f + __expf(-x)); }
template <int M> __device__ __forceinline__ float swz_xor(float v) { return __int_as_float(__builtin_amdgcn_ds_swizzle(__float_as_int(v), (M << 10) | 0x1f)); }
__device__ __forceinline__ float wave_sum(float v) {
    v += swz_xor<1>(v); v += swz_xor<2>(v); v += swz_xor<4>(v); v += swz_xor<8>(v); v += swz_xor<16>(v);
    const auto r = __builtin_amdgcn_permlane32_swap(__float_as_uint(v), __float_as_uint(v), false, false);
    return __uint_as_float(r[0]) + __uint_as_float(r[1]);
}
__device__ __forceinline__ float wave_max(float v) {
    v = fmaxf(v, swz_xor<1>(v)); v = fmaxf(v, swz_xor<2>(v)); v = fmaxf(v, swz_xor<4>(v)); v = fmaxf(v, swz_xor<8>(v)); v = fmaxf(v, swz_xor<16>(v));
    const auto r = __builtin_amdgcn_permlane32_swap(__float_as_uint(v), __float_as_uint(v), false, false);
    return fmaxf(__uint_as_float(r[0]), __uint_as_float(r[1]));
}
}

namespace pg8 {
#define PG8_LAS __attribute__((address_space(3)))
typedef short bf16x8 __attribute__((ext_vector_type(8)));
typedef float f32x4 __attribute__((ext_vector_type(4)));
typedef float f32x2 __attribute__((ext_vector_type(2)));
typedef unsigned u32x4 __attribute__((ext_vector_type(4)));
typedef unsigned u32x2 __attribute__((ext_vector_type(2)));
typedef int i32x8 __attribute__((ext_vector_type(8)));
constexpr int BM = 256, BK = 64, HALF = 128, HTB = HALF * BK * 2  , STAGE_BYTES = 8 * HTB, NXCD = 8, WGM = 8;

__host__ __device__ __forceinline__ int lds_byte(int r, int c) { const int st = (r >> 4) * 2 + (c >> 5), rr = r & 15, cc = c & 31, ob = rr * 64 + cc * 2; return st * 1024 + (ob ^ (((ob >> 9) & 1) << 5)); }
__host__ __device__ __forceinline__ void stage_rc(int b, int& R, int& C) { const int st = b / 1024, sb = b % 1024, swz = sb ^ (((sb >> 9) & 1) << 5); R = (st >> 1) * 16 + swz / 64; C = (st & 1) * 32 + (swz % 64) / 2; }
__host__ __device__ __forceinline__ int perm32(int rho) { const int n = rho >> 4, i = rho & 15; return 8 * (i >> 2) + 4 * n + (i & 3); }

struct Unit { int pm, pn, ao, bo; };
struct Gemm { const bf16_t* A; const bf16_t* Bt; const int* arow; PG8_LAS int* ltab; };

template <bool BATCHED = false>
struct StaticOrderT {
    int nM, nN, nwg, G, c, lda, ldb, apn;
    __device__ void init(int M, int N, int G_, int c_, int lda_, int ldb_, int apn_ = 0) { nM = M / BM; nN = N / BM; nwg = nM * nN; G = G_; c = c_; lda = lda_; ldb = ldb_; apn = apn_; }
    __device__ bool next(int i, Unit& u) const {
        const long L = (long)i * G + c; if (L >= nwg) return false;
        int wgid = (int)L; { const int q = nwg / NXCD, r = nwg % NXCD, xcd = wgid % NXCD, off = wgid / NXCD; wgid = (xcd < r ? xcd * (q + 1) : r * (q + 1) + (xcd - r) * q) + off; }
        const int nig = WGM * nN, gid = wgid / nig, fm = gid * WGM, gsz = (nM - fm) < WGM ? (nM - fm) : WGM;
        u.pm = fm + ((wgid % nig) % gsz); u.pn = (wgid % nig) / gsz;
        u.ao = u.pm * BM * lda + u.pn * apn; u.bo = (BATCHED ? ((u.pm >> 5) * 4 + u.pn) : u.pn) * BM * ldb; return true;
    }
};
typedef StaticOrderT<false> StaticOrder;
typedef StaticOrderT<true> BatchOrder;
struct MoeOrder {
    int nM, nwg, G, c, lda, ldb; const int* tile_e;
    __device__ void init(int ntiles, const int* te, int G_, int c_, int lda_, int ldb_) { nM = ntiles; nwg = nM * 4; G = G_; c = c_; tile_e = te; lda = lda_; ldb = ldb_; }
    __device__ bool next(int i, Unit& u) const {
        const long L = (long)i * G + c; if (L >= nwg) return false;
        int wgid = (int)L; { const int q = nwg / NXCD, r = nwg % NXCD, xcd = wgid % NXCD, off = wgid / NXCD; wgid = (xcd < r ? xcd * (q + 1) : r * (q + 1) + (xcd - r) * q) + off; }
        const int nig = WGM * 4, gid = wgid / nig, fm = gid * WGM, gsz = (nM - fm) < WGM ? (nM - fm) : WGM;
        u.pm = fm + ((wgid % nig) % gsz); u.pn = (wgid % nig) / gsz;
        const int e = __builtin_amdgcn_readfirstlane(tile_e[u.pm]); u.ao = u.pm * BM * lda; u.bo = (e * 4 + u.pn) * BM * ldb; return true;
    }
};
template <int KIND>
struct SetupOrder {
    int idx, n;
    __device__ void init(int c, int c0, int n_) { idx = c - c0; n = n_; }
    __device__ bool next(int i, Unit& u) const {
        if (i != 0 || idx < 0 || idx >= n) return false;
        const int x = idx >> 4, y = (idx >> 2) & 3, z = idx & 3;
        if (KIND == 0) { u.pm = x * 4 + y; u.pn = z; u.ao = (x * 256) * 2048 + y * 256; u.bo = z * 256 * 1024 + y * 256; }
        if (KIND == 1) { u.pm = x * 4 + y; u.pn = z; u.ao = y * 256 * 1024 + z * 256; u.bo = (x * 256) * 2048 + 1024 + z * 256; }
        if (KIND == 2) { u.pm = y; u.pn = z; u.ao = y * 256 * 1024 + z * 256; u.bo = z * 256 * 256; }
        return true;
    }
};

__device__ __forceinline__ int fresh_lane() { unsigned m = ~0u; asm volatile("" : "+s"(m)); return (int)__builtin_amdgcn_mbcnt_hi(m, __builtin_amdgcn_mbcnt_lo(m, 0u)); }
__device__ __forceinline__ unsigned cvt_pk_bf16(float lo, float hi) { unsigned r; asm volatile("v_cvt_pk_bf16_f32 %0, %1, %2" : "=v"(r) : "v"(lo), "v"(hi)); return r; }


template <class Epi, class Sched, bool ALIGN_EPI, bool SP2, bool GATHER, int LDA, int LDB, int KK, bool FP8 = false>
__device__ __forceinline__ void gemm_phase(PG8_LAS unsigned char* lds, int tid_in, const Gemm g, const Sched& S, const Epi& E) {
    int tid_ = tid_in; asm volatile("" : "+v"(tid_));
    const int tid = tid_, wid = __builtin_amdgcn_readfirstlane(tid >> 6), lane = tid & 63, wr = wid >> 2, wc = wid & 3, fr = lane & 15, fq = lane >> 4;
    constexpr int ELT = FP8 ? 1 : 2, K = KK, nt = K * ELT / (BK * 2), lda = LDA * ELT, ldb = LDB * ELT; (void)K;
    unsigned voffA[2], voffB[2];
#pragma unroll
    for (int i = 0; i < 2; ++i) { int R, C; stage_rc(tid * 16 + i * 8192, R, C); const int Rb = Epi::PERM ? ((R & ~31) + perm32(R & 31)) : R;
        voffA[i] = GATHER ? (unsigned)C * 2u : (unsigned)(R * lda + C * 2); voffB[i] = (unsigned)(Rb * ldb + C * 2); }
    const size_t kstep = (size_t)(BK * 2);
    const size_t hstepA = GATHER ? 0 : (size_t)HALF * lda, hstepB = (size_t)HALF * ldb;
    const unsigned ldsw = (unsigned)wid * 1024u, ldsbase = (unsigned)(size_t)lds;
    const int aoff = lds_byte(wr * 64 + fr, fq * 8), boff = lds_byte(wc * 32 + fr, fq * 8);
    const PG8_LAS unsigned char* ldsA = lds + aoff; const PG8_LAS unsigned char* ldsB = lds + 4 * HTB + boff; asm volatile("" : "+v"(ldsA), "+v"(ldsB));
    unsigned cg[2][2];
#define PG8_SA(b, h) (((b) * 2 + (h)) * HTB)
#define PG8_SB(b, h) ((4 + (b) * 2 + (h)) * HTB)
#define PG8_GLDS(sbase, voff32, ldsaddr) asm volatile("s_mov_b32 m0, %2\n\ts_nop 0\n\tglobal_load_lds_dwordx4 %0, %1" :: "v"(voff32), "s"(sbase), "s"(ldsaddr) : "memory", "m0")
#define PG8_STAGE(bufoff, gbase, voff) do { const char* _sb = (const char*)(gbase); _Pragma("unroll") for (int _i = 0; _i < 2; ++_i) \
        PG8_GLDS(_sb + (size_t)_i * 64 * ldb, (voff)[0], (unsigned)(ldsbase + (bufoff) + ldsw + _i * 8192)); } while (0)
#define PG8_STAGE_A(bufoff, abase, h, GO) do { const char* _sb = GATHER ? (const char*)(abase) : (const char*)(abase) + ((h) ? hstepA : (size_t)0); _Pragma("unroll") for (int _i = 0; _i < 2; ++_i) { \
        if constexpr (GATHER) PG8_GLDS(_sb, GO[h][_i], (unsigned)(ldsbase + (bufoff) + ldsw + _i * 8192)); \
        else PG8_GLDS(_sb + (size_t)_i * 64 * lda, voffA[0], (unsigned)(ldsbase + (bufoff) + ldsw + _i * 8192)); } } while (0)
#define PG8_GLOAD(dst, pm_) do { const int _t = wid * 64 + fresh_lane(); int rowA_[2]; unsigned colA_[2]; _Pragma("unroll") for (int _i = 0; _i < 2; ++_i) { int _R, _C; stage_rc(_t * 16 + _i * 8192, _R, _C); rowA_[_i] = _R; colA_[_i] = (unsigned)_C * 2u; }   \
        _Pragma("unroll") for (int _h = 0; _h < 2; ++_h) _Pragma("unroll") for (int _i = 0; _i < 2; ++_i) \
        dst[_h][_i] = (unsigned)g.ltab[(pm_) * BM + _h * HALF + rowA_[_i]] * (unsigned)lda + colA_[_i]; } while (0)
#define PG8_GSWITCH do { if constexpr (GATHER) { if (last && has_next) { PG8_GLOAD(cg, ui + 1); } } } while (0)
#define PG8_LDA(dst, b, h) do { _Pragma("unroll") for (int m = 0; m < 4; ++m) { if constexpr (FP8) { typedef int i32x4_ __attribute__((ext_vector_type(4))); \
        dst##8[m] = __builtin_shufflevector(*(const PG8_LAS i32x4_*)(ldsA + PG8_SA(b, h) + m * 2048), *(const PG8_LAS i32x4_*)(ldsA + PG8_SA(b, h) + m * 2048 + 1024), 0, 1, 2, 3, 4, 5, 6, 7); } \
        else { _Pragma("unroll") for (int k = 0; k < 2; ++k) dst[m][k] = *(const PG8_LAS bf16x8*)(ldsA + PG8_SA(b, h) + m * 2048 + k * 1024); } } } while (0)
#define PG8_LDB(dst, b, h) do { _Pragma("unroll") for (int n = 0; n < 2; ++n) { if constexpr (FP8) { typedef int i32x4_ __attribute__((ext_vector_type(4))); \
        dst##8[n] = __builtin_shufflevector(*(const PG8_LAS i32x4_*)(ldsB + PG8_SA(b, h) + n * 2048), *(const PG8_LAS i32x4_*)(ldsB + PG8_SA(b, h) + n * 2048 + 1024), 0, 1, 2, 3, 4, 5, 6, 7); } \
        else { _Pragma("unroll") for (int k = 0; k < 2; ++k) dst[n][k] = *(const PG8_LAS bf16x8*)(ldsB + PG8_SA(b, h) + n * 2048 + k * 1024); } } } while (0)
#define PG8_MMA(ai, bj, At, Bt) do { __builtin_amdgcn_s_setprio(1); _Pragma("unroll") for (int m = 0; m < 4; ++m) _Pragma("unroll") for (int n = 0; n < 2; ++n) { \
        if constexpr (FP8) acc[ai][bj][m][n] = __builtin_amdgcn_mfma_scale_f32_16x16x128_f8f6f4(Bt##8[n], At##8[m], acc[ai][bj][m][n], 0, 0, 0, 0x7f7f7f7f, 0, 0x7f7f7f7f); \
        else { _Pragma("unroll") for (int k = 0; k < 2; ++k) acc[ai][bj][m][n] = __builtin_amdgcn_mfma_f32_16x16x32_bf16(Bt[n][k], At[m][k], acc[ai][bj][m][n], 0, 0, 0); } } \
        __builtin_amdgcn_s_setprio(0); } while (0)
#define PG8_WAIT_V(n) asm volatile("s_waitcnt vmcnt(" #n ")" ::: "memory")
#define PG8_WAIT_L(n) asm volatile("s_waitcnt lgkmcnt(" #n ")" ::: "memory")
#define PG8_BAR __builtin_amdgcn_s_barrier()
#define PG8_SCHED __builtin_amdgcn_sched_barrier(0)
    Unit cur, nxt; int ui = 0;
    if (!S.next(0, cur)) return;
    f32x4 acc[2][2][4][2];
#pragma unroll
    for (int a = 0; a < 2; ++a)
#pragma unroll
        for (int b = 0; b < 2; ++b)
#pragma unroll
            for (int m = 0; m < 4; ++m)
#pragma unroll
                for (int n = 0; n < 2; ++n) acc[a][b][m][n] = (f32x4){0.f, 0.f, 0.f, 0.f};
    bf16x8 At[4][2], B0[2][2], B1[2][2]; i32x8 At8[4], B08[2], B18[2];
    const char* cA = GATHER ? (const char*)g.A : (const char*)g.A + (size_t)cur.ao * ELT; const char* cB = (const char*)g.Bt + (size_t)cur.bo * ELT;
    if constexpr (GATHER) {
        for (int i = 0; i < 8; ++i) { Unit u_; if (!S.next(i, u_)) break; if (tid < BM) g.ltab[i * BM + tid] = g.arow[u_.pm * BM + tid]; }
        asm volatile("s_waitcnt vmcnt(0) lgkmcnt(0)" ::: "memory"); PG8_BAR; asm volatile("" ::: "memory");
        PG8_GLOAD(cg, 0); }
    if constexpr (SP2) {
        PG8_STAGE(PG8_SB(0, 0), cB, voffB); PG8_STAGE(PG8_SB(0, 1), cB + hstepB, voffB); PG8_STAGE_A(PG8_SA(0, 0), cA, 0, cg); PG8_STAGE_A(PG8_SA(0, 1), cA, 1, cg);
        if (wr == 1) PG8_BAR;
        PG8_WAIT_V(2); PG8_BAR;
        PG8_STAGE(PG8_SB(1, 0), cB + kstep, voffB); PG8_STAGE_A(PG8_SA(1, 0), cA + kstep, 0, cg); PG8_STAGE(PG8_SB(1, 1), cB + hstepB + kstep, voffB);
        PG8_WAIT_V(6); PG8_BAR;
    } else {
        PG8_STAGE(PG8_SB(0, 0), cB, voffB); PG8_STAGE_A(PG8_SA(0, 0), cA, 0, cg); PG8_STAGE(PG8_SB(0, 1), cB + hstepB, voffB); PG8_STAGE_A(PG8_SA(0, 1), cA, 1, cg);
        if (wr == 1) PG8_BAR;
        PG8_WAIT_V(4); PG8_BAR;
        PG8_STAGE(PG8_SB(1, 0), cB + kstep, voffB); PG8_STAGE_A(PG8_SA(1, 0), cA + kstep, 0, cg); PG8_STAGE(PG8_SB(1, 1), cB + hstepB + kstep, voffB);
        PG8_WAIT_V(6); PG8_BAR;
    }
    for (;;) {
        const bool has_next = S.next(ui + 1, nxt);
        const char* nA = GATHER ? (const char*)g.A : (has_next ? (const char*)g.A + (size_t)nxt.ao * ELT : cA);
        const char* nB = has_next ? (const char*)g.Bt + (size_t)nxt.bo * ELT : cB;
#pragma unroll 1
        for (int t = 0; t < nt; t += 2) {
            const bool last = (t == nt - 2);
            const char* a1 = cA + (size_t)(t + 1) * kstep;
            const char* a2 = last ? nA : cA + (size_t)(t + 2) * kstep; const char* b2 = last ? nB : cB + (size_t)(t + 2) * kstep;
            const char* a3 = a2 + kstep; const char* b3 = b2 + kstep;
            if constexpr (SP2) {
            PG8_LDB(B0, 0, 0); PG8_LDB(B1, 0, 1); PG8_SCHED; PG8_LDA(At, 0, 0); PG8_STAGE_A(PG8_SA(1, 1), a1, 1, cg); PG8_GSWITCH;
            PG8_WAIT_V(8); PG8_WAIT_L(0); PG8_BAR; PG8_MMA(0, 0, At, B0); PG8_MMA(0, 1, At, B1); PG8_BAR; PG8_SCHED;
            PG8_LDA(At, 0, 1); PG8_STAGE(PG8_SB(0, 0), b2, voffB); PG8_STAGE(PG8_SB(0, 1), b2 + hstepB, voffB); PG8_STAGE_A(PG8_SA(0, 0), a2, 0, cg);
            PG8_WAIT_V(8); PG8_WAIT_L(0); PG8_BAR; PG8_MMA(1, 0, At, B0); PG8_MMA(1, 1, At, B1); PG8_BAR; PG8_SCHED;
            PG8_LDB(B0, 1, 0); PG8_LDB(B1, 1, 1); PG8_SCHED; PG8_LDA(At, 1, 0); PG8_STAGE_A(PG8_SA(0, 1), a2, 1, cg);
            PG8_WAIT_V(8); PG8_WAIT_L(0); PG8_BAR; PG8_MMA(0, 0, At, B0); PG8_MMA(0, 1, At, B1); PG8_BAR; PG8_SCHED;
            PG8_LDA(At, 1, 1); PG8_STAGE(PG8_SB(1, 0), b3, voffB); PG8_STAGE(PG8_SB(1, 1), b3 + hstepB, voffB); PG8_STAGE_A(PG8_SA(1, 0), a3, 0, cg);
            PG8_WAIT_V(8); PG8_WAIT_L(0); PG8_BAR; PG8_MMA(1, 0, At, B0); PG8_MMA(1, 1, At, B1); PG8_BAR; PG8_SCHED;
            } else {
            PG8_LDB(B0, 0, 0); PG8_SCHED; PG8_LDA(At, 0, 0); PG8_STAGE_A(PG8_SA(1, 1), a1, 1, cg); PG8_GSWITCH;
            PG8_WAIT_L(8); PG8_BAR; PG8_WAIT_L(0); PG8_MMA(0, 0, At, B0); PG8_BAR; PG8_SCHED;
            PG8_LDB(B1, 0, 1); PG8_STAGE(PG8_SB(0, 0), b2, voffB);
            PG8_BAR; PG8_WAIT_L(0); PG8_MMA(0, 1, At, B1); PG8_BAR;
            PG8_LDA(At, 0, 1); PG8_STAGE_A(PG8_SA(0, 0), a2, 0, cg);
            PG8_BAR; PG8_WAIT_L(0); PG8_MMA(1, 0, At, B0); PG8_BAR; PG8_SCHED;
            PG8_STAGE(PG8_SB(0, 1), b2 + hstepB, voffB);
            PG8_WAIT_V(6); PG8_BAR; PG8_MMA(1, 1, At, B1); PG8_BAR;
            PG8_LDB(B0, 1, 0); PG8_SCHED; PG8_LDA(At, 1, 0); PG8_STAGE_A(PG8_SA(0, 1), a2, 1, cg);
            PG8_WAIT_L(8); PG8_BAR; PG8_WAIT_L(0); PG8_MMA(0, 0, At, B0); PG8_BAR; PG8_SCHED;
            PG8_LDB(B1, 1, 1); PG8_STAGE(PG8_SB(1, 0), b3, voffB);
            PG8_BAR; PG8_WAIT_L(0); PG8_MMA(0, 1, At, B1); PG8_BAR;
            PG8_LDA(At, 1, 1); PG8_STAGE_A(PG8_SA(1, 0), a3, 0, cg);
            PG8_BAR; PG8_WAIT_L(0); PG8_MMA(1, 0, At, B0); PG8_BAR; PG8_SCHED;
            PG8_STAGE(PG8_SB(1, 1), b3 + hstepB, voffB);
            PG8_WAIT_V(6); PG8_BAR; PG8_MMA(1, 1, At, B1); PG8_BAR;
            }
        }
        if constexpr (ALIGN_EPI) { if (wr == 0) PG8_BAR; }
        { const int _l = fresh_lane(); E(acc, cur, wr, wc, _l & 15, _l >> 4); }
        if (!has_next) break;
#pragma unroll
        for (int a = 0; a < 2; ++a)
#pragma unroll
            for (int b = 0; b < 2; ++b)
#pragma unroll
                for (int m = 0; m < 4; ++m)
#pragma unroll
                    for (int n = 0; n < 2; ++n) acc[a][b][m][n] = (f32x4){0.f, 0.f, 0.f, 0.f};
        cur = nxt; cA = nA; cB = nB; ++ui;
        if constexpr (ALIGN_EPI) { if (wr == 1) PG8_BAR; }
    }
    PG8_WAIT_V(0);
    if constexpr (!ALIGN_EPI) { if (wr == 0) PG8_BAR; }
    PG8_BAR;
#undef PG8_SA
#undef PG8_SB
#undef PG8_STAGE
#undef PG8_GLDS
#undef PG8_STAGE_A
#undef PG8_GLOAD
#undef PG8_GSWITCH
#undef PG8_LDA
#undef PG8_LDB
#undef PG8_MMA
#undef PG8_WAIT_V
#undef PG8_WAIT_L
#undef PG8_BAR
#undef PG8_SCHED
}
}
namespace pg8 {

__device__ __forceinline__ float fast_sigmoid_mul(float x, float z) { return x * __builtin_amdgcn_rcpf(1.f + __builtin_amdgcn_exp2f(-1.4426950408889634f * z)); }
__device__ __forceinline__ float gelu_t(float x) { const float u = 0.7978845608028654f * (x + 0.044715f * x * x * x); return fast_sigmoid_mul(x, 2.f * u); }
__device__ __forceinline__ float silu_f(float x) { return fast_sigmoid_mul(x, x); }
__device__ __forceinline__ u32x4 pack8(const f32x4 v0, const f32x4 v1) { u32x4 w; w.x = cvt_pk_bf16(v0[0], v0[1]); w.y = cvt_pk_bf16(v0[2], v0[3]); w.z = cvt_pk_bf16(v1[0], v1[1]); w.w = cvt_pk_bf16(v1[2], v1[3]); return w; }

struct EpiBf16 {
    static constexpr bool PERM = true;
    bf16_t* O; int ldo; float scale;
    __device__ __forceinline__ void operator()(f32x4 (&acc)[2][2][4][2], const Unit& u, int wr, int wc, int fr, int fq) const {
        const int row0 = u.pm * BM + wr * 64 + fr, col0 = u.pn * BM + wc * 32 + 8 * fq;
#pragma unroll
        for (int ai = 0; ai < 2; ++ai)
#pragma unroll
            for (int m = 0; m < 4; ++m) { bf16_t* rowp = O + (size_t)(row0 + ai * HALF + m * 16) * ldo + col0;
#pragma unroll
                for (int bj = 0; bj < 2; ++bj) *(u32x4*)(rowp + bj * HALF) = pack8(acc[ai][bj][m][0] * scale, acc[ai][bj][m][1] * scale); }
    }
};
__device__ __forceinline__ unsigned pk4_fp8(float a, float b, float c, float d) {
    a = __builtin_amdgcn_fmed3f(a, -448.f, 448.f); b = __builtin_amdgcn_fmed3f(b, -448.f, 448.f); c = __builtin_amdgcn_fmed3f(c, -448.f, 448.f); d = __builtin_amdgcn_fmed3f(d, -448.f, 448.f);
    unsigned p; asm volatile("" : "=v"(p));
    p = (unsigned)__builtin_amdgcn_cvt_pk_fp8_f32(a, b, (int)p, false); p = (unsigned)__builtin_amdgcn_cvt_pk_fp8_f32(c, d, (int)p, true); return p;
}
__device__ __forceinline__ unsigned pk4_fp8_nc(float a, float b, float c, float d) {
    unsigned p; asm volatile("" : "=v"(p));
    p = (unsigned)__builtin_amdgcn_cvt_pk_fp8_f32(a, b, (int)p, false); p = (unsigned)__builtin_amdgcn_cvt_pk_fp8_f32(c, d, (int)p, true); return p;
}
__device__ __forceinline__ u32x4 widen16(const u32x2 a, const u32x2 b) {
    const auto r0 = __builtin_amdgcn_permlane16_swap(a.x, b.x, false, false), r1 = __builtin_amdgcn_permlane16_swap(a.y, b.y, false, false);
    u32x4 v; v.x = r0[0]; v.y = r1[0]; v.z = r0[1]; v.w = r1[1]; return v;
}
constexpr float F8_XS = 16.f, F8_WS = 64.f, F8_HS = 8.f;
struct EpiF8 {
    static constexpr bool PERM = true;
    unsigned char* O; int ldo; float scale;
    __device__ __forceinline__ void operator()(f32x4 (&acc)[2][2][4][2], const Unit& u, int wr, int wc, int fr, int fq) const {
        const int row0 = u.pm * BM + wr * 64 + fr, col0 = u.pn * BM + wc * 32 + 8 * fq;
#pragma unroll
        for (int ai = 0; ai < 2; ++ai)
#pragma unroll
            for (int m = 0; m < 4; ++m) { unsigned char* rowp = O + (size_t)(row0 + ai * HALF + m * 16) * ldo + col0; u32x2 w[2];
#pragma unroll
                for (int bj = 0; bj < 2; ++bj) { const f32x4 v0 = acc[ai][bj][m][0] * scale, v1 = acc[ai][bj][m][1] * scale;
                    w[bj].x = pk4_fp8(v0[0], v0[1], v0[2], v0[3]); w[bj].y = pk4_fp8(v1[0], v1[1], v1[2], v1[3]); }
                *(u32x4*)(rowp + ((fq & 1) ? HALF - 8 : 0)) = widen16(w[0], w[1]); }
    }
};
constexpr float F8_MS = 64.f, F8_PS = 256.f, F8_NS = 16.f, F8_DS = 32.f, F8_YS = 256.f;
struct EpiGU8 {
    static constexpr bool PERM = true;
    unsigned char* HS8;
    __device__ __forceinline__ void operator()(f32x4 (&acc)[2][2][4][2], const Unit& u, int wr, int wc, int fr, int fq) const {
        const int row0 = u.pm * BM + wr * 64 + fr, col0 = u.pn * HALF + wc * 32 + 8 * fq;
        constexpr float s = 1.f / (F8_XS * F8_WS);
#pragma unroll
        for (int ai = 0; ai < 2; ++ai) { u32x2 wq[4];
#pragma unroll
            for (int m = 0; m < 4; ++m) {
                f32x4 h[2];
#pragma unroll
                for (int n = 0; n < 2; ++n) { const f32x4 g = acc[ai][0][m][n], up = acc[ai][1][m][n];
                    const f32x4 t = g * (-s * 1.4426950408889634f); f32x4 d;
#pragma unroll
                    for (int j = 0; j < 4; ++j) d[j] = __builtin_amdgcn_exp2f(t[j]);
                    d = d + 1.f; f32x4 r;
#pragma unroll
                    for (int j = 0; j < 4; ++j) r[j] = __builtin_amdgcn_rcpf(d[j]);
                    h[n] = ((g * up) * (s * s * F8_HS)) * r; }
                wq[m].x = pk4_fp8(h[0][0], h[0][1], h[0][2], h[0][3]); wq[m].y = pk4_fp8(h[1][0], h[1][1], h[1][2], h[1][3]); }
#pragma unroll
            for (int m = 0; m < 4; m += 2) {
                unsigned char* p16 = HS8 + (size_t)(row0 + ai * HALF + (m + (fq & 1)) * 16) * nv::DE + col0 - ((fq & 1) ? 8 : 0);
                *(u32x4*)p16 = widen16(wq[m], wq[m + 1]); } }
    }
};
template <bool OUT8>
struct EpiSoftmaxT {
    static constexpr bool PERM = true;
    void* O; PG8_LAS float* tbl;
    const PG8_LAS f32x2* st; const PG8_LAS f32x2* cv; const PG8_LAS int* tag;
    __device__ __forceinline__ void operator()(f32x4 (&acc)[2][2][4][2], const Unit& u, int wr, int wc, int fr, int fq) const {
        const int row0 = u.pm * BM + wr * 64 + fr, col0 = u.pn * BM + wc * 32 + 8 * fq;
        int slot = 0; { const int key = u.pm * 4 + u.pn;
#pragma unroll
            for (int i = 1; i < 4; ++i) if (tag[i] == key) slot = i; }
        slot = __builtin_amdgcn_readfirstlane(slot);
#pragma unroll
        for (int bj = 0; bj < 2; ++bj) {
            f32x4 c1[2], c0[2];
            { const PG8_LAS f32x4* cp = (const PG8_LAS f32x4*)(cv + slot * 256 + bj * HALF + wc * 32 + 8 * fq);
#pragma unroll
              for (int n = 0; n < 2; ++n) { const f32x4 lo = cp[2 * n], hi = cp[2 * n + 1]; c1[n] = (f32x4){lo[0], lo[2], hi[0], hi[2]}; c0[n] = (f32x4){lo[1], lo[3], hi[1], hi[3]}; } }
#pragma unroll
            for (int ai = 0; ai < 2; ++ai)
#pragma unroll
                for (int m = 0; m < 4; ++m) { const f32x2 ac = st[slot * 256 + ai * HALF + wr * 64 + m * 16 + fr];
#pragma unroll
                    for (int n = 0; n < 2; ++n) { acc[ai][bj][m][n] = acc[ai][bj][m][n] * ac[0] + (c1[n] * ac[1] + c0[n]); asm volatile("" : "+v"(acc[ai][bj][m][n])); } }
        }
#pragma unroll
        for (int ai = 0; ai < 2; ++ai)
#pragma unroll
            for (int m = 0; m < 4; ++m) { float mx = -INFINITY;
#pragma unroll
                for (int bj = 0; bj < 2; ++bj)
#pragma unroll
                    for (int n = 0; n < 2; ++n)
#pragma unroll
                        for (int j = 0; j < 4; ++j) mx = fmaxf(mx, acc[ai][bj][m][n][j]);
                mx = fmaxf(mx, nv::swz_xor<16>(mx));
                { const auto r = __builtin_amdgcn_permlane32_swap(__float_as_uint(mx), __float_as_uint(mx), false, false); mx = fmaxf(__uint_as_float(r[0]), __uint_as_float(r[1])); }
                if (fq == 0) tbl[(ai * HALF + wr * 64 + m * 16 + fr) * 4 + wc] = mx; }
        asm volatile("s_waitcnt lgkmcnt(0)" ::: "memory"); __builtin_amdgcn_s_barrier(); asm volatile("" ::: "memory");
#pragma unroll
        for (int ai = 0; ai < 2; ++ai)
#pragma unroll
            for (int m = 0; m < 4; ++m) { const f32x4 t4 = *(const PG8_LAS f32x4*)(tbl + (ai * HALF + wr * 64 + m * 16 + fr) * 4);
                const float M = fmaxf(fmaxf(t4[0], t4[1]), fmaxf(t4[2], t4[3])); f32x4 sv = (f32x4){0.f, 0.f, 0.f, 0.f};
#pragma unroll
                for (int bj = 0; bj < 2; ++bj)
#pragma unroll
                    for (int n = 0; n < 2; ++n) { const f32x4 d = acc[ai][bj][m][n] - M; f32x4 p;
#pragma unroll
                        for (int j = 0; j < 4; ++j) p[j] = __builtin_amdgcn_exp2f(d[j]);
                        acc[ai][bj][m][n] = p; sv = sv + p; }
                float s = (sv[0] + sv[1]) + (sv[2] + sv[3]);
                s += nv::swz_xor<16>(s);
                { const auto r = __builtin_amdgcn_permlane32_swap(__float_as_uint(s), __float_as_uint(s), false, false); s = __uint_as_float(r[0]) + __uint_as_float(r[1]); }
                if (fq == 0) tbl[1024 + (ai * HALF + wr * 64 + m * 16 + fr) * 4 + wc] = s; }
        asm volatile("s_waitcnt lgkmcnt(0)" ::: "memory"); __builtin_amdgcn_s_barrier(); asm volatile("" ::: "memory");
#pragma unroll
        for (int ai = 0; ai < 2; ++ai)
#pragma unroll
            for (int m = 0; m < 4; ++m) { const f32x4 t4 = *(const PG8_LAS f32x4*)(tbl + 1024 + (ai * HALF + wr * 64 + m * 16 + fr) * 4);
                const float inv = 1.f / ((t4[0] + t4[1]) + (t4[2] + t4[3]));
                if constexpr (OUT8) { unsigned char* rowp = (unsigned char*)O + (size_t)(row0 + ai * HALF + m * 16) * nv::D + col0; const float s8 = inv * F8_PS;
                    u32x2 w[2];
#pragma unroll
                    for (int bj = 0; bj < 2; ++bj) { const f32x4 v0 = acc[ai][bj][m][0] * s8, v1 = acc[ai][bj][m][1] * s8;
                        w[bj].x = pk4_fp8_nc(v0[0], v0[1], v0[2], v0[3]); w[bj].y = pk4_fp8_nc(v1[0], v1[1], v1[2], v1[3]); }
                    *(u32x4*)(rowp + ((fq & 1) ? HALF - 8 : 0)) = widen16(w[0], w[1]); }
                else { bf16_t* rowp = (bf16_t*)O + (size_t)(row0 + ai * HALF + m * 16) * nv::D + col0;
#pragma unroll
                    for (int bj = 0; bj < 2; ++bj) *(u32x4*)(rowp + bj * HALF) = pack8(acc[ai][bj][m][0] * inv, acc[ai][bj][m][1] * inv); } }
    }
};
struct EpiZ {
    static constexpr bool PERM = true;
    bf16_t* Z; unsigned char* ZG8; float* PART; const bf16_t* R; const float* g; float scale;
    __device__ __forceinline__ void operator()(f32x4 (&acc)[2][2][4][2], const Unit& u, int wr, int wc, int fr, int fq) const {
        const int row0 = u.pm * BM + wr * 64 + fr, col0 = u.pn * BM + wc * 32 + 8 * fq;
        f32x4 gv[2][2];
#pragma unroll
        for (int bj = 0; bj < 2; ++bj)
#pragma unroll
            for (int n = 0; n < 2; ++n) gv[bj][n] = *(const f32x4*)(g + col0 + bj * HALF + 4 * n) * F8_XS;
        u32x4 rr[8][2]; float ps[4], pq[4];
#define EPIZ_LOAD(r_) do { _Pragma("unroll") for (int bj = 0; bj < 2; ++bj) rr[r_][bj] = *(const u32x4*)(R + (size_t)(row0 + ((r_) >> 2) * HALF + ((r_) & 3) * 16) * nv::D + col0 + bj * HALF); } while (0)
#pragma unroll
        for (int r = 0; r < 2; ++r) EPIZ_LOAD(r);
#pragma unroll
        for (int r = 0; r < 8; ++r) { const int ai = r >> 2, m = r & 3;
            asm volatile("" ::: "memory");
            { const size_t off = (size_t)(row0 + ai * HALF + m * 16) * nv::D + col0; float s = 0.f, q = 0.f; u32x2 wz[2];
#pragma unroll
                for (int bj = 0; bj < 2; ++bj) { const u32x4 x = rr[r][bj];
                    f32x4 r0, r1; r0[0] = __uint_as_float(x.x << 16); r0[1] = __uint_as_float(x.x & 0xffff0000u); r0[2] = __uint_as_float(x.y << 16); r0[3] = __uint_as_float(x.y & 0xffff0000u);
                    r1[0] = __uint_as_float(x.z << 16); r1[1] = __uint_as_float(x.z & 0xffff0000u); r1[2] = __uint_as_float(x.w << 16); r1[3] = __uint_as_float(x.w & 0xffff0000u);
                    const f32x4 z0 = r0 * nv::ALPHA + acc[ai][bj][m][0] * scale, z1 = r1 * nv::ALPHA + acc[ai][bj][m][1] * scale;
                    *(u32x4*)(Z + off + bj * HALF) = pack8(z0, z1);
                    { const f32x4 sv = z0 + z1, qv = z0 * z0 + z1 * z1; s += (sv[0] + sv[1]) + (sv[2] + sv[3]); q += (qv[0] + qv[1]) + (qv[2] + qv[3]); }
                    const f32x4 v0 = z0 * gv[bj][0], v1 = z1 * gv[bj][1];
                    wz[bj].x = pk4_fp8(v0[0], v0[1], v0[2], v0[3]); wz[bj].y = pk4_fp8(v1[0], v1[1], v1[2], v1[3]); }
                *(u32x4*)(ZG8 + off + ((fq & 1) ? HALF - 8 : 0)) = widen16(wz[0], wz[1]);
                s += nv::swz_xor<16>(s); q += nv::swz_xor<16>(q);
                { const auto p = __builtin_amdgcn_permlane32_swap(__float_as_uint(s), __float_as_uint(s), false, false); s = __uint_as_float(p[0]) + __uint_as_float(p[1]); }
                { const auto p = __builtin_amdgcn_permlane32_swap(__float_as_uint(q), __float_as_uint(q), false, false); q = __uint_as_float(p[0]) + __uint_as_float(p[1]); }
                ps[m] = s; pq[m] = q;
                if (m == 3) { f32x2 o; o[0] = fq == 0 ? ps[0] : fq == 1 ? ps[1] : fq == 2 ? ps[2] : ps[3]; o[1] = fq == 0 ? pq[0] : fq == 1 ? pq[1] : fq == 2 ? pq[2] : pq[3];
                    *(f32x2*)(PART + ((size_t)(row0 + ai * HALF + fq * 16) * 16 + u.pn * 4 + wc) * 2) = o; } }
            asm volatile("" ::: "memory");
            if (r + 2 < 8) EPIZ_LOAD(r + 2);
        }
#undef EPIZ_LOAD
    }
};
struct EpiInproj0 {
    static constexpr bool PERM = true;
    bf16_t* O; const float* rope; float in_scale;
    __device__ __forceinline__ void operator()(f32x4 (&acc)[2][2][4][2], const Unit& u, int wr, int wc, int fr, int fq) const {
        const int row0 = u.pm * BM + wr * 64 + fr, col0 = u.pn * BM + wc * 32 + 8 * fq;
#pragma unroll
        for (int ai = 0; ai < 2; ++ai)
#pragma unroll
            for (int bj = 0; bj < 2; ++bj)
#pragma unroll
                for (int m = 0; m < 4; ++m) { acc[ai][bj][m][0] *= in_scale; acc[ai][bj][m][1] *= in_scale; }
        if (u.pn >= 3) {
#pragma unroll
            for (int ai = 0; ai < 2; ++ai)
#pragma unroll
                for (int m = 0; m < 4; ++m) { bf16_t* rowp = O + (size_t)(row0 + ai * HALF + m * 16) * nv::NIN0 + col0;
#pragma unroll
                    for (int bj = 0; bj < 2; ++bj) { f32x4 v[2];
#pragma unroll
                        for (int n = 0; n < 2; ++n) { const f32x4 x = acc[ai][bj][m][n]; constexpr float k1 = -2.f * 0.7978845608028654f * 1.4426950408889634f, k3 = k1 * 0.044715f;
                            const f32x4 t = x * ((x * x) * k3 + k1); f32x4 d;
#pragma unroll
                            for (int j = 0; j < 4; ++j) d[j] = __builtin_amdgcn_exp2f(t[j]);
                            d = d + 1.f; f32x4 r;
#pragma unroll
                            for (int j = 0; j < 4; ++j) r[j] = __builtin_amdgcn_rcpf(d[j]);
                            v[n] = x * r; }
                        *(u32x4*)(rowp + bj * HALF) = pack8(v[0], v[1]); } }
        } else {
            const bool wave_rope = (wc & 1) == 0;
            const float sgn = fq == 0 ? -1.f : 1.f;
#pragma unroll
            for (int ai = 0; ai < 2; ++ai)
#pragma unroll
                for (int m = 0; m < 4; ++m) { const int row = row0 + ai * HALF + m * 16; bf16_t* rowp = O + (size_t)row * nv::NIN0 + col0;
                    f32x4 c0, c1, s0, s1;
                    if (wave_rope) { const float* rp = rope + (size_t)row * 16; c0 = *(const f32x4*)rp; c1 = *(const f32x4*)(rp + 4); s0 = *(const f32x4*)(rp + 8); s1 = *(const f32x4*)(rp + 12); }
#pragma unroll
                    for (int bj = 0; bj < 2; ++bj) { f32x4 v0 = acc[ai][bj][m][0], v1 = acc[ai][bj][m][1];
                        if (wave_rope && (u.pn < 2 || bj == 0)) {
                            f32x4 p0, p1;
#pragma unroll
                            for (int j = 0; j < 4; ++j) { p0[j] = nv::swz_xor<16>(v0[j]); p1[j] = nv::swz_xor<16>(v1[j]); }
                            if (fq < 2) {
#pragma unroll
                                for (int j = 0; j < 4; ++j) { v0[j] = v0[j] * c0[j] + sgn * p0[j] * s0[j]; v1[j] = v1[j] * c1[j] + sgn * p1[j] * s1[j]; } }
                        }
                        *(u32x4*)(rowp + bj * HALF) = pack8(v0, v1); } }
        }
    }
};
}

#define LAS __attribute__((address_space(3)))
#define GAS __attribute__((address_space(1)))
typedef GAS unsigned gu32;
#define RLX_AGENT __ATOMIC_RELAXED, __HIP_MEMORY_SCOPE_AGENT
#define LDS_WAIT() asm volatile("s_waitcnt lgkmcnt(0)" ::: "memory")
#define VM_WAIT() asm volatile("s_waitcnt vmcnt(0)" ::: "memory")

#define XB_TMO      128
#define XB_XCNT(j)  (256  + 64 * (j))
#define XB_XSUB(j)  (1280 + 64 * (j))
#define XB_XGEN(j)  (2304 + 64 * (j))
#define XB_TOP      3328
#define XB_TOPGEN   3392
#define XCD_BAR_WORDS 3456
#define XB_SPIN_CAP (1u << 18)
__device__ __forceinline__ unsigned xb_ld(unsigned* p)              { return __hip_atomic_load(p, __ATOMIC_RELAXED, __HIP_MEMORY_SCOPE_AGENT); }
__device__ __forceinline__ unsigned xb_add(unsigned* p, unsigned v) { return __hip_atomic_fetch_add(p, v, __ATOMIC_RELAXED, __HIP_MEMORY_SCOPE_AGENT); }
__device__ __forceinline__ unsigned xb_xcc_id() { return (unsigned)__builtin_amdgcn_s_getreg((3 << 11) | 20) & 0xFu; }
#define XB_SPIN(cond, bar) do { unsigned _sp = 0; while (cond) { __builtin_amdgcn_s_sleep(1); \
    if ((++_sp & 255u) == 0u) { if (xb_ld(&(bar)[XB_TMO])) break; if (_sp > XB_SPIN_CAP) { atomicAdd(&(bar)[XB_TMO], 1u); break; } } } } while (0)
struct XcdBarrier { unsigned* bar; unsigned x; volatile LAS unsigned* st; int wave; };
__device__ __forceinline__ unsigned lane_id_fresh() { unsigned m = ~0u; asm volatile("" : "+s"(m)); return __builtin_amdgcn_mbcnt_hi(m, __builtin_amdgcn_mbcnt_lo(m, 0u)); }
__device__ __forceinline__ bool xb_thread0(int wave) { return wave == 0 && lane_id_fresh() == 0u; }
__device__ __forceinline__ XcdBarrier xcd_barrier_post(unsigned* bar, volatile LAS unsigned* st, int wave) {
    XcdBarrier b; b.bar = bar; b.x = xb_xcc_id(); b.st = st; b.wave = wave;
    if (xb_thread0(wave)) (void)xb_add(&bar[XB_XCNT(b.x)], 1u);
    return b;
}
__device__ __forceinline__ void xcd_barrier_complete(unsigned* bar, unsigned x, unsigned& nloc, unsigned& nx) {
    const unsigned G = gridDim.x * gridDim.y * gridDim.z;
    unsigned sum, cnt, mine, sp = 0u;
    for (;;) {
        sum = 0u; cnt = 0u; mine = 0u;
#pragma unroll
        for (unsigned j = 0; j < 16; ++j) { const unsigned c = xb_ld(&bar[XB_XCNT(j)]); sum += c; cnt += (c > 0u) ? 1u : 0u; mine = (j == x) ? c : mine; }
        if (sum == G) break;
        __builtin_amdgcn_s_sleep(1);
        if ((++sp & 255u) == 0u) { if (xb_ld(&bar[XB_TMO])) break; if (sp > XB_SPIN_CAP) { atomicAdd(&bar[XB_TMO], 1u); break; } }
    }
    nloc = mine > 0u ? mine : 1u; nx = cnt > 0u ? cnt : 1u;
}
__device__ __forceinline__ void xcd_barrier(const XcdBarrier& b) {
    asm volatile("s_waitcnt vmcnt(0)" ::: "memory");
    __syncthreads();
    if (xb_thread0(b.wave)) {
        unsigned* bar = b.bar;
        __builtin_amdgcn_s_waitcnt(0);
        unsigned nloc = b.st[0], nx = b.st[1];
        if (nloc == 0u) { xcd_barrier_complete(bar, b.x, nloc, nx); b.st[0] = nloc; b.st[1] = nx; }
        const unsigned old = xb_add(&bar[XB_XSUB(b.x)], 1u);
        const unsigned gen = old / nloc;
        if (old + 1u == (gen + 1u) * nloc) {
            __builtin_amdgcn_fence(__ATOMIC_RELEASE, "agent");
            asm volatile("s_waitcnt vmcnt(0)" ::: "memory");
            const unsigned og = xb_add(&bar[XB_TOP], 1u);
            const unsigned tg = og / nx;
            asm volatile("buffer_inv sc1" ::: "memory");
            if (og + 1u == (tg + 1u) * nx) xb_add(&bar[XB_TOPGEN], 1u);
            else XB_SPIN(xb_ld(&bar[XB_TOPGEN]) == tg, bar);
            asm volatile("" ::: "memory");
            xb_add(&bar[XB_XGEN(b.x)], 1u);
            asm volatile("s_waitcnt vmcnt(0)" ::: "memory");
        } else {
            asm volatile("buffer_inv sc1" ::: "memory");
            XB_SPIN(xb_ld(&bar[XB_XGEN(b.x)]) == gen, bar);
            asm volatile("s_waitcnt vmcnt(0)" ::: "memory");
        }
    }
    __syncthreads();
}

namespace mk {
using namespace nv;
typedef unsigned v4u __attribute__((ext_vector_type(4)));
typedef unsigned v2u __attribute__((ext_vector_type(2)));
typedef float f32x4 __attribute__((ext_vector_type(4)));
constexpr int NWAVES = 8, NTHREADS = 512;
constexpr int LDS_BYTES = 160 * 1024;
constexpr int MISC_OFF = LDS_BYTES - 256;
constexpr int CW_BAR = 4096;
constexpr size_t CTL_ZERO_BYTES = 64 * 1024;

__device__ __forceinline__ unsigned pk2(float lo, float hi) { return pg8::cvt_pk_bf16(lo, hi); }

struct Frame {
    LAS unsigned char* lds; int tid, lane, wave, vcu, G, bx;
};

struct TItem { const float* src; unsigned char* dst; int ldw, ldt, k0, n0, dr, f8; };
template <int MAP, bool F8>
__device__ __forceinline__ void titem_fill(TItem& t, const void* srcp, int K, int N, void* dstp, size_t dstb, int r) {
    const int nblk = N / 32, per = (K / 64) * nblk, bi = r / per, it = r % per, kb = it / nblk, nb = it % nblk, n0 = 32 * nb;
    int dr = n0; if (MAP == 1) dr = (n0 >> 7) * 256 + (n0 & 127); if (MAP == 2) dr = (n0 >> 7) * 256 + 128 + (n0 & 127);
    t.src = (const float*)srcp + (size_t)bi * K * N; t.dst = (unsigned char*)dstp + (size_t)bi * dstb * (F8 ? 1 : 2); t.ldw = N; t.ldt = K; t.k0 = 64 * kb; t.n0 = n0; t.dr = dr; t.f8 = F8 ? 1 : 0;
}
struct TRegs { f32x4 v[8]; };
__device__ __forceinline__ void titem_load(const TItem& t, int lane, TRegs& R) {
    const float* p = t.src + (size_t)(t.k0 + (lane >> 3)) * t.ldw + t.n0 + (lane & 7) * 4;
#pragma unroll
    for (int i = 0; i < 8; ++i) R.v[i] = __builtin_nontemporal_load((const f32x4*)(p + (size_t)(8 * i) * t.ldw));
}
__device__ __forceinline__ void titem_finish(const TItem& t, int lane, const TRegs& R, LAS float* scr) {
    const float sc = t.f8 ? pg8::F8_WS : 1.f;
    { LAS float* d = scr + (lane >> 3) * 33 + (lane & 7) * 4;
#pragma unroll
      for (int i = 0; i < 8; ++i) { d[(8 * i) * 33 + 0] = R.v[i][0] * sc; d[(8 * i) * 33 + 1] = R.v[i][1] * sc; d[(8 * i) * 33 + 2] = R.v[i][2] * sc; d[(8 * i) * 33 + 3] = R.v[i][3] * sc; } }
    LDS_WAIT(); asm volatile("" ::: "memory");
    const int c = lane & 7;
#pragma unroll
    for (int j = 0; j < 4; ++j) { const int n = (lane >> 3) + 8 * j; const LAS float* s = scr + (8 * c) * 33 + n;
        if (t.f8) { v2u o; o.x = pg8::pk4_fp8(s[0 * 33], s[1 * 33], s[2 * 33], s[3 * 33]); o.y = pg8::pk4_fp8(s[4 * 33], s[5 * 33], s[6 * 33], s[7 * 33]);
            __builtin_nontemporal_store(o, (v2u*)(t.dst + (size_t)(t.dr + n) * t.ldt + t.k0 + 8 * c)); }
        else { v4u o; o.x = pk2(s[0 * 33], s[1 * 33]); o.y = pk2(s[2 * 33], s[3 * 33]); o.z = pk2(s[4 * 33], s[5 * 33]); o.w = pk2(s[6 * 33], s[7 * 33]);
            __builtin_nontemporal_store(o, (v4u*)((bf16_t*)t.dst + (size_t)(t.dr + n) * t.ldt + t.k0 + 8 * c)); } }
    LDS_WAIT(); asm volatile("" ::: "memory");
}

struct InvFreq { float f[8]; };
struct Args {
    const void* in[40]; float* out; unsigned char* ws; InvFreq inv; int ph_lo, ph_hi;
};

struct RowV { float v[16]; };
__device__ __forceinline__ void unpk8(const v4u u, float* x) {
    x[0] = __uint_as_float(u.x << 16); x[1] = __uint_as_float(u.x & 0xffff0000u); x[2] = __uint_as_float(u.y << 16); x[3] = __uint_as_float(u.y & 0xffff0000u);
    x[4] = __uint_as_float(u.z << 16); x[5] = __uint_as_float(u.z & 0xffff0000u); x[6] = __uint_as_float(u.w << 16); x[7] = __uint_as_float(u.w & 0xffff0000u);
}
struct RowRaw { v4u a, b; };
__device__ __forceinline__ RowRaw load_raw(const bf16_t* p, int lane) { RowRaw r; r.a = __builtin_nontemporal_load((const v4u*)(p + 8 * lane)); r.b = __builtin_nontemporal_load((const v4u*)(p + 512 + 8 * lane)); return r; }
__device__ __forceinline__ void unpack_row(const RowRaw& r, RowV& x) { unpk8(r.a, x.v); unpk8(r.b, x.v + 8); }
struct RowRaw8 { v2u a, b; };
__device__ __forceinline__ RowRaw8 load_raw8(const unsigned char* p, int lane) { RowRaw8 r; r.a = __builtin_nontemporal_load((const v2u*)(p + 8 * lane)); r.b = __builtin_nontemporal_load((const v2u*)(p + 512 + 8 * lane)); return r; }
__device__ __forceinline__ void unpk8_fp8(const v2u u, float* x, float s) {
    typedef float v2f_ __attribute__((ext_vector_type(2)));
    const v2f_ a = __builtin_amdgcn_cvt_pk_f32_fp8((int)u.x, false), b = __builtin_amdgcn_cvt_pk_f32_fp8((int)u.x, true), c = __builtin_amdgcn_cvt_pk_f32_fp8((int)u.y, false), d = __builtin_amdgcn_cvt_pk_f32_fp8((int)u.y, true);
    x[0] = a[0] * s; x[1] = a[1] * s; x[2] = b[0] * s; x[3] = b[1] * s; x[4] = c[0] * s; x[5] = c[1] * s; x[6] = d[0] * s; x[7] = d[1] * s;
}
__device__ __forceinline__ void unpack_row8(const RowRaw8& r, RowV& x, float s) { unpk8_fp8(r.a, x.v, s); unpk8_fp8(r.b, x.v + 8, s); }
struct GB { float g[16], b[16]; };
__device__ __forceinline__ void load_gb(const float* g, const float* b, int lane, GB& o) {
#pragma unroll
    for (int hh = 0; hh < 2; ++hh)
#pragma unroll
        for (int q = 0; q < 2; ++q) { const float4 gg = *(const float4*)(g + 512 * hh + 8 * lane + 4 * q), bb = *(const float4*)(b + 512 * hh + 8 * lane + 4 * q);
            o.g[8 * hh + 4 * q + 0] = gg.x; o.g[8 * hh + 4 * q + 1] = gg.y; o.g[8 * hh + 4 * q + 2] = gg.z; o.g[8 * hh + 4 * q + 3] = gg.w;
            o.b[8 * hh + 4 * q + 0] = bb.x; o.b[8 * hh + 4 * q + 1] = bb.y; o.b[8 * hh + 4 * q + 2] = bb.z; o.b[8 * hh + 4 * q + 3] = bb.w; }
}
__device__ __forceinline__ void ln_rowv(RowV& z, const GB& gb) {
    float s = 0.f, q = 0.f;
#pragma unroll
    for (int i = 0; i < 16; ++i) { s += z.v[i]; q += z.v[i] * z.v[i]; }
    s += swz_xor<1>(s); q += swz_xor<1>(q); s += swz_xor<2>(s); q += swz_xor<2>(q); s += swz_xor<4>(s); q += swz_xor<4>(q); s += swz_xor<8>(s); q += swz_xor<8>(q); s += swz_xor<16>(s); q += swz_xor<16>(q);
    { const auto r = __builtin_amdgcn_permlane32_swap(__float_as_uint(s), __float_as_uint(s), false, false); s = __uint_as_float(r[0]) + __uint_as_float(r[1]); }
    { const auto r = __builtin_amdgcn_permlane32_swap(__float_as_uint(q), __float_as_uint(q), false, false); q = __uint_as_float(r[0]) + __uint_as_float(r[1]); }
    const float mu = s * (1.f / D), var = fmaxf(q * (1.f / D) - mu * mu, 0.f);
    const float rstd = 1.f / sqrtf(var + LN_EPS), c = -mu * rstd;
#pragma unroll
    for (int i = 0; i < 16; ++i) z.v[i] = (z.v[i] * rstd + c) * gb.g[i] + gb.b[i];
}
__device__ __forceinline__ void store_rowv_bf16(bf16_t* p, int lane, const RowV& r) {
    v4u a, b; a.x = pk2(r.v[0], r.v[1]); a.y = pk2(r.v[2], r.v[3]); a.z = pk2(r.v[4], r.v[5]); a.w = pk2(r.v[6], r.v[7]);
    b.x = pk2(r.v[8], r.v[9]); b.y = pk2(r.v[10], r.v[11]); b.z = pk2(r.v[12], r.v[13]); b.w = pk2(r.v[14], r.v[15]);
    *(v4u*)(p + 8 * lane) = a; *(v4u*)(p + 512 + 8 * lane) = b;
}
__device__ __forceinline__ unsigned dpp_xor1(unsigned v) { return (unsigned)__builtin_amdgcn_update_dpp(0, (int)v, 0xB1  , 0xF, 0xF, true); }
__device__ __forceinline__ void store_rowv_fp8(unsigned char* p, int lane, const RowV& r, float s) {
    v2u a, b; a.x = pg8::pk4_fp8(r.v[0] * s, r.v[1] * s, r.v[2] * s, r.v[3] * s); a.y = pg8::pk4_fp8(r.v[4] * s, r.v[5] * s, r.v[6] * s, r.v[7] * s);
    b.x = pg8::pk4_fp8(r.v[8] * s, r.v[9] * s, r.v[10] * s, r.v[11] * s); b.y = pg8::pk4_fp8(r.v[12] * s, r.v[13] * s, r.v[14] * s, r.v[15] * s);
    const bool odd = (lane & 1) != 0;
    const unsigned rx = dpp_xor1(odd ? a.x : b.x), ry = dpp_xor1(odd ? a.y : b.y);
    v4u o; o.x = odd ? rx : a.x; o.y = odd ? ry : a.y; o.z = odd ? b.x : rx; o.w = odd ? b.y : ry;
    *(v4u*)(p + (odd ? 512 + 8 * (lane - 1) : 8 * lane)) = o;
}
constexpr int LNR = 4;

__device__ __forceinline__ void phase_ln_add(const Frame& F, const bf16_t* X, const bf16_t* Y, const float* g, const float* b, bf16_t* out, unsigned char* out8) {
    const int gw = F.vcu * NWAVES + F.wave, NGW = F.G * NWAVES;
    GB gb; load_gb(g, b, F.lane, gb);
    for (int row = gw; row < T; row += LNR * NGW) {
        RowRaw rx[LNR], ry[LNR];
#pragma unroll
        for (int k = 0; k < LNR; ++k) { const int rr = row + k * NGW; if (rr < T) { rx[k] = load_raw(X + (size_t)rr * D, F.lane); if (Y) ry[k] = load_raw(Y + (size_t)rr * D, F.lane); } }
#pragma unroll
        for (int k = 0; k < LNR; ++k) { const int rr = row + k * NGW; if (rr < T) {
            RowV x; unpack_row(rx[k], x);
            if (Y) { RowV y; unpack_row(ry[k], y);
#pragma unroll
                for (int i = 0; i < 16; ++i) x.v[i] = ALPHA * x.v[i] + y.v[i]; }
            ln_rowv(x, gb);
            store_rowv_bf16(out + (size_t)rr * D, F.lane, x);
            store_rowv_fp8(out8 + (size_t)rr * D, F.lane, x, pg8::F8_XS); } }
    }
}
__device__ __forceinline__ void phase_ln_moe(const Frame& F, const bf16_t* X, const unsigned char* DS, const int* pos, const float* ewgt, const float* g, const float* b, bf16_t* outb, float* outf, unsigned char* out8) {
    const int gw = F.vcu * NWAVES + F.wave, NGW = F.G * NWAVES;
    GB gb; load_gb(g, b, F.lane, gb);
    for (int row = gw; row < T; row += LNR * NGW) {
        RowRaw rx[LNR]; RowRaw8 r1[LNR], r2[LNR]; float w1[LNR], w2[LNR];
#pragma unroll
        for (int k = 0; k < LNR; ++k) { const int rr = row + k * NGW; if (rr < T) {
            const int2 pp = *(const int2*)(pos + 2 * rr); const float2 ww = *(const float2*)(ewgt + 2 * rr); w1[k] = ww.x; w2[k] = ww.y;
            rx[k] = load_raw(X + (size_t)rr * D, F.lane); r1[k] = load_raw8(DS + (size_t)pp.x * D, F.lane); r2[k] = load_raw8(DS + (size_t)pp.y * D, F.lane); } }
#pragma unroll
        for (int k = 0; k < LNR; ++k) { const int rr = row + k * NGW; if (rr < T) {
            RowV x, y1, y2; unpack_row(rx[k], x); unpack_row8(r1[k], y1, 1.f / pg8::F8_DS); unpack_row8(r2[k], y2, 1.f / pg8::F8_DS);
#pragma unroll
            for (int i = 0; i < 16; ++i) x.v[i] = ALPHA * x.v[i] + (w1[k] * y1.v[i] + w2[k] * y2.v[i]);
            ln_rowv(x, gb);
            if (outb) store_rowv_bf16(outb + (size_t)rr * D, F.lane, x);
            if (out8) store_rowv_fp8(out8 + (size_t)rr * D, F.lane, x, pg8::F8_XS);
            if (outf) { float* o = outf + (size_t)rr * D + 8 * F.lane;
                { f32x4 a0 = {x.v[0], x.v[1], x.v[2], x.v[3]}, a1 = {x.v[4], x.v[5], x.v[6], x.v[7]}, a2 = {x.v[8], x.v[9], x.v[10], x.v[11]}, a3 = {x.v[12], x.v[13], x.v[14], x.v[15]};
                  __builtin_nontemporal_store(a0, (f32x4*)(o)); __builtin_nontemporal_store(a1, (f32x4*)(o + 4)); __builtin_nontemporal_store(a2, (f32x4*)(o + 512)); __builtin_nontemporal_store(a3, (f32x4*)(o + 516)); } } } }
    }
}
__device__ __forceinline__ void phase_cvec(const Frame& F, const unsigned char* MT8, const float* g, const float* b, float* CV) {
    const int gw = F.vcu * NWAVES + F.wave, NGW = F.G * NWAVES;
    GB gb; load_gb(g, b, F.lane, gb);
    for (int r0 = gw; r0 < B * XH * MEM; r0 += 2 * NGW) {
      RowRaw8 rw2[2];
#pragma unroll
      for (int k = 0; k < 2; ++k) { const int r = r0 + k * NGW < B * XH * MEM ? r0 + k * NGW : r0; rw2[k] = load_raw8(MT8 + (size_t)r * D, F.lane); }
#pragma unroll
      for (int k = 0; k < 2; ++k) { const int r = r0 + k * NGW; if (r < B * XH * MEM) {
        RowV m; unpack_row8(rw2[k], m, 1.f / pg8::F8_MS);
        float s1 = 0.f, s0 = 0.f;
#pragma unroll
        for (int i = 0; i < 16; ++i) { s1 += gb.g[i] * m.v[i]; s0 += gb.b[i] * m.v[i]; }
        s1 = wave_sum(s1); s0 = wave_sum(s0);
        if (F.lane < 2) CV[2 * (size_t)r + F.lane] = F.lane == 0 ? s1 : s0;
      } }
    }
}
template <class Sched>
__device__ __forceinline__ void scores_prepass(const Frame& F, const Sched& S, const float* PART, const float* CV, float in_scale, LAS float* st, LAS float* cv, LAS int* tag) {
#pragma unroll 1
    for (int i = 0; i < 4; ++i) { pg8::Unit u; const bool ok = S.next(i, u);
        if (F.tid == 0) tag[i] = ok ? u.pm * 4 + u.pn : -1;
        if (!ok) continue;
        if (F.tid < 256) { const f32x4* p = (const f32x4*)(PART + ((size_t)u.pm * 256 + F.tid) * 32); float s = 0.f, q = 0.f;
#pragma unroll
            for (int j = 0; j < 8; ++j) { const f32x4 v = p[j]; s += v[0] + v[2]; q += v[1] + v[3]; }
            const float mu = s * (1.f / D), var = fmaxf(q * (1.f / D) - mu * mu, 0.f), rstd = 1.f / sqrtf(var + LN_EPS);
            st[(i * 256 + F.tid) * 2] = rstd * in_scale; st[(i * 256 + F.tid) * 2 + 1] = -mu * rstd; }
        else { const int t = F.tid - 256; const float2 c = *(const float2*)(CV + 2 * (size_t)((u.pm >> 5) * 1024 + u.pn * 256 + t)); cv[(i * 256 + t) * 2] = c.x; cv[(i * 256 + t) * 2 + 1] = c.y; }
    }
    __syncthreads();
}
constexpr int RW_LD = 20, GBL_LD = 68;
__device__ __forceinline__ void lds_gb(const LAS float* gp, GB& o) {
#pragma unroll
    for (int q4 = 0; q4 < 4; ++q4) { const f32x4 gg = *(const LAS f32x4*)(gp + 4 * q4), bb = *(const LAS f32x4*)(gp + 16 + 4 * q4);
        o.g[4 * q4] = gg[0]; o.g[4 * q4 + 1] = gg[1]; o.g[4 * q4 + 2] = gg[2]; o.g[4 * q4 + 3] = gg[3]; o.b[4 * q4] = bb[0]; o.b[4 * q4 + 1] = bb[1]; o.b[4 * q4 + 2] = bb[2]; o.b[4 * q4 + 3] = bb[3]; }
}
__device__ __forceinline__ void phase_ln_router(const Frame& F, const bf16_t* X, const float* g1, const float* b1, const unsigned char* Y, const float* g, const float* b, bf16_t* out, unsigned char* out8, const float* rw, const float* rbias, int* eidx, float* ewgt, int* bcnt) {
    LAS float* rwl = (LAS float*)F.lds;
    LAS int* hist = (LAS int*)(F.lds + 1024 * RW_LD * 4);
    LAS float* lgs = (LAS float*)(F.lds + 1024 * RW_LD * 4 + 256) + F.wave * 256;
    { float4 rv[8];
#pragma unroll
      for (int u = 0; u < 8; ++u) { const int i = F.tid + u * NTHREADS, k = i >> 2, q = i & 3; rv[u] = *(const float4*)(rw + (size_t)k * 16 + 4 * q); }
#pragma unroll
      for (int u = 0; u < 8; ++u) { const int i = F.tid + u * NTHREADS, k = i >> 2, q = i & 3; const float4 v = rv[u];
        const int j = (k >> 9) * 8 + (k & 7), l = (k >> 3) & 63; LAS float* d = rwl + (j * 64 + l) * RW_LD + 4 * q; d[0] = v.x; d[1] = v.y; d[2] = v.z; d[3] = v.w; } }
    LAS float* g1l = (LAS float*)(F.lds + 1024 * RW_LD * 4 + 256 + 8192);
    { float gv[8];
#pragma unroll
      for (int u = 0; u < 8; ++u) { const int i = F.tid + u * NTHREADS, sel = i >> 10, k = i & 1023; const float* src = sel == 0 ? g1 : sel == 1 ? b1 : sel == 2 ? g : b; gv[u] = src[k]; }
#pragma unroll
      for (int u = 0; u < 8; ++u) { const int i = F.tid + u * NTHREADS, sel = i >> 10, k = i & 1023; g1l[((k >> 3) & 63) * GBL_LD + sel * 16 + (k >> 9) * 8 + (k & 7)] = gv[u]; } }
    const int lane = F.lane;
    for (int vb = F.vcu; vb < T / 128; vb += F.G) {
        if (F.tid < 16) hist[F.tid] = 0;
        __syncthreads();
        RowRaw rx[4]; RowRaw8 ry[4];
#pragma unroll
        for (int k = 0; k < 4; ++k) { const int r_ = vb * 128 + F.wave * 16 + k; rx[k] = load_raw(X + (size_t)r_ * D, lane); ry[k] = load_raw8(Y + (size_t)r_ * D, lane); }
#pragma unroll 1
        for (int it = 0; it < 4; ++it) {
            const int row0 = vb * 128 + F.wave * 16 + it * 4;
            RowV x[4];
#pragma unroll
            for (int k = 0; k < 4; ++k) { unpack_row(rx[k], x[k]);
                { GB gb1; lds_gb(g1l + lane * GBL_LD, gb1); ln_rowv(x[k], gb1); }
                { RowV y; unpack_row8(ry[k], y, 1.f / pg8::F8_YS);
#pragma unroll
                    for (int i = 0; i < 16; ++i) x[k].v[i] = ALPHA * x[k].v[i] + y.v[i]; }
                { GB gb; lds_gb(g1l + lane * GBL_LD + 32, gb); ln_rowv(x[k], gb); }
                store_rowv_bf16(out + (size_t)(row0 + k) * D, lane, x[k]);
                store_rowv_fp8(out8 + (size_t)(row0 + k) * D, lane, x[k], pg8::F8_XS); }
            if (it < 3) {
#pragma unroll
              for (int k = 0; k < 4; ++k) { rx[k] = load_raw(X + (size_t)(row0 + 4 + k) * D, lane); ry[k] = load_raw8(Y + (size_t)(row0 + 4 + k) * D, lane); } }
            typedef float f32x2_ __attribute__((ext_vector_type(2)));
            f32x2_ v2[32];
#pragma unroll
            for (int i = 0; i < 32; ++i) v2[i] = (f32x2_){0.f, 0.f};
#pragma unroll
            for (int j = 0; j < 16; ++j) { const LAS float* wr = rwl + (j * 64 + lane) * RW_LD;
#pragma unroll
                for (int e4 = 0; e4 < 4; ++e4) { const f32x4 w4 = *(const LAS f32x4*)(wr + 4 * e4); const f32x2_ wlo = (f32x2_){w4[0], w4[1]}, whi = (f32x2_){w4[2], w4[3]};
#pragma unroll
                    for (int k = 0; k < 4; ++k) { const f32x2_ xx = (f32x2_){x[k].v[j], x[k].v[j]};
                        v2[8 * k + 2 * e4 + 0] = __builtin_elementwise_fma(xx, wlo, v2[8 * k + 2 * e4 + 0]); v2[8 * k + 2 * e4 + 1] = __builtin_elementwise_fma(xx, whi, v2[8 * k + 2 * e4 + 1]); } } }
            float val[64];
#pragma unroll
            for (int i = 0; i < 32; ++i) { val[2 * i] = v2[i][0]; val[2 * i + 1] = v2[i][1]; }
#pragma unroll
            for (int i = 0; i < 32; ++i) { const auto rr = __builtin_amdgcn_permlane32_swap(__float_as_uint(val[i]), __float_as_uint(val[i + 32]), false, false); val[i] = __uint_as_float(rr[0]) + __uint_as_float(rr[1]); }
            { const bool bt = (lane & 16) != 0;
#pragma unroll
              for (int i = 0; i < 16; ++i) { const float keep = bt ? val[i + 16] : val[i], send = bt ? val[i] : val[i + 16]; val[i] = keep + swz_xor<16>(send); } }
            { const bool bt = (lane & 8) != 0;
#pragma unroll
              for (int i = 0; i < 8; ++i) { const float keep = bt ? val[i + 8] : val[i], send = bt ? val[i] : val[i + 8]; val[i] = keep + swz_xor<8>(send); } }
            { const bool bt = (lane & 4) != 0;
#pragma unroll
              for (int i = 0; i < 4; ++i) { const float keep = bt ? val[i + 4] : val[i], send = bt ? val[i] : val[i + 4]; val[i] = keep + swz_xor<4>(send); } }
            { const bool bt = (lane & 2) != 0;
#pragma unroll
              for (int i = 0; i < 2; ++i) { const float keep = bt ? val[i + 2] : val[i], send = bt ? val[i] : val[i + 2]; val[i] = keep + swz_xor<2>(send); } }
            { const bool bt = (lane & 1) != 0; const float keep = bt ? val[1] : val[0], send = bt ? val[0] : val[1]; val[0] = keep + swz_xor<1>(send); }
            lgs[it * 64 + lane] = val[0];
        }
        LDS_WAIT();
        if (lane < 16) {
            {
                const int row = vb * 128 + F.wave * 16 + lane;
                float lg[16];
#pragma unroll
                for (int e4 = 0; e4 < 4; ++e4) { const f32x4 t4 = *(const LAS f32x4*)(lgs + 16 * lane + 4 * e4); lg[4 * e4] = t4[0]; lg[4 * e4 + 1] = t4[1]; lg[4 * e4 + 2] = t4[2]; lg[4 * e4 + 3] = t4[3]; }
                float mx = lg[0];
#pragma unroll
                for (int e = 1; e < 16; ++e) mx = fmaxf(mx, lg[e]);
                float sc[16], sum = 0.f;
#pragma unroll
                for (int e = 0; e < 16; ++e) { sc[e] = __expf(lg[e] - mx); sum += sc[e]; }
                const float isum = 1.f / sum;
                float bz[16];
#pragma unroll
                for (int e = 0; e < 16; ++e) { sc[e] *= isum; bz[e] = sc[e] + rbias[e]; }
                float gs[4]; int gi1[4], gi2[4];
#pragma unroll
                for (int gq = 0; gq < 4; ++gq) {
                    float m1 = bz[4 * gq]; int i1 = 0;
#pragma unroll
                    for (int j = 1; j < 4; ++j) if (bz[4 * gq + j] > m1) { m1 = bz[4 * gq + j]; i1 = j; }
                    float m2 = -INFINITY; int i2 = 0;
#pragma unroll
                    for (int j = 0; j < 4; ++j) if (j != i1 && bz[4 * gq + j] > m2) { m2 = bz[4 * gq + j]; i2 = j; }
                    gs[gq] = m1 + m2; gi1[gq] = i1; gi2[gq] = i2;
                }
                int gsel = 0; float gm = gs[0];
#pragma unroll
                for (int gq = 1; gq < 4; ++gq) if (gs[gq] > gm) { gm = gs[gq]; gsel = gq; }
                int i1 = gi1[0], i2 = gi2[0];
#pragma unroll
                for (int gq = 1; gq < 4; ++gq) if (gsel == gq) { i1 = gi1[gq]; i2 = gi2[gq]; }
                const int e1 = gsel * 4 + i1, e2 = gsel * 4 + i2;
                float s1 = 0.f, s2 = 0.f;
#pragma unroll
                for (int e = 0; e < 16; ++e) { if (e == e1) s1 = sc[e]; if (e == e2) s2 = sc[e]; }
                const float inv = 1.f / (s1 + s2);
                *(int2*)(eidx + 2 * row) = make_int2(e1, e2); *(float2*)(ewgt + 2 * row) = make_float2(s1 * inv, s2 * inv);
                atomicAdd((int*)&hist[e1], 1); atomicAdd((int*)&hist[e2], 1);
            }
        }
        __syncthreads();
        if (F.tid < 16) bcnt[vb * 16 + F.tid] = hist[F.tid];
        __syncthreads();
    }
}
__device__ __forceinline__ void phase_moe_book(const Frame& F, const int* eidx, const int* bcnt, int* tok, int* pos, int* tile_e) {
    LAS int* bc = (LAS int*)F.lds;
    LAS int* part = bc + 4096;
    LAS int* off = part + 256;
    LAS int* base = off + 32;
    LAS int* tot = base + 16;
    LAS int* wcnt = tot + 16;
    for (int i = F.tid; i < 4096; i += NTHREADS) bc[i] = bcnt[i];
    __syncthreads();
    if (F.tid < 256) { const int e = F.tid & 15, ch = F.tid >> 4; int s = 0;
#pragma unroll
        for (int j = 0; j < 16; ++j) s += bc[(ch * 16 + j) * 16 + e];
        part[ch * 16 + e] = s; }
    __syncthreads();
    if (F.tid < 16) { int t = 0;
#pragma unroll
        for (int ch = 0; ch < 16; ++ch) t += part[ch * 16 + F.tid];
        tot[F.tid] = t; }
    __syncthreads();
    if (F.tid == 0) { int o = 0;
#pragma unroll
        for (int e = 0; e < 16; ++e) { off[e] = o; o += (tot[e] + 255) & ~255; } off[16] = o; }
    __syncthreads();
    for (int vb = F.vcu; vb < T / 128; vb += F.G) {
        if (F.tid < 16) { const int e = F.tid, chv = vb >> 4; int bs = 0;
            for (int ch = 0; ch < chv; ++ch) bs += part[ch * 16 + e];
            for (int b2 = chv * 16; b2 < vb; ++b2) bs += bc[b2 * 16 + e];
            base[e] = bs; }
        int e = 0, rank = 0;
        if (F.tid < 256) {
            e = eidx[vb * 256 + F.tid];
            const unsigned long long lt = (1ull << F.lane) - 1ull;
#pragma unroll
            for (int k = 0; k < 16; ++k) { const unsigned long long mk = __ballot(e == k); if (e == k) rank = __popcll(mk & lt); if (F.lane == 0) wcnt[F.wave * 16 + k] = __popcll(mk); }
        }
        __syncthreads();
        if (F.tid < 256) {
            for (int w2 = 0; w2 < F.wave; ++w2) rank += wcnt[w2 * 16 + e];
            const int r = off[e] + base[e] + rank;
            pos[vb * 256 + F.tid] = r; tok[r] = vb * 128 + (F.tid >> 1);
        }
        if (vb < 16) { const int e2 = vb, r0 = off[e2] + tot[e2], r1 = off[e2 + 1]; for (int r = r0 + F.tid; r < r1; r += NTHREADS) tok[r] = 0; }
        if (vb == 16) {
            for (int tl = F.tid; tl < NTILE; tl += NTHREADS) { int e3 = -1;
#pragma unroll
                for (int k = 0; k < 16; ++k) if (tl * 256 >= off[k] && tl * 256 < off[k + 1]) e3 = k;
                tile_e[tl] = e3; }
            if (F.tid == 0) tile_e[NTILE] = off[16] >> 8;
        }
        __syncthreads();
    }
}
__device__ __forceinline__ void phase_pool(const Frame& F, const bf16_t* HP, unsigned char* PO) {
    constexpr int RUN = 16;
    const int gt = F.vcu * NTHREADS + F.tid, NGT = F.G * NTHREADS;
#pragma unroll 1
    for (int it = gt; it < (T / RUN) * (D / 8); it += NGT) {
        const int c8 = it & 127, run = it >> 7, g = c8 >> 5, win = 2 << g, t0 = run * RUN, ts0 = t0 & (S - 1);
        const bf16_t* hp = HP + (size_t)t0 * D + c8 * 8; unsigned char* po = PO + (size_t)t0 * D + c8 * 8;
        v4u raw[31];
#pragma unroll
        for (int j = 0; j < 31; ++j) { raw[j] = (v4u){0u, 0u, 0u, 0u}; if (j >= 15 || ts0 > 0) raw[j] = *(const v4u*)(hp + (ptrdiff_t)(j - 15) * D); }
        float s[8];
#pragma unroll
        for (int q = 0; q < 8; ++q) s[q] = 0.f;
#pragma unroll
        for (int k = 1; k < 16; ++k) { float v[8]; unpk8(raw[15 - k], v); const bool in = k < win;
#pragma unroll
            for (int q = 0; q < 8; ++q) s[q] += in ? v[q] : 0.f; }
#pragma unroll
        for (int i = 0; i < RUN; ++i) {
            float hn[8]; unpk8(raw[15 + i], hn);
            const int ts = ts0 + i;
#pragma unroll
            for (int q = 0; q < 8; ++q) s[q] += hn[q];
            const float inv = 1.f / (float)(ts + 1 < win ? ts + 1 : win);
            v2u o; const float xs = pg8::F8_XS; o.x = pg8::pk4_fp8((s[0] * inv - hn[0]) * xs, (s[1] * inv - hn[1]) * xs, (s[2] * inv - hn[2]) * xs, (s[3] * inv - hn[3]) * xs); o.y = pg8::pk4_fp8((s[4] * inv - hn[4]) * xs, (s[5] * inv - hn[5]) * xs, (s[6] * inv - hn[6]) * xs, (s[7] * inv - hn[7]) * xs);
            *(v2u*)(po + (size_t)i * D) = o;
            { const v4u r2 = raw[14 + i], r4 = raw[12 + i], r8 = raw[8 + i], r16 = raw[i]; v4u lv;
              lv.x = g == 0 ? r2.x : g == 1 ? r4.x : g == 2 ? r8.x : r16.x; lv.y = g == 0 ? r2.y : g == 1 ? r4.y : g == 2 ? r8.y : r16.y;
              lv.z = g == 0 ? r2.z : g == 1 ? r4.z : g == 2 ? r8.z : r16.z; lv.w = g == 0 ? r2.w : g == 1 ? r4.w : g == 2 ? r8.w : r16.w;
              float ho[8]; unpk8(lv, ho);
#pragma unroll
              for (int q = 0; q < 8; ++q) s[q] -= ho[q]; }
        }
    }
}
}
namespace mk {
typedef short bf16x8 __attribute__((ext_vector_type(8)));
typedef float f32x16 __attribute__((ext_vector_type(16)));
#define MFMA32(a, b, c) __builtin_amdgcn_mfma_f32_32x32x16_bf16((a), (b), (c), 0, 0, 0)
__device__ __forceinline__ int crow(int i, int h) { return (i & 3) + 8 * (i >> 2) + 4 * h; }
__device__ __forceinline__ float swap32_max(float v) { const auto r = __builtin_amdgcn_permlane32_swap(__float_as_uint(v), __float_as_uint(v), false, false); return fmaxf(__uint_as_float(r[0]), __uint_as_float(r[1])); }
__device__ __forceinline__ float swap32_sum(float v) { const auto r = __builtin_amdgcn_permlane32_swap(__float_as_uint(v), __float_as_uint(v), false, false); return __uint_as_float(r[0]) + __uint_as_float(r[1]); }
__device__ __forceinline__ unsigned pkbf(float lo, float hi) { unsigned r; asm volatile("v_cvt_pk_bf16_f32 %0, %1, %2" : "=v"(r) : "v"(lo), "v"(hi)); return r; }
__device__ __forceinline__ bf16x8 pack_step(const f32x16& x, int s) {
    v4u p; p.x = pkbf(x[8 * s + 0], x[8 * s + 1]); p.y = pkbf(x[8 * s + 2], x[8 * s + 3]); p.z = pkbf(x[8 * s + 4], x[8 * s + 5]); p.w = pkbf(x[8 * s + 6], x[8 * s + 7]);
    return __builtin_bit_cast(bf16x8, p);
}
__device__ __forceinline__ bf16x8 lds_frag2x8(const LAS unsigned char* p) {
    const v2u a = *(const LAS v2u*)p, b = *(const LAS v2u*)(p + 16);
    v4u q; q.x = a.x; q.y = a.y; q.z = b.x; q.w = b.y; return __builtin_bit_cast(bf16x8, q);
}
__device__ __forceinline__ void unpack8(const v4u u, float (&x)[8]) {
    x[0] = __uint_as_float(u.x << 16); x[1] = __uint_as_float(u.x & 0xffff0000u); x[2] = __uint_as_float(u.y << 16); x[3] = __uint_as_float(u.y & 0xffff0000u);
    x[4] = __uint_as_float(u.z << 16); x[5] = __uint_as_float(u.z & 0xffff0000u); x[6] = __uint_as_float(u.w << 16); x[7] = __uint_as_float(u.w & 0xffff0000u);
}

__device__ __forceinline__ v4u widen4x4(unsigned i0, unsigned i1, unsigned i2, unsigned i3) {
    const auto a = __builtin_amdgcn_permlane32_swap(i0, i2, false, false), b = __builtin_amdgcn_permlane32_swap(i1, i3, false, false);
    v4u v; v.x = a[0]; v.y = a[1]; v.z = b[0]; v.w = b[1]; return v;
}
constexpr float F8_MIXS = 8.f;
__device__ __forceinline__ void phase_swa_sgu(const Frame& F, const bf16_t* H0, const float* sinks, const float* lng, const float* lnb, const bf16_t* SW, const float* bs, unsigned char* MIX) {
    constexpr int KSTR = 272, VSTR = 520, VT_OFF = 256 * KSTR, VGSTR = 272, VGW = 64 * VGSTR;
    LAS unsigned char* KS = F.lds; LAS unsigned char* VT = F.lds + VT_OFF;
    LAS float* gbl = (LAS float*)(F.lds + 8 * VGW);
    for (int i = F.tid; i < 1024; i += NTHREADS) gbl[i] = i < 512 ? lng[i] : lnb[i - 512];
    const int lane = F.lane, r = lane & 31, h = lane >> 5, w = F.wave, kvh = w >> 2;
    const float NEG = -INFINITY;
    for (int vb = F.vcu; vb < T / 128; vb += F.G) {
        const int n = vb & 63; const size_t row0 = (size_t)vb * 128;
#pragma unroll
        for (int i = 0; i < 8; ++i) { const int p = F.tid + NTHREADS * i, row = p >> 4, c16 = p & 15; v4u v = (v4u){0u, 0u, 0u, 0u};
            if (n > 0 || row >= 128) v = *(const v4u*)(H0 + (row0 + row - 128) * NIN0 + 512 + c16 * 8);
            *(LAS v4u*)(KS + row * KSTR + c16 * 16) = v; }
#pragma unroll
        for (int i = 0; i < 8; ++i) { const int p = F.tid + NTHREADS * i, c16 = p >> 8, row = p & 255; v4u v = (v4u){0u, 0u, 0u, 0u};
            if (n > 0 || row >= 128) v = *(const v4u*)(H0 + (row0 + row - 128) * NIN0 + 640 + c16 * 8);
            LAS bf16_t* d = (LAS bf16_t*)(VT + (c16 * 8) * VSTR + row * 2);
            d[0 * (VSTR / 2)] = (bf16_t)(v.x & 0xffffu); d[1 * (VSTR / 2)] = (bf16_t)(v.x >> 16); d[2 * (VSTR / 2)] = (bf16_t)(v.y & 0xffffu); d[3 * (VSTR / 2)] = (bf16_t)(v.y >> 16);
            d[4 * (VSTR / 2)] = (bf16_t)(v.z & 0xffffu); d[5 * (VSTR / 2)] = (bf16_t)(v.z >> 16); d[6 * (VSTR / 2)] = (bf16_t)(v.w & 0xffffu); d[7 * (VSTR / 2)] = (bf16_t)(v.w >> 16); }
        __syncthreads();
        const float sink2 = sinks[w] * 1.4426950408889634f;
        bf16x8 qn[4];
        { const bf16_t* qp = H0 + (row0 + r) * NIN0 + w * 64 + 8 * h;
#pragma unroll
          for (int ks = 0; ks < 4; ++ks) qn[ks] = *(const bf16x8*)(qp + 16 * ks); }
#pragma unroll 1
        for (int qg = 0; qg < 4; ++qg) {
            bf16x8 qf[4];
#pragma unroll
            for (int ks = 0; ks < 4; ++ks) qf[ks] = qn[ks];
            if (qg < 3) { const bf16_t* qp = H0 + (row0 + 32 * (qg + 1) + r) * NIN0 + w * 64 + 8 * h;
#pragma unroll
              for (int ks = 0; ks < 4; ++ks) qn[ks] = *(const bf16x8*)(qp + 16 * ks); }
            f32x16 st[5];
#pragma unroll
            for (int kt = 0; kt < 5; ++kt) {
#pragma unroll
                for (int i = 0; i < 16; ++i) st[kt][i] = 0.f;
                const LAS unsigned char* kp = KS + (32 * qg + 32 * kt + r) * KSTR + (kvh * 64 + 8 * h) * 2;
#pragma unroll
                for (int ks = 0; ks < 4; ++ks) { const bf16x8 kf = *(const LAS bf16x8*)(kp + 32 * ks); st[kt] = MFMA32(kf, qf[ks], st[kt]); }
            }
            float m = sink2;
            int rq = r; asm volatile("" : "+v"(rq));
#pragma unroll
            for (int kt = 0; kt < 5; ++kt)
#pragma unroll
                for (int i = 0; i < 16; ++i) { const int dk = 32 * kt + crow(i, h) - rq;
                    float s = st[kt][i] * ASCALE;
                    if (kt == 0) s = dk >= 1 ? s : NEG;
                    if (kt == 4) s = dk <= 128 ? s : NEG;
                    st[kt][i] = s; }
            if (n == 0) {
#pragma unroll
                for (int kt = 0; kt < 5; ++kt)
#pragma unroll
                    for (int i = 0; i < 16; ++i) if (32 * qg + 32 * kt + crow(i, h) < 128) st[kt][i] = NEG; }
#pragma unroll
            for (int kt = 0; kt < 5; ++kt)
#pragma unroll
                for (int i = 0; i < 16; ++i) m = fmaxf(m, st[kt][i]);
            m = swap32_max(m);
            float l = 0.f;
#pragma unroll
            for (int kt = 0; kt < 5; ++kt)
#pragma unroll
                for (int i = 0; i < 16; ++i) { const float p = __builtin_amdgcn_exp2f(st[kt][i] - m); st[kt][i] = p; l += p; }
            l = swap32_sum(l) + __builtin_amdgcn_exp2f(sink2 - m);
            f32x16 o[2];
#pragma unroll
            for (int i = 0; i < 16; ++i) { o[0][i] = 0.f; o[1][i] = 0.f; }
#pragma unroll
            for (int kt = 0; kt < 5; ++kt)
#pragma unroll
                for (int s = 0; s < 2; ++s) { const bf16x8 pf = pack_step(st[kt], s);
#pragma unroll
                    for (int dt = 0; dt < 2; ++dt) { const bf16x8 vf = lds_frag2x8(VT + (kvh * 64 + 32 * dt + r) * VSTR + (32 * qg + 32 * kt + 16 * s + 4 * h) * 2); o[dt] = MFMA32(vf, pf, o[dt]); } }
            const float inv = F8_MIXS / l;
            unsigned char* op = MIX + (row0 + 32 * qg + r) * D + w * 64 + 16 * h;
#pragma unroll
            for (int dt = 0; dt < 2; ++dt) { unsigned it4[4];
#pragma unroll
                for (int g4 = 0; g4 < 4; ++g4) it4[g4] = pg8::pk4_fp8(o[dt][4 * g4 + 0] * inv, o[dt][4 * g4 + 1] * inv, o[dt][4 * g4 + 2] * inv, o[dt][4 * g4 + 3] * inv);
                *(v4u*)(op + 32 * dt) = widen4x4(it4[0], it4[1], it4[2], it4[3]); }
        }
        __syncthreads();
        {
            LAS unsigned char* VG = F.lds + w * VGW; const int g = w;
            const int lane2 = (int)lane_id_fresh(), r2 = lane2 & 31, h2 = lane2 >> 5;
            v4u vraw[2][8];
#pragma unroll
            for (int it = 0; it < 2; ++it) { const bf16_t* vp = H0 + (row0 + 64 * it + lane2) * NIN0 + 1280 + g * 64;
#pragma unroll
                for (int cq = 0; cq < 8; ++cq) vraw[it][cq] = __builtin_nontemporal_load((const v4u*)(vp + 8 * cq)); }
#pragma unroll
            for (int it = 0; it < 2; ++it) { const int s = 64 * it + lane2;
                float x[8][8]; float sum = 0.f;
#pragma unroll
                for (int cq = 0; cq < 8; ++cq) { unpack8(vraw[it][cq], x[cq]);
#pragma unroll
                    for (int e = 0; e < 8; ++e) sum += x[cq][e]; }
                const float mu = sum * (1.f / 64.f); float q = 0.f;
#pragma unroll
                for (int cq = 0; cq < 8; ++cq)
#pragma unroll
                    for (int e = 0; e < 8; ++e) { x[cq][e] -= mu; q += x[cq][e] * x[cq][e]; }
                const float rstd = 1.f / sqrtf(q * (1.f / 64.f) + LN_EPS);
#pragma unroll
                for (int cq = 0; cq < 8; ++cq) { const LAS f32x4* gq = (const LAS f32x4*)(gbl + g * 64 + 8 * cq); const LAS f32x4* bq = (const LAS f32x4*)(gbl + 512 + g * 64 + 8 * cq);
                    const f32x4 g0 = gq[0], g1 = gq[1], b0 = bq[0], b1 = bq[1];
#pragma unroll
                    for (int e = 0; e < 8; ++e) { const int c = 8 * cq + e; const float gg = e < 4 ? g0[e & 3] : g1[e & 3], bb = e < 4 ? b0[e & 3] : b1[e & 3]; *(LAS bf16_t*)(VG + c * VGSTR + s * 2) = f2bf(x[cq][e] * rstd * gg + bb); } }
            }
            v2u uall[4][2][4];
#pragma unroll
            for (int tt = 0; tt < 4; ++tt) { const bf16_t* up = H0 + (row0 + 32 * tt + r2) * NIN0 + 768 + g * 64 + 4 * h2;
#pragma unroll
                for (int ct = 0; ct < 2; ++ct)
#pragma unroll
                    for (int g4 = 0; g4 < 4; ++g4) uall[tt][ct][g4] = *(const v2u*)(up + 32 * ct + 8 * g4); }
            LDS_WAIT();
#pragma unroll
            for (int tt = 0; tt < 4; ++tt) {
                f32x16 acc[2];
#pragma unroll
                for (int i = 0; i < 16; ++i) { acc[0][i] = 0.f; acc[1][i] = 0.f; }
                const bf16_t* wp = SW + ((size_t)(g * 128 + 32 * tt + r2) * 128 + 8 * h2);
                const int nks = 2 * (tt + 1);
                bf16x8 bfr[8];
#pragma unroll
                for (int ks = 0; ks < 8; ++ks) if (ks < nks) bfr[ks] = *(const bf16x8*)(wp + 16 * ks);
                const int t = 32 * tt + r2; const float bias = bs[g * 128 + t];
                unsigned char* op = MIX + (row0 + t) * D + 512 + g * 64 + 16 * h2;
#pragma unroll
                for (int ks = 0; ks < 8; ++ks) if (ks < nks) {
#pragma unroll
                    for (int ct = 0; ct < 2; ++ct) { const bf16x8 af = *(const LAS bf16x8*)(VG + (32 * ct + r2) * VGSTR + (16 * ks + 8 * h2) * 2); acc[ct] = MFMA32(af, bfr[ks], acc[ct]); } }
#pragma unroll
                for (int ct = 0; ct < 2; ++ct) { unsigned it4[4];
#pragma unroll
                    for (int g4 = 0; g4 < 4; ++g4) { const v2u u2 = uall[tt][ct][g4];
                        const float u0 = __uint_as_float(u2.x << 16), u1 = __uint_as_float(u2.x & 0xffff0000u), u2f = __uint_as_float(u2.y << 16), u3 = __uint_as_float(u2.y & 0xffff0000u);
                        it4[g4] = pg8::pk4_fp8(F8_MIXS * u0 * (acc[ct][4 * g4 + 0] + bias), F8_MIXS * u1 * (acc[ct][4 * g4 + 1] + bias), F8_MIXS * u2f * (acc[ct][4 * g4 + 2] + bias), F8_MIXS * u3 * (acc[ct][4 * g4 + 3] + bias)); }
                    *(v4u*)(op + 32 * ct) = widen4x4(it4[0], it4[1], it4[2], it4[3]); }
            }
        }
        __syncthreads();
    }
}

}
namespace mk {
constexpr int NPHASE = 23;
constexpr int N_EARLY = 896 + 2 * 1024, NITEMS = N_EARLY + 3 * 512 + 2 * (512 + 3 * 4096);
constexpr int GEMM_CUS_P1 = 160;

typedef const __attribute__((address_space(4))) Args* KArgs;
__device__ __forceinline__ KArgs kargs() { KArgs p = (KArgs)__builtin_amdgcn_kernarg_segment_ptr(); asm volatile("" : "+s"(p)); return p; }

__device__ __forceinline__ void decode_item(KArgs ka, bf16_t* WB, int it, TItem& t) {
                    int r = it;
#define JOB(MAP, F8_, src, K_, N_, dst, dstb, cnt) if (r < (cnt)) { titem_fill<MAP, F8_>(t, src, K_, N_, dst, dstb, r); return; } r -= (cnt);
                    JOB(0, true, ka->in[5], 1024, 1792, WB + WB_IN0, 0, 896)
                    JOB(0, false, ka->in[15], 1024, 2048, WB + WB_LAYER + WL_XKV, 0, 1024)
                    JOB(0, false, ka->in[31], 1024, 2048, WB + WB_LAYER + WL_SIZE + WL_XKV, 0, 1024)
                    JOB(0, true, ka->in[11], 1024, 1024, WB + WB_OUT0, 0, 512)
                    JOB(0, true, ka->in[24], 1024, 1024, WB + WB_IN1, 0, 512)
                    JOB(0, false, ka->in[27], 1024, 1024, WB + WB_OUT1, 0, 512)
#define LAYER_JOBS(l, c2) { bf16_t* Wl = WB + WB_LAYER + (size_t)(l) * WL_SIZE; \
                        JOB(0, false, ka->in[(c2) + 4], 1024, 1024, Wl + WL_XO, 0, 512) \
                        JOB(1, true, ka->in[(c2) + 7], 1024, 512, Wl + WL_GU, (size_t)1024 * 1024, 4096)     \
                        JOB(2, true, ka->in[(c2) + 8], 1024, 512, Wl + WL_GU, (size_t)1024 * 1024, 4096) \
                        JOB(0, true, ka->in[(c2) + 9], 512, 1024, Wl + WL_DN, (size_t)1024 * 512, 4096) }
                    LAYER_JOBS(0, 12)
                    LAYER_JOBS(1, 28)
#undef LAYER_JOBS
#undef JOB
}

__device__ __forceinline__ bool in_range(int k) { KArgs ka = kargs(); return ka->ph_lo <= k && k < ka->ph_hi; }

__global__ void __launch_bounds__(NTHREADS, 2) mega(Args a) {
    extern __shared__ __attribute__((aligned(16))) unsigned char lds_raw[];
    LAS unsigned char* const F0lds = (LAS unsigned char*)lds_raw;
    const int F0wave = __builtin_amdgcn_readfirstlane((int)threadIdx.x >> 6);
    const int F0G = gridDim.x, F0bx = blockIdx.x, F0vcu = (F0G % 8 == 0) ? (F0bx % 8) * (F0G / 8) + F0bx / 8 : F0bx;
    volatile LAS unsigned* MISC = (volatile LAS unsigned*)(F0lds + MISC_OFF);
    if (threadIdx.x < 64) MISC[threadIdx.x] = 0u;
    __syncthreads();
    unsigned* ctl = (unsigned*)(a.ws + WS_CTL);
    XcdBarrier bar = xcd_barrier_post(ctl + CW_BAR + a.ph_lo * XCD_BAR_WORDS, MISC + 8, F0wave);
#ifdef MK_PHASE_RANGE
#define IN(k) in_range(k)
#define SEAM(k) do { if (IN(k) && IN((k) + 1)) { XcdBarrier b2_ = bar; asm volatile("" : "+s"(b2_.bar), "+s"(b2_.x)); xcd_barrier(b2_); } } while (0)
#else
#define IN(k) true
#define SEAM(k) do { XcdBarrier b2_ = bar; asm volatile("" : "+s"(b2_.bar), "+s"(b2_.x)); xcd_barrier(b2_); } while (0)
#endif
#define PH KArgs ka = kargs(); unsigned char* ws = ka->ws; (void)ws; Frame Fp; Fp.lds = F0lds; Fp.wave = F0wave; Fp.vcu = F0vcu; Fp.G = F0G; Fp.bx = F0bx; asm volatile("" : "+s"(Fp.wave), "+s"(Fp.vcu), "+s"(Fp.G), "+s"(Fp.bx)); \
    Fp.lane = (int)lane_id_fresh(); Fp.tid = Fp.wave * 64 + Fp.lane; const Frame& F = Fp; \
    const int bx = Fp.bx; (void)bx; LAS unsigned char* glds = F.lds; (void)glds; \
    bf16_t* RA = (bf16_t*)(ws + WS_A); bf16_t* RB = (bf16_t*)(ws + WS_B); bf16_t* RC = (bf16_t*)(ws + WS_C); bf16_t* RD = (bf16_t*)(ws + WS_D); bf16_t* WB = (bf16_t*)(ws + WS_WB); \
    (void)RA; (void)RB; (void)RC; (void)RD; (void)WB;
#define PHC PH const int cb = L == 0 ? 12 : 28; (void)cb; bf16_t* WBl = WB + WB_LAYER + (size_t)L * WL_SIZE; (void)WBl; \
    bf16_t *Z1 = L == 0 ? RC : RD, *X2 = RA, *HS = RB, *DS = RD, *X3 = L == 0 ? RC : nullptr;   unsigned char *ZG8 = (unsigned char*)(L == 0 ? RD : RA), *P8 = (unsigned char*)(L == 0 ? RA : RC), *X2_8 = (unsigned char*)(L == 0 ? RD : RC); bf16_t* Y2 = RB; \
    (void)Z1; (void)P8; (void)ZG8; (void)X2_8; (void)Y2; (void)X2; (void)HS; (void)DS; (void)X3;
#ifndef DOUBLE_MASK
#define DOUBLE_MASK 0u
#endif
#if DOUBLE_MASK != 0
#define REP(k) for (int rep_ = 0, nrep_ = 1 + (int)((DOUBLE_MASK >> (k)) & 1u); rep_ < nrep_; ++rep_)
#else
#define REP(k)
#endif
#define INF(i) ((const float*)ka->in[i])
#define WSI(off) ((int*)(ws + (off)))
#define WSF(off) ((float*)(ws + (off)))

#define GEMM_STD(EPI, ORD, LDA_, LDB_, K_) pg8::gemm_phase<EPI, ORD, true, true, false, LDA_, LDB_, K_>(glds, F.tid, g, S, E)
    for (int L = 0; L < 2; ++L) {
        const int cbp = L == 0 ? 0 : 11;
        if (L == 0) {
            if (IN(0)) REP(0) { PH
                LAS float* scrA = (LAS float*)(F.lds + F.wave * 16896), * scrB = scrA + 64 * 33;
                const int gw = F.vcu * NWAVES + F.wave, NGW = F.G * NWAVES;
                for (int it = gw; it < N_EARLY; it += 2 * NGW) {
                    TItem ta, tb; TRegs ra, rb; const int itb = it + NGW < N_EARLY ? it + NGW : it;
                    decode_item(ka, WB, it, ta); titem_load(ta, F.lane, ra);
                    decode_item(ka, WB, itb, tb); titem_load(tb, F.lane, rb);
                    titem_finish(ta, F.lane, ra, scrA);
                    titem_finish(tb, F.lane, rb, scrB);
                }
                const int gt = F.vcu * NTHREADS + F.tid, NGT = F.G * NTHREADS;
                { const float4* x4 = (const float4*)ka->in[0]; v2u* o = (v2u*)RA; unsigned* o8 = (unsigned*)RB;
                  for (int i = gt; i < T * D / 4; i += 4 * NGT) { float4 v[4];
#pragma unroll
                      for (int k = 0; k < 4; ++k) { const f32x4 t_ = __builtin_nontemporal_load((const f32x4*)(x4 + i + k * NGT)); v[k] = make_float4(t_[0], t_[1], t_[2], t_[3]); }
#pragma unroll
                      for (int k = 0; k < 4; ++k) { v2u w; w.x = pk2(v[k].x, v[k].y); w.y = pk2(v[k].z, v[k].w); o[i + k * NGT] = w;
                          o8[i + k * NGT] = pg8::pk4_fp8(v[k].x * pg8::F8_XS, v[k].y * pg8::F8_XS, v[k].z * pg8::F8_XS, v[k].w * pg8::F8_XS); } } }
                { const float4* m4 = (const float4*)ka->in[1]; v2u* o = (v2u*)(ws + WS_MEMB);
                  for (int i = gt; i < B * MEM * D / 4; i += NGT) { const float4 v = m4[i]; v2u w; w.x = pk2(v.x, v.y); w.y = pk2(v.z, v.w); o[i] = w; } }
                { const int* positions = (const int*)ka->in[2]; float* ropew = WSF(WS_ROPE);
                  for (int i = gt; i < 4 * T; i += NGT) { const int t = i >> 2, q2 = i & 3; const float p = (float)positions[t];
                      float cs[2], sn[2];
#pragma unroll
                      for (int jj = 0; jj < 2; ++jj) { const float f = q2 == 0 ? ka->inv.f[jj] : q2 == 1 ? ka->inv.f[2 + jj] : q2 == 2 ? ka->inv.f[4 + jj] : ka->inv.f[6 + jj];
                          const float ang = p * f; double rev = (double)ang * 0.15915494309189535; rev -= rint(rev); const float rr = (float)rev;
                          cs[jj] = __builtin_amdgcn_cosf(rr); sn[jj] = __builtin_amdgcn_sinf(rr); }
                      *(float2*)(ropew + (size_t)t * 16 + 2 * q2) = make_float2(cs[0], cs[1]); *(float2*)(ropew + (size_t)t * 16 + 8 + 2 * q2) = make_float2(sn[0], sn[1]); } }
            }
            SEAM(0);
            if (IN(1)) REP(1) { PH float* rope = WSF(WS_ROPE); bf16_t* MEMB = (bf16_t*)(ws + WS_MEMB);
              const int GC = F.G >= 256 ? GEMM_CUS_P1 : F.G;
              if (bx >= GC || F.G < 256) {
                const int cid = F.G >= 256 ? bx - GC : bx, NC = F.G >= 256 ? F.G - GC : F.G;
                LAS float* scrA = (LAS float*)(F.lds + F.wave * 16896), * scrB = scrA + 64 * 33;
                const int gw = cid * NWAVES + F.wave, NGW = NC * NWAVES;
#define CLAMP_IT(x) ((x) < NITEMS ? (x) : NITEMS - 1)
                { TItem ta, tb, tc, td; TRegs ra, rb, rc, rd; int it = N_EARLY + gw;
                  decode_item(ka, WB, CLAMP_IT(it), ta); titem_load(ta, F.lane, ra);
                  decode_item(ka, WB, CLAMP_IT(it + NGW), tb); titem_load(tb, F.lane, rb);
                  for (; it < NITEMS; it += 4 * NGW) {
                      decode_item(ka, WB, CLAMP_IT(it + 2 * NGW), tc); titem_load(tc, F.lane, rc);
                      decode_item(ka, WB, CLAMP_IT(it + 3 * NGW), td); titem_load(td, F.lane, rd);
                      titem_finish(ta, F.lane, ra, scrA); titem_finish(tb, F.lane, rb, scrB);
                      decode_item(ka, WB, CLAMP_IT(it + 4 * NGW), ta); titem_load(ta, F.lane, ra);
                      decode_item(ka, WB, CLAMP_IT(it + 5 * NGW), tb); titem_load(tb, F.lane, rb);
                      titem_finish(tc, F.lane, rc, scrA); titem_finish(td, F.lane, rd, scrB);
                  } }
#undef CLAMP_IT
                const int gt = cid * NTHREADS + F.tid, NGT = NC * NTHREADS;
#pragma unroll
                for (int l = 0; l < 2; ++l) { const float4* q4 = (const float4*)ka->in[l == 0 ? 14 : 30]; v2u* o = (v2u*)(WB + WB_LAYER + (size_t)l * WL_SIZE + WL_XQ);
                  for (int i = gt; i < D * D / 4; i += NGT) { const float4 v = q4[i]; v2u w; w.x = pk2(v.x, v.y); w.y = pk2(v.z, v.w); o[i] = w; } }
                { const float4* p4 = (const float4*)ka->in[25]; const float4* s4 = (const float4*)ka->in[26]; v2u* o = (v2u*)(WB + WB_POOL);
                  for (int i = gt; i < 4 * 256 * 256 / 4; i += NGT) { const float4 v = p4[i]; const float4 sc = s4[(i >> 14) * 64 + (i & 63)]; v2u w; w.x = pk2(v.x * sc.x, v.y * sc.y); w.y = pk2(v.z * sc.z, v.w * sc.w); o[i] = w; } }
                { const float* sw = INF(9); bf16_t* o = WB + WB_SGUW;
                  for (int i = gt; i < 8 * 128 * 128; i += NGT) { const int s2 = i & 127, t = (i >> 7) & 127; o[i] = f2bf(s2 <= t ? sw[i] : 0.f); } }
                __syncthreads();
              }
              if (bx < GC) {
#pragma unroll 1
                for (int l = 0; l < 2; ++l) {
                    bf16_t* Wl = WB + WB_LAYER + (size_t)l * WL_SIZE;
                    pg8::Gemm g{MEMB, Wl + WL_XKV, nullptr, nullptr};
                    const int c2 = bx - 96 - 32 * l;
                    pg8::StaticOrder S; S.init(B * MEM, 2048, GC, (c2 >= 0 && c2 < 32) ? c2 : (1 << 20), D, D);
                    pg8::EpiBf16 E{(bf16_t*)(ws + WS_MEMKV) + (size_t)l * B * MEM * 2048, 2048, 1.f};
                    GEMM_STD(pg8::EpiBf16, pg8::StaticOrder, D, D, D);
                }
                {
                    pg8::Gemm g{RB, WB + WB_IN0, nullptr, nullptr};
                    pg8::StaticOrder S; S.init(T, NIN0, GC, bx, D, D);
                    pg8::EpiInproj0 E{RD, rope, 1.f / (pg8::F8_XS * pg8::F8_WS)};
                    pg8::gemm_phase<pg8::EpiInproj0, pg8::StaticOrder, true, true, false, D, D, D, true>(glds, F.tid, g, S, E);
                }
              }
            }
            SEAM(1);
            if (IN(2)) REP(2) { PH
                { bf16_t* Wl = WB + WB_LAYER; const bf16_t* KV = (const bf16_t*)(ws + WS_MEMKV);
                  { pg8::Gemm g{KV, Wl + WL_XQ, nullptr, nullptr}; pg8::SetupOrder<0> S; S.init(bx, 0, 64); pg8::EpiF8 E{ws + WS_MT, D, QSCALE * pg8::F8_MS}; GEMM_STD(pg8::EpiF8, pg8::SetupOrder<0>, 2048, 1024, 256); }
                  { pg8::Gemm g{Wl + WL_XO, KV, nullptr, nullptr}; pg8::SetupOrder<1> S; S.init(bx, 64, 64); pg8::EpiF8 E{ws + WS_NT, D, pg8::F8_NS}; GEMM_STD(pg8::EpiF8, pg8::SetupOrder<1>, 1024, 2048, 256); }
                  { pg8::Gemm g{WB + WB_OUT1, WB + WB_POOL, nullptr, nullptr}; pg8::SetupOrder<2> S; S.init(bx, 128, 16); pg8::EpiF8 E{(unsigned char*)(WB + WB_WEFF), D, pg8::F8_WS}; GEMM_STD(pg8::EpiF8, pg8::SetupOrder<2>, 1024, 256, 256); } }
                phase_swa_sgu(F, RD, INF(6), INF(7), INF(8), WB + WB_SGUW, INF(10), (unsigned char*)RB);
            }
            SEAM(2);
            if (IN(3)) REP(3) { PH
                phase_cvec(F, ws + WS_MT, INF(12), INF(13), WSF(WS_CV));
                pg8::Gemm g{RB, WB + WB_OUT0, nullptr, nullptr};
                pg8::StaticOrder S; S.init(T, D, F.G, bx, D, D);
                pg8::EpiZ E{RC, (unsigned char*)RD, WSF(WS_PART), RA, INF(12), 1.f / (F8_MIXS * pg8::F8_WS)};
                pg8::gemm_phase<pg8::EpiZ, pg8::StaticOrder, true, true, false, D, D, D, true>(glds, F.tid, g, S, E);
            }
            SEAM(3);
        } else {
            if (IN(12)) REP(12) { PH
                pg8::Gemm g{RB, WB + WB_IN1, nullptr, nullptr};
                pg8::StaticOrder S; S.init(T, D, F.G, bx, D, D);
                pg8::EpiBf16 E{RA, D, 1.f / (pg8::F8_XS * pg8::F8_WS)};
                pg8::gemm_phase<pg8::EpiBf16, pg8::StaticOrder, true, true, false, D, D, D, true>(glds, F.tid, g, S, E);
            }
            SEAM(12);
            if (IN(13)) REP(13) { PH
                { bf16_t* Wl = WB + WB_LAYER + WL_SIZE; const bf16_t* KV = (const bf16_t*)(ws + WS_MEMKV) + (size_t)B * MEM * 2048;
                  { pg8::Gemm g{KV, Wl + WL_XQ, nullptr, nullptr}; pg8::SetupOrder<0> S; S.init(bx, 0, 64); pg8::EpiF8 E{ws + WS_MT, D, QSCALE * pg8::F8_MS}; GEMM_STD(pg8::EpiF8, pg8::SetupOrder<0>, 2048, 1024, 256); }
                  { pg8::Gemm g{Wl + WL_XO, KV, nullptr, nullptr}; pg8::SetupOrder<1> S; S.init(bx, 64, 64); pg8::EpiF8 E{ws + WS_NT, D, pg8::F8_NS}; GEMM_STD(pg8::EpiF8, pg8::SetupOrder<1>, 1024, 2048, 256); } }
                phase_pool(F, RA, (unsigned char*)RB);
            }
            SEAM(13);
            if (IN(14)) REP(14) { PH
                phase_cvec(F, ws + WS_MT, INF(28), INF(29), WSF(WS_CV));
                pg8::Gemm g{RB, WB + WB_WEFF, nullptr, nullptr};
                pg8::StaticOrder S; S.init(T, D, F.G, bx, D, D);
                pg8::EpiZ E{RD, (unsigned char*)RA, WSF(WS_PART), RC, INF(28), 1.f / (pg8::F8_XS * pg8::F8_WS)};
                pg8::gemm_phase<pg8::EpiZ, pg8::StaticOrder, true, true, false, D, D, D, true>(glds, F.tid, g, S, E);
            }
            SEAM(14);
        }
        if (IN(cbp + 5)) REP(cbp + 5) { PHC
            pg8::Gemm g{(const bf16_t*)ZG8, (const bf16_t*)(ws + WS_MT), nullptr, nullptr};
            pg8::BatchOrder S; S.init(T, D, F.G, bx, D, D);
            LAS float* stl = (LAS float*)(F.lds + 131072 + 8192); LAS float* cvl = stl + 2048; LAS int* tagl = (LAS int*)(cvl + 2048);
            scores_prepass(F, S, WSF(WS_PART), WSF(WS_CV), 1.f / (pg8::F8_XS * pg8::F8_MS), stl, cvl, tagl);
            pg8::EpiSoftmaxT<true> E{P8, (LAS float*)(F.lds + 131072), (const LAS pg8::f32x2*)stl, (const LAS pg8::f32x2*)cvl, tagl};
            pg8::gemm_phase<pg8::EpiSoftmaxT<true>, pg8::BatchOrder, true, true, false, D, D, D, true>(glds, F.tid, g, S, E);
        }
        SEAM(cbp + 5);
        if (IN(cbp + 6)) REP(cbp + 6) { PHC
            pg8::Gemm g{(const bf16_t*)P8, (const bf16_t*)(ws + WS_NT), nullptr, nullptr};
            pg8::BatchOrder S; S.init(T, D, F.G, bx, D, D);
            pg8::EpiF8 E{(unsigned char*)Y2, D, pg8::F8_YS / (pg8::F8_PS * pg8::F8_NS)};
            pg8::gemm_phase<pg8::EpiF8, pg8::BatchOrder, true, true, false, D, D, D, true>(glds, F.tid, g, S, E);
        }
        SEAM(cbp + 6);
        if (IN(cbp + 7)) REP(cbp + 7) { PHC phase_ln_router(F, Z1, INF(cb), INF(cb + 1), (const unsigned char*)Y2, INF(cb + 5), INF(cb + 6), X2, X2_8, INF(3), INF(4), WSI(WS_EIDX), WSF(WS_EWGT), WSI(WS_BCNT)); }
        SEAM(cbp + 7);
        if (IN(cbp + 8)) REP(cbp + 8) { PHC phase_moe_book(F, WSI(WS_EIDX), WSI(WS_BCNT), WSI(WS_TOK), WSI(WS_POS), WSI(WS_TILE)); }
        SEAM(cbp + 8);
        if (IN(cbp + 9)) REP(cbp + 9) { PHC const int* tile_e = WSI(WS_TILE); const int* tok = WSI(WS_TOK);
            const int ntiles = __builtin_amdgcn_readfirstlane(tile_e[NTILE]);
            pg8::Gemm g{(const bf16_t*)X2_8, WBl + WL_GU, tok, (LAS int*)(F.lds + 131072)};
            pg8::MoeOrder S; S.init(ntiles, tile_e, F.G, bx, D, D);
            pg8::EpiGU8 E{(unsigned char*)HS};
            pg8::gemm_phase<pg8::EpiGU8, pg8::MoeOrder, true, true, true, D, D, D, true>(glds, F.tid, g, S, E);
        }
        SEAM(cbp + 9);
        if (IN(cbp + 10)) REP(cbp + 10) { PHC const int* tile_e = WSI(WS_TILE);
            const int ntiles = __builtin_amdgcn_readfirstlane(tile_e[NTILE]);
            pg8::Gemm g{HS, WBl + WL_DN, nullptr, nullptr};
            pg8::MoeOrder S; S.init(ntiles, tile_e, F.G, bx, DE, DE);
            pg8::EpiF8 E{(unsigned char*)DS, D, pg8::F8_DS / (pg8::F8_HS * pg8::F8_WS)};
            pg8::gemm_phase<pg8::EpiF8, pg8::MoeOrder, true, true, false, DE, DE, DE, true>(glds, F.tid, g, S, E);
        }
        SEAM(cbp + 10);
        if (IN(cbp + 11)) REP(cbp + 11) { PHC phase_ln_moe(F, X2, (const unsigned char*)DS, WSI(WS_POS), WSF(WS_EWGT), INF(cb + 10), INF(cb + 11), X3, L == 1 ? ka->out : nullptr, L == 0 ? (unsigned char*)RB : nullptr); }
        if (L == 0) SEAM(cbp + 11);
    }
#undef GEMM_STD
#undef IN
#undef SEAM
#undef INF
#undef PH
#undef PHC
#undef WSI
#undef WSF
}
}
using namespace nv;
extern "C" void kernel_launch(void* const* d_in, const int* in_sizes, int n_in, void* d_out, int out_size, void* d_ws, size_t ws_size, hipStream_t stream) {
    (void)in_sizes; (void)out_size;
    if (ws_size < WS_END || n_in != 40) return;
    static int grid = 0;
    if (grid == 0) {
        int dev = 0, cus = 0;
        if (hipGetDevice(&dev) != hipSuccess || hipDeviceGetAttribute(&cus, hipDeviceAttributeMultiprocessorCount, dev) != hipSuccess) { grid = -1; return; }
        if (hipFuncSetAttribute((const void*)mk::mega, hipFuncAttributeMaxDynamicSharedMemorySize, mk::LDS_BYTES) != hipSuccess) { grid = -1; return; }
        int per_cu = 0;
        if (hipOccupancyMaxActiveBlocksPerMultiprocessor(&per_cu, (const void*)mk::mega, mk::NTHREADS, mk::LDS_BYTES) != hipSuccess || per_cu < 1) { (void)hipGetLastError(); }
        grid = cus;
    }
    if (grid < 0) return;
    unsigned char* ws = (unsigned char*)d_ws;
    (void)hipMemsetAsync(ws + WS_CTL, 0, mk::CTL_ZERO_BYTES, stream);
    mk::Args a{};
    for (int i = 0; i < 40; ++i) a.in[i] = d_in[i];
    a.out = (float*)d_out; a.ws = ws;
    for (int j = 0; j < 8; ++j) a.inv.f[j] = (float)pow(500000.0, -(double)((float)j * 2.0f / 16.0f));
    a.ph_lo = 0; a.ph_hi = mk::NPHASE;
    hipLaunchKernelGGL(mk::mega, dim3(grid), dim3(mk::NTHREADS), mk::LDS_BYTES, stream, a);
}
```

```cpp
#include <hip/hip_runtime.h>
#include <stdint.h>
#include <math.h>

typedef unsigned short bf16_t;

namespace nv {
constexpr int B = 4, S = 8192, T = B * S, D = 1024;
constexpr int NIN0 = 1792;
constexpr int MEM = 256, XH = 4, XHD = 256;
constexpr int NE = 16, DE = 512;
constexpr int MPAD = 65536 + 16 * 256;
constexpr int NTILE = MPAD / 256;
constexpr float ALPHA = 1.4142135623730951f;
constexpr float LN_EPS = 1e-5f;
constexpr float QSCALE = 0.0625f * 1.4426950408889634f;
constexpr float ASCALE = 0.125f * 1.4426950408889634f;

constexpr size_t MiB = 1u << 20;
constexpr size_t WS_CTL = 0;
constexpr size_t WS_ROPE = 2 * MiB;
constexpr size_t WS_EIDX = 4 * MiB;
constexpr size_t WS_EWGT = 5 * MiB;
constexpr size_t WS_POS = 6 * MiB;
constexpr size_t WS_BCNT = 7 * MiB;
constexpr size_t WS_TILE = 7 * MiB + 65536;
constexpr size_t WS_TOK = 7 * MiB + 131072;
constexpr size_t WS_MEMKV = 8 * MiB;
constexpr size_t WS_MEMB = 20 * MiB;
constexpr size_t WS_WB = 24 * MiB;
constexpr size_t WS_A = 152 * MiB, WS_B = 220 * MiB, WS_C = 288 * MiB, WS_D = 356 * MiB;
constexpr size_t WS_MT = 492 * MiB;
constexpr size_t WS_NT = 500 * MiB;
constexpr size_t WS_CV = 496 * MiB;
constexpr size_t WS_PART = 504 * MiB;
constexpr size_t WS_END = 508 * MiB;
constexpr size_t WB_IN0 = 0;
constexpr size_t WB_OUT0 = WB_IN0 + (size_t)1792 * 1024;
constexpr size_t WB_IN1 = WB_OUT0 + (size_t)1024 * 1024;
constexpr size_t WB_POOL = WB_IN1 + (size_t)1024 * 1024;
constexpr size_t WB_OUT1 = WB_POOL + (size_t)1024 * 256;
constexpr size_t WB_WEFF = WB_OUT1 + (size_t)1024 * 1024;
constexpr size_t WB_SGUW = WB_WEFF + (size_t)1024 * 1024;
constexpr size_t WB_LAYER = WB_SGUW + (size_t)8 * 128 * 128;
constexpr size_t WL_XQ = 0;
constexpr size_t WL_XKV = WL_XQ + (size_t)1024 * 1024;
constexpr size_t WL_XO = WL_XKV + (size_t)2048 * 1024;
constexpr size_t WL_GU = WL_XO + (size_t)1024 * 1024;
constexpr size_t WL_DN = WL_GU + (size_t)16 * 1024 * 1024;
constexpr size_t WL_SIZE = WL_DN + (size_t)16 * 1024 * 512;
static_assert((WB_LAYER + 2 * WL_SIZE) * 2 <= 128 * MiB, "bf16 weight region");

__device__ __forceinline__ float bf2f(bf16_t v) { return __uint_as_float((unsigned)v << 16); }
__device__ __forceinline__ bf16_t f2bf(float f) { unsigned u = __float_as_uint(f); return (bf16_t)((u + 0x7fffu + ((u >> 16) & 1u)) >> 16); }
__device__ __forceinline__ float gelu_tanh(float x) { const float u = 0.7978845608028654f * (x + 0.044715f * x * x * x); const float e = __expf(2.f * u); const float th = 1.f - 2.f / (e + 1.f); return 0.5f * x * (1.f + th); }
__device__ __forceinline__ float silu(float x) { return x / (1.f + __expf(-x)); }
template <int M> __device__ __forceinline__ float swz_xor(float v) { return __int_as_float(__builtin_amdgcn_ds_swizzle(__float_as_int(v), (M << 10) | 0x1f)); }
__device__ __forceinline__ float wave_sum(float v) {
    v += swz_xor<1>(v); v += swz_xor<2>(v); v += swz_xor<4>(v); v += swz_xor<8>(v); v += swz_xor<16>(v);
    const auto r = __builtin_amdgcn_permlane32_swap(__float_as_uint(v), __float_as_uint(v), false, false);
    return __uint_as_float(r[0]) + __uint_as_float(r[1]);
}
__device__ __forceinline__ float wave_max(float v) {
    v = fmaxf(v, swz_xor<1>(v)); v = fmaxf(v, swz_xor<2>(v)); v = fmaxf(v, swz_xor<4>(v)); v = fmaxf(v, swz_xor<8>(v)); v = fmaxf(v, swz_xor<16>(v));
    const auto r = __builtin_amdgcn_permlane32_swap(__float_as_uint(v), __float_as_uint(v), false, false);
    return fmaxf(__uint_as_float(r[0]), __uint_as_float(r[1]));
}
}

namespace pg8 {
#define PG8_LAS __attribute__((address_space(3)))
typedef short bf16x8 __attribute__((ext_vector_type(8)));
typedef float f32x4 __attribute__((ext_vector_type(4)));
typedef float f32x2 __attribute__((ext_vector_type(2)));
typedef unsigned u32x4 __attribute__((ext_vector_type(4)));
typedef unsigned u32x2 __attribute__((ext_vector_type(2)));
typedef int i32x8 __attribute__((ext_vector_type(8)));
constexpr int BM = 256, BK = 64, HALF = 128, HTB = HALF * BK * 2  , STAGE_BYTES = 8 * HTB, NXCD = 8, WGM = 8;

__host__ __device__ __forceinline__ int lds_byte(int r, int c) { const int st = (r >> 4) * 2 + (c >> 5), rr = r & 15, cc = c & 31, ob = rr * 64 + cc * 2; return st * 1024 + (ob ^ (((ob >> 9) & 1) << 5)); }
__host__ __device__ __forceinline__ void stage_rc(int b, int& R, int& C) { const int st = b / 1024, sb = b % 1024, swz = sb ^ (((sb >> 9) & 1) << 5); R = (st >> 1) * 16 + swz / 64; C = (st & 1) * 32 + (swz % 64) / 2; }
__host__ __device__ __forceinline__ int perm32(int rho) { const int n = rho >> 4, i = rho & 15; return 8 * (i >> 2) + 4 * n + (i & 3); }

struct Unit { int pm, pn, ao, bo; };
struct Gemm { const bf16_t* A; const bf16_t* Bt; const int* arow; PG8_LAS int* ltab; };

template <bool BATCHED = false>
struct StaticOrderT {
    int nM, nN, nwg, G, c, lda, ldb, apn;
    __device__ void init(int M, int N, int G_, int c_, int lda_, int ldb_, int apn_ = 0) { nM = M / BM; nN = N / BM; nwg = nM * nN; G = G_; c = c_; lda = lda_; ldb = ldb_; apn = apn_; }
    __device__ bool next(int i, Unit& u) const {
        const long L = (long)i * G + c; if (L >= nwg) return false;
        int wgid = (int)L; { const int q = nwg / NXCD, r = nwg % NXCD, xcd = wgid % NXCD, off = wgid / NXCD; wgid = (xcd < r ? xcd * (q + 1) : r * (q + 1) + (xcd - r) * q) + off; }
        const int nig = WGM * nN, gid = wgid / nig, fm = gid * WGM, gsz = (nM - fm) < WGM ? (nM - fm) : WGM;
        u.pm = fm + ((wgid % nig) % gsz); u.pn = (wgid % nig) / gsz;
        u.ao = u.pm * BM * lda + u.pn * apn; u.bo = (BATCHED ? ((u.pm >> 5) * 4 + u.pn) : u.pn) * BM * ldb; return true;
    }
};
typedef StaticOrderT<false> StaticOrder;
typedef StaticOrderT<true> BatchOrder;
struct MoeOrder {
    int nM, nwg, G, c, lda, ldb; const int* tile_e;
    __device__ void init(int ntiles, const int* te, int G_, int c_, int lda_, int ldb_) { nM = ntiles; nwg = nM * 4; G = G_; c = c_; tile_e = te; lda = lda_; ldb = ldb_; }
    __device__ bool next(int i, Unit& u) const {
        const long L = (long)i * G + c; if (L >= nwg) return false;
        int wgid = (int)L; { const int q = nwg / NXCD, r = nwg % NXCD, xcd = wgid % NXCD, off = wgid / NXCD; wgid = (xcd < r ? xcd * (q + 1) : r * (q + 1) + (xcd - r) * q) + off; }
        const int nig = WGM * 4, gid = wgid / nig, fm = gid * WGM, gsz = (nM - fm) < WGM ? (nM - fm) : WGM;
        u.pm = fm + ((wgid % nig) % gsz); u.pn = (wgid % nig) / gsz;
        const int e = __builtin_amdgcn_readfirstlane(tile_e[u.pm]); u.ao = u.pm * BM * lda; u.bo = (e * 4 + u.pn) * BM * ldb; return true;
    }
};
template <int KIND>
struct SetupOrder {
    int idx, n;
    __device__ void init(int c, int c0, int n_) { idx = c - c0; n = n_; }
    __device__ bool next(int i, Unit& u) const {
        if (i != 0 || idx < 0 || idx >= n) return false;
        const int x = idx >> 4, y = (idx >> 2) & 3, z = idx & 3;
        if (KIND == 0) { u.pm = x * 4 + y; u.pn = z; u.ao = (x * 256) * 2048 + y * 256; u.bo = z * 256 * 1024 + y * 256; }
        if (KIND == 1) { u.pm = x * 4 + y; u.pn = z; u.ao = y * 256 * 1024 + z * 256; u.bo = (x * 256) * 2048 + 1024 + z * 256; }
        if (KIND == 2) { u.pm = y; u.pn = z; u.ao = y * 256 * 1024 + z * 256; u.bo = z * 256 * 256; }
        return true;
    }
};

__device__ __forceinline__ int fresh_lane() { unsigned m = ~0u; asm volatile("" : "+s"(m)); return (int)__builtin_amdgcn_mbcnt_hi(m, __builtin_amdgcn_mbcnt_lo(m, 0u)); }
__device__ __forceinline__ unsigned cvt_pk_bf16(float lo, float hi) { unsigned r; asm volatile("v_cvt_pk_bf16_f32 %0, %1, %2" : "=v"(r) : "v"(lo), "v"(hi)); return r; }


template <class Epi, class Sched, bool ALIGN_EPI, bool SP2, bool GATHER, int LDA, int LDB, int KK, bool FP8 = false>
__device__ __forceinline__ void gemm_phase(PG8_LAS unsigned char* lds, int tid_in, const Gemm g, const Sched& S, const Epi& E) {
    int tid_ = tid_in; asm volatile("" : "+v"(tid_));
    const int tid = tid_, wid = __builtin_amdgcn_readfirstlane(tid >> 6), lane = tid & 63, wr = wid >> 2, wc = wid & 3, fr = lane & 15, fq = lane >> 4;
    constexpr int ELT = FP8 ? 1 : 2, K = KK, nt = K * ELT / (BK * 2), lda = LDA * ELT, ldb = LDB * ELT; (void)K;
    unsigned voffA[2], voffB[2];
#pragma unroll
    for (int i = 0; i < 2; ++i) { int R, C; stage_rc(tid * 16 + i * 8192, R, C); const int Rb = Epi::PERM ? ((R & ~31) + perm32(R & 31)) : R;
        voffA[i] = GATHER ? (unsigned)C * 2u : (unsigned)(R * lda + C * 2); voffB[i] = (unsigned)(Rb * ldb + C * 2); }
    const size_t kstep = (size_t)(BK * 2);
    const size_t hstepA = GATHER ? 0 : (size_t)HALF * lda, hstepB = (size_t)HALF * ldb;
    const unsigned ldsw = (unsigned)wid * 1024u, ldsbase = (unsigned)(size_t)lds;
    const int aoff = lds_byte(wr * 64 + fr, fq * 8), boff = lds_byte(wc * 32 + fr, fq * 8);
    const PG8_LAS unsigned char* ldsA = lds + aoff; const PG8_LAS unsigned char* ldsB = lds + 4 * HTB + boff; asm volatile("" : "+v"(ldsA), "+v"(ldsB));
    unsigned cg[2][2];
#define PG8_SA(b, h) (((b) * 2 + (h)) * HTB)
#define PG8_SB(b, h) ((4 + (b) * 2 + (h)) * HTB)
#define PG8_GLDS(sbase, voff32, ldsaddr) asm volatile("s_mov_b32 m0, %2\n\ts_nop 0\n\tglobal_load_lds_dwordx4 %0, %1" :: "v"(voff32), "s"(sbase), "s"(ldsaddr) : "memory", "m0")
#define PG8_STAGE(bufoff, gbase, voff) do { const char* _sb = (const char*)(gbase); _Pragma("unroll") for (int _i = 0; _i < 2; ++_i) \
        PG8_GLDS(_sb + (size_t)_i * 64 * ldb, (voff)[0], (unsigned)(ldsbase + (bufoff) + ldsw + _i * 8192)); } while (0)
#define PG8_STAGE_A(bufoff, abase, h, GO) do { const char* _sb = GATHER ? (const char*)(abase) : (const char*)(abase) + ((h) ? hstepA : (size_t)0); _Pragma("unroll") for (int _i = 0; _i < 2; ++_i) { \
        if constexpr (GATHER) PG8_GLDS(_sb, GO[h][_i], (unsigned)(ldsbase + (bufoff) + ldsw + _i * 8192)); \
        else PG8_GLDS(_sb + (size_t)_i * 64 * lda, voffA[0], (unsigned)(ldsbase + (bufoff) + ldsw + _i * 8192)); } } while (0)
#define PG8_GLOAD(dst, pm_) do { const int _t = wid * 64 + fresh_lane(); int rowA_[2]; unsigned colA_[2]; _Pragma("unroll") for (int _i = 0; _i < 2; ++_i) { int _R, _C; stage_rc(_t * 16 + _i * 8192, _R, _C); rowA_[_i] = _R; colA_[_i] = (unsigned)_C * 2u; }   \
        _Pragma("unroll") for (int _h = 0; _h < 2; ++_h) _Pragma("unroll") for (int _i = 0; _i < 2; ++_i) \
        dst[_h][_i] = (unsigned)g.ltab[(pm_) * BM + _h * HALF + rowA_[_i]] * (unsigned)lda + colA_[_i]; } while (0)
#define PG8_GSWITCH do { if constexpr (GATHER) { if (last && has_next) { PG8_GLOAD(cg, ui + 1); } } } while (0)
#define PG8_LDA(dst, b, h) do { _Pragma("unroll") for (int m = 0; m < 4; ++m) { if constexpr (FP8) { typedef int i32x4_ __attribute__((ext_vector_type(4))); \
        dst##8[m] = __builtin_shufflevector(*(const PG8_LAS i32x4_*)(ldsA + PG8_SA(b, h) + m * 2048), *(const PG8_LAS i32x4_*)(ldsA + PG8_SA(b, h) + m * 2048 + 1024), 0, 1, 2, 3, 4, 5, 6, 7); } \
        else { _Pragma("unroll") for (int k = 0; k < 2; ++k) dst[m][k] = *(const PG8_LAS bf16x8*)(ldsA + PG8_SA(b, h) + m * 2048 + k * 1024); } } } while (0)
#define PG8_LDB(dst, b, h) do { _Pragma("unroll") for (int n = 0; n < 2; ++n) { if constexpr (FP8) { typedef int i32x4_ __attribute__((ext_vector_type(4))); \
        dst##8[n] = __builtin_shufflevector(*(const PG8_LAS i32x4_*)(ldsB + PG8_SA(b, h) + n * 2048), *(const PG8_LAS i32x4_*)(ldsB + PG8_SA(b, h) + n * 2048 + 1024), 0, 1, 2, 3, 4, 5, 6, 7); } \
        else { _Pragma("unroll") for (int k = 0; k < 2; ++k) dst[n][k] = *(const PG8_LAS bf16x8*)(ldsB + PG8_SA(b, h) + n * 2048 + k * 1024); } } } while (0)
#define PG8_MMA(ai, bj, At, Bt) do { __builtin_amdgcn_s_setprio(1); _Pragma("unroll") for (int m = 0; m < 4; ++m) _Pragma("unroll") for (int n = 0; n < 2; ++n) { \
        if constexpr (FP8) acc[ai][bj][m][n] = __builtin_amdgcn_mfma_scale_f32_16x16x128_f8f6f4(Bt##8[n], At##8[m], acc[ai][bj][m][n], 0, 0, 0, 0x7f7f7f7f, 0, 0x7f7f7f7f); \
        else { _Pragma("unroll") for (int k = 0; k < 2; ++k) acc[ai][bj][m][n] = __builtin_amdgcn_mfma_f32_16x16x32_bf16(Bt[n][k], At[m][k], acc[ai][bj][m][n], 0, 0, 0); } } \
        __builtin_amdgcn_s_setprio(0); } while (0)
#define PG8_WAIT_V(n) asm volatile("s_waitcnt vmcnt(" #n ")" ::: "memory")
#define PG8_WAIT_L(n) asm volatile("s_waitcnt lgkmcnt(" #n ")" ::: "memory")
#define PG8_BAR __builtin_amdgcn_s_barrier()
#define PG8_SCHED __builtin_amdgcn_sched_barrier(0)
    Unit cur, nxt; int ui = 0;
    if (!S.next(0, cur)) return;
    f32x4 acc[2][2][4][2];
#pragma unroll
    for (int a = 0; a < 2; ++a)
#pragma unroll
        for (int b = 0; b < 2; ++b)
#pragma unroll
            for (int m = 0; m < 4; ++m)
#pragma unroll
                for (int n = 0; n < 2; ++n) acc[a][b][m][n] = (f32x4){0.f, 0.f, 0.f, 0.f};
    bf16x8 At[4][2], B0[2][2], B1[2][2]; i32x8 At8[4], B08[2], B18[2];
    const char* cA = GATHER ? (const char*)g.A : (const char*)g.A + (size_t)cur.ao * ELT; const char* cB = (const char*)g.Bt + (size_t)cur.bo * ELT;
    if constexpr (GATHER) {
        for (int i = 0; i < 8; ++i) { Unit u_; if (!S.next(i, u_)) break; if (tid < BM) g.ltab[i * BM + tid] = g.arow[u_.pm * BM + tid]; }
        asm volatile("s_waitcnt vmcnt(0) lgkmcnt(0)" ::: "memory"); PG8_BAR; asm volatile("" ::: "memory");
        PG8_GLOAD(cg, 0); }
    if constexpr (SP2) {
        PG8_STAGE(PG8_SB(0, 0), cB, voffB); PG8_STAGE(PG8_SB(0, 1), cB + hstepB, voffB); PG8_STAGE_A(PG8_SA(0, 0), cA, 0, cg); PG8_STAGE_A(PG8_SA(0, 1), cA, 1, cg);
        if (wr == 1) PG8_BAR;
        PG8_WAIT_V(2); PG8_BAR;
        PG8_STAGE(PG8_SB(1, 0), cB + kstep, voffB); PG8_STAGE_A(PG8_SA(1, 0), cA + kstep, 0, cg); PG8_STAGE(PG8_SB(1, 1), cB + hstepB + kstep, voffB);
        PG8_WAIT_V(6); PG8_BAR;
    } else {
        PG8_STAGE(PG8_SB(0, 0), cB, voffB); PG8_STAGE_A(PG8_SA(0, 0), cA, 0, cg); PG8_STAGE(PG8_SB(0, 1), cB + hstepB, voffB); PG8_STAGE_A(PG8_SA(0, 1), cA, 1, cg);
        if (wr == 1) PG8_BAR;
        PG8_WAIT_V(4); PG8_BAR;
        PG8_STAGE(PG8_SB(1, 0), cB + kstep, voffB); PG8_STAGE_A(PG8_SA(1, 0), cA + kstep, 0, cg); PG8_STAGE(PG8_SB(1, 1), cB + hstepB + kstep, voffB);
        PG8_WAIT_V(6); PG8_BAR;
    }
    for (;;) {
        const bool has_next = S.next(ui + 1, nxt);
        const char* nA = GATHER ? (const char*)g.A : (has_next ? (const char*)g.A + (size_t)nxt.ao * ELT : cA);
        const char* nB = has_next ? (const char*)g.Bt + (size_t)nxt.bo * ELT : cB;
#pragma unroll 1
        for (int t = 0; t < nt; t += 2) {
            const bool last = (t == nt - 2);
            const char* a1 = cA + (size_t)(t + 1) * kstep;
            const char* a2 = last ? nA : cA + (size_t)(t + 2) * kstep; const char* b2 = last ? nB : cB + (size_t)(t + 2) * kstep;
            const char* a3 = a2 + kstep; const char* b3 = b2 + kstep;
            if constexpr (SP2) {
            PG8_LDB(B0, 0, 0); PG8_LDB(B1, 0, 1); PG8_SCHED; PG8_LDA(At, 0, 0); PG8_STAGE_A(PG8_SA(1, 1), a1, 1, cg); PG8_GSWITCH;
            PG8_WAIT_V(8); PG8_WAIT_L(0); PG8_BAR; PG8_MMA(0, 0, At, B0); PG8_MMA(0, 1, At, B1); PG8_BAR; PG8_SCHED;
            PG8_LDA(At, 0, 1); PG8_STAGE(PG8_SB(0, 0), b2, voffB); PG8_STAGE(PG8_SB(0, 1), b2 + hstepB, voffB); PG8_STAGE_A(PG8_SA(0, 0), a2, 0, cg);
            PG8_WAIT_V(8); PG8_WAIT_L(0); PG8_BAR; PG8_MMA(1, 0, At, B0); PG8_MMA(1, 1, At, B1); PG8_BAR; PG8_SCHED;
            PG8_LDB(B0, 1, 0); PG8_LDB(B1, 1, 1); PG8_SCHED; PG8_LDA(At, 1, 0); PG8_STAGE_A(PG8_SA(0, 1), a2, 1, cg);
            PG8_WAIT_V(8); PG8_WAIT_L(0); PG8_BAR; PG8_MMA(0, 0, At, B0); PG8_MMA(0, 1, At, B1); PG8_BAR; PG8_SCHED;
            PG8_LDA(At, 1, 1); PG8_STAGE(PG8_SB(1, 0), b3, voffB); PG8_STAGE(PG8_SB(1, 1), b3 + hstepB, voffB); PG8_STAGE_A(PG8_SA(1, 0), a3, 0, cg);
            PG8_WAIT_V(8); PG8_WAIT_L(0); PG8_BAR; PG8_MMA(1, 0, At, B0); PG8_MMA(1, 1, At, B1); PG8_BAR; PG8_SCHED;
            } else {
            PG8_LDB(B0, 0, 0); PG8_SCHED; PG8_LDA(At, 0, 0); PG8_STAGE_A(PG8_SA(1, 1), a1, 1, cg); PG8_GSWITCH;
            PG8_WAIT_L(8); PG8_BAR; PG8_WAIT_L(0); PG8_MMA(0, 0, At, B0); PG8_BAR; PG8_SCHED;
            PG8_LDB(B1, 0, 1); PG8_STAGE(PG8_SB(0, 0), b2, voffB);
            PG8_BAR; PG8_WAIT_L(0); PG8_MMA(0, 1, At, B1); PG8_BAR;
            PG8_LDA(At, 0, 1); PG8_STAGE_A(PG8_SA(0, 0), a2, 0, cg);
            PG8_BAR; PG8_WAIT_L(0); PG8_MMA(1, 0, At, B0); PG8_BAR; PG8_SCHED;
            PG8_STAGE(PG8_SB(0, 1), b2 + hstepB, voffB);
            PG8_WAIT_V(6); PG8_BAR; PG8_MMA(1, 1, At, B1); PG8_BAR;
            PG8_LDB(B0, 1, 0); PG8_SCHED; PG8_LDA(At, 1, 0); PG8_STAGE_A(PG8_SA(0, 1), a2, 1, cg);
            PG8_WAIT_L(8); PG8_BAR; PG8_WAIT_L(0); PG8_MMA(0, 0, At, B0); PG8_BAR; PG8_SCHED;
            PG8_LDB(B1, 1, 1); PG8_STAGE(PG8_SB(1, 0), b3, voffB);
            PG8_BAR; PG8_WAIT_L(0); PG8_MMA(0, 1, At, B1); PG8_BAR;
            PG8_LDA(At, 1, 1); PG8_STAGE_A(PG8_SA(1, 0), a3, 0, cg);
            PG8_BAR; PG8_WAIT_L(0); PG8_MMA(1, 0, At, B0); PG8_BAR; PG8_SCHED;
            PG8_STAGE(PG8_SB(1, 1), b3 + hstepB, voffB);
            PG8_WAIT_V(6); PG8_BAR; PG8_MMA(1, 1, At, B1); PG8_BAR;
            }
        }
        if constexpr (ALIGN_EPI) { if (wr == 0) PG8_BAR; }
        { const int _l = fresh_lane(); E(acc, cur, wr, wc, _l & 15, _l >> 4); }
        if (!has_next) break;
#pragma unroll
        for (int a = 0; a < 2; ++a)
#pragma unroll
            for (int b = 0; b < 2; ++b)
#pragma unroll
                for (int m = 0; m < 4; ++m)
#pragma unroll
                    for (int n = 0; n < 2; ++n) acc[a][b][m][n] = (f32x4){0.f, 0.f, 0.f, 0.f};
        cur = nxt; cA = nA; cB = nB; ++ui;
        if constexpr (ALIGN_EPI) { if (wr == 1) PG8_BAR; }
    }
    PG8_WAIT_V(0);
    if constexpr (!ALIGN_EPI) { if (wr == 0) PG8_BAR; }
    PG8_BAR;
#undef PG8_SA
#undef PG8_SB
#undef PG8_STAGE
#undef PG8_GLDS
#undef PG8_STAGE_A
#undef PG8_GLOAD
#undef PG8_GSWITCH
#undef PG8_LDA
#undef PG8_LDB
#undef PG8_MMA
#undef PG8_WAIT_V
#undef PG8_WAIT_L
#undef PG8_BAR
#undef PG8_SCHED
}
}
namespace pg8 {

__device__ __forceinline__ float fast_sigmoid_mul(float x, float z) { return x * __builtin_amdgcn_rcpf(1.f + __builtin_amdgcn_exp2f(-1.4426950408889634f * z)); }
__device__ __forceinline__ float gelu_t(float x) { const float u = 0.7978845608028654f * (x + 0.044715f * x * x * x); return fast_sigmoid_mul(x, 2.f * u); }
__device__ __forceinline__ float silu_f(float x) { return fast_sigmoid_mul(x, x); }
__device__ __forceinline__ u32x4 pack8(const f32x4 v0, const f32x4 v1) { u32x4 w; w.x = cvt_pk_bf16(v0[0], v0[1]); w.y = cvt_pk_bf16(v0[2], v0[3]); w.z = cvt_pk_bf16(v1[0], v1[1]); w.w = cvt_pk_bf16(v1[2], v1[3]); return w; }

struct EpiBf16 {
    static constexpr bool PERM = true;
    bf16_t* O; int ldo; float scale;
    __device__ __forceinline__ void operator()(f32x4 (&acc)[2][2][4][2], const Unit& u, int wr, int wc, int fr, int fq) const {
        const int row0 = u.pm * BM + wr * 64 + fr, col0 = u.pn * BM + wc * 32 + 8 * fq;
#pragma unroll
        for (int ai = 0; ai < 2; ++ai)
#pragma unroll
            for (int m = 0; m < 4; ++m) { bf16_t* rowp = O + (size_t)(row0 + ai * HALF + m * 16) * ldo + col0;
#pragma unroll
                for (int bj = 0; bj < 2; ++bj) *(u32x4*)(rowp + bj * HALF) = pack8(acc[ai][bj][m][0] * scale, acc[ai][bj][m][1] * scale); }
    }
};
__device__ __forceinline__ unsigned pk4_fp8(float a, float b, float c, float d) {
    a = __builtin_amdgcn_fmed3f(a, -448.f, 448.f); b = __builtin_amdgcn_fmed3f(b, -448.f, 448.f); c = __builtin_amdgcn_fmed3f(c, -448.f, 448.f); d = __builtin_amdgcn_fmed3f(d, -448.f, 448.f);
    unsigned p; asm volatile("" : "=v"(p));
    p = (unsigned)__builtin_amdgcn_cvt_pk_fp8_f32(a, b, (int)p, false); p = (unsigned)__builtin_amdgcn_cvt_pk_fp8_f32(c, d, (int)p, true); return p;
}
__device__ __forceinline__ unsigned pk4_fp8_nc(float a, float b, float c, float d) {
    unsigned p; asm volatile("" : "=v"(p));
    p = (unsigned)__builtin_amdgcn_cvt_pk_fp8_f32(a, b, (int)p, false); p = (unsigned)__builtin_amdgcn_cvt_pk_fp8_f32(c, d, (int)p, true); return p;
}
__device__ __forceinline__ u32x4 widen16(const u32x2 a, const u32x2 b) {
    const auto r0 = __builtin_amdgcn_permlane16_swap(a.x, b.x, false, false), r1 = __builtin_amdgcn_permlane16_swap(a.y, b.y, false, false);
    u32x4 v; v.x = r0[0]; v.y = r1[0]; v.z = r0[1]; v.w = r1[1]; return v;
}
constexpr float F8_XS = 16.f, F8_WS = 64.f, F8_HS = 8.f;
struct EpiF8 {
    static constexpr bool PERM = true;
    unsigned char* O; int ldo; float scale;
    __device__ __forceinline__ void operator()(f32x4 (&acc)[2][2][4][2], const Unit& u, int wr, int wc, int fr, int fq) const {
        const int row0 = u.pm * BM + wr * 64 + fr, col0 = u.pn * BM + wc * 32 + 8 * fq;
#pragma unroll
        for (int ai = 0; ai < 2; ++ai)
#pragma unroll
            for (int m = 0; m < 4; ++m) { unsigned char* rowp = O + (size_t)(row0 + ai * HALF + m * 16) * ldo + col0; u32x2 w[2];
#pragma unroll
                for (int bj = 0; bj < 2; ++bj) { const f32x4 v0 = acc[ai][bj][m][0] * scale, v1 = acc[ai][bj][m][1] * scale;
                    w[bj].x = pk4_fp8(v0[0], v0[1], v0[2], v0[3]); w[bj].y = pk4_fp8(v1[0], v1[1], v1[2], v1[3]); }
                *(u32x4*)(rowp + ((fq & 1) ? HALF - 8 : 0)) = widen16(w[0], w[1]); }
    }
};
constexpr float F8_MS = 64.f, F8_PS = 256.f, F8_NS = 16.f, F8_DS = 32.f, F8_YS = 256.f;
struct EpiGU8 {
    static constexpr bool PERM = true;
    unsigned char* HS8;
    __device__ __forceinline__ void operator()(f32x4 (&acc)[2][2][4][2], const Unit& u, int wr, int wc, int fr, int fq) const {
        const int row0 = u.pm * BM + wr * 64 + fr, col0 = u.pn * HALF + wc * 32 + 8 * fq;
        constexpr float s = 1.f / (F8_XS * F8_WS);
#pragma unroll
        for (int ai = 0; ai < 2; ++ai) { u32x2 wq[4];
#pragma unroll
            for (int m = 0; m < 4; ++m) {
                f32x4 h[2];
#pragma unroll
                for (int n = 0; n < 2; ++n) { const f32x4 g = acc[ai][0][m][n], up = acc[ai][1][m][n];
                    const f32x4 t = g * (-s * 1.4426950408889634f); f32x4 d;
#pragma unroll
                    for (int j = 0; j < 4; ++j) d[j] = __builtin_amdgcn_exp2f(t[j]);
                    d = d + 1.f; f32x4 r;
#pragma unroll
                    for (int j = 0; j < 4; ++j) r[j] = __builtin_amdgcn_rcpf(d[j]);
                    h[n] = ((g * up) * (s * s * F8_HS)) * r; }
                wq[m].x = pk4_fp8(h[0][0], h[0][1], h[0][2], h[0][3]); wq[m].y = pk4_fp8(h[1][0], h[1][1], h[1][2], h[1][3]); }
#pragma unroll
            for (int m = 0; m < 4; m += 2) {
                unsigned char* p16 = HS8 + (size_t)(row0 + ai * HALF + (m + (fq & 1)) * 16) * nv::DE + col0 - ((fq & 1) ? 8 : 0);
                *(u32x4*)p16 = widen16(wq[m], wq[m + 1]); } }
    }
};
template <bool OUT8>
struct EpiSoftmaxT {
    static constexpr bool PERM = true;
    void* O; PG8_LAS float* tbl;
    const PG8_LAS f32x2* st; const PG8_LAS f32x2* cv; const PG8_LAS int* tag;
    __device__ __forceinline__ void operator()(f32x4 (&acc)[2][2][4][2], const Unit& u, int wr, int wc, int fr, int fq) const {
        const int row0 = u.pm * BM + wr * 64 + fr, col0 = u.pn * BM + wc * 32 + 8 * fq;
        int slot = 0; { const int key = u.pm * 4 + u.pn;
#pragma unroll
            for (int i = 1; i < 4; ++i) if (tag[i] == key) slot = i; }
        slot = __builtin_amdgcn_readfirstlane(slot);
#pragma unroll
        for (int bj = 0; bj < 2; ++bj) {
            f32x4 c1[2], c0[2];
            { const PG8_LAS f32x4* cp = (const PG8_LAS f32x4*)(cv + slot * 256 + bj * HALF + wc * 32 + 8 * fq);
#pragma unroll
              for (int n = 0; n < 2; ++n) { const f32x4 lo = cp[2 * n], hi = cp[2 * n + 1]; c1[n] = (f32x4){lo[0], lo[2], hi[0], hi[2]}; c0[n] = (f32x4){lo[1], lo[3], hi[1], hi[3]}; } }
#pragma unroll
            for (int ai = 0; ai < 2; ++ai)
#pragma unroll
                for (int m = 0; m < 4; ++m) { const f32x2 ac = st[slot * 256 + ai * HALF + wr * 64 + m * 16 + fr];
#pragma unroll
                    for (int n = 0; n < 2; ++n) { acc[ai][bj][m][n] = acc[ai][bj][m][n] * ac[0] + (c1[n] * ac[1] + c0[n]); asm volatile("" : "+v"(acc[ai][bj][m][n])); } }
        }
#pragma unroll
        for (int ai = 0; ai < 2; ++ai)
#pragma unroll
            for (int m = 0; m < 4; ++m) { float mx = -INFINITY;
#pragma unroll
                for (int bj = 0; bj < 2; ++bj)
#pragma unroll
                    for (int n = 0; n < 2; ++n)
#pragma unroll
                        for (int j = 0; j < 4; ++j) mx = fmaxf(mx, acc[ai][bj][m][n][j]);
                mx = fmaxf(mx, nv::swz_xor<16>(mx));
                { const auto r = __builtin_amdgcn_permlane32_swap(__float_as_uint(mx), __float_as_uint(mx), false, false); mx = fmaxf(__uint_as_float(r[0]), __uint_as_float(r[1])); }
                if (fq == 0) tbl[(ai * HALF + wr * 64 + m * 16 + fr) * 4 + wc] = mx; }
        asm volatile("s_waitcnt lgkmcnt(0)" ::: "memory"); __builtin_amdgcn_s_barrier(); asm volatile("" ::: "memory");
#pragma unroll
        for (int ai = 0; ai < 2; ++ai)
#pragma unroll
            for (int m = 0; m < 4; ++m) { const f32x4 t4 = *(const PG8_LAS f32x4*)(tbl + (ai * HALF + wr * 64 + m * 16 + fr) * 4);
                const float M = fmaxf(fmaxf(t4[0], t4[1]), fmaxf(t4[2], t4[3])); f32x4 sv = (f32x4){0.f, 0.f, 0.f, 0.f};
#pragma unroll
                for (int bj = 0; bj < 2; ++bj)
#pragma unroll
                    for (int n = 0; n < 2; ++n) { const f32x4 d = acc[ai][bj][m][n] - M; f32x4 p;
#pragma unroll
                        for (int j = 0; j < 4; ++j) p[j] = __builtin_amdgcn_exp2f(d[j]);
                        acc[ai][bj][m][n] = p; sv = sv + p; }
                float s = (sv[0] + sv[1]) + (sv[2] + sv[3]);
                s += nv::swz_xor<16>(s);
                { const auto r = __builtin_amdgcn_permlane32_swap(__float_as_uint(s), __float_as_uint(s), false, false); s = __uint_as_float(r[0]) + __uint_as_float(r[1]); }
                if (fq == 0) tbl[1024 + (ai * HALF + wr * 64 + m * 16 + fr) * 4 + wc] = s; }
        asm volatile("s_waitcnt lgkmcnt(0)" ::: "memory"); __builtin_amdgcn_s_barrier(); asm volatile("" ::: "memory");
#pragma unroll
        for (int ai = 0; ai < 2; ++ai)
#pragma unroll
            for (int m = 0; m < 4; ++m) { const f32x4 t4 = *(const PG8_LAS f32x4*)(tbl + 1024 + (ai * HALF + wr * 64 + m * 16 + fr) * 4);
                const float inv = 1.f / ((t4[0] + t4[1]) + (t4[2] + t4[3]));
                if constexpr (OUT8) { unsigned char* rowp = (unsigned char*)O + (size_t)(row0 + ai * HALF + m * 16) * nv::D + col0; const float s8 = inv * F8_PS;
                    u32x2 w[2];
#pragma unroll
                    for (int bj = 0; bj < 2; ++bj) { const f32x4 v0 = acc[ai][bj][m][0] * s8, v1 = acc[ai][bj][m][1] * s8;
                        w[bj].x = pk4_fp8_nc(v0[0], v0[1], v0[2], v0[3]); w[bj].y = pk4_fp8_nc(v1[0], v1[1], v1[2], v1[3]); }
                    *(u32x4*)(rowp + ((fq & 1) ? HALF - 8 : 0)) = widen16(w[0], w[1]); }
                else { bf16_t* rowp = (bf16_t*)O + (size_t)(row0 + ai * HALF + m * 16) * nv::D + col0;
#pragma unroll
                    for (int bj = 0; bj < 2; ++bj) *(u32x4*)(rowp + bj * HALF) = pack8(acc[ai][bj][m][0] * inv, acc[ai][bj][m][1] * inv); } }
    }
};
struct EpiZ {
    static constexpr bool PERM = true;
    bf16_t* Z; unsigned char* ZG8; float* PART; const bf16_t* R; const float* g; float scale;
    __device__ __forceinline__ void operator()(f32x4 (&acc)[2][2][4][2], const Unit& u, int wr, int wc, int fr, int fq) const {
        const int row0 = u.pm * BM + wr * 64 + fr, col0 = u.pn * BM + wc * 32 + 8 * fq;
        f32x4 gv[2][2];
#pragma unroll
        for (int bj = 0; bj < 2; ++bj)
#pragma unroll
            for (int n = 0; n < 2; ++n) gv[bj][n] = *(const f32x4*)(g + col0 + bj * HALF + 4 * n) * F8_XS;
        u32x4 rr[8][2]; float ps[4], pq[4];
#define EPIZ_LOAD(r_) do { _Pragma("unroll") for (int bj = 0; bj < 2; ++bj) rr[r_][bj] = *(const u32x4*)(R + (size_t)(row0 + ((r_) >> 2) * HALF + ((r_) & 3) * 16) * nv::D + col0 + bj * HALF); } while (0)
#pragma unroll
        for (int r = 0; r < 2; ++r) EPIZ_LOAD(r);
#pragma unroll
        for (int r = 0; r < 8; ++r) { const int ai = r >> 2, m = r & 3;
            asm volatile("" ::: "memory");
            { const size_t off = (size_t)(row0 + ai * HALF + m * 16) * nv::D + col0; float s = 0.f, q = 0.f; u32x2 wz[2];
#pragma unroll
                for (int bj = 0; bj < 2; ++bj) { const u32x4 x = rr[r][bj];
                    f32x4 r0, r1; r0[0] = __uint_as_float(x.x << 16); r0[1] = __uint_as_float(x.x & 0xffff0000u); r0[2] = __uint_as_float(x.y << 16); r0[3] = __uint_as_float(x.y & 0xffff0000u);
                    r1[0] = __uint_as_float(x.z << 16); r1[1] = __uint_as_float(x.z & 0xffff0000u); r1[2] = __uint_as_float(x.w << 16); r1[3] = __uint_as_float(x.w & 0xffff0000u);
                    const f32x4 z0 = r0 * nv::ALPHA + acc[ai][bj][m][0] * scale, z1 = r1 * nv::ALPHA + acc[ai][bj][m][1] * scale;
                    *(u32x4*)(Z + off + bj * HALF) = pack8(z0, z1);
                    { const f32x4 sv = z0 + z1, qv = z0 * z0 + z1 * z1; s += (sv[0] + sv[1]) + (sv[2] + sv[3]); q += (qv[0] + qv[1]) + (qv[2] + qv[3]); }
                    const f32x4 v0 = z0 * gv[bj][0], v1 = z1 * gv[bj][1];
                    wz[bj].x = pk4_fp8(v0[0], v0[1], v0[2], v0[3]); wz[bj].y = pk4_fp8(v1[0], v1[1], v1[2], v1[3]); }
                *(u32x4*)(ZG8 + off + ((fq & 1) ? HALF - 8 : 0)) = widen16(wz[0], wz[1]);
                s += nv::swz_xor<16>(s); q += nv::swz_xor<16>(q);
                { const auto p = __builtin_amdgcn_permlane32_swap(__float_as_uint(s), __float_as_uint(s), false, false); s = __uint_as_float(p[0]) + __uint_as_float(p[1]); }
                { const auto p = __builtin_amdgcn_permlane32_swap(__float_as_uint(q), __float_as_uint(q), false, false); q = __uint_as_float(p[0]) + __uint_as_float(p[1]); }
                ps[m] = s; pq[m] = q;
                if (m == 3) { f32x2 o; o[0] = fq == 0 ? ps[0] : fq == 1 ? ps[1] : fq == 2 ? ps[2] : ps[3]; o[1] = fq == 0 ? pq[0] : fq == 1 ? pq[1] : fq == 2 ? pq[2] : pq[3];
                    *(f32x2*)(PART + ((size_t)(row0 + ai * HALF + fq * 16) * 16 + u.pn * 4 + wc) * 2) = o; } }
            asm volatile("" ::: "memory");
            if (r + 2 < 8) EPIZ_LOAD(r + 2);
        }
#undef EPIZ_LOAD
    }
};
struct EpiInproj0 {
    static constexpr bool PERM = true;
    bf16_t* O; const float* rope; float in_scale;
    __device__ __forceinline__ void operator()(f32x4 (&acc)[2][2][4][2], const Unit& u, int wr, int wc, int fr, int fq) const {
        const int row0 = u.pm * BM + wr * 64 + fr, col0 = u.pn * BM + wc * 32 + 8 * fq;
#pragma unroll
        for (int ai = 0; ai < 2; ++ai)
#pragma unroll
            for (int bj = 0; bj < 2; ++bj)
#pragma unroll
                for (int m = 0; m < 4; ++m) { acc[ai][bj][m][0] *= in_scale; acc[ai][bj][m][1] *= in_scale; }
        if (u.pn >= 3) {
#pragma unroll
            for (int ai = 0; ai < 2; ++ai)
#pragma unroll
                for (int m = 0; m < 4; ++m) { bf16_t* rowp = O + (size_t)(row0 + ai * HALF + m * 16) * nv::NIN0 + col0;
#pragma unroll
                    for (int bj = 0; bj < 2; ++bj) { f32x4 v[2];
#pragma unroll
                        for (int n = 0; n < 2; ++n) { const f32x4 x = acc[ai][bj][m][n]; constexpr float k1 = -2.f * 0.7978845608028654f * 1.4426950408889634f, k3 = k1 * 0.044715f;
                            const f32x4 t = x * ((x * x) * k3 + k1); f32x4 d;
#pragma unroll
                            for (int j = 0; j < 4; ++j) d[j] = __builtin_amdgcn_exp2f(t[j]);
                            d = d + 1.f; f32x4 r;
#pragma unroll
                            for (int j = 0; j < 4; ++j) r[j] = __builtin_amdgcn_rcpf(d[j]);
                            v[n] = x * r; }
                        *(u32x4*)(rowp + bj * HALF) = pack8(v[0], v[1]); } }
        } else {
            const bool wave_rope = (wc & 1) == 0;
            const float sgn = fq == 0 ? -1.f : 1.f;
#pragma unroll
            for (int ai = 0; ai < 2; ++ai)
#pragma unroll
                for (int m = 0; m < 4; ++m) { const int row = row0 + ai * HALF + m * 16; bf16_t* rowp = O + (size_t)row * nv::NIN0 + col0;
                    f32x4 c0, c1, s0, s1;
                    if (wave_rope) { const float* rp = rope + (size_t)row * 16; c0 = *(const f32x4*)rp; c1 = *(const f32x4*)(rp + 4); s0 = *(const f32x4*)(rp + 8); s1 = *(const f32x4*)(rp + 12); }
#pragma unroll
                    for (int bj = 0; bj < 2; ++bj) { f32x4 v0 = acc[ai][bj][m][0], v1 = acc[ai][bj][m][1];
                        if (wave_rope && (u.pn < 2 || bj == 0)) {
                            f32x4 p0, p1;
#pragma unroll
                            for (int j = 0; j < 4; ++j) { p0[j] = nv::swz_xor<16>(v0[j]); p1[j] = nv::swz_xor<16>(v1[j]); }
                            if (fq < 2) {
#pragma unroll
                                for (int j = 0; j < 4; ++j) { v0[j] = v0[j] * c0[j] + sgn * p0[j] * s0[j]; v1[j] = v1[j] * c1[j] + sgn * p1[j] * s1[j]; } }
                        }
                        *(u32x4*)(rowp + bj * HALF) = pack8(v0, v1); } }
        }
    }
};
}

#define LAS __attribute__((address_space(3)))
#define GAS __attribute__((address_space(1)))
typedef GAS unsigned gu32;
#define RLX_AGENT __ATOMIC_RELAXED, __HIP_MEMORY_SCOPE_AGENT
#define LDS_WAIT() asm volatile("s_waitcnt lgkmcnt(0)" ::: "memory")
#define VM_WAIT() asm volatile("s_waitcnt vmcnt(0)" ::: "memory")

#define XB_TMO      128
#define XB_XCNT(j)  (256  + 64 * (j))
#define XB_XSUB(j)  (1280 + 64 * (j))
#define XB_XGEN(j)  (2304 + 64 * (j))
#define XB_TOP      3328
#define XB_TOPGEN   3392
#define XCD_BAR_WORDS 3456
#define XB_SPIN_CAP (1u << 18)
__device__ __forceinline__ unsigned xb_ld(unsigned* p)              { return __hip_atomic_load(p, __ATOMIC_RELAXED, __HIP_MEMORY_SCOPE_AGENT); }
__device__ __forceinline__ unsigned xb_add(unsigned* p, unsigned v) { return __hip_atomic_fetch_add(p, v, __ATOMIC_RELAXED, __HIP_MEMORY_SCOPE_AGENT); }
__device__ __forceinline__ unsigned xb_xcc_id() { return (unsigned)__builtin_amdgcn_s_getreg((3 << 11) | 20) & 0xFu; }
#define XB_SPIN(cond, bar) do { unsigned _sp = 0; while (cond) { __builtin_amdgcn_s_sleep(1); \
    if ((++_sp & 255u) == 0u) { if (xb_ld(&(bar)[XB_TMO])) break; if (_sp > XB_SPIN_CAP) { atomicAdd(&(bar)[XB_TMO], 1u); break; } } } } while (0)
struct XcdBarrier { unsigned* bar; unsigned x; volatile LAS unsigned* st; int wave; };
__device__ __forceinline__ unsigned lane_id_fresh() { unsigned m = ~0u; asm volatile("" : "+s"(m)); return __builtin_amdgcn_mbcnt_hi(m, __builtin_amdgcn_mbcnt_lo(m, 0u)); }
__device__ __forceinline__ bool xb_thread0(int wave) { return wave == 0 && lane_id_fresh() == 0u; }
__device__ __forceinline__ XcdBarrier xcd_barrier_post(unsigned* bar, volatile LAS unsigned* st, int wave) {
    XcdBarrier b; b.bar = bar; b.x = xb_xcc_id(); b.st = st; b.wave = wave;
    if (xb_thread0(wave)) (void)xb_add(&bar[XB_XCNT(b.x)], 1u);
    return b;
}
__device__ __forceinline__ void xcd_barrier_complete(unsigned* bar, unsigned x, unsigned& nloc, unsigned& nx) {
    const unsigned G = gridDim.x * gridDim.y * gridDim.z;
    unsigned sum, cnt, mine, sp = 0u;
    for (;;) {
        sum = 0u; cnt = 0u; mine = 0u;
#pragma unroll
        for (unsigned j = 0; j < 16; ++j) { const unsigned c = xb_ld(&bar[XB_XCNT(j)]); sum += c; cnt += (c > 0u) ? 1u : 0u; mine = (j == x) ? c : mine; }
        if (sum == G) break;
        __builtin_amdgcn_s_sleep(1);
        if ((++sp & 255u) == 0u) { if (xb_ld(&bar[XB_TMO])) break; if (sp > XB_SPIN_CAP) { atomicAdd(&bar[XB_TMO], 1u); break; } }
    }
    nloc = mine > 0u ? mine : 1u; nx = cnt > 0u ? cnt : 1u;
}
__device__ __forceinline__ void xcd_barrier(const XcdBarrier& b) {
    asm volatile("s_waitcnt vmcnt(0)" ::: "memory");
    __syncthreads();
    if (xb_thread0(b.wave)) {
        unsigned* bar = b.bar;
        __builtin_amdgcn_s_waitcnt(0);
        unsigned nloc = b.st[0], nx = b.st[1];
        if (nloc == 0u) { xcd_barrier_complete(bar, b.x, nloc, nx); b.st[0] = nloc; b.st[1] = nx; }
        const unsigned old = xb_add(&bar[XB_XSUB(b.x)], 1u);
        const unsigned gen = old / nloc;
        if (old + 1u == (gen + 1u) * nloc) {
            __builtin_amdgcn_fence(__ATOMIC_RELEASE, "agent");
            asm volatile("s_waitcnt vmcnt(0)" ::: "memory");
            const unsigned og = xb_add(&bar[XB_TOP], 1u);
            const unsigned tg = og / nx;
            asm volatile("buffer_inv sc1" ::: "memory");
            if (og + 1u == (tg + 1u) * nx) xb_add(&bar[XB_TOPGEN], 1u);
            else XB_SPIN(xb_ld(&bar[XB_TOPGEN]) == tg, bar);
            asm volatile("" ::: "memory");
            xb_add(&bar[XB_XGEN(b.x)], 1u);
            asm volatile("s_waitcnt vmcnt(0)" ::: "memory");
        } else {
            asm volatile("buffer_inv sc1" ::: "memory");
            XB_SPIN(xb_ld(&bar[XB_XGEN(b.x)]) == gen, bar);
            asm volatile("s_waitcnt vmcnt(0)" ::: "memory");
        }
    }
    __syncthreads();
}

namespace mk {
using namespace nv;
typedef unsigned v4u __attribute__((ext_vector_type(4)));
typedef unsigned v2u __attribute__((ext_vector_type(2)));
typedef float f32x4 __attribute__((ext_vector_type(4)));
constexpr int NWAVES = 8, NTHREADS = 512;
constexpr int LDS_BYTES = 160 * 1024;
constexpr int MISC_OFF = LDS_BYTES - 256;
constexpr int CW_BAR = 4096;
constexpr size_t CTL_ZERO_BYTES = 64 * 1024;

__device__ __forceinline__ unsigned pk2(float lo, float hi) { return pg8::cvt_pk_bf16(lo, hi); }

struct Frame {
    LAS unsigned char* lds; int tid, lane, wave, vcu, G, bx;
};

struct TItem { const float* src; unsigned char* dst; int ldw, ldt, k0, n0, dr, f8; };
template <int MAP, bool F8>
__device__ __forceinline__ void titem_fill(TItem& t, const void* srcp, int K, int N, void* dstp, size_t dstb, int r) {
    const int nblk = N / 32, per = (K / 64) * nblk, bi = r / per, it = r % per, kb = it / nblk, nb = it % nblk, n0 = 32 * nb;
    int dr = n0; if (MAP == 1) dr = (n0 >> 7) * 256 + (n0 & 127); if (MAP == 2) dr = (n0 >> 7) * 256 + 128 + (n0 & 127);
    t.src = (const float*)srcp + (size_t)bi * K * N; t.dst = (unsigned char*)dstp + (size_t)bi * dstb * (F8 ? 1 : 2); t.ldw = N; t.ldt = K; t.k0 = 64 * kb; t.n0 = n0; t.dr = dr; t.f8 = F8 ? 1 : 0;
}
struct TRegs { f32x4 v[8]; };
__device__ __forceinline__ void titem_load(const TItem& t, int lane, TRegs& R) {
    const float* p = t.src + (size_t)(t.k0 + (lane >> 3)) * t.ldw + t.n0 + (lane & 7) * 4;
#pragma unroll
    for (int i = 0; i < 8; ++i) R.v[i] = __builtin_nontemporal_load((const f32x4*)(p + (size_t)(8 * i) * t.ldw));
}
__device__ __forceinline__ void titem_finish(const TItem& t, int lane, const TRegs& R, LAS float* scr) {
    const float sc = t.f8 ? pg8::F8_WS : 1.f;
    { LAS float* d = scr + (lane >> 3) * 33 + (lane & 7) * 4;
#pragma unroll
      for (int i = 0; i < 8; ++i) { d[(8 * i) * 33 + 0] = R.v[i][0] * sc; d[(8 * i) * 33 + 1] = R.v[i][1] * sc; d[(8 * i) * 33 + 2] = R.v[i][2] * sc; d[(8 * i) * 33 + 3] = R.v[i][3] * sc; } }
    LDS_WAIT(); asm volatile("" ::: "memory");
    const int c = lane & 7;
#pragma unroll
    for (int j = 0; j < 4; ++j) { const int n = (lane >> 3) + 8 * j; const LAS float* s = scr + (8 * c) * 33 + n;
        if (t.f8) { v2u o; o.x = pg8::pk4_fp8(s[0 * 33], s[1 * 33], s[2 * 33], s[3 * 33]); o.y = pg8::pk4_fp8(s[4 * 33], s[5 * 33], s[6 * 33], s[7 * 33]);
            __builtin_nontemporal_store(o, (v2u*)(t.dst + (size_t)(t.dr + n) * t.ldt + t.k0 + 8 * c)); }
        else { v4u o; o.x = pk2(s[0 * 33], s[1 * 33]); o.y = pk2(s[2 * 33], s[3 * 33]); o.z = pk2(s[4 * 33], s[5 * 33]); o.w = pk2(s[6 * 33], s[7 * 33]);
            __builtin_nontemporal_store(o, (v4u*)((bf16_t*)t.dst + (size_t)(t.dr + n) * t.ldt + t.k0 + 8 * c)); } }
    LDS_WAIT(); asm volatile("" ::: "memory");
}

struct InvFreq { float f[8]; };
struct Args {
    const void* in[40]; float* out; unsigned char* ws; InvFreq inv; int ph_lo, ph_hi;
};

struct RowV { float v[16]; };
__device__ __forceinline__ void unpk8(const v4u u, float* x) {
    x[0] = __uint_as_float(u.x << 16); x[1] = __uint_as_float(u.x & 0xffff0000u); x[2] = __uint_as_float(u.y << 16); x[3] = __uint_as_float(u.y & 0xffff0000u);
    x[4] = __uint_as_float(u.z << 16); x[5] = __uint_as_float(u.z & 0xffff0000u); x[6] = __uint_as_float(u.w << 16); x[7] = __uint_as_float(u.w & 0xffff0000u);
}
struct RowRaw { v4u a, b; };
__device__ __forceinline__ RowRaw load_raw(const bf16_t* p, int lane) { RowRaw r; r.a = __builtin_nontemporal_load((const v4u*)(p + 8 * lane)); r.b = __builtin_nontemporal_load((const v4u*)(p + 512 + 8 * lane)); return r; }
__device__ __forceinline__ void unpack_row(const RowRaw& r, RowV& x) { unpk8(r.a, x.v); unpk8(r.b, x.v + 8); }
struct RowRaw8 { v2u a, b; };
__device__ __forceinline__ RowRaw8 load_raw8(const unsigned char* p, int lane) { RowRaw8 r; r.a = __builtin_nontemporal_load((const v2u*)(p + 8 * lane)); r.b = __builtin_nontemporal_load((const v2u*)(p + 512 + 8 * lane)); return r; }
__device__ __forceinline__ void unpk8_fp8(const v2u u, float* x, float s) {
    typedef float v2f_ __attribute__((ext_vector_type(2)));
    const v2f_ a = __builtin_amdgcn_cvt_pk_f32_fp8((int)u.x, false), b = __builtin_amdgcn_cvt_pk_f32_fp8((int)u.x, true), c = __builtin_amdgcn_cvt_pk_f32_fp8((int)u.y, false), d = __builtin_amdgcn_cvt_pk_f32_fp8((int)u.y, true);
    x[0] = a[0] * s; x[1] = a[1] * s; x[2] = b[0] * s; x[3] = b[1] * s; x[4] = c[0] * s; x[5] = c[1] * s; x[6] = d[0] * s; x[7] = d[1] * s;
}
__device__ __forceinline__ void unpack_row8(const RowRaw8& r, RowV& x, float s) { unpk8_fp8(r.a, x.v, s); unpk8_fp8(r.b, x.v + 8, s); }
struct GB { float g[16], b[16]; };
__device__ __forceinline__ void load_gb(const float* g, const float* b, int lane, GB& o) {
#pragma unroll
    for (int hh = 0; hh < 2; ++hh)
#pragma unroll
        for (int q = 0; q < 2; ++q) { const float4 gg = *(const float4*)(g + 512 * hh + 8 * lane + 4 * q), bb = *(const float4*)(b + 512 * hh + 8 * lane + 4 * q);
            o.g[8 * hh + 4 * q + 0] = gg.x; o.g[8 * hh + 4 * q + 1] = gg.y; o.g[8 * hh + 4 * q + 2] = gg.z; o.g[8 * hh + 4 * q + 3] = gg.w;
            o.b[8 * hh + 4 * q + 0] = bb.x; o.b[8 * hh + 4 * q + 1] = bb.y; o.b[8 * hh + 4 * q + 2] = bb.z; o.b[8 * hh + 4 * q + 3] = bb.w; }
}
__device__ __forceinline__ void ln_rowv(RowV& z, const GB& gb) {
    float s = 0.f, q = 0.f;
#pragma unroll
    for (int i = 0; i < 16; ++i) { s += z.v[i]; q += z.v[i] * z.v[i]; }
    s += swz_xor<1>(s); q += swz_xor<1>(q); s += swz_xor<2>(s); q += swz_xor<2>(q); s += swz_xor<4>(s); q += swz_xor<4>(q); s += swz_xor<8>(s); q += swz_xor<8>(q); s += swz_xor<16>(s); q += swz_xor<16>(q);
    { const auto r = __builtin_amdgcn_permlane32_swap(__float_as_uint(s), __float_as_uint(s), false, false); s = __uint_as_float(r[0]) + __uint_as_float(r[1]); }
    { const auto r = __builtin_amdgcn_permlane32_swap(__float_as_uint(q), __float_as_uint(q), false, false); q = __uint_as_float(r[0]) + __uint_as_float(r[1]); }
    const float mu = s * (1.f / D), var = fmaxf(q * (1.f / D) - mu * mu, 0.f);
    const float rstd = 1.f / sqrtf(var + LN_EPS), c = -mu * rstd;
#pragma unroll
    for (int i = 0; i < 16; ++i) z.v[i] = (z.v[i] * rstd + c) * gb.g[i] + gb.b[i];
}
__device__ __forceinline__ void store_rowv_bf16(bf16_t* p, int lane, const RowV& r) {
    v4u a, b; a.x = pk2(r.v[0], r.v[1]); a.y = pk2(r.v[2], r.v[3]); a.z = pk2(r.v[4], r.v[5]); a.w = pk2(r.v[6], r.v[7]);
    b.x = pk2(r.v[8], r.v[9]); b.y = pk2(r.v[10], r.v[11]); b.z = pk2(r.v[12], r.v[13]); b.w = pk2(r.v[14], r.v[15]);
    *(v4u*)(p + 8 * lane) = a; *(v4u*)(p + 512 + 8 * lane) = b;
}
__device__ __forceinline__ unsigned dpp_xor1(unsigned v) { return (unsigned)__builtin_amdgcn_update_dpp(0, (int)v, 0xB1  , 0xF, 0xF, true); }
__device__ __forceinline__ void store_rowv_fp8(unsigned char* p, int lane, const RowV& r, float s) {
    v2u a, b; a.x = pg8::pk4_fp8(r.v[0] * s, r.v[1] * s, r.v[2] * s, r.v[3] * s); a.y = pg8::pk4_fp8(r.v[4] * s, r.v[5] * s, r.v[6] * s, r.v[7] * s);
    b.x = pg8::pk4_fp8(r.v[8] * s, r.v[9] * s, r.v[10] * s, r.v[11] * s); b.y = pg8::pk4_fp8(r.v[12] * s, r.v[13] * s, r.v[14] * s, r.v[15] * s);
    const bool odd = (lane & 1) != 0;
    const unsigned rx = dpp_xor1(odd ? a.x : b.x), ry = dpp_xor1(odd ? a.y : b.y);
    v4u o; o.x = odd ? rx : a.x; o.y = odd ? ry : a.y; o.z = odd ? b.x : rx; o.w = odd ? b.y : ry;
    *(v4u*)(p + (odd ? 512 + 8 * (lane - 1) : 8 * lane)) = o;
}
constexpr int LNR = 4;

__device__ __forceinline__ void phase_ln_add(const Frame& F, const bf16_t* X, const bf16_t* Y, const float* g, const float* b, bf16_t* out, unsigned char* out8) {
    const int gw = F.vcu * NWAVES + F.wave, NGW = F.G * NWAVES;
    GB gb; load_gb(g, b, F.lane, gb);
    for (int row = gw; row < T; row += LNR * NGW) {
        RowRaw rx[LNR], ry[LNR];
#pragma unroll
        for (int k = 0; k < LNR; ++k) { const int rr = row + k * NGW; if (rr < T) { rx[k] = load_raw(X + (size_t)rr * D, F.lane); if (Y) ry[k] = load_raw(Y + (size_t)rr * D, F.lane); } }
#pragma unroll
        for (int k = 0; k < LNR; ++k) { const int rr = row + k * NGW; if (rr < T) {
            RowV x; unpack_row(rx[k], x);
            if (Y) { RowV y; unpack_row(ry[k], y);
#pragma unroll
                for (int i = 0; i < 16; ++i) x.v[i] = ALPHA * x.v[i] + y.v[i]; }
            ln_rowv(x, gb);
            store_rowv_bf16(out + (size_t)rr * D, F.lane, x);
            store_rowv_fp8(out8 + (size_t)rr * D, F.lane, x, pg8::F8_XS); } }
    }
}
__device__ __forceinline__ void phase_ln_moe(const Frame& F, const bf16_t* X, const unsigned char* DS, const int* pos, const float* ewgt, const float* g, const float* b, bf16_t* outb, float* outf, unsigned char* out8) {
    const int gw = F.vcu * NWAVES + F.wave, NGW = F.G * NWAVES;
    GB gb; load_gb(g, b, F.lane, gb);
    for (int row = gw; row < T; row += LNR * NGW) {
        RowRaw rx[LNR]; RowRaw8 r1[LNR], r2[LNR]; float w1[LNR], w2[LNR];
#pragma unroll
        for (int k = 0; k < LNR; ++k) { const int rr = row + k * NGW; if (rr < T) {
            const int2 pp = *(const int2*)(pos + 2 * rr); const float2 ww = *(const float2*)(ewgt + 2 * rr); w1[k] = ww.x; w2[k] = ww.y;
            rx[k] = load_raw(X + (size_t)rr * D, F.lane); r1[k] = load_raw8(DS + (size_t)pp.x * D, F.lane); r2[k] = load_raw8(DS + (size_t)pp.y * D, F.lane); } }
#pragma unroll
        for (int k = 0; k < LNR; ++k) { const int rr = row + k * NGW; if (rr < T) {
            RowV x, y1, y2; unpack_row(rx[k], x); unpack_row8(r1[k], y1, 1.f / pg8::F8_DS); unpack_row8(r2[k], y2, 1.f / pg8::F8_DS);
#pragma unroll
            for (int i = 0; i < 16; ++i) x.v[i] = ALPHA * x.v[i] + (w1[k] * y1.v[i] + w2[k] * y2.v[i]);
            ln_rowv(x, gb);
            if (outb) store_rowv_bf16(outb + (size_t)rr * D, F.lane, x);
            if (out8) store_rowv_fp8(out8 + (size_t)rr * D, F.lane, x, pg8::F8_XS);
            if (outf) { float* o = outf + (size_t)rr * D + 8 * F.lane;
                { f32x4 a0 = {x.v[0], x.v[1], x.v[2], x.v[3]}, a1 = {x.v[4], x.v[5], x.v[6], x.v[7]}, a2 = {x.v[8], x.v[9], x.v[10], x.v[11]}, a3 = {x.v[12], x.v[13], x.v[14], x.v[15]};
                  __builtin_nontemporal_store(a0, (f32x4*)(o)); __builtin_nontemporal_store(a1, (f32x4*)(o + 4)); __builtin_nontemporal_store(a2, (f32x4*)(o + 512)); __builtin_nontemporal_store(a3, (f32x4*)(o + 516)); } } } }
    }
}
__device__ __forceinline__ void phase_cvec(const Frame& F, const unsigned char* MT8, const float* g, const float* b, float* CV) {
    const int gw = F.vcu * NWAVES + F.wave, NGW = F.G * NWAVES;
    GB gb; load_gb(g, b, F.lane, gb);
    for (int r0 = gw; r0 < B * XH * MEM; r0 += 2 * NGW) {
      RowRaw8 rw2[2];
#pragma unroll
      for (int k = 0; k < 2; ++k) { const int r = r0 + k * NGW < B * XH * MEM ? r0 + k * NGW : r0; rw2[k] = load_raw8(MT8 + (size_t)r * D, F.lane); }
#pragma unroll
      for (int k = 0; k < 2; ++k) { const int r = r0 + k * NGW; if (r < B * XH * MEM) {
        RowV m; unpack_row8(rw2[k], m, 1.f / pg8::F8_MS);
        float s1 = 0.f, s0 = 0.f;
#pragma unroll
        for (int i = 0; i < 16; ++i) { s1 += gb.g[i] * m.v[i]; s0 += gb.b[i] * m.v[i]; }
        s1 = wave_sum(s1); s0 = wave_sum(s0);
        if (F.lane < 2) CV[2 * (size_t)r + F.lane] = F.lane == 0 ? s1 : s0;
      } }
    }
}
template <class Sched>
__device__ __forceinline__ void scores_prepass(const Frame& F, const Sched& S, const float* PART, const float* CV, float in_scale, LAS float* st, LAS float* cv, LAS int* tag) {
#pragma unroll 1
    for (int i = 0; i < 4; ++i) { pg8::Unit u; const bool ok = S.next(i, u);
        if (F.tid == 0) tag[i] = ok ? u.pm * 4 + u.pn : -1;
        if (!ok) continue;
        if (F.tid < 256) { const f32x4* p = (const f32x4*)(PART + ((size_t)u.pm * 256 + F.tid) * 32); float s = 0.f, q = 0.f;
#pragma unroll
            for (int j = 0; j < 8; ++j) { const f32x4 v = p[j]; s += v[0] + v[2]; q += v[1] + v[3]; }
            const float mu = s * (1.f / D), var = fmaxf(q * (1.f / D) - mu * mu, 0.f), rstd = 1.f / sqrtf(var + LN_EPS);
            st[(i * 256 + F.tid) * 2] = rstd * in_scale; st[(i * 256 + F.tid) * 2 + 1] = -mu * rstd; }
        else { const int t = F.tid - 256; const float2 c = *(const float2*)(CV + 2 * (size_t)((u.pm >> 5) * 1024 + u.pn * 256 + t)); cv[(i * 256 + t) * 2] = c.x; cv[(i * 256 + t) * 2 + 1] = c.y; }
    }
    __syncthreads();
}
constexpr int RW_LD = 20, GBL_LD = 68;
__device__ __forceinline__ void lds_gb(const LAS float* gp, GB& o) {
#pragma unroll
    for (int q4 = 0; q4 < 4; ++q4) { const f32x4 gg = *(const LAS f32x4*)(gp + 4 * q4), bb = *(const LAS f32x4*)(gp + 16 + 4 * q4);
        o.g[4 * q4] = gg[0]; o.g[4 * q4 + 1] = gg[1]; o.g[4 * q4 + 2] = gg[2]; o.g[4 * q4 + 3] = gg[3]; o.b[4 * q4] = bb[0]; o.b[4 * q4 + 1] = bb[1]; o.b[4 * q4 + 2] = bb[2]; o.b[4 * q4 + 3] = bb[3]; }
}
__device__ __forceinline__ void phase_ln_router(const Frame& F, const bf16_t* X, const float* g1, const float* b1, const unsigned char* Y, const float* g, const float* b, bf16_t* out, unsigned char* out8, const float* rw, const float* rbias, int* eidx, float* ewgt, int* bcnt) {
    LAS float* rwl = (LAS float*)F.lds;
    LAS int* hist = (LAS int*)(F.lds + 1024 * RW_LD * 4);
    LAS float* lgs = (LAS float*)(F.lds + 1024 * RW_LD * 4 + 256) + F.wave * 256;
    { float4 rv[8];
#pragma unroll
      for (int u = 0; u < 8; ++u) { const int i = F.tid + u * NTHREADS, k = i >> 2, q = i & 3; rv[u] = *(const float4*)(rw + (size_t)k * 16 + 4 * q); }
#pragma unroll
      for (int u = 0; u < 8; ++u) { const int i = F.tid + u * NTHREADS, k = i >> 2, q = i & 3; const float4 v = rv[u];
        const int j = (k >> 9) * 8 + (k & 7), l = (k >> 3) & 63; LAS float* d = rwl + (j * 64 + l) * RW_LD + 4 * q; d[0] = v.x; d[1] = v.y; d[2] = v.z; d[3] = v.w; } }
    LAS float* g1l = (LAS float*)(F.lds + 1024 * RW_LD * 4 + 256 + 8192);
    { float gv[8];
#pragma unroll
      for (int u = 0; u < 8; ++u) { const int i = F.tid + u * NTHREADS, sel = i >> 10, k = i & 1023; const float* src = sel == 0 ? g1 : sel == 1 ? b1 : sel == 2 ? g : b; gv[u] = src[k]; }
#pragma unroll
      for (int u = 0; u < 8; ++u) { const int i = F.tid + u * NTHREADS, sel = i >> 10, k = i & 1023; g1l[((k >> 3) & 63) * GBL_LD + sel * 16 + (k >> 9) * 8 + (k & 7)] = gv[u]; } }
    const int lane = F.lane;
    for (int vb = F.vcu; vb < T / 128; vb += F.G) {
        if (F.tid < 16) hist[F.tid] = 0;
        __syncthreads();
        RowRaw rx[4]; RowRaw8 ry[4];
#pragma unroll
        for (int k = 0; k < 4; ++k) { const int r_ = vb * 128 + F.wave * 16 + k; rx[k] = load_raw(X + (size_t)r_ * D, lane); ry[k] = load_raw8(Y + (size_t)r_ * D, lane); }
#pragma unroll 1
        for (int it = 0; it < 4; ++it) {
            const int row0 = vb * 128 + F.wave * 16 + it * 4;
            RowV x[4];
#pragma unroll
            for (int k = 0; k < 4; ++k) { unpack_row(rx[k], x[k]);
                { GB gb1; lds_gb(g1l + lane * GBL_LD, gb1); ln_rowv(x[k], gb1); }
                { RowV y; unpack_row8(ry[k], y, 1.f / pg8::F8_YS);
#pragma unroll
                    for (int i = 0; i < 16; ++i) x[k].v[i] = ALPHA * x[k].v[i] + y.v[i]; }
                { GB gb; lds_gb(g1l + lane * GBL_LD + 32, gb); ln_rowv(x[k], gb); }
                store_rowv_bf16(out + (size_t)(row0 + k) * D, lane, x[k]);
                store_rowv_fp8(out8 + (size_t)(row0 + k) * D, lane, x[k], pg8::F8_XS); }
            if (it < 3) {
#pragma unroll
              for (int k = 0; k < 4; ++k) { rx[k] = load_raw(X + (size_t)(row0 + 4 + k) * D, lane); ry[k] = load_raw8(Y + (size_t)(row0 + 4 + k) * D, lane); } }
            typedef float f32x2_ __attribute__((ext_vector_type(2)));
            f32x2_ v2[32];
#pragma unroll
            for (int i = 0; i < 32; ++i) v2[i] = (f32x2_){0.f, 0.f};
#pragma unroll
            for (int j = 0; j < 16; ++j) { const LAS float* wr = rwl + (j * 64 + lane) * RW_LD;
#pragma unroll
                for (int e4 = 0; e4 < 4; ++e4) { const f32x4 w4 = *(const LAS f32x4*)(wr + 4 * e4); const f32x2_ wlo = (f32x2_){w4[0], w4[1]}, whi = (f32x2_){w4[2], w4[3]};
#pragma unroll
                    for (int k = 0; k < 4; ++k) { const f32x2_ xx = (f32x2_){x[k].v[j], x[k].v[j]};
                        v2[8 * k + 2 * e4 + 0] = __builtin_elementwise_fma(xx, wlo, v2[8 * k + 2 * e4 + 0]); v2[8 * k + 2 * e4 + 1] = __builtin_elementwise_fma(xx, whi, v2[8 * k + 2 * e4 + 1]); } } }
            float val[64];
#pragma unroll
            for (int i = 0; i < 32; ++i) { val[2 * i] = v2[i][0]; val[2 * i + 1] = v2[i][1]; }
#pragma unroll
            for (int i = 0; i < 32; ++i) { const auto rr = __builtin_amdgcn_permlane32_swap(__float_as_uint(val[i]), __float_as_uint(val[i + 32]), false, false); val[i] = __uint_as_float(rr[0]) + __uint_as_float(rr[1]); }
            { const bool bt = (lane & 16) != 0;
#pragma unroll
              for (int i = 0; i < 16; ++i) { const float keep = bt ? val[i + 16] : val[i], send = bt ? val[i] : val[i + 16]; val[i] = keep + swz_xor<16>(send); } }
            { const bool bt = (lane & 8) != 0;
#pragma unroll
              for (int i = 0; i < 8; ++i) { const float keep = bt ? val[i + 8] : val[i], send = bt ? val[i] : val[i + 8]; val[i] = keep + swz_xor<8>(send); } }
            { const bool bt = (lane & 4) != 0;
#pragma unroll
              for (int i = 0; i < 4; ++i) { const float keep = bt ? val[i + 4] : val[i], send = bt ? val[i] : val[i + 4]; val[i] = keep + swz_xor<4>(send); } }
            { const bool bt = (lane & 2) != 0;
#pragma unroll
              for (int i = 0; i < 2; ++i) { const float keep = bt ? val[i + 2] : val[i], send = bt ? val[i] : val[i + 2]; val[i] = keep + swz_xor<2>(send); } }
            { const bool bt = (lane & 1) != 0; const float keep = bt ? val[1] : val[0], send = bt ? val[0] : val[1]; val[0] = keep + swz_xor<1>(send); }
            lgs[it * 64 + lane] = val[0];
        }
        LDS_WAIT();
        if (lane < 16) {
            {
                const int row = vb * 128 + F.wave * 16 + lane;
                float lg[16];
#pragma unroll
                for (int e4 = 0; e4 < 4; ++e4) { const f32x4 t4 = *(const LAS f32x4*)(lgs + 16 * lane + 4 * e4); lg[4 * e4] = t4[0]; lg[4 * e4 + 1] = t4[1]; lg[4 * e4 + 2] = t4[2]; lg[4 * e4 + 3] = t4[3]; }
                float mx = lg[0];
#pragma unroll
                for (int e = 1; e < 16; ++e) mx = fmaxf(mx, lg[e]);
                float sc[16], sum = 0.f;
#pragma unroll
                for (int e = 0; e < 16; ++e) { sc[e] = __expf(lg[e] - mx); sum += sc[e]; }
                const float isum = 1.f / sum;
                float bz[16];
#pragma unroll
                for (int e = 0; e < 16; ++e) { sc[e] *= isum; bz[e] = sc[e] + rbias[e]; }
                float gs[4]; int gi1[4], gi2[4];
#pragma unroll
                for (int gq = 0; gq < 4; ++gq) {
                    float m1 = bz[4 * gq]; int i1 = 0;
#pragma unroll
                    for (int j = 1; j < 4; ++j) if (bz[4 * gq + j] > m1) { m1 = bz[4 * gq + j]; i1 = j; }
                    float m2 = -INFINITY; int i2 = 0;
#pragma unroll
                    for (int j = 0; j < 4; ++j) if (j != i1 && bz[4 * gq + j] > m2) { m2 = bz[4 * gq + j]; i2 = j; }
                    gs[gq] = m1 + m2; gi1[gq] = i1; gi2[gq] = i2;
                }
                int gsel = 0; float gm = gs[0];
#pragma unroll
                for (int gq = 1; gq < 4; ++gq) if (gs[gq] > gm) { gm = gs[gq]; gsel = gq; }
                int i1 = gi1[0], i2 = gi2[0];
#pragma unroll
                for (int gq = 1; gq < 4; ++gq) if (gsel == gq) { i1 = gi1[gq]; i2 = gi2[gq]; }
                const int e1 = gsel * 4 + i1, e2 = gsel * 4 + i2;
                float s1 = 0.f, s2 = 0.f;
#pragma unroll
                for (int e = 0; e < 16; ++e) { if (e == e1) s1 = sc[e]; if (e == e2) s2 = sc[e]; }
                const float inv = 1.f / (s1 + s2);
                *(int2*)(eidx + 2 * row) = make_int2(e1, e2); *(float2*)(ewgt + 2 * row) = make_float2(s1 * inv, s2 * inv);
                atomicAdd((int*)&hist[e1], 1); atomicAdd((int*)&hist[e2], 1);
            }
        }
        __syncthreads();
        if (F.tid < 16) bcnt[vb * 16 + F.tid] = hist[F.tid];
        __syncthreads();
    }
}
__device__ __forceinline__ void phase_moe_book(const Frame& F, const int* eidx, const int* bcnt, int* tok, int* pos, int* tile_e) {
    LAS int* bc = (LAS int*)F.lds;
    LAS int* part = bc + 4096;
    LAS int* off = part + 256;
    LAS int* base = off + 32;
    LAS int* tot = base + 16;
    LAS int* wcnt = tot + 16;
    for (int i = F.tid; i < 4096; i += NTHREADS) bc[i] = bcnt[i];
    __syncthreads();
    if (F.tid < 256) { const int e = F.tid & 15, ch = F.tid >> 4; int s = 0;
#pragma unroll
        for (int j = 0; j < 16; ++j) s += bc[(ch * 16 + j) * 16 + e];
        part[ch * 16 + e] = s; }
    __syncthreads();
    if (F.tid < 16) { int t = 0;
#pragma unroll
        for (int ch = 0; ch < 16; ++ch) t += part[ch * 16 + F.tid];
        tot[F.tid] = t; }
    __syncthreads();
    if (F.tid == 0) { int o = 0;
#pragma unroll
        for (int e = 0; e < 16; ++e) { off[e] = o; o += (tot[e] + 255) & ~255; } off[16] = o; }
    __syncthreads();
    for (int vb = F.vcu; vb < T / 128; vb += F.G) {
        if (F.tid < 16) { const int e = F.tid, chv = vb >> 4; int bs = 0;
            for (int ch = 0; ch < chv; ++ch) bs += part[ch * 16 + e];
            for (int b2 = chv * 16; b2 < vb; ++b2) bs += bc[b2 * 16 + e];
            base[e] = bs; }
        int e = 0, rank = 0;
        if (F.tid < 256) {
            e = eidx[vb * 256 + F.tid];
            const unsigned long long lt = (1ull << F.lane) - 1ull;
#pragma unroll
            for (int k = 0; k < 16; ++k) { const unsigned long long mk = __ballot(e == k); if (e == k) rank = __popcll(mk & lt); if (F.lane == 0) wcnt[F.wave * 16 + k] = __popcll(mk); }
        }
        __syncthreads();
        if (F.tid < 256) {
            for (int w2 = 0; w2 < F.wave; ++w2) rank += wcnt[w2 * 16 + e];
            const int r = off[e] + base[e] + rank;
            pos[vb * 256 + F.tid] = r; tok[r] = vb * 128 + (F.tid >> 1);
        }
        if (vb < 16) { const int e2 = vb, r0 = off[e2] + tot[e2], r1 = off[e2 + 1]; for (int r = r0 + F.tid; r < r1; r += NTHREADS) tok[r] = 0; }
        if (vb == 16) {
            for (int tl = F.tid; tl < NTILE; tl += NTHREADS) { int e3 = -1;
#pragma unroll
                for (int k = 0; k < 16; ++k) if (tl * 256 >= off[k] && tl * 256 < off[k + 1]) e3 = k;
                tile_e[tl] = e3; }
            if (F.tid == 0) tile_e[NTILE] = off[16] >> 8;
        }
        __syncthreads();
    }
}
__device__ __forceinline__ void phase_pool(const Frame& F, const bf16_t* HP, unsigned char* PO) {
    constexpr int RUN = 16;
    const int gt = F.vcu * NTHREADS + F.tid, NGT = F.G * NTHREADS;
#pragma unroll 1
    for (int it = gt; it < (T / RUN) * (D / 8); it += NGT) {
        const int c8 = it & 127, run = it >> 7, g = c8 >> 5, win = 2 << g, t0 = run * RUN, ts0 = t0 & (S - 1);
        const bf16_t* hp = HP + (size_t)t0 * D + c8 * 8; unsigned char* po = PO + (size_t)t0 * D + c8 * 8;
        v4u raw[31];
#pragma unroll
        for (int j = 0; j < 31; ++j) { raw[j] = (v4u){0u, 0u, 0u, 0u}; if (j >= 15 || ts0 > 0) raw[j] = *(const v4u*)(hp + (ptrdiff_t)(j - 15) * D); }
        float s[8]; v2u oprev = (v2u){0u, 0u};
#pragma unroll
        for (int q = 0; q < 8; ++q) s[q] = 0.f;
#pragma unroll
        for (int k = 1; k < 16; ++k) { float v[8]; unpk8(raw[15 - k], v); const bool in = k < win;
#pragma unroll
            for (int q = 0; q < 8; ++q) s[q] += in ? v[q] : 0.f; }
#pragma unroll
        for (int i = 0; i < RUN; ++i) {
            float hn[8]; unpk8(raw[15 + i], hn);
            const int ts = ts0 + i;
#pragma unroll
            for (int q = 0; q < 8; ++q) s[q] += hn[q];
            const float inv = 1.f / (float)(ts + 1 < win ? ts + 1 : win);
            v2u o; const float xs = pg8::F8_XS; o.x = pg8::pk4_fp8((s[0] * inv - hn[0]) * xs, (s[1] * inv - hn[1]) * xs, (s[2] * inv - hn[2]) * xs, (s[3] * inv - hn[3]) * xs); o.y = pg8::pk4_fp8((s[4] * inv - hn[4]) * xs, (s[5] * inv - hn[5]) * xs, (s[6] * inv - hn[6]) * xs, (s[7] * inv - hn[7]) * xs);
            if ((i & 1) == 0) oprev = o;
            else {
                const bool odd = (c8 & 1) != 0;
                const unsigned rx = dpp_xor1(odd ? oprev.x : o.x), ry = dpp_xor1(odd ? oprev.y : o.y);
                v4u w; w.x = odd ? rx : oprev.x; w.y = odd ? ry : oprev.y; w.z = odd ? o.x : rx; w.w = odd ? o.y : ry;
                *(v4u*)(po + (size_t)(i - 1 + (odd ? 1 : 0)) * D - (odd ? 8 : 0)) = w; }
            { const v4u r2 = raw[14 + i], r4 = raw[12 + i], r8 = raw[8 + i], r16 = raw[i]; v4u lv;
              lv.x = g == 0 ? r2.x : g == 1 ? r4.x : g == 2 ? r8.x : r16.x; lv.y = g == 0 ? r2.y : g == 1 ? r4.y : g == 2 ? r8.y : r16.y;
              lv.z = g == 0 ? r2.z : g == 1 ? r4.z : g == 2 ? r8.z : r16.z; lv.w = g == 0 ? r2.w : g == 1 ? r4.w : g == 2 ? r8.w : r16.w;
              float ho[8]; unpk8(lv, ho);
#pragma unroll
              for (int q = 0; q < 8; ++q) s[q] -= ho[q]; }
        }
    }
}
}
namespace mk {
typedef short bf16x8 __attribute__((ext_vector_type(8)));
typedef float f32x16 __attribute__((ext_vector_type(16)));
#define MFMA32(a, b, c) __builtin_amdgcn_mfma_f32_32x32x16_bf16((a), (b), (c), 0, 0, 0)
__device__ __forceinline__ int crow(int i, int h) { return (i & 3) + 8 * (i >> 2) + 4 * h; }
__device__ __forceinline__ float swap32_max(float v) { const auto r = __builtin_amdgcn_permlane32_swap(__float_as_uint(v), __float_as_uint(v), false, false); return fmaxf(__uint_as_float(r[0]), __uint_as_float(r[1])); }
__device__ __forceinline__ float swap32_sum(float v) { const auto r = __builtin_amdgcn_permlane32_swap(__float_as_uint(v), __float_as_uint(v), false, false); return __uint_as_float(r[0]) + __uint_as_float(r[1]); }
__device__ __forceinline__ unsigned pkbf(float lo, float hi) { unsigned r; asm volatile("v_cvt_pk_bf16_f32 %0, %1, %2" : "=v"(r) : "v"(lo), "v"(hi)); return r; }
__device__ __forceinline__ bf16x8 pack_step(const f32x16& x, int s) {
    v4u p; p.x = pkbf(x[8 * s + 0], x[8 * s + 1]); p.y = pkbf(x[8 * s + 2], x[8 * s + 3]); p.z = pkbf(x[8 * s + 4], x[8 * s + 5]); p.w = pkbf(x[8 * s + 6], x[8 * s + 7]);
    return __builtin_bit_cast(bf16x8, p);
}
__device__ __forceinline__ bf16x8 lds_frag2x8(const LAS unsigned char* p) {
    const v2u a = *(const LAS v2u*)p, b = *(const LAS v2u*)(p + 16);
    v4u q; q.x = a.x; q.y = a.y; q.z = b.x; q.w = b.y; return __builtin_bit_cast(bf16x8, q);
}
__device__ __forceinline__ void unpack8(const v4u u, float (&x)[8]) {
    x[0] = __uint_as_float(u.x << 16); x[1] = __uint_as_float(u.x & 0xffff0000u); x[2] = __uint_as_float(u.y << 16); x[3] = __uint_as_float(u.y & 0xffff0000u);
    x[4] = __uint_as_float(u.z << 16); x[5] = __uint_as_float(u.z & 0xffff0000u); x[6] = __uint_as_float(u.w << 16); x[7] = __uint_as_float(u.w & 0xffff0000u);
}

__device__ __forceinline__ v4u widen4x4(unsigned i0, unsigned i1, unsigned i2, unsigned i3) {
    const auto a = __builtin_amdgcn_permlane32_swap(i0, i2, false, false), b = __builtin_amdgcn_permlane32_swap(i1, i3, false, false);
    v4u v; v.x = a[0]; v.y = a[1]; v.z = b[0]; v.w = b[1]; return v;
}
constexpr float F8_MIXS = 8.f;
__device__ __forceinline__ void phase_swa_sgu(const Frame& F, const bf16_t* H0, const float* sinks, const float* lng, const float* lnb, const bf16_t* SW, const float* bs, unsigned char* MIX) {
    constexpr int KSTR = 272, VSTR = 520, VT_OFF = 256 * KSTR, VGSTR = 272, VGW = 64 * VGSTR;
    LAS unsigned char* KS = F.lds; LAS unsigned char* VT = F.lds + VT_OFF;
    LAS float* gbl = (LAS float*)(F.lds + 8 * VGW);
    for (int i = F.tid; i < 1024; i += NTHREADS) gbl[i] = i < 512 ? lng[i] : lnb[i - 512];
    const int lane = F.lane, r = lane & 31, h = lane >> 5, w = F.wave, kvh = w >> 2;
    const float NEG = -INFINITY;
    for (int vb = F.vcu; vb < T / 128; vb += F.G) {
        const int n = vb & 63; const size_t row0 = (size_t)vb * 128;
#pragma unroll
        for (int i = 0; i < 8; ++i) { const int p = F.tid + NTHREADS * i, row = p >> 4, c16 = p & 15; v4u v = (v4u){0u, 0u, 0u, 0u};
            if (n > 0 || row >= 128) v = *(const v4u*)(H0 + (row0 + row - 128) * NIN0 + 512 + c16 * 8);
            *(LAS v4u*)(KS + row * KSTR + c16 * 16) = v; }
#pragma unroll
        for (int i = 0; i < 8; ++i) { const int p = F.tid + NTHREADS * i, c16 = p >> 8, row = p & 255; v4u v = (v4u){0u, 0u, 0u, 0u};
            if (n > 0 || row >= 128) v = *(const v4u*)(H0 + (row0 + row - 128) * NIN0 + 640 + c16 * 8);
            LAS bf16_t* d = (LAS bf16_t*)(VT + (c16 * 8) * VSTR + row * 2);
            d[0 * (VSTR / 2)] = (bf16_t)(v.x & 0xffffu); d[1 * (VSTR / 2)] = (bf16_t)(v.x >> 16); d[2 * (VSTR / 2)] = (bf16_t)(v.y & 0xffffu); d[3 * (VSTR / 2)] = (bf16_t)(v.y >> 16);
            d[4 * (VSTR / 2)] = (bf16_t)(v.z & 0xffffu); d[5 * (VSTR / 2)] = (bf16_t)(v.z >> 16); d[6 * (VSTR / 2)] = (bf16_t)(v.w & 0xffffu); d[7 * (VSTR / 2)] = (bf16_t)(v.w >> 16); }
        __syncthreads();
        const float sink2 = sinks[w] * 1.4426950408889634f;
        bf16x8 qn[4];
        { const bf16_t* qp = H0 + (row0 + r) * NIN0 + w * 64 + 8 * h;
#pragma unroll
          for (int ks = 0; ks < 4; ++ks) qn[ks] = *(const bf16x8*)(qp + 16 * ks); }
#pragma unroll 1
        for (int qg = 0; qg < 4; ++qg) {
            bf16x8 qf[4];
#pragma unroll
            for (int ks = 0; ks < 4; ++ks) qf[ks] = qn[ks];
            if (qg < 3) { const bf16_t* qp = H0 + (row0 + 32 * (qg + 1) + r) * NIN0 + w * 64 + 8 * h;
#pragma unroll
              for (int ks = 0; ks < 4; ++ks) qn[ks] = *(const bf16x8*)(qp + 16 * ks); }
            f32x16 st[5];
#pragma unroll
            for (int kt = 0; kt < 5; ++kt) {
#pragma unroll
                for (int i = 0; i < 16; ++i) st[kt][i] = 0.f;
                const LAS unsigned char* kp = KS + (32 * qg + 32 * kt + r) * KSTR + (kvh * 64 + 8 * h) * 2;
#pragma unroll
                for (int ks = 0; ks < 4; ++ks) { const bf16x8 kf = *(const LAS bf16x8*)(kp + 32 * ks); st[kt] = MFMA32(kf, qf[ks], st[kt]); }
            }
            float m = sink2;
            int rq = r; asm volatile("" : "+v"(rq));
#pragma unroll
            for (int kt = 0; kt < 5; ++kt)
#pragma unroll
                for (int i = 0; i < 16; ++i) { const int dk = 32 * kt + crow(i, h) - rq;
                    float s = st[kt][i] * ASCALE;
                    if (kt == 0) s = dk >= 1 ? s : NEG;
                    if (kt == 4) s = dk <= 128 ? s : NEG;
                    st[kt][i] = s; }
            if (n == 0) {
#pragma unroll
                for (int kt = 0; kt < 5; ++kt)
#pragma unroll
                    for (int i = 0; i < 16; ++i) if (32 * qg + 32 * kt + crow(i, h) < 128) st[kt][i] = NEG; }
#pragma unroll
            for (int kt = 0; kt < 5; ++kt)
#pragma unroll
                for (int i = 0; i < 16; ++i) m = fmaxf(m, st[kt][i]);
            m = swap32_max(m);
            float l = 0.f;
#pragma unroll
            for (int kt = 0; kt < 5; ++kt)
#pragma unroll
                for (int i = 0; i < 16; ++i) { const float p = __builtin_amdgcn_exp2f(st[kt][i] - m); st[kt][i] = p; l += p; }
            l = swap32_sum(l) + __builtin_amdgcn_exp2f(sink2 - m);
            f32x16 o[2];
#pragma unroll
            for (int i = 0; i < 16; ++i) { o[0][i] = 0.f; o[1][i] = 0.f; }
#pragma unroll
            for (int kt = 0; kt < 5; ++kt)
#pragma unroll
                for (int s = 0; s < 2; ++s) { const bf16x8 pf = pack_step(st[kt], s);
#pragma unroll
                    for (int dt = 0; dt < 2; ++dt) { const bf16x8 vf = lds_frag2x8(VT + (kvh * 64 + 32 * dt + r) * VSTR + (32 * qg + 32 * kt + 16 * s + 4 * h) * 2); o[dt] = MFMA32(vf, pf, o[dt]); } }
            const float inv = F8_MIXS / l;
            unsigned char* op = MIX + (row0 + 32 * qg + r) * D + w * 64 + 16 * h;
#pragma unroll
            for (int dt = 0; dt < 2; ++dt) { unsigned it4[4];
#pragma unroll
                for (int g4 = 0; g4 < 4; ++g4) it4[g4] = pg8::pk4_fp8(o[dt][4 * g4 + 0] * inv, o[dt][4 * g4 + 1] * inv, o[dt][4 * g4 + 2] * inv, o[dt][4 * g4 + 3] * inv);
                *(v4u*)(op + 32 * dt) = widen4x4(it4[0], it4[1], it4[2], it4[3]); }
        }
        __syncthreads();
        {
            LAS unsigned char* VG = F.lds + w * VGW; const int g = w;
            const int lane2 = (int)lane_id_fresh(), r2 = lane2 & 31, h2 = lane2 >> 5;
            v4u vraw[2][8];
#pragma unroll
            for (int it = 0; it < 2; ++it) { const bf16_t* vp = H0 + (row0 + 64 * it + lane2) * NIN0 + 1280 + g * 64;
#pragma unroll
                for (int cq = 0; cq < 8; ++cq) vraw[it][cq] = __builtin_nontemporal_load((const v4u*)(vp + 8 * cq)); }
#pragma unroll
            for (int it = 0; it < 2; ++it) { const int s = 64 * it + lane2;
                float x[8][8]; float sum = 0.f;
#pragma unroll
                for (int cq = 0; cq < 8; ++cq) { unpack8(vraw[it][cq], x[cq]);
#pragma unroll
                    for (int e = 0; e < 8; ++e) sum += x[cq][e]; }
                const float mu = sum * (1.f / 64.f); float q = 0.f;
#pragma unroll
                for (int cq = 0; cq < 8; ++cq)
#pragma unroll
                    for (int e = 0; e < 8; ++e) { x[cq][e] -= mu; q += x[cq][e] * x[cq][e]; }
                const float rstd = 1.f / sqrtf(q * (1.f / 64.f) + LN_EPS);
#pragma unroll
                for (int cq = 0; cq < 8; ++cq) { const LAS f32x4* gq = (const LAS f32x4*)(gbl + g * 64 + 8 * cq); const LAS f32x4* bq = (const LAS f32x4*)(gbl + 512 + g * 64 + 8 * cq);
                    const f32x4 g0 = gq[0], g1 = gq[1], b0 = bq[0], b1 = bq[1];
#pragma unroll
                    for (int e = 0; e < 8; ++e) { const int c = 8 * cq + e; const float gg = e < 4 ? g0[e & 3] : g1[e & 3], bb = e < 4 ? b0[e & 3] : b1[e & 3]; *(LAS bf16_t*)(VG + c * VGSTR + s * 2) = f2bf(x[cq][e] * rstd * gg + bb); } }
            }
            v2u uall[4][2][4];
#pragma unroll
            for (int tt = 0; tt < 4; ++tt) { const bf16_t* up = H0 + (row0 + 32 * tt + r2) * NIN0 + 768 + g * 64 + 4 * h2;
#pragma unroll
                for (int ct = 0; ct < 2; ++ct)
#pragma unroll
                    for (int g4 = 0; g4 < 4; ++g4) uall[tt][ct][g4] = *(const v2u*)(up + 32 * ct + 8 * g4); }
            LDS_WAIT();
#pragma unroll
            for (int tt = 0; tt < 4; ++tt) {
                f32x16 acc[2];
#pragma unroll
                for (int i = 0; i < 16; ++i) { acc[0][i] = 0.f; acc[1][i] = 0.f; }
                const bf16_t* wp = SW + ((size_t)(g * 128 + 32 * tt + r2) * 128 + 8 * h2);
                const int nks = 2 * (tt + 1);
                bf16x8 bfr[8];
#pragma unroll
                for (int ks = 0; ks < 8; ++ks) if (ks < nks) bfr[ks] = *(const bf16x8*)(wp + 16 * ks);
                const int t = 32 * tt + r2; const float bias = bs[g * 128 + t];
                unsigned char* op = MIX + (row0 + t) * D + 512 + g * 64 + 16 * h2;
#pragma unroll
                for (int ks = 0; ks < 8; ++ks) if (ks < nks) {
#pragma unroll
                    for (int ct = 0; ct < 2; ++ct) { const bf16x8 af = *(const LAS bf16x8*)(VG + (32 * ct + r2) * VGSTR + (16 * ks + 8 * h2) * 2); acc[ct] = MFMA32(af, bfr[ks], acc[ct]); } }
#pragma unroll
                for (int ct = 0; ct < 2; ++ct) { unsigned it4[4];
#pragma unroll
                    for (int g4 = 0; g4 < 4; ++g4) { const v2u u2 = uall[tt][ct][g4];
                        const float u0 = __uint_as_float(u2.x << 16), u1 = __uint_as_float(u2.x & 0xffff0000u), u2f = __uint_as_float(u2.y << 16), u3 = __uint_as_float(u2.y & 0xffff0000u);
                        it4[g4] = pg8::pk4_fp8(F8_MIXS * u0 * (acc[ct][4 * g4 + 0] + bias), F8_MIXS * u1 * (acc[ct][4 * g4 + 1] + bias), F8_MIXS * u2f * (acc[ct][4 * g4 + 2] + bias), F8_MIXS * u3 * (acc[ct][4 * g4 + 3] + bias)); }
                    *(v4u*)(op + 32 * ct) = widen4x4(it4[0], it4[1], it4[2], it4[3]); }
            }
        }
        __syncthreads();
    }
}

}
namespace mk {
constexpr int NPHASE = 23;
constexpr int N_EARLY = 896 + 2 * 1024, NITEMS = N_EARLY + 3 * 512 + 2 * (512 + 3 * 4096);
constexpr int GEMM_CUS_P1 = 160;

typedef const __attribute__((address_space(4))) Args* KArgs;
__device__ __forceinline__ KArgs kargs() { KArgs p = (KArgs)__builtin_amdgcn_kernarg_segment_ptr(); asm volatile("" : "+s"(p)); return p; }

__device__ __forceinline__ void decode_item(KArgs ka, bf16_t* WB, int it, TItem& t) {
                    int r = it;
#define JOB(MAP, F8_, src, K_, N_, dst, dstb, cnt) if (r < (cnt)) { titem_fill<MAP, F8_>(t, src, K_, N_, dst, dstb, r); return; } r -= (cnt);
                    JOB(0, true, ka->in[5], 1024, 1792, WB + WB_IN0, 0, 896)
                    JOB(0, false, ka->in[15], 1024, 2048, WB + WB_LAYER + WL_XKV, 0, 1024)
                    JOB(0, false, ka->in[31], 1024, 2048, WB + WB_LAYER + WL_SIZE + WL_XKV, 0, 1024)
                    JOB(0, true, ka->in[11], 1024, 1024, WB + WB_OUT0, 0, 512)
                    JOB(0, true, ka->in[24], 1024, 1024, WB + WB_IN1, 0, 512)
                    JOB(0, false, ka->in[27], 1024, 1024, WB + WB_OUT1, 0, 512)
#define LAYER_JOBS(l, c2) { bf16_t* Wl = WB + WB_LAYER + (size_t)(l) * WL_SIZE; \
                        JOB(0, false, ka->in[(c2) + 4], 1024, 1024, Wl + WL_XO, 0, 512) \
                        JOB(1, true, ka->in[(c2) + 7], 1024, 512, Wl + WL_GU, (size_t)1024 * 1024, 4096)     \
                        JOB(2, true, ka->in[(c2) + 8], 1024, 512, Wl + WL_GU, (size_t)1024 * 1024, 4096) \
                        JOB(0, true, ka->in[(c2) + 9], 512, 1024, Wl + WL_DN, (size_t)1024 * 512, 4096) }
                    LAYER_JOBS(0, 12)
                    LAYER_JOBS(1, 28)
#undef LAYER_JOBS
#undef JOB
}

__device__ __forceinline__ bool in_range(int k) { KArgs ka = kargs(); return ka->ph_lo <= k && k < ka->ph_hi; }

__global__ void __launch_bounds__(NTHREADS, 2) mega(Args a) {
    extern __shared__ __attribute__((aligned(16))) unsigned char lds_raw[];
    LAS unsigned char* const F0lds = (LAS unsigned char*)lds_raw;
    const int F0wave = __builtin_amdgcn_readfirstlane((int)threadIdx.x >> 6);
    const int F0G = gridDim.x, F0bx = blockIdx.x, F0vcu = (F0G % 8 == 0) ? (F0bx % 8) * (F0G / 8) + F0bx / 8 : F0bx;
    volatile LAS unsigned* MISC = (volatile LAS unsigned*)(F0lds + MISC_OFF);
    if (threadIdx.x < 64) MISC[threadIdx.x] = 0u;
    __syncthreads();
    unsigned* ctl = (unsigned*)(a.ws + WS_CTL);
    XcdBarrier bar = xcd_barrier_post(ctl + CW_BAR + a.ph_lo * XCD_BAR_WORDS, MISC + 8, F0wave);
#ifdef MK_PHASE_RANGE
#define IN(k) in_range(k)
#define SEAM(k) do { if (IN(k) && IN((k) + 1)) { XcdBarrier b2_ = bar; asm volatile("" : "+s"(b2_.bar), "+s"(b2_.x)); xcd_barrier(b2_); } } while (0)
#else
#define IN(k) true
#define SEAM(k) do { XcdBarrier b2_ = bar; asm volatile("" : "+s"(b2_.bar), "+s"(b2_.x)); xcd_barrier(b2_); } while (0)
#endif
#define PH KArgs ka = kargs(); unsigned char* ws = ka->ws; (void)ws; Frame Fp; Fp.lds = F0lds; Fp.wave = F0wave; Fp.vcu = F0vcu; Fp.G = F0G; Fp.bx = F0bx; asm volatile("" : "+s"(Fp.wave), "+s"(Fp.vcu), "+s"(Fp.G), "+s"(Fp.bx)); \
    Fp.lane = (int)lane_id_fresh(); Fp.tid = Fp.wave * 64 + Fp.lane; const Frame& F = Fp; \
    const int bx = Fp.bx; (void)bx; LAS unsigned char* glds = F.lds; (void)glds; \
    bf16_t* RA = (bf16_t*)(ws + WS_A); bf16_t* RB = (bf16_t*)(ws + WS_B); bf16_t* RC = (bf16_t*)(ws + WS_C); bf16_t* RD = (bf16_t*)(ws + WS_D); bf16_t* WB = (bf16_t*)(ws + WS_WB); \
    (void)RA; (void)RB; (void)RC; (void)RD; (void)WB;
#define PHC PH const int cb = L == 0 ? 12 : 28; (void)cb; bf16_t* WBl = WB + WB_LAYER + (size_t)L * WL_SIZE; (void)WBl; \
    bf16_t *Z1 = L == 0 ? RC : RD, *X2 = RA, *HS = RB, *DS = RD, *X3 = L == 0 ? RC : nullptr;   unsigned char *ZG8 = (unsigned char*)(L == 0 ? RD : RA), *P8 = (unsigned char*)(L == 0 ? RA : RC), *X2_8 = (unsigned char*)(L == 0 ? RD : RC); bf16_t* Y2 = RB; \
    (void)Z1; (void)P8; (void)ZG8; (void)X2_8; (void)Y2; (void)X2; (void)HS; (void)DS; (void)X3;
#ifndef DOUBLE_MASK
#define DOUBLE_MASK 0u
#endif
#if DOUBLE_MASK != 0
#define REP(k) for (int rep_ = 0, nrep_ = 1 + (int)((DOUBLE_MASK >> (k)) & 1u); rep_ < nrep_; ++rep_)
#else
#define REP(k)
#endif
#define INF(i) ((const float*)ka->in[i])
#define WSI(off) ((int*)(ws + (off)))
#define WSF(off) ((float*)(ws + (off)))

#define GEMM_STD(EPI, ORD, LDA_, LDB_, K_) pg8::gemm_phase<EPI, ORD, true, true, false, LDA_, LDB_, K_>(glds, F.tid, g, S, E)
    for (int L = 0; L < 2; ++L) {
        const int cbp = L == 0 ? 0 : 11;
        if (L == 0) {
            if (IN(0)) REP(0) { PH
                LAS float* scrA = (LAS float*)(F.lds + F.wave * 16896), * scrB = scrA + 64 * 33;
                const int gw = F.vcu * NWAVES + F.wave, NGW = F.G * NWAVES;
                for (int it = gw; it < N_EARLY; it += 2 * NGW) {
                    TItem ta, tb; TRegs ra, rb; const int itb = it + NGW < N_EARLY ? it + NGW : it;
                    decode_item(ka, WB, it, ta); titem_load(ta, F.lane, ra);
                    decode_item(ka, WB, itb, tb); titem_load(tb, F.lane, rb);
                    titem_finish(ta, F.lane, ra, scrA);
                    titem_finish(tb, F.lane, rb, scrB);
                }
                const int gt = F.vcu * NTHREADS + F.tid, NGT = F.G * NTHREADS;
                { const float4* x4 = (const float4*)ka->in[0]; v2u* o = (v2u*)RA; unsigned* o8 = (unsigned*)RB;
                  for (int i = gt; i < T * D / 4; i += 4 * NGT) { float4 v[4];
#pragma unroll
                      for (int k = 0; k < 4; ++k) { const f32x4 t_ = __builtin_nontemporal_load((const f32x4*)(x4 + i + k * NGT)); v[k] = make_float4(t_[0], t_[1], t_[2], t_[3]); }
#pragma unroll
                      for (int k = 0; k < 4; ++k) { v2u w; w.x = pk2(v[k].x, v[k].y); w.y = pk2(v[k].z, v[k].w); o[i + k * NGT] = w;
                          o8[i + k * NGT] = pg8::pk4_fp8(v[k].x * pg8::F8_XS, v[k].y * pg8::F8_XS, v[k].z * pg8::F8_XS, v[k].w * pg8::F8_XS); } } }
                { const float4* m4 = (const float4*)ka->in[1]; v2u* o = (v2u*)(ws + WS_MEMB);
                  for (int i = gt; i < B * MEM * D / 4; i += NGT) { const float4 v = m4[i]; v2u w; w.x = pk2(v.x, v.y); w.y = pk2(v.z, v.w); o[i] = w; } }
                { const int* positions = (const int*)ka->in[2]; float* ropew = WSF(WS_ROPE);
                  for (int t = gt; t < T; t += NGT) { const float p = (float)positions[t];
#pragma unroll
                      for (int j = 0; j < 8; ++j) { const float ang = p * ka->inv.f[j]; double rev = (double)ang * 0.15915494309189535; rev -= rint(rev); const float rr = (float)rev;
                          ropew[(size_t)t * 16 + j] = __builtin_amdgcn_cosf(rr); ropew[(size_t)t * 16 + 8 + j] = __builtin_amdgcn_sinf(rr); } } }
            }
            SEAM(0);
            if (IN(1)) REP(1) { PH float* rope = WSF(WS_ROPE); bf16_t* MEMB = (bf16_t*)(ws + WS_MEMB);
              const int GC = F.G >= 256 ? GEMM_CUS_P1 : F.G;
              if (bx >= GC || F.G < 256) {
                const int cid = F.G >= 256 ? bx - GC : bx, NC = F.G >= 256 ? F.G - GC : F.G;
                LAS float* scrA = (LAS float*)(F.lds + F.wave * 16896), * scrB = scrA + 64 * 33;
                const int gw = cid * NWAVES + F.wave, NGW = NC * NWAVES;
#define CLAMP_IT(x) ((x) < NITEMS ? (x) : NITEMS - 1)
                { TItem ta, tb, tc, td; TRegs ra, rb, rc, rd; int it = N_EARLY + gw;
                  decode_item(ka, WB, CLAMP_IT(it), ta); titem_load(ta, F.lane, ra);
                  decode_item(ka, WB, CLAMP_IT(it + NGW), tb); titem_load(tb, F.lane, rb);
                  for (; it < NITEMS; it += 4 * NGW) {
                      decode_item(ka, WB, CLAMP_IT(it + 2 * NGW), tc); titem_load(tc, F.lane, rc);
                      decode_item(ka, WB, CLAMP_IT(it + 3 * NGW), td); titem_load(td, F.lane, rd);
                      titem_finish(ta, F.lane, ra, scrA); titem_finish(tb, F.lane, rb, scrB);
                      decode_item(ka, WB, CLAMP_IT(it + 4 * NGW), ta); titem_load(ta, F.lane, ra);
                      decode_item(ka, WB, CLAMP_IT(it + 5 * NGW), tb); titem_load(tb, F.lane, rb);
                      titem_finish(tc, F.lane, rc, scrA); titem_finish(td, F.lane, rd, scrB);
                  } }
#undef CLAMP_IT
                const int gt = cid * NTHREADS + F.tid, NGT = NC * NTHREADS;
#pragma unroll
                for (int l = 0; l < 2; ++l) { const float4* q4 = (const float4*)ka->in[l == 0 ? 14 : 30]; v2u* o = (v2u*)(WB + WB_LAYER + (size_t)l * WL_SIZE + WL_XQ);
                  for (int i = gt; i < D * D / 4; i += NGT) { const float4 v = q4[i]; v2u w; w.x = pk2(v.x, v.y); w.y = pk2(v.z, v.w); o[i] = w; } }
                { const float4* p4 = (const float4*)ka->in[25]; const float4* s4 = (const float4*)ka->in[26]; v2u* o = (v2u*)(WB + WB_POOL);
                  for (int i = gt; i < 4 * 256 * 256 / 4; i += NGT) { const float4 v = p4[i]; const float4 sc = s4[(i >> 14) * 64 + (i & 63)]; v2u w; w.x = pk2(v.x * sc.x, v.y * sc.y); w.y = pk2(v.z * sc.z, v.w * sc.w); o[i] = w; } }
                { const float* sw = INF(9); bf16_t* o = WB + WB_SGUW;
                  for (int i = gt; i < 8 * 128 * 128; i += NGT) { const int s2 = i & 127, t = (i >> 7) & 127; o[i] = f2bf(s2 <= t ? sw[i] : 0.f); } }
                __syncthreads();
              }
              if (bx < GC) {
#pragma unroll 1
                for (int l = 0; l < 2; ++l) {
                    bf16_t* Wl = WB + WB_LAYER + (size_t)l * WL_SIZE;
                    pg8::Gemm g{MEMB, Wl + WL_XKV, nullptr, nullptr};
                    const int c2 = bx - 96 - 32 * l;
                    pg8::StaticOrder S; S.init(B * MEM, 2048, GC, (c2 >= 0 && c2 < 32) ? c2 : (1 << 20), D, D);
                    pg8::EpiBf16 E{(bf16_t*)(ws + WS_MEMKV) + (size_t)l * B * MEM * 2048, 2048, 1.f};
                    GEMM_STD(pg8::EpiBf16, pg8::StaticOrder, D, D, D);
                }
                {
                    pg8::Gemm g{RB, WB + WB_IN0, nullptr, nullptr};
                    pg8::StaticOrder S; S.init(T, NIN0, GC, bx, D, D);
                    pg8::EpiInproj0 E{RD, rope, 1.f / (pg8::F8_XS * pg8::F8_WS)};
                    pg8::gemm_phase<pg8::EpiInproj0, pg8::StaticOrder, true, true, false, D, D, D, true>(glds, F.tid, g, S, E);
                }
              }
            }
            SEAM(1);
            if (IN(2)) REP(2) { PH
                { bf16_t* Wl = WB + WB_LAYER; const bf16_t* KV = (const bf16_t*)(ws + WS_MEMKV);
                  { pg8::Gemm g{KV, Wl + WL_XQ, nullptr, nullptr}; pg8::SetupOrder<0> S; S.init(bx, 0, 64); pg8::EpiF8 E{ws + WS_MT, D, QSCALE * pg8::F8_MS}; GEMM_STD(pg8::EpiF8, pg8::SetupOrder<0>, 2048, 1024, 256); }
                  { pg8::Gemm g{Wl + WL_XO, KV, nullptr, nullptr}; pg8::SetupOrder<1> S; S.init(bx, 64, 64); pg8::EpiF8 E{ws + WS_NT, D, pg8::F8_NS}; GEMM_STD(pg8::EpiF8, pg8::SetupOrder<1>, 1024, 2048, 256); }
                  { pg8::Gemm g{WB + WB_OUT1, WB + WB_POOL, nullptr, nullptr}; pg8::SetupOrder<2> S; S.init(bx, 128, 16); pg8::EpiF8 E{(unsigned char*)(WB + WB_WEFF), D, pg8::F8_WS}; GEMM_STD(pg8::EpiF8, pg8::SetupOrder<2>, 1024, 256, 256); } }
                phase_swa_sgu(F, RD, INF(6), INF(7), INF(8), WB + WB_SGUW, INF(10), (unsigned char*)RB);
            }
            SEAM(2);
            if (IN(3)) REP(3) { PH
                phase_cvec(F, ws + WS_MT, INF(12), INF(13), WSF(WS_CV));
                pg8::Gemm g{RB, WB + WB_OUT0, nullptr, nullptr};
                pg8::StaticOrder S; S.init(T, D, F.G, bx, D, D);
                pg8::EpiZ E{RC, (unsigned char*)RD, WSF(WS_PART), RA, INF(12), 1.f / (F8_MIXS * pg8::F8_WS)};
                pg8::gemm_phase<pg8::EpiZ, pg8::StaticOrder, true, true, false, D, D, D, true>(glds, F.tid, g, S, E);
            }
            SEAM(3);
        } else {
            if (IN(12)) REP(12) { PH
                pg8::Gemm g{RB, WB + WB_IN1, nullptr, nullptr};
                pg8::StaticOrder S; S.init(T, D, F.G, bx, D, D);
                pg8::EpiBf16 E{RA, D, 1.f / (pg8::F8_XS * pg8::F8_WS)};
                pg8::gemm_phase<pg8::EpiBf16, pg8::StaticOrder, true, true, false, D, D, D, true>(glds, F.tid, g, S, E);
            }
            SEAM(12);
            if (IN(13)) REP(13) { PH
                { bf16_t* Wl = WB + WB_LAYER + WL_SIZE; const bf16_t* KV = (const bf16_t*)(ws + WS_MEMKV) + (size_t)B * MEM * 2048;
                  { pg8::Gemm g{KV, Wl + WL_XQ, nullptr, nullptr}; pg8::SetupOrder<0> S; S.init(bx, 0, 64); pg8::EpiF8 E{ws + WS_MT, D, QSCALE * pg8::F8_MS}; GEMM_STD(pg8::EpiF8, pg8::SetupOrder<0>, 2048, 1024, 256); }
                  { pg8::Gemm g{Wl + WL_XO, KV, nullptr, nullptr}; pg8::SetupOrder<1> S; S.init(bx, 64, 64); pg8::EpiF8 E{ws + WS_NT, D, pg8::F8_NS}; GEMM_STD(pg8::EpiF8, pg8::SetupOrder<1>, 1024, 2048, 256); } }
                phase_pool(F, RA, (unsigned char*)RB);
            }
            SEAM(13);
            if (IN(14)) REP(14) { PH
                phase_cvec(F, ws + WS_MT, INF(28), INF(29), WSF(WS_CV));
                pg8::Gemm g{RB, WB + WB_WEFF, nullptr, nullptr};
                pg8::StaticOrder S; S.init(T, D, F.G, bx, D, D);
                pg8::EpiZ E{RD, (unsigned char*)RA, WSF(WS_PART), RC, INF(28), 1.f / (pg8::F8_XS * pg8::F8_WS)};
                pg8::gemm_phase<pg8::EpiZ, pg8::StaticOrder, true, true, false, D, D, D, true>(glds, F.tid, g, S, E);
            }
            SEAM(14);
        }
        if (IN(cbp + 5)) REP(cbp + 5) { PHC
            pg8::Gemm g{(const bf16_t*)ZG8, (const bf16_t*)(ws + WS_MT), nullptr, nullptr};
            pg8::BatchOrder S; S.init(T, D, F.G, bx, D, D);
            LAS float* stl = (LAS float*)(F.lds + 131072 + 8192); LAS float* cvl = stl + 2048; LAS int* tagl = (LAS int*)(cvl + 2048);
            scores_prepass(F, S, WSF(WS_PART), WSF(WS_CV), 1.f / (pg8::F8_XS * pg8::F8_MS), stl, cvl, tagl);
            pg8::EpiSoftmaxT<true> E{P8, (LAS float*)(F.lds + 131072), (const LAS pg8::f32x2*)stl, (const LAS pg8::f32x2*)cvl, tagl};
            pg8::gemm_phase<pg8::EpiSoftmaxT<true>, pg8::BatchOrder, true, true, false, D, D, D, true>(glds, F.tid, g, S, E);
        }
        SEAM(cbp + 5);
        if (IN(cbp + 6)) REP(cbp + 6) { PHC
            pg8::Gemm g{(const bf16_t*)P8, (const bf16_t*)(ws + WS_NT), nullptr, nullptr};
            pg8::BatchOrder S; S.init(T, D, F.G, bx, D, D);
            pg8::EpiF8 E{(unsigned char*)Y2, D, pg8::F8_YS / (pg8::F8_PS * pg8::F8_NS)};
            pg8::gemm_phase<pg8::EpiF8, pg8::BatchOrder, true, true, false, D, D, D, true>(glds, F.tid, g, S, E);
        }
        SEAM(cbp + 6);
        if (IN(cbp + 7)) REP(cbp + 7) { PHC phase_ln_router(F, Z1, INF(cb), INF(cb + 1), (const unsigned char*)Y2, INF(cb + 5), INF(cb + 6), X2, X2_8, INF(3), INF(4), WSI(WS_EIDX), WSF(WS_EWGT), WSI(WS_BCNT)); }
        SEAM(cbp + 7);
        if (IN(cbp + 8)) REP(cbp + 8) { PHC phase_moe_book(F, WSI(WS_EIDX), WSI(WS_BCNT), WSI(WS_TOK), WSI(WS_POS), WSI(WS_TILE)); }
        SEAM(cbp + 8);
        if (IN(cbp + 9)) REP(cbp + 9) { PHC const int* tile_e = WSI(WS_TILE); const int* tok = WSI(WS_TOK);
            const int ntiles = __builtin_amdgcn_readfirstlane(tile_e[NTILE]);
            pg8::Gemm g{(const bf16_t*)X2_8, WBl + WL_GU, tok, (LAS int*)(F.lds + 131072)};
            pg8::MoeOrder S; S.init(ntiles, tile_e, F.G, bx, D, D);
            pg8::EpiGU8 E{(unsigned char*)HS};
            pg8::gemm_phase<pg8::EpiGU8, pg8::MoeOrder, true, true, true, D, D, D, true>(glds, F.tid, g, S, E);
        }
        SEAM(cbp + 9);
        if (IN(cbp + 10)) REP(cbp + 10) { PHC const int* tile_e = WSI(WS_TILE);
            const int ntiles = __builtin_amdgcn_readfirstlane(tile_e[NTILE]);
            pg8::Gemm g{HS, WBl + WL_DN, nullptr, nullptr};
            pg8::MoeOrder S; S.init(ntiles, tile_e, F.G, bx, DE, DE);
            pg8::EpiF8 E{(unsigned char*)DS, D, pg8::F8_DS / (pg8::F8_HS * pg8::F8_WS)};
            pg8::gemm_phase<pg8::EpiF8, pg8::MoeOrder, true, true, false, DE, DE, DE, true>(glds, F.tid, g, S, E);
        }
        SEAM(cbp + 10);
        if (IN(cbp + 11)) REP(cbp + 11) { PHC phase_ln_moe(F, X2, (const unsigned char*)DS, WSI(WS_POS), WSF(WS_EWGT), INF(cb + 10), INF(cb + 11), X3, L == 1 ? ka->out : nullptr, L == 0 ? (unsigned char*)RB : nullptr); }
        if (L == 0) SEAM(cbp + 11);
    }
#undef GEMM_STD
#undef IN
#undef SEAM
#undef INF
#undef PH
#undef PHC
#undef WSI
#undef WSF
}
}
using namespace nv;
extern "C" void kernel_launch(void* const* d_in, const int* in_sizes, int n_in, void* d_out, int out_size, void* d_ws, size_t ws_size, hipStream_t stream) {
    (void)in_sizes; (void)out_size;
    if (ws_size < WS_END || n_in != 40) return;
    static int grid = 0;
    if (grid == 0) {
        int dev = 0, cus = 0;
        if (hipGetDevice(&dev) != hipSuccess || hipDeviceGetAttribute(&cus, hipDeviceAttributeMultiprocessorCount, dev) != hipSuccess) { grid = -1; return; }
        if (hipFuncSetAttribute((const void*)mk::mega, hipFuncAttributeMaxDynamicSharedMemorySize, mk::LDS_BYTES) != hipSuccess) { grid = -1; return; }
        int per_cu = 0;
        if (hipOccupancyMaxActiveBlocksPerMultiprocessor(&per_cu, (const void*)mk::mega, mk::NTHREADS, mk::LDS_BYTES) != hipSuccess || per_cu < 1) { (void)hipGetLastError(); }
        grid = cus;
    }
    if (grid < 0) return;
    unsigned char* ws = (unsigned char*)d_ws;
    (void)hipMemsetAsync(ws + WS_CTL, 0, mk::CTL_ZERO_BYTES, stream);
    mk::Args a{};
    for (int i = 0; i < 40; ++i) a.in[i] = d_in[i];
    a.out = (float*)d_out; a.ws = ws;
    for (int j = 0; j < 8; ++j) a.inv.f[j] = (float)pow(500000.0, -(double)((float)j * 2.0f / 16.0f));
    a.ph_lo = 0; a.ph_hi = mk::NPHASE;
    hipLaunchKernelGGL(mk::mega, dim3(grid), dim3(mk::NTHREADS), mk::LDS_BYTES, stream, a);
}
```

```cpp
#include <hip/hip_runtime.h>
#include <stdint.h>
#include <math.h>

typedef unsigned short bf16_t;

namespace nv {
constexpr int B = 4, S = 8192, T = B * S, D = 1024;
constexpr int NIN0 = 1792;
constexpr int MEM = 256, XH = 4, XHD = 256;
constexpr int NE = 16, DE = 512;
constexpr int MPAD = 65536 + 16 * 256;
constexpr int NTILE = MPAD / 256;
constexpr float ALPHA = 1.4142135623730951f;
constexpr float LN_EPS = 1e-5f;
constexpr float QSCALE = 0.0625f * 1.4426950408889634f;
constexpr float ASCALE = 0.125f * 1.4426950408889634f;

constexpr size_t MiB = 1u << 20;
constexpr size_t WS_CTL = 0;
constexpr size_t WS_ROPE = 2 * MiB;
constexpr size_t WS_EIDX = 4 * MiB;
constexpr size_t WS_EWGT = 5 * MiB;
constexpr size_t WS_POS = 6 * MiB;
constexpr size_t WS_BCNT = 7 * MiB;
constexpr size_t WS_TILE = 7 * MiB + 65536;
constexpr size_t WS_TOK = 7 * MiB + 131072;
constexpr size_t WS_MEMKV = 8 * MiB;
constexpr size_t WS_TOKE = 16 * MiB;
constexpr size_t WS_MEMB = 20 * MiB;
constexpr size_t WS_WB = 24 * MiB;
constexpr size_t WS_A = 152 * MiB, WS_B = 220 * MiB, WS_C = 288 * MiB, WS_D = 356 * MiB;
constexpr size_t WS_MT = 492 * MiB;
constexpr size_t WS_NT = 500 * MiB;
constexpr size_t WS_CV = 496 * MiB;
constexpr size_t WS_STAT = 497 * MiB;
constexpr size_t WS_PART = 504 * MiB;
constexpr size_t WS_END = 508 * MiB;
constexpr size_t WB_IN0 = 0;
constexpr size_t WB_OUT0 = WB_IN0 + (size_t)1792 * 1024;
constexpr size_t WB_IN1 = WB_OUT0 + (size_t)1024 * 1024;
constexpr size_t WB_POOL = WB_IN1 + (size_t)1024 * 1024;
constexpr size_t WB_OUT1 = WB_POOL + (size_t)1024 * 256;
constexpr size_t WB_WEFF = WB_OUT1 + (size_t)1024 * 1024;
constexpr size_t WB_SGUW = WB_WEFF + (size_t)1024 * 1024;
constexpr size_t WB_LAYER = WB_SGUW + (size_t)8 * 128 * 128;
constexpr size_t WL_XQ = 0;
constexpr size_t WL_XKV = WL_XQ + (size_t)1024 * 1024;
constexpr size_t WL_XO = WL_XKV + (size_t)2048 * 1024;
constexpr size_t WL_GU = WL_XO + (size_t)1024 * 1024;
constexpr size_t WL_DN = WL_GU + (size_t)16 * 1024 * 1024;
constexpr size_t WL_SIZE = WL_DN + (size_t)16 * 1024 * 512;
static_assert((WB_LAYER + 2 * WL_SIZE) * 2 <= 128 * MiB, "bf16 weight region");

__device__ __forceinline__ float bf2f(bf16_t v) { return __uint_as_float((unsigned)v << 16); }
__device__ __forceinline__ bf16_t f2bf(float f) { unsigned u = __float_as_uint(f); return (bf16_t)((u + 0x7fffu + ((u >> 16) & 1u)) >> 16); }
__device__ __forceinline__ float gelu_tanh(float x) { const float u = 0.7978845608028654f * (x + 0.044715f * x * x * x); const float e = __expf(2.f * u); const float th = 1.f - 2.f / (e + 1.f); return 0.5f * x * (1.f + th); }
__device__ __forceinline__ float silu(float x) { return x / (1.f + __expf(-x)); }
template <int M> __device__ __forceinline__ float swz_xor(float v) { return __int_as_float(__builtin_amdgcn_ds_swizzle(__float_as_int(v), (M << 10) | 0x1f)); }
__device__ __forceinline__ float wave_sum(float v) {
    v += swz_xor<1>(v); v += swz_xor<2>(v); v += swz_xor<4>(v); v += swz_xor<8>(v); v += swz_xor<16>(v);
    const auto r = __builtin_amdgcn_permlane32_swap(__float_as_uint(v), __float_as_uint(v), false, false);
    return __uint_as_float(r[0]) + __uint_as_float(r[1]);
}
__device__ __forceinline__ float wave_max(float v) {
    v = fmaxf(v, swz_xor<1>(v)); v = fmaxf(v, swz_xor<2>(v)); v = fmaxf(v, swz_xor<4>(v)); v = fmaxf(v, swz_xor<8>(v)); v = fmaxf(v, swz_xor<16>(v));
    const auto r = __builtin_amdgcn_permlane32_swap(__float_as_uint(v), __float_as_uint(v), false, false);
    return fmaxf(__uint_as_float(r[0]), __uint_as_float(r[1]));
}
}

namespace pg8 {
#define PG8_LAS __attribute__((address_space(3)))
typedef short bf16x8 __attribute__((ext_vector_type(8)));
typedef float f32x4 __attribute__((ext_vector_type(4)));
typedef float f32x2 __attribute__((ext_vector_type(2)));
typedef unsigned u32x4 __attribute__((ext_vector_type(4)));
typedef unsigned u32x2 __attribute__((ext_vector_type(2)));
typedef int i32x8 __attribute__((ext_vector_type(8)));
constexpr int BM = 256, BK = 64, HALF = 128, HTB = HALF * BK * 2  , STAGE_BYTES = 8 * HTB, NXCD = 8, WGM = 8;

__host__ __device__ __forceinline__ int lds_byte(int r, int c) { const int st = (r >> 4) * 2 + (c >> 5), rr = r & 15, cc = c & 31, ob = rr * 64 + cc * 2; return st * 1024 + (ob ^ (((ob >> 9) & 1) << 5)); }
__host__ __device__ __forceinline__ void stage_rc(int b, int& R, int& C) { const int st = b / 1024, sb = b % 1024, swz = sb ^ (((sb >> 9) & 1) << 5); R = (st >> 1) * 16 + swz / 64; C = (st & 1) * 32 + (swz % 64) / 2; }
__host__ __device__ __forceinline__ int perm32(int rho) { const int n = rho >> 4, i = rho & 15; return 8 * (i >> 2) + 4 * n + (i & 3); }

struct Unit { int pm, pn, ao, bo; };
struct Gemm { const bf16_t* A; const bf16_t* Bt; const int* arow; PG8_LAS int* ltab; const PG8_LAS int* offl; };

template <bool BATCHED = false>
struct StaticOrderT {
    int nM, nN, nwg, G, c, lda, ldb, apn;
    __device__ void init(int M, int N, int G_, int c_, int lda_, int ldb_, int apn_ = 0) { nM = M / BM; nN = N / BM; nwg = nM * nN; G = G_; c = c_; lda = lda_; ldb = ldb_; apn = apn_; }
    __device__ bool next(int i, Unit& u) const {
        const long L = (long)i * G + c; if (L >= nwg) return false;
        int wgid = (int)L; { const int q = nwg / NXCD, r = nwg % NXCD, xcd = wgid % NXCD, off = wgid / NXCD; wgid = (xcd < r ? xcd * (q + 1) : r * (q + 1) + (xcd - r) * q) + off; }
        const int nig = WGM * nN, gid = wgid / nig, fm = gid * WGM, gsz = (nM - fm) < WGM ? (nM - fm) : WGM;
        u.pm = fm + ((wgid % nig) % gsz); u.pn = (wgid % nig) / gsz;
        u.ao = u.pm * BM * lda + u.pn * apn; u.bo = (BATCHED ? ((u.pm >> 5) * 4 + u.pn) : u.pn) * BM * ldb; return true;
    }
};
typedef StaticOrderT<false> StaticOrder;
typedef StaticOrderT<true> BatchOrder;
struct MoeOrder {
    int nM, nwg, G, c, lda, ldb; const PG8_LAS int* tile_e;
    __device__ void init(int ntiles, const PG8_LAS int* te, int G_, int c_, int lda_, int ldb_) { nM = ntiles; nwg = nM * 4; G = G_; c = c_; tile_e = te; lda = lda_; ldb = ldb_; }
    __device__ bool next(int i, Unit& u) const {
        const long L = (long)i * G + c; if (L >= nwg) return false;
        int wgid = (int)L; { const int q = nwg / NXCD, r = nwg % NXCD, xcd = wgid % NXCD, off = wgid / NXCD; wgid = (xcd < r ? xcd * (q + 1) : r * (q + 1) + (xcd - r) * q) + off; }
        const int nig = WGM * 4, gid = wgid / nig, fm = gid * WGM, gsz = (nM - fm) < WGM ? (nM - fm) : WGM;
        u.pm = fm + ((wgid % nig) % gsz); u.pn = (wgid % nig) / gsz;
        const int e = __builtin_amdgcn_readfirstlane(tile_e[u.pm]); u.ao = u.pm * BM * lda; u.bo = (e * 4 + u.pn) * BM * ldb; return true;
    }
};
template <int KIND>
struct SetupOrder {
    int idx, n;
    __device__ void init(int c, int c0, int n_) { idx = c - c0; n = n_; }
    __device__ bool next(int i, Unit& u) const {
        if (i != 0 || idx < 0 || idx >= n) return false;
        const int x = idx >> 4, y = (idx >> 2) & 3, z = idx & 3;
        if (KIND == 0) { u.pm = x * 4 + y; u.pn = z; u.ao = (x * 256) * 2048 + y * 256; u.bo = z * 256 * 1024 + y * 256; }
        if (KIND == 1) { u.pm = x * 4 + y; u.pn = z; u.ao = y * 256 * 1024 + z * 256; u.bo = (x * 256) * 2048 + 1024 + z * 256; }
        if (KIND == 2) { u.pm = y; u.pn = z; u.ao = y * 256 * 1024 + z * 256; u.bo = z * 256 * 256; }
        return true;
    }
};

__device__ __forceinline__ int fresh_lane() { unsigned m = ~0u; asm volatile("" : "+s"(m)); return (int)__builtin_amdgcn_mbcnt_hi(m, __builtin_amdgcn_mbcnt_lo(m, 0u)); }
__device__ __forceinline__ unsigned cvt_pk_bf16(float lo, float hi) { unsigned r; asm volatile("v_cvt_pk_bf16_f32 %0, %1, %2" : "=v"(r) : "v"(lo), "v"(hi)); return r; }


template <class E, class = void> struct epi_contig { static constexpr bool value = false; };
template <class E> struct epi_contig<E, decltype((void)E::CONTIG)> { static constexpr bool value = E::CONTIG; };
template <class Epi, class Sched, bool ALIGN_EPI, bool SP2, bool GATHER, int LDA, int LDB, int KK, bool FP8 = false>
__device__ __forceinline__ void gemm_phase(PG8_LAS unsigned char* lds, int tid_in, const Gemm g, const Sched& S, const Epi& E) {
    int tid_ = tid_in; asm volatile("" : "+v"(tid_));
    const int tid = tid_, wid = __builtin_amdgcn_readfirstlane(tid >> 6), lane = tid & 63, wr = wid >> 2, wc = wid & 3, fr = lane & 15, fq = lane >> 4;
    constexpr int ELT = FP8 ? 1 : 2, K = KK, nt = K * ELT / (BK * 2), lda = LDA * ELT, ldb = LDB * ELT; (void)K;
    unsigned voffA[2], voffB[2];
#pragma unroll
    for (int i = 0; i < 2; ++i) { int R, C; stage_rc(tid * 16 + i * 8192, R, C); const int Rb = epi_contig<Epi>::value ? ((R >> 5) * 64 + perm32(R & 31)) : Epi::PERM ? ((R & ~31) + perm32(R & 31)) : R;
        voffA[i] = GATHER ? (unsigned)C * 2u : (unsigned)(R * lda + C * 2); voffB[i] = (unsigned)(Rb * ldb + C * 2); }
    const size_t kstep = (size_t)(BK * 2);
    const size_t hstepA = GATHER ? 0 : (size_t)HALF * lda, hstepB = (size_t)(epi_contig<Epi>::value ? 32 : HALF) * ldb;
    const unsigned ldsw = (unsigned)wid * 1024u, ldsbase = (unsigned)(size_t)lds;
    const int aoff = lds_byte(wr * 64 + fr, fq * 8), boff = lds_byte(wc * 32 + fr, fq * 8);
    const PG8_LAS unsigned char* ldsA = lds + aoff; const PG8_LAS unsigned char* ldsB = lds + 4 * HTB + boff; asm volatile("" : "+v"(ldsA), "+v"(ldsB));
    unsigned cg[2][2];
#define PG8_SA(b, h) (((b) * 2 + (h)) * HTB)
#define PG8_SB(b, h) ((4 + (b) * 2 + (h)) * HTB)
#define PG8_GLDS(sbase, voff32, ldsaddr) asm volatile("s_mov_b32 m0, %2\n\ts_nop 0\n\tglobal_load_lds_dwordx4 %0, %1" :: "v"(voff32), "s"(sbase), "s"(ldsaddr) : "memory", "m0")
#define PG8_STAGE(bufoff, gbase, voff) do { const char* _sb = (const char*)(gbase); _Pragma("unroll") for (int _i = 0; _i < 2; ++_i) \
        PG8_GLDS(_sb + (size_t)_i * (epi_contig<Epi>::value ? 128 : 64) * ldb, (voff)[0], (unsigned)(ldsbase + (bufoff) + ldsw + _i * 8192)); } while (0)
#define PG8_STAGE_A(bufoff, abase, h, GO) do { const char* _sb = GATHER ? (const char*)(abase) : (const char*)(abase) + ((h) ? hstepA : (size_t)0); _Pragma("unroll") for (int _i = 0; _i < 2; ++_i) { \
        if constexpr (GATHER) PG8_GLDS(_sb, GO[h][_i], (unsigned)(ldsbase + (bufoff) + ldsw + _i * 8192)); \
        else PG8_GLDS(_sb + (size_t)_i * 64 * lda, voffA[0], (unsigned)(ldsbase + (bufoff) + ldsw + _i * 8192)); } } while (0)
#define PG8_GLOAD(dst, pm_) do { const int _t = wid * 64 + fresh_lane(); int rowA_[2]; unsigned colA_[2]; _Pragma("unroll") for (int _i = 0; _i < 2; ++_i) { int _R, _C; stage_rc(_t * 16 + _i * 8192, _R, _C); rowA_[_i] = _R; colA_[_i] = (unsigned)_C * 2u; }   \
        _Pragma("unroll") for (int _h = 0; _h < 2; ++_h) _Pragma("unroll") for (int _i = 0; _i < 2; ++_i) \
        dst[_h][_i] = (unsigned)g.ltab[(pm_) * BM + _h * HALF + rowA_[_i]] * (unsigned)lda + colA_[_i]; } while (0)
#define PG8_GSWITCH do { if constexpr (GATHER) { if (last && has_next) { PG8_GLOAD(cg, ui + 1); } } } while (0)
#define PG8_LDA(dst, b, h) do { _Pragma("unroll") for (int m = 0; m < 4; ++m) { if constexpr (FP8) { typedef int i32x4_ __attribute__((ext_vector_type(4))); \
        dst##8[m] = __builtin_shufflevector(*(const PG8_LAS i32x4_*)(ldsA + PG8_SA(b, h) + m * 2048), *(const PG8_LAS i32x4_*)(ldsA + PG8_SA(b, h) + m * 2048 + 1024), 0, 1, 2, 3, 4, 5, 6, 7); } \
        else { _Pragma("unroll") for (int k = 0; k < 2; ++k) dst[m][k] = *(const PG8_LAS bf16x8*)(ldsA + PG8_SA(b, h) + m * 2048 + k * 1024); } } } while (0)
#define PG8_LDB(dst, b, h) do { _Pragma("unroll") for (int n = 0; n < 2; ++n) { if constexpr (FP8) { typedef int i32x4_ __attribute__((ext_vector_type(4))); \
        dst##8[n] = __builtin_shufflevector(*(const PG8_LAS i32x4_*)(ldsB + PG8_SA(b, h) + n * 2048), *(const PG8_LAS i32x4_*)(ldsB + PG8_SA(b, h) + n * 2048 + 1024), 0, 1, 2, 3, 4, 5, 6, 7); } \
        else { _Pragma("unroll") for (int k = 0; k < 2; ++k) dst[n][k] = *(const PG8_LAS bf16x8*)(ldsB + PG8_SA(b, h) + n * 2048 + k * 1024); } } } while (0)
#define PG8_MMA(ai, bj, At, Bt) do { __builtin_amdgcn_s_setprio(1); _Pragma("unroll") for (int m = 0; m < 4; ++m) _Pragma("unroll") for (int n = 0; n < 2; ++n) { \
        if constexpr (FP8) acc[ai][bj][m][n] = __builtin_amdgcn_mfma_scale_f32_16x16x128_f8f6f4(Bt##8[n], At##8[m], acc[ai][bj][m][n], 0, 0, 0, 0x7f7f7f7f, 0, 0x7f7f7f7f); \
        else { _Pragma("unroll") for (int k = 0; k < 2; ++k) acc[ai][bj][m][n] = __builtin_amdgcn_mfma_f32_16x16x32_bf16(Bt[n][k], At[m][k], acc[ai][bj][m][n], 0, 0, 0); } } \
        __builtin_amdgcn_s_setprio(0); } while (0)
#define PG8_WAIT_V(n) asm volatile("s_waitcnt vmcnt(" #n ")" ::: "memory")
#define PG8_WAIT_L(n) asm volatile("s_waitcnt lgkmcnt(" #n ")" ::: "memory")
#define PG8_BAR __builtin_amdgcn_s_barrier()
#define PG8_SCHED __builtin_amdgcn_sched_barrier(0)
    Unit cur, nxt; int ui = 0;
    if (!S.next(0, cur)) return;
    f32x4 acc[2][2][4][2];
#pragma unroll
    for (int a = 0; a < 2; ++a)
#pragma unroll
        for (int b = 0; b < 2; ++b)
#pragma unroll
            for (int m = 0; m < 4; ++m)
#pragma unroll
                for (int n = 0; n < 2; ++n) acc[a][b][m][n] = (f32x4){0.f, 0.f, 0.f, 0.f};
    bf16x8 At[4][2], B0[2][2], B1[2][2]; i32x8 At8[4], B08[2], B18[2];
    const char* cA = GATHER ? (const char*)g.A : (const char*)g.A + (size_t)cur.ao * ELT; const char* cB = (const char*)g.Bt + (size_t)cur.bo * ELT;
    if constexpr (GATHER) {
        for (int i = 0; i < 8; ++i) { Unit u_; if (!S.next(i, u_)) break; if (tid < BM) { const int e_ = S.tile_e[u_.pm], rk_ = u_.pm * BM + tid - g.offl[e_]; g.ltab[i * BM + tid] = rk_ < g.offl[32 + e_] ? g.arow[e_ * 32768 + rk_] : 0; } }
        asm volatile("s_waitcnt vmcnt(0) lgkmcnt(0)" ::: "memory"); PG8_BAR; asm volatile("" ::: "memory");
        PG8_GLOAD(cg, 0); }
    if constexpr (SP2) {
        PG8_STAGE(PG8_SB(0, 0), cB, voffB); PG8_STAGE(PG8_SB(0, 1), cB + hstepB, voffB); PG8_STAGE_A(PG8_SA(0, 0), cA, 0, cg); PG8_STAGE_A(PG8_SA(0, 1), cA, 1, cg);
        if (wr == 1) PG8_BAR;
        PG8_WAIT_V(2); PG8_BAR;
        PG8_STAGE(PG8_SB(1, 0), cB + kstep, voffB); PG8_STAGE_A(PG8_SA(1, 0), cA + kstep, 0, cg); PG8_STAGE(PG8_SB(1, 1), cB + hstepB + kstep, voffB);
        PG8_WAIT_V(6); PG8_BAR;
    } else {
        PG8_STAGE(PG8_SB(0, 0), cB, voffB); PG8_STAGE_A(PG8_SA(0, 0), cA, 0, cg); PG8_STAGE(PG8_SB(0, 1), cB + hstepB, voffB); PG8_STAGE_A(PG8_SA(0, 1), cA, 1, cg);
        if (wr == 1) PG8_BAR;
        PG8_WAIT_V(4); PG8_BAR;
        PG8_STAGE(PG8_SB(1, 0), cB + kstep, voffB); PG8_STAGE_A(PG8_SA(1, 0), cA + kstep, 0, cg); PG8_STAGE(PG8_SB(1, 1), cB + hstepB + kstep, voffB);
        PG8_WAIT_V(6); PG8_BAR;
    }
    for (;;) {
        const bool has_next = S.next(ui + 1, nxt);
        const char* nA = GATHER ? (const char*)g.A : (has_next ? (const char*)g.A + (size_t)nxt.ao * ELT : cA);
        const char* nB = has_next ? (const char*)g.Bt + (size_t)nxt.bo * ELT : cB;
#pragma unroll 1
        for (int t = 0; t < nt; t += 2) {
            const bool last = (t == nt - 2);
            const char* a1 = cA + (size_t)(t + 1) * kstep;
            const char* a2 = last ? nA : cA + (size_t)(t + 2) * kstep; const char* b2 = last ? nB : cB + (size_t)(t + 2) * kstep;
            const char* a3 = a2 + kstep; const char* b3 = b2 + kstep;
            if constexpr (SP2) {
            PG8_LDB(B0, 0, 0); PG8_LDB(B1, 0, 1); PG8_SCHED; PG8_LDA(At, 0, 0); PG8_STAGE_A(PG8_SA(1, 1), a1, 1, cg); PG8_GSWITCH;
            PG8_WAIT_V(8); PG8_WAIT_L(0); PG8_BAR; PG8_MMA(0, 0, At, B0); PG8_MMA(0, 1, At, B1); PG8_BAR; PG8_SCHED;
            PG8_LDA(At, 0, 1); PG8_STAGE(PG8_SB(0, 0), b2, voffB); PG8_STAGE(PG8_SB(0, 1), b2 + hstepB, voffB); PG8_STAGE_A(PG8_SA(0, 0), a2, 0, cg);
            PG8_WAIT_V(8); PG8_WAIT_L(0); PG8_BAR; PG8_MMA(1, 0, At, B0); PG8_MMA(1, 1, At, B1); PG8_BAR; PG8_SCHED;
            PG8_LDB(B0, 1, 0); PG8_LDB(B1, 1, 1); PG8_SCHED; PG8_LDA(At, 1, 0); PG8_STAGE_A(PG8_SA(0, 1), a2, 1, cg);
            PG8_WAIT_V(8); PG8_WAIT_L(0); PG8_BAR; PG8_MMA(0, 0, At, B0); PG8_MMA(0, 1, At, B1); PG8_BAR; PG8_SCHED;
            PG8_LDA(At, 1, 1); PG8_STAGE(PG8_SB(1, 0), b3, voffB); PG8_STAGE(PG8_SB(1, 1), b3 + hstepB, voffB); PG8_STAGE_A(PG8_SA(1, 0), a3, 0, cg);
            PG8_WAIT_V(8); PG8_WAIT_L(0); PG8_BAR; PG8_MMA(1, 0, At, B0); PG8_MMA(1, 1, At, B1); PG8_BAR; PG8_SCHED;
            } else {
            PG8_LDB(B0, 0, 0); PG8_SCHED; PG8_LDA(At, 0, 0); PG8_STAGE_A(PG8_SA(1, 1), a1, 1, cg); PG8_GSWITCH;
            PG8_WAIT_L(8); PG8_BAR; PG8_WAIT_L(0); PG8_MMA(0, 0, At, B0); PG8_BAR; PG8_SCHED;
            PG8_LDB(B1, 0, 1); PG8_STAGE(PG8_SB(0, 0), b2, voffB);
            PG8_BAR; PG8_WAIT_L(0); PG8_MMA(0, 1, At, B1); PG8_BAR;
            PG8_LDA(At, 0, 1); PG8_STAGE_A(PG8_SA(0, 0), a2, 0, cg);
            PG8_BAR; PG8_WAIT_L(0); PG8_MMA(1, 0, At, B0); PG8_BAR; PG8_SCHED;
            PG8_STAGE(PG8_SB(0, 1), b2 + hstepB, voffB);
            PG8_WAIT_V(6); PG8_BAR; PG8_MMA(1, 1, At, B1); PG8_BAR;
            PG8_LDB(B0, 1, 0); PG8_SCHED; PG8_LDA(At, 1, 0); PG8_STAGE_A(PG8_SA(0, 1), a2, 1, cg);
            PG8_WAIT_L(8); PG8_BAR; PG8_WAIT_L(0); PG8_MMA(0, 0, At, B0); PG8_BAR; PG8_SCHED;
            PG8_LDB(B1, 1, 1); PG8_STAGE(PG8_SB(1, 0), b3, voffB);
            PG8_BAR; PG8_WAIT_L(0); PG8_MMA(0, 1, At, B1); PG8_BAR;
            PG8_LDA(At, 1, 1); PG8_STAGE_A(PG8_SA(1, 0), a3, 0, cg);
            PG8_BAR; PG8_WAIT_L(0); PG8_MMA(1, 0, At, B0); PG8_BAR; PG8_SCHED;
            PG8_STAGE(PG8_SB(1, 1), b3 + hstepB, voffB);
            PG8_WAIT_V(6); PG8_BAR; PG8_MMA(1, 1, At, B1); PG8_BAR;
            }
        }
        if constexpr (ALIGN_EPI) { if (wr == 0) PG8_BAR; }
        { const int _l = fresh_lane(); E(acc, cur, wr, wc, _l & 15, _l >> 4); }
        if (!has_next) break;
#pragma unroll
        for (int a = 0; a < 2; ++a)
#pragma unroll
            for (int b = 0; b < 2; ++b)
#pragma unroll
                for (int m = 0; m < 4; ++m)
#pragma unroll
                    for (int n = 0; n < 2; ++n) acc[a][b][m][n] = (f32x4){0.f, 0.f, 0.f, 0.f};
        cur = nxt; cA = nA; cB = nB; ++ui;
        if constexpr (ALIGN_EPI) { if (wr == 1) PG8_BAR; }
    }
    PG8_WAIT_V(0);
    if constexpr (!ALIGN_EPI) { if (wr == 0) PG8_BAR; }
    PG8_BAR;
#undef PG8_SA
#undef PG8_SB
#undef PG8_STAGE
#undef PG8_GLDS
#undef PG8_STAGE_A
#undef PG8_GLOAD
#undef PG8_GSWITCH
#undef PG8_LDA
#undef PG8_LDB
#undef PG8_MMA
#undef PG8_WAIT_V
#undef PG8_WAIT_L
#undef PG8_BAR
#undef PG8_SCHED
}
}
namespace pg8 {

__device__ __forceinline__ float fast_sigmoid_mul(float x, float z) { return x * __builtin_amdgcn_rcpf(1.f + __builtin_amdgcn_exp2f(-1.4426950408889634f * z)); }
__device__ __forceinline__ float gelu_t(float x) { const float u = 0.7978845608028654f * (x + 0.044715f * x * x * x); return fast_sigmoid_mul(x, 2.f * u); }
__device__ __forceinline__ float silu_f(float x) { return fast_sigmoid_mul(x, x); }
__device__ __forceinline__ u32x4 pack8(const f32x4 v0, const f32x4 v1) { u32x4 w; w.x = cvt_pk_bf16(v0[0], v0[1]); w.y = cvt_pk_bf16(v0[2], v0[3]); w.z = cvt_pk_bf16(v1[0], v1[1]); w.w = cvt_pk_bf16(v1[2], v1[3]); return w; }

struct EpiBf16 {
    static constexpr bool PERM = true, CONTIG = true;
    bf16_t* O; int ldo; float scale;
    __device__ __forceinline__ void operator()(f32x4 (&acc)[2][2][4][2], const Unit& u, int wr, int wc, int fr, int fq) const {
        const int row0 = u.pm * BM + wr * 64 + fr, col0 = u.pn * BM + wc * 64 + 8 * fq;
#pragma unroll
        for (int ai = 0; ai < 2; ++ai)
#pragma unroll
            for (int m = 0; m < 4; ++m) { bf16_t* rowp = O + (size_t)(row0 + ai * HALF + m * 16) * ldo + col0;
#pragma unroll
                for (int bj = 0; bj < 2; ++bj) *(u32x4*)(rowp + bj * 32) = pack8(acc[ai][bj][m][0] * scale, acc[ai][bj][m][1] * scale); }
    }
};
__device__ __forceinline__ unsigned pk4_fp8(float a, float b, float c, float d) {
    a = __builtin_amdgcn_fmed3f(a, -448.f, 448.f); b = __builtin_amdgcn_fmed3f(b, -448.f, 448.f); c = __builtin_amdgcn_fmed3f(c, -448.f, 448.f); d = __builtin_amdgcn_fmed3f(d, -448.f, 448.f);
    unsigned p; asm volatile("" : "=v"(p));
    p = (unsigned)__builtin_amdgcn_cvt_pk_fp8_f32(a, b, (int)p, false); p = (unsigned)__builtin_amdgcn_cvt_pk_fp8_f32(c, d, (int)p, true); return p;
}
__device__ __forceinline__ unsigned pk4_fp8_nc(float a, float b, float c, float d) {
    unsigned p; asm volatile("" : "=v"(p));
    p = (unsigned)__builtin_amdgcn_cvt_pk_fp8_f32(a, b, (int)p, false); p = (unsigned)__builtin_amdgcn_cvt_pk_fp8_f32(c, d, (int)p, true); return p;
}
__device__ __forceinline__ u32x4 widen16(const u32x2 a, const u32x2 b) {
    const auto r0 = __builtin_amdgcn_permlane16_swap(a.x, b.x, false, false), r1 = __builtin_amdgcn_permlane16_swap(a.y, b.y, false, false);
    u32x4 v; v.x = r0[0]; v.y = r1[0]; v.z = r0[1]; v.w = r1[1]; return v;
}
constexpr float F8_XS = 16.f, F8_WS = 64.f, F8_HS = 8.f;
struct EpiF8 {
    static constexpr bool PERM = true;
    unsigned char* O; int ldo; float scale;
    __device__ __forceinline__ void operator()(f32x4 (&acc)[2][2][4][2], const Unit& u, int wr, int wc, int fr, int fq) const {
        const int row0 = u.pm * BM + wr * 64 + fr, col0 = u.pn * BM + wc * 32 + 8 * fq;
#pragma unroll
        for (int ai = 0; ai < 2; ++ai)
#pragma unroll
            for (int m = 0; m < 4; ++m) { unsigned char* rowp = O + (size_t)(row0 + ai * HALF + m * 16) * ldo + col0; u32x2 w[2];
#pragma unroll
                for (int bj = 0; bj < 2; ++bj) { const f32x4 v0 = acc[ai][bj][m][0] * scale, v1 = acc[ai][bj][m][1] * scale;
                    w[bj].x = pk4_fp8(v0[0], v0[1], v0[2], v0[3]); w[bj].y = pk4_fp8(v1[0], v1[1], v1[2], v1[3]); }
                *(u32x4*)(rowp + ((fq & 1) ? HALF - 8 : 0)) = widen16(w[0], w[1]); }
    }
};
struct EpiF8C {
    static constexpr bool PERM = true, CONTIG = true;
    unsigned char* O; int ldo; float scale;
    __device__ __forceinline__ void operator()(f32x4 (&acc)[2][2][4][2], const Unit& u, int wr, int wc, int fr, int fq) const {
        const int row0 = u.pm * BM + wr * 64 + fr, col0 = u.pn * BM + wc * 64 + 8 * fq;
#pragma unroll
        for (int ai = 0; ai < 2; ++ai)
#pragma unroll
            for (int m = 0; m < 4; ++m) { unsigned char* rowp = O + (size_t)(row0 + ai * HALF + m * 16) * ldo + col0; u32x2 w[2];
#pragma unroll
                for (int bj = 0; bj < 2; ++bj) { const f32x4 v0 = acc[ai][bj][m][0] * scale, v1 = acc[ai][bj][m][1] * scale;
                    w[bj].x = pk4_fp8(v0[0], v0[1], v0[2], v0[3]); w[bj].y = pk4_fp8(v1[0], v1[1], v1[2], v1[3]); }
                *(u32x4*)(rowp + ((fq & 1) ? 32 - 8 : 0)) = widen16(w[0], w[1]); }
    }
};
constexpr float F8_MS = 64.f, F8_PS = 256.f, F8_NS = 16.f, F8_DS = 32.f, F8_YS = 256.f;
struct EpiGU8 {
    static constexpr bool PERM = true;
    unsigned char* HS8;
    __device__ __forceinline__ void operator()(f32x4 (&acc)[2][2][4][2], const Unit& u, int wr, int wc, int fr, int fq) const {
        const int row0 = u.pm * BM + wr * 64 + fr, col0 = u.pn * HALF + wc * 32 + 8 * fq;
        constexpr float s = 1.f / (F8_XS * F8_WS);
#pragma unroll
        for (int ai = 0; ai < 2; ++ai) { u32x2 wq[4];
#pragma unroll
            for (int m = 0; m < 4; ++m) {
                f32x4 h[2];
#pragma unroll
                for (int n = 0; n < 2; ++n) { const f32x4 g = acc[ai][0][m][n], up = acc[ai][1][m][n];
                    const f32x4 t = g * (-s * 1.4426950408889634f); f32x4 d;
#pragma unroll
                    for (int j = 0; j < 4; ++j) d[j] = __builtin_amdgcn_exp2f(t[j]);
                    d = d + 1.f; f32x4 r;
#pragma unroll
                    for (int j = 0; j < 4; ++j) r[j] = __builtin_amdgcn_rcpf(d[j]);
                    h[n] = ((g * up) * (s * s * F8_HS)) * r; }
                wq[m].x = pk4_fp8(h[0][0], h[0][1], h[0][2], h[0][3]); wq[m].y = pk4_fp8(h[1][0], h[1][1], h[1][2], h[1][3]); }
#pragma unroll
            for (int m = 0; m < 4; m += 2) {
                unsigned char* p16 = HS8 + (size_t)(row0 + ai * HALF + (m + (fq & 1)) * 16) * nv::DE + col0 - ((fq & 1) ? 8 : 0);
                *(u32x4*)p16 = widen16(wq[m], wq[m + 1]); } }
    }
};
template <bool OUT8>
struct EpiSoftmaxT {
    static constexpr bool PERM = true, CONTIG = true;
    void* O; PG8_LAS float* tbl;
    const PG8_LAS f32x2* st; const PG8_LAS f32x2* cv; const PG8_LAS int* tag;
    __device__ __forceinline__ void operator()(f32x4 (&acc)[2][2][4][2], const Unit& u, int wr, int wc, int fr, int fq) const {
        const int row0 = u.pm * BM + wr * 64 + fr, col0 = u.pn * BM + wc * 64 + 8 * fq;
        int slot = 0; { const int key = u.pm * 4 + u.pn;
#pragma unroll
            for (int i = 1; i < 4; ++i) if (tag[i] == key) slot = i; }
        slot = __builtin_amdgcn_readfirstlane(slot);
#pragma unroll
        for (int bj = 0; bj < 2; ++bj) {
            f32x4 c1[2], c0[2];
            { const PG8_LAS f32x4* cp = (const PG8_LAS f32x4*)(cv + slot * 256 + wc * 64 + bj * 32 + 8 * fq);
#pragma unroll
              for (int n = 0; n < 2; ++n) { const f32x4 lo = cp[2 * n], hi = cp[2 * n + 1]; c1[n] = (f32x4){lo[0], lo[2], hi[0], hi[2]}; c0[n] = (f32x4){lo[1], lo[3], hi[1], hi[3]}; } }
#pragma unroll
            for (int ai = 0; ai < 2; ++ai)
#pragma unroll
                for (int m = 0; m < 4; ++m) { const f32x2 ac = st[slot * 256 + ai * HALF + wr * 64 + m * 16 + fr];
#pragma unroll
                    for (int n = 0; n < 2; ++n) { acc[ai][bj][m][n] = acc[ai][bj][m][n] * ac[0] + (c1[n] * ac[1] + c0[n]); asm volatile("" : "+v"(acc[ai][bj][m][n])); } }
        }
#pragma unroll
        for (int ai = 0; ai < 2; ++ai)
#pragma unroll
            for (int m = 0; m < 4; ++m) { float mx = -INFINITY;
#pragma unroll
                for (int bj = 0; bj < 2; ++bj)
#pragma unroll
                    for (int n = 0; n < 2; ++n)
#pragma unroll
                        for (int j = 0; j < 4; ++j) mx = fmaxf(mx, acc[ai][bj][m][n][j]);
                mx = fmaxf(mx, nv::swz_xor<16>(mx));
                { const auto r = __builtin_amdgcn_permlane32_swap(__float_as_uint(mx), __float_as_uint(mx), false, false); mx = fmaxf(__uint_as_float(r[0]), __uint_as_float(r[1])); }
                if (fq == 0) tbl[(ai * HALF + wr * 64 + m * 16 + fr) * 4 + wc] = mx; }
        asm volatile("s_waitcnt lgkmcnt(0)" ::: "memory"); __builtin_amdgcn_s_barrier(); asm volatile("" ::: "memory");
#pragma unroll
        for (int ai = 0; ai < 2; ++ai)
#pragma unroll
            for (int m = 0; m < 4; ++m) { const f32x4 t4 = *(const PG8_LAS f32x4*)(tbl + (ai * HALF + wr * 64 + m * 16 + fr) * 4);
                const float M = fmaxf(fmaxf(t4[0], t4[1]), fmaxf(t4[2], t4[3])); f32x4 sv = (f32x4){0.f, 0.f, 0.f, 0.f};
#pragma unroll
                for (int bj = 0; bj < 2; ++bj)
#pragma unroll
                    for (int n = 0; n < 2; ++n) { const f32x4 d = acc[ai][bj][m][n] - M; f32x4 p;
#pragma unroll
                        for (int j = 0; j < 4; ++j) p[j] = __builtin_amdgcn_exp2f(d[j]);
                        acc[ai][bj][m][n] = p; sv = sv + p; }
                float s = (sv[0] + sv[1]) + (sv[2] + sv[3]);
                s += nv::swz_xor<16>(s);
                { const auto r = __builtin_amdgcn_permlane32_swap(__float_as_uint(s), __float_as_uint(s), false, false); s = __uint_as_float(r[0]) + __uint_as_float(r[1]); }
                if (fq == 0) tbl[1024 + (ai * HALF + wr * 64 + m * 16 + fr) * 4 + wc] = s; }
        asm volatile("s_waitcnt lgkmcnt(0)" ::: "memory"); __builtin_amdgcn_s_barrier(); asm volatile("" ::: "memory");
#pragma unroll
        for (int ai = 0; ai < 2; ++ai)
#pragma unroll
            for (int m = 0; m < 4; ++m) { const f32x4 t4 = *(const PG8_LAS f32x4*)(tbl + 1024 + (ai * HALF + wr * 64 + m * 16 + fr) * 4);
                const float inv = 1.f / ((t4[0] + t4[1]) + (t4[2] + t4[3]));
                if constexpr (OUT8) { unsigned char* rowp = (unsigned char*)O + (size_t)(row0 + ai * HALF + m * 16) * nv::D + col0; const float s8 = inv * F8_PS;
                    u32x2 w[2];
#pragma unroll
                    for (int bj = 0; bj < 2; ++bj) { const f32x4 v0 = acc[ai][bj][m][0] * s8, v1 = acc[ai][bj][m][1] * s8;
                        w[bj].x = pk4_fp8_nc(v0[0], v0[1], v0[2], v0[3]); w[bj].y = pk4_fp8_nc(v1[0], v1[1], v1[2], v1[3]); }
                    *(u32x4*)(rowp + ((fq & 1) ? 32 - 8 : 0)) = widen16(w[0], w[1]); }
                else { bf16_t* rowp = (bf16_t*)O + (size_t)(row0 + ai * HALF + m * 16) * nv::D + col0;
#pragma unroll
                    for (int bj = 0; bj < 2; ++bj) *(u32x4*)(rowp + bj * 32) = pack8(acc[ai][bj][m][0] * inv, acc[ai][bj][m][1] * inv); } }
    }
};
template <bool RF32>
struct EpiZT {
    static constexpr bool PERM = true, CONTIG = true;
    bf16_t* Z; unsigned char* ZG8; float* PART; const void* R; const float* g; float scale;
    __device__ __forceinline__ void operator()(f32x4 (&acc)[2][2][4][2], const Unit& u, int wr, int wc, int fr, int fq) const {
        const int row0 = u.pm * BM + wr * 64 + fr, col0 = u.pn * BM + wc * 64 + 8 * fq;
        f32x4 gv[2][2];
#pragma unroll
        for (int bj = 0; bj < 2; ++bj)
#pragma unroll
            for (int n = 0; n < 2; ++n) gv[bj][n] = *(const f32x4*)(g + col0 + bj * 32 + 4 * n) * F8_XS;
        u32x4 rr[8][2]; f32x4 rf[8][2][2]; float ps[4], pq[4]; (void)rr; (void)rf;
#define EPIZ_LOAD(r_) do { _Pragma("unroll") for (int bj = 0; bj < 2; ++bj) { const size_t o_ = (size_t)(row0 + ((r_) >> 2) * HALF + ((r_) & 3) * 16) * nv::D + col0 + bj * 32; \
        if constexpr (RF32) { rf[r_][bj][0] = __builtin_nontemporal_load((const f32x4*)((const float*)R + o_)); rf[r_][bj][1] = __builtin_nontemporal_load((const f32x4*)((const float*)R + o_ + 4)); } \
        else rr[r_][bj] = *(const u32x4*)((const bf16_t*)R + o_); } } while (0)
#pragma unroll
        for (int r = 0; r < 2; ++r) EPIZ_LOAD(r);
#pragma unroll
        for (int r = 0; r < 8; ++r) { const int ai = r >> 2, m = r & 3;
            asm volatile("" ::: "memory");
            { const size_t off = (size_t)(row0 + ai * HALF + m * 16) * nv::D + col0; float s = 0.f, q = 0.f; u32x2 wz[2];
#pragma unroll
                for (int bj = 0; bj < 2; ++bj) { f32x4 r0, r1;
                    if constexpr (RF32) { r0 = rf[r][bj][0]; r1 = rf[r][bj][1]; }
                    else { const u32x4 x = rr[r][bj]; r0[0] = __uint_as_float(x.x << 16); r0[1] = __uint_as_float(x.x & 0xffff0000u); r0[2] = __uint_as_float(x.y << 16); r0[3] = __uint_as_float(x.y & 0xffff0000u);
                        r1[0] = __uint_as_float(x.z << 16); r1[1] = __uint_as_float(x.z & 0xffff0000u); r1[2] = __uint_as_float(x.w << 16); r1[3] = __uint_as_float(x.w & 0xffff0000u); }
                    const f32x4 z0 = r0 * nv::ALPHA + acc[ai][bj][m][0] * scale, z1 = r1 * nv::ALPHA + acc[ai][bj][m][1] * scale;
                    *(u32x4*)(Z + off + bj * 32) = pack8(z0, z1);
                    { const f32x4 sv = z0 + z1, qv = z0 * z0 + z1 * z1; s += (sv[0] + sv[1]) + (sv[2] + sv[3]); q += (qv[0] + qv[1]) + (qv[2] + qv[3]); }
                    const f32x4 v0 = z0 * gv[bj][0], v1 = z1 * gv[bj][1];
                    wz[bj].x = pk4_fp8(v0[0], v0[1], v0[2], v0[3]); wz[bj].y = pk4_fp8(v1[0], v1[1], v1[2], v1[3]); }
                *(u32x4*)(ZG8 + off + ((fq & 1) ? 32 - 8 : 0)) = widen16(wz[0], wz[1]);
                s += nv::swz_xor<16>(s); q += nv::swz_xor<16>(q);
                { const auto p = __builtin_amdgcn_permlane32_swap(__float_as_uint(s), __float_as_uint(s), false, false); s = __uint_as_float(p[0]) + __uint_as_float(p[1]); }
                { const auto p = __builtin_amdgcn_permlane32_swap(__float_as_uint(q), __float_as_uint(q), false, false); q = __uint_as_float(p[0]) + __uint_as_float(p[1]); }
                ps[m] = s; pq[m] = q;
                if (m == 3) { f32x2 o; o[0] = fq == 0 ? ps[0] : fq == 1 ? ps[1] : fq == 2 ? ps[2] : ps[3]; o[1] = fq == 0 ? pq[0] : fq == 1 ? pq[1] : fq == 2 ? pq[2] : pq[3];
                    *(f32x2*)(PART + ((size_t)(row0 + ai * HALF + fq * 16) * 16 + u.pn * 4 + wc) * 2) = o; } }
            asm volatile("" ::: "memory");
            if (r + 2 < 8) EPIZ_LOAD(r + 2);
        }
#undef EPIZ_LOAD
    }
};
struct EpiInproj0 {
    static constexpr bool PERM = true;
    bf16_t* O; const float* rope; float in_scale;
    __device__ __forceinline__ void operator()(f32x4 (&acc)[2][2][4][2], const Unit& u, int wr, int wc, int fr, int fq) const {
        const int row0 = u.pm * BM + wr * 64 + fr, col0 = u.pn * BM + wc * 32 + 8 * fq;
        const float sc_ = u.pn < 2 ? in_scale * nv::ASCALE : in_scale;
#pragma unroll
        for (int ai = 0; ai < 2; ++ai)
#pragma unroll
            for (int bj = 0; bj < 2; ++bj)
#pragma unroll
                for (int m = 0; m < 4; ++m) { acc[ai][bj][m][0] *= sc_; acc[ai][bj][m][1] *= sc_; }
        if (u.pn >= 3) {
#pragma unroll
            for (int ai = 0; ai < 2; ++ai)
#pragma unroll
                for (int m = 0; m < 4; ++m) { bf16_t* rowp = O + (size_t)(row0 + ai * HALF + m * 16) * nv::NIN0 + col0;
#pragma unroll
                    for (int bj = 0; bj < 2; ++bj) { f32x4 v[2];
#pragma unroll
                        for (int n = 0; n < 2; ++n) { const f32x4 x = acc[ai][bj][m][n]; constexpr float k1 = -2.f * 0.7978845608028654f * 1.4426950408889634f, k3 = k1 * 0.044715f;
                            const f32x4 t = x * ((x * x) * k3 + k1); f32x4 d;
#pragma unroll
                            for (int j = 0; j < 4; ++j) d[j] = __builtin_amdgcn_exp2f(t[j]);
                            d = d + 1.f; f32x4 r;
#pragma unroll
                            for (int j = 0; j < 4; ++j) r[j] = __builtin_amdgcn_rcpf(d[j]);
                            v[n] = x * r; }
                        *(u32x4*)(rowp + bj * HALF) = pack8(v[0], v[1]); } }
        } else {
            const bool wave_rope = (wc & 1) == 0;
            const float sgn = fq == 0 ? -1.f : 1.f;
#pragma unroll
            for (int ai = 0; ai < 2; ++ai)
#pragma unroll
                for (int m = 0; m < 4; ++m) { const int row = row0 + ai * HALF + m * 16; bf16_t* rowp = O + (size_t)row * nv::NIN0 + col0;
                    f32x4 c0, c1, s0, s1;
                    if (wave_rope) { const float* rp = rope + (size_t)row * 16; c0 = *(const f32x4*)rp; c1 = *(const f32x4*)(rp + 4); s0 = *(const f32x4*)(rp + 8); s1 = *(const f32x4*)(rp + 12); }
#pragma unroll
                    for (int bj = 0; bj < 2; ++bj) { f32x4 v0 = acc[ai][bj][m][0], v1 = acc[ai][bj][m][1];
                        if (wave_rope && (u.pn < 2 || bj == 0)) {
                            f32x4 p0, p1;
#pragma unroll
                            for (int j = 0; j < 4; ++j) { p0[j] = nv::swz_xor<16>(v0[j]); p1[j] = nv::swz_xor<16>(v1[j]); }
                            if (fq < 2) {
#pragma unroll
                                for (int j = 0; j < 4; ++j) { v0[j] = v0[j] * c0[j] + sgn * p0[j] * s0[j]; v1[j] = v1[j] * c1[j] + sgn * p1[j] * s1[j]; } }
                        }
                        *(u32x4*)(rowp + bj * HALF) = pack8(v0, v1); } }
        }
    }
};
}

#define LAS __attribute__((address_space(3)))
#define GAS __attribute__((address_space(1)))
typedef GAS unsigned gu32;
#define RLX_AGENT __ATOMIC_RELAXED, __HIP_MEMORY_SCOPE_AGENT
#define LDS_WAIT() asm volatile("s_waitcnt lgkmcnt(0)" ::: "memory")
#define VM_WAIT() asm volatile("s_waitcnt vmcnt(0)" ::: "memory")

#define XB_TMO      128
#define XB_XCNT(j)  (256  + 64 * (j))
#define XB_XSUB(j)  (1280 + 64 * (j))
#define XB_XGEN(j)  (2304 + 64 * (j))
#define XB_TOP      3328
#define XB_TOPGEN   3392
#define XCD_BAR_WORDS 3456
#define XB_SPIN_CAP (1u << 18)
__device__ __forceinline__ unsigned xb_ld(unsigned* p)              { return __hip_atomic_load(p, __ATOMIC_RELAXED, __HIP_MEMORY_SCOPE_AGENT); }
__device__ __forceinline__ unsigned xb_add(unsigned* p, unsigned v) { return __hip_atomic_fetch_add(p, v, __ATOMIC_RELAXED, __HIP_MEMORY_SCOPE_AGENT); }
__device__ __forceinline__ unsigned xb_xcc_id() { return (unsigned)__builtin_amdgcn_s_getreg((3 << 11) | 20) & 0xFu; }
#define XB_SPIN(cond, bar) do { unsigned _sp = 0; while (cond) { __builtin_amdgcn_s_sleep(4);   \
    if ((++_sp & 255u) == 0u) { if (xb_ld(&(bar)[XB_TMO])) break; if (_sp > XB_SPIN_CAP) { atomicAdd(&(bar)[XB_TMO], 1u); break; } } } } while (0)
struct XcdBarrier { unsigned* bar; unsigned x; volatile LAS unsigned* st; int wave; };
__device__ __forceinline__ unsigned lane_id_fresh() { unsigned m = ~0u; asm volatile("" : "+s"(m)); return __builtin_amdgcn_mbcnt_hi(m, __builtin_amdgcn_mbcnt_lo(m, 0u)); }
__device__ __forceinline__ bool xb_thread0(int wave) { return wave == 0 && lane_id_fresh() == 0u; }
__device__ __forceinline__ XcdBarrier xcd_barrier_post(unsigned* bar, volatile LAS unsigned* st, int wave) {
    XcdBarrier b; b.bar = bar; b.x = xb_xcc_id(); b.st = st; b.wave = wave;
    if (xb_thread0(wave)) (void)xb_add(&bar[XB_XCNT(b.x)], 1u);
    return b;
}
__device__ __forceinline__ void xcd_barrier_complete(unsigned* bar, unsigned x, unsigned& nloc, unsigned& nx) {
    const unsigned G = gridDim.x * gridDim.y * gridDim.z;
    unsigned sum, cnt, mine, sp = 0u;
    for (;;) {
        sum = 0u; cnt = 0u; mine = 0u;
#pragma unroll
        for (unsigned j = 0; j < 16; ++j) { const unsigned c = xb_ld(&bar[XB_XCNT(j)]); sum += c; cnt += (c > 0u) ? 1u : 0u; mine = (j == x) ? c : mine; }
        if (sum == G) break;
        __builtin_amdgcn_s_sleep(1);
        if ((++sp & 255u) == 0u) { if (xb_ld(&bar[XB_TMO])) break; if (sp > XB_SPIN_CAP) { atomicAdd(&bar[XB_TMO], 1u); break; } }
    }
    nloc = mine > 0u ? mine : 1u; nx = cnt > 0u ? cnt : 1u;
}
__device__ __forceinline__ void xcd_barrier(const XcdBarrier& b, const bool wait = true) {
    asm volatile("s_waitcnt vmcnt(0)" ::: "memory");
    __syncthreads();
    if (xb_thread0(b.wave)) {
        unsigned* bar = b.bar;
        __builtin_amdgcn_s_waitcnt(0);
        unsigned nloc = b.st[0], nx = b.st[1];
        if (nloc == 0u) { xcd_barrier_complete(bar, b.x, nloc, nx); b.st[0] = nloc; b.st[1] = nx; }
        const unsigned old = xb_add(&bar[XB_XSUB(b.x)], 1u);
        const unsigned gen = old / nloc;
        if (old + 1u == (gen + 1u) * nloc) {
            __builtin_amdgcn_fence(__ATOMIC_RELEASE, "agent");
            asm volatile("s_waitcnt vmcnt(0)" ::: "memory");
            const unsigned og = xb_add(&bar[XB_TOP], 1u);
            const unsigned tg = og / nx;
            asm volatile("buffer_inv sc1" ::: "memory");
            if (og + 1u == (tg + 1u) * nx) xb_add(&bar[XB_TOPGEN], 1u);
            else if (wait) XB_SPIN(xb_ld(&bar[XB_TOPGEN]) == tg, bar);
            asm volatile("" ::: "memory");
            asm volatile("s_waitcnt vmcnt(0)" ::: "memory");
        } else {
            asm volatile("buffer_inv sc1" ::: "memory");
            if (wait) XB_SPIN(xb_ld(&bar[XB_TOPGEN]) == gen, bar);
            asm volatile("s_waitcnt vmcnt(0)" ::: "memory");
        }
    }
    __syncthreads();
}
__device__ __forceinline__ void xcd_barrier_settle(const XcdBarrier& b, unsigned gen) {
    if (xb_thread0(b.wave)) { unsigned* bar = b.bar; XB_SPIN(xb_ld(&bar[XB_TOPGEN]) == gen, bar); asm volatile("s_waitcnt vmcnt(0)" ::: "memory"); }
}

namespace mk {
using namespace nv;
typedef unsigned v4u __attribute__((ext_vector_type(4)));
typedef unsigned v2u __attribute__((ext_vector_type(2)));
typedef float f32x4 __attribute__((ext_vector_type(4)));
constexpr int NWAVES = 8, NTHREADS = 512;
constexpr int LDS_BYTES = 160 * 1024;
constexpr int MISC_OFF = LDS_BYTES - 256;
constexpr int CW_BAR = 4096;
constexpr size_t CTL_ZERO_BYTES = 64 * 1024;

__device__ __forceinline__ unsigned pk2(float lo, float hi) { return pg8::cvt_pk_bf16(lo, hi); }

struct Frame {
    LAS unsigned char* lds; int tid, lane, wave, vcu, G, bx;
};

struct TItem { const float* src; unsigned char* dst; int ldw, ldt, k0, n0, dr, f8; };
template <int MAP, bool F8>
__device__ __forceinline__ void titem_fill(TItem& t, const void* srcp, int K, int N, void* dstp, size_t dstb, int r) {
    const int nblk = N / 32, per = (K / 64) * nblk, bi = r / per, it = r % per, kb = it / nblk, nb = it % nblk, n0 = 32 * nb;
    int dr = n0; if (MAP == 1) dr = (n0 >> 7) * 256 + (n0 & 127); if (MAP == 2) dr = (n0 >> 7) * 256 + 128 + (n0 & 127);
    t.src = (const float*)srcp + (size_t)bi * K * N; t.dst = (unsigned char*)dstp + (size_t)bi * dstb * (F8 ? 1 : 2); t.ldw = N; t.ldt = K; t.k0 = 64 * kb; t.n0 = n0; t.dr = dr; t.f8 = F8 ? 1 : 0;
}
struct TRegs { f32x4 v[8]; };
__device__ __forceinline__ void titem_load(const TItem& t, int lane, TRegs& R) {
    const float* p = t.src + (size_t)(t.k0 + (lane >> 3)) * t.ldw + t.n0 + (lane & 7) * 4;
#pragma unroll
    for (int i = 0; i < 8; ++i) R.v[i] = __builtin_nontemporal_load((const f32x4*)(p + (size_t)(8 * i) * t.ldw));
}
__device__ __forceinline__ void titem_finish(const TItem& t, int lane, const TRegs& R, LAS float* scr) {
    const float sc = t.f8 ? pg8::F8_WS : 1.f;
    { LAS float* d = scr + (lane >> 3) * 33 + (lane & 7) * 4;
#pragma unroll
      for (int i = 0; i < 8; ++i) { d[(8 * i) * 33 + 0] = R.v[i][0] * sc; d[(8 * i) * 33 + 1] = R.v[i][1] * sc; d[(8 * i) * 33 + 2] = R.v[i][2] * sc; d[(8 * i) * 33 + 3] = R.v[i][3] * sc; } }
    LDS_WAIT(); asm volatile("" ::: "memory");
    const int c = lane & 7;
#pragma unroll
    for (int j = 0; j < 4; ++j) { const int n = (lane >> 3) + 8 * j; const LAS float* s = scr + (8 * c) * 33 + n;
        if (t.f8) { v2u o; o.x = pg8::pk4_fp8(s[0 * 33], s[1 * 33], s[2 * 33], s[3 * 33]); o.y = pg8::pk4_fp8(s[4 * 33], s[5 * 33], s[6 * 33], s[7 * 33]);
            __builtin_nontemporal_store(o, (v2u*)(t.dst + (size_t)(t.dr + n) * t.ldt + t.k0 + 8 * c)); }
        else { v4u o; o.x = pk2(s[0 * 33], s[1 * 33]); o.y = pk2(s[2 * 33], s[3 * 33]); o.z = pk2(s[4 * 33], s[5 * 33]); o.w = pk2(s[6 * 33], s[7 * 33]);
            __builtin_nontemporal_store(o, (v4u*)((bf16_t*)t.dst + (size_t)(t.dr + n) * t.ldt + t.k0 + 8 * c)); } }
    LDS_WAIT(); asm volatile("" ::: "memory");
}

struct InvFreq { float f[8]; };
struct Args {
    const void* in[40]; float* out; unsigned char* ws; InvFreq inv; int ph_lo, ph_hi;
};

struct RowV { float v[16]; };
__device__ __forceinline__ void unpk8(const v4u u, float* x) {
    x[0] = __uint_as_float(u.x << 16); x[1] = __uint_as_float(u.x & 0xffff0000u); x[2] = __uint_as_float(u.y << 16); x[3] = __uint_as_float(u.y & 0xffff0000u);
    x[4] = __uint_as_float(u.z << 16); x[5] = __uint_as_float(u.z & 0xffff0000u); x[6] = __uint_as_float(u.w << 16); x[7] = __uint_as_float(u.w & 0xffff0000u);
}
struct RowRaw { v4u a, b; };
__device__ __forceinline__ RowRaw load_raw(const bf16_t* p, int lane) { RowRaw r; r.a = __builtin_nontemporal_load((const v4u*)(p + 8 * lane)); r.b = __builtin_nontemporal_load((const v4u*)(p + 512 + 8 * lane)); return r; }
__device__ __forceinline__ void unpack_row(const RowRaw& r, RowV& x) { unpk8(r.a, x.v); unpk8(r.b, x.v + 8); }
struct RowRaw8 { v2u a, b; };
__device__ __forceinline__ RowRaw8 load_raw8(const unsigned char* p, int lane) { RowRaw8 r; r.a = __builtin_nontemporal_load((const v2u*)(p + 8 * lane)); r.b = __builtin_nontemporal_load((const v2u*)(p + 512 + 8 * lane)); return r; }
__device__ __forceinline__ void unpk8_fp8(const v2u u, float* x, float s) {
    typedef float v2f_ __attribute__((ext_vector_type(2)));
    const v2f_ a = __builtin_amdgcn_cvt_pk_f32_fp8((int)u.x, false), b = __builtin_amdgcn_cvt_pk_f32_fp8((int)u.x, true), c = __builtin_amdgcn_cvt_pk_f32_fp8((int)u.y, false), d = __builtin_amdgcn_cvt_pk_f32_fp8((int)u.y, true);
    x[0] = a[0] * s; x[1] = a[1] * s; x[2] = b[0] * s; x[3] = b[1] * s; x[4] = c[0] * s; x[5] = c[1] * s; x[6] = d[0] * s; x[7] = d[1] * s;
}
__device__ __forceinline__ void unpack_row8(const RowRaw8& r, RowV& x, float s) { unpk8_fp8(r.a, x.v, s); unpk8_fp8(r.b, x.v + 8, s); }
typedef float f32p __attribute__((ext_vector_type(2)));
__device__ __forceinline__ void raw8_pairs(const RowRaw8& r, f32p (&y)[8]) {
    y[0] = __builtin_amdgcn_cvt_pk_f32_fp8((int)r.a.x, false); y[1] = __builtin_amdgcn_cvt_pk_f32_fp8((int)r.a.x, true); y[2] = __builtin_amdgcn_cvt_pk_f32_fp8((int)r.a.y, false); y[3] = __builtin_amdgcn_cvt_pk_f32_fp8((int)r.a.y, true);
    y[4] = __builtin_amdgcn_cvt_pk_f32_fp8((int)r.b.x, false); y[5] = __builtin_amdgcn_cvt_pk_f32_fp8((int)r.b.x, true); y[6] = __builtin_amdgcn_cvt_pk_f32_fp8((int)r.b.y, false); y[7] = __builtin_amdgcn_cvt_pk_f32_fp8((int)r.b.y, true);
}
__device__ __forceinline__ void axpy_row8(RowV& x, const RowRaw8& r, float s) {
    f32p y[8]; raw8_pairs(r, y); const f32p s2 = {s, s}, a2 = {ALPHA, ALPHA};
#pragma unroll
    for (int i = 0; i < 8; ++i) { f32p v = {x.v[2 * i], x.v[2 * i + 1]}; v = __builtin_elementwise_fma(y[i], s2, v * a2); x.v[2 * i] = v[0]; x.v[2 * i + 1] = v[1]; }
}
__device__ __forceinline__ void axpy2_row8(RowV& x, const RowRaw8& r1, float s1, const RowRaw8& r2, float s2_) {
    f32p y1[8], y2[8]; raw8_pairs(r1, y1); raw8_pairs(r2, y2); const f32p a = {s1, s1}, b = {s2_, s2_}, a2 = {ALPHA, ALPHA};
#pragma unroll
    for (int i = 0; i < 8; ++i) { f32p v = {x.v[2 * i], x.v[2 * i + 1]}; v = __builtin_elementwise_fma(y1[i], a, v * a2); v = __builtin_elementwise_fma(y2[i], b, v); x.v[2 * i] = v[0]; x.v[2 * i + 1] = v[1]; }
}
struct GB { float g[16], b[16]; };
__device__ __forceinline__ void load_gb(const float* g, const float* b, int lane, GB& o) {
#pragma unroll
    for (int hh = 0; hh < 2; ++hh)
#pragma unroll
        for (int q = 0; q < 2; ++q) { const float4 gg = *(const float4*)(g + 512 * hh + 8 * lane + 4 * q), bb = *(const float4*)(b + 512 * hh + 8 * lane + 4 * q);
            o.g[8 * hh + 4 * q + 0] = gg.x; o.g[8 * hh + 4 * q + 1] = gg.y; o.g[8 * hh + 4 * q + 2] = gg.z; o.g[8 * hh + 4 * q + 3] = gg.w;
            o.b[8 * hh + 4 * q + 0] = bb.x; o.b[8 * hh + 4 * q + 1] = bb.y; o.b[8 * hh + 4 * q + 2] = bb.z; o.b[8 * hh + 4 * q + 3] = bb.w; }
}
__device__ __forceinline__ void ln_rowv(RowV& z, const GB& gb) {
    typedef float f32x2_ __attribute__((ext_vector_type(2)));
    f32x2_ s2 = {0.f, 0.f}, q2 = {0.f, 0.f};
#pragma unroll
    for (int i = 0; i < 8; ++i) { const f32x2_ v = {z.v[2 * i], z.v[2 * i + 1]}; s2 = s2 + v; q2 = __builtin_elementwise_fma(v, v, q2); }
    float s = s2[0] + s2[1], q = q2[0] + q2[1];
    s += swz_xor<1>(s); q += swz_xor<1>(q); s += swz_xor<2>(s); q += swz_xor<2>(q); s += swz_xor<4>(s); q += swz_xor<4>(q); s += swz_xor<8>(s); q += swz_xor<8>(q); s += swz_xor<16>(s); q += swz_xor<16>(q);
    { const auto r = __builtin_amdgcn_permlane32_swap(__float_as_uint(s), __float_as_uint(s), false, false); s = __uint_as_float(r[0]) + __uint_as_float(r[1]); }
    { const auto r = __builtin_amdgcn_permlane32_swap(__float_as_uint(q), __float_as_uint(q), false, false); q = __uint_as_float(r[0]) + __uint_as_float(r[1]); }
    const float mu = s * (1.f / D), var = fmaxf(q * (1.f / D) - mu * mu, 0.f);
    const float rstd = __builtin_amdgcn_rsqf(var + LN_EPS), c = -mu * rstd;
    const f32x2_ r2 = {rstd, rstd}, c2 = {c, c};
#pragma unroll
    for (int i = 0; i < 8; ++i) { f32x2_ v = {z.v[2 * i], z.v[2 * i + 1]}; const f32x2_ g2 = {gb.g[2 * i], gb.g[2 * i + 1]}, b2 = {gb.b[2 * i], gb.b[2 * i + 1]};
        v = __builtin_elementwise_fma(v, r2, c2); v = __builtin_elementwise_fma(v, g2, b2); z.v[2 * i] = v[0]; z.v[2 * i + 1] = v[1]; }
}
__device__ __forceinline__ void store_rowv_bf16(bf16_t* p, int lane, const RowV& r) {
    v4u a, b; a.x = pk2(r.v[0], r.v[1]); a.y = pk2(r.v[2], r.v[3]); a.z = pk2(r.v[4], r.v[5]); a.w = pk2(r.v[6], r.v[7]);
    b.x = pk2(r.v[8], r.v[9]); b.y = pk2(r.v[10], r.v[11]); b.z = pk2(r.v[12], r.v[13]); b.w = pk2(r.v[14], r.v[15]);
    *(v4u*)(p + 8 * lane) = a; *(v4u*)(p + 512 + 8 * lane) = b;
}
__device__ __forceinline__ unsigned dpp_xor1(unsigned v) { return (unsigned)__builtin_amdgcn_update_dpp(0, (int)v, 0xB1  , 0xF, 0xF, true); }
__device__ __forceinline__ void store_rowv_fp8(unsigned char* p, int lane, const RowV& r, float s) {
    f32p t[8]; { const f32p s2 = {s, s};
#pragma unroll
      for (int i = 0; i < 8; ++i) { const f32p v = {r.v[2 * i], r.v[2 * i + 1]}; t[i] = v * s2; } }
    v2u a, b; a.x = pg8::pk4_fp8(t[0][0], t[0][1], t[1][0], t[1][1]); a.y = pg8::pk4_fp8(t[2][0], t[2][1], t[3][0], t[3][1]);
    b.x = pg8::pk4_fp8(t[4][0], t[4][1], t[5][0], t[5][1]); b.y = pg8::pk4_fp8(t[6][0], t[6][1], t[7][0], t[7][1]);
    const bool odd = (lane & 1) != 0;
    const unsigned rx = dpp_xor1(odd ? a.x : b.x), ry = dpp_xor1(odd ? a.y : b.y);
    v4u o; o.x = odd ? rx : a.x; o.y = odd ? ry : a.y; o.z = odd ? b.x : rx; o.w = odd ? b.y : ry;
    *(v4u*)(p + (odd ? 512 + 8 * (lane - 1) : 8 * lane)) = o;
}
__device__ __forceinline__ void moe_offsets(const Frame& F, unsigned* gcnt, LAS int* offl) {
    if (F.tid < 16) {
        const int cnt = (int)__hip_atomic_load(gcnt + F.tid, __ATOMIC_RELAXED, __HIP_MEMORY_SCOPE_AGENT);
        const int pad = (cnt + 255) & ~255; int inc = pad;
        inc += __builtin_amdgcn_update_dpp(0, inc, 0x111, 0xF, 0xF, true); inc += __builtin_amdgcn_update_dpp(0, inc, 0x112, 0xF, 0xF, true);
        inc += __builtin_amdgcn_update_dpp(0, inc, 0x114, 0xF, 0xF, true); inc += __builtin_amdgcn_update_dpp(0, inc, 0x118, 0xF, 0xF, true);
        const int exc = inc - pad;
        offl[F.tid] = exc; offl[32 + F.tid] = cnt; if (F.tid == 15) offl[16] = inc;
        for (int tl = exc >> 8; tl < (inc >> 8); ++tl) offl[64 + tl] = F.tid;
    }
    __syncthreads();
}
constexpr int LNR = 4;

__device__ __forceinline__ void phase_ln_add(const Frame& F, const bf16_t* X, const bf16_t* Y, const float* g, const float* b, bf16_t* out, unsigned char* out8) {
    const int gw = F.vcu * NWAVES + F.wave, NGW = F.G * NWAVES;
    GB gb; load_gb(g, b, F.lane, gb);
    for (int row = gw; row < T; row += LNR * NGW) {
        RowRaw rx[LNR], ry[LNR];
#pragma unroll
        for (int k = 0; k < LNR; ++k) { const int rr = row + k * NGW; if (rr < T) { rx[k] = load_raw(X + (size_t)rr * D, F.lane); if (Y) ry[k] = load_raw(Y + (size_t)rr * D, F.lane); } }
#pragma unroll
        for (int k = 0; k < LNR; ++k) { const int rr = row + k * NGW; if (rr < T) {
            RowV x; unpack_row(rx[k], x);
            if (Y) { RowV y; unpack_row(ry[k], y);
#pragma unroll
                for (int i = 0; i < 16; ++i) x.v[i] = ALPHA * x.v[i] + y.v[i]; }
            ln_rowv(x, gb);
            store_rowv_bf16(out + (size_t)rr * D, F.lane, x);
            store_rowv_fp8(out8 + (size_t)rr * D, F.lane, x, pg8::F8_XS); } }
    }
}
__device__ __forceinline__ void phase_ln_moe(const Frame& F, const bf16_t* X, const unsigned char* DS, const LAS int* offl, const int* pos, const float* ewgt, const float* g, const float* b, bf16_t* outb, float* outf, unsigned char* out8) {
    const int gw = F.vcu * NWAVES + F.wave, NGW = F.G * NWAVES;
    GB gb; load_gb(g, b, F.lane, gb);
    for (int row = gw; row < T; row += LNR * NGW) {
        RowRaw rx[LNR]; RowRaw8 r1[LNR], r2[LNR]; float w1[LNR], w2[LNR];
#pragma unroll
        for (int k = 0; k < LNR; ++k) { const int rr = row + k * NGW; if (rr < T) {
            int2 pp = *(const int2*)(pos + 2 * rr); pp.x = offl[pp.x >> 15] + (pp.x & 32767); pp.y = offl[pp.y >> 15] + (pp.y & 32767); const float2 ww = *(const float2*)(ewgt + 2 * rr); w1[k] = ww.x; w2[k] = ww.y;
            rx[k] = load_raw(X + (size_t)rr * D, F.lane); r1[k] = load_raw8(DS + (size_t)pp.x * D, F.lane); r2[k] = load_raw8(DS + (size_t)pp.y * D, F.lane); } }
#pragma unroll
        for (int k = 0; k < LNR; ++k) { const int rr = row + k * NGW; if (rr < T) {
            RowV x; unpack_row(rx[k], x); axpy2_row8(x, r1[k], w1[k] * (1.f / pg8::F8_DS), r2[k], w2[k] * (1.f / pg8::F8_DS));
            ln_rowv(x, gb);
            if (outb) store_rowv_bf16(outb + (size_t)rr * D, F.lane, x);
            if (out8) store_rowv_fp8(out8 + (size_t)rr * D, F.lane, x, pg8::F8_XS);
            if (outf) { float* o = outf + (size_t)rr * D + 8 * F.lane;
                { f32x4 a0 = {x.v[0], x.v[1], x.v[2], x.v[3]}, a1 = {x.v[4], x.v[5], x.v[6], x.v[7]}, a2 = {x.v[8], x.v[9], x.v[10], x.v[11]}, a3 = {x.v[12], x.v[13], x.v[14], x.v[15]};
                  __builtin_nontemporal_store(a0, (f32x4*)(o)); __builtin_nontemporal_store(a1, (f32x4*)(o + 4)); __builtin_nontemporal_store(a2, (f32x4*)(o + 512)); __builtin_nontemporal_store(a3, (f32x4*)(o + 516)); } } } }
    }
}
__device__ __forceinline__ void phase_cvec(const Frame& F, const unsigned char* MT8, const float* g, const float* b, float* CV) {
    const int gw = F.vcu * NWAVES + F.wave, NGW = F.G * NWAVES;
    GB gb; load_gb(g, b, F.lane, gb);
    for (int r0 = gw; r0 < B * XH * MEM; r0 += 2 * NGW) {
      RowRaw8 rw2[2];
#pragma unroll
      for (int k = 0; k < 2; ++k) { const int r = r0 + k * NGW < B * XH * MEM ? r0 + k * NGW : r0; rw2[k] = load_raw8(MT8 + (size_t)r * D, F.lane); }
#pragma unroll
      for (int k = 0; k < 2; ++k) { const int r = r0 + k * NGW; if (r < B * XH * MEM) {
        RowV m; unpack_row8(rw2[k], m, 1.f / pg8::F8_MS);
        float s1 = 0.f, s0 = 0.f;
#pragma unroll
        for (int i = 0; i < 16; ++i) { s1 += gb.g[i] * m.v[i]; s0 += gb.b[i] * m.v[i]; }
        s1 = wave_sum(s1); s0 = wave_sum(s0);
        if (F.lane < 2) CV[2 * (size_t)r + F.lane] = F.lane == 0 ? s1 : s0;
      } }
    }
}
template <class Sched>
__device__ __forceinline__ void scores_prepass(const Frame& F, const Sched& S, const float* PART, const float* CV, float* STAT, float in_scale, LAS float* st, LAS float* cv, LAS int* tag) {
#pragma unroll 1
    for (int i = 0; i < 4; ++i) { pg8::Unit u; const bool ok = S.next(i, u);
        if (F.tid == 0) tag[i] = ok ? u.pm * 4 + u.pn : -1;
        if (!ok) continue;
        if (F.tid < 256) { const f32x4* p = (const f32x4*)(PART + ((size_t)u.pm * 256 + F.tid) * 32); float s = 0.f, q = 0.f;
#pragma unroll
            for (int j = 0; j < 8; ++j) { const f32x4 v = p[j]; s += v[0] + v[2]; q += v[1] + v[3]; }
            const float mu = s * (1.f / D), var = fmaxf(q * (1.f / D) - mu * mu, 0.f), rstd = 1.f / sqrtf(var + LN_EPS);
            float isc = in_scale; asm volatile("" : "+v"(isc));
            st[(i * 256 + F.tid) * 2] = rstd * isc; st[(i * 256 + F.tid) * 2 + 1] = -mu * rstd;
            if (u.pn == 0) *(float2*)(STAT + 2 * ((size_t)u.pm * 256 + F.tid)) = make_float2(rstd, -mu * rstd); }
        else { const int t = F.tid - 256; const float2 c = *(const float2*)(CV + 2 * (size_t)((u.pm >> 5) * 1024 + u.pn * 256 + t)); cv[(i * 256 + t) * 2] = c.x; cv[(i * 256 + t) * 2 + 1] = c.y; }
    }
    __syncthreads();
}
constexpr int RW_LD = 20, GBL_LD = 68;
__device__ __forceinline__ void lds_gb(const LAS float* gp, GB& o) {
#pragma unroll
    for (int q4 = 0; q4 < 4; ++q4) { const f32x4 gg = *(const LAS f32x4*)(gp + 4 * q4), bb = *(const LAS f32x4*)(gp + 16 + 4 * q4);
        o.g[4 * q4] = gg[0]; o.g[4 * q4 + 1] = gg[1]; o.g[4 * q4 + 2] = gg[2]; o.g[4 * q4 + 3] = gg[3]; o.b[4 * q4] = bb[0]; o.b[4 * q4 + 1] = bb[1]; o.b[4 * q4 + 2] = bb[2]; o.b[4 * q4 + 3] = bb[3]; }
}
__device__ __forceinline__ f32p ln_stats(const RowV& z) {
    f32p s2 = {0.f, 0.f}, q2 = {0.f, 0.f};
#pragma unroll
    for (int i = 0; i < 8; ++i) { const f32p v = {z.v[2 * i], z.v[2 * i + 1]}; s2 = s2 + v; q2 = __builtin_elementwise_fma(v, v, q2); }
    float s = s2[0] + s2[1], q = q2[0] + q2[1];
    s += swz_xor<1>(s); q += swz_xor<1>(q); s += swz_xor<2>(s); q += swz_xor<2>(q); s += swz_xor<4>(s); q += swz_xor<4>(q); s += swz_xor<8>(s); q += swz_xor<8>(q); s += swz_xor<16>(s); q += swz_xor<16>(q);
    { const auto r = __builtin_amdgcn_permlane32_swap(__float_as_uint(s), __float_as_uint(s), false, false); s = __uint_as_float(r[0]) + __uint_as_float(r[1]); }
    { const auto r = __builtin_amdgcn_permlane32_swap(__float_as_uint(q), __float_as_uint(q), false, false); q = __uint_as_float(r[0]) + __uint_as_float(r[1]); }
    const float mu = s * (1.f / D), var = fmaxf(q * (1.f / D) - mu * mu, 0.f), rstd = __builtin_amdgcn_rsqf(var + LN_EPS);
    return (f32p){rstd, -mu * rstd};
}
__device__ __forceinline__ void ln_apply4(RowV (&x)[4], const f32p (&st)[4], const LAS float* gp) {
#pragma unroll
    for (int q4 = 0; q4 < 4; ++q4) { const f32x4 gg = *(const LAS f32x4*)(gp + 4 * q4), bb = *(const LAS f32x4*)(gp + 16 + 4 * q4);
#pragma unroll
        for (int k = 0; k < 4; ++k) { const f32p r2 = {st[k][0], st[k][0]}, c2 = {st[k][1], st[k][1]};
#pragma unroll
            for (int h = 0; h < 2; ++h) { const int i = 2 * q4 + h; f32p v = {x[k].v[2 * i], x[k].v[2 * i + 1]}; const f32p g2 = {gg[2 * h], gg[2 * h + 1]}, b2 = {bb[2 * h], bb[2 * h + 1]};
                v = __builtin_elementwise_fma(v, r2, c2); v = __builtin_elementwise_fma(v, g2, b2); x[k].v[2 * i] = v[0]; x[k].v[2 * i + 1] = v[1]; } } }
}
__device__ __forceinline__ void phase_ln_router(const Frame& F, const bf16_t* X, const float* STAT, const float* g1, const float* b1, const unsigned char* Y, const float* g, const float* b, bf16_t* out, unsigned char* out8, const float* rw, const float* rbias, int* pos, float* ewgt, unsigned* gcnt, int* tokE) {
    LAS float* rwl = (LAS float*)F.lds;
    LAS int* hist = (LAS int*)(F.lds + 1024 * RW_LD * 4);
    LAS float* lgs = (LAS float*)(F.lds + 1024 * RW_LD * 4 + 256) + F.wave * 256;
    const int lane = F.lane;
    RowRaw rx[4]; RowRaw8 ry[4]; f32p st0 = {0.f, 0.f};
    { const int vb0 = F.vcu < T / 128 ? F.vcu : 0;
#pragma unroll
      for (int k = 0; k < 4; ++k) { const int r_ = vb0 * 128 + F.wave * 16 + k; rx[k] = load_raw(X + (size_t)r_ * D, lane); ry[k] = load_raw8(Y + (size_t)r_ * D, lane); }
      if (lane < 16) st0 = *(const f32p*)(STAT + 2 * (size_t)(vb0 * 128 + F.wave * 16 + lane)); }
    { float4 rv[8];
#pragma unroll
      for (int u = 0; u < 8; ++u) { const int i = F.tid + u * NTHREADS, k = i >> 2, q = i & 3; rv[u] = *(const float4*)(rw + (size_t)k * 16 + 4 * q); }
#pragma unroll
      for (int u = 0; u < 8; ++u) { const int i = F.tid + u * NTHREADS, k = i >> 2, q = i & 3; const float4 v = rv[u];
        const int j = (k >> 9) * 8 + (k & 7), l = (k >> 3) & 63; *(LAS f32x4*)(rwl + (j * 64 + l) * RW_LD + 4 * q) = (f32x4){v.x, v.y, v.z, v.w}; } }
    LAS f32p* stw = (LAS f32p*)(F.lds + 1024 * RW_LD * 4 + 256 + 8192 + 64 * GBL_LD * 4) + F.wave * 16;
    LAS float* g1l = (LAS float*)(F.lds + 1024 * RW_LD * 4 + 256 + 8192);
    { float gv[8];
#pragma unroll
      for (int u = 0; u < 8; ++u) { const int i = F.tid + u * NTHREADS, sel = i >> 10, k = i & 1023; const float* src = sel == 0 ? g1 : sel == 1 ? b1 : sel == 2 ? g : b; gv[u] = src[k]; }
#pragma unroll
      for (int u = 0; u < 8; ++u) { const int i = F.tid + u * NTHREADS, sel = i >> 10, k = i & 1023; g1l[((k >> 3) & 63) * GBL_LD + sel * 16 + (k >> 9) * 8 + (k & 7)] = gv[u]; } }
    for (int vb = F.vcu; vb < T / 128; vb += F.G) {
        if (F.tid < 16) hist[F.tid] = 0;
        __syncthreads();
        if (vb != F.vcu) {
#pragma unroll
            for (int k = 0; k < 4; ++k) { const int r_ = vb * 128 + F.wave * 16 + k; rx[k] = load_raw(X + (size_t)r_ * D, lane); ry[k] = load_raw8(Y + (size_t)r_ * D, lane); }
            if (lane < 16) st0 = *(const f32p*)(STAT + 2 * (size_t)(vb * 128 + F.wave * 16 + lane)); }
        if (lane < 16) stw[lane] = st0;
#pragma unroll 1
        for (int it = 0; it < 4; ++it) {
            const int row0 = vb * 128 + F.wave * 16 + it * 4;
            RowV x[4];
#pragma unroll
            for (int k = 0; k < 4; ++k) unpack_row(rx[k], x[k]);
            if (it < 3) {
#pragma unroll
                for (int k = 0; k < 4; ++k) rx[k] = load_raw(X + (size_t)(row0 + 4 + k) * D, lane); }
            { f32p st[4];
#pragma unroll
              for (int k = 0; k < 4; ++k) st[k] = stw[it * 4 + k];
              ln_apply4(x, st, g1l + lane * GBL_LD);
#pragma unroll
              for (int k = 0; k < 4; ++k) axpy_row8(x[k], ry[k], 1.f / pg8::F8_YS);
              if (it < 3) {
#pragma unroll
                  for (int k = 0; k < 4; ++k) ry[k] = load_raw8(Y + (size_t)(row0 + 4 + k) * D, lane); }
#pragma unroll
              for (int k = 0; k < 4; ++k) st[k] = ln_stats(x[k]);
              ln_apply4(x, st, g1l + lane * GBL_LD + 32); }
#pragma unroll
            for (int k = 0; k < 4; ++k) {
                store_rowv_bf16(out + (size_t)(row0 + k) * D, lane, x[k]);
                store_rowv_fp8(out8 + (size_t)(row0 + k) * D, lane, x[k], pg8::F8_XS); }
            typedef float f32x2_ __attribute__((ext_vector_type(2)));
            f32x2_ v2[32];
#pragma unroll
            for (int i = 0; i < 32; ++i) v2[i] = (f32x2_){0.f, 0.f};
#pragma unroll
            for (int j = 0; j < 16; ++j) { const LAS float* wr = rwl + (j * 64 + lane) * RW_LD;
#pragma unroll
                for (int e4 = 0; e4 < 4; ++e4) { const f32x4 w4 = *(const LAS f32x4*)(wr + 4 * e4); const f32x2_ wlo = (f32x2_){w4[0], w4[1]}, whi = (f32x2_){w4[2], w4[3]};
#pragma unroll
                    for (int k = 0; k < 4; ++k) { const f32x2_ xx = (f32x2_){x[k].v[j], x[k].v[j]};
                        v2[8 * k + 2 * e4 + 0] = __builtin_elementwise_fma(xx, wlo, v2[8 * k + 2 * e4 + 0]); v2[8 * k + 2 * e4 + 1] = __builtin_elementwise_fma(xx, whi, v2[8 * k + 2 * e4 + 1]); } } }
            float val[64];
#pragma unroll
            for (int i = 0; i < 32; ++i) { val[2 * i] = v2[i][0]; val[2 * i + 1] = v2[i][1]; }
#pragma unroll
            for (int i = 0; i < 32; ++i) { const auto rr = __builtin_amdgcn_permlane32_swap(__float_as_uint(val[i]), __float_as_uint(val[i + 32]), false, false); val[i] = __uint_as_float(rr[0]) + __uint_as_float(rr[1]); }
            { const bool bt = (lane & 16) != 0;
#pragma unroll
              for (int i = 0; i < 16; ++i) { const float keep = bt ? val[i + 16] : val[i], send = bt ? val[i] : val[i + 16]; val[i] = keep + swz_xor<16>(send); } }
            { const bool bt = (lane & 8) != 0;
#pragma unroll
              for (int i = 0; i < 8; ++i) { const float keep = bt ? val[i + 8] : val[i], send = bt ? val[i] : val[i + 8]; val[i] = keep + swz_xor<8>(send); } }
            { const bool bt = (lane & 4) != 0;
#pragma unroll
              for (int i = 0; i < 4; ++i) { const float keep = bt ? val[i + 4] : val[i], send = bt ? val[i] : val[i + 4]; val[i] = keep + swz_xor<4>(send); } }
            { const bool bt = (lane & 2) != 0;
#pragma unroll
              for (int i = 0; i < 2; ++i) { const float keep = bt ? val[i + 2] : val[i], send = bt ? val[i] : val[i + 2]; val[i] = keep + swz_xor<2>(send); } }
            { const bool bt = (lane & 1) != 0; const float keep = bt ? val[1] : val[0], send = bt ? val[0] : val[1]; val[0] = keep + swz_xor<1>(send); }
            lgs[it * 64 + lane] = val[0];
        }
        LDS_WAIT();
        int se1 = 0, se2 = 0, rk1 = 0, rk2 = 0;
        if (lane < 16) {
            {
                const int row = vb * 128 + F.wave * 16 + lane;
                float lg[16];
#pragma unroll
                for (int e4 = 0; e4 < 4; ++e4) { const f32x4 t4 = *(const LAS f32x4*)(lgs + 16 * lane + 4 * e4); lg[4 * e4] = t4[0]; lg[4 * e4 + 1] = t4[1]; lg[4 * e4 + 2] = t4[2]; lg[4 * e4 + 3] = t4[3]; }
                float mx = lg[0];
#pragma unroll
                for (int e = 1; e < 16; ++e) mx = fmaxf(mx, lg[e]);
                float sc[16], sum = 0.f;
#pragma unroll
                for (int e = 0; e < 16; ++e) { sc[e] = __expf(lg[e] - mx); sum += sc[e]; }
                const float isum = 1.f / sum;
                float bz[16];
#pragma unroll
                for (int e = 0; e < 16; ++e) { sc[e] *= isum; bz[e] = sc[e] + rbias[e]; }
                float gs[4]; int gi1[4], gi2[4];
#pragma unroll
                for (int gq = 0; gq < 4; ++gq) {
                    float m1 = bz[4 * gq]; int i1 = 0;
#pragma unroll
                    for (int j = 1; j < 4; ++j) if (bz[4 * gq + j] > m1) { m1 = bz[4 * gq + j]; i1 = j; }
                    float m2 = -INFINITY; int i2 = 0;
#pragma unroll
                    for (int j = 0; j < 4; ++j) if (j != i1 && bz[4 * gq + j] > m2) { m2 = bz[4 * gq + j]; i2 = j; }
                    gs[gq] = m1 + m2; gi1[gq] = i1; gi2[gq] = i2;
                }
                int gsel = 0; float gm = gs[0];
#pragma unroll
                for (int gq = 1; gq < 4; ++gq) if (gs[gq] > gm) { gm = gs[gq]; gsel = gq; }
                int i1 = gi1[0], i2 = gi2[0];
#pragma unroll
                for (int gq = 1; gq < 4; ++gq) if (gsel == gq) { i1 = gi1[gq]; i2 = gi2[gq]; }
                const int e1 = gsel * 4 + i1, e2 = gsel * 4 + i2;
                float s1 = 0.f, s2 = 0.f;
#pragma unroll
                for (int e = 0; e < 16; ++e) { if (e == e1) s1 = sc[e]; if (e == e2) s2 = sc[e]; }
                const float inv = 1.f / (s1 + s2);
                *(float2*)(ewgt + 2 * row) = make_float2(s1 * inv, s2 * inv);
                se1 = e1; se2 = e2; rk1 = atomicAdd((int*)&hist[e1], 1); rk2 = atomicAdd((int*)&hist[e2], 1);
            }
        }
        __syncthreads();
        if (F.tid < 16) hist[16 + F.tid] = (int)__hip_atomic_fetch_add(gcnt + F.tid, (unsigned)hist[F.tid], __ATOMIC_RELAXED, __HIP_MEMORY_SCOPE_AGENT);
        __syncthreads();
        if (lane < 16) { const int row = vb * 128 + F.wave * 16 + lane; const int p1 = se1 * 32768 + hist[16 + se1] + rk1, p2 = se2 * 32768 + hist[16 + se2] + rk2;
            *(int2*)(pos + 2 * row) = make_int2(p1, p2); tokE[p1] = row; tokE[p2] = row; }
        __syncthreads();
    }
}
__device__ __forceinline__ void phase_moe_book(const Frame& F, const int* eidx, const int* bcnt, int* tok, int* pos, int* tile_e) {
    LAS int* bc = (LAS int*)F.lds;
    LAS int* part = bc + 4096;
    LAS int* off = part + 256;
    LAS int* base = off + 32;
    LAS int* tot = base + 16;
    LAS int* wcnt = tot + 16;
    for (int i = F.tid; i < 4096; i += NTHREADS) bc[i] = bcnt[i];
    __syncthreads();
    if (F.tid < 256) { const int e = F.tid & 15, ch = F.tid >> 4; int s = 0;
#pragma unroll
        for (int j = 0; j < 16; ++j) s += bc[(ch * 16 + j) * 16 + e];
        part[ch * 16 + e] = s; }
    __syncthreads();
    if (F.tid < 16) { int t = 0;
#pragma unroll
        for (int ch = 0; ch < 16; ++ch) t += part[ch * 16 + F.tid];
        tot[F.tid] = t; }
    __syncthreads();
    if (F.tid == 0) { int o = 0;
#pragma unroll
        for (int e = 0; e < 16; ++e) { off[e] = o; o += (tot[e] + 255) & ~255; } off[16] = o; }
    __syncthreads();
    for (int vb = F.vcu; vb < T / 128; vb += F.G) {
        if (F.tid < 16) { const int e = F.tid, chv = vb >> 4; int bs = 0;
            for (int ch = 0; ch < chv; ++ch) bs += part[ch * 16 + e];
            for (int b2 = chv * 16; b2 < vb; ++b2) bs += bc[b2 * 16 + e];
            base[e] = bs; }
        int e = 0, rank = 0;
        if (F.tid < 256) {
            e = eidx[vb * 256 + F.tid];
            const unsigned long long lt = (1ull << F.lane) - 1ull;
#pragma unroll
            for (int k = 0; k < 16; ++k) { const unsigned long long mk = __ballot(e == k); if (e == k) rank = __popcll(mk & lt); if (F.lane == 0) wcnt[F.wave * 16 + k] = __popcll(mk); }
        }
        __syncthreads();
        if (F.tid < 256) {
            for (int w2 = 0; w2 < F.wave; ++w2) rank += wcnt[w2 * 16 + e];
            const int r = off[e] + base[e] + rank;
            pos[vb * 256 + F.tid] = r; tok[r] = vb * 128 + (F.tid >> 1);
        }
        if (vb < 16) { const int e2 = vb, r0 = off[e2] + tot[e2], r1 = off[e2 + 1]; for (int r = r0 + F.tid; r < r1; r += NTHREADS) tok[r] = 0; }
        if (vb == 16) {
            for (int tl = F.tid; tl < NTILE; tl += NTHREADS) { int e3 = -1;
#pragma unroll
                for (int k = 0; k < 16; ++k) if (tl * 256 >= off[k] && tl * 256 < off[k + 1]) e3 = k;
                tile_e[tl] = e3; }
            if (F.tid == 0) tile_e[NTILE] = off[16] >> 8;
        }
        __syncthreads();
    }
}
__device__ __forceinline__ void phase_pool(const Frame& F, const bf16_t* HP, unsigned char* PO) {
    constexpr int RUN = 16;
    const int gt = F.vcu * NTHREADS + F.tid, NGT = F.G * NTHREADS;
#pragma unroll 1
    for (int it = gt; it < (T / RUN) * (D / 8); it += NGT) {
        const int c8 = it & 127, run = it >> 7, g = c8 >> 5, win = 2 << g, t0 = run * RUN, ts0 = t0 & (S - 1);
        const bf16_t* hp = HP + (size_t)t0 * D + c8 * 8; unsigned char* po = PO + (size_t)t0 * D + c8 * 8;
        v4u raw[31];
#pragma unroll
        for (int j = 0; j < 31; ++j) { raw[j] = (v4u){0u, 0u, 0u, 0u}; if (j >= 15 || ts0 > 0) raw[j] = *(const v4u*)(hp + (ptrdiff_t)(j - 15) * D); }
        float s[8];
#pragma unroll
        for (int q = 0; q < 8; ++q) s[q] = 0.f;
#pragma unroll
        for (int k = 1; k < 16; ++k) { float v[8]; unpk8(raw[15 - k], v); const bool in = k < win;
#pragma unroll
            for (int q = 0; q < 8; ++q) s[q] += in ? v[q] : 0.f; }
#pragma unroll
        for (int i = 0; i < RUN; ++i) {
            float hn[8]; unpk8(raw[15 + i], hn);
            const int ts = ts0 + i;
#pragma unroll
            for (int q = 0; q < 8; ++q) s[q] += hn[q];
            const float inv = 1.f / (float)(ts + 1 < win ? ts + 1 : win);
            v2u o; const float xs = pg8::F8_XS; o.x = pg8::pk4_fp8((s[0] * inv - hn[0]) * xs, (s[1] * inv - hn[1]) * xs, (s[2] * inv - hn[2]) * xs, (s[3] * inv - hn[3]) * xs); o.y = pg8::pk4_fp8((s[4] * inv - hn[4]) * xs, (s[5] * inv - hn[5]) * xs, (s[6] * inv - hn[6]) * xs, (s[7] * inv - hn[7]) * xs);
            *(v2u*)(po + (size_t)i * D) = o;
            { const v4u r2 = raw[14 + i], r4 = raw[12 + i], r8 = raw[8 + i], r16 = raw[i]; v4u lv;
              lv.x = g == 0 ? r2.x : g == 1 ? r4.x : g == 2 ? r8.x : r16.x; lv.y = g == 0 ? r2.y : g == 1 ? r4.y : g == 2 ? r8.y : r16.y;
              lv.z = g == 0 ? r2.z : g == 1 ? r4.z : g == 2 ? r8.z : r16.z; lv.w = g == 0 ? r2.w : g == 1 ? r4.w : g == 2 ? r8.w : r16.w;
              float ho[8]; unpk8(lv, ho);
#pragma unroll
              for (int q = 0; q < 8; ++q) s[q] -= ho[q]; }
        }
    }
}
}
namespace mk {
typedef short bf16x8 __attribute__((ext_vector_type(8)));
typedef float f32x16 __attribute__((ext_vector_type(16)));
#define MFMA32(a, b, c) __builtin_amdgcn_mfma_f32_32x32x16_bf16((a), (b), (c), 0, 0, 0)
__device__ __forceinline__ int crow(int i, int h) { return (i & 3) + 8 * (i >> 2) + 4 * h; }
__device__ __forceinline__ float swap32_max(float v) { const auto r = __builtin_amdgcn_permlane32_swap(__float_as_uint(v), __float_as_uint(v), false, false); return fmaxf(__uint_as_float(r[0]), __uint_as_float(r[1])); }
__device__ __forceinline__ float swap32_sum(float v) { const auto r = __builtin_amdgcn_permlane32_swap(__float_as_uint(v), __float_as_uint(v), false, false); return __uint_as_float(r[0]) + __uint_as_float(r[1]); }
__device__ __forceinline__ unsigned pkbf(float lo, float hi) { unsigned r; asm volatile("v_cvt_pk_bf16_f32 %0, %1, %2" : "=v"(r) : "v"(lo), "v"(hi)); return r; }
__device__ __forceinline__ bf16x8 pack_step(const f32x16& x, int s) {
    v4u p; p.x = pkbf(x[8 * s + 0], x[8 * s + 1]); p.y = pkbf(x[8 * s + 2], x[8 * s + 3]); p.z = pkbf(x[8 * s + 4], x[8 * s + 5]); p.w = pkbf(x[8 * s + 6], x[8 * s + 7]);
    return __builtin_bit_cast(bf16x8, p);
}
__device__ __forceinline__ bf16x8 lds_frag2x8(const LAS unsigned char* p) {
    const v2u a = *(const LAS v2u*)p, b = *(const LAS v2u*)(p + 16);
    v4u q; q.x = a.x; q.y = a.y; q.z = b.x; q.w = b.y; return __builtin_bit_cast(bf16x8, q);
}
__device__ __forceinline__ void unpack8(const v4u u, float (&x)[8]) {
    x[0] = __uint_as_float(u.x << 16); x[1] = __uint_as_float(u.x & 0xffff0000u); x[2] = __uint_as_float(u.y << 16); x[3] = __uint_as_float(u.y & 0xffff0000u);
    x[4] = __uint_as_float(u.z << 16); x[5] = __uint_as_float(u.z & 0xffff0000u); x[6] = __uint_as_float(u.w << 16); x[7] = __uint_as_float(u.w & 0xffff0000u);
}

__device__ __forceinline__ v4u widen4x4(unsigned i0, unsigned i1, unsigned i2, unsigned i3) {
    const auto a = __builtin_amdgcn_permlane32_swap(i0, i2, false, false), b = __builtin_amdgcn_permlane32_swap(i1, i3, false, false);
    v4u v; v.x = a[0]; v.y = a[1]; v.z = b[0]; v.w = b[1]; return v;
}
constexpr float F8_MIXS = 8.f;
__device__ __forceinline__ void phase_swa_sgu(const Frame& F, const bf16_t* H0, const float* sinks, const float* lng, const float* lnb, const bf16_t* SW, const float* bs, unsigned char* MIX) {
    constexpr int KSTR = 272, VSTR = 520, VT_OFF = 256 * KSTR, VGSTR = 272, VGW = 64 * VGSTR;
    LAS unsigned char* KS = F.lds; LAS unsigned char* VT = F.lds + VT_OFF;
    LAS float* gbl = (LAS float*)(F.lds + 8 * VGW);
    for (int i = F.tid; i < 1024; i += NTHREADS) gbl[i] = i < 512 ? lng[i] : lnb[i - 512];
    const int lane = F.lane, r = lane & 31, h = lane >> 5, w = F.wave, kvh = w >> 2;
    const float NEG = -INFINITY;
    for (int vb = F.vcu; vb < T / 128; vb += F.G) {
        const int n = vb & 63; const size_t row0 = (size_t)vb * 128;
#pragma unroll
        for (int i = 0; i < 8; ++i) { const int p = F.tid + NTHREADS * i, row = p >> 4, c16 = p & 15; v4u v = (v4u){0u, 0u, 0u, 0u};
            if (n > 0 || row >= 128) v = *(const v4u*)(H0 + (row0 + row - 128) * NIN0 + 512 + c16 * 8);
            *(LAS v4u*)(KS + row * KSTR + c16 * 16) = v; }
#pragma unroll
        for (int i = 0; i < 8; ++i) { const int p = F.tid + NTHREADS * i, c16 = p >> 8, row = p & 255; v4u v = (v4u){0u, 0u, 0u, 0u};
            if (n > 0 || row >= 128) v = *(const v4u*)(H0 + (row0 + row - 128) * NIN0 + 640 + c16 * 8);
            LAS bf16_t* d = (LAS bf16_t*)(VT + (c16 * 8) * VSTR + row * 2);
            d[0 * (VSTR / 2)] = (bf16_t)(v.x & 0xffffu); d[1 * (VSTR / 2)] = (bf16_t)(v.x >> 16); d[2 * (VSTR / 2)] = (bf16_t)(v.y & 0xffffu); d[3 * (VSTR / 2)] = (bf16_t)(v.y >> 16);
            d[4 * (VSTR / 2)] = (bf16_t)(v.z & 0xffffu); d[5 * (VSTR / 2)] = (bf16_t)(v.z >> 16); d[6 * (VSTR / 2)] = (bf16_t)(v.w & 0xffffu); d[7 * (VSTR / 2)] = (bf16_t)(v.w >> 16); }
        __syncthreads();
        const float sink2 = sinks[w] * 1.4426950408889634f;
        bf16x8 qn[4];
        { const bf16_t* qp = H0 + (row0 + r) * NIN0 + w * 64 + 8 * h;
#pragma unroll
          for (int ks = 0; ks < 4; ++ks) qn[ks] = *(const bf16x8*)(qp + 16 * ks); }
#pragma unroll 1
        for (int qg = 0; qg < 4; ++qg) {
            bf16x8 qf[4];
#pragma unroll
            for (int ks = 0; ks < 4; ++ks) qf[ks] = qn[ks];
            if (qg < 3) { const bf16_t* qp = H0 + (row0 + 32 * (qg + 1) + r) * NIN0 + w * 64 + 8 * h;
#pragma unroll
              for (int ks = 0; ks < 4; ++ks) qn[ks] = *(const bf16x8*)(qp + 16 * ks); }
            f32x16 st[5];
#pragma unroll
            for (int kt = 0; kt < 5; ++kt) {
#pragma unroll
                for (int i = 0; i < 16; ++i) st[kt][i] = 0.f;
                const LAS unsigned char* kp = KS + (32 * qg + 32 * kt + r) * KSTR + (kvh * 64 + 8 * h) * 2;
#pragma unroll
                for (int ks = 0; ks < 4; ++ks) { const bf16x8 kf = *(const LAS bf16x8*)(kp + 32 * ks); st[kt] = MFMA32(kf, qf[ks], st[kt]); }
            }
            float m = sink2;
            int rq = r; asm volatile("" : "+v"(rq));
#pragma unroll
            for (int kt = 0; kt < 5; ++kt)
#pragma unroll
                for (int i = 0; i < 16; ++i) { const int dk = 32 * kt + crow(i, h) - rq;
                    float s = st[kt][i];
                    if (kt == 0) s = dk >= 1 ? s : NEG;
                    if (kt == 4) s = dk <= 128 ? s : NEG;
                    st[kt][i] = s; }
            if (n == 0) {
#pragma unroll
                for (int kt = 0; kt < 5; ++kt)
#pragma unroll
                    for (int i = 0; i < 16; ++i) if (32 * qg + 32 * kt + crow(i, h) < 128) st[kt][i] = NEG; }
#pragma unroll
            for (int kt = 0; kt < 5; ++kt)
#pragma unroll
                for (int i = 0; i < 16; ++i) m = fmaxf(m, st[kt][i]);
            m = swap32_max(m);
            float l;
            { f32x16 lv;
#pragma unroll
              for (int kt = 0; kt < 5; ++kt) { const f32x16 d = st[kt] - m; f32x16 p;
#pragma unroll
                  for (int i = 0; i < 16; ++i) p[i] = __builtin_amdgcn_exp2f(d[i]);
                  st[kt] = p; lv = kt == 0 ? p : lv + p; }
              l = 0.f;
#pragma unroll
              for (int i = 0; i < 16; i += 2) l += lv[i] + lv[i + 1]; }
            l = swap32_sum(l) + __builtin_amdgcn_exp2f(sink2 - m);
            f32x16 o[2];
#pragma unroll
            for (int i = 0; i < 16; ++i) { o[0][i] = 0.f; o[1][i] = 0.f; }
#pragma unroll
            for (int kt = 0; kt < 5; ++kt)
#pragma unroll
                for (int s = 0; s < 2; ++s) { const bf16x8 pf = pack_step(st[kt], s);
#pragma unroll
                    for (int dt = 0; dt < 2; ++dt) { const bf16x8 vf = lds_frag2x8(VT + (kvh * 64 + 32 * dt + r) * VSTR + (32 * qg + 32 * kt + 16 * s + 4 * h) * 2); o[dt] = MFMA32(vf, pf, o[dt]); } }
            const float inv = F8_MIXS / l;
            unsigned char* op = MIX + (row0 + 32 * qg + r) * D + w * 64 + 16 * h;
#pragma unroll
            for (int dt = 0; dt < 2; ++dt) { unsigned it4[4];
#pragma unroll
                for (int g4 = 0; g4 < 4; ++g4) it4[g4] = pg8::pk4_fp8(o[dt][4 * g4 + 0] * inv, o[dt][4 * g4 + 1] * inv, o[dt][4 * g4 + 2] * inv, o[dt][4 * g4 + 3] * inv);
                *(v4u*)(op + 32 * dt) = widen4x4(it4[0], it4[1], it4[2], it4[3]); }
        }
        __syncthreads();
        {
            LAS unsigned char* VG = F.lds + w * VGW; const int g = w;
            const int lane2 = (int)lane_id_fresh(), r2 = lane2 & 31, h2 = lane2 >> 5;
            v4u vraw[2][8];
#pragma unroll
            for (int it = 0; it < 2; ++it) { const bf16_t* vp = H0 + (row0 + 64 * it + lane2) * NIN0 + 1280 + g * 64;
#pragma unroll
                for (int cq = 0; cq < 8; ++cq) vraw[it][cq] = __builtin_nontemporal_load((const v4u*)(vp + 8 * cq)); }
#pragma unroll
            for (int it = 0; it < 2; ++it) { const int s = 64 * it + lane2;
                float x[8][8]; float sum = 0.f;
#pragma unroll
                for (int cq = 0; cq < 8; ++cq) { unpack8(vraw[it][cq], x[cq]);
#pragma unroll
                    for (int e = 0; e < 8; ++e) sum += x[cq][e]; }
                const float mu = sum * (1.f / 64.f); float q = 0.f;
#pragma unroll
                for (int cq = 0; cq < 8; ++cq)
#pragma unroll
                    for (int e = 0; e < 8; ++e) { x[cq][e] -= mu; q += x[cq][e] * x[cq][e]; }
                const float rstd = 1.f / sqrtf(q * (1.f / 64.f) + LN_EPS);
#pragma unroll
                for (int cq = 0; cq < 8; ++cq) { const LAS f32x4* gq = (const LAS f32x4*)(gbl + g * 64 + 8 * cq); const LAS f32x4* bq = (const LAS f32x4*)(gbl + 512 + g * 64 + 8 * cq);
                    const f32x4 g0 = gq[0], g1 = gq[1], b0 = bq[0], b1 = bq[1];
#pragma unroll
                    for (int e = 0; e < 8; e += 2) { const int c = 8 * cq + e;
                        const float ga = e < 4 ? g0[e & 3] : g1[e & 3], ba = e < 4 ? b0[e & 3] : b1[e & 3], gb_ = e < 4 ? g0[(e + 1) & 3] : g1[(e + 1) & 3], bb_ = e < 4 ? b0[(e + 1) & 3] : b1[(e + 1) & 3];
                        const unsigned p2 = pkbf(x[cq][e] * rstd * ga + ba, x[cq][e + 1] * rstd * gb_ + bb_);
                        *(LAS bf16_t*)(VG + c * VGSTR + s * 2) = (bf16_t)(p2 & 0xffffu); *(LAS bf16_t*)(VG + (c + 1) * VGSTR + s * 2) = (bf16_t)(p2 >> 16); } }
            }
            v2u uall[4][2][4];
#pragma unroll
            for (int tt = 0; tt < 4; ++tt) { const bf16_t* up = H0 + (row0 + 32 * tt + r2) * NIN0 + 768 + g * 64 + 4 * h2;
#pragma unroll
                for (int ct = 0; ct < 2; ++ct)
#pragma unroll
                    for (int g4 = 0; g4 < 4; ++g4) uall[tt][ct][g4] = *(const v2u*)(up + 32 * ct + 8 * g4); }
            LDS_WAIT();
#pragma unroll
            for (int tt = 0; tt < 4; ++tt) {
                f32x16 acc[2];
#pragma unroll
                for (int i = 0; i < 16; ++i) { acc[0][i] = 0.f; acc[1][i] = 0.f; }
                const bf16_t* wp = SW + ((size_t)(g * 128 + 32 * tt + r2) * 128 + 8 * h2);
                const int nks = 2 * (tt + 1);
                bf16x8 bfr[8];
#pragma unroll
                for (int ks = 0; ks < 8; ++ks) if (ks < nks) bfr[ks] = *(const bf16x8*)(wp + 16 * ks);
                const int t = 32 * tt + r2; const float bias = bs[g * 128 + t];
                unsigned char* op = MIX + (row0 + t) * D + 512 + g * 64 + 16 * h2;
#pragma unroll
                for (int ks = 0; ks < 8; ++ks) if (ks < nks) {
#pragma unroll
                    for (int ct = 0; ct < 2; ++ct) { const bf16x8 af = *(const LAS bf16x8*)(VG + (32 * ct + r2) * VGSTR + (16 * ks + 8 * h2) * 2); acc[ct] = MFMA32(af, bfr[ks], acc[ct]); } }
#pragma unroll
                for (int ct = 0; ct < 2; ++ct) { unsigned it4[4];
#pragma unroll
                    for (int g4 = 0; g4 < 4; ++g4) { const v2u u2 = uall[tt][ct][g4];
                        const float u0 = __uint_as_float(u2.x << 16), u1 = __uint_as_float(u2.x & 0xffff0000u), u2f = __uint_as_float(u2.y << 16), u3 = __uint_as_float(u2.y & 0xffff0000u);
                        it4[g4] = pg8::pk4_fp8(F8_MIXS * u0 * (acc[ct][4 * g4 + 0] + bias), F8_MIXS * u1 * (acc[ct][4 * g4 + 1] + bias), F8_MIXS * u2f * (acc[ct][4 * g4 + 2] + bias), F8_MIXS * u3 * (acc[ct][4 * g4 + 3] + bias)); }
                    *(v4u*)(op + 32 * ct) = widen4x4(it4[0], it4[1], it4[2], it4[3]); }
            }
        }
        __syncthreads();
    }
}

}
namespace mk {
constexpr int NPHASE = 23;
constexpr int N_EARLY = 896 + 2 * 1024, NITEMS = N_EARLY + 3 * 512 + 2 * (512 + 3 * 4096);
constexpr int GEMM_CUS_P1 = 160;

typedef const __attribute__((address_space(4))) Args* KArgs;
__device__ __forceinline__ KArgs kargs() { KArgs p = (KArgs)__builtin_amdgcn_kernarg_segment_ptr(); asm volatile("" : "+s"(p)); return p; }

__device__ __forceinline__ void decode_item(KArgs ka, bf16_t* WB, int it, TItem& t) {
                    int r = it;
#define JOB(MAP, F8_, src, K_, N_, dst, dstb, cnt) if (r < (cnt)) { titem_fill<MAP, F8_>(t, src, K_, N_, dst, dstb, r); return; } r -= (cnt);
                    JOB(0, true, ka->in[5], 1024, 1792, WB + WB_IN0, 0, 896)
                    JOB(0, false, ka->in[15], 1024, 2048, WB + WB_LAYER + WL_XKV, 0, 1024)
                    JOB(0, false, ka->in[31], 1024, 2048, WB + WB_LAYER + WL_SIZE + WL_XKV, 0, 1024)
                    JOB(0, true, ka->in[11], 1024, 1024, WB + WB_OUT0, 0, 512)
                    JOB(0, true, ka->in[24], 1024, 1024, WB + WB_IN1, 0, 512)
                    JOB(0, false, ka->in[27], 1024, 1024, WB + WB_OUT1, 0, 512)
#define LAYER_JOBS(l, c2) { bf16_t* Wl = WB + WB_LAYER + (size_t)(l) * WL_SIZE; \
                        JOB(0, false, ka->in[(c2) + 4], 1024, 1024, Wl + WL_XO, 0, 512) \
                        JOB(1, true, ka->in[(c2) + 7], 1024, 512, Wl + WL_GU, (size_t)1024 * 1024, 4096)     \
                        JOB(2, true, ka->in[(c2) + 8], 1024, 512, Wl + WL_GU, (size_t)1024 * 1024, 4096) \
                        JOB(0, true, ka->in[(c2) + 9], 512, 1024, Wl + WL_DN, (size_t)1024 * 512, 4096) }
                    LAYER_JOBS(0, 12)
                    LAYER_JOBS(1, 28)
#undef LAYER_JOBS
#undef JOB
}

__device__ __forceinline__ bool in_range(int k) { KArgs ka = kargs(); return ka->ph_lo <= k && k < ka->ph_hi; }

__global__ void __launch_bounds__(NTHREADS, 2) mega(Args a) {
    extern __shared__ __attribute__((aligned(16))) unsigned char lds_raw[];
    LAS unsigned char* const F0lds = (LAS unsigned char*)lds_raw;
    const int F0wave = __builtin_amdgcn_readfirstlane((int)threadIdx.x >> 6);
    const int F0G = gridDim.x, F0bx = blockIdx.x, F0vcu = (F0G % 8 == 0) ? (F0bx % 8) * (F0G / 8) + F0bx / 8 : F0bx;
    volatile LAS unsigned* MISC = (volatile LAS unsigned*)(F0lds + MISC_OFF);
    if (threadIdx.x < 64) MISC[threadIdx.x] = 0u;
    __syncthreads();
    unsigned* ctl = (unsigned*)(a.ws + WS_CTL);
    XcdBarrier bar = xcd_barrier_post(ctl + CW_BAR + a.ph_lo * XCD_BAR_WORDS, MISC + 8, F0wave);
#ifdef MK_PHASE_RANGE
#define IN(k) in_range(k)
#define SEAM(k) do { if (IN(k) && IN((k) + 1)) { XcdBarrier b2_ = bar; asm volatile("" : "+s"(b2_.bar), "+s"(b2_.x)); xcd_barrier(b2_); } } while (0)
#else
#define IN(k) true
#define SEAM(k) do { XcdBarrier b2_ = bar; asm volatile("" : "+s"(b2_.bar), "+s"(b2_.x)); xcd_barrier(b2_); } while (0)
#endif
#define PH KArgs ka = kargs(); unsigned char* ws = ka->ws; (void)ws; Frame Fp; Fp.lds = F0lds; Fp.wave = F0wave; Fp.vcu = F0vcu; Fp.G = F0G; Fp.bx = F0bx; asm volatile("" : "+s"(Fp.wave), "+s"(Fp.vcu), "+s"(Fp.G), "+s"(Fp.bx)); \
    Fp.lane = (int)lane_id_fresh(); Fp.tid = Fp.wave * 64 + Fp.lane; const Frame& F = Fp; \
    const int bx = Fp.bx; (void)bx; LAS unsigned char* glds = F.lds; (void)glds; \
    bf16_t* RA = (bf16_t*)(ws + WS_A); bf16_t* RB = (bf16_t*)(ws + WS_B); bf16_t* RC = (bf16_t*)(ws + WS_C); bf16_t* RD = (bf16_t*)(ws + WS_D); bf16_t* WB = (bf16_t*)(ws + WS_WB); \
    (void)RA; (void)RB; (void)RC; (void)RD; (void)WB;
#define PHC PH const int cb = L == 0 ? 12 : 28; (void)cb; bf16_t* WBl = WB + WB_LAYER + (size_t)L * WL_SIZE; (void)WBl; \
    bf16_t *Z1 = L == 0 ? RC : RD, *X2 = RA, *HS = RB, *DS = RD, *X3 = L == 0 ? RC : nullptr;   unsigned char *ZG8 = (unsigned char*)(L == 0 ? RD : RA), *P8 = (unsigned char*)(L == 0 ? RA : RC), *X2_8 = (unsigned char*)(L == 0 ? RD : RC); bf16_t* Y2 = RB; \
    (void)Z1; (void)P8; (void)ZG8; (void)X2_8; (void)Y2; (void)X2; (void)HS; (void)DS; (void)X3;
#ifndef DOUBLE_MASK
#define DOUBLE_MASK 0u
#endif
#if DOUBLE_MASK != 0
#define REP(k) for (int rep_ = 0, nrep_ = 1 + (int)((DOUBLE_MASK >> (k)) & 1u); rep_ < nrep_; ++rep_)
#else
#define REP(k)
#endif
#define INF(i) ((const float*)ka->in[i])
#define WSI(off) ((int*)(ws + (off)))
#define WSF(off) ((float*)(ws + (off)))

#define GEMM_STD(EPI, ORD, LDA_, LDB_, K_) pg8::gemm_phase<EPI, ORD, true, true, false, LDA_, LDB_, K_>(glds, F.tid, g, S, E)
    for (int L = 0; L < 2; ++L) {
        const int cbp = L == 0 ? 0 : 11;
        if (L == 0) {
            if (IN(0)) REP(0) { PH
                LAS float* scrA = (LAS float*)(F.lds + F.wave * 16896), * scrB = scrA + 64 * 33;
                const int gw = F.vcu * NWAVES + F.wave, NGW = F.G * NWAVES;
                for (int it = gw; it < N_EARLY; it += 2 * NGW) {
                    TItem ta, tb; TRegs ra, rb; const int itb = it + NGW < N_EARLY ? it + NGW : it;
                    decode_item(ka, WB, it, ta); titem_load(ta, F.lane, ra);
                    decode_item(ka, WB, itb, tb); titem_load(tb, F.lane, rb);
                    titem_finish(ta, F.lane, ra, scrA);
                    titem_finish(tb, F.lane, rb, scrB);
                }
                const int gt = F.vcu * NTHREADS + F.tid, NGT = F.G * NTHREADS;
                { const float4* x4 = (const float4*)ka->in[0]; unsigned* o8 = (unsigned*)RB;
                  for (int i = gt; i < T * D / 4; i += 4 * NGT) { float4 v[4];
#pragma unroll
                      for (int k = 0; k < 4; ++k) { const f32x4 t_ = __builtin_nontemporal_load((const f32x4*)(x4 + i + k * NGT)); v[k] = make_float4(t_[0], t_[1], t_[2], t_[3]); }
#pragma unroll
                      for (int k = 0; k < 4; ++k) {
                          o8[i + k * NGT] = pg8::pk4_fp8(v[k].x * pg8::F8_XS, v[k].y * pg8::F8_XS, v[k].z * pg8::F8_XS, v[k].w * pg8::F8_XS); } } }
                { const float4* m4 = (const float4*)ka->in[1]; v2u* o = (v2u*)(ws + WS_MEMB);
                  for (int i = gt; i < B * MEM * D / 4; i += NGT) { const float4 v = m4[i]; v2u w; w.x = pk2(v.x, v.y); w.y = pk2(v.z, v.w); o[i] = w; } }
                { const int* positions = (const int*)ka->in[2]; float* ropew = WSF(WS_ROPE);
                  for (int t = gt; t < T; t += NGT) { const float p = (float)positions[t];
#pragma unroll
                      for (int j = 0; j < 8; ++j) { const float ang = p * ka->inv.f[j]; double rev = (double)ang * 0.15915494309189535; rev -= rint(rev); const float rr = (float)rev;
                          ropew[(size_t)t * 16 + j] = __builtin_amdgcn_cosf(rr); ropew[(size_t)t * 16 + 8 + j] = __builtin_amdgcn_sinf(rr); } } }
            }
            { XcdBarrier b2_ = bar; asm volatile("" : "+s"(b2_.bar), "+s"(b2_.x)); xcd_barrier(b2_, !(F0G >= 256 && F0bx >= GEMM_CUS_P1)); }
            if (IN(1)) REP(1) { PH float* rope = WSF(WS_ROPE); bf16_t* MEMB = (bf16_t*)(ws + WS_MEMB);
              const int GC = F.G >= 256 ? GEMM_CUS_P1 : F.G;
              if (bx >= GC || F.G < 256) {
                const int cid = F.G >= 256 ? bx - GC : bx, NC = F.G >= 256 ? F.G - GC : F.G;
                LAS float* scrA = (LAS float*)(F.lds + F.wave * 16896), * scrB = scrA + 64 * 33;
                const int gw = cid * NWAVES + F.wave, NGW = NC * NWAVES;
#define CLAMP_IT(x) ((x) < NITEMS ? (x) : NITEMS - 1)
                { TItem ta, tb, tc, td; TRegs ra, rb, rc, rd; int it = N_EARLY + gw;
                  decode_item(ka, WB, CLAMP_IT(it), ta); titem_load(ta, F.lane, ra);
                  decode_item(ka, WB, CLAMP_IT(it + NGW), tb); titem_load(tb, F.lane, rb);
                  for (; it < NITEMS; it += 4 * NGW) {
                      decode_item(ka, WB, CLAMP_IT(it + 2 * NGW), tc); titem_load(tc, F.lane, rc);
                      decode_item(ka, WB, CLAMP_IT(it + 3 * NGW), td); titem_load(td, F.lane, rd);
                      titem_finish(ta, F.lane, ra, scrA); titem_finish(tb, F.lane, rb, scrB);
                      decode_item(ka, WB, CLAMP_IT(it + 4 * NGW), ta); titem_load(ta, F.lane, ra);
                      decode_item(ka, WB, CLAMP_IT(it + 5 * NGW), tb); titem_load(tb, F.lane, rb);
                      titem_finish(tc, F.lane, rc, scrA); titem_finish(td, F.lane, rd, scrB);
                  } }
#undef CLAMP_IT
                const int gt = cid * NTHREADS + F.tid, NGT = NC * NTHREADS;
#pragma unroll
                for (int l = 0; l < 2; ++l) { const float4* q4 = (const float4*)ka->in[l == 0 ? 14 : 30]; v2u* o = (v2u*)(WB + WB_LAYER + (size_t)l * WL_SIZE + WL_XQ);
                  for (int i = gt; i < D * D / 4; i += NGT) { const float4 v = q4[i]; v2u w; w.x = pk2(v.x, v.y); w.y = pk2(v.z, v.w); o[i] = w; } }
                { const float4* p4 = (const float4*)ka->in[25]; const float4* s4 = (const float4*)ka->in[26]; v2u* o = (v2u*)(WB + WB_POOL);
                  for (int i = gt; i < 4 * 256 * 256 / 4; i += NGT) { const float4 v = p4[i]; const float4 sc = s4[(i >> 14) * 64 + (i & 63)]; v2u w; w.x = pk2(v.x * sc.x, v.y * sc.y); w.y = pk2(v.z * sc.z, v.w * sc.w); o[i] = w; } }
                { const float* sw = INF(9); bf16_t* o = WB + WB_SGUW;
                  for (int i = gt; i < 8 * 128 * 128; i += NGT) { const int s2 = i & 127, t = (i >> 7) & 127; o[i] = f2bf(s2 <= t ? sw[i] : 0.f); } }
                __syncthreads();
              }
              if (bx < GC) {
#pragma unroll 1
                for (int l = 0; l < 2; ++l) {
                    bf16_t* Wl = WB + WB_LAYER + (size_t)l * WL_SIZE;
                    pg8::Gemm g{MEMB, Wl + WL_XKV, nullptr, nullptr};
                    const int c2 = bx - 96 - 32 * l;
                    pg8::StaticOrder S; S.init(B * MEM, 2048, GC, (c2 >= 0 && c2 < 32) ? c2 : (1 << 20), D, D);
                    pg8::EpiBf16 E{(bf16_t*)(ws + WS_MEMKV) + (size_t)l * B * MEM * 2048, 2048, 1.f};
                    GEMM_STD(pg8::EpiBf16, pg8::StaticOrder, D, D, D);
                }
                {
                    pg8::Gemm g{RB, WB + WB_IN0, nullptr, nullptr};
                    pg8::StaticOrder S; S.init(T, NIN0, GC, bx, D, D);
                    pg8::EpiInproj0 E{RD, rope, 1.f / (pg8::F8_XS * pg8::F8_WS)};
                    pg8::gemm_phase<pg8::EpiInproj0, pg8::StaticOrder, true, true, false, D, D, D, true>(glds, F.tid, g, S, E);
                }
              }
            }
            if (F0G >= 256 && F0bx >= GEMM_CUS_P1) { XcdBarrier b2_ = bar; asm volatile("" : "+s"(b2_.bar), "+s"(b2_.x)); xcd_barrier_settle(b2_, 0u); }
            SEAM(1);
            if (IN(2)) REP(2) { PH
                { bf16_t* Wl = WB + WB_LAYER; const bf16_t* KV = (const bf16_t*)(ws + WS_MEMKV);
                  { pg8::Gemm g{KV, Wl + WL_XQ, nullptr, nullptr}; pg8::SetupOrder<0> S; S.init(bx, 0, 64); pg8::EpiF8 E{ws + WS_MT, D, QSCALE * pg8::F8_MS}; GEMM_STD(pg8::EpiF8, pg8::SetupOrder<0>, 2048, 1024, 256); }
                  { pg8::Gemm g{Wl + WL_XO, KV, nullptr, nullptr}; pg8::SetupOrder<1> S; S.init(bx, 64, 64); pg8::EpiF8 E{ws + WS_NT, D, pg8::F8_NS}; GEMM_STD(pg8::EpiF8, pg8::SetupOrder<1>, 1024, 2048, 256); }
                  { pg8::Gemm g{WB + WB_OUT1, WB + WB_POOL, nullptr, nullptr}; pg8::SetupOrder<2> S; S.init(bx, 128, 16); pg8::EpiF8 E{(unsigned char*)(WB + WB_WEFF), D, pg8::F8_WS}; GEMM_STD(pg8::EpiF8, pg8::SetupOrder<2>, 1024, 256, 256); } }
                phase_swa_sgu(F, RD, INF(6), INF(7), INF(8), WB + WB_SGUW, INF(10), (unsigned char*)RB);
            }
            SEAM(2);
            if (IN(3)) REP(3) { PH
                phase_cvec(F, ws + WS_MT, INF(12), INF(13), WSF(WS_CV));
                pg8::Gemm g{RB, WB + WB_OUT0, nullptr, nullptr};
                pg8::StaticOrder S; S.init(T, D, F.G, bx, D, D);
                pg8::EpiZT<true> E{RC, (unsigned char*)RD, WSF(WS_PART), ka->in[0], INF(12), 1.f / (F8_MIXS * pg8::F8_WS)};
                pg8::gemm_phase<pg8::EpiZT<true>, pg8::StaticOrder, true, true, false, D, D, D, true>(glds, F.tid, g, S, E);
            }
            SEAM(3);
        } else {
            if (IN(12)) REP(12) { PH
                pg8::Gemm g{RB, WB + WB_IN1, nullptr, nullptr};
                pg8::StaticOrder S; S.init(T, D, F.G, bx, D, D);
                pg8::EpiBf16 E{RA, D, 1.f / (pg8::F8_XS * pg8::F8_WS)};
                pg8::gemm_phase<pg8::EpiBf16, pg8::StaticOrder, true, true, false, D, D, D, true>(glds, F.tid, g, S, E);
            }
            SEAM(12);
            if (IN(13)) REP(13) { PH
                if (F.G < 256) { bf16_t* Wl = WB + WB_LAYER + WL_SIZE; const bf16_t* KV = (const bf16_t*)(ws + WS_MEMKV) + (size_t)B * MEM * 2048;
                  { pg8::Gemm g{KV, Wl + WL_XQ, nullptr, nullptr}; pg8::SetupOrder<0> S; S.init(bx, 0, 64); pg8::EpiF8 E{ws + WS_MT, D, QSCALE * pg8::F8_MS}; GEMM_STD(pg8::EpiF8, pg8::SetupOrder<0>, 2048, 1024, 256); }
                  { pg8::Gemm g{Wl + WL_XO, KV, nullptr, nullptr}; pg8::SetupOrder<1> S; S.init(bx, 64, 64); pg8::EpiF8 E{ws + WS_NT, D, pg8::F8_NS}; GEMM_STD(pg8::EpiF8, pg8::SetupOrder<1>, 1024, 2048, 256); } }
                phase_pool(F, RA, (unsigned char*)RB);
            }
            SEAM(13);
            if (IN(14)) REP(14) { PH
                if (F.G < 256) phase_cvec(F, ws + WS_MT, INF(28), INF(29), WSF(WS_CV));
                pg8::Gemm g{RB, WB + WB_WEFF, nullptr, nullptr};
                pg8::StaticOrder S; S.init(T, D, F.G, bx, D, D);
                pg8::EpiZT<false> E{RD, (unsigned char*)RA, WSF(WS_PART), RC, INF(28), 1.f / (pg8::F8_XS * pg8::F8_WS)};
                pg8::gemm_phase<pg8::EpiZT<false>, pg8::StaticOrder, true, true, false, D, D, D, true>(glds, F.tid, g, S, E);
            }
            SEAM(14);
        }
        if (IN(cbp + 5)) REP(cbp + 5) { PHC
            pg8::Gemm g{(const bf16_t*)ZG8, (const bf16_t*)(ws + WS_MT), nullptr, nullptr};
            pg8::BatchOrder S; S.init(T, D, F.G, bx, D, D);
            LAS float* stl = (LAS float*)(F.lds + 131072 + 8192); LAS float* cvl = stl + 2048; LAS int* tagl = (LAS int*)(cvl + 2048);
            scores_prepass(F, S, WSF(WS_PART), WSF(WS_CV), WSF(WS_STAT), 1.f / (pg8::F8_XS * pg8::F8_MS), stl, cvl, tagl);
            pg8::EpiSoftmaxT<true> E{P8, (LAS float*)(F.lds + 131072), (const LAS pg8::f32x2*)stl, (const LAS pg8::f32x2*)cvl, tagl};
            pg8::gemm_phase<pg8::EpiSoftmaxT<true>, pg8::BatchOrder, true, true, false, D, D, D, true>(glds, F.tid, g, S, E);
        }
        SEAM(cbp + 5);
        if (IN(cbp + 6)) REP(cbp + 6) { PHC
            pg8::Gemm g{(const bf16_t*)P8, (const bf16_t*)(ws + WS_NT), nullptr, nullptr};
            pg8::BatchOrder S; S.init(T, D, F.G, bx, D, D);
            pg8::EpiF8C E{(unsigned char*)Y2, D, pg8::F8_YS / (pg8::F8_PS * pg8::F8_NS)};
            pg8::gemm_phase<pg8::EpiF8C, pg8::BatchOrder, true, true, false, D, D, D, true>(glds, F.tid, g, S, E);
        }
        SEAM(cbp + 6);
        if (IN(cbp + 7)) REP(cbp + 7) { PHC phase_ln_router(F, Z1, WSF(WS_STAT), INF(cb), INF(cb + 1), (const unsigned char*)Y2, INF(cb + 5), INF(cb + 6), X2, X2_8, INF(3), INF(4), WSI(WS_POS), WSF(WS_EWGT), (unsigned*)(ws + WS_CTL) + 12288 + 32 * L, WSI(WS_TOKE)); }
        SEAM(cbp + 7);
        if (IN(cbp + 9)) REP(cbp + 9) { PHC LAS int* offl = (LAS int*)(F.lds + 147456); moe_offsets(F, (unsigned*)(ws + WS_CTL) + 12288 + 32 * L, offl); const LAS int* tile_e = offl + 64; const int* tok = WSI(WS_TOKE);
            const int ntiles = __builtin_amdgcn_readfirstlane(offl[16] >> 8);
            pg8::Gemm g{(const bf16_t*)X2_8, WBl + WL_GU, tok, (LAS int*)(F.lds + 131072), offl};
            pg8::MoeOrder S; S.init(ntiles, tile_e, F.G, bx, D, D);
            pg8::EpiGU8 E{(unsigned char*)HS};
            pg8::gemm_phase<pg8::EpiGU8, pg8::MoeOrder, true, true, true, D, D, D, true>(glds, F.tid, g, S, E);
            if (L == 0 && F0G >= 256) {
                int nb = 4 * ntiles - 4 * F0G; nb = nb < 0 ? 0 : nb;
                const int fc = F0bx - nb;
                if (fc >= 0 && fc < 128) {
                    KArgs ka2 = kargs(); unsigned char* ws2 = ka2->ws; bf16_t* Wl2 = (bf16_t*)(ws2 + WS_WB) + WB_LAYER + WL_SIZE; const bf16_t* KV2 = (const bf16_t*)(ws2 + WS_MEMKV) + (size_t)B * MEM * 2048;
                    const int tid2 = F0wave * 64 + (int)lane_id_fresh();
                    { pg8::Gemm g2{KV2, Wl2 + WL_XQ, nullptr, nullptr}; pg8::SetupOrder<0> S2; S2.init(fc, 0, 64); pg8::EpiF8 E2{ws2 + WS_MT, D, QSCALE * pg8::F8_MS}; pg8::gemm_phase<pg8::EpiF8, pg8::SetupOrder<0>, true, true, false, 2048, 1024, 256>(F0lds, tid2, g2, S2, E2); }
                    { pg8::Gemm g2{Wl2 + WL_XO, KV2, nullptr, nullptr}; pg8::SetupOrder<1> S2; S2.init(fc, 64, 64); pg8::EpiF8 E2{ws2 + WS_NT, D, pg8::F8_NS}; pg8::gemm_phase<pg8::EpiF8, pg8::SetupOrder<1>, true, true, false, 1024, 2048, 256>(F0lds, tid2, g2, S2, E2); }
                }
            }
        }
        SEAM(cbp + 9);
        if (IN(cbp + 10)) REP(cbp + 10) { PHC LAS int* offl = (LAS int*)(F.lds + 147456); const LAS int* tile_e = offl + 64;
            const int ntiles = __builtin_amdgcn_readfirstlane(offl[16] >> 8);
            pg8::Gemm g{HS, WBl + WL_DN, nullptr, nullptr};
            pg8::MoeOrder S; S.init(ntiles, tile_e, F.G, bx, DE, DE);
            pg8::EpiF8C E{(unsigned char*)DS, D, pg8::F8_DS / (pg8::F8_HS * pg8::F8_WS)};
            pg8::gemm_phase<pg8::EpiF8C, pg8::MoeOrder, true, true, false, DE, DE, DE, true>(glds, F.tid, g, S, E);
            if (L == 0 && F0G >= 256) {
                int nb = 4 * ntiles - 4 * F0G; nb = nb < 0 ? 0 : nb;
                if (F0bx >= nb) { KArgs ka2 = kargs(); Frame F2; F2.lds = F0lds; F2.wave = F0wave; F2.bx = F0bx; F2.G = F0G - nb; F2.vcu = F0bx - nb; F2.lane = (int)lane_id_fresh(); F2.tid = F0wave * 64 + F2.lane;
                    phase_cvec(F2, ka2->ws + WS_MT, (const float*)ka2->in[28], (const float*)ka2->in[29], (float*)(ka2->ws + WS_CV)); }
            }
        }
        SEAM(cbp + 10);
        if (IN(cbp + 11)) REP(cbp + 11) { PHC LAS int* offl = (LAS int*)(F.lds + 147456); phase_ln_moe(F, X2, (const unsigned char*)DS, offl, WSI(WS_POS), WSF(WS_EWGT), INF(cb + 10), INF(cb + 11), X3, L == 1 ? ka->out : nullptr, L == 0 ? (unsigned char*)RB : nullptr); }
        if (L == 0) SEAM(cbp + 11);
    }
#undef GEMM_STD
#undef IN
#undef SEAM
#undef INF
#undef PH
#undef PHC
#undef WSI
#undef WSF
}
}
using namespace nv;
extern "C" void kernel_launch(void* const* d_in, const int* in_sizes, int n_in, void* d_out, int out_size, void* d_ws, size_t ws_size, hipStream_t stream) {
    (void)in_sizes; (void)out_size;
    if (ws_size < WS_END || n_in != 40) return;
    static int grid = 0;
    if (grid == 0) {
        int dev = 0, cus = 0;
        if (hipGetDevice(&dev) != hipSuccess || hipDeviceGetAttribute(&cus, hipDeviceAttributeMultiprocessorCount, dev) != hipSuccess) { grid = -1; return; }
        if (hipFuncSetAttribute((const void*)mk::mega, hipFuncAttributeMaxDynamicSharedMemorySize, mk::LDS_BYTES) != hipSuccess) { grid = -1; return; }
        int per_cu = 0;
        if (hipOccupancyMaxActiveBlocksPerMultiprocessor(&per_cu, (const void*)mk::mega, mk::NTHREADS, mk::LDS_BYTES) != hipSuccess || per_cu < 1) { (void)hipGetLastError(); }
        grid = cus;
    }
    if (grid < 0) return;
    unsigned char* ws = (unsigned char*)d_ws;
    (void)hipMemsetAsync(ws + WS_CTL, 0, mk::CTL_ZERO_BYTES, stream);
    mk::Args a{};
    for (int i = 0; i < 40; ++i) a.in[i] = d_in[i];
    a.out = (float*)d_out; a.ws = ws;
    for (int j = 0; j < 8; ++j) a.inv.f[j] = (float)pow(500000.0, -(double)((float)j * 2.0f / 16.0f));
    a.ph_lo = 0; a.ph_hi = mk::NPHASE;
    hipLaunchKernelGGL(mk::mega, dim3(grid), dim3(mk::NTHREADS), mk::LDS_BYTES, stream, a);
}
```
